# Optimizing an MI355X kernel written in HIP

```python
import math
import jax, jax.numpy as jnp
from jax import lax
import numpy as np

D_MODEL = 1024
BATCH = 8
SEQ = 2048
DEPTH = 1
DEC_BATCH = 128
DEC_SEQ = 4
PAST_LEN = 16384
PAGE_SIZE = 128

D_RG = D_MODEL
RG_BLOCKS = 8
RG_BLOCK_W = D_RG // RG_BLOCKS
RG_C = 8.0
CONV_W = 4
D_SSD = D_MODEL
SSD_HEAD_DIM = 64
SSD_HEADS = D_SSD // SSD_HEAD_DIM
SSD_GROUPS = 2
SSD_STATE = 128
SSD_CHUNK = 128
D_SSD_CONV = D_SSD + 2 * SSD_GROUPS * SSD_STATE
D_XA = D_MODEL
MEM_HEADS = 4
MEM_HEAD_DIM = D_XA // MEM_HEADS
N_MEM = 256
D_MIX = D_RG + D_SSD + D_XA
IN_SIZES = (D_RG, D_RG, D_SSD_CONV, D_SSD, SSD_HEADS, D_XA, D_XA)
D_IN = sum(IN_SIZES)
DEEPNORM_ALPHA = (2 * DEPTH) ** 0.25
DEEPNORM_BETA = (8 * DEPTH) ** -0.25
LN_EPS = 1e-5
RMS_EPS = 1e-5

kernel_name = 'hymba_style_rglru_ssd_memxattn_step'


def _causal_conv(u, buf, w, b):
    seqlen = u.shape[1]
    up = jnp.concatenate([buf.astype(jnp.float32), u], axis=1)
    w = w.astype(jnp.float32)
    y = up[:, 0:seqlen] * w[0]
    for k in range(1, CONV_W):
        y = y + up[:, k:k + seqlen] * w[k]
    return y + b.astype(jnp.float32), up[:, -(CONV_W - 1):]


def _rg_lru(u, h0, w_a, b_a, w_i, b_i, lam):
    bsz, seqlen, _ = u.shape
    f32 = jnp.float32
    ub = u.reshape(bsz, seqlen, RG_BLOCKS, RG_BLOCK_W)
    r = jax.nn.sigmoid(jnp.einsum('blki,kij->blkj', ub, w_a.astype(f32)).reshape(bsz, seqlen, D_RG) + b_a.astype(f32))
    i = jax.nn.sigmoid(jnp.einsum('blki,kij->blkj', ub, w_i.astype(f32)).reshape(bsz, seqlen, D_RG) + b_i.astype(f32))
    log_a = -RG_C * r * jax.nn.softplus(-lam.astype(f32))
    a = jnp.exp(log_a)
    bterm = jnp.sqrt(-jnp.expm1(2.0 * log_a)) * (i * u)
    bterm = bterm.at[:, 0].add(a[:, 0] * h0.astype(f32))

    def combine(left, right):
        a1, b1 = left
        a2, b2 = right
        return a1 * a2, a2 * b1 + b2

    _, h = lax.associative_scan(combine, (a, bterm), axis=1)
    return h, h[:, -1]


def _ssd_chunked(x, dt, a, bmat, cmat, h0):
    bsz, seqlen = x.shape[:2]
    q = SSD_CHUNK if seqlen % SSD_CHUNK == 0 else seqlen
    c = seqlen // q
    hg = SSD_HEADS // SSD_GROUPS
    xs = (x * dt[..., None]).reshape(bsz, c, q, SSD_GROUPS, hg, SSD_HEAD_DIM)
    da = (dt * a).reshape(bsz, c, q, SSD_GROUPS, hg)
    bc = bmat.reshape(bsz, c, q, SSD_GROUPS, SSD_STATE)
    cc = cmat.reshape(bsz, c, q, SSD_GROUPS, SSD_STATE)
    acum = jnp.cumsum(da, axis=2)
    causal = jnp.tril(jnp.ones((q, q), dtype=bool))
    seg = acum[:, :, :, None] - acum[:, :, None, :]
    decay = jnp.exp(jnp.where(causal[None, None, :, :, None, None], seg, -jnp.inf))
    cb = jnp.einsum('bcign,bcjgn->bcijg', cc, bc)
    y_diag = jnp.einsum('bcijg,bcijgh,bcjghp->bcighp', cb, decay, xs)
    decay_to_end = jnp.exp(acum[:, :, -1:] - acum)
    chunk_states = jnp.einsum('bcjgn,bcjgh,bcjghp->bcghpn', bc, decay_to_end, xs)
    chunk_decay = jnp.exp(acum[:, :, -1])

    def step(h, inp):
        st, dec = inp
        return h * dec[..., None, None] + st, h

    h0g = h0.reshape(bsz, SSD_GROUPS, hg, SSD_HEAD_DIM, SSD_STATE)
    h_last, h_in = lax.scan(step, h0g, (jnp.moveaxis(chunk_states, 1, 0), jnp.moveaxis(chunk_decay, 1, 0)))
    h_in = jnp.moveaxis(h_in, 0, 1)
    y_off = jnp.einsum('bcign,bcghpn,bcigh->bcighp', cc, h_in, jnp.exp(acum))
    y = (y_diag + y_off).reshape(bsz, seqlen, SSD_HEADS, SSD_HEAD_DIM)
    return y, h_last.reshape(bsz, SSD_HEADS, SSD_HEAD_DIM, SSD_STATE)


def _layer(x, mem_k, mem_v, rg_buf, rg_h0, ssd_buf, ssd_h0, wl):
    (w_in, rg_conv_w, rg_conv_b, w_rg_a, b_rg_a, w_rg_i, b_rg_i, rg_lambda,
     ssd_conv_w, ssd_conv_b, ssd_dt_bias, ssd_a_log, ssd_d, ssd_norm_g,
     w_out, ln_g, ln_b) = wl
    f32 = jnp.float32
    bsz, seqlen, _ = x.shape
    xf = x.astype(f32)
    proj = xf @ w_in.astype(f32)
    offs = np.cumsum(IN_SIZES)[:-1].tolist()
    rg_x, rg_gate, ssd_xbc, ssd_z, ssd_dt, xa_q, xa_gate = jnp.split(proj, offs, axis=-1)

    rg_u, rg_buf_new = _causal_conv(rg_x, rg_buf, rg_conv_w, rg_conv_b)
    rg_h, rg_h_last = _rg_lru(rg_u, rg_h0, w_rg_a, b_rg_a, w_rg_i, b_rg_i, rg_lambda)
    rg_out = rg_h * jax.nn.silu(rg_gate)

    xbc, ssd_buf_new = _causal_conv(ssd_xbc, ssd_buf, ssd_conv_w, ssd_conv_b)
    xbc = jax.nn.silu(xbc)
    gn = SSD_GROUPS * SSD_STATE
    s_x = xbc[..., :D_SSD].reshape(bsz, seqlen, SSD_HEADS, SSD_HEAD_DIM)
    s_b = xbc[..., D_SSD:D_SSD + gn].reshape(bsz, seqlen, SSD_GROUPS, SSD_STATE)
    s_c = xbc[..., D_SSD + gn:].reshape(bsz, seqlen, SSD_GROUPS, SSD_STATE)
    dt = jax.nn.softplus(ssd_dt + ssd_dt_bias.astype(f32))
    a = -jnp.exp(ssd_a_log.astype(f32))
    s_y, ssd_h_last = _ssd_chunked(s_x, dt, a, s_b, s_c, ssd_h0.astype(f32))
    s_y = s_y + ssd_d.astype(f32)[:, None] * s_x
    s_y = s_y.reshape(bsz, seqlen, D_SSD) * jax.nn.silu(ssd_z)
    s_y = s_y.reshape(bsz, seqlen, SSD_GROUPS, D_SSD // SSD_GROUPS)
    s_y = s_y * lax.rsqrt(jnp.mean(s_y * s_y, axis=-1, keepdims=True) + RMS_EPS)
    ssd_out = s_y.reshape(bsz, seqlen, D_SSD) * ssd_norm_g.astype(f32)

    q = xa_q.reshape(bsz, seqlen, MEM_HEADS, MEM_HEAD_DIM)
    s = jnp.einsum('blhd,bmhd->bhlm', q, mem_k.astype(f32)) * (MEM_HEAD_DIM ** -0.5)
    pr = jax.nn.softmax(s, axis=-1)
    o = jnp.einsum('bhlm,bmhd->blhd', pr, mem_v.astype(f32)).reshape(bsz, seqlen, D_XA)
    xa_out = o * jax.nn.silu(xa_gate)

    mix = jnp.concatenate([rg_out, ssd_out, xa_out], axis=-1) @ w_out.astype(f32)
    res = DEEPNORM_ALPHA * xf + mix
    mu = jnp.mean(res, axis=-1, keepdims=True)
    var = jnp.mean(jnp.square(res - mu), axis=-1, keepdims=True)
    y = (res - mu) * lax.rsqrt(var + LN_EPS) * ln_g.astype(f32) + ln_b.astype(f32)
    od = x.dtype
    return y.astype(od), rg_buf_new.astype(od), rg_h_last.astype(od), ssd_buf_new.astype(od), ssd_h_last.astype(od)


def setup_inputs(seed: int = 0) -> dict:
    key = jax.random.key(seed)
    ks = jax.random.split(key, 32)
    f32 = jnp.float32

    def nrm(k, shape, scale=1.0):
        return jax.random.normal(k, shape, f32) * scale

    x_prompt = nrm(ks[0], (BATCH, SEQ, D_MODEL))
    x_sample = nrm(ks[1], (DEC_BATCH, DEC_SEQ, D_MODEL))
    mem_prompt = nrm(ks[2], (BATCH, N_MEM, D_MODEL))
    state_rg_conv = nrm(ks[3], (DEPTH, DEC_BATCH, CONV_W - 1, D_RG))
    state_rg_h = nrm(ks[4], (DEPTH, DEC_BATCH, D_RG), 0.5)
    state_ssd_conv = nrm(ks[5], (DEPTH, DEC_BATCH, CONV_W - 1, D_SSD_CONV))
    state_ssd_h = nrm(ks[6], (DEPTH, DEC_BATCH, SSD_HEADS, SSD_HEAD_DIM, SSD_STATE), 0.1)
    cache_mem_k = nrm(ks[7], (DEPTH, DEC_BATCH, N_MEM, MEM_HEADS, MEM_HEAD_DIM))
    cache_mem_v = nrm(ks[8], (DEPTH, DEC_BATCH, N_MEM, MEM_HEADS, MEM_HEAD_DIM), DEEPNORM_BETA)
    w_in = nrm(ks[9], (DEPTH, D_MODEL, D_IN), D_MODEL ** -0.5)
    rg_conv_w = nrm(ks[10], (DEPTH, CONV_W, D_RG), CONV_W ** -0.5)
    rg_conv_b = nrm(ks[11], (DEPTH, D_RG), 0.01)
    w_rg_a = nrm(ks[12], (DEPTH, RG_BLOCKS, RG_BLOCK_W, RG_BLOCK_W), RG_BLOCK_W ** -0.5)
    b_rg_a = nrm(ks[13], (DEPTH, D_RG), 0.01)
    w_rg_i = nrm(ks[14], (DEPTH, RG_BLOCKS, RG_BLOCK_W, RG_BLOCK_W), RG_BLOCK_W ** -0.5)
    b_rg_i = nrm(ks[15], (DEPTH, D_RG), 0.01)
    a0 = jax.random.uniform(ks[16], (DEPTH, D_RG), f32, 0.9, 0.999)
    rg_lambda = jnp.log(a0) - jnp.log1p(-a0)
    ssd_conv_w = nrm(ks[17], (DEPTH, CONV_W, D_SSD_CONV), CONV_W ** -0.5)
    ssd_conv_b = nrm(ks[18], (DEPTH, D_SSD_CONV), 0.01)
    dt0 = jnp.exp(jax.random.uniform(ks[19], (DEPTH, SSD_HEADS), f32, math.log(1e-3), math.log(1e-1)))
    ssd_dt_bias = dt0 + jnp.log(-jnp.expm1(-dt0))
    ssd_a_log = jnp.log(jax.random.uniform(ks[20], (DEPTH, SSD_HEADS), f32, 1.0, 16.0))
    ssd_d = 1.0 + nrm(ks[21], (DEPTH, SSD_HEADS), 0.1)
    ssd_norm_g = 1.0 + nrm(ks[22], (DEPTH, D_SSD), 0.1)
    w_mem_k = nrm(ks[23], (DEPTH, D_MODEL, D_XA), D_MODEL ** -0.5)
    w_mem_v = nrm(ks[24], (DEPTH, D_MODEL, D_XA), D_MODEL ** -0.5 * DEEPNORM_BETA)
    w_out = nrm(ks[25], (DEPTH, D_MIX, D_MODEL), D_MIX ** -0.5 * DEEPNORM_BETA)
    ln_g = 1.0 + nrm(ks[26], (DEPTH, D_MODEL), 0.1)
    ln_b = nrm(ks[27], (DEPTH, D_MODEL), 0.01)
    return {
        'x_prompt': x_prompt, 'x_sample': x_sample, 'mem_prompt': mem_prompt,
        'state_rg_conv': state_rg_conv, 'state_rg_h': state_rg_h,
        'state_ssd_conv': state_ssd_conv, 'state_ssd_h': state_ssd_h,
        'cache_mem_k': cache_mem_k, 'cache_mem_v': cache_mem_v,
        'w_in': w_in, 'rg_conv_w': rg_conv_w, 'rg_conv_b': rg_conv_b,
        'w_rg_a': w_rg_a, 'b_rg_a': b_rg_a, 'w_rg_i': w_rg_i, 'b_rg_i': b_rg_i,
        'rg_lambda': rg_lambda, 'ssd_conv_w': ssd_conv_w, 'ssd_conv_b': ssd_conv_b,
        'ssd_dt_bias': ssd_dt_bias, 'ssd_a_log': ssd_a_log, 'ssd_d': ssd_d,
        'ssd_norm_g': ssd_norm_g, 'w_mem_k': w_mem_k, 'w_mem_v': w_mem_v,
        'w_out': w_out, 'ln_g': ln_g, 'ln_b': ln_b,
    }


def reference(x_prompt, x_sample, mem_prompt, state_rg_conv, state_rg_h, state_ssd_conv,
              state_ssd_h, cache_mem_k, cache_mem_v, w_in, rg_conv_w, rg_conv_b, w_rg_a,
              b_rg_a, w_rg_i, b_rg_i, rg_lambda, ssd_conv_w, ssd_conv_b, ssd_dt_bias,
              ssd_a_log, ssd_d, ssd_norm_g, w_mem_k, w_mem_v, w_out, ln_g, ln_b):
    f32 = jnp.float32
    bp = x_prompt.shape[0]
    yp, ys = x_prompt, x_sample
    rgc_p, rgh_p, sc_p, sh_p, mk_p, mv_p = [], [], [], [], [], []
    rgc_s, rgh_s, sc_s, sh_s = [], [], [], []
    memf = mem_prompt.astype(f32)
    for l in range(DEPTH):
        wl = (w_in[l], rg_conv_w[l], rg_conv_b[l], w_rg_a[l], b_rg_a[l], w_rg_i[l], b_rg_i[l],
              rg_lambda[l], ssd_conv_w[l], ssd_conv_b[l], ssd_dt_bias[l], ssd_a_log[l], ssd_d[l],
              ssd_norm_g[l], w_out[l], ln_g[l], ln_b[l])
        mk = (memf @ w_mem_k[l].astype(f32)).reshape(bp, N_MEM, MEM_HEADS, MEM_HEAD_DIM)
        mv = (memf @ w_mem_v[l].astype(f32)).reshape(bp, N_MEM, MEM_HEADS, MEM_HEAD_DIM)
        yp, a1, a2, a3, a4 = _layer(
            yp, mk, mv,
            jnp.zeros((bp, CONV_W - 1, D_RG), f32), jnp.zeros((bp, D_RG), f32),
            jnp.zeros((bp, CONV_W - 1, D_SSD_CONV), f32),
            jnp.zeros((bp, SSD_HEADS, SSD_HEAD_DIM, SSD_STATE), f32), wl)
        rgc_p.append(a1); rgh_p.append(a2); sc_p.append(a3); sh_p.append(a4)
        mk_p.append(mk.astype(x_prompt.dtype)); mv_p.append(mv.astype(x_prompt.dtype))
        ys, b1, b2, b3, b4 = _layer(
            ys, cache_mem_k[l], cache_mem_v[l], state_rg_conv[l], state_rg_h[l],
            state_ssd_conv[l], state_ssd_h[l], wl)
        rgc_s.append(b1); rgh_s.append(b2); sc_s.append(b3); sh_s.append(b4)
    return (yp, ys,
            jnp.stack(rgc_p), jnp.stack(rgh_p), jnp.stack(sc_p), jnp.stack(sh_p),
            jnp.stack(mk_p), jnp.stack(mv_p),
            jnp.stack(rgc_s), jnp.stack(rgh_s), jnp.stack(sc_s), jnp.stack(sh_s))
```

```cpp
#include <hip/hip_runtime.h>
#include <hip/hip_cooperative_groups.h>
#include <cstdio>
namespace cg = cooperative_groups;

#ifndef PHM
#define PHM 127
#endif
#ifndef N_LAUNCH_PER_PHASE
#define N_LAUNCH_PER_PHASE 0
#endif

#define DI __device__ __forceinline__
#define LAS __attribute__((address_space(3)))
typedef unsigned short bf16_t;
typedef short bf16x8 __attribute__((ext_vector_type(8)));
typedef float f32x4 __attribute__((ext_vector_type(4)));
typedef unsigned u32x4 __attribute__((ext_vector_type(4)));
typedef unsigned u32x2 __attribute__((ext_vector_type(2)));

constexpr int NTOKP = 16384, NTOKS = 512, NTOK = 16896, DM = 1024, NPROJ = 6656, DMIX = 3072, DIN = 6672;
constexpr int C_RGX = 0, C_RGG = 1024, C_XBC = 2048, C_Z = 3584, C_Q = 4608, C_XG = 5632;
constexpr int NPHASE = 7;
constexpr int LDS_BYTES = 131072;

constexpr size_t O_YP = 0, O_YS = O_YP + (size_t)NTOKP * DM, O_RGCP = O_YS + (size_t)NTOKS * DM, O_RGHP = O_RGCP + 8 * 3 * 1024, O_SCP = O_RGHP + 8 * 1024,
                 O_SHP = O_SCP + 8 * 3 * 1536, O_MKP = O_SHP + (size_t)8 * 16 * 64 * 128, O_MVP = O_MKP + (size_t)2048 * 1024, O_RGCS = O_MVP + (size_t)2048 * 1024,
                 O_RGHS = O_RGCS + (size_t)128 * 3 * 1024, O_SCS = O_RGHS + 128 * 1024, O_SHS = O_SCS + (size_t)128 * 3 * 1536;

constexpr size_t al256(size_t x) { return (x + 255) & ~(size_t)255; }
constexpr size_t W_XB = 0;
constexpr size_t W_WINT = al256(W_XB + (size_t)NTOK * DM * 2);
constexpr size_t W_WDTT = al256(W_WINT + (size_t)NPROJ * DM * 2);
constexpr size_t W_WDTF = al256(W_WDTT + 16 * 1024 * 2);
constexpr size_t W_WOUTT = al256(W_WDTF + 16 * 1024 * 4);
constexpr size_t W_WKVT = al256(W_WOUTT + (size_t)1024 * 3072 * 2);
constexpr size_t W_MEMB = al256(W_WKVT + (size_t)2048 * 1024 * 2);
constexpr size_t W_WGT = al256(W_MEMB + (size_t)2048 * 1024 * 2);
constexpr size_t W_KB = al256(W_WGT + (size_t)8 * 4 * 64 * 128 * 2);
constexpr size_t W_VT = al256(W_KB + (size_t)2048 * 1024 * 2);
constexpr size_t W_XACT = al256(W_VT + (size_t)2048 * 1024 * 2);
constexpr size_t W_DT = al256(W_XACT + (size_t)NTOKP * 1536 * 2);
constexpr size_t W_ACUM = al256(W_DT + (size_t)NTOKP * 16 * 4);
constexpr size_t W_CD = al256(W_ACUM + (size_t)NTOKP * 16 * 4);
constexpr size_t W_ST = al256(W_CD + 8 * 16 * 16 * 4);
constexpr size_t W_MIX = al256(W_ST + (size_t)8 * 16 * 16 * 8192 * 4);
constexpr size_t W_PROJ = al256(W_MIX + (size_t)NTOK * DMIX * 2);
constexpr size_t W_RES = W_PROJ;
constexpr size_t W_END = al256(W_PROJ + (size_t)NTOK * NPROJ * 2);

struct Params {
    const float *x_prompt, *x_sample, *mem_prompt, *state_rg_conv, *state_rg_h, *state_ssd_conv, *state_ssd_h, *cache_k, *cache_v;
    const float *w_in, *rg_conv_w, *rg_conv_b, *w_rg_a, *b_rg_a, *w_rg_i, *b_rg_i, *rg_lambda, *ssd_conv_w, *ssd_conv_b, *ssd_dt_bias, *ssd_a_log, *ssd_d, *ssd_norm_g,
        *w_mem_k, *w_mem_v, *w_out, *ln_g, *ln_b;
    float* out; unsigned char* ws;
    int ph_lo, ph_hi;
};

DI int otid() { int t = threadIdx.x; asm volatile("" : "+v"(t)); return t; }
DI int obid() { int t = blockIdx.x; asm volatile("" : "+s"(t)); return t; }
DI float bf2f(bf16_t b) { return __uint_as_float(((unsigned)b) << 16); }
DI bf16_t f2bf(float f) { unsigned u = __float_as_uint(f); u += 0x7FFFu + ((u >> 16) & 1u); return (bf16_t)(u >> 16); }
DI unsigned pack2(float lo, float hi) { return (unsigned)f2bf(lo) | ((unsigned)f2bf(hi) << 16); }
DI float bflo(unsigned w) { return __uint_as_float(w << 16); }
DI float bfhi(unsigned w) { return __uint_as_float(w & 0xFFFF0000u); }
DI void unpack8(const u32x4 v, float (&o)[8]) { o[0] = bflo(v.x); o[1] = bfhi(v.x); o[2] = bflo(v.y); o[3] = bfhi(v.y); o[4] = bflo(v.z); o[5] = bfhi(v.z); o[6] = bflo(v.w); o[7] = bfhi(v.w); }
DI u32x4 pack8(const float (&o)[8]) { u32x4 w; w.x = pack2(o[0], o[1]); w.y = pack2(o[2], o[3]); w.z = pack2(o[4], o[5]); w.w = pack2(o[6], o[7]); return w; }
DI bf16x8 as_frag(u32x4 w) { return __builtin_bit_cast(bf16x8, w); }
DI bf16x8 frag2(u32x2 lo, u32x2 hi) { u32x4 w; w.x = lo.x; w.y = lo.y; w.z = hi.x; w.w = hi.y; return __builtin_bit_cast(bf16x8, w); }
DI float siluf(float x) { return x / (1.f + __expf(-x)); }
DI float sigmf(float x) { return 1.f / (1.f + __expf(-x)); }
DI float softplusf(float v) { return v > 20.f ? v : log1pf(__expf(v)); }
#define MFMA16(a, b, c) __builtin_amdgcn_mfma_f32_16x16x32_bf16((a), (b), (c), 0, 0, 0)

namespace pg8 {
constexpr int BM = 256, BK = 64, HALF = 128, HTB = HALF * BK * 2, STAGE_BYTES = 8 * HTB, NXCD = 8, WGM = 8;
DI int lds_byte(int r, int c) { const int st = (r >> 4) * 2 + (c >> 5), rr = r & 15, cc = c & 31, ob = rr * 64 + cc * 2; return st * 1024 + (ob ^ (((ob >> 9) & 1) << 5)); }
DI void stage_rc(int b, int& R, int& C) { const int st = b / 1024, sb = b % 1024, swz = sb ^ (((sb >> 9) & 1) << 5); R = (st >> 1) * 16 + swz / 64; C = (st & 1) * 32 + (swz % 64) / 2; }
DI int perm32(int rho) { const int n = rho >> 4, i = rho & 15; return 8 * (i >> 2) + 4 * n + (i & 3); }
struct Unit { int pm, pn; };
struct Gemm { const bf16_t* A; const bf16_t* Bt; int M, N, K; };
struct StaticOrder {
    int nM, nN, nwg, G, c;
    DI void init(int M, int N, int G_, int c_) { nM = M / BM; nN = N / BM; nwg = nM * nN; G = G_; c = c_; }
    DI bool next(int i, Unit& u) const {
        const long L = (long)i * G + c; if (L >= nwg) return false;
        int wgid = (int)L; { const int q = nwg / NXCD, r = nwg % NXCD, xcd = wgid % NXCD, off = wgid / NXCD; wgid = (xcd < r ? xcd * (q + 1) : r * (q + 1) + (xcd - r) * q) + off; }
        const int nig = WGM * nN, gid = wgid / nig, fm = gid * WGM, gsz = (nM - fm) < WGM ? (nM - fm) : WGM;
        u.pm = fm + ((wgid % nig) % gsz); u.pn = (wgid % nig) / gsz; return true;
    }
};
DI unsigned cvt_pk_bf16(float lo, float hi) { unsigned r; asm volatile("v_cvt_pk_bf16_f32 %0, %1, %2" : "=v"(r) : "v"(lo), "v"(hi)); return r; }

struct EpiBf16 {
    static constexpr bool PERM = true;
    bf16_t* O; int ldc;
    DI void operator()(const f32x4 (&acc)[2][2][4][2], const Unit& u, int wr, int wc, int fr, int fq) const {
        const int row0 = u.pm * BM + wr * 64 + fr; const int col0 = u.pn * BM + wc * 32 + 8 * fq;
#pragma unroll
        for (int ai = 0; ai < 2; ++ai)
#pragma unroll
            for (int m = 0; m < 4; ++m) { bf16_t* rowp = O + (size_t)(row0 + ai * HALF + m * 16) * ldc + col0;
#pragma unroll
                for (int bj = 0; bj < 2; ++bj) { const f32x4 v0 = acc[ai][bj][m][0], v1 = acc[ai][bj][m][1];
                    u32x4 w; w.x = cvt_pk_bf16(v0[0], v0[1]); w.y = cvt_pk_bf16(v0[2], v0[3]); w.z = cvt_pk_bf16(v1[0], v1[1]); w.w = cvt_pk_bf16(v1[2], v1[3]);
                    *(u32x4*)(rowp + bj * HALF) = w; } }
    }
};
struct EpiKV {
    static constexpr bool PERM = false;
    float* mk; float* mv; bf16_t* kb; bf16_t* vt;
    DI void operator()(const f32x4 (&acc)[2][2][4][2], const Unit& u, int wr, int wc, int fr, int fq) const {
        const int row0 = u.pm * BM + wr * 64 + fr, col0 = u.pn * BM + wc * 32 + 4 * fq;
#pragma unroll
        for (int ai = 0; ai < 2; ++ai)
#pragma unroll
            for (int m = 0; m < 4; ++m) { const int row = row0 + ai * HALF + m * 16;
#pragma unroll
                for (int bj = 0; bj < 2; ++bj)
#pragma unroll
                    for (int n = 0; n < 2; ++n) { const int col = col0 + bj * HALF + n * 16; const f32x4 v = acc[ai][bj][m][n];
                        if (col < 1024) { *(f32x4*)(mk + (size_t)row * 1024 + col) = v; u32x2 w; w.x = cvt_pk_bf16(v[0], v[1]); w.y = cvt_pk_bf16(v[2], v[3]); *(u32x2*)(kb + (size_t)row * 1024 + col) = w; }
                        else { const int cc = col - 1024; *(f32x4*)(mv + (size_t)row * 1024 + cc) = v; const int bb = row >> 8, mt = row & 255;
#pragma unroll
                            for (int j = 0; j < 4; ++j) { const int c2 = cc + j, head = c2 >> 8, d = c2 & 255; vt[((size_t)((bb * 4 + head) * 256 + d)) * 256 + mt] = f2bf(v[j]); } } } }
    }
};
struct EpiRes {
    static constexpr bool PERM = false;
    float* res; const float* xp; const float* xs; float alpha;
    DI void operator()(const f32x4 (&acc)[2][2][4][2], const Unit& u, int wr, int wc, int fr, int fq) const {
        const int row0 = u.pm * BM + wr * 64 + fr, col0 = u.pn * BM + wc * 32 + 4 * fq;
#pragma unroll
        for (int ai = 0; ai < 2; ++ai)
#pragma unroll
            for (int m = 0; m < 4; ++m) { const int row = row0 + ai * HALF + m * 16; const float* xr = row < NTOKP ? xp + (size_t)row * 1024 : xs + (size_t)(row - NTOKP) * 1024;
#pragma unroll
                for (int bj = 0; bj < 2; ++bj)
#pragma unroll
                    for (int n = 0; n < 2; ++n) { const int col = col0 + bj * HALF + n * 16; const f32x4 xv = *(const f32x4*)(xr + col);
                        *(f32x4*)(res + (size_t)row * 1024 + col) = acc[ai][bj][m][n] + xv * alpha; } }
    }
};

template <class Epi, class Sched>
DI void gemm_phase(LAS unsigned char* lds, const Gemm g, const Sched& S, const Epi& E) {
    const int tid = otid(), wid = __builtin_amdgcn_readfirstlane(tid >> 6), lane = tid & 63, wr = wid >> 2, wc = wid & 3, fr = lane & 15, fq = lane >> 4;
    const int K = g.K, nt = K / BK;
    unsigned voffA[2], voffB[2];
#pragma unroll
    for (int i = 0; i < 2; ++i) { int R, C; stage_rc(tid * 16 + i * 8192, R, C); const int Rb = Epi::PERM ? ((R & ~31) + perm32(R & 31)) : R;
        voffA[i] = (unsigned)(R * K + C) * 2u; voffB[i] = (unsigned)(Rb * K + C) * 2u; }
    const size_t kstep = (size_t)(BK * 2);
    const size_t hstep = (size_t)HALF * K * 2;
    const size_t tstep = 2 * hstep;
    const unsigned ldsw = (unsigned)wid * 1024u;
    const int aoff = lds_byte(wr * 64 + fr, fq * 8), boff = lds_byte(wc * 32 + fr, fq * 8);
#define PG8_SA(b, h) (((b) * 2 + (h)) * HTB)
#define PG8_SB(b, h) ((4 + (b) * 2 + (h)) * HTB)
#define PG8_STAGE(bufoff, gbase, voff) do { _Pragma("unroll") for (int _i = 0; _i < 2; ++_i) \
        __builtin_amdgcn_global_load_lds((const unsigned*)((const char*)(gbase) + (voff)[_i]), (LAS unsigned*)(lds + (bufoff) + ldsw + _i * 8192), 16, 0, 0); } while (0)
#define PG8_LDA(dst, b, h) do { _Pragma("unroll") for (int m = 0; m < 4; ++m) _Pragma("unroll") for (int k = 0; k < 2; ++k) dst[m][k] = *(const LAS bf16x8*)(lds + PG8_SA(b, h) + aoff + m * 2048 + k * 1024); } while (0)
#define PG8_LDB(dst, b, h) do { _Pragma("unroll") for (int n = 0; n < 2; ++n) _Pragma("unroll") for (int k = 0; k < 2; ++k) dst[n][k] = *(const LAS bf16x8*)(lds + PG8_SB(b, h) + boff + n * 2048 + k * 1024); } while (0)
#define PG8_MMA(ai, bj, At, Bt) do { __builtin_amdgcn_s_setprio(1); _Pragma("unroll") for (int m = 0; m < 4; ++m) _Pragma("unroll") for (int n = 0; n < 2; ++n) _Pragma("unroll") for (int k = 0; k < 2; ++k) \
        acc[ai][bj][m][n] = __builtin_amdgcn_mfma_f32_16x16x32_bf16(Bt[n][k], At[m][k], acc[ai][bj][m][n], 0, 0, 0); __builtin_amdgcn_s_setprio(0); } while (0)
#define PG8_WAIT_V(n) asm volatile("s_waitcnt vmcnt(" #n ")" ::: "memory")
#define PG8_WAIT_L(n) asm volatile("s_waitcnt lgkmcnt(" #n ")" ::: "memory")
#define PG8_BAR __builtin_amdgcn_s_barrier()
#define PG8_SCHED __builtin_amdgcn_sched_barrier(0)
    Unit cur, nxt; int ui = 0;
    if (!S.next(0, cur)) return;
    f32x4 acc[2][2][4][2];
#pragma unroll
    for (int a = 0; a < 2; ++a)
#pragma unroll
        for (int b = 0; b < 2; ++b)
#pragma unroll
            for (int m = 0; m < 4; ++m)
#pragma unroll
                for (int n = 0; n < 2; ++n) acc[a][b][m][n] = (f32x4){0.f, 0.f, 0.f, 0.f};
    bf16x8 At[4][2], B0[2][2], B1[2][2];
    const char* cA = (const char*)g.A + (size_t)cur.pm * tstep; const char* cB = (const char*)g.Bt + (size_t)cur.pn * tstep;
    PG8_STAGE(PG8_SB(0, 0), cB, voffB); PG8_STAGE(PG8_SA(0, 0), cA, voffA); PG8_STAGE(PG8_SB(0, 1), cB + hstep, voffB); PG8_STAGE(PG8_SA(0, 1), cA + hstep, voffA);
    if (wr == 1) PG8_BAR;
    PG8_WAIT_V(4); PG8_BAR;
    PG8_STAGE(PG8_SB(1, 0), cB + kstep, voffB); PG8_STAGE(PG8_SA(1, 0), cA + kstep, voffA); PG8_STAGE(PG8_SB(1, 1), cB + hstep + kstep, voffB);
    PG8_WAIT_V(6); PG8_BAR;
    for (;;) {
        const bool has_next = S.next(ui + 1, nxt);
        const char* nA = has_next ? (const char*)g.A + (size_t)nxt.pm * tstep : cA; const char* nB = has_next ? (const char*)g.Bt + (size_t)nxt.pn * tstep : cB;
        for (int t = 0; t < nt; t += 2) {
            const bool last = (t == nt - 2);
            const char* a1 = cA + (size_t)(t + 1) * kstep;
            const char* a2 = last ? nA : cA + (size_t)(t + 2) * kstep; const char* b2 = last ? nB : cB + (size_t)(t + 2) * kstep;
            const char* a3 = a2 + kstep; const char* b3 = b2 + kstep;
            PG8_LDB(B0, 0, 0); PG8_SCHED; PG8_LDA(At, 0, 0); PG8_STAGE(PG8_SA(1, 1), a1 + hstep, voffA);
            PG8_WAIT_L(8); PG8_BAR; PG8_WAIT_L(0); PG8_MMA(0, 0, At, B0); PG8_BAR; PG8_SCHED;
            PG8_LDB(B1, 0, 1); PG8_STAGE(PG8_SB(0, 0), b2, voffB);
            PG8_BAR; PG8_WAIT_L(0); PG8_MMA(0, 1, At, B1); PG8_BAR;
            PG8_LDA(At, 0, 1); PG8_STAGE(PG8_SA(0, 0), a2, voffA);
            PG8_BAR; PG8_WAIT_L(0); PG8_MMA(1, 0, At, B0); PG8_BAR; PG8_SCHED;
            PG8_STAGE(PG8_SB(0, 1), b2 + hstep, voffB);
            PG8_WAIT_V(6); PG8_BAR; PG8_MMA(1, 1, At, B1); PG8_BAR;
            PG8_LDB(B0, 1, 0); PG8_SCHED; PG8_LDA(At, 1, 0); PG8_STAGE(PG8_SA(0, 1), a2 + hstep, voffA);
            PG8_WAIT_L(8); PG8_BAR; PG8_WAIT_L(0); PG8_MMA(0, 0, At, B0); PG8_BAR; PG8_SCHED;
            PG8_LDB(B1, 1, 1); PG8_STAGE(PG8_SB(1, 0), b3, voffB);
            PG8_BAR; PG8_WAIT_L(0); PG8_MMA(0, 1, At, B1); PG8_BAR;
            PG8_LDA(At, 1, 1); PG8_STAGE(PG8_SA(1, 0), a3, voffA);
            PG8_BAR; PG8_WAIT_L(0); PG8_MMA(1, 0, At, B0); PG8_BAR; PG8_SCHED;
            PG8_STAGE(PG8_SB(1, 1), b3 + hstep, voffB);
            PG8_WAIT_V(6); PG8_BAR; PG8_MMA(1, 1, At, B1); PG8_BAR;
        }
        E(acc, cur, wr, wc, fr, fq);
        if (!has_next) break;
#pragma unroll
        for (int a = 0; a < 2; ++a)
#pragma unroll
            for (int b = 0; b < 2; ++b)
#pragma unroll
                for (int m = 0; m < 4; ++m)
#pragma unroll
                    for (int n = 0; n < 2; ++n) acc[a][b][m][n] = (f32x4){0.f, 0.f, 0.f, 0.f};
        cur = nxt; cA = nA; cB = nB; ++ui;
    }
    PG8_WAIT_V(0);
    if (wr == 0) PG8_BAR;
    PG8_BAR;
#undef PG8_SA
#undef PG8_SB
#undef PG8_STAGE
#undef PG8_LDA
#undef PG8_LDB
#undef PG8_MMA
#undef PG8_WAIT_V
#undef PG8_WAIT_L
#undef PG8_BAR
#undef PG8_SCHED
}
}

DI void tr_tile(const float* src, int ld_src, int k0, int c0, bf16_t* dst, int ld_dst, int n0, float* lds) {
    const int tid = otid();
#pragma unroll
    for (int pass = 0; pass < 2; ++pass) { const int r = pass * 32 + (tid >> 4), c4 = (tid & 15) * 4;
        const f32x4 v = *(const f32x4*)(src + (size_t)(k0 + r) * ld_src + c0 + c4);
        lds[r * 65 + c4 + 0] = v[0]; lds[r * 65 + c4 + 1] = v[1]; lds[r * 65 + c4 + 2] = v[2]; lds[r * 65 + c4 + 3] = v[3]; }
    __syncthreads();
    const int nn = tid >> 3, kc = (tid & 7) * 8;
    float o[8];
#pragma unroll
    for (int e = 0; e < 8; ++e) o[e] = lds[(kc + e) * 65 + nn];
    *(u32x4*)(dst + (size_t)(n0 + nn) * ld_dst + k0 + kc) = pack8(o);
    __syncthreads();
}

DI void phase_prep(const Params& p, unsigned char* lds) {
    unsigned char* ws = p.ws;
    const int bidx_ = obid(); const size_t gtid = (size_t)bidx_ * 512 + otid(), nthr = (size_t)gridDim.x * 512;
    { bf16_t* xb = (bf16_t*)(ws + W_XB);
      for (size_t v = gtid; v < (size_t)NTOK * 128; v += nthr) { const float* s = v < (size_t)NTOKP * 128 ? p.x_prompt + v * 8 : p.x_sample + (v - (size_t)NTOKP * 128) * 8;
          const f32x4 a = *(const f32x4*)s, b = *(const f32x4*)(s + 4); float o[8] = {a[0], a[1], a[2], a[3], b[0], b[1], b[2], b[3]}; *(u32x4*)(xb + v * 8) = pack8(o); } }
    { bf16_t* mb = (bf16_t*)(ws + W_MEMB);
      for (size_t v = gtid; v < (size_t)2048 * 128; v += nthr) { const float* s = p.mem_prompt + v * 8;
          const f32x4 a = *(const f32x4*)s, b = *(const f32x4*)(s + 4); float o[8] = {a[0], a[1], a[2], a[3], b[0], b[1], b[2], b[3]}; *(u32x4*)(mb + v * 8) = pack8(o); } }
    { bf16_t* wd = (bf16_t*)(ws + W_WDTT); float* wf = (float*)(ws + W_WDTF);
      for (size_t i = gtid; i < 16 * 1024; i += nthr) { const int h = (int)(i >> 10), k = (int)(i & 1023); const float v = p.w_in[(size_t)k * DIN + 4608 + h]; wd[i] = f2bf(v); wf[i] = v; } }
    { bf16_t* wg = (bf16_t*)(ws + W_WGT);
      for (size_t i = gtid; i < (size_t)8 * 4 * 64 * 128; i += nthr) { const int k = (int)(i >> 15), qd = (int)(i >> 13) & 3, nn = (int)(i >> 7) & 63, ii = (int)(i & 127);
          const float v = nn < 32 ? p.w_rg_a[((size_t)k * 128 + ii) * 128 + qd * 32 + nn] : p.w_rg_i[((size_t)k * 128 + ii) * 128 + qd * 32 + nn - 32]; wg[i] = f2bf(v); } }
    float* tl = (float*)lds;
    for (int t = bidx_; t < 1664 + 768 + 512; t += gridDim.x) {
        if (t < 1664) { const int kt = t & 15, ntile = t >> 4; const int n0 = ntile * 64, c0 = n0 < 4608 ? n0 : n0 + 16;
            tr_tile(p.w_in, DIN, kt * 64, c0, (bf16_t*)(ws + W_WINT), 1024, n0, tl); }
        else if (t < 1664 + 768) { const int u = t - 1664; const int kt = u % 48, ntile = u / 48;
            tr_tile(p.w_out, 1024, kt * 64, ntile * 64, (bf16_t*)(ws + W_WOUTT), 3072, ntile * 64, tl); }
        else { const int u = t - 1664 - 768; const int kt = u & 15, ntile = u >> 4; const int n0 = ntile * 64;
            if (n0 < 1024) tr_tile(p.w_mem_k, 1024, kt * 64, n0, (bf16_t*)(ws + W_WKVT), 1024, n0, tl);
            else tr_tile(p.w_mem_v, 1024, kt * 64, n0 - 1024, (bf16_t*)(ws + W_WKVT), 1024, n0, tl); }
    }
}

DI void conv8_ssd_prompt(const Params& p, const bf16_t* proj, int rowbase, int t, int ch, float (&o)[8]) {
    const f32x4 b0 = *(const f32x4*)(p.ssd_conv_b + ch), b1 = *(const f32x4*)(p.ssd_conv_b + ch + 4);
    float acc[8] = {b0[0], b0[1], b0[2], b0[3], b1[0], b1[1], b1[2], b1[3]};
#pragma unroll
    for (int kk = 0; kk < 4; ++kk) { const int tt = t - 3 + kk;
        if (tt >= 0) { const u32x4 v = *(const u32x4*)(proj + (size_t)(rowbase + tt) * NPROJ + C_XBC + ch); float x[8]; unpack8(v, x);
            const f32x4 w0 = *(const f32x4*)(p.ssd_conv_w + kk * 1536 + ch), w1 = *(const f32x4*)(p.ssd_conv_w + kk * 1536 + ch + 4);
            acc[0] += x[0] * w0[0]; acc[1] += x[1] * w0[1]; acc[2] += x[2] * w0[2]; acc[3] += x[3] * w0[3];
            acc[4] += x[4] * w1[0]; acc[5] += x[5] * w1[1]; acc[6] += x[6] * w1[2]; acc[7] += x[7] * w1[3]; } }
#pragma unroll
    for (int e = 0; e < 8; ++e) o[e] = siluf(acc[e]);
}

DI void ssd1_item(const Params& p, unsigned char* lds, int b, int c, int g) {
    unsigned char* ws = p.ws;
    const int tid = otid(), w = tid >> 6, lane = tid & 63, l15 = lane & 15, q = lane >> 4;
    float* dt_s = (float*)lds; float* acum_s = dt_s + 2048; float* w_s = acum_s + 2048;
    bf16_t* BT = (bf16_t*)(lds + 20480); bf16_t* xsT = (bf16_t*)(lds + 20480 + 34816);
    const bf16_t* xb = (const bf16_t*)(ws + W_XB); const bf16_t* wdt = (const bf16_t*)(ws + W_WDTT); const bf16_t* proj = (const bf16_t*)(ws + W_PROJ);
    bf16_t* xact = (bf16_t*)(ws + W_XACT); float* dt_g = (float*)(ws + W_DT); float* acum_g = (float*)(ws + W_ACUM); float* cd_g = (float*)(ws + W_CD); float* st_g = (float*)(ws + W_ST);
    const int tok0 = b * 2048 + c * 128;
    __syncthreads();
    { f32x4 acc = {0.f, 0.f, 0.f, 0.f}; const bf16_t* ap = xb + (size_t)(tok0 + 16 * w + l15) * 1024 + q * 8; const bf16_t* bp = wdt + l15 * 1024 + q * 8;
#pragma unroll 8
      for (int ks = 0; ks < 32; ++ks) { const bf16x8 a = *(const bf16x8*)(ap + ks * 32); const bf16x8 bb = *(const bf16x8*)(bp + ks * 32); acc = MFMA16(a, bb, acc); }
      const float bias = p.ssd_dt_bias[l15];
#pragma unroll
      for (int r = 0; r < 4; ++r) { const int i = 16 * w + 4 * q + r; const float dt = softplusf(acc[r] + bias); dt_s[i * 16 + l15] = dt; dt_g[(size_t)(tok0 + i) * 16 + l15] = dt; } }
    __syncthreads();
    if (tid < 16) { const float ah = -__expf(p.ssd_a_log[tid]); float run = 0.f;
        for (int i = 0; i < 128; ++i) { run += dt_s[i * 16 + tid] * ah; acum_s[i * 16 + tid] = run; acum_g[(size_t)(tok0 + i) * 16 + tid] = run; } }
    __syncthreads();
    if (tid < 8) cd_g[(b * 16 + c) * 16 + 8 * g + tid] = __expf(acum_s[127 * 16 + 8 * g + tid]);
    for (int idx = tid; idx < 1024; idx += 512) { const int j = idx >> 3, hl = idx & 7, h = 8 * g + hl; w_s[idx] = dt_s[j * 16 + h] * __expf(acum_s[127 * 16 + h] - acum_s[j * 16 + h]); }
    for (int idx = tid; idx < 4096; idx += 512) { const int which = idx >> 11, rem = idx & 2047, j = rem >> 4, cv = (rem & 15) * 8; const int ch = 1024 + which * 256 + g * 128 + cv;
        float o[8]; conv8_ssd_prompt(p, proj, b * 2048, c * 128 + j, ch, o); const u32x4 pk = pack8(o);
        *(u32x4*)(xact + (size_t)(tok0 + j) * 1536 + ch) = pk;
        if (which == 0) { const bf16_t* e16 = (const bf16_t*)&pk;
#pragma unroll
            for (int e = 0; e < 8; ++e) BT[(cv + e) * 136 + j] = f2bf(o[e]); (void)e16; } }
    for (int hl = 0; hl < 8; ++hl) {
        __syncthreads();
        for (int idx = tid; idx < 1024; idx += 512) { const int j = idx >> 3, pv = (idx & 7) * 8; const int ch = g * 512 + hl * 64 + pv;
            float o[8]; conv8_ssd_prompt(p, proj, b * 2048, c * 128 + j, ch, o);
            *(u32x4*)(xact + (size_t)(tok0 + j) * 1536 + ch) = pack8(o);
            const float wj = w_s[j * 8 + hl];
#pragma unroll
            for (int e = 0; e < 8; ++e) xsT[(pv + e) * 136 + j] = f2bf(o[e] * wj); }
        __syncthreads();
        const int pt = w & 3, nh = w >> 2;
        f32x4 acc[4];
#pragma unroll
        for (int nt = 0; nt < 4; ++nt) acc[nt] = (f32x4){0.f, 0.f, 0.f, 0.f};
#pragma unroll
        for (int ks = 0; ks < 4; ++ks) { const bf16x8 a = *(const bf16x8*)(xsT + (pt * 16 + l15) * 136 + ks * 32 + q * 8);
#pragma unroll
            for (int nt = 0; nt < 4; ++nt) { const bf16x8 bb = *(const bf16x8*)(BT + (nh * 64 + nt * 16 + l15) * 136 + ks * 32 + q * 8); acc[nt] = MFMA16(a, bb, acc[nt]); } }
        float* sp = st_g + (size_t)(((b * 16 + c) * 16 + 8 * g + hl)) * 8192;
#pragma unroll
        for (int nt = 0; nt < 4; ++nt)
#pragma unroll
            for (int r = 0; r < 4; ++r) sp[(pt * 16 + 4 * q + r) * 128 + nh * 64 + nt * 16 + l15] = acc[nt][r];
    }
    if (c == 15) {
        for (int idx = tid; idx < 3 * 768; idx += 512) { const int jj = idx / 768, cc = idx % 768; const int ch = cc < 512 ? g * 512 + cc : (cc < 640 ? 1024 + g * 128 + (cc - 512) : 1280 + g * 128 + (cc - 640));
            p.out[O_SCP + (size_t)(b * 3 + jj) * 1536 + ch] = bf2f(proj[(size_t)(b * 2048 + 2045 + jj) * NPROJ + C_XBC + ch]); }
    }
}

DI void statepass_item(const Params& p, int sp) {
    const int b = sp >> 5, h = (sp >> 1) & 15, half = sp & 1; const int e0 = half * 4096 + otid() * 8;
    float* st_g = (float*)(p.ws + W_ST); const float* cd_g = (const float*)(p.ws + W_CD);
    f32x4 r0 = {0.f, 0.f, 0.f, 0.f}, r1 = {0.f, 0.f, 0.f, 0.f};
    for (int c = 0; c < 16; ++c) { float* ptr = st_g + (size_t)((b * 16 + c) * 16 + h) * 8192 + e0; const float cd = cd_g[(b * 16 + c) * 16 + h];
        const f32x4 v0 = *(const f32x4*)ptr, v1 = *(const f32x4*)(ptr + 4); *(f32x4*)ptr = r0; *(f32x4*)(ptr + 4) = r1; r0 = r0 * cd + v0; r1 = r1 * cd + v1; }
    float* o = p.out + O_SHP + (size_t)(b * 16 + h) * 8192 + e0; *(f32x4*)o = r0; *(f32x4*)(o + 4) = r1;
}

DI void rg_item(const Params& p, unsigned char* lds, const bool sample, int bidx, int k, int qd) {
    unsigned char* ws = p.ws;
    const int tid = otid(), w = tid >> 6, lane = tid & 63, l15 = lane & 15, q = lane >> 4;
    bf16_t* uA = (bf16_t*)lds;
    float* sa = (float*)(lds + 34816); float* sb = sa + 4096;
    float* segA = sb + 4096; float* segB = segA + 512; float* hcar = segB + 512;
    const bf16_t* proj = (const bf16_t*)(ws + W_PROJ); bf16_t* mix = (bf16_t*)(ws + W_MIX);
    const bf16_t* wg = (const bf16_t*)(ws + W_WGT) + (size_t)((k * 4 + qd) * 64) * 128;
    bf16x8 bw[4][4];
#pragma unroll
    for (int nt = 0; nt < 4; ++nt)
#pragma unroll
        for (int ks = 0; ks < 4; ++ks) bw[nt][ks] = *(const bf16x8*)(wg + (nt * 16 + l15) * 128 + ks * 32 + q * 8);
    float ba[2], bi[2], spl[2];
#pragma unroll
    for (int ntl = 0; ntl < 2; ++ntl) { const int ch = k * 128 + qd * 32 + ntl * 16 + l15; ba[ntl] = p.b_rg_a[ch]; bi[ntl] = p.b_rg_i[ch]; spl[ntl] = softplusf(-p.rg_lambda[ch]); }
    __syncthreads();
    if (tid < 32) hcar[tid] = 0.f;
    const int ntiles = sample ? 1 : 16;
    for (int tile = 0; tile < ntiles; ++tile) {
        __syncthreads();
        { const int row = tid >> 2, cg0 = (tid & 3) * 32;
#pragma unroll
          for (int v = 0; v < 4; ++v) { const int c8 = cg0 + v * 8, ch = k * 128 + c8;
              const f32x4 b0 = *(const f32x4*)(p.rg_conv_b + ch), b1 = *(const f32x4*)(p.rg_conv_b + ch + 4);
              float acc[8] = {b0[0], b0[1], b0[2], b0[3], b1[0], b1[1], b1[2], b1[3]};
#pragma unroll
              for (int kk = 0; kk < 4; ++kk) { float x[8]; bool have = true;
                  if (!sample) { const int tt = tile * 128 + row - 3 + kk; if (tt >= 0) { const u32x4 vv = *(const u32x4*)(proj + (size_t)(bidx * 2048 + tt) * NPROJ + C_RGX + ch); unpack8(vv, x); } else have = false; }
                  else { const int sbi = bidx * 32 + (row >> 2), ui = (row & 3) + kk;
                      if (ui < 3) { const float* s = p.state_rg_conv + (size_t)(sbi * 3 + ui) * 1024 + ch; const f32x4 s0 = *(const f32x4*)s, s1 = *(const f32x4*)(s + 4);
                          x[0] = s0[0]; x[1] = s0[1]; x[2] = s0[2]; x[3] = s0[3]; x[4] = s1[0]; x[5] = s1[1]; x[6] = s1[2]; x[7] = s1[3]; }
                      else { const u32x4 vv = *(const u32x4*)(proj + (size_t)(NTOKP + sbi * 4 + ui - 3) * NPROJ + C_RGX + ch); unpack8(vv, x); } }
                  if (have) { const f32x4 w0 = *(const f32x4*)(p.rg_conv_w + kk * 1024 + ch), w1 = *(const f32x4*)(p.rg_conv_w + kk * 1024 + ch + 4);
                      acc[0] += x[0] * w0[0]; acc[1] += x[1] * w0[1]; acc[2] += x[2] * w0[2]; acc[3] += x[3] * w0[3];
                      acc[4] += x[4] * w1[0]; acc[5] += x[5] * w1[1]; acc[6] += x[6] * w1[2]; acc[7] += x[7] * w1[3]; } }
              *(u32x4*)(uA + row * 136 + c8) = pack8(acc); } }
        __syncthreads();
        { f32x4 acc[4];
#pragma unroll
          for (int nt = 0; nt < 4; ++nt) acc[nt] = (f32x4){0.f, 0.f, 0.f, 0.f};
#pragma unroll
          for (int ks = 0; ks < 4; ++ks) { const bf16x8 a = *(const bf16x8*)(uA + (16 * w + l15) * 136 + ks * 32 + q * 8);
#pragma unroll
              for (int nt = 0; nt < 4; ++nt) acc[nt] = MFMA16(a, bw[nt][ks], acc[nt]); }
#pragma unroll
          for (int ntl = 0; ntl < 2; ++ntl)
#pragma unroll
              for (int r = 0; r < 4; ++r) { const int row = 16 * w + 4 * q + r, cl = ntl * 16 + l15;
                  const float rr = sigmf(acc[ntl][r] + ba[ntl]), ii = sigmf(acc[2 + ntl][r] + bi[ntl]);
                  const float la = -8.f * rr * spl[ntl]; float a = __expf(la); const float uval = bf2f(uA[row * 136 + qd * 32 + cl]);
                  float bt = sqrtf(-expm1f(2.f * la)) * ii * uval;
                  const bool first = sample ? ((row & 3) == 0) : (tile == 0 && row == 0);
                  if (first) { const float h0 = sample ? p.state_rg_h[(size_t)(bidx * 32 + (row >> 2)) * 1024 + k * 128 + qd * 32 + cl] : 0.f; bt += a * h0; a = 0.f; }
                  sa[row * 32 + cl] = a; sb[row * 32 + cl] = bt; } }
        __syncthreads();
        const int cl = tid & 31, seg = tid >> 5;
        { float A = 1.f, B = 0.f;
#pragma unroll
          for (int j = 0; j < 8; ++j) { const int row = seg * 8 + j; const float a = sa[row * 32 + cl], bb = sb[row * 32 + cl]; B = a * B + bb; A = a * A; }
          segA[seg * 32 + cl] = A; segB[seg * 32 + cl] = B; }
        __syncthreads();
        float h = hcar[cl];
        for (int s = 0; s < seg; ++s) h = segA[s * 32 + cl] * h + segB[s * 32 + cl];
        const int chg = k * 128 + qd * 32 + cl;
#pragma unroll
        for (int j = 0; j < 8; ++j) { const int row = seg * 8 + j; h = sa[row * 32 + cl] * h + sb[row * 32 + cl];
            const size_t grow = sample ? (size_t)(NTOKP + bidx * 128 + row) : (size_t)(bidx * 2048 + tile * 128 + row);
            const float gate = bf2f(proj[grow * NPROJ + C_RGG + chg]);
            mix[grow * DMIX + chg] = f2bf(h * siluf(gate));
            if (sample) { if ((row & 3) == 3) p.out[O_RGHS + (size_t)(bidx * 32 + (row >> 2)) * 1024 + chg] = h; }
            else if (tile == 15 && row == 127) p.out[O_RGHP + (size_t)bidx * 1024 + chg] = h; }
        __syncthreads();
        if (seg == 15) hcar[cl] = h;
    }
    if (!sample) { if (tid < 96) { const int jj = tid >> 5, cl = tid & 31, chg = k * 128 + qd * 32 + cl;
            p.out[O_RGCP + (size_t)(bidx * 3 + jj) * 1024 + chg] = bf2f(proj[(size_t)(bidx * 2048 + 2045 + jj) * NPROJ + C_RGX + chg]); } }
    else { for (int idx = tid; idx < 32 * 3 * 32; idx += 512) { const int cl = idx & 31, jj = (idx >> 5) % 3, sl = idx / 96; const int sbi = bidx * 32 + sl, chg = k * 128 + qd * 32 + cl;
            p.out[O_RGCS + (size_t)(sbi * 3 + jj) * 1024 + chg] = bf2f(proj[(size_t)(NTOKP + sbi * 4 + 1 + jj) * NPROJ + C_RGX + chg]); } }
}

DI void attnp_item(const Params& p, int b, int head, int qt) {
    unsigned char* ws = p.ws;
    const int tid = otid(), w = tid >> 6, lane = tid & 63, l15 = lane & 15, q = lane >> 4;
    const bf16_t* proj = (const bf16_t*)(ws + W_PROJ); const bf16_t* kb = (const bf16_t*)(ws + W_KB); const bf16_t* vt = (const bf16_t*)(ws + W_VT); bf16_t* mix = (bf16_t*)(ws + W_MIX);
    const int tokb = b * 2048 + qt * 128 + 16 * w;
    bf16x8 qf[8];
#pragma unroll
    for (int ks = 0; ks < 8; ++ks) qf[ks] = *(const bf16x8*)(proj + (size_t)(tokb + l15) * NPROJ + C_Q + head * 256 + ks * 32 + q * 8);
    f32x4 st[16];
#pragma unroll
    for (int mt = 0; mt < 16; ++mt) { st[mt] = (f32x4){0.f, 0.f, 0.f, 0.f}; const bf16_t* kp = kb + (size_t)(b * 256 + 16 * mt + l15) * 1024 + head * 256 + q * 8;
#pragma unroll
        for (int ks = 0; ks < 8; ++ks) { const bf16x8 kf = *(const bf16x8*)(kp + ks * 32); st[mt] = MFMA16(kf, qf[ks], st[mt]); } }
    float mx = -3.0e38f;
#pragma unroll
    for (int mt = 0; mt < 16; ++mt)
#pragma unroll
        for (int r = 0; r < 4; ++r) { st[mt][r] *= 0.0625f; mx = fmaxf(mx, st[mt][r]); }
    mx = fmaxf(mx, __shfl_xor(mx, 16)); mx = fmaxf(mx, __shfl_xor(mx, 32));
    float l = 0.f;
#pragma unroll
    for (int mt = 0; mt < 16; ++mt)
#pragma unroll
        for (int r = 0; r < 4; ++r) { const float e = __expf(st[mt][r] - mx); st[mt][r] = e; l += e; }
    l += __shfl_xor(l, 16); l += __shfl_xor(l, 32);
    bf16x8 pf[8];
#pragma unroll
    for (int s = 0; s < 8; ++s) { float m8[8] = {st[2 * s][0], st[2 * s][1], st[2 * s][2], st[2 * s][3], st[2 * s + 1][0], st[2 * s + 1][1], st[2 * s + 1][2], st[2 * s + 1][3]}; pf[s] = as_frag(pack8(m8)); }
    float linv[4];
#pragma unroll
    for (int r = 0; r < 4; ++r) linv[r] = 1.f / __shfl(l, 4 * q + r);
#pragma unroll 2
    for (int dt = 0; dt < 16; ++dt) { f32x4 o = {0.f, 0.f, 0.f, 0.f}; const bf16_t* vp = vt + ((size_t)((b * 4 + head) * 256 + 16 * dt + l15)) * 256 + 4 * q;
#pragma unroll
        for (int s = 0; s < 8; ++s) { const u32x2 lo = *(const u32x2*)(vp + 32 * s), hi = *(const u32x2*)(vp + 32 * s + 16); o = MFMA16(pf[s], frag2(lo, hi), o); }
#pragma unroll
        for (int r = 0; r < 4; ++r) { const size_t tok = (size_t)(tokb + 4 * q + r); const int d = 16 * dt + l15;
            const float gate = bf2f(proj[tok * NPROJ + C_XG + head * 256 + d]); mix[tok * DMIX + 2048 + head * 256 + d] = f2bf(o[r] * linv[r] * siluf(gate)); } }
}

DI float wave_sum(float v) { v += __shfl_xor(v, 32); v += __shfl_xor(v, 16); v += __shfl_xor(v, 8); v += __shfl_xor(v, 4); v += __shfl_xor(v, 2); v += __shfl_xor(v, 1); return v; }
DI float wave_max(float v) { v = fmaxf(v, __shfl_xor(v, 32)); v = fmaxf(v, __shfl_xor(v, 16)); v = fmaxf(v, __shfl_xor(v, 8)); v = fmaxf(v, __shfl_xor(v, 4)); v = fmaxf(v, __shfl_xor(v, 2)); v = fmaxf(v, __shfl_xor(v, 1)); return v; }

DI void attns_item(const Params& p, unsigned char* lds, int sbi, int head) {
    unsigned char* ws = p.ws;
    const int tid = otid(), w = tid >> 6, lane = tid & 63;
    const bf16_t* proj = (const bf16_t*)(ws + W_PROJ); bf16_t* mix = (bf16_t*)(ws + W_MIX);
    float* qs = (float*)lds; float* sc = qs + 1024; float* ored = sc + 1024;
    __syncthreads();
    for (int idx = tid; idx < 1024; idx += 512) { const int t = idx >> 8, d = idx & 255; qs[idx] = bf2f(proj[(size_t)(NTOKP + sbi * 4 + t) * NPROJ + C_Q + head * 256 + d]); }
    __syncthreads();
    f32x4 qv[4];
#pragma unroll
    for (int t = 0; t < 4; ++t) qv[t] = *(const f32x4*)(qs + t * 256 + lane * 4);
    for (int m = w; m < 256; m += 8) { const f32x4 kv = *(const f32x4*)(p.cache_k + ((size_t)(sbi * 256 + m) * 4 + head) * 256 + lane * 4);
#pragma unroll
        for (int t = 0; t < 4; ++t) { float s = kv[0] * qv[t][0] + kv[1] * qv[t][1] + kv[2] * qv[t][2] + kv[3] * qv[t][3]; s = wave_sum(s); if (lane == 0) sc[t * 256 + m] = s * 0.0625f; } }
    __syncthreads();
    if (w < 4) { const f32x4 v = *(const f32x4*)(sc + w * 256 + lane * 4); float mx = fmaxf(fmaxf(v[0], v[1]), fmaxf(v[2], v[3])); mx = wave_max(mx);
        f32x4 e; e[0] = __expf(v[0] - mx); e[1] = __expf(v[1] - mx); e[2] = __expf(v[2] - mx); e[3] = __expf(v[3] - mx); float s = wave_sum(e[0] + e[1] + e[2] + e[3]); const float inv = 1.f / s;
        *(f32x4*)(sc + w * 256 + lane * 4) = e * inv; }
    __syncthreads();
    f32x4 acc[4];
#pragma unroll
    for (int t = 0; t < 4; ++t) acc[t] = (f32x4){0.f, 0.f, 0.f, 0.f};
    for (int m = w; m < 256; m += 8) { const f32x4 vv = *(const f32x4*)(p.cache_v + ((size_t)(sbi * 256 + m) * 4 + head) * 256 + lane * 4);
#pragma unroll
        for (int t = 0; t < 4; ++t) acc[t] += vv * sc[t * 256 + m]; }
#pragma unroll
    for (int t = 0; t < 4; ++t) *(f32x4*)(ored + (w * 4 + t) * 256 + lane * 4) = acc[t];
    __syncthreads();
    for (int idx = tid; idx < 1024; idx += 512) { const int t = idx >> 8, d = idx & 255; float s = 0.f;
#pragma unroll
        for (int ww = 0; ww < 8; ++ww) s += ored[(ww * 4 + t) * 256 + d];
        const size_t tok = (size_t)(NTOKP + sbi * 4 + t); const float gate = bf2f(proj[tok * NPROJ + C_XG + head * 256 + d]); mix[tok * DMIX + 2048 + head * 256 + d] = f2bf(s * siluf(gate)); }
}

DI void ssds_item(const Params& p, unsigned char* lds, int sbi, int g) {
    unsigned char* ws = p.ws;
    const int tid = otid(), w = tid >> 6, lane = tid & 63;
    const bf16_t* proj = (const bf16_t*)(ws + W_PROJ); bf16_t* mix = (bf16_t*)(ws + W_MIX); const float* wdf = (const float*)(ws + W_WDTF);
    float* xs = (float*)lds; float* Bs = xs + 2048; float* Cs = Bs + 512; float* yg = Cs + 512; float* dts = yg + 2048; float* decs = dts + 32;
    __syncthreads();
#pragma unroll
    for (int d = 0; d < 4; ++d) { const int pi = w * 4 + d, t = pi & 3, hl = pi >> 2, h = 8 * g + hl; float s = 0.f;
#pragma unroll
        for (int i = 0; i < 4; ++i) { const f32x4 xv = *(const f32x4*)(p.x_sample + (size_t)(sbi * 4 + t) * 1024 + i * 256 + lane * 4), wv = *(const f32x4*)(wdf + h * 1024 + i * 256 + lane * 4);
            s += xv[0] * wv[0] + xv[1] * wv[1] + xv[2] * wv[2] + xv[3] * wv[3]; }
        s = wave_sum(s);
        if (lane == 0) { const float dt = softplusf(s + p.ssd_dt_bias[h]); dts[t * 8 + hl] = dt; decs[t * 8 + hl] = __expf(-dt * __expf(p.ssd_a_log[h])); } }
    for (int idx = tid; idx < 4 * 768; idx += 512) { const int t = idx / 768, cc = idx % 768; const int ch = cc < 512 ? g * 512 + cc : (cc < 640 ? 1024 + g * 128 + (cc - 512) : 1280 + g * 128 + (cc - 640));
        float acc = p.ssd_conv_b[ch];
#pragma unroll
        for (int kk = 0; kk < 4; ++kk) { const int ui = t + kk; const float x = ui < 3 ? p.state_ssd_conv[(size_t)(sbi * 3 + ui) * 1536 + ch] : bf2f(proj[(size_t)(NTOKP + sbi * 4 + ui - 3) * NPROJ + C_XBC + ch]);
            acc += x * p.ssd_conv_w[kk * 1536 + ch]; }
        const float a = siluf(acc);
        if (cc < 512) xs[t * 512 + cc] = a; else if (cc < 640) Bs[t * 128 + cc - 512] = a; else Cs[t * 128 + cc - 640] = a; }
    for (int idx = tid; idx < 3 * 768; idx += 512) { const int jj = idx / 768, cc = idx % 768; const int ch = cc < 512 ? g * 512 + cc : (cc < 640 ? 1024 + g * 128 + (cc - 512) : 1280 + g * 128 + (cc - 640));
        p.out[O_SCS + (size_t)(sbi * 3 + jj) * 1536 + ch] = bf2f(proj[(size_t)(NTOKP + sbi * 4 + 1 + jj) * NPROJ + C_XBC + ch]); }
    __syncthreads();
    const int pp = tid >> 3, n0 = (tid & 7) * 16;
    for (int hl = 0; hl < 8; ++hl) { const int h = 8 * g + hl; const size_t so = ((size_t)(sbi * 16 + h) * 64 + pp) * 128 + n0;
        f32x4 hs[4];
#pragma unroll
        for (int v = 0; v < 4; ++v) hs[v] = *(const f32x4*)(p.state_ssd_h + so + v * 4);
        const float dsk = p.ssd_d[h];
#pragma unroll
        for (int t = 0; t < 4; ++t) { const float dec = decs[t * 8 + hl], xv = xs[t * 512 + hl * 64 + pp], dtx = dts[t * 8 + hl] * xv; float part = 0.f;
#pragma unroll
            for (int v = 0; v < 4; ++v) { const f32x4 bv = *(const f32x4*)(Bs + t * 128 + n0 + v * 4), cv = *(const f32x4*)(Cs + t * 128 + n0 + v * 4);
                hs[v] = hs[v] * dec + bv * dtx; part += cv[0] * hs[v][0] + cv[1] * hs[v][1] + cv[2] * hs[v][2] + cv[3] * hs[v][3]; }
            part += __shfl_xor(part, 1); part += __shfl_xor(part, 2); part += __shfl_xor(part, 4);
            if ((tid & 7) == 0) { const float y = part + dsk * xv; const float z = bf2f(proj[(size_t)(NTOKP + sbi * 4 + t) * NPROJ + C_Z + h * 64 + pp]); yg[t * 512 + hl * 64 + pp] = y * siluf(z); } }
#pragma unroll
        for (int v = 0; v < 4; ++v) *(f32x4*)(p.out + O_SHS + so + v * 4) = hs[v];
    }
    __syncthreads();
    if (w < 4) { const int t = w; float ss = 0.f; float v[8];
#pragma unroll
        for (int e = 0; e < 8; ++e) { v[e] = yg[t * 512 + e * 64 + lane]; ss += v[e] * v[e]; }
        ss = wave_sum(ss); const float rstd = rsqrtf(ss * (1.f / 512.f) + 1e-5f);
#pragma unroll
        for (int e = 0; e < 8; ++e) { const int cc = e * 64 + lane; mix[(size_t)(NTOKP + sbi * 4 + t) * DMIX + 1024 + g * 512 + cc] = f2bf(v[e] * rstd * p.ssd_norm_g[g * 512 + cc]); } }
}

DI void ssd3_item(const Params& p, unsigned char* lds, int b, int c, int g) {
    unsigned char* ws = p.ws;
    const int tid = otid(), w = tid >> 6, lane = tid & 63, l15 = lane & 15, q = lane >> 4;
    float* acum_s = (float*)lds; float* dt_s = acum_s + 1024;
    bf16_t* xT = (bf16_t*)(lds + 8192);
    const bf16_t* proj = (const bf16_t*)(ws + W_PROJ); const bf16_t* xact = (const bf16_t*)(ws + W_XACT); bf16_t* mix = (bf16_t*)(ws + W_MIX);
    const float* dt_g = (const float*)(ws + W_DT); const float* acum_g = (const float*)(ws + W_ACUM); const float* st_g = (const float*)(ws + W_ST);
    const int tok0 = b * 2048 + c * 128;
    __syncthreads();
    for (int idx = tid; idx < 1024; idx += 512) { const int j = idx >> 3, hl = idx & 7; acum_s[idx] = acum_g[(size_t)(tok0 + j) * 16 + 8 * g + hl]; dt_s[idx] = dt_g[(size_t)(tok0 + j) * 16 + 8 * g + hl]; }
    bf16x8 cf[4];
#pragma unroll
    for (int ks = 0; ks < 4; ++ks) cf[ks] = *(const bf16x8*)(xact + (size_t)(tok0 + 16 * w + l15) * 1536 + 1280 + g * 128 + ks * 32 + q * 8);
    f32x4 cbt[8];
#pragma unroll
    for (int jt = 0; jt < 8; ++jt) { cbt[jt] = (f32x4){0.f, 0.f, 0.f, 0.f};
        if (jt <= w) {
#pragma unroll
            for (int ks = 0; ks < 4; ++ks) { const bf16x8 bfr = *(const bf16x8*)(xact + (size_t)(tok0 + 16 * jt + l15) * 1536 + 1024 + g * 128 + ks * 32 + q * 8); cbt[jt] = MFMA16(bfr, cf[ks], cbt[jt]); } } }
    float ssq[4] = {0.f, 0.f, 0.f, 0.f};
    const int irow = 16 * w + l15;
    for (int hl = 0; hl < 8; ++hl) { const int h = 8 * g + hl;
        __syncthreads();
        for (int idx = tid; idx < 1024; idx += 512) { const int j = idx >> 3, pv = (idx & 7) * 8; const u32x4 v = *(const u32x4*)(xact + (size_t)(tok0 + j) * 1536 + g * 512 + hl * 64 + pv);
            const bf16_t* e16 = (const bf16_t*)&v; (void)e16;
            xT[(pv + 0) * 136 + j] = (bf16_t)(v.x & 0xFFFF); xT[(pv + 1) * 136 + j] = (bf16_t)(v.x >> 16); xT[(pv + 2) * 136 + j] = (bf16_t)(v.y & 0xFFFF); xT[(pv + 3) * 136 + j] = (bf16_t)(v.y >> 16);
            xT[(pv + 4) * 136 + j] = (bf16_t)(v.z & 0xFFFF); xT[(pv + 5) * 136 + j] = (bf16_t)(v.z >> 16); xT[(pv + 6) * 136 + j] = (bf16_t)(v.w & 0xFFFF); xT[(pv + 7) * 136 + j] = (bf16_t)(v.w >> 16); }
        __syncthreads();
        const float ai = acum_s[irow * 8 + hl];
        bf16x8 af[4];
#pragma unroll
        for (int s = 0; s < 4; ++s) { float m8[8];
#pragma unroll
            for (int hf = 0; hf < 2; ++hf) { const int jt = 2 * s + hf;
#pragma unroll
                for (int r = 0; r < 4; ++r) { const int j = 16 * jt + 4 * q + r; float val = 0.f;
                    if (jt <= w && j <= irow) val = cbt[jt][r] * __expf(ai - acum_s[j * 8 + hl]) * dt_s[j * 8 + hl];
                    m8[hf * 4 + r] = val; } }
            af[s] = as_frag(pack8(m8)); }
        const float dsk = p.ssd_d[h];
        float ea[4];
#pragma unroll
        for (int r = 0; r < 4; ++r) ea[r] = __expf(acum_s[(16 * w + 4 * q + r) * 8 + hl]);
#pragma unroll
        for (int pt = 0; pt < 4; ++pt) { f32x4 yd = {0.f, 0.f, 0.f, 0.f}, yo = {0.f, 0.f, 0.f, 0.f};
            const bf16_t* xr = xT + (16 * pt + l15) * 136;
#pragma unroll
            for (int s = 0; s < 4; ++s) if (2 * s <= w) { const u32x2 lo = *(const u32x2*)(xr + 32 * s + 4 * q), hi = *(const u32x2*)(xr + 32 * s + 16 + 4 * q); yd = MFMA16(af[s], frag2(lo, hi), yd); }
            const float* hp = st_g + ((size_t)((b * 16 + c) * 16 + h) * 64 + 16 * pt + l15) * 128 + q * 8;
#pragma unroll
            for (int ks = 0; ks < 4; ++ks) { const f32x4 f0 = *(const f32x4*)(hp + ks * 32), f1 = *(const f32x4*)(hp + ks * 32 + 4); float m8[8] = {f0[0], f0[1], f0[2], f0[3], f1[0], f1[1], f1[2], f1[3]};
                yo = MFMA16(cf[ks], as_frag(pack8(m8)), yo); }
            const u32x2 xv2 = *(const u32x2*)(xr + 16 * w + 4 * q); const float xv[4] = {bflo(xv2.x), bfhi(xv2.x), bflo(xv2.y), bfhi(xv2.y)};
#pragma unroll
            for (int r = 0; r < 4; ++r) { const size_t tok = (size_t)(tok0 + 16 * w + 4 * q + r); const int pp = 16 * pt + l15;
                const float y = yd[r] + ea[r] * yo[r] + dsk * xv[r]; const float z = bf2f(proj[tok * NPROJ + C_Z + h * 64 + pp]); const float val = y * siluf(z);
                ssq[r] += val * val; mix[tok * DMIX + 1024 + g * 512 + hl * 64 + pp] = f2bf(val); } }
    }
    float rstd[4];
#pragma unroll
    for (int r = 0; r < 4; ++r) { float s = ssq[r]; s += __shfl_xor(s, 1); s += __shfl_xor(s, 2); s += __shfl_xor(s, 4); s += __shfl_xor(s, 8); rstd[r] = rsqrtf(s * (1.f / 512.f) + 1e-5f); }
    for (int hl = 0; hl < 8; ++hl)
#pragma unroll
        for (int pt = 0; pt < 4; ++pt) { const int cc = hl * 64 + 16 * pt + l15; const float gn = p.ssd_norm_g[g * 512 + cc];
#pragma unroll
            for (int r = 0; r < 4; ++r) { bf16_t* mp = mix + (size_t)(tok0 + 16 * w + 4 * q + r) * DMIX + 1024 + g * 512 + cc; *mp = f2bf(bf2f(*mp) * rstd[r] * gn); } }
}

DI void ln_rows(const Params& p) {
    const float* res = (const float*)(p.ws + W_RES);
    const int tid = otid(); const int lane = tid & 63; const int gw = obid() * 8 + (tid >> 6), nw = gridDim.x * 8;
    f32x4 gg[4], bb[4];
#pragma unroll
    for (int i = 0; i < 4; ++i) { gg[i] = *(const f32x4*)(p.ln_g + i * 256 + lane * 4); bb[i] = *(const f32x4*)(p.ln_b + i * 256 + lane * 4); }
    for (int row = gw; row < NTOK; row += nw) { f32x4 v[4]; float s = 0.f;
#pragma unroll
        for (int i = 0; i < 4; ++i) { v[i] = *(const f32x4*)(res + (size_t)row * 1024 + i * 256 + lane * 4); s += v[i][0] + v[i][1] + v[i][2] + v[i][3]; }
        const float mu = wave_sum(s) * (1.f / 1024.f); float s2 = 0.f;
#pragma unroll
        for (int i = 0; i < 4; ++i) { v[i] = v[i] - mu; s2 += v[i][0] * v[i][0] + v[i][1] * v[i][1] + v[i][2] * v[i][2] + v[i][3] * v[i][3]; }
        const float rstd = rsqrtf(wave_sum(s2) * (1.f / 1024.f) + 1e-5f);
#pragma unroll
        for (int i = 0; i < 4; ++i) *(f32x4*)(p.out + (size_t)row * 1024 + i * 256 + lane * 4) = v[i] * rstd * gg[i] + bb[i]; }
}

__global__ void __launch_bounds__(512, 2) hymba_fwd(Params p) {
    extern __shared__ __attribute__((aligned(16))) unsigned char shm[];
    cg::grid_group grid = cg::this_grid();
    const int G = gridDim.x, bid = blockIdx.x;
    for (int ph = p.ph_lo; ph < p.ph_hi; ++ph) {
        if (ph == 0) { if (PHM & 1) phase_prep(p, shm); }
        else if (ph == 1 && (PHM & 2)) {
            { pg8::Gemm g; g.A = (const bf16_t*)(p.ws + W_XB); g.Bt = (const bf16_t*)(p.ws + W_WINT); g.M = NTOK; g.N = NPROJ; g.K = 1024;
              pg8::StaticOrder S; S.init(g.M, g.N, G, bid); pg8::EpiBf16 E; E.O = (bf16_t*)(p.ws + W_PROJ); E.ldc = NPROJ;
              pg8::gemm_phase<pg8::EpiBf16, pg8::StaticOrder>((LAS unsigned char*)shm, g, S, E); }
            { pg8::Gemm g; g.A = (const bf16_t*)(p.ws + W_MEMB); g.Bt = (const bf16_t*)(p.ws + W_WKVT); g.M = 2048; g.N = 2048; g.K = 1024;
              const int shift = (66 * 26) % G; pg8::StaticOrder S; S.init(g.M, g.N, G, (bid + G - shift) % G);
              pg8::EpiKV E; E.mk = p.out + O_MKP; E.mv = p.out + O_MVP; E.kb = (bf16_t*)(p.ws + W_KB); E.vt = (bf16_t*)(p.ws + W_VT);
              pg8::gemm_phase<pg8::EpiKV, pg8::StaticOrder>((LAS unsigned char*)shm, g, S, E); }
        }
        else if (ph == 2 && (PHM & 4)) { for (int it = bid; it < 256; it += G) ssd1_item(p, shm, it >> 5, (it >> 1) & 15, it & 1); }
        else if (ph == 3 && (PHM & 8)) {
            for (int it = bid; it < 1920; it += G) {
                if (it < 256) rg_item(p, shm, false, it >> 5, (it >> 2) & 7, it & 3);
                else if (it < 512) statepass_item(p, it - 256);
                else if (it < 640) { const int u = it - 512; rg_item(p, shm, true, u >> 5, (u >> 2) & 7, u & 3); }
                else if (it < 896) { const int u = it - 640; ssds_item(p, shm, u >> 1, u & 1); }
                else if (it < 1408) { const int u = it - 896; attns_item(p, shm, u >> 2, u & 3); }
                else { const int u = it - 1408; attnp_item(p, u >> 6, (u >> 4) & 3, u & 15); }
            }
        }
        else if (ph == 4 && (PHM & 16)) { for (int it = bid; it < 256; it += G) ssd3_item(p, shm, it >> 5, (it >> 1) & 15, it & 1); }
        else if (ph == 5 && (PHM & 32)) {
            pg8::Gemm g; g.A = (const bf16_t*)(p.ws + W_MIX); g.Bt = (const bf16_t*)(p.ws + W_WOUTT); g.M = NTOK; g.N = 1024; g.K = 3072;
            pg8::StaticOrder S; S.init(g.M, g.N, G, bid); pg8::EpiRes E; E.res = (float*)(p.ws + W_RES); E.xp = p.x_prompt; E.xs = p.x_sample; E.alpha = 1.189207115002721f;
            pg8::gemm_phase<pg8::EpiRes, pg8::StaticOrder>((LAS unsigned char*)shm, g, S, E);
        }
        else if (ph == 6 && (PHM & 64)) ln_rows(p);
        if (ph + 1 < p.ph_hi) grid.sync();
    }
}

extern "C" void kernel_launch(void* const* d_in, const int* in_sizes, int n_in, void* d_out, int out_size, void* d_ws, size_t ws_size, hipStream_t stream) {
    static int grid_blocks = 0;
    if (!grid_blocks) {
        int dev = 0, cus = 0, per_cu = 0;
        hipGetDevice(&dev);
        hipDeviceGetAttribute(&cus, hipDeviceAttributeMultiprocessorCount, dev);
        if (hipFuncSetAttribute((const void*)hymba_fwd, hipFuncAttributeMaxDynamicSharedMemorySize, LDS_BYTES) != hipSuccess) fprintf(stderr, "hipFuncSetAttribute failed\n");
        hipOccupancyMaxActiveBlocksPerMultiprocessor(&per_cu, (const void*)hymba_fwd, 512, LDS_BYTES);
        if (per_cu < 1) { fprintf(stderr, "occupancy query says %d blocks per CU\n", per_cu); per_cu = 1; }
        grid_blocks = cus * 1;
        if (ws_size < W_END) fprintf(stderr, "workspace too small: %zu < %zu\n", ws_size, (size_t)W_END);
    }
    Params p{};
    const float** fp = (const float**)&p;
    for (int i = 0; i < 28; ++i) fp[i] = (const float*)d_in[i];
    p.out = (float*)d_out; p.ws = (unsigned char*)d_ws;
#if N_LAUNCH_PER_PHASE
    for (int ph = 0; ph < NPHASE; ++ph) { p.ph_lo = ph; p.ph_hi = ph + 1;
        hipLaunchKernelGGL(hymba_fwd, dim3(grid_blocks), dim3(512), LDS_BYTES, stream, p); }
#else
    p.ph_lo = 0; p.ph_hi = NPHASE;
    void* args[] = {&p};
    hipError_t e = hipLaunchCooperativeKernel((const void*)hymba_fwd, dim3(grid_blocks), dim3(512), args, LDS_BYTES, stream);
    if (e != hipSuccess) fprintf(stderr, "cooperative launch failed: %s (grid %d)\n", hipGetErrorString(e), grid_blocks);
#endif
}
```

```cpp
#include <hip/hip_runtime.h>
#include <hip/hip_cooperative_groups.h>
#include <cstdio>
namespace cg = cooperative_groups;

#ifndef REP2
#define REP2 1
#endif
#ifndef REP3
#define REP3 1
#endif
#ifndef REP4
#define REP4 1
#endif
#ifndef R3LO
#define R3LO 0
#define R3HI 256
#endif
#ifndef REP0
#define REP0 1
#endif
#ifndef REP1
#define REP1 1
#endif
#ifndef REP5
#define REP5 1
#endif
#ifndef REP6
#define REP6 1
#endif
#ifndef REPS
#define REPS 1
#endif
#ifndef PHM
#define PHM 127
#endif
#ifndef N_LAUNCH_PER_PHASE
#define N_LAUNCH_PER_PHASE 0
#endif

#define DI __device__ __forceinline__
#define LAS __attribute__((address_space(3)))
typedef unsigned short bf16_t;
typedef short bf16x8 __attribute__((ext_vector_type(8)));
typedef float f32x4 __attribute__((ext_vector_type(4)));
typedef unsigned u32x4 __attribute__((ext_vector_type(4)));
typedef unsigned u32x2 __attribute__((ext_vector_type(2)));

constexpr int NTOKP = 16384, NTOKS = 512, NTOK = 16896, DM = 1024, NPROJ = 6656, DMIX = 3072, DIN = 6672;
constexpr int C_RGX = 0, C_RGG = 1024, C_XBC = 2048, C_Z = 3584, C_Q = 4608, C_XG = 5632;
constexpr int NPHASE = 7;
constexpr int LDS_BYTES = 131072 + 64;

constexpr size_t O_YP = 0, O_YS = O_YP + (size_t)NTOKP * DM, O_RGCP = O_YS + (size_t)NTOKS * DM, O_RGHP = O_RGCP + 8 * 3 * 1024, O_SCP = O_RGHP + 8 * 1024,
                 O_SHP = O_SCP + 8 * 3 * 1536, O_MKP = O_SHP + (size_t)8 * 16 * 64 * 128, O_MVP = O_MKP + (size_t)2048 * 1024, O_RGCS = O_MVP + (size_t)2048 * 1024,
                 O_RGHS = O_RGCS + (size_t)128 * 3 * 1024, O_SCS = O_RGHS + 128 * 1024, O_SHS = O_SCS + (size_t)128 * 3 * 1536;

constexpr size_t al256(size_t x) { return (x + 255) & ~(size_t)255; }
constexpr size_t W_XB = 0;
constexpr size_t W_WINT = al256(W_XB + (size_t)NTOK * DM * 2);
constexpr size_t W_WDTT = al256(W_WINT + (size_t)NPROJ * DM * 2);
constexpr size_t W_WDTF = al256(W_WDTT + 16 * 1024 * 2);
constexpr size_t W_WOUTT = al256(W_WDTF + 16 * 1024 * 4);
constexpr size_t W_WKVT = al256(W_WOUTT + (size_t)1024 * 3072 * 2);
constexpr size_t W_MEMB = al256(W_WKVT + (size_t)2048 * 1024 * 2);
constexpr size_t W_WGT = al256(W_MEMB + (size_t)2048 * 1024 * 2);
constexpr size_t W_KB = al256(W_WGT + (size_t)8 * 4 * 64 * 128 * 2);
constexpr size_t W_VT = al256(W_KB + (size_t)2048 * 1024 * 2);
constexpr size_t W_XACT = al256(W_VT + (size_t)2048 * 1024 * 2);
constexpr size_t W_DT = al256(W_XACT + (size_t)NTOKP * 1536 * 2);
constexpr size_t W_ACUM = al256(W_DT + (size_t)NTOKP * 16 * 4);
constexpr size_t W_CD = al256(W_ACUM + (size_t)NTOKP * 16 * 4);
constexpr size_t W_ST = al256(W_CD + 8 * 16 * 16 * 4);
constexpr size_t W_MIX = al256(W_ST + (size_t)8 * 16 * 16 * 8192 * 4);
constexpr size_t W_PROJ = al256(W_MIX + (size_t)NTOK * DMIX * 2);
constexpr size_t W_RES = W_PROJ;
constexpr size_t W_BAR = al256(W_PROJ + (size_t)NTOK * NPROJ * 2);
constexpr size_t W_END = al256(W_BAR + 3456 * 4);

struct Params {
    const float *x_prompt, *x_sample, *mem_prompt, *state_rg_conv, *state_rg_h, *state_ssd_conv, *state_ssd_h, *cache_k, *cache_v;
    const float *w_in, *rg_conv_w, *rg_conv_b, *w_rg_a, *b_rg_a, *w_rg_i, *b_rg_i, *rg_lambda, *ssd_conv_w, *ssd_conv_b, *ssd_dt_bias, *ssd_a_log, *ssd_d, *ssd_norm_g,
        *w_mem_k, *w_mem_v, *w_out, *ln_g, *ln_b;
    float* out; unsigned char* ws;
    int ph_lo, ph_hi;
};

DI int otid() { int t = threadIdx.x; asm volatile("" : "+v"(t)); return t; }
DI int obid() { int t = blockIdx.x; asm volatile("" : "+s"(t)); return t; }
DI float bf2f(bf16_t b) { return __uint_as_float(((unsigned)b) << 16); }
DI bf16_t f2bf(float f) { unsigned u = __float_as_uint(f); u += 0x7FFFu + ((u >> 16) & 1u); return (bf16_t)(u >> 16); }
DI unsigned pack2(float lo, float hi) { return (unsigned)f2bf(lo) | ((unsigned)f2bf(hi) << 16); }
DI float bflo(unsigned w) { return __uint_as_float(w << 16); }
DI float bfhi(unsigned w) { return __uint_as_float(w & 0xFFFF0000u); }
DI void unpack8(const u32x4 v, float (&o)[8]) { o[0] = bflo(v.x); o[1] = bfhi(v.x); o[2] = bflo(v.y); o[3] = bfhi(v.y); o[4] = bflo(v.z); o[5] = bfhi(v.z); o[6] = bflo(v.w); o[7] = bfhi(v.w); }
DI u32x4 pack8(const float (&o)[8]) { u32x4 w; w.x = pack2(o[0], o[1]); w.y = pack2(o[2], o[3]); w.z = pack2(o[4], o[5]); w.w = pack2(o[6], o[7]); return w; }
DI bf16x8 as_frag(u32x4 w) { return __builtin_bit_cast(bf16x8, w); }
DI bf16x8 frag2(u32x2 lo, u32x2 hi) { u32x4 w; w.x = lo.x; w.y = lo.y; w.z = hi.x; w.w = hi.y; return __builtin_bit_cast(bf16x8, w); }
DI float siluf(float x) { return x / (1.f + __expf(-x)); }
DI float sigmf(float x) { return 1.f / (1.f + __expf(-x)); }
DI float softplusf(float v) { return v > 20.f ? v : log1pf(__expf(v)); }
#define MFMA16(a, b, c) __builtin_amdgcn_mfma_f32_16x16x32_bf16((a), (b), (c), 0, 0, 0)

#define XB_TMO      128
#define XB_XCNT(j)  (256  + 64 * (j))
#define XB_XSUB(j)  (1280 + 64 * (j))
#define XB_XGEN(j)  (2304 + 64 * (j))
#define XB_TOP      3328
#define XB_TOPGEN   3392
#define XCD_BAR_WORDS 3456
#define XB_SPIN_CAP (1u << 20)
DI unsigned xb_ld(unsigned* p)              { return __hip_atomic_load(p, __ATOMIC_RELAXED, __HIP_MEMORY_SCOPE_AGENT); }
DI unsigned xb_add(unsigned* p, unsigned v) { return __hip_atomic_fetch_add(p, v, __ATOMIC_RELAXED, __HIP_MEMORY_SCOPE_AGENT); }
DI unsigned xb_xcc_id() { return (unsigned)__builtin_amdgcn_s_getreg((3 << 11) | 20) & 0xFu; }
#define XB_SPIN(cond, bar) do { unsigned _sp = 0; while (cond) { __builtin_amdgcn_s_sleep(1); \
    if ((++_sp & 255u) == 0u) { if (xb_ld(&(bar)[XB_TMO])) break; if (_sp > XB_SPIN_CAP) { atomicAdd(&(bar)[XB_TMO], 1u); break; } } } } while (0)
struct XcdBarrier { unsigned* bar; unsigned x; volatile LAS unsigned* st; };
DI XcdBarrier xcd_barrier_post(unsigned* bar, volatile LAS unsigned* st) {
    XcdBarrier b; b.bar = bar; b.x = xb_xcc_id(); b.st = st;
    if (threadIdx.x == 0) (void)xb_add(&bar[XB_XCNT(b.x)], 1u);
    return b;
}
DI void xcd_barrier_complete(unsigned* bar, unsigned x, unsigned& nloc, unsigned& nx) {
    const unsigned G = gridDim.x * gridDim.y * gridDim.z;
    unsigned sum, cnt, mine, sp = 0u;
    for (;;) {
        sum = 0u; cnt = 0u; mine = 0u;
#pragma unroll
        for (unsigned j = 0; j < 16; ++j) { const unsigned c = xb_ld(&bar[XB_XCNT(j)]); sum += c; cnt += (c > 0u) ? 1u : 0u; mine = (j == x) ? c : mine; }
        if (sum == G) break;
        __builtin_amdgcn_s_sleep(1);
        if ((++sp & 255u) == 0u) { if (xb_ld(&bar[XB_TMO])) break; if (sp > XB_SPIN_CAP) { atomicAdd(&bar[XB_TMO], 1u); break; } }
    }
    nloc = mine > 0u ? mine : 1u; nx = cnt > 0u ? cnt : 1u;
}
DI void xcd_barrier(const XcdBarrier& b) {
    asm volatile("s_waitcnt vmcnt(0)" ::: "memory");
    __syncthreads();
    if (threadIdx.x == 0) {
        unsigned* bar = b.bar;
        __builtin_amdgcn_s_waitcnt(0);
        unsigned nloc = b.st[0], nx = b.st[1];
        if (nloc == 0u) { xcd_barrier_complete(bar, b.x, nloc, nx); b.st[0] = nloc; b.st[1] = nx; }
        const unsigned old = xb_add(&bar[XB_XSUB(b.x)], 1u);
        const unsigned gen = old / nloc;
        if (old + 1u == (gen + 1u) * nloc) {
            __builtin_amdgcn_fence(__ATOMIC_RELEASE, "agent");
            asm volatile("s_waitcnt vmcnt(0)" ::: "memory");
            const unsigned og = xb_add(&bar[XB_TOP], 1u);
            const unsigned tg = og / nx;
            if (og + 1u == (tg + 1u) * nx) xb_add(&bar[XB_TOPGEN], 1u);
            else XB_SPIN(xb_ld(&bar[XB_TOPGEN]) == tg, bar);
            __builtin_amdgcn_fence(__ATOMIC_ACQUIRE, "agent");
            xb_add(&bar[XB_XGEN(b.x)], 1u);
            asm volatile("s_waitcnt vmcnt(0)" ::: "memory");
        } else {
            XB_SPIN(xb_ld(&bar[XB_XGEN(b.x)]) == gen, bar);
            __builtin_amdgcn_fence(__ATOMIC_ACQUIRE, "agent");
            asm volatile("s_waitcnt vmcnt(0)" ::: "memory");
        }
    }
    __syncthreads();
}

namespace pg8 {
constexpr int BM = 256, BK = 64, HALF = 128, HTB = HALF * BK * 2, STAGE_BYTES = 8 * HTB, NXCD = 8, WGM = 8;
DI int lds_byte(int r, int c) { const int st = (r >> 4) * 2 + (c >> 5), rr = r & 15, cc = c & 31, ob = rr * 64 + cc * 2; return st * 1024 + (ob ^ (((ob >> 9) & 1) << 5)); }
DI void stage_rc(int b, int& R, int& C) { const int st = b / 1024, sb = b % 1024, swz = sb ^ (((sb >> 9) & 1) << 5); R = (st >> 1) * 16 + swz / 64; C = (st & 1) * 32 + (swz % 64) / 2; }
DI int perm32(int rho) { const int n = rho >> 4, i = rho & 15; return 8 * (i >> 2) + 4 * n + (i & 3); }
struct Unit { int pm, pn; };
struct Gemm { const bf16_t* A; const bf16_t* Bt; int M, N, K; };
struct StaticOrder {
    int nM, nN, nwg, G, c;
    DI void init(int M, int N, int G_, int c_) { nM = M / BM; nN = N / BM; nwg = nM * nN; G = G_; c = c_; }
    DI bool next(int i, Unit& u) const {
        const long L = (long)i * G + c; if (L >= nwg) return false;
        int wgid = (int)L; { const int q = nwg / NXCD, r = nwg % NXCD, xcd = wgid % NXCD, off = wgid / NXCD; wgid = (xcd < r ? xcd * (q + 1) : r * (q + 1) + (xcd - r) * q) + off; }
        const int nig = WGM * nN, gid = wgid / nig, fm = gid * WGM, gsz = (nM - fm) < WGM ? (nM - fm) : WGM;
        u.pm = fm + ((wgid % nig) % gsz); u.pn = (wgid % nig) / gsz; return true;
    }
};
DI unsigned cvt_pk_bf16(float lo, float hi) { unsigned r; asm volatile("v_cvt_pk_bf16_f32 %0, %1, %2" : "=v"(r) : "v"(lo), "v"(hi)); return r; }

struct EpiBf16 {
    static constexpr bool PERM = true;
    bf16_t* O; int ldc;
    DI void operator()(const f32x4 (&acc)[2][2][4][2], const Unit& u, int wr, int wc, int fr, int fq) const {
        const int row0 = u.pm * BM + wr * 64 + fr; const int col0 = u.pn * BM + wc * 32 + 8 * fq;
#pragma unroll
        for (int ai = 0; ai < 2; ++ai)
#pragma unroll
            for (int m = 0; m < 4; ++m) { bf16_t* rowp = O + (size_t)(row0 + ai * HALF + m * 16) * ldc + col0;
#pragma unroll
                for (int bj = 0; bj < 2; ++bj) { const f32x4 v0 = acc[ai][bj][m][0], v1 = acc[ai][bj][m][1];
                    u32x4 w; w.x = cvt_pk_bf16(v0[0], v0[1]); w.y = cvt_pk_bf16(v0[2], v0[3]); w.z = cvt_pk_bf16(v1[0], v1[1]); w.w = cvt_pk_bf16(v1[2], v1[3]);
                    *(u32x4*)(rowp + bj * HALF) = w; } }
    }
};
struct EpiKV {
    static constexpr bool PERM = false;
    float* mk; float* mv; bf16_t* kb; bf16_t* vt;
    DI void operator()(const f32x4 (&acc)[2][2][4][2], const Unit& u, int wr, int wc, int fr, int fq) const {
        const int row0 = u.pm * BM + wr * 64 + fr, col0 = u.pn * BM + wc * 32 + 4 * fq;
#pragma unroll
        for (int ai = 0; ai < 2; ++ai)
#pragma unroll
            for (int m = 0; m < 4; ++m) { const int row = row0 + ai * HALF + m * 16;
#pragma unroll
                for (int bj = 0; bj < 2; ++bj)
#pragma unroll
                    for (int n = 0; n < 2; ++n) { const int col = col0 + bj * HALF + n * 16; const f32x4 v = acc[ai][bj][m][n];
                        if (col < 1024) { *(f32x4*)(mk + (size_t)row * 1024 + col) = v; u32x2 w; w.x = cvt_pk_bf16(v[0], v[1]); w.y = cvt_pk_bf16(v[2], v[3]); *(u32x2*)(kb + (size_t)row * 1024 + col) = w; }
                        else { const int cc = col - 1024; *(f32x4*)(mv + (size_t)row * 1024 + cc) = v; const int bb = row >> 8, mt = row & 255;
#pragma unroll
                            for (int j = 0; j < 4; ++j) { const int c2 = cc + j, head = c2 >> 8, d = c2 & 255; vt[((size_t)((bb * 4 + head) * 256 + d)) * 256 + mt] = f2bf(v[j]); } } } }
    }
};
struct EpiRes {
    static constexpr bool PERM = false;
    float* res; const float* xp; const float* xs; float alpha;
    DI void operator()(const f32x4 (&acc)[2][2][4][2], const Unit& u, int wr, int wc, int fr, int fq) const {
        const int row0 = u.pm * BM + wr * 64 + fr, col0 = u.pn * BM + wc * 32 + 4 * fq;
#pragma unroll
        for (int ai = 0; ai < 2; ++ai)
#pragma unroll
            for (int m = 0; m < 4; ++m) { const int row = row0 + ai * HALF + m * 16; const float* xr = row < NTOKP ? xp + (size_t)row * 1024 : xs + (size_t)(row - NTOKP) * 1024;
#pragma unroll
                for (int bj = 0; bj < 2; ++bj)
#pragma unroll
                    for (int n = 0; n < 2; ++n) { const int col = col0 + bj * HALF + n * 16; const f32x4 xv = *(const f32x4*)(xr + col);
                        *(f32x4*)(res + (size_t)row * 1024 + col) = acc[ai][bj][m][n] + xv * alpha; } }
    }
};

template <class Epi, class Sched>
DI void gemm_phase(LAS unsigned char* lds, const Gemm g, const Sched& S, const Epi& E) {
    const int tid = otid(), wid = __builtin_amdgcn_readfirstlane(tid >> 6), lane = tid & 63, wr = wid >> 2, wc = wid & 3, fr = lane & 15, fq = lane >> 4;
    const int K = g.K, nt = K / BK;
    unsigned voffA[2], voffB[2];
#pragma unroll
    for (int i = 0; i < 2; ++i) { int R, C; stage_rc(tid * 16 + i * 8192, R, C); const int Rb = Epi::PERM ? ((R & ~31) + perm32(R & 31)) : R;
        voffA[i] = (unsigned)(R * K + C) * 2u; voffB[i] = (unsigned)(Rb * K + C) * 2u; }
    const size_t kstep = (size_t)(BK * 2);
    const size_t hstep = (size_t)HALF * K * 2;
    const size_t tstep = 2 * hstep;
    const unsigned ldsw = (unsigned)wid * 1024u;
    const int aoff = lds_byte(wr * 64 + fr, fq * 8), boff = lds_byte(wc * 32 + fr, fq * 8);
#define PG8_SA(b, h) (((b) * 2 + (h)) * HTB)
#define PG8_SB(b, h) ((4 + (b) * 2 + (h)) * HTB)
#define PG8_STAGE(bufoff, gbase, voff) do { _Pragma("unroll") for (int _i = 0; _i < 2; ++_i) \
        __builtin_amdgcn_global_load_lds((const unsigned*)((const char*)(gbase) + (voff)[_i]), (LAS unsigned*)(lds + (bufoff) + ldsw + _i * 8192), 16, 0, 0); } while (0)
#define PG8_LDA(dst, b, h) do { _Pragma("unroll") for (int m = 0; m < 4; ++m) _Pragma("unroll") for (int k = 0; k < 2; ++k) dst[m][k] = *(const LAS bf16x8*)(lds + PG8_SA(b, h) + aoff + m * 2048 + k * 1024); } while (0)
#define PG8_LDB(dst, b, h) do { _Pragma("unroll") for (int n = 0; n < 2; ++n) _Pragma("unroll") for (int k = 0; k < 2; ++k) dst[n][k] = *(const LAS bf16x8*)(lds + PG8_SB(b, h) + boff + n * 2048 + k * 1024); } while (0)
#define PG8_MMA(ai, bj, At, Bt) do { __builtin_amdgcn_s_setprio(1); _Pragma("unroll") for (int m = 0; m < 4; ++m) _Pragma("unroll") for (int n = 0; n < 2; ++n) _Pragma("unroll") for (int k = 0; k < 2; ++k) \
        acc[ai][bj][m][n] = __builtin_amdgcn_mfma_f32_16x16x32_bf16(Bt[n][k], At[m][k], acc[ai][bj][m][n], 0, 0, 0); __builtin_amdgcn_s_setprio(0); } while (0)
#define PG8_WAIT_V(n) asm volatile("s_waitcnt vmcnt(" #n ")" ::: "memory")
#define PG8_WAIT_L(n) asm volatile("s_waitcnt lgkmcnt(" #n ")" ::: "memory")
#define PG8_BAR __builtin_amdgcn_s_barrier()
#define PG8_SCHED __builtin_amdgcn_sched_barrier(0)
    Unit cur, nxt; int ui = 0;
    if (!S.next(0, cur)) return;
    f32x4 acc[2][2][4][2];
#pragma unroll
    for (int a = 0; a < 2; ++a)
#pragma unroll
        for (int b = 0; b < 2; ++b)
#pragma unroll
            for (int m = 0; m < 4; ++m)
#pragma unroll
                for (int n = 0; n < 2; ++n) acc[a][b][m][n] = (f32x4){0.f, 0.f, 0.f, 0.f};
    bf16x8 At[4][2], B0[2][2], B1[2][2];
    const char* cA = (const char*)g.A + (size_t)cur.pm * tstep; const char* cB = (const char*)g.Bt + (size_t)cur.pn * tstep;
    PG8_STAGE(PG8_SB(0, 0), cB, voffB); PG8_STAGE(PG8_SA(0, 0), cA, voffA); PG8_STAGE(PG8_SB(0, 1), cB + hstep, voffB); PG8_STAGE(PG8_SA(0, 1), cA + hstep, voffA);
    if (wr == 1) PG8_BAR;
    PG8_WAIT_V(4); PG8_BAR;
    PG8_STAGE(PG8_SB(1, 0), cB + kstep, voffB); PG8_STAGE(PG8_SA(1, 0), cA + kstep, voffA); PG8_STAGE(PG8_SB(1, 1), cB + hstep + kstep, voffB);
    PG8_WAIT_V(6); PG8_BAR;
    for (;;) {
        const bool has_next = S.next(ui + 1, nxt);
        const char* nA = has_next ? (const char*)g.A + (size_t)nxt.pm * tstep : cA; const char* nB = has_next ? (const char*)g.Bt + (size_t)nxt.pn * tstep : cB;
        for (int t = 0; t < nt; t += 2) {
            const bool last = (t == nt - 2);
            const char* a1 = cA + (size_t)(t + 1) * kstep;
            const char* a2 = last ? nA : cA + (size_t)(t + 2) * kstep; const char* b2 = last ? nB : cB + (size_t)(t + 2) * kstep;
            const char* a3 = a2 + kstep; const char* b3 = b2 + kstep;
            PG8_LDB(B0, 0, 0); PG8_SCHED; PG8_LDA(At, 0, 0); PG8_STAGE(PG8_SA(1, 1), a1 + hstep, voffA);
            PG8_WAIT_L(8); PG8_BAR; PG8_WAIT_L(0); PG8_MMA(0, 0, At, B0); PG8_BAR; PG8_SCHED;
            PG8_LDB(B1, 0, 1); PG8_STAGE(PG8_SB(0, 0), b2, voffB);
            PG8_BAR; PG8_WAIT_L(0); PG8_MMA(0, 1, At, B1); PG8_BAR;
            PG8_LDA(At, 0, 1); PG8_STAGE(PG8_SA(0, 0), a2, voffA);
            PG8_BAR; PG8_WAIT_L(0); PG8_MMA(1, 0, At, B0); PG8_BAR; PG8_SCHED;
            PG8_STAGE(PG8_SB(0, 1), b2 + hstep, voffB);
            PG8_WAIT_V(6); PG8_BAR; PG8_MMA(1, 1, At, B1); PG8_BAR;
            PG8_LDB(B0, 1, 0); PG8_SCHED; PG8_LDA(At, 1, 0); PG8_STAGE(PG8_SA(0, 1), a2 + hstep, voffA);
            PG8_WAIT_L(8); PG8_BAR; PG8_WAIT_L(0); PG8_MMA(0, 0, At, B0); PG8_BAR; PG8_SCHED;
            PG8_LDB(B1, 1, 1); PG8_STAGE(PG8_SB(1, 0), b3, voffB);
            PG8_BAR; PG8_WAIT_L(0); PG8_MMA(0, 1, At, B1); PG8_BAR;
            PG8_LDA(At, 1, 1); PG8_STAGE(PG8_SA(1, 0), a3, voffA);
            PG8_BAR; PG8_WAIT_L(0); PG8_MMA(1, 0, At, B0); PG8_BAR; PG8_SCHED;
            PG8_STAGE(PG8_SB(1, 1), b3 + hstep, voffB);
            PG8_WAIT_V(6); PG8_BAR; PG8_MMA(1, 1, At, B1); PG8_BAR;
        }
        E(acc, cur, wr, wc, fr, fq);
        if (!has_next) break;
#pragma unroll
        for (int a = 0; a < 2; ++a)
#pragma unroll
            for (int b = 0; b < 2; ++b)
#pragma unroll
                for (int m = 0; m < 4; ++m)
#pragma unroll
                    for (int n = 0; n < 2; ++n) acc[a][b][m][n] = (f32x4){0.f, 0.f, 0.f, 0.f};
        cur = nxt; cA = nA; cB = nB; ++ui;
    }
    PG8_WAIT_V(0);
    if (wr == 0) PG8_BAR;
    PG8_BAR;
#undef PG8_SA
#undef PG8_SB
#undef PG8_STAGE
#undef PG8_LDA
#undef PG8_LDB
#undef PG8_MMA
#undef PG8_WAIT_V
#undef PG8_WAIT_L
#undef PG8_BAR
#undef PG8_SCHED
}
}

DI void tr_tile(const float* src, int ld_src, int k0, int c0, bf16_t* dst, int ld_dst, int n0, float* lds) {
    const int tid = otid();
#pragma unroll
    for (int pass = 0; pass < 2; ++pass) { const int r = pass * 32 + (tid >> 4), c4 = (tid & 15) * 4;
        const f32x4 v = *(const f32x4*)(src + (size_t)(k0 + r) * ld_src + c0 + c4);
        lds[r * 65 + c4 + 0] = v[0]; lds[r * 65 + c4 + 1] = v[1]; lds[r * 65 + c4 + 2] = v[2]; lds[r * 65 + c4 + 3] = v[3]; }
    __syncthreads();
    const int nn = tid >> 3, kc = (tid & 7) * 8;
    float o[8];
#pragma unroll
    for (int e = 0; e < 8; ++e) o[e] = lds[(kc + e) * 65 + nn];
    *(u32x4*)(dst + (size_t)(n0 + nn) * ld_dst + k0 + kc) = pack8(o);
    __syncthreads();
}

DI void phase_prep(const Params& p, unsigned char* lds) {
    unsigned char* ws = p.ws;
    const int bidx_ = obid(); const size_t gtid = (size_t)bidx_ * 512 + otid(), nthr = (size_t)gridDim.x * 512;
    { bf16_t* xb = (bf16_t*)(ws + W_XB);
      for (size_t v = gtid; v < (size_t)NTOK * 128; v += nthr) { const float* s = v < (size_t)NTOKP * 128 ? p.x_prompt + v * 8 : p.x_sample + (v - (size_t)NTOKP * 128) * 8;
          const f32x4 a = *(const f32x4*)s, b = *(const f32x4*)(s + 4); float o[8] = {a[0], a[1], a[2], a[3], b[0], b[1], b[2], b[3]}; *(u32x4*)(xb + v * 8) = pack8(o); } }
    { bf16_t* mb = (bf16_t*)(ws + W_MEMB);
      for (size_t v = gtid; v < (size_t)2048 * 128; v += nthr) { const float* s = p.mem_prompt + v * 8;
          const f32x4 a = *(const f32x4*)s, b = *(const f32x4*)(s + 4); float o[8] = {a[0], a[1], a[2], a[3], b[0], b[1], b[2], b[3]}; *(u32x4*)(mb + v * 8) = pack8(o); } }
    { bf16_t* wd = (bf16_t*)(ws + W_WDTT); float* wf = (float*)(ws + W_WDTF);
      for (size_t i = gtid; i < 16 * 1024; i += nthr) { const int h = (int)(i >> 10), k = (int)(i & 1023); const float v = p.w_in[(size_t)k * DIN + 4608 + h]; wd[i] = f2bf(v); wf[i] = v; } }
    { bf16_t* wg = (bf16_t*)(ws + W_WGT);
      for (size_t i = gtid; i < (size_t)8 * 4 * 64 * 128; i += nthr) { const int k = (int)(i >> 15), qd = (int)(i >> 13) & 3, nn = (int)(i >> 7) & 63, ii = (int)(i & 127);
          const float v = nn < 32 ? p.w_rg_a[((size_t)k * 128 + ii) * 128 + qd * 32 + nn] : p.w_rg_i[((size_t)k * 128 + ii) * 128 + qd * 32 + nn - 32]; wg[i] = f2bf(v); } }
    float* tl = (float*)lds;
    for (int t = bidx_; t < 1664 + 768 + 512; t += gridDim.x) {
        if (t < 1664) { const int kt = t & 15, ntile = t >> 4; const int n0 = ntile * 64, c0 = n0 < 4608 ? n0 : n0 + 16;
            tr_tile(p.w_in, DIN, kt * 64, c0, (bf16_t*)(ws + W_WINT), 1024, n0, tl); }
        else if (t < 1664 + 768) { const int u = t - 1664; const int kt = u % 48, ntile = u / 48;
            tr_tile(p.w_out, 1024, kt * 64, ntile * 64, (bf16_t*)(ws + W_WOUTT), 3072, ntile * 64, tl); }
        else { const int u = t - 1664 - 768; const int kt = u & 15, ntile = u >> 4; const int n0 = ntile * 64;
            if (n0 < 1024) tr_tile(p.w_mem_k, 1024, kt * 64, n0, (bf16_t*)(ws + W_WKVT), 1024, n0, tl);
            else tr_tile(p.w_mem_v, 1024, kt * 64, n0 - 1024, (bf16_t*)(ws + W_WKVT), 1024, n0, tl); }
    }
}

DI void conv8_ssd_prompt(const Params& p, const bf16_t* proj, int rowbase, int t, int ch, float (&o)[8]) {
    const f32x4 b0 = *(const f32x4*)(p.ssd_conv_b + ch), b1 = *(const f32x4*)(p.ssd_conv_b + ch + 4);
    float acc[8] = {b0[0], b0[1], b0[2], b0[3], b1[0], b1[1], b1[2], b1[3]};
#pragma unroll
    for (int kk = 0; kk < 4; ++kk) { const int tt = t - 3 + kk;
        if (tt >= 0) { const u32x4 v = *(const u32x4*)(proj + (size_t)(rowbase + tt) * NPROJ + C_XBC + ch); float x[8]; unpack8(v, x);
            const f32x4 w0 = *(const f32x4*)(p.ssd_conv_w + kk * 1536 + ch), w1 = *(const f32x4*)(p.ssd_conv_w + kk * 1536 + ch + 4);
            acc[0] += x[0] * w0[0]; acc[1] += x[1] * w0[1]; acc[2] += x[2] * w0[2]; acc[3] += x[3] * w0[3];
            acc[4] += x[4] * w1[0]; acc[5] += x[5] * w1[1]; acc[6] += x[6] * w1[2]; acc[7] += x[7] * w1[3]; } }
#pragma unroll
    for (int e = 0; e < 8; ++e) o[e] = siluf(acc[e]);
}

DI void ssd1_item(const Params& p, unsigned char* lds, int b, int c, int g) {
    unsigned char* ws = p.ws;
    const int tid = otid(), w = tid >> 6, lane = tid & 63, l15 = lane & 15, q = lane >> 4;
    float* dt_s = (float*)lds; float* acum_s = dt_s + 2048; float* w_s = acum_s + 2048;
    bf16_t* BT = (bf16_t*)(lds + 20480); bf16_t* xsT = (bf16_t*)(lds + 20480 + 34816);
    const bf16_t* xb = (const bf16_t*)(ws + W_XB); const bf16_t* wdt = (const bf16_t*)(ws + W_WDTT); const bf16_t* proj = (const bf16_t*)(ws + W_PROJ);
    bf16_t* xact = (bf16_t*)(ws + W_XACT); float* dt_g = (float*)(ws + W_DT); float* acum_g = (float*)(ws + W_ACUM); float* cd_g = (float*)(ws + W_CD); float* st_g = (float*)(ws + W_ST);
    const int tok0 = b * 2048 + c * 128;
    __syncthreads();
    { f32x4 acc = {0.f, 0.f, 0.f, 0.f}; const bf16_t* ap = xb + (size_t)(tok0 + 16 * w + l15) * 1024 + q * 8; const bf16_t* bp = wdt + l15 * 1024 + q * 8;
#pragma unroll 8
      for (int ks = 0; ks < 32; ++ks) { const bf16x8 a = *(const bf16x8*)(ap + ks * 32); const bf16x8 bb = *(const bf16x8*)(bp + ks * 32); acc = MFMA16(a, bb, acc); }
      const float bias = p.ssd_dt_bias[l15];
#pragma unroll
      for (int r = 0; r < 4; ++r) { const int i = 16 * w + 4 * q + r; const float dt = softplusf(acc[r] + bias); dt_s[i * 16 + l15] = dt; dt_g[(size_t)(tok0 + i) * 16 + l15] = dt; } }
    __syncthreads();
    if (tid < 16) { const float ah = -__expf(p.ssd_a_log[tid]); float run = 0.f;
        for (int i = 0; i < 128; ++i) { run += dt_s[i * 16 + tid] * ah; acum_s[i * 16 + tid] = run; acum_g[(size_t)(tok0 + i) * 16 + tid] = run; } }
    __syncthreads();
    if (tid < 8) cd_g[(b * 16 + c) * 16 + 8 * g + tid] = __expf(acum_s[127 * 16 + 8 * g + tid]);
    for (int idx = tid; idx < 1024; idx += 512) { const int j = idx >> 3, hl = idx & 7, h = 8 * g + hl; w_s[idx] = dt_s[j * 16 + h] * __expf(acum_s[127 * 16 + h] - acum_s[j * 16 + h]); }
    for (int idx = tid; idx < 4096; idx += 512) { const int which = idx >> 11, rem = idx & 2047, j = rem >> 4, cv = (rem & 15) * 8; const int ch = 1024 + which * 256 + g * 128 + cv;
        float o[8]; conv8_ssd_prompt(p, proj, b * 2048, c * 128 + j, ch, o); const u32x4 pk = pack8(o);
        *(u32x4*)(xact + (size_t)(tok0 + j) * 1536 + ch) = pk;
        if (which == 0) { const bf16_t* e16 = (const bf16_t*)&pk;
#pragma unroll
            for (int e = 0; e < 8; ++e) BT[(cv + e) * 136 + j] = f2bf(o[e]); (void)e16; } }
    for (int hl = 0; hl < 8; ++hl) {
        __syncthreads();
        for (int idx = tid; idx < 1024; idx += 512) { const int j = idx >> 3, pv = (idx & 7) * 8; const int ch = g * 512 + hl * 64 + pv;
            float o[8]; conv8_ssd_prompt(p, proj, b * 2048, c * 128 + j, ch, o);
            *(u32x4*)(xact + (size_t)(tok0 + j) * 1536 + ch) = pack8(o);
            const float wj = w_s[j * 8 + hl];
#pragma unroll
            for (int e = 0; e < 8; ++e) xsT[(pv + e) * 136 + j] = f2bf(o[e] * wj); }
        __syncthreads();
        const int pt = w & 3, nh = w >> 2;
        f32x4 acc[4];
#pragma unroll
        for (int nt = 0; nt < 4; ++nt) acc[nt] = (f32x4){0.f, 0.f, 0.f, 0.f};
#pragma unroll
        for (int ks = 0; ks < 4; ++ks) { const bf16x8 a = *(const bf16x8*)(xsT + (pt * 16 + l15) * 136 + ks * 32 + q * 8);
#pragma unroll
            for (int nt = 0; nt < 4; ++nt) { const bf16x8 bb = *(const bf16x8*)(BT + (nh * 64 + nt * 16 + l15) * 136 + ks * 32 + q * 8); acc[nt] = MFMA16(a, bb, acc[nt]); } }
        float* sp = st_g + (size_t)(((b * 16 + c) * 16 + 8 * g + hl)) * 8192;
#pragma unroll
        for (int nt = 0; nt < 4; ++nt)
#pragma unroll
            for (int r = 0; r < 4; ++r) sp[(pt * 16 + 4 * q + r) * 128 + nh * 64 + nt * 16 + l15] = acc[nt][r];
    }
    if (c == 15) {
        for (int idx = tid; idx < 3 * 768; idx += 512) { const int jj = idx / 768, cc = idx % 768; const int ch = cc < 512 ? g * 512 + cc : (cc < 640 ? 1024 + g * 128 + (cc - 512) : 1280 + g * 128 + (cc - 640));
            p.out[O_SCP + (size_t)(b * 3 + jj) * 1536 + ch] = bf2f(proj[(size_t)(b * 2048 + 2045 + jj) * NPROJ + C_XBC + ch]); }
    }
}

DI void statepass_item(const Params& p, int sp) {
    const int b = sp >> 5, h = (sp >> 1) & 15, half = sp & 1; const int e0 = half * 4096 + otid() * 8;
    float* st_g = (float*)(p.ws + W_ST); const float* cd_g = (const float*)(p.ws + W_CD);
    f32x4 r0 = {0.f, 0.f, 0.f, 0.f}, r1 = {0.f, 0.f, 0.f, 0.f};
    for (int c = 0; c < 16; ++c) { float* ptr = st_g + (size_t)((b * 16 + c) * 16 + h) * 8192 + e0; const float cd = cd_g[(b * 16 + c) * 16 + h];
        const f32x4 v0 = *(const f32x4*)ptr, v1 = *(const f32x4*)(ptr + 4); *(f32x4*)ptr = r0; *(f32x4*)(ptr + 4) = r1; r0 = r0 * cd + v0; r1 = r1 * cd + v1; }
    float* o = p.out + O_SHP + (size_t)(b * 16 + h) * 8192 + e0; *(f32x4*)o = r0; *(f32x4*)(o + 4) = r1;
}

DI void rg_item(const Params& p, unsigned char* lds, const bool sample, int bidx, int k, int qd) {
    unsigned char* ws = p.ws;
    const int tid = otid(), w = tid >> 6, lane = tid & 63, l15 = lane & 15, q = lane >> 4;
    bf16_t* uA = (bf16_t*)lds;
    float* sa = (float*)(lds + 34816); float* sb = sa + 4096;
    float* segA = sb + 4096; float* segB = segA + 512; float* hcar = segB + 512;
    const bf16_t* proj = (const bf16_t*)(ws + W_PROJ); bf16_t* mix = (bf16_t*)(ws + W_MIX);
    const bf16_t* wg = (const bf16_t*)(ws + W_WGT) + (size_t)((k * 4 + qd) * 64) * 128;
    bf16x8 bw[4][4];
#pragma unroll
    for (int nt = 0; nt < 4; ++nt)
#pragma unroll
        for (int ks = 0; ks < 4; ++ks) bw[nt][ks] = *(const bf16x8*)(wg + (nt * 16 + l15) * 128 + ks * 32 + q * 8);
    float ba[2], bi[2], spl[2];
#pragma unroll
    for (int ntl = 0; ntl < 2; ++ntl) { const int ch = k * 128 + qd * 32 + ntl * 16 + l15; ba[ntl] = p.b_rg_a[ch]; bi[ntl] = p.b_rg_i[ch]; spl[ntl] = softplusf(-p.rg_lambda[ch]); }
    __syncthreads();
    if (tid < 32) hcar[tid] = 0.f;
    const int ntiles = sample ? 1 : 16;
    for (int tile = 0; tile < ntiles; ++tile) {
        __syncthreads();
        { const int row = tid >> 2, cg0 = (tid & 3) * 32;
#pragma unroll
          for (int v = 0; v < 4; ++v) { const int c8 = cg0 + v * 8, ch = k * 128 + c8;
              const f32x4 b0 = *(const f32x4*)(p.rg_conv_b + ch), b1 = *(const f32x4*)(p.rg_conv_b + ch + 4);
              float acc[8] = {b0[0], b0[1], b0[2], b0[3], b1[0], b1[1], b1[2], b1[3]};
#pragma unroll
              for (int kk = 0; kk < 4; ++kk) { float x[8]; bool have = true;
                  if (!sample) { const int tt = tile * 128 + row - 3 + kk; if (tt >= 0) { const u32x4 vv = *(const u32x4*)(proj + (size_t)(bidx * 2048 + tt) * NPROJ + C_RGX + ch); unpack8(vv, x); } else have = false; }
                  else { const int sbi = bidx * 32 + (row >> 2), ui = (row & 3) + kk;
                      if (ui < 3) { const float* s = p.state_rg_conv + (size_t)(sbi * 3 + ui) * 1024 + ch; const f32x4 s0 = *(const f32x4*)s, s1 = *(const f32x4*)(s + 4);
                          x[0] = s0[0]; x[1] = s0[1]; x[2] = s0[2]; x[3] = s0[3]; x[4] = s1[0]; x[5] = s1[1]; x[6] = s1[2]; x[7] = s1[3]; }
                      else { const u32x4 vv = *(const u32x4*)(proj + (size_t)(NTOKP + sbi * 4 + ui - 3) * NPROJ + C_RGX + ch); unpack8(vv, x); } }
                  if (have) { const f32x4 w0 = *(const f32x4*)(p.rg_conv_w + kk * 1024 + ch), w1 = *(const f32x4*)(p.rg_conv_w + kk * 1024 + ch + 4);
                      acc[0] += x[0] * w0[0]; acc[1] += x[1] * w0[1]; acc[2] += x[2] * w0[2]; acc[3] += x[3] * w0[3];
                      acc[4] += x[4] * w1[0]; acc[5] += x[5] * w1[1]; acc[6] += x[6] * w1[2]; acc[7] += x[7] * w1[3]; } }
              *(u32x4*)(uA + row * 136 + c8) = pack8(acc); } }
        __syncthreads();
        { f32x4 acc[4];
#pragma unroll
          for (int nt = 0; nt < 4; ++nt) acc[nt] = (f32x4){0.f, 0.f, 0.f, 0.f};
#pragma unroll
          for (int ks = 0; ks < 4; ++ks) { const bf16x8 a = *(const bf16x8*)(uA + (16 * w + l15) * 136 + ks * 32 + q * 8);
#pragma unroll
              for (int nt = 0; nt < 4; ++nt) acc[nt] = MFMA16(a, bw[nt][ks], acc[nt]); }
#pragma unroll
          for (int ntl = 0; ntl < 2; ++ntl)
#pragma unroll
              for (int r = 0; r < 4; ++r) { const int row = 16 * w + 4 * q + r, cl = ntl * 16 + l15;
                  const float rr = sigmf(acc[ntl][r] + ba[ntl]), ii = sigmf(acc[2 + ntl][r] + bi[ntl]);
                  const float la = -8.f * rr * spl[ntl]; float a = __expf(la); const float uval = bf2f(uA[row * 136 + qd * 32 + cl]);
                  float bt = sqrtf(-expm1f(2.f * la)) * ii * uval;
                  const bool first = sample ? ((row & 3) == 0) : (tile == 0 && row == 0);
                  if (first) { const float h0 = sample ? p.state_rg_h[(size_t)(bidx * 32 + (row >> 2)) * 1024 + k * 128 + qd * 32 + cl] : 0.f; bt += a * h0; a = 0.f; }
                  sa[row * 32 + cl] = a; sb[row * 32 + cl] = bt; } }
        __syncthreads();
        const int cl = tid & 31, seg = tid >> 5;
        { float A = 1.f, B = 0.f;
#pragma unroll
          for (int j = 0; j < 8; ++j) { const int row = seg * 8 + j; const float a = sa[row * 32 + cl], bb = sb[row * 32 + cl]; B = a * B + bb; A = a * A; }
          segA[seg * 32 + cl] = A; segB[seg * 32 + cl] = B; }
        __syncthreads();
        float h = hcar[cl];
        for (int s = 0; s < seg; ++s) h = segA[s * 32 + cl] * h + segB[s * 32 + cl];
        const int chg = k * 128 + qd * 32 + cl;
        float gts[8];
#pragma unroll
        for (int j = 0; j < 8; ++j) { const int row = seg * 8 + j; const size_t grow = sample ? (size_t)(NTOKP + bidx * 128 + row) : (size_t)(bidx * 2048 + tile * 128 + row);
            gts[j] = bf2f(proj[grow * NPROJ + C_RGG + chg]); }
#pragma unroll
        for (int j = 0; j < 8; ++j) { const int row = seg * 8 + j; h = sa[row * 32 + cl] * h + sb[row * 32 + cl];
            const size_t grow = sample ? (size_t)(NTOKP + bidx * 128 + row) : (size_t)(bidx * 2048 + tile * 128 + row);
            mix[grow * DMIX + chg] = f2bf(h * siluf(gts[j]));
            if (sample) { if ((row & 3) == 3) p.out[O_RGHS + (size_t)(bidx * 32 + (row >> 2)) * 1024 + chg] = h; }
            else if (tile == 15 && row == 127) p.out[O_RGHP + (size_t)bidx * 1024 + chg] = h; }
        __syncthreads();
        if (seg == 15) hcar[cl] = h;
    }
    if (!sample) { if (tid < 96) { const int jj = tid >> 5, cl = tid & 31, chg = k * 128 + qd * 32 + cl;
            p.out[O_RGCP + (size_t)(bidx * 3 + jj) * 1024 + chg] = bf2f(proj[(size_t)(bidx * 2048 + 2045 + jj) * NPROJ + C_RGX + chg]); } }
    else { for (int idx = tid; idx < 32 * 3 * 32; idx += 512) { const int cl = idx & 31, jj = (idx >> 5) % 3, sl = idx / 96; const int sbi = bidx * 32 + sl, chg = k * 128 + qd * 32 + cl;
            p.out[O_RGCS + (size_t)(sbi * 3 + jj) * 1024 + chg] = bf2f(proj[(size_t)(NTOKP + sbi * 4 + 1 + jj) * NPROJ + C_RGX + chg]); } }
}

DI void attnp_item(const Params& p, int b, int head, int qt) {
    unsigned char* ws = p.ws;
    const int tid = otid(), w = tid >> 6, lane = tid & 63, l15 = lane & 15, q = lane >> 4;
    const bf16_t* proj = (const bf16_t*)(ws + W_PROJ); const bf16_t* kb = (const bf16_t*)(ws + W_KB); const bf16_t* vt = (const bf16_t*)(ws + W_VT); bf16_t* mix = (bf16_t*)(ws + W_MIX);
    const int tokb = b * 2048 + qt * 128 + 16 * w;
    bf16x8 qf[8];
#pragma unroll
    for (int ks = 0; ks < 8; ++ks) qf[ks] = *(const bf16x8*)(proj + (size_t)(tokb + l15) * NPROJ + C_Q + head * 256 + ks * 32 + q * 8);
    f32x4 st[16];
#pragma unroll
    for (int mt = 0; mt < 16; ++mt) { st[mt] = (f32x4){0.f, 0.f, 0.f, 0.f}; const bf16_t* kp = kb + (size_t)(b * 256 + 16 * mt + l15) * 1024 + head * 256 + q * 8;
#pragma unroll
        for (int ks = 0; ks < 8; ++ks) { const bf16x8 kf = *(const bf16x8*)(kp + ks * 32); st[mt] = MFMA16(kf, qf[ks], st[mt]); } }
    float mx = -3.0e38f;
#pragma unroll
    for (int mt = 0; mt < 16; ++mt)
#pragma unroll
        for (int r = 0; r < 4; ++r) { st[mt][r] *= 0.0625f; mx = fmaxf(mx, st[mt][r]); }
    mx = fmaxf(mx, __shfl_xor(mx, 16)); mx = fmaxf(mx, __shfl_xor(mx, 32));
    float l = 0.f;
#pragma unroll
    for (int mt = 0; mt < 16; ++mt)
#pragma unroll
        for (int r = 0; r < 4; ++r) { const float e = __expf(st[mt][r] - mx); st[mt][r] = e; l += e; }
    l += __shfl_xor(l, 16); l += __shfl_xor(l, 32);
    bf16x8 pf[8];
#pragma unroll
    for (int s = 0; s < 8; ++s) { float m8[8] = {st[2 * s][0], st[2 * s][1], st[2 * s][2], st[2 * s][3], st[2 * s + 1][0], st[2 * s + 1][1], st[2 * s + 1][2], st[2 * s + 1][3]}; pf[s] = as_frag(pack8(m8)); }
    float linv[4];
#pragma unroll
    for (int r = 0; r < 4; ++r) linv[r] = 1.f / __shfl(l, 4 * q + r);
#pragma unroll 2
    for (int dt = 0; dt < 16; ++dt) { f32x4 o = {0.f, 0.f, 0.f, 0.f}; const bf16_t* vp = vt + ((size_t)((b * 4 + head) * 256 + 16 * dt + l15)) * 256 + 4 * q;
        float gt[4];
#pragma unroll
        for (int r = 0; r < 4; ++r) gt[r] = bf2f(proj[(size_t)(tokb + 4 * q + r) * NPROJ + C_XG + head * 256 + 16 * dt + l15]);
#pragma unroll
        for (int s = 0; s < 8; ++s) { const u32x2 lo = *(const u32x2*)(vp + 32 * s), hi = *(const u32x2*)(vp + 32 * s + 16); o = MFMA16(pf[s], frag2(lo, hi), o); }
#pragma unroll
        for (int r = 0; r < 4; ++r) { const size_t tok = (size_t)(tokb + 4 * q + r); const int d = 16 * dt + l15;
            mix[tok * DMIX + 2048 + head * 256 + d] = f2bf(o[r] * linv[r] * siluf(gt[r])); } }
}

DI float wave_sum(float v) { v += __shfl_xor(v, 32); v += __shfl_xor(v, 16); v += __shfl_xor(v, 8); v += __shfl_xor(v, 4); v += __shfl_xor(v, 2); v += __shfl_xor(v, 1); return v; }
DI float wave_max(float v) { v = fmaxf(v, __shfl_xor(v, 32)); v = fmaxf(v, __shfl_xor(v, 16)); v = fmaxf(v, __shfl_xor(v, 8)); v = fmaxf(v, __shfl_xor(v, 4)); v = fmaxf(v, __shfl_xor(v, 2)); v = fmaxf(v, __shfl_xor(v, 1)); return v; }

DI void attns_item(const Params& p, unsigned char* lds, int sbi, int head) {
    unsigned char* ws = p.ws;
    const int tid = otid(), w = tid >> 6, lane = tid & 63;
    const bf16_t* proj = (const bf16_t*)(ws + W_PROJ); bf16_t* mix = (bf16_t*)(ws + W_MIX);
    float* qs = (float*)lds; float* sc = qs + 1024; float* ored = sc + 1024;
    __syncthreads();
    for (int idx = tid; idx < 1024; idx += 512) { const int t = idx >> 8, d = idx & 255; qs[idx] = bf2f(proj[(size_t)(NTOKP + sbi * 4 + t) * NPROJ + C_Q + head * 256 + d]); }
    __syncthreads();
    f32x4 qv[4];
#pragma unroll
    for (int t = 0; t < 4; ++t) qv[t] = *(const f32x4*)(qs + t * 256 + lane * 4);
    for (int m = w; m < 256; m += 8) { const f32x4 kv = *(const f32x4*)(p.cache_k + ((size_t)(sbi * 256 + m) * 4 + head) * 256 + lane * 4);
#pragma unroll
        for (int t = 0; t < 4; ++t) { float s = kv[0] * qv[t][0] + kv[1] * qv[t][1] + kv[2] * qv[t][2] + kv[3] * qv[t][3]; s = wave_sum(s); if (lane == 0) sc[t * 256 + m] = s * 0.0625f; } }
    __syncthreads();
    if (w < 4) { const f32x4 v = *(const f32x4*)(sc + w * 256 + lane * 4); float mx = fmaxf(fmaxf(v[0], v[1]), fmaxf(v[2], v[3])); mx = wave_max(mx);
        f32x4 e; e[0] = __expf(v[0] - mx); e[1] = __expf(v[1] - mx); e[2] = __expf(v[2] - mx); e[3] = __expf(v[3] - mx); float s = wave_sum(e[0] + e[1] + e[2] + e[3]); const float inv = 1.f / s;
        *(f32x4*)(sc + w * 256 + lane * 4) = e * inv; }
    __syncthreads();
    f32x4 acc[4];
#pragma unroll
    for (int t = 0; t < 4; ++t) acc[t] = (f32x4){0.f, 0.f, 0.f, 0.f};
    for (int m = w; m < 256; m += 8) { const f32x4 vv = *(const f32x4*)(p.cache_v + ((size_t)(sbi * 256 + m) * 4 + head) * 256 + lane * 4);
#pragma unroll
        for (int t = 0; t < 4; ++t) acc[t] += vv * sc[t * 256 + m]; }
#pragma unroll
    for (int t = 0; t < 4; ++t) *(f32x4*)(ored + (w * 4 + t) * 256 + lane * 4) = acc[t];
    __syncthreads();
    for (int idx = tid; idx < 1024; idx += 512) { const int t = idx >> 8, d = idx & 255; float s = 0.f;
#pragma unroll
        for (int ww = 0; ww < 8; ++ww) s += ored[(ww * 4 + t) * 256 + d];
        const size_t tok = (size_t)(NTOKP + sbi * 4 + t); const float gate = bf2f(proj[tok * NPROJ + C_XG + head * 256 + d]); mix[tok * DMIX + 2048 + head * 256 + d] = f2bf(s * siluf(gate)); }
}

DI void ssds_item(const Params& p, unsigned char* lds, int sbi, int g) {
    unsigned char* ws = p.ws;
    const int tid = otid(), w = tid >> 6, lane = tid & 63;
    const bf16_t* proj = (const bf16_t*)(ws + W_PROJ); bf16_t* mix = (bf16_t*)(ws + W_MIX); const float* wdf = (const float*)(ws + W_WDTF);
    float* xs = (float*)lds; float* Bs = xs + 2048; float* Cs = Bs + 512; float* yg = Cs + 512; float* dts = yg + 2048; float* decs = dts + 32;
    __syncthreads();
#pragma unroll
    for (int d = 0; d < 4; ++d) { const int pi = w * 4 + d, t = pi & 3, hl = pi >> 2, h = 8 * g + hl; float s = 0.f;
#pragma unroll
        for (int i = 0; i < 4; ++i) { const f32x4 xv = *(const f32x4*)(p.x_sample + (size_t)(sbi * 4 + t) * 1024 + i * 256 + lane * 4), wv = *(const f32x4*)(wdf + h * 1024 + i * 256 + lane * 4);
            s += xv[0] * wv[0] + xv[1] * wv[1] + xv[2] * wv[2] + xv[3] * wv[3]; }
        s = wave_sum(s);
        if (lane == 0) { const float dt = softplusf(s + p.ssd_dt_bias[h]); dts[t * 8 + hl] = dt; decs[t * 8 + hl] = __expf(-dt * __expf(p.ssd_a_log[h])); } }
    for (int idx = tid; idx < 4 * 768; idx += 512) { const int t = idx / 768, cc = idx % 768; const int ch = cc < 512 ? g * 512 + cc : (cc < 640 ? 1024 + g * 128 + (cc - 512) : 1280 + g * 128 + (cc - 640));
        float acc = p.ssd_conv_b[ch];
#pragma unroll
        for (int kk = 0; kk < 4; ++kk) { const int ui = t + kk; const float x = ui < 3 ? p.state_ssd_conv[(size_t)(sbi * 3 + ui) * 1536 + ch] : bf2f(proj[(size_t)(NTOKP + sbi * 4 + ui - 3) * NPROJ + C_XBC + ch]);
            acc += x * p.ssd_conv_w[kk * 1536 + ch]; }
        const float a = siluf(acc);
        if (cc < 512) xs[t * 512 + cc] = a; else if (cc < 640) Bs[t * 128 + cc - 512] = a; else Cs[t * 128 + cc - 640] = a; }
    for (int idx = tid; idx < 3 * 768; idx += 512) { const int jj = idx / 768, cc = idx % 768; const int ch = cc < 512 ? g * 512 + cc : (cc < 640 ? 1024 + g * 128 + (cc - 512) : 1280 + g * 128 + (cc - 640));
        p.out[O_SCS + (size_t)(sbi * 3 + jj) * 1536 + ch] = bf2f(proj[(size_t)(NTOKP + sbi * 4 + 1 + jj) * NPROJ + C_XBC + ch]); }
    __syncthreads();
    const int pp = tid >> 3, n0 = (tid & 7) * 16;
    for (int hl = 0; hl < 8; ++hl) { const int h = 8 * g + hl; const size_t so = ((size_t)(sbi * 16 + h) * 64 + pp) * 128 + n0;
        f32x4 hs[4];
#pragma unroll
        for (int v = 0; v < 4; ++v) hs[v] = *(const f32x4*)(p.state_ssd_h + so + v * 4);
        const float dsk = p.ssd_d[h];
#pragma unroll
        for (int t = 0; t < 4; ++t) { const float dec = decs[t * 8 + hl], xv = xs[t * 512 + hl * 64 + pp], dtx = dts[t * 8 + hl] * xv; float part = 0.f;
#pragma unroll
            for (int v = 0; v < 4; ++v) { const f32x4 bv = *(const f32x4*)(Bs + t * 128 + n0 + v * 4), cv = *(const f32x4*)(Cs + t * 128 + n0 + v * 4);
                hs[v] = hs[v] * dec + bv * dtx; part += cv[0] * hs[v][0] + cv[1] * hs[v][1] + cv[2] * hs[v][2] + cv[3] * hs[v][3]; }
            part += __shfl_xor(part, 1); part += __shfl_xor(part, 2); part += __shfl_xor(part, 4);
            if ((tid & 7) == 0) { const float y = part + dsk * xv; const float z = bf2f(proj[(size_t)(NTOKP + sbi * 4 + t) * NPROJ + C_Z + h * 64 + pp]); yg[t * 512 + hl * 64 + pp] = y * siluf(z); } }
#pragma unroll
        for (int v = 0; v < 4; ++v) *(f32x4*)(p.out + O_SHS + so + v * 4) = hs[v];
    }
    __syncthreads();
    if (w < 4) { const int t = w; float ss = 0.f; float v[8];
#pragma unroll
        for (int e = 0; e < 8; ++e) { v[e] = yg[t * 512 + e * 64 + lane]; ss += v[e] * v[e]; }
        ss = wave_sum(ss); const float rstd = rsqrtf(ss * (1.f / 512.f) + 1e-5f);
#pragma unroll
        for (int e = 0; e < 8; ++e) { const int cc = e * 64 + lane; mix[(size_t)(NTOKP + sbi * 4 + t) * DMIX + 1024 + g * 512 + cc] = f2bf(v[e] * rstd * p.ssd_norm_g[g * 512 + cc]); } }
}

DI void ssd3_item(const Params& p, unsigned char* lds, int b, int c, int g) {
    unsigned char* ws = p.ws;
    const int tid = otid(), w = tid >> 6, lane = tid & 63, l15 = lane & 15, q = lane >> 4;
    float* acum_s = (float*)lds; float* dt_s = acum_s + 1024;
    bf16_t* xT = (bf16_t*)(lds + 8192);
    const bf16_t* proj = (const bf16_t*)(ws + W_PROJ); const bf16_t* xact = (const bf16_t*)(ws + W_XACT); bf16_t* mix = (bf16_t*)(ws + W_MIX);
    const float* dt_g = (const float*)(ws + W_DT); const float* acum_g = (const float*)(ws + W_ACUM); const float* st_g = (const float*)(ws + W_ST);
    const int tok0 = b * 2048 + c * 128;
    __syncthreads();
    for (int idx = tid; idx < 1024; idx += 512) { const int j = idx >> 3, hl = idx & 7; acum_s[idx] = acum_g[(size_t)(tok0 + j) * 16 + 8 * g + hl]; dt_s[idx] = dt_g[(size_t)(tok0 + j) * 16 + 8 * g + hl]; }
    bf16x8 cf[4];
#pragma unroll
    for (int ks = 0; ks < 4; ++ks) cf[ks] = *(const bf16x8*)(xact + (size_t)(tok0 + 16 * w + l15) * 1536 + 1280 + g * 128 + ks * 32 + q * 8);
    f32x4 cbt[8];
#pragma unroll
    for (int jt = 0; jt < 8; ++jt) { cbt[jt] = (f32x4){0.f, 0.f, 0.f, 0.f};
        if (jt <= w) {
#pragma unroll
            for (int ks = 0; ks < 4; ++ks) { const bf16x8 bfr = *(const bf16x8*)(xact + (size_t)(tok0 + 16 * jt + l15) * 1536 + 1024 + g * 128 + ks * 32 + q * 8); cbt[jt] = MFMA16(bfr, cf[ks], cbt[jt]); } } }
    float ssq[4] = {0.f, 0.f, 0.f, 0.f};
    const int irow = 16 * w + l15;
    for (int hl = 0; hl < 8; ++hl) { const int h = 8 * g + hl;
        __syncthreads();
        for (int idx = tid; idx < 1024; idx += 512) { const int j = idx >> 3, pv = (idx & 7) * 8; const u32x4 v = *(const u32x4*)(xact + (size_t)(tok0 + j) * 1536 + g * 512 + hl * 64 + pv);
            const bf16_t* e16 = (const bf16_t*)&v; (void)e16;
            xT[(pv + 0) * 136 + j] = (bf16_t)(v.x & 0xFFFF); xT[(pv + 1) * 136 + j] = (bf16_t)(v.x >> 16); xT[(pv + 2) * 136 + j] = (bf16_t)(v.y & 0xFFFF); xT[(pv + 3) * 136 + j] = (bf16_t)(v.y >> 16);
            xT[(pv + 4) * 136 + j] = (bf16_t)(v.z & 0xFFFF); xT[(pv + 5) * 136 + j] = (bf16_t)(v.z >> 16); xT[(pv + 6) * 136 + j] = (bf16_t)(v.w & 0xFFFF); xT[(pv + 7) * 136 + j] = (bf16_t)(v.w >> 16); }
        __syncthreads();
        const float ai = acum_s[irow * 8 + hl];
        bf16x8 af[4];
#pragma unroll
        for (int s = 0; s < 4; ++s) { float m8[8];
#pragma unroll
            for (int hf = 0; hf < 2; ++hf) { const int jt = 2 * s + hf;
#pragma unroll
                for (int r = 0; r < 4; ++r) { const int j = 16 * jt + 4 * q + r; float val = 0.f;
                    if (jt <= w && j <= irow) val = cbt[jt][r] * __expf(ai - acum_s[j * 8 + hl]) * dt_s[j * 8 + hl];
                    m8[hf * 4 + r] = val; } }
            af[s] = as_frag(pack8(m8)); }
        const float dsk = p.ssd_d[h];
        float ea[4];
#pragma unroll
        for (int r = 0; r < 4; ++r) ea[r] = __expf(acum_s[(16 * w + 4 * q + r) * 8 + hl]);
        float zz[4][4];
#pragma unroll
        for (int pt = 0; pt < 4; ++pt)
#pragma unroll
            for (int r = 0; r < 4; ++r) zz[pt][r] = bf2f(proj[(size_t)(tok0 + 16 * w + 4 * q + r) * NPROJ + C_Z + h * 64 + 16 * pt + l15]);
#pragma unroll
        for (int pt = 0; pt < 4; ++pt) { f32x4 yd = {0.f, 0.f, 0.f, 0.f}, yo = {0.f, 0.f, 0.f, 0.f};
            const bf16_t* xr = xT + (16 * pt + l15) * 136;
#pragma unroll
            for (int s = 0; s < 4; ++s) if (2 * s <= w) { const u32x2 lo = *(const u32x2*)(xr + 32 * s + 4 * q), hi = *(const u32x2*)(xr + 32 * s + 16 + 4 * q); yd = MFMA16(af[s], frag2(lo, hi), yd); }
            const float* hp = st_g + ((size_t)((b * 16 + c) * 16 + h) * 64 + 16 * pt + l15) * 128 + q * 8;
#pragma unroll
            for (int ks = 0; ks < 4; ++ks) { const f32x4 f0 = *(const f32x4*)(hp + ks * 32), f1 = *(const f32x4*)(hp + ks * 32 + 4); float m8[8] = {f0[0], f0[1], f0[2], f0[3], f1[0], f1[1], f1[2], f1[3]};
                yo = MFMA16(cf[ks], as_frag(pack8(m8)), yo); }
            const u32x2 xv2 = *(const u32x2*)(xr + 16 * w + 4 * q); const float xv[4] = {bflo(xv2.x), bfhi(xv2.x), bflo(xv2.y), bfhi(xv2.y)};
#pragma unroll
            for (int r = 0; r < 4; ++r) { const size_t tok = (size_t)(tok0 + 16 * w + 4 * q + r); const int pp = 16 * pt + l15;
                const float y = yd[r] + ea[r] * yo[r] + dsk * xv[r]; const float val = y * siluf(zz[pt][r]);
                ssq[r] += val * val; mix[tok * DMIX + 1024 + g * 512 + hl * 64 + pp] = f2bf(val); } }
    }
    float rstd[4];
#pragma unroll
    for (int r = 0; r < 4; ++r) { float s = ssq[r]; s += __shfl_xor(s, 1); s += __shfl_xor(s, 2); s += __shfl_xor(s, 4); s += __shfl_xor(s, 8); rstd[r] = rsqrtf(s * (1.f / 512.f) + 1e-5f); }
    for (int hl = 0; hl < 8; ++hl)
#pragma unroll
        for (int pt = 0; pt < 4; ++pt) { const int cc = hl * 64 + 16 * pt + l15; const float gn = p.ssd_norm_g[g * 512 + cc];
#pragma unroll
            for (int r = 0; r < 4; ++r) { bf16_t* mp = mix + (size_t)(tok0 + 16 * w + 4 * q + r) * DMIX + 1024 + g * 512 + cc; *mp = f2bf(bf2f(*mp) * rstd[r] * gn); } }
}

DI void ln_rows(const Params& p) {
    const float* res = (const float*)(p.ws + W_RES);
    const int tid = otid(); const int lane = tid & 63; const int gw = obid() * 8 + (tid >> 6), nw = gridDim.x * 8;
    f32x4 gg[4], bb[4];
#pragma unroll
    for (int i = 0; i < 4; ++i) { gg[i] = *(const f32x4*)(p.ln_g + i * 256 + lane * 4); bb[i] = *(const f32x4*)(p.ln_b + i * 256 + lane * 4); }
    for (int row = gw; row < NTOK; row += nw) { f32x4 v[4]; float s = 0.f;
#pragma unroll
        for (int i = 0; i < 4; ++i) { v[i] = *(const f32x4*)(res + (size_t)row * 1024 + i * 256 + lane * 4); s += v[i][0] + v[i][1] + v[i][2] + v[i][3]; }
        const float mu = wave_sum(s) * (1.f / 1024.f); float s2 = 0.f;
#pragma unroll
        for (int i = 0; i < 4; ++i) { v[i] = v[i] - mu; s2 += v[i][0] * v[i][0] + v[i][1] * v[i][1] + v[i][2] * v[i][2] + v[i][3] * v[i][3]; }
        const float rstd = rsqrtf(wave_sum(s2) * (1.f / 1024.f) + 1e-5f);
#pragma unroll
        for (int i = 0; i < 4; ++i) *(f32x4*)(p.out + (size_t)row * 1024 + i * 256 + lane * 4) = v[i] * rstd * gg[i] + bb[i]; }
}

__global__ void __launch_bounds__(512, 2) hymba_fwd(Params p) {
    extern __shared__ __attribute__((aligned(16))) unsigned char shm[];
    cg::grid_group grid = cg::this_grid();
    const int G = gridDim.x, bid = blockIdx.x;
    if (threadIdx.x < 4) ((volatile LAS unsigned*)(LAS unsigned char*)shm)[32768 + threadIdx.x] = 0u;
    __syncthreads();
    XcdBarrier xb = xcd_barrier_post((unsigned*)(p.ws + W_BAR), (volatile LAS unsigned*)(LAS unsigned char*)shm + 32768);
    if (p.ph_lo < 0) grid.sync();
    for (int ph = p.ph_lo; ph < p.ph_hi; ++ph) {
        if (ph == 0) { for (int rep = 0; rep < REP0; ++rep) phase_prep(p, shm); }
        else if (ph == 1 && (PHM & 2)) { for (int rep = 0; rep < REP1; ++rep) {
            { pg8::Gemm g; g.A = (const bf16_t*)(p.ws + W_XB); g.Bt = (const bf16_t*)(p.ws + W_WINT); g.M = NTOK; g.N = NPROJ; g.K = 1024;
              pg8::StaticOrder S; S.init(g.M, g.N, G, bid); pg8::EpiBf16 E; E.O = (bf16_t*)(p.ws + W_PROJ); E.ldc = NPROJ;
              pg8::gemm_phase<pg8::EpiBf16, pg8::StaticOrder>((LAS unsigned char*)shm, g, S, E); }
            { pg8::Gemm g; g.A = (const bf16_t*)(p.ws + W_MEMB); g.Bt = (const bf16_t*)(p.ws + W_WKVT); g.M = 2048; g.N = 2048; g.K = 1024;
              const int shift = (66 * 26) % G; pg8::StaticOrder S; S.init(g.M, g.N, G, (bid + G - shift) % G);
              pg8::EpiKV E; E.mk = p.out + O_MKP; E.mv = p.out + O_MVP; E.kb = (bf16_t*)(p.ws + W_KB); E.vt = (bf16_t*)(p.ws + W_VT);
              pg8::gemm_phase<pg8::EpiKV, pg8::StaticOrder>((LAS unsigned char*)shm, g, S, E); }
        } }
        else if (ph == 2 && (PHM & 4)) { for (int rep = 0; rep < REP2; ++rep) for (int it = bid; it < 256; it += G) ssd1_item(p, shm, it >> 5, (it >> 1) & 15, it & 1); }
        else if (ph == 3 && (PHM & 8)) {
            for (int rep = 0; rep < REP3; ++rep) for (int it = bid; it < 1920; it += G) {
                if (rep > 0 && (it < R3LO || it >= R3HI)) continue;
                if (it < 256) rg_item(p, shm, false, it >> 5, (it >> 2) & 7, it & 3);
                else if (it < 512) statepass_item(p, it - 256);
                else if (it < 640) { const int u = it - 512; rg_item(p, shm, true, u >> 5, (u >> 2) & 7, u & 3); }
                else if (it < 896) { const int u = it - 640; ssds_item(p, shm, u >> 1, u & 1); }
                else if (it < 1408) { const int u = it - 896; attns_item(p, shm, u >> 2, u & 3); }
                else { const int u = it - 1408; attnp_item(p, u >> 6, (u >> 4) & 3, u & 15); }
            }
        }
        else if (ph == 4 && (PHM & 16)) { for (int rep = 0; rep < REP4; ++rep) for (int it = bid; it < 256; it += G) ssd3_item(p, shm, it >> 5, (it >> 1) & 15, it & 1); }
        else if (ph == 5 && (PHM & 32)) { for (int rep = 0; rep < REP5; ++rep) {
            pg8::Gemm g; g.A = (const bf16_t*)(p.ws + W_MIX); g.Bt = (const bf16_t*)(p.ws + W_WOUTT); g.M = NTOK; g.N = 1024; g.K = 3072;
            pg8::StaticOrder S; S.init(g.M, g.N, G, bid); pg8::EpiRes E; E.res = (float*)(p.ws + W_RES); E.xp = p.x_prompt; E.xs = p.x_sample; E.alpha = 1.189207115002721f;
            pg8::gemm_phase<pg8::EpiRes, pg8::StaticOrder>((LAS unsigned char*)shm, g, S, E);
        } }
        else if (ph == 6 && (PHM & 64)) { for (int rep = 0; rep < REP6; ++rep) ln_rows(p); }
        if (ph + 1 < p.ph_hi) { for (int rep = 0; rep < REPS; ++rep) xcd_barrier(xb); }
    }
}

extern "C" void kernel_launch(void* const* d_in, const int* in_sizes, int n_in, void* d_out, int out_size, void* d_ws, size_t ws_size, hipStream_t stream) {
    static int grid_blocks = 0;
    if (!grid_blocks) {
        int dev = 0, cus = 0, per_cu = 0;
        hipGetDevice(&dev);
        hipDeviceGetAttribute(&cus, hipDeviceAttributeMultiprocessorCount, dev);
        if (hipFuncSetAttribute((const void*)hymba_fwd, hipFuncAttributeMaxDynamicSharedMemorySize, LDS_BYTES) != hipSuccess) fprintf(stderr, "hipFuncSetAttribute failed\n");
        hipOccupancyMaxActiveBlocksPerMultiprocessor(&per_cu, (const void*)hymba_fwd, 512, LDS_BYTES);
        if (per_cu < 1) { fprintf(stderr, "occupancy query says %d blocks per CU\n", per_cu); per_cu = 1; }
        grid_blocks = cus * 1;
        if (ws_size < W_END) fprintf(stderr, "workspace too small: %zu < %zu\n", ws_size, (size_t)W_END);
    }
    if (hipMemsetAsync((char*)d_ws + W_BAR, 0, 3456 * 4, stream) != hipSuccess) fprintf(stderr, "memset failed\n");
    Params p{};
    const float** fp = (const float**)&p;
    for (int i = 0; i < 28; ++i) fp[i] = (const float*)d_in[i];
    p.out = (float*)d_out; p.ws = (unsigned char*)d_ws;
#if N_LAUNCH_PER_PHASE
    for (int ph = 0; ph < NPHASE; ++ph) { p.ph_lo = ph; p.ph_hi = ph + 1;
        hipLaunchKernelGGL(hymba_fwd, dim3(grid_blocks), dim3(512), LDS_BYTES, stream, p); }
#else
    p.ph_lo = 0; p.ph_hi = NPHASE;
    void* args[] = {&p};
    hipError_t e = hipLaunchCooperativeKernel((const void*)hymba_fwd, dim3(grid_blocks), dim3(512), args, LDS_BYTES, stream);
    if (e != hipSuccess) fprintf(stderr, "cooperative launch failed: %s (grid %d)\n", hipGetErrorString(e), grid_blocks);
#endif
}
```

```cpp
#include <hip/hip_runtime.h>
#include <hip/hip_cooperative_groups.h>
#include <cstdio>
namespace cg = cooperative_groups;

#ifndef REP2
#define REP2 1
#endif
#ifndef REP3
#define REP3 1
#endif
#ifndef REP4
#define REP4 1
#endif
#ifndef R3LO
#define R3LO 0
#define R3HI 256
#endif
#ifndef REP0
#define REP0 1
#endif
#ifndef REP1
#define REP1 1
#endif
#ifndef REP5
#define REP5 1
#endif
#ifndef REP6
#define REP6 1
#endif
#ifndef REPS
#define REPS 1
#endif
#ifndef PHM
#define PHM 127
#endif
#ifndef N_LAUNCH_PER_PHASE
#define N_LAUNCH_PER_PHASE 0
#endif

#define DI __device__ __forceinline__
#define LAS __attribute__((address_space(3)))
typedef unsigned short bf16_t;
typedef short bf16x8 __attribute__((ext_vector_type(8)));
typedef float f32x4 __attribute__((ext_vector_type(4)));
typedef unsigned u32x4 __attribute__((ext_vector_type(4)));
typedef unsigned u32x2 __attribute__((ext_vector_type(2)));

constexpr int NTOKP = 16384, NTOKS = 512, NTOK = 16896, DM = 1024, NPROJ = 6656, DMIX = 3072, DIN = 6672;
constexpr int C_RGX = 0, C_RGG = 1024, C_XBC = 2048, C_Z = 3584, C_Q = 4608, C_XG = 5632;
constexpr int NPHASE = 7;
constexpr int LDS_BYTES = 131072 + 64;

constexpr size_t O_YP = 0, O_YS = O_YP + (size_t)NTOKP * DM, O_RGCP = O_YS + (size_t)NTOKS * DM, O_RGHP = O_RGCP + 8 * 3 * 1024, O_SCP = O_RGHP + 8 * 1024,
                 O_SHP = O_SCP + 8 * 3 * 1536, O_MKP = O_SHP + (size_t)8 * 16 * 64 * 128, O_MVP = O_MKP + (size_t)2048 * 1024, O_RGCS = O_MVP + (size_t)2048 * 1024,
                 O_RGHS = O_RGCS + (size_t)128 * 3 * 1024, O_SCS = O_RGHS + 128 * 1024, O_SHS = O_SCS + (size_t)128 * 3 * 1536;

constexpr size_t al256(size_t x) { return (x + 255) & ~(size_t)255; }
constexpr size_t W_XB = 0;
constexpr size_t W_WINT = al256(W_XB + (size_t)NTOK * DM * 2);
constexpr size_t W_WDTT = al256(W_WINT + (size_t)NPROJ * DM * 2);
constexpr size_t W_WDTF = al256(W_WDTT + 16 * 1024 * 2);
constexpr size_t W_WOUTT = al256(W_WDTF + 16 * 1024 * 4);
constexpr size_t W_WKVT = al256(W_WOUTT + (size_t)1024 * 3072 * 2);
constexpr size_t W_MEMB = al256(W_WKVT + (size_t)2048 * 1024 * 2);
constexpr size_t W_WGT = al256(W_MEMB + (size_t)2048 * 1024 * 2);
constexpr size_t W_KB = al256(W_WGT + (size_t)8 * 4 * 64 * 128 * 2);
constexpr size_t W_VT = al256(W_KB + (size_t)2048 * 1024 * 2);
constexpr size_t W_XACT = al256(W_VT + (size_t)2048 * 1024 * 2);
constexpr size_t W_DT = al256(W_XACT + (size_t)NTOKP * 1536 * 2);
constexpr size_t W_ACUM = al256(W_DT + (size_t)NTOKP * 16 * 4);
constexpr size_t W_CD = al256(W_ACUM + (size_t)NTOKP * 16 * 4);
constexpr size_t W_ST = al256(W_CD + 8 * 16 * 16 * 4);
constexpr size_t W_MIX = al256(W_ST + (size_t)8 * 16 * 16 * 8192 * 4);
constexpr size_t W_PROJ = al256(W_MIX + (size_t)NTOK * DMIX * 2);
constexpr size_t W_RES = W_PROJ;
constexpr size_t W_BAR = al256(W_PROJ + (size_t)NTOK * NPROJ * 2);
constexpr size_t W_END = al256(W_BAR + 3456 * 4);

struct Params {
    const float *x_prompt, *x_sample, *mem_prompt, *state_rg_conv, *state_rg_h, *state_ssd_conv, *state_ssd_h, *cache_k, *cache_v;
    const float *w_in, *rg_conv_w, *rg_conv_b, *w_rg_a, *b_rg_a, *w_rg_i, *b_rg_i, *rg_lambda, *ssd_conv_w, *ssd_conv_b, *ssd_dt_bias, *ssd_a_log, *ssd_d, *ssd_norm_g,
        *w_mem_k, *w_mem_v, *w_out, *ln_g, *ln_b;
    float* out; unsigned char* ws;
    int ph_lo, ph_hi;
};
typedef const __attribute__((address_space(4))) Params* KP;
DI KP kparams() { KP k = (KP)__builtin_amdgcn_kernarg_segment_ptr(); asm volatile("" : "+s"(k)); return k; }

DI int otid() { int t = threadIdx.x; asm volatile("" : "+v"(t)); return t; }
DI int obid() { int t = blockIdx.x; asm volatile("" : "+s"(t)); return t; }
DI float bf2f(bf16_t b) { return __uint_as_float(((unsigned)b) << 16); }
DI bf16_t f2bf(float f) { unsigned u = __float_as_uint(f); u += 0x7FFFu + ((u >> 16) & 1u); return (bf16_t)(u >> 16); }
DI unsigned pack2(float lo, float hi) { return (unsigned)f2bf(lo) | ((unsigned)f2bf(hi) << 16); }
DI float bflo(unsigned w) { return __uint_as_float(w << 16); }
DI float bfhi(unsigned w) { return __uint_as_float(w & 0xFFFF0000u); }
DI void unpack8(const u32x4 v, float (&o)[8]) { o[0] = bflo(v.x); o[1] = bfhi(v.x); o[2] = bflo(v.y); o[3] = bfhi(v.y); o[4] = bflo(v.z); o[5] = bfhi(v.z); o[6] = bflo(v.w); o[7] = bfhi(v.w); }
DI u32x4 pack8(const float (&o)[8]) { u32x4 w; w.x = pack2(o[0], o[1]); w.y = pack2(o[2], o[3]); w.z = pack2(o[4], o[5]); w.w = pack2(o[6], o[7]); return w; }
DI bf16x8 as_frag(u32x4 w) { return __builtin_bit_cast(bf16x8, w); }
DI bf16x8 frag2(u32x2 lo, u32x2 hi) { u32x4 w; w.x = lo.x; w.y = lo.y; w.z = hi.x; w.w = hi.y; return __builtin_bit_cast(bf16x8, w); }
DI float shx(float v, int m, int lane) { return __int_as_float(__builtin_amdgcn_ds_bpermute((lane ^ m) << 2, __float_as_int(v))); }
DI float shl(float v, int src) { return __int_as_float(__builtin_amdgcn_ds_bpermute(src << 2, __float_as_int(v))); }
DI float siluf(float x) { return x / (1.f + __expf(-x)); }
DI float sigmf(float x) { return 1.f / (1.f + __expf(-x)); }
DI float softplusf(float v) { return v > 20.f ? v : __logf(1.f + __expf(v)); }
#define MFMA16(a, b, c) __builtin_amdgcn_mfma_f32_16x16x32_bf16((a), (b), (c), 0, 0, 0)

#define XB_TMO      128
#define XB_XCNT(j)  (256  + 64 * (j))
#define XB_XSUB(j)  (1280 + 64 * (j))
#define XB_XGEN(j)  (2304 + 64 * (j))
#define XB_TOP      3328
#define XB_TOPGEN   3392
#define XCD_BAR_WORDS 3456
#define XB_SPIN_CAP (1u << 20)
DI unsigned xb_ld(unsigned* ptr)              { return __hip_atomic_load(ptr, __ATOMIC_RELAXED, __HIP_MEMORY_SCOPE_AGENT); }
DI unsigned xb_add(unsigned* ptr, unsigned v) { return __hip_atomic_fetch_add(ptr, v, __ATOMIC_RELAXED, __HIP_MEMORY_SCOPE_AGENT); }
DI unsigned xb_xcc_id() { return (unsigned)__builtin_amdgcn_s_getreg((3 << 11) | 20) & 0xFu; }
#define XB_SPIN(cond, bar) do { unsigned _sp = 0; while (cond) { __builtin_amdgcn_s_sleep(1); \
    if ((++_sp & 255u) == 0u) { if (xb_ld(&(bar)[XB_TMO])) break; if (_sp > XB_SPIN_CAP) { atomicAdd(&(bar)[XB_TMO], 1u); break; } } } } while (0)
struct XcdBarrier { unsigned* bar; unsigned x; volatile LAS unsigned* st; };
DI XcdBarrier xcd_barrier_post(unsigned* bar, volatile LAS unsigned* st) {
    XcdBarrier b; b.bar = bar; b.x = xb_xcc_id(); b.st = st;
    if (threadIdx.x == 0) (void)xb_add(&bar[XB_XCNT(b.x)], 1u);
    return b;
}
DI void xcd_barrier_complete(unsigned* bar, unsigned x, unsigned& nloc, unsigned& nx) {
    const unsigned G = gridDim.x * gridDim.y * gridDim.z;
    unsigned sum, cnt, mine, sp = 0u;
    for (;;) {
        sum = 0u; cnt = 0u; mine = 0u;
#pragma unroll
        for (unsigned j = 0; j < 16; ++j) { const unsigned c = xb_ld(&bar[XB_XCNT(j)]); sum += c; cnt += (c > 0u) ? 1u : 0u; mine = (j == x) ? c : mine; }
        if (sum == G) break;
        __builtin_amdgcn_s_sleep(1);
        if ((++sp & 255u) == 0u) { if (xb_ld(&bar[XB_TMO])) break; if (sp > XB_SPIN_CAP) { atomicAdd(&bar[XB_TMO], 1u); break; } }
    }
    nloc = mine > 0u ? mine : 1u; nx = cnt > 0u ? cnt : 1u;
}
DI void xcd_barrier(const XcdBarrier& b) {
    asm volatile("s_waitcnt vmcnt(0)" ::: "memory");
    __syncthreads();
    if (threadIdx.x == 0) {
        unsigned* bar = b.bar;
        __builtin_amdgcn_s_waitcnt(0);
        unsigned nloc = b.st[0], nx = b.st[1];
        if (nloc == 0u) { xcd_barrier_complete(bar, b.x, nloc, nx); b.st[0] = nloc; b.st[1] = nx; }
        const unsigned old = xb_add(&bar[XB_XSUB(b.x)], 1u);
        const unsigned gen = old / nloc;
        if (old + 1u == (gen + 1u) * nloc) {
            __builtin_amdgcn_fence(__ATOMIC_RELEASE, "agent");
            asm volatile("s_waitcnt vmcnt(0)" ::: "memory");
            const unsigned og = xb_add(&bar[XB_TOP], 1u);
            const unsigned tg = og / nx;
            if (og + 1u == (tg + 1u) * nx) xb_add(&bar[XB_TOPGEN], 1u);
            else XB_SPIN(xb_ld(&bar[XB_TOPGEN]) == tg, bar);
            __builtin_amdgcn_fence(__ATOMIC_ACQUIRE, "agent");
            xb_add(&bar[XB_XGEN(b.x)], 1u);
            asm volatile("s_waitcnt vmcnt(0)" ::: "memory");
        } else {
            XB_SPIN(xb_ld(&bar[XB_XGEN(b.x)]) == gen, bar);
            __builtin_amdgcn_fence(__ATOMIC_ACQUIRE, "agent");
            asm volatile("s_waitcnt vmcnt(0)" ::: "memory");
        }
    }
    __syncthreads();
}

namespace pg8 {
constexpr int BM = 256, BK = 64, HALF = 128, HTB = HALF * BK * 2, STAGE_BYTES = 8 * HTB, NXCD = 8, WGM = 8;
DI int lds_byte(int r, int c) { const int st = (r >> 4) * 2 + (c >> 5), rr = r & 15, cc = c & 31, ob = rr * 64 + cc * 2; return st * 1024 + (ob ^ (((ob >> 9) & 1) << 5)); }
DI void stage_rc(int b, int& R, int& C) { const int st = b / 1024, sb = b % 1024, swz = sb ^ (((sb >> 9) & 1) << 5); R = (st >> 1) * 16 + swz / 64; C = (st & 1) * 32 + (swz % 64) / 2; }
DI int perm32(int rho) { const int n = rho >> 4, i = rho & 15; return 8 * (i >> 2) + 4 * n + (i & 3); }
struct Unit { int pm, pn; };
struct Gemm { const bf16_t* A; const bf16_t* Bt; int M, N, K; };
struct StaticOrder {
    int nM, nN, nwg, G, c;
    DI void init(int M, int N, int G_, int c_) { nM = M / BM; nN = N / BM; nwg = nM * nN; G = G_; c = c_; }
    DI bool next(int i, Unit& u) const {
        const long L = (long)i * G + c; if (L >= nwg) return false;
        int wgid = (int)L; { const int q = nwg / NXCD, r = nwg % NXCD, xcd = wgid % NXCD, off = wgid / NXCD; wgid = (xcd < r ? xcd * (q + 1) : r * (q + 1) + (xcd - r) * q) + off; }
        const int nig = WGM * nN, gid = wgid / nig, fm = gid * WGM, gsz = (nM - fm) < WGM ? (nM - fm) : WGM;
        u.pm = fm + ((wgid % nig) % gsz); u.pn = (wgid % nig) / gsz; return true;
    }
};
DI unsigned cvt_pk_bf16(float lo, float hi) { unsigned r; asm volatile("v_cvt_pk_bf16_f32 %0, %1, %2" : "=v"(r) : "v"(lo), "v"(hi)); return r; }

struct EpiBf16 {
    static constexpr bool PERM = true;
    bf16_t* O; int ldc;
    DI void operator()(const f32x4 (&acc)[2][2][4][2], const Unit& u, int wr, int wc, int fr, int fq) const {
        const int row0 = u.pm * BM + wr * 64 + fr; const int col0 = u.pn * BM + wc * 32 + 8 * fq;
#pragma unroll
        for (int ai = 0; ai < 2; ++ai)
#pragma unroll
            for (int m = 0; m < 4; ++m) { bf16_t* rowp = O + (size_t)(row0 + ai * HALF + m * 16) * ldc + col0;
#pragma unroll
                for (int bj = 0; bj < 2; ++bj) { const f32x4 v0 = acc[ai][bj][m][0], v1 = acc[ai][bj][m][1];
                    u32x4 w; w.x = cvt_pk_bf16(v0[0], v0[1]); w.y = cvt_pk_bf16(v0[2], v0[3]); w.z = cvt_pk_bf16(v1[0], v1[1]); w.w = cvt_pk_bf16(v1[2], v1[3]);
                    *(u32x4*)(rowp + bj * HALF) = w; } }
    }
};
struct EpiKV {
    static constexpr bool PERM = false;
    float* mk; float* mv; bf16_t* kb; bf16_t* vt;
    DI void operator()(const f32x4 (&acc)[2][2][4][2], const Unit& u, int wr, int wc, int fr, int fq) const {
        const int row0 = u.pm * BM + wr * 64 + fr, col0 = u.pn * BM + wc * 32 + 4 * fq;
#pragma unroll
        for (int ai = 0; ai < 2; ++ai)
#pragma unroll
            for (int m = 0; m < 4; ++m) { const int row = row0 + ai * HALF + m * 16;
#pragma unroll
                for (int bj = 0; bj < 2; ++bj)
#pragma unroll
                    for (int n = 0; n < 2; ++n) { const int col = col0 + bj * HALF + n * 16; const f32x4 v = acc[ai][bj][m][n];
                        if (col < 1024) { *(f32x4*)(mk + (size_t)row * 1024 + col) = v; u32x2 w; w.x = cvt_pk_bf16(v[0], v[1]); w.y = cvt_pk_bf16(v[2], v[3]); *(u32x2*)(kb + (size_t)row * 1024 + col) = w; }
                        else { const int cc = col - 1024; *(f32x4*)(mv + (size_t)row * 1024 + cc) = v; const int bb = row >> 8, mt = row & 255;
#pragma unroll
                            for (int j = 0; j < 4; ++j) { const int c2 = cc + j, head = c2 >> 8, d = c2 & 255; vt[((size_t)((bb * 4 + head) * 256 + d)) * 256 + mt] = f2bf(v[j]); } } } }
    }
};
struct EpiRes {
    static constexpr bool PERM = false;
    float* res; const float* xp; const float* xs; float alpha;
    DI void operator()(const f32x4 (&acc)[2][2][4][2], const Unit& u, int wr, int wc, int fr, int fq) const {
        const int row0 = u.pm * BM + wr * 64 + fr, col0 = u.pn * BM + wc * 32 + 4 * fq;
#pragma unroll
        for (int ai = 0; ai < 2; ++ai)
#pragma unroll
            for (int m = 0; m < 4; ++m) { const int row = row0 + ai * HALF + m * 16; const float* xr = row < NTOKP ? xp + (size_t)row * 1024 : xs + (size_t)(row - NTOKP) * 1024;
#pragma unroll
                for (int bj = 0; bj < 2; ++bj)
#pragma unroll
                    for (int n = 0; n < 2; ++n) { const int col = col0 + bj * HALF + n * 16; const f32x4 xv = *(const f32x4*)(xr + col);
                        *(f32x4*)(res + (size_t)row * 1024 + col) = acc[ai][bj][m][n] + xv * alpha; } }
    }
};

template <class Epi, class Sched>
DI void gemm_phase(LAS unsigned char* lds, const Gemm g, const Sched& S, const Epi& E) {
    const int tid = otid(), wid = __builtin_amdgcn_readfirstlane(tid >> 6), lane = tid & 63, wr = wid >> 2, wc = wid & 3, fr = lane & 15, fq = lane >> 4;
    const int K = g.K, nt = K / BK;
    unsigned voffA[2], voffB[2];
#pragma unroll
    for (int i = 0; i < 2; ++i) { int R, C; stage_rc(tid * 16 + i * 8192, R, C); const int Rb = Epi::PERM ? ((R & ~31) + perm32(R & 31)) : R;
        voffA[i] = (unsigned)(R * K + C) * 2u; voffB[i] = (unsigned)(Rb * K + C) * 2u; }
    const size_t kstep = (size_t)(BK * 2);
    const size_t hstep = (size_t)HALF * K * 2;
    const size_t tstep = 2 * hstep;
    const unsigned ldsw = (unsigned)wid * 1024u;
    const int aoff = lds_byte(wr * 64 + fr, fq * 8), boff = lds_byte(wc * 32 + fr, fq * 8);
#define PG8_SA(b, h) (((b) * 2 + (h)) * HTB)
#define PG8_SB(b, h) ((4 + (b) * 2 + (h)) * HTB)
#define PG8_STAGE(bufoff, gbase, voff) do { _Pragma("unroll") for (int _i = 0; _i < 2; ++_i) \
        __builtin_amdgcn_global_load_lds((const unsigned*)((const char*)(gbase) + (voff)[_i]), (LAS unsigned*)(lds + (bufoff) + ldsw + _i * 8192), 16, 0, 0); } while (0)
#define PG8_LDA(dst, b, h) do { _Pragma("unroll") for (int m = 0; m < 4; ++m) _Pragma("unroll") for (int k = 0; k < 2; ++k) dst[m][k] = *(const LAS bf16x8*)(lds + PG8_SA(b, h) + aoff + m * 2048 + k * 1024); } while (0)
#define PG8_LDB(dst, b, h) do { _Pragma("unroll") for (int n = 0; n < 2; ++n) _Pragma("unroll") for (int k = 0; k < 2; ++k) dst[n][k] = *(const LAS bf16x8*)(lds + PG8_SB(b, h) + boff + n * 2048 + k * 1024); } while (0)
#define PG8_MMA(ai, bj, At, Bt) do { __builtin_amdgcn_s_setprio(1); _Pragma("unroll") for (int m = 0; m < 4; ++m) _Pragma("unroll") for (int n = 0; n < 2; ++n) _Pragma("unroll") for (int k = 0; k < 2; ++k) \
        acc[ai][bj][m][n] = __builtin_amdgcn_mfma_f32_16x16x32_bf16(Bt[n][k], At[m][k], acc[ai][bj][m][n], 0, 0, 0); __builtin_amdgcn_s_setprio(0); } while (0)
#define PG8_WAIT_V(n) asm volatile("s_waitcnt vmcnt(" #n ")" ::: "memory")
#define PG8_WAIT_L(n) asm volatile("s_waitcnt lgkmcnt(" #n ")" ::: "memory")
#define PG8_BAR __builtin_amdgcn_s_barrier()
#define PG8_SCHED __builtin_amdgcn_sched_barrier(0)
    Unit cur, nxt; int ui = 0;
    if (!S.next(0, cur)) return;
    f32x4 acc[2][2][4][2];
#pragma unroll
    for (int a = 0; a < 2; ++a)
#pragma unroll
        for (int b = 0; b < 2; ++b)
#pragma unroll
            for (int m = 0; m < 4; ++m)
#pragma unroll
                for (int n = 0; n < 2; ++n) acc[a][b][m][n] = (f32x4){0.f, 0.f, 0.f, 0.f};
    bf16x8 At[4][2], B0[2][2], B1[2][2];
    const char* cA = (const char*)g.A + (size_t)cur.pm * tstep; const char* cB = (const char*)g.Bt + (size_t)cur.pn * tstep;
    PG8_STAGE(PG8_SB(0, 0), cB, voffB); PG8_STAGE(PG8_SA(0, 0), cA, voffA); PG8_STAGE(PG8_SB(0, 1), cB + hstep, voffB); PG8_STAGE(PG8_SA(0, 1), cA + hstep, voffA);
    if (wr == 1) PG8_BAR;
    PG8_WAIT_V(4); PG8_BAR;
    PG8_STAGE(PG8_SB(1, 0), cB + kstep, voffB); PG8_STAGE(PG8_SA(1, 0), cA + kstep, voffA); PG8_STAGE(PG8_SB(1, 1), cB + hstep + kstep, voffB);
    PG8_WAIT_V(6); PG8_BAR;
    for (;;) {
        const bool has_next = S.next(ui + 1, nxt);
        const char* nA = has_next ? (const char*)g.A + (size_t)nxt.pm * tstep : cA; const char* nB = has_next ? (const char*)g.Bt + (size_t)nxt.pn * tstep : cB;
        for (int t = 0; t < nt; t += 2) {
            const bool last = (t == nt - 2);
            const char* a1 = cA + (size_t)(t + 1) * kstep;
            const char* a2 = last ? nA : cA + (size_t)(t + 2) * kstep; const char* b2 = last ? nB : cB + (size_t)(t + 2) * kstep;
            const char* a3 = a2 + kstep; const char* b3 = b2 + kstep;
            PG8_LDB(B0, 0, 0); PG8_SCHED; PG8_LDA(At, 0, 0); PG8_STAGE(PG8_SA(1, 1), a1 + hstep, voffA);
            PG8_WAIT_L(8); PG8_BAR; PG8_WAIT_L(0); PG8_MMA(0, 0, At, B0); PG8_BAR; PG8_SCHED;
            PG8_LDB(B1, 0, 1); PG8_STAGE(PG8_SB(0, 0), b2, voffB);
            PG8_BAR; PG8_WAIT_L(0); PG8_MMA(0, 1, At, B1); PG8_BAR;
            PG8_LDA(At, 0, 1); PG8_STAGE(PG8_SA(0, 0), a2, voffA);
            PG8_BAR; PG8_WAIT_L(0); PG8_MMA(1, 0, At, B0); PG8_BAR; PG8_SCHED;
            PG8_STAGE(PG8_SB(0, 1), b2 + hstep, voffB);
            PG8_WAIT_V(6); PG8_BAR; PG8_MMA(1, 1, At, B1); PG8_BAR;
            PG8_LDB(B0, 1, 0); PG8_SCHED; PG8_LDA(At, 1, 0); PG8_STAGE(PG8_SA(0, 1), a2 + hstep, voffA);
            PG8_WAIT_L(8); PG8_BAR; PG8_WAIT_L(0); PG8_MMA(0, 0, At, B0); PG8_BAR; PG8_SCHED;
            PG8_LDB(B1, 1, 1); PG8_STAGE(PG8_SB(1, 0), b3, voffB);
            PG8_BAR; PG8_WAIT_L(0); PG8_MMA(0, 1, At, B1); PG8_BAR;
            PG8_LDA(At, 1, 1); PG8_STAGE(PG8_SA(1, 0), a3, voffA);
            PG8_BAR; PG8_WAIT_L(0); PG8_MMA(1, 0, At, B0); PG8_BAR; PG8_SCHED;
            PG8_STAGE(PG8_SB(1, 1), b3 + hstep, voffB);
            PG8_WAIT_V(6); PG8_BAR; PG8_MMA(1, 1, At, B1); PG8_BAR;
        }
        E(acc, cur, wr, wc, fr, fq);
        if (!has_next) break;
#pragma unroll
        for (int a = 0; a < 2; ++a)
#pragma unroll
            for (int b = 0; b < 2; ++b)
#pragma unroll
                for (int m = 0; m < 4; ++m)
#pragma unroll
                    for (int n = 0; n < 2; ++n) acc[a][b][m][n] = (f32x4){0.f, 0.f, 0.f, 0.f};
        cur = nxt; cA = nA; cB = nB; ++ui;
    }
    PG8_WAIT_V(0);
    if (wr == 0) PG8_BAR;
    PG8_BAR;
#undef PG8_SA
#undef PG8_SB
#undef PG8_STAGE
#undef PG8_LDA
#undef PG8_LDB
#undef PG8_MMA
#undef PG8_WAIT_V
#undef PG8_WAIT_L
#undef PG8_BAR
#undef PG8_SCHED
}
}

DI void tr_tile(const float* src, int ld_src, int k0, int c0, bf16_t* dst, int ld_dst, int n0, float* lds) {
    const int tid = otid();
#pragma unroll
    for (int pass = 0; pass < 2; ++pass) { const int r = pass * 32 + (tid >> 4), c4 = (tid & 15) * 4;
        const f32x4 v = *(const f32x4*)(src + (size_t)(k0 + r) * ld_src + c0 + c4);
        lds[r * 65 + c4 + 0] = v[0]; lds[r * 65 + c4 + 1] = v[1]; lds[r * 65 + c4 + 2] = v[2]; lds[r * 65 + c4 + 3] = v[3]; }
    __syncthreads();
    const int nn = tid >> 3, kc = (tid & 7) * 8;
    float o[8];
#pragma unroll
    for (int e = 0; e < 8; ++e) o[e] = lds[(kc + e) * 65 + nn];
    *(u32x4*)(dst + (size_t)(n0 + nn) * ld_dst + k0 + kc) = pack8(o);
    __syncthreads();
}

DI void phase_prep(KP pk_in, unsigned char* lds) {
    KP pk = pk_in; asm volatile("" : "+s"(pk));
    unsigned char* ws = pk->ws;
    const int bidx_ = obid(); const size_t gtid = (size_t)bidx_ * 512 + otid(), nthr = (size_t)gridDim.x * 512;
    { bf16_t* xb = (bf16_t*)(ws + W_XB);
      for (size_t v = gtid; v < (size_t)NTOK * 128; v += nthr) { const float* s = v < (size_t)NTOKP * 128 ? pk->x_prompt + v * 8 : pk->x_sample + (v - (size_t)NTOKP * 128) * 8;
          const f32x4 a = *(const f32x4*)s, b = *(const f32x4*)(s + 4); float o[8] = {a[0], a[1], a[2], a[3], b[0], b[1], b[2], b[3]}; *(u32x4*)(xb + v * 8) = pack8(o); } }
    { bf16_t* mb = (bf16_t*)(ws + W_MEMB);
      for (size_t v = gtid; v < (size_t)2048 * 128; v += nthr) { const float* s = pk->mem_prompt + v * 8;
          const f32x4 a = *(const f32x4*)s, b = *(const f32x4*)(s + 4); float o[8] = {a[0], a[1], a[2], a[3], b[0], b[1], b[2], b[3]}; *(u32x4*)(mb + v * 8) = pack8(o); } }
    { bf16_t* wd = (bf16_t*)(ws + W_WDTT); float* wf = (float*)(ws + W_WDTF);
      for (size_t i = gtid; i < 16 * 1024; i += nthr) { const int h = (int)(i >> 10), k = (int)(i & 1023); const float v = pk->w_in[(size_t)k * DIN + 4608 + h]; wd[i] = f2bf(v); wf[i] = v; } }
    { bf16_t* wg = (bf16_t*)(ws + W_WGT);
      for (size_t i = gtid; i < (size_t)8 * 4 * 64 * 128; i += nthr) { const int k = (int)(i >> 15), qd = (int)(i >> 13) & 3, nn = (int)(i >> 7) & 63, ii = (int)(i & 127);
          const float v = nn < 32 ? pk->w_rg_a[((size_t)k * 128 + ii) * 128 + qd * 32 + nn] : pk->w_rg_i[((size_t)k * 128 + ii) * 128 + qd * 32 + nn - 32]; wg[i] = f2bf(v); } }
    float* tl = (float*)lds;
    for (int t = bidx_; t < 1664 + 768 + 512; t += gridDim.x) {
        if (t < 1664) { const int kt = t & 15, ntile = t >> 4; const int n0 = ntile * 64, c0 = n0 < 4608 ? n0 : n0 + 16;
            tr_tile(pk->w_in, DIN, kt * 64, c0, (bf16_t*)(ws + W_WINT), 1024, n0, tl); }
        else if (t < 1664 + 768) { const int u = t - 1664; const int kt = u % 48, ntile = u / 48;
            tr_tile(pk->w_out, 1024, kt * 64, ntile * 64, (bf16_t*)(ws + W_WOUTT), 3072, ntile * 64, tl); }
        else { const int u = t - 1664 - 768; const int kt = u & 15, ntile = u >> 4; const int n0 = ntile * 64;
            if (n0 < 1024) tr_tile(pk->w_mem_k, 1024, kt * 64, n0, (bf16_t*)(ws + W_WKVT), 1024, n0, tl);
            else tr_tile(pk->w_mem_v, 1024, kt * 64, n0 - 1024, (bf16_t*)(ws + W_WKVT), 1024, n0, tl); }
    }
}

DI void conv8_ssd_prompt(KP pk, const bf16_t* proj, int rowbase, int t, int ch, float (&o)[8]) {
    const f32x4 b0 = *(const f32x4*)(pk->ssd_conv_b + ch), b1 = *(const f32x4*)(pk->ssd_conv_b + ch + 4);
    float acc[8] = {b0[0], b0[1], b0[2], b0[3], b1[0], b1[1], b1[2], b1[3]};
    u32x4 vv[4];
#pragma unroll
    for (int kk = 0; kk < 4; ++kk) { const int tt = t - 3 + kk; vv[kk] = *(const u32x4*)(proj + (size_t)(rowbase + (tt < 0 ? 0 : tt)) * NPROJ + C_XBC + ch); }
#pragma unroll
    for (int kk = 0; kk < 4; ++kk) { const int tt = t - 3 + kk; const float msk = tt >= 0 ? 1.f : 0.f; float x[8]; unpack8(vv[kk], x);
            const f32x4 w0 = *(const f32x4*)(pk->ssd_conv_w + kk * 1536 + ch) * msk, w1 = *(const f32x4*)(pk->ssd_conv_w + kk * 1536 + ch + 4) * msk;
            acc[0] += x[0] * w0[0]; acc[1] += x[1] * w0[1]; acc[2] += x[2] * w0[2]; acc[3] += x[3] * w0[3];
            acc[4] += x[4] * w1[0]; acc[5] += x[5] * w1[1]; acc[6] += x[6] * w1[2]; acc[7] += x[7] * w1[3]; }
#pragma unroll
    for (int e = 0; e < 8; ++e) o[e] = siluf(acc[e]);
}

DI void ssd1_item(KP pk_in, unsigned char* lds, int b, int c, int g) {
    KP pk = pk_in; asm volatile("" : "+s"(pk));
    unsigned char* ws = pk->ws;
    const int tid = otid(), w = tid >> 6, lane = tid & 63, l15 = lane & 15, q = lane >> 4;
    float* dt_s = (float*)lds; float* acum_s = dt_s + 2048; float* w_s = acum_s + 2048;
    bf16_t* BT = (bf16_t*)(lds + 20480); bf16_t* xsT = (bf16_t*)(lds + 20480 + 34816);
    const bf16_t* xb = (const bf16_t*)(ws + W_XB); const bf16_t* wdt = (const bf16_t*)(ws + W_WDTT); const bf16_t* proj = (const bf16_t*)(ws + W_PROJ);
    bf16_t* xact = (bf16_t*)(ws + W_XACT); float* dt_g = (float*)(ws + W_DT); float* acum_g = (float*)(ws + W_ACUM); float* cd_g = (float*)(ws + W_CD); float* st_g = (float*)(ws + W_ST);
    const int tok0 = b * 2048 + c * 128;
    __syncthreads();
    { f32x4 acc = {0.f, 0.f, 0.f, 0.f}; const bf16_t* ap = xb + (size_t)(tok0 + 16 * w + l15) * 1024 + q * 8; const bf16_t* bp = wdt + l15 * 1024 + q * 8;
#pragma unroll 8
      for (int ks = 0; ks < 32; ++ks) { const bf16x8 a = *(const bf16x8*)(ap + ks * 32); const bf16x8 bb = *(const bf16x8*)(bp + ks * 32); acc = MFMA16(a, bb, acc); }
      const float bias = pk->ssd_dt_bias[l15];
#pragma unroll
      for (int r = 0; r < 4; ++r) { const int i = 16 * w + 4 * q + r; const float dt = softplusf(acc[r] + bias); dt_s[i * 16 + l15] = dt; dt_g[(size_t)(tok0 + i) * 16 + l15] = dt; } }
    __syncthreads();
    if (tid < 16) { const float ah = -__expf(pk->ssd_a_log[tid]); float run = 0.f;
        for (int i = 0; i < 128; ++i) { run += dt_s[i * 16 + tid] * ah; acum_s[i * 16 + tid] = run; acum_g[(size_t)(tok0 + i) * 16 + tid] = run; } }
    __syncthreads();
    if (tid < 8) cd_g[(b * 16 + c) * 16 + 8 * g + tid] = __expf(acum_s[127 * 16 + 8 * g + tid]);
    for (int idx = tid; idx < 1024; idx += 512) { const int j = idx >> 3, hl = idx & 7, h = 8 * g + hl; w_s[idx] = dt_s[j * 16 + h] * __expf(acum_s[127 * 16 + h] - acum_s[j * 16 + h]); }
    for (int idx = tid; idx < 4096; idx += 512) { const int which = idx >> 11, rem = idx & 2047, j = rem >> 4, cv = (rem & 15) * 8; const int ch = 1024 + which * 256 + g * 128 + cv;
        float o[8]; conv8_ssd_prompt(pk, proj, b * 2048, c * 128 + j, ch, o); const u32x4 pk = pack8(o);
        *(u32x4*)(xact + (size_t)(tok0 + j) * 1536 + ch) = pk;
        if (which == 0) { const bf16_t* e16 = (const bf16_t*)&pk;
#pragma unroll
            for (int e = 0; e < 8; ++e) BT[(cv + e) * 136 + j] = f2bf(o[e]); (void)e16; } }
    for (int hl = 0; hl < 8; ++hl) {
        __syncthreads();
        for (int idx = tid; idx < 1024; idx += 512) { const int j = idx >> 3, pv = (idx & 7) * 8; const int ch = g * 512 + hl * 64 + pv;
            float o[8]; conv8_ssd_prompt(pk, proj, b * 2048, c * 128 + j, ch, o);
            *(u32x4*)(xact + (size_t)(tok0 + j) * 1536 + ch) = pack8(o);
            const float wj = w_s[j * 8 + hl];
#pragma unroll
            for (int e = 0; e < 8; ++e) xsT[(pv + e) * 136 + j] = f2bf(o[e] * wj); }
        __syncthreads();
        const int pt = w & 3, nh = w >> 2;
        f32x4 acc[4];
#pragma unroll
        for (int nt = 0; nt < 4; ++nt) acc[nt] = (f32x4){0.f, 0.f, 0.f, 0.f};
#pragma unroll
        for (int ks = 0; ks < 4; ++ks) { const bf16x8 a = *(const bf16x8*)(xsT + (pt * 16 + l15) * 136 + ks * 32 + q * 8);
#pragma unroll
            for (int nt = 0; nt < 4; ++nt) { const bf16x8 bb = *(const bf16x8*)(BT + (nh * 64 + nt * 16 + l15) * 136 + ks * 32 + q * 8); acc[nt] = MFMA16(a, bb, acc[nt]); } }
        float* sp = st_g + (size_t)(((b * 16 + c) * 16 + 8 * g + hl)) * 8192;
#pragma unroll
        for (int nt = 0; nt < 4; ++nt)
#pragma unroll
            for (int r = 0; r < 4; ++r) sp[(pt * 16 + 4 * q + r) * 128 + nh * 64 + nt * 16 + l15] = acc[nt][r];
    }
    if (c == 15) {
        for (int idx = tid; idx < 3 * 768; idx += 512) { const int jj = idx / 768, cc = idx % 768; const int ch = cc < 512 ? g * 512 + cc : (cc < 640 ? 1024 + g * 128 + (cc - 512) : 1280 + g * 128 + (cc - 640));
            pk->out[O_SCP + (size_t)(b * 3 + jj) * 1536 + ch] = bf2f(proj[(size_t)(b * 2048 + 2045 + jj) * NPROJ + C_XBC + ch]); }
    }
}

DI void statepass_item(KP pk_in, int sp) {
    KP pk = pk_in; asm volatile("" : "+s"(pk));
    const int b = sp >> 5, h = (sp >> 1) & 15, half = sp & 1; const int e0 = half * 4096 + otid() * 8;
    float* st_g = (float*)(pk->ws + W_ST); const float* cd_g = (const float*)(pk->ws + W_CD);
    f32x4 r0 = {0.f, 0.f, 0.f, 0.f}, r1 = {0.f, 0.f, 0.f, 0.f};
    for (int c = 0; c < 16; ++c) { float* ptr = st_g + (size_t)((b * 16 + c) * 16 + h) * 8192 + e0; const float cd = cd_g[(b * 16 + c) * 16 + h];
        const f32x4 v0 = *(const f32x4*)ptr, v1 = *(const f32x4*)(ptr + 4); *(f32x4*)ptr = r0; *(f32x4*)(ptr + 4) = r1; r0 = r0 * cd + v0; r1 = r1 * cd + v1; }
    float* o = pk->out + O_SHP + (size_t)(b * 16 + h) * 8192 + e0; *(f32x4*)o = r0; *(f32x4*)(o + 4) = r1;
}

DI void rg_item(KP pk_in, unsigned char* lds, const bool sample, int bidx, int k, int qd) {
    KP pk = pk_in; asm volatile("" : "+s"(pk));
    unsigned char* ws = pk->ws;
    const int tid = otid(), w = tid >> 6, lane = tid & 63, l15 = lane & 15, q = lane >> 4;
    bf16_t* uA = (bf16_t*)lds;
    float* sa = (float*)(lds + 34816); float* sb = sa + 4096;
    float* segA = sb + 4096; float* segB = segA + 512; float* hcar = segB + 512;
    const bf16_t* proj = (const bf16_t*)(ws + W_PROJ); bf16_t* mix = (bf16_t*)(ws + W_MIX);
    const bf16_t* wg = (const bf16_t*)(ws + W_WGT) + (size_t)((k * 4 + qd) * 64) * 128;
    bf16_t* wS = (bf16_t*)(lds + 73728);
    __syncthreads();
    for (int idx = tid; idx < 1024; idx += 512) { const int n = idx >> 4, c8 = (idx & 15) * 8; *(u32x4*)(wS + n * 136 + c8) = *(const u32x4*)(wg + n * 128 + c8); }
    float ba[2], bi[2], spl[2];
#pragma unroll
    for (int ntl = 0; ntl < 2; ++ntl) { const int ch = k * 128 + qd * 32 + ntl * 16 + l15; ba[ntl] = pk->b_rg_a[ch]; bi[ntl] = pk->b_rg_i[ch]; spl[ntl] = softplusf(-pk->rg_lambda[ch]); }
    __syncthreads();
    if (tid < 32) hcar[tid] = 0.f;
    const int ntiles = sample ? 1 : 16;
    for (int tile = 0; tile < ntiles; ++tile) {
        __syncthreads();
        { const int row = tid >> 2, cg0 = (tid & 3) * 32;
#pragma unroll
          for (int v = 0; v < 4; ++v) { const int c8 = cg0 + v * 8, ch = k * 128 + c8;
              const f32x4 b0 = *(const f32x4*)(pk->rg_conv_b + ch), b1 = *(const f32x4*)(pk->rg_conv_b + ch + 4);
              float acc[8] = {b0[0], b0[1], b0[2], b0[3], b1[0], b1[1], b1[2], b1[3]};
#pragma unroll
              for (int kk = 0; kk < 4; ++kk) { float x[8]; float have = 1.f;
                  if (!sample) { const int tt = tile * 128 + row - 3 + kk; have = tt >= 0 ? 1.f : 0.f; const u32x4 vv = *(const u32x4*)(proj + (size_t)(bidx * 2048 + (tt < 0 ? 0 : tt)) * NPROJ + C_RGX + ch); unpack8(vv, x); }
                  else { const int sbi = bidx * 32 + (row >> 2), ui = (row & 3) + kk;
                      if (ui < 3) { const float* s = pk->state_rg_conv + (size_t)(sbi * 3 + ui) * 1024 + ch; const f32x4 s0 = *(const f32x4*)s, s1 = *(const f32x4*)(s + 4);
                          x[0] = s0[0]; x[1] = s0[1]; x[2] = s0[2]; x[3] = s0[3]; x[4] = s1[0]; x[5] = s1[1]; x[6] = s1[2]; x[7] = s1[3]; }
                      else { const u32x4 vv = *(const u32x4*)(proj + (size_t)(NTOKP + sbi * 4 + ui - 3) * NPROJ + C_RGX + ch); unpack8(vv, x); } }
                  { const f32x4 w0 = *(const f32x4*)(pk->rg_conv_w + kk * 1024 + ch) * have, w1 = *(const f32x4*)(pk->rg_conv_w + kk * 1024 + ch + 4) * have;
                      acc[0] += x[0] * w0[0]; acc[1] += x[1] * w0[1]; acc[2] += x[2] * w0[2]; acc[3] += x[3] * w0[3];
                      acc[4] += x[4] * w1[0]; acc[5] += x[5] * w1[1]; acc[6] += x[6] * w1[2]; acc[7] += x[7] * w1[3]; } }
              *(u32x4*)(uA + row * 136 + c8) = pack8(acc); } }
        __syncthreads();
        { f32x4 acc[4];
#pragma unroll
          for (int nt = 0; nt < 4; ++nt) acc[nt] = (f32x4){0.f, 0.f, 0.f, 0.f};
#pragma unroll
          for (int ks = 0; ks < 4; ++ks) { const bf16x8 a = *(const bf16x8*)(uA + (16 * w + l15) * 136 + ks * 32 + q * 8);
#pragma unroll
              for (int nt = 0; nt < 4; ++nt) { const bf16x8 bb = *(const bf16x8*)(wS + (nt * 16 + l15) * 136 + ks * 32 + q * 8); acc[nt] = MFMA16(a, bb, acc[nt]); } }
#pragma unroll
          for (int ntl = 0; ntl < 2; ++ntl)
#pragma unroll
              for (int r = 0; r < 4; ++r) { const int row = 16 * w + 4 * q + r, cl = ntl * 16 + l15;
                  const float rr = sigmf(acc[ntl][r] + ba[ntl]), ii = sigmf(acc[2 + ntl][r] + bi[ntl]);
                  const float la = -8.f * rr * spl[ntl]; float a = __expf(la); const float uval = bf2f(uA[row * 136 + qd * 32 + cl]);
                  float bt = sqrtf(fmaxf(1.f - a * a, 0.f)) * ii * uval;
                  const bool first = sample ? ((row & 3) == 0) : (tile == 0 && row == 0);
                  if (first) { const float h0 = sample ? pk->state_rg_h[(size_t)(bidx * 32 + (row >> 2)) * 1024 + k * 128 + qd * 32 + cl] : 0.f; bt += a * h0; a = 0.f; }
                  sa[row * 32 + cl] = a; sb[row * 32 + cl] = bt; } }
        __syncthreads();
        const int cl = tid & 31, seg = tid >> 5;
        { float A = 1.f, B = 0.f;
#pragma unroll
          for (int j = 0; j < 8; ++j) { const int row = seg * 8 + j; const float a = sa[row * 32 + cl], bb = sb[row * 32 + cl]; B = a * B + bb; A = a * A; }
          segA[seg * 32 + cl] = A; segB[seg * 32 + cl] = B; }
        __syncthreads();
        float h = hcar[cl];
        for (int s = 0; s < seg; ++s) h = segA[s * 32 + cl] * h + segB[s * 32 + cl];
        const int chg = k * 128 + qd * 32 + cl;
        float gts[8];
#pragma unroll
        for (int j = 0; j < 8; ++j) { const int row = seg * 8 + j; const size_t grow = sample ? (size_t)(NTOKP + bidx * 128 + row) : (size_t)(bidx * 2048 + tile * 128 + row);
            gts[j] = bf2f(proj[grow * NPROJ + C_RGG + chg]); }
#pragma unroll
        for (int j = 0; j < 8; ++j) { const int row = seg * 8 + j; h = sa[row * 32 + cl] * h + sb[row * 32 + cl];
            const size_t grow = sample ? (size_t)(NTOKP + bidx * 128 + row) : (size_t)(bidx * 2048 + tile * 128 + row);
            mix[grow * DMIX + chg] = f2bf(h * siluf(gts[j]));
            if (sample) { if ((row & 3) == 3) pk->out[O_RGHS + (size_t)(bidx * 32 + (row >> 2)) * 1024 + chg] = h; }
            else if (tile == 15 && row == 127) pk->out[O_RGHP + (size_t)bidx * 1024 + chg] = h; }
        __syncthreads();
        if (seg == 15) hcar[cl] = h;
    }
    if (!sample) { if (tid < 96) { const int jj = tid >> 5, cl = tid & 31, chg = k * 128 + qd * 32 + cl;
            pk->out[O_RGCP + (size_t)(bidx * 3 + jj) * 1024 + chg] = bf2f(proj[(size_t)(bidx * 2048 + 2045 + jj) * NPROJ + C_RGX + chg]); } }
    else { for (int idx = tid; idx < 32 * 3 * 32; idx += 512) { const int cl = idx & 31, jj = (idx >> 5) % 3, sl = idx / 96; const int sbi = bidx * 32 + sl, chg = k * 128 + qd * 32 + cl;
            pk->out[O_RGCS + (size_t)(sbi * 3 + jj) * 1024 + chg] = bf2f(proj[(size_t)(NTOKP + sbi * 4 + 1 + jj) * NPROJ + C_RGX + chg]); } }
}

DI void attnp_item(KP pk_in, int b, int head, int qt) {
    KP pk = pk_in; asm volatile("" : "+s"(pk));
    unsigned char* ws = pk->ws;
    const int tid = otid(), w = tid >> 6, lane = tid & 63, l15 = lane & 15, q = lane >> 4;
    const bf16_t* proj = (const bf16_t*)(ws + W_PROJ); const bf16_t* kb = (const bf16_t*)(ws + W_KB); const bf16_t* vt = (const bf16_t*)(ws + W_VT); bf16_t* mix = (bf16_t*)(ws + W_MIX);
    const int tokb = b * 2048 + qt * 128 + 16 * w;
    bf16x8 qf[8];
#pragma unroll
    for (int ks = 0; ks < 8; ++ks) qf[ks] = *(const bf16x8*)(proj + (size_t)(tokb + l15) * NPROJ + C_Q + head * 256 + ks * 32 + q * 8);
    f32x4 st[16];
#pragma unroll
    for (int mt = 0; mt < 16; ++mt) { st[mt] = (f32x4){0.f, 0.f, 0.f, 0.f}; const bf16_t* kp = kb + (size_t)(b * 256 + 16 * mt + l15) * 1024 + head * 256 + q * 8;
#pragma unroll
        for (int ks = 0; ks < 8; ++ks) { const bf16x8 kf = *(const bf16x8*)(kp + ks * 32); st[mt] = MFMA16(kf, qf[ks], st[mt]); } }
    float mx = -3.0e38f;
#pragma unroll
    for (int mt = 0; mt < 16; ++mt)
#pragma unroll
        for (int r = 0; r < 4; ++r) { st[mt][r] *= 0.0625f; mx = fmaxf(mx, st[mt][r]); }
    mx = fmaxf(mx, shx(mx, 16, lane)); mx = fmaxf(mx, shx(mx, 32, lane));
    float l = 0.f;
#pragma unroll
    for (int mt = 0; mt < 16; ++mt)
#pragma unroll
        for (int r = 0; r < 4; ++r) { const float e = __expf(st[mt][r] - mx); st[mt][r] = e; l += e; }
    l += shx(l, 16, lane); l += shx(l, 32, lane);
    bf16x8 pf[8];
#pragma unroll
    for (int s = 0; s < 8; ++s) { float m8[8] = {st[2 * s][0], st[2 * s][1], st[2 * s][2], st[2 * s][3], st[2 * s + 1][0], st[2 * s + 1][1], st[2 * s + 1][2], st[2 * s + 1][3]}; pf[s] = as_frag(pack8(m8)); }
    float linv[4];
#pragma unroll
    for (int r = 0; r < 4; ++r) linv[r] = 1.f / shl(l, 4 * q + r);
#pragma unroll 2
    for (int dt = 0; dt < 16; ++dt) { f32x4 o = {0.f, 0.f, 0.f, 0.f}; const bf16_t* vp = vt + ((size_t)((b * 4 + head) * 256 + 16 * dt + l15)) * 256 + 4 * q;
        float gt[4];
#pragma unroll
        for (int r = 0; r < 4; ++r) gt[r] = bf2f(proj[(size_t)(tokb + 4 * q + r) * NPROJ + C_XG + head * 256 + 16 * dt + l15]);
#pragma unroll
        for (int s = 0; s < 8; ++s) { const u32x2 lo = *(const u32x2*)(vp + 32 * s), hi = *(const u32x2*)(vp + 32 * s + 16); o = MFMA16(pf[s], frag2(lo, hi), o); }
#pragma unroll
        for (int r = 0; r < 4; ++r) { const size_t tok = (size_t)(tokb + 4 * q + r); const int d = 16 * dt + l15;
            mix[tok * DMIX + 2048 + head * 256 + d] = f2bf(o[r] * linv[r] * siluf(gt[r])); } }
}

DI float wave_sum(float v, int lane) { v += shx(v, 32, lane); v += shx(v, 16, lane); v += shx(v, 8, lane); v += shx(v, 4, lane); v += shx(v, 2, lane); v += shx(v, 1, lane); return v; }
DI float wave_max(float v, int lane) { v = fmaxf(v, shx(v, 32, lane)); v = fmaxf(v, shx(v, 16, lane)); v = fmaxf(v, shx(v, 8, lane)); v = fmaxf(v, shx(v, 4, lane)); v = fmaxf(v, shx(v, 2, lane)); v = fmaxf(v, shx(v, 1, lane)); return v; }

DI void attns_item(KP pk_in, unsigned char* lds, int sbi, int head) {
    KP pk = pk_in; asm volatile("" : "+s"(pk));
    unsigned char* ws = pk->ws;
    const int tid = otid(), w = tid >> 6, lane = tid & 63;
    const bf16_t* proj = (const bf16_t*)(ws + W_PROJ); bf16_t* mix = (bf16_t*)(ws + W_MIX);
    float* qs = (float*)lds; float* sc = qs + 1024; float* ored = sc + 1024;
    __syncthreads();
    for (int idx = tid; idx < 1024; idx += 512) { const int t = idx >> 8, d = idx & 255; qs[idx] = bf2f(proj[(size_t)(NTOKP + sbi * 4 + t) * NPROJ + C_Q + head * 256 + d]); }
    __syncthreads();
    f32x4 qv[4];
#pragma unroll
    for (int t = 0; t < 4; ++t) qv[t] = *(const f32x4*)(qs + t * 256 + lane * 4);
    for (int m = w; m < 256; m += 8) { const f32x4 kv = *(const f32x4*)(pk->cache_k + ((size_t)(sbi * 256 + m) * 4 + head) * 256 + lane * 4);
#pragma unroll
        for (int t = 0; t < 4; ++t) { float s = kv[0] * qv[t][0] + kv[1] * qv[t][1] + kv[2] * qv[t][2] + kv[3] * qv[t][3]; s = wave_sum(s, lane); if (lane == 0) sc[t * 256 + m] = s * 0.0625f; } }
    __syncthreads();
    if (w < 4) { const f32x4 v = *(const f32x4*)(sc + w * 256 + lane * 4); float mx = fmaxf(fmaxf(v[0], v[1]), fmaxf(v[2], v[3])); mx = wave_max(mx, lane);
        f32x4 e; e[0] = __expf(v[0] - mx); e[1] = __expf(v[1] - mx); e[2] = __expf(v[2] - mx); e[3] = __expf(v[3] - mx); float s = wave_sum(e[0] + e[1] + e[2] + e[3], lane); const float inv = 1.f / s;
        *(f32x4*)(sc + w * 256 + lane * 4) = e * inv; }
    __syncthreads();
    f32x4 acc[4];
#pragma unroll
    for (int t = 0; t < 4; ++t) acc[t] = (f32x4){0.f, 0.f, 0.f, 0.f};
    for (int m = w; m < 256; m += 8) { const f32x4 vv = *(const f32x4*)(pk->cache_v + ((size_t)(sbi * 256 + m) * 4 + head) * 256 + lane * 4);
#pragma unroll
        for (int t = 0; t < 4; ++t) acc[t] += vv * sc[t * 256 + m]; }
#pragma unroll
    for (int t = 0; t < 4; ++t) *(f32x4*)(ored + (w * 4 + t) * 256 + lane * 4) = acc[t];
    __syncthreads();
    for (int idx = tid; idx < 1024; idx += 512) { const int t = idx >> 8, d = idx & 255; float s = 0.f;
#pragma unroll
        for (int ww = 0; ww < 8; ++ww) s += ored[(ww * 4 + t) * 256 + d];
        const size_t tok = (size_t)(NTOKP + sbi * 4 + t); const float gate = bf2f(proj[tok * NPROJ + C_XG + head * 256 + d]); mix[tok * DMIX + 2048 + head * 256 + d] = f2bf(s * siluf(gate)); }
}

DI void ssds_item(KP pk_in, unsigned char* lds, int sbi, int g) {
    KP pk = pk_in; asm volatile("" : "+s"(pk));
    unsigned char* ws = pk->ws;
    const int tid = otid(), w = tid >> 6, lane = tid & 63;
    const bf16_t* proj = (const bf16_t*)(ws + W_PROJ); bf16_t* mix = (bf16_t*)(ws + W_MIX); const float* wdf = (const float*)(ws + W_WDTF);
    float* xs = (float*)lds; float* Bs = xs + 2048; float* Cs = Bs + 512; float* yg = Cs + 512; float* dts = yg + 2048; float* decs = dts + 32;
    __syncthreads();
#pragma unroll
    for (int d = 0; d < 4; ++d) { const int pi = w * 4 + d, t = pi & 3, hl = pi >> 2, h = 8 * g + hl; float s = 0.f;
#pragma unroll
        for (int i = 0; i < 4; ++i) { const f32x4 xv = *(const f32x4*)(pk->x_sample + (size_t)(sbi * 4 + t) * 1024 + i * 256 + lane * 4), wv = *(const f32x4*)(wdf + h * 1024 + i * 256 + lane * 4);
            s += xv[0] * wv[0] + xv[1] * wv[1] + xv[2] * wv[2] + xv[3] * wv[3]; }
        s = wave_sum(s, lane);
        if (lane == 0) { const float dt = softplusf(s + pk->ssd_dt_bias[h]); dts[t * 8 + hl] = dt; decs[t * 8 + hl] = __expf(-dt * __expf(pk->ssd_a_log[h])); } }
    for (int idx = tid; idx < 4 * 768; idx += 512) { const int t = idx / 768, cc = idx % 768; const int ch = cc < 512 ? g * 512 + cc : (cc < 640 ? 1024 + g * 128 + (cc - 512) : 1280 + g * 128 + (cc - 640));
        float acc = pk->ssd_conv_b[ch];
#pragma unroll
        for (int kk = 0; kk < 4; ++kk) { const int ui = t + kk; const float x = ui < 3 ? pk->state_ssd_conv[(size_t)(sbi * 3 + ui) * 1536 + ch] : bf2f(proj[(size_t)(NTOKP + sbi * 4 + ui - 3) * NPROJ + C_XBC + ch]);
            acc += x * pk->ssd_conv_w[kk * 1536 + ch]; }
        const float a = siluf(acc);
        if (cc < 512) xs[t * 512 + cc] = a; else if (cc < 640) Bs[t * 128 + cc - 512] = a; else Cs[t * 128 + cc - 640] = a; }
    for (int idx = tid; idx < 3 * 768; idx += 512) { const int jj = idx / 768, cc = idx % 768; const int ch = cc < 512 ? g * 512 + cc : (cc < 640 ? 1024 + g * 128 + (cc - 512) : 1280 + g * 128 + (cc - 640));
        pk->out[O_SCS + (size_t)(sbi * 3 + jj) * 1536 + ch] = bf2f(proj[(size_t)(NTOKP + sbi * 4 + 1 + jj) * NPROJ + C_XBC + ch]); }
    __syncthreads();
    const int pp = tid >> 3, n0 = (tid & 7) * 16;
    for (int hl = 0; hl < 8; ++hl) { const int h = 8 * g + hl; const size_t so = ((size_t)(sbi * 16 + h) * 64 + pp) * 128 + n0;
        f32x4 hs[4];
#pragma unroll
        for (int v = 0; v < 4; ++v) hs[v] = *(const f32x4*)(pk->state_ssd_h + so + v * 4);
        const float dsk = pk->ssd_d[h];
#pragma unroll
        for (int t = 0; t < 4; ++t) { const float dec = decs[t * 8 + hl], xv = xs[t * 512 + hl * 64 + pp], dtx = dts[t * 8 + hl] * xv; float part = 0.f;
#pragma unroll
            for (int v = 0; v < 4; ++v) { const f32x4 bv = *(const f32x4*)(Bs + t * 128 + n0 + v * 4), cv = *(const f32x4*)(Cs + t * 128 + n0 + v * 4);
                hs[v] = hs[v] * dec + bv * dtx; part += cv[0] * hs[v][0] + cv[1] * hs[v][1] + cv[2] * hs[v][2] + cv[3] * hs[v][3]; }
            part += shx(part, 1, lane); part += shx(part, 2, lane); part += shx(part, 4, lane);
            if ((tid & 7) == 0) { const float y = part + dsk * xv; const float z = bf2f(proj[(size_t)(NTOKP + sbi * 4 + t) * NPROJ + C_Z + h * 64 + pp]); yg[t * 512 + hl * 64 + pp] = y * siluf(z); } }
#pragma unroll
        for (int v = 0; v < 4; ++v) *(f32x4*)(pk->out + O_SHS + so + v * 4) = hs[v];
    }
    __syncthreads();
    if (w < 4) { const int t = w; float ss = 0.f; float v[8];
#pragma unroll
        for (int e = 0; e < 8; ++e) { v[e] = yg[t * 512 + e * 64 + lane]; ss += v[e] * v[e]; }
        ss = wave_sum(ss, lane); const float rstd = rsqrtf(ss * (1.f / 512.f) + 1e-5f);
#pragma unroll
        for (int e = 0; e < 8; ++e) { const int cc = e * 64 + lane; mix[(size_t)(NTOKP + sbi * 4 + t) * DMIX + 1024 + g * 512 + cc] = f2bf(v[e] * rstd * pk->ssd_norm_g[g * 512 + cc]); } }
}

DI void ssd3_item(KP pk_in, unsigned char* lds, int b, int c, int g) {
    KP pk = pk_in; asm volatile("" : "+s"(pk));
    unsigned char* ws = pk->ws;
    const int tid = otid(), w = tid >> 6, lane = tid & 63, l15 = lane & 15, q = lane >> 4;
    float* acum_s = (float*)lds; float* dt_s = acum_s + 1024;
    bf16_t* xT = (bf16_t*)(lds + 8192);
    const bf16_t* proj = (const bf16_t*)(ws + W_PROJ); const bf16_t* xact = (const bf16_t*)(ws + W_XACT); bf16_t* mix = (bf16_t*)(ws + W_MIX);
    const float* dt_g = (const float*)(ws + W_DT); const float* acum_g = (const float*)(ws + W_ACUM); const float* st_g = (const float*)(ws + W_ST);
    const int tok0 = b * 2048 + c * 128;
    __syncthreads();
    for (int idx = tid; idx < 1024; idx += 512) { const int j = idx >> 3, hl = idx & 7; acum_s[idx] = acum_g[(size_t)(tok0 + j) * 16 + 8 * g + hl]; dt_s[idx] = dt_g[(size_t)(tok0 + j) * 16 + 8 * g + hl]; }
    bf16x8 cf[4];
#pragma unroll
    for (int ks = 0; ks < 4; ++ks) cf[ks] = *(const bf16x8*)(xact + (size_t)(tok0 + 16 * w + l15) * 1536 + 1280 + g * 128 + ks * 32 + q * 8);
    f32x4 cbt[8];
#pragma unroll
    for (int jt = 0; jt < 8; ++jt) { cbt[jt] = (f32x4){0.f, 0.f, 0.f, 0.f};
        if (jt <= w) {
#pragma unroll
            for (int ks = 0; ks < 4; ++ks) { const bf16x8 bfr = *(const bf16x8*)(xact + (size_t)(tok0 + 16 * jt + l15) * 1536 + 1024 + g * 128 + ks * 32 + q * 8); cbt[jt] = MFMA16(bfr, cf[ks], cbt[jt]); } } }
    float ssq[4] = {0.f, 0.f, 0.f, 0.f};
    const int irow = 16 * w + l15;
    for (int hl = 0; hl < 8; ++hl) { const int h = 8 * g + hl;
        __syncthreads();
        for (int idx = tid; idx < 1024; idx += 512) { const int j = idx >> 3, pv = (idx & 7) * 8; const u32x4 v = *(const u32x4*)(xact + (size_t)(tok0 + j) * 1536 + g * 512 + hl * 64 + pv);
            const bf16_t* e16 = (const bf16_t*)&v; (void)e16;
            xT[(pv + 0) * 136 + j] = (bf16_t)(v.x & 0xFFFF); xT[(pv + 1) * 136 + j] = (bf16_t)(v.x >> 16); xT[(pv + 2) * 136 + j] = (bf16_t)(v.y & 0xFFFF); xT[(pv + 3) * 136 + j] = (bf16_t)(v.y >> 16);
            xT[(pv + 4) * 136 + j] = (bf16_t)(v.z & 0xFFFF); xT[(pv + 5) * 136 + j] = (bf16_t)(v.z >> 16); xT[(pv + 6) * 136 + j] = (bf16_t)(v.w & 0xFFFF); xT[(pv + 7) * 136 + j] = (bf16_t)(v.w >> 16); }
        __syncthreads();
        const float ai = acum_s[irow * 8 + hl];
        bf16x8 af[4];
#pragma unroll
        for (int s = 0; s < 4; ++s) { float m8[8];
#pragma unroll
            for (int hf = 0; hf < 2; ++hf) { const int jt = 2 * s + hf;
#pragma unroll
                for (int r = 0; r < 4; ++r) { const int j = 16 * jt + 4 * q + r; float val = 0.f;
                    if (jt <= w && j <= irow) val = cbt[jt][r] * __expf(ai - acum_s[j * 8 + hl]) * dt_s[j * 8 + hl];
                    m8[hf * 4 + r] = val; } }
            af[s] = as_frag(pack8(m8)); }
        const float dsk = pk->ssd_d[h];
        float ea[4];
#pragma unroll
        for (int r = 0; r < 4; ++r) ea[r] = __expf(acum_s[(16 * w + 4 * q + r) * 8 + hl]);
        float zz[4][4];
#pragma unroll
        for (int pt = 0; pt < 4; ++pt)
#pragma unroll
            for (int r = 0; r < 4; ++r) zz[pt][r] = bf2f(proj[(size_t)(tok0 + 16 * w + 4 * q + r) * NPROJ + C_Z + h * 64 + 16 * pt + l15]);
#pragma unroll
        for (int pt = 0; pt < 4; ++pt) { f32x4 yd = {0.f, 0.f, 0.f, 0.f}, yo = {0.f, 0.f, 0.f, 0.f};
            const bf16_t* xr = xT + (16 * pt + l15) * 136;
#pragma unroll
            for (int s = 0; s < 4; ++s) if (2 * s <= w) { const u32x2 lo = *(const u32x2*)(xr + 32 * s + 4 * q), hi = *(const u32x2*)(xr + 32 * s + 16 + 4 * q); yd = MFMA16(af[s], frag2(lo, hi), yd); }
            const float* hp = st_g + ((size_t)((b * 16 + c) * 16 + h) * 64 + 16 * pt + l15) * 128 + q * 8;
#pragma unroll
            for (int ks = 0; ks < 4; ++ks) { const f32x4 f0 = *(const f32x4*)(hp + ks * 32), f1 = *(const f32x4*)(hp + ks * 32 + 4); float m8[8] = {f0[0], f0[1], f0[2], f0[3], f1[0], f1[1], f1[2], f1[3]};
                yo = MFMA16(cf[ks], as_frag(pack8(m8)), yo); }
            const u32x2 xv2 = *(const u32x2*)(xr + 16 * w + 4 * q); const float xv[4] = {bflo(xv2.x), bfhi(xv2.x), bflo(xv2.y), bfhi(xv2.y)};
#pragma unroll
            for (int r = 0; r < 4; ++r) { const size_t tok = (size_t)(tok0 + 16 * w + 4 * q + r); const int pp = 16 * pt + l15;
                const float y = yd[r] + ea[r] * yo[r] + dsk * xv[r]; const float val = y * siluf(zz[pt][r]);
                ssq[r] += val * val; mix[tok * DMIX + 1024 + g * 512 + hl * 64 + pp] = f2bf(val); } }
    }
    float rstd[4];
#pragma unroll
    for (int r = 0; r < 4; ++r) { float s = ssq[r]; s += shx(s, 1, lane); s += shx(s, 2, lane); s += shx(s, 4, lane); s += shx(s, 8, lane); rstd[r] = rsqrtf(s * (1.f / 512.f) + 1e-5f); }
    for (int hl = 0; hl < 8; ++hl)
#pragma unroll
        for (int pt = 0; pt < 4; ++pt) { const int cc = hl * 64 + 16 * pt + l15; const float gn = pk->ssd_norm_g[g * 512 + cc];
#pragma unroll
            for (int r = 0; r < 4; ++r) { bf16_t* mp = mix + (size_t)(tok0 + 16 * w + 4 * q + r) * DMIX + 1024 + g * 512 + cc; *mp = f2bf(bf2f(*mp) * rstd[r] * gn); } }
}

DI void ln_rows(KP pk_in) {
    KP pk = pk_in; asm volatile("" : "+s"(pk));
    const float* res = (const float*)(pk->ws + W_RES);
    const int tid = otid(); const int lane = tid & 63; const int gw = obid() * 8 + (tid >> 6), nw = gridDim.x * 8;
    f32x4 gg[4], bb[4];
#pragma unroll
    for (int i = 0; i < 4; ++i) { gg[i] = *(const f32x4*)(pk->ln_g + i * 256 + lane * 4); bb[i] = *(const f32x4*)(pk->ln_b + i * 256 + lane * 4); }
    for (int row = gw; row < NTOK; row += nw) { f32x4 v[4]; float s = 0.f;
#pragma unroll
        for (int i = 0; i < 4; ++i) { v[i] = *(const f32x4*)(res + (size_t)row * 1024 + i * 256 + lane * 4); s += v[i][0] + v[i][1] + v[i][2] + v[i][3]; }
        const float mu = wave_sum(s, lane) * (1.f / 1024.f); float s2 = 0.f;
#pragma unroll
        for (int i = 0; i < 4; ++i) { v[i] = v[i] - mu; s2 += v[i][0] * v[i][0] + v[i][1] * v[i][1] + v[i][2] * v[i][2] + v[i][3] * v[i][3]; }
        const float rstd = rsqrtf(wave_sum(s2, lane) * (1.f / 1024.f) + 1e-5f);
#pragma unroll
        for (int i = 0; i < 4; ++i) *(f32x4*)(pk->out + (size_t)row * 1024 + i * 256 + lane * 4) = v[i] * rstd * gg[i] + bb[i]; }
}

__global__ void __launch_bounds__(512, 2) hymba_fwd(Params p_unused) {
    KP pk = kparams();
    extern __shared__ __attribute__((aligned(16))) unsigned char shm[];
    cg::grid_group grid = cg::this_grid();
    const int G = gridDim.x;
    if (threadIdx.x < 4) ((volatile LAS unsigned*)(LAS unsigned char*)shm)[32768 + threadIdx.x] = 0u;
    __syncthreads();
    const int ph_lo_chk = pk->ph_lo;
    XcdBarrier xb = xcd_barrier_post((unsigned*)(pk->ws + W_BAR), (volatile LAS unsigned*)(LAS unsigned char*)shm + 32768);
    if (ph_lo_chk < 0) grid.sync();
    { KP pk = kparams(); for (int rep = 0; rep < REP0; ++rep) phase_prep(pk, shm); }
    xcd_barrier(xb);
    { KP pk = kparams(); const int bid = obid();
      for (int rep = 0; rep < REP1; ++rep) {
        { pg8::Gemm g; g.A = (const bf16_t*)(pk->ws + W_XB); g.Bt = (const bf16_t*)(pk->ws + W_WINT); g.M = NTOK; g.N = NPROJ; g.K = 1024;
          pg8::StaticOrder S; S.init(g.M, g.N, G, bid); pg8::EpiBf16 E; E.O = (bf16_t*)(pk->ws + W_PROJ); E.ldc = NPROJ;
          pg8::gemm_phase<pg8::EpiBf16, pg8::StaticOrder>((LAS unsigned char*)shm, g, S, E); }
        { pg8::Gemm g; g.A = (const bf16_t*)(pk->ws + W_MEMB); g.Bt = (const bf16_t*)(pk->ws + W_WKVT); g.M = 2048; g.N = 2048; g.K = 1024;
          const int shift = (66 * 26) % G; pg8::StaticOrder S; S.init(g.M, g.N, G, (bid + G - shift) % G);
          pg8::EpiKV E; E.mk = pk->out + O_MKP; E.mv = pk->out + O_MVP; E.kb = (bf16_t*)(pk->ws + W_KB); E.vt = (bf16_t*)(pk->ws + W_VT);
          pg8::gemm_phase<pg8::EpiKV, pg8::StaticOrder>((LAS unsigned char*)shm, g, S, E); } } }
    xcd_barrier(xb);
    { KP pk = kparams(); const int bid = obid();
      for (int rep = 0; rep < REP2; ++rep) for (int it = bid; it < 256; it += G) ssd1_item(pk, shm, it >> 5, (it >> 1) & 15, it & 1); }
    xcd_barrier(xb);
    { KP pk = kparams(); const int bid = obid();
      for (int rep = 0; rep < REP3; ++rep) for (int it = bid; it < 1920; it += G) {
          if (rep > 0 && (it < R3LO || it >= R3HI)) continue;
          if (it < 256) rg_item(pk, shm, false, it >> 5, (it >> 2) & 7, it & 3);
          else if (it < 512) statepass_item(pk, it - 256);
          else if (it < 640) { const int u = it - 512; rg_item(pk, shm, true, u >> 5, (u >> 2) & 7, u & 3); }
          else if (it < 896) { const int u = it - 640; ssds_item(pk, shm, u >> 1, u & 1); }
          else if (it < 1408) { const int u = it - 896; attns_item(pk, shm, u >> 2, u & 3); }
          else { const int u = it - 1408; attnp_item(pk, u >> 6, (u >> 4) & 3, u & 15); } } }
    xcd_barrier(xb);
    { KP pk = kparams(); const int bid = obid();
      for (int rep = 0; rep < REP4; ++rep) for (int it = bid; it < 256; it += G) ssd3_item(pk, shm, it >> 5, (it >> 1) & 15, it & 1); }
    xcd_barrier(xb);
    { KP pk = kparams(); const int bid = obid();
      for (int rep = 0; rep < REP5; ++rep) {
        pg8::Gemm g; g.A = (const bf16_t*)(pk->ws + W_MIX); g.Bt = (const bf16_t*)(pk->ws + W_WOUTT); g.M = NTOK; g.N = 1024; g.K = 3072;
        pg8::StaticOrder S; S.init(g.M, g.N, G, bid); pg8::EpiRes E; E.res = (float*)(pk->ws + W_RES); E.xp = pk->x_prompt; E.xs = pk->x_sample; E.alpha = 1.189207115002721f;
        pg8::gemm_phase<pg8::EpiRes, pg8::StaticOrder>((LAS unsigned char*)shm, g, S, E); } }
    xcd_barrier(xb);
    { KP pk = kparams(); for (int rep = 0; rep < REP6; ++rep) ln_rows(pk); }
}

extern "C" void kernel_launch(void* const* d_in, const int* in_sizes, int n_in, void* d_out, int out_size, void* d_ws, size_t ws_size, hipStream_t stream) {
    static int grid_blocks = 0;
    if (!grid_blocks) {
        int dev = 0, cus = 0, per_cu = 0;
        hipGetDevice(&dev);
        hipDeviceGetAttribute(&cus, hipDeviceAttributeMultiprocessorCount, dev);
        if (hipFuncSetAttribute((const void*)hymba_fwd, hipFuncAttributeMaxDynamicSharedMemorySize, LDS_BYTES) != hipSuccess) fprintf(stderr, "hipFuncSetAttribute failed\n");
        hipOccupancyMaxActiveBlocksPerMultiprocessor(&per_cu, (const void*)hymba_fwd, 512, LDS_BYTES);
        if (per_cu < 1) { fprintf(stderr, "occupancy query says %d blocks per CU\n", per_cu); per_cu = 1; }
        grid_blocks = cus * 1;
        if (ws_size < W_END) fprintf(stderr, "workspace too small: %zu < %zu\n", ws_size, (size_t)W_END);
    }
    if (hipMemsetAsync((char*)d_ws + W_BAR, 0, 3456 * 4, stream) != hipSuccess) fprintf(stderr, "memset failed\n");
    Params p{};
    const float** fp = (const float**)&p;
    for (int i = 0; i < 28; ++i) fp[i] = (const float*)d_in[i];
    p.out = (float*)d_out; p.ws = (unsigned char*)d_ws;
    p.ph_lo = 0; p.ph_hi = NPHASE;
    void* args[] = {&p};
    hipError_t e = hipLaunchCooperativeKernel((const void*)hymba_fwd, dim3(grid_blocks), dim3(512), args, LDS_BYTES, stream);
    if (e != hipSuccess) fprintf(stderr, "cooperative launch failed: %s (grid %d)\n", hipGetErrorString(e), grid_blocks);
}
```

```cpp
#include <hip/hip_runtime.h>
#include <hip/hip_cooperative_groups.h>
#include <cstdio>
namespace cg = cooperative_groups;

#ifndef REP2
#define REP2 1
#endif
#ifndef REP3
#define REP3 1
#endif
#ifndef REP4
#define REP4 1
#endif
#ifndef R3LO
#define R3LO 0
#define R3HI 256
#endif
#ifndef REP0
#define REP0 1
#endif
#ifndef REP1
#define REP1 1
#endif
#ifndef REP5
#define REP5 1
#endif
#ifndef REP6
#define REP6 1
#endif
#ifndef REPS
#define REPS 1
#endif
#ifndef PHM
#define PHM 127
#endif
#ifndef N_LAUNCH_PER_PHASE
#define N_LAUNCH_PER_PHASE 0
#endif

#define DI __device__ __forceinline__
#define LAS __attribute__((address_space(3)))
typedef unsigned short bf16_t;
typedef short bf16x8 __attribute__((ext_vector_type(8)));
typedef float f32x4 __attribute__((ext_vector_type(4)));
typedef unsigned u32x4 __attribute__((ext_vector_type(4)));
typedef unsigned u32x2 __attribute__((ext_vector_type(2)));

constexpr int NTOKP = 16384, NTOKS = 512, NTOK = 16896, DM = 1024, NPROJ = 6656, DMIX = 3072, DIN = 6672;
constexpr int C_RGX = 0, C_RGG = 1024, C_XBC = 2048, C_Z = 3584, C_Q = 4608, C_XG = 5632;
constexpr int NPHASE = 7;
constexpr int LDS_BYTES = 131072 + 64;

constexpr size_t O_YP = 0, O_YS = O_YP + (size_t)NTOKP * DM, O_RGCP = O_YS + (size_t)NTOKS * DM, O_RGHP = O_RGCP + 8 * 3 * 1024, O_SCP = O_RGHP + 8 * 1024,
                 O_SHP = O_SCP + 8 * 3 * 1536, O_MKP = O_SHP + (size_t)8 * 16 * 64 * 128, O_MVP = O_MKP + (size_t)2048 * 1024, O_RGCS = O_MVP + (size_t)2048 * 1024,
                 O_RGHS = O_RGCS + (size_t)128 * 3 * 1024, O_SCS = O_RGHS + 128 * 1024, O_SHS = O_SCS + (size_t)128 * 3 * 1536;

constexpr size_t al256(size_t x) { return (x + 255) & ~(size_t)255; }
constexpr size_t W_XB = 0;
constexpr size_t W_WINT = al256(W_XB + (size_t)NTOK * DM * 2);
constexpr size_t W_WDTT = al256(W_WINT + (size_t)NPROJ * DM * 2);
constexpr size_t W_WDTF = al256(W_WDTT + 16 * 1024 * 2);
constexpr size_t W_WOUTT = al256(W_WDTF + 16 * 1024 * 4);
constexpr size_t W_WKVT = al256(W_WOUTT + (size_t)1024 * 3072 * 2);
constexpr size_t W_MEMB = al256(W_WKVT + (size_t)2048 * 1024 * 2);
constexpr size_t W_WGT = al256(W_MEMB + (size_t)2048 * 1024 * 2);
constexpr size_t W_KB = al256(W_WGT + (size_t)8 * 4 * 64 * 128 * 2);
constexpr size_t W_VT = al256(W_KB + (size_t)2048 * 1024 * 2);
constexpr size_t W_XACT = al256(W_VT + (size_t)2048 * 1024 * 2);
constexpr size_t W_DT = al256(W_XACT + (size_t)NTOKP * 1536 * 2);
constexpr size_t W_ACUM = al256(W_DT + (size_t)NTOKP * 16 * 4);
constexpr size_t W_CD = al256(W_ACUM + (size_t)NTOKP * 16 * 4);
constexpr size_t W_ST = al256(W_CD + 8 * 16 * 16 * 4);
constexpr size_t W_MIX = al256(W_ST + (size_t)8 * 16 * 16 * 8192 * 4);
constexpr size_t W_PROJ = al256(W_MIX + (size_t)NTOK * DMIX * 2);
constexpr size_t W_RES = W_PROJ;
constexpr size_t W_BAR = al256(W_PROJ + (size_t)NTOK * NPROJ * 2);
constexpr size_t W_END = al256(W_BAR + 3456 * 4);

struct Params {
    const float *x_prompt, *x_sample, *mem_prompt, *state_rg_conv, *state_rg_h, *state_ssd_conv, *state_ssd_h, *cache_k, *cache_v;
    const float *w_in, *rg_conv_w, *rg_conv_b, *w_rg_a, *b_rg_a, *w_rg_i, *b_rg_i, *rg_lambda, *ssd_conv_w, *ssd_conv_b, *ssd_dt_bias, *ssd_a_log, *ssd_d, *ssd_norm_g,
        *w_mem_k, *w_mem_v, *w_out, *ln_g, *ln_b;
    float* out; unsigned char* ws;
    int ph_lo, ph_hi;
};
typedef const __attribute__((address_space(4))) Params* KP;
DI KP kparams() { KP k = (KP)__builtin_amdgcn_kernarg_segment_ptr(); asm volatile("" : "+s"(k)); return k; }

DI int otid() { int t = threadIdx.x; asm volatile("" : "+v"(t)); return t; }
DI int obid() { int t = blockIdx.x; asm volatile("" : "+s"(t)); return t; }
DI float bf2f(bf16_t b) { return __uint_as_float(((unsigned)b) << 16); }
DI bf16_t f2bf(float f) { unsigned u = __float_as_uint(f); u += 0x7FFFu + ((u >> 16) & 1u); return (bf16_t)(u >> 16); }
DI unsigned pack2(float lo, float hi) { return (unsigned)f2bf(lo) | ((unsigned)f2bf(hi) << 16); }
DI float bflo(unsigned w) { return __uint_as_float(w << 16); }
DI float bfhi(unsigned w) { return __uint_as_float(w & 0xFFFF0000u); }
DI void unpack8(const u32x4 v, float (&o)[8]) { o[0] = bflo(v.x); o[1] = bfhi(v.x); o[2] = bflo(v.y); o[3] = bfhi(v.y); o[4] = bflo(v.z); o[5] = bfhi(v.z); o[6] = bflo(v.w); o[7] = bfhi(v.w); }
DI u32x4 pack8(const float (&o)[8]) { u32x4 w; w.x = pack2(o[0], o[1]); w.y = pack2(o[2], o[3]); w.z = pack2(o[4], o[5]); w.w = pack2(o[6], o[7]); return w; }
DI bf16x8 as_frag(u32x4 w) { return __builtin_bit_cast(bf16x8, w); }
DI bf16x8 frag2(u32x2 lo, u32x2 hi) { u32x4 w; w.x = lo.x; w.y = lo.y; w.z = hi.x; w.w = hi.y; return __builtin_bit_cast(bf16x8, w); }
DI float shx(float v, int m, int lane) { return __int_as_float(__builtin_amdgcn_ds_bpermute((lane ^ m) << 2, __float_as_int(v))); }
DI float shl(float v, int src) { return __int_as_float(__builtin_amdgcn_ds_bpermute(src << 2, __float_as_int(v))); }
DI float siluf(float x) { return x / (1.f + __expf(-x)); }
DI float sigmf(float x) { return 1.f / (1.f + __expf(-x)); }
DI float softplusf(float v) { return v > 20.f ? v : __logf(1.f + __expf(v)); }
#define MFMA16(a, b, c) __builtin_amdgcn_mfma_f32_16x16x32_bf16((a), (b), (c), 0, 0, 0)

#define XB_TMO      128
#define XB_XCNT(j)  (256  + 64 * (j))
#define XB_XSUB(j)  (1280 + 64 * (j))
#define XB_XGEN(j)  (2304 + 64 * (j))
#define XB_TOP      3328
#define XB_TOPGEN   3392
#define XCD_BAR_WORDS 3456
#define XB_SPIN_CAP (1u << 20)
DI unsigned xb_ld(unsigned* ptr)              { return __hip_atomic_load(ptr, __ATOMIC_RELAXED, __HIP_MEMORY_SCOPE_AGENT); }
DI unsigned xb_add(unsigned* ptr, unsigned v) { return __hip_atomic_fetch_add(ptr, v, __ATOMIC_RELAXED, __HIP_MEMORY_SCOPE_AGENT); }
DI unsigned xb_xcc_id() { return (unsigned)__builtin_amdgcn_s_getreg((3 << 11) | 20) & 0xFu; }
#define XB_SPIN(cond, bar) do { unsigned _sp = 0; while (cond) { __builtin_amdgcn_s_sleep(1); \
    if ((++_sp & 255u) == 0u) { if (xb_ld(&(bar)[XB_TMO])) break; if (_sp > XB_SPIN_CAP) { atomicAdd(&(bar)[XB_TMO], 1u); break; } } } } while (0)
struct XcdBarrier { unsigned* bar; unsigned x; volatile LAS unsigned* st; };
DI XcdBarrier xcd_barrier_post(unsigned* bar, volatile LAS unsigned* st) {
    XcdBarrier b; b.bar = bar; b.x = xb_xcc_id(); b.st = st;
    if (threadIdx.x == 0) (void)xb_add(&bar[XB_XCNT(b.x)], 1u);
    return b;
}
DI void xcd_barrier_complete(unsigned* bar, unsigned x, unsigned& nloc, unsigned& nx) {
    const unsigned G = gridDim.x * gridDim.y * gridDim.z;
    unsigned sum, cnt, mine, sp = 0u;
    for (;;) {
        sum = 0u; cnt = 0u; mine = 0u;
#pragma unroll
        for (unsigned j = 0; j < 16; ++j) { const unsigned c = xb_ld(&bar[XB_XCNT(j)]); sum += c; cnt += (c > 0u) ? 1u : 0u; mine = (j == x) ? c : mine; }
        if (sum == G) break;
        __builtin_amdgcn_s_sleep(1);
        if ((++sp & 255u) == 0u) { if (xb_ld(&bar[XB_TMO])) break; if (sp > XB_SPIN_CAP) { atomicAdd(&bar[XB_TMO], 1u); break; } }
    }
    nloc = mine > 0u ? mine : 1u; nx = cnt > 0u ? cnt : 1u;
}
DI void xcd_barrier(const XcdBarrier& b) {
    asm volatile("s_waitcnt vmcnt(0)" ::: "memory");
    __syncthreads();
    if (threadIdx.x == 0) {
        unsigned* bar = b.bar;
        __builtin_amdgcn_s_waitcnt(0);
        unsigned nloc = b.st[0], nx = b.st[1];
        if (nloc == 0u) { xcd_barrier_complete(bar, b.x, nloc, nx); b.st[0] = nloc; b.st[1] = nx; }
        const unsigned old = xb_add(&bar[XB_XSUB(b.x)], 1u);
        const unsigned gen = old / nloc;
        if (old + 1u == (gen + 1u) * nloc) {
            __builtin_amdgcn_fence(__ATOMIC_RELEASE, "agent");
            asm volatile("s_waitcnt vmcnt(0)" ::: "memory");
            const unsigned og = xb_add(&bar[XB_TOP], 1u);
            const unsigned tg = og / nx;
            if (og + 1u == (tg + 1u) * nx) xb_add(&bar[XB_TOPGEN], 1u);
            else XB_SPIN(xb_ld(&bar[XB_TOPGEN]) == tg, bar);
            __builtin_amdgcn_fence(__ATOMIC_ACQUIRE, "agent");
            xb_add(&bar[XB_XGEN(b.x)], 1u);
            asm volatile("s_waitcnt vmcnt(0)" ::: "memory");
        } else {
            XB_SPIN(xb_ld(&bar[XB_XGEN(b.x)]) == gen, bar);
            __builtin_amdgcn_fence(__ATOMIC_ACQUIRE, "agent");
            asm volatile("s_waitcnt vmcnt(0)" ::: "memory");
        }
    }
    __syncthreads();
}

namespace pg8 {
constexpr int BM = 256, BK = 64, HALF = 128, HTB = HALF * BK * 2, STAGE_BYTES = 8 * HTB, NXCD = 8, WGM = 8;
DI int lds_byte(int r, int c) { const int st = (r >> 4) * 2 + (c >> 5), rr = r & 15, cc = c & 31, ob = rr * 64 + cc * 2; return st * 1024 + (ob ^ (((ob >> 9) & 1) << 5)); }
DI void stage_rc(int b, int& R, int& C) { const int st = b / 1024, sb = b % 1024, swz = sb ^ (((sb >> 9) & 1) << 5); R = (st >> 1) * 16 + swz / 64; C = (st & 1) * 32 + (swz % 64) / 2; }
DI int perm32(int rho) { const int n = rho >> 4, i = rho & 15; return 8 * (i >> 2) + 4 * n + (i & 3); }
struct Unit { int pm, pn; };
struct Gemm { const bf16_t* A; const bf16_t* Bt; int M, N, K; };
struct StaticOrder {
    int nM, nN, nwg, G, c;
    DI void init(int M, int N, int G_, int c_) { nM = M / BM; nN = N / BM; nwg = nM * nN; G = G_; c = c_; }
    DI bool next(int i, Unit& u) const {
        const long L = (long)i * G + c; if (L >= nwg) return false;
        int wgid = (int)L; { const int q = nwg / NXCD, r = nwg % NXCD, xcd = wgid % NXCD, off = wgid / NXCD; wgid = (xcd < r ? xcd * (q + 1) : r * (q + 1) + (xcd - r) * q) + off; }
        const int nig = WGM * nN, gid = wgid / nig, fm = gid * WGM, gsz = (nM - fm) < WGM ? (nM - fm) : WGM;
        u.pm = fm + ((wgid % nig) % gsz); u.pn = (wgid % nig) / gsz; return true;
    }
};
DI unsigned cvt_pk_bf16(float lo, float hi) { unsigned r; asm volatile("v_cvt_pk_bf16_f32 %0, %1, %2" : "=v"(r) : "v"(lo), "v"(hi)); return r; }

struct EpiBf16 {
    static constexpr bool PERM = true;
    bf16_t* O; int ldc;
    DI void operator()(const f32x4 (&acc)[2][2][4][2], const Unit& u, int wr, int wc, int fr, int fq) const {
        const int row0 = u.pm * BM + wr * 64 + fr; const int col0 = u.pn * BM + wc * 32 + 8 * fq;
#pragma unroll
        for (int ai = 0; ai < 2; ++ai)
#pragma unroll
            for (int m = 0; m < 4; ++m) { bf16_t* rowp = O + (size_t)(row0 + ai * HALF + m * 16) * ldc + col0;
#pragma unroll
                for (int bj = 0; bj < 2; ++bj) { const f32x4 v0 = acc[ai][bj][m][0], v1 = acc[ai][bj][m][1];
                    u32x4 w; w.x = cvt_pk_bf16(v0[0], v0[1]); w.y = cvt_pk_bf16(v0[2], v0[3]); w.z = cvt_pk_bf16(v1[0], v1[1]); w.w = cvt_pk_bf16(v1[2], v1[3]);
                    *(u32x4*)(rowp + bj * HALF) = w; } }
    }
};
struct EpiKV {
    static constexpr bool PERM = false;
    float* mk; float* mv; bf16_t* kb; bf16_t* vt;
    DI void operator()(const f32x4 (&acc)[2][2][4][2], const Unit& u, int wr, int wc, int fr, int fq) const {
        const int row0 = u.pm * BM + wr * 64 + fr, col0 = u.pn * BM + wc * 32 + 4 * fq;
#pragma unroll
        for (int ai = 0; ai < 2; ++ai)
#pragma unroll
            for (int m = 0; m < 4; ++m) { const int row = row0 + ai * HALF + m * 16;
#pragma unroll
                for (int bj = 0; bj < 2; ++bj)
#pragma unroll
                    for (int n = 0; n < 2; ++n) { const int col = col0 + bj * HALF + n * 16; const f32x4 v = acc[ai][bj][m][n];
                        if (col < 1024) { *(f32x4*)(mk + (size_t)row * 1024 + col) = v; u32x2 w; w.x = cvt_pk_bf16(v[0], v[1]); w.y = cvt_pk_bf16(v[2], v[3]); *(u32x2*)(kb + (size_t)row * 1024 + col) = w; }
                        else { const int cc = col - 1024; *(f32x4*)(mv + (size_t)row * 1024 + cc) = v; const int bb = row >> 8, mt = row & 255;
#pragma unroll
                            for (int j = 0; j < 4; ++j) { const int c2 = cc + j, head = c2 >> 8, d = c2 & 255; vt[((size_t)((bb * 4 + head) * 256 + d)) * 256 + mt] = f2bf(v[j]); } } } }
    }
};
struct EpiRes {
    static constexpr bool PERM = false;
    float* res; const float* xp; const float* xs; float alpha;
    DI void operator()(const f32x4 (&acc)[2][2][4][2], const Unit& u, int wr, int wc, int fr, int fq) const {
        const int row0 = u.pm * BM + wr * 64 + fr, col0 = u.pn * BM + wc * 32 + 4 * fq;
#pragma unroll
        for (int ai = 0; ai < 2; ++ai)
#pragma unroll
            for (int m = 0; m < 4; ++m) { const int row = row0 + ai * HALF + m * 16; const float* xr = row < NTOKP ? xp + (size_t)row * 1024 : xs + (size_t)(row - NTOKP) * 1024;
#pragma unroll
                for (int bj = 0; bj < 2; ++bj)
#pragma unroll
                    for (int n = 0; n < 2; ++n) { const int col = col0 + bj * HALF + n * 16; const f32x4 xv = *(const f32x4*)(xr + col);
                        *(f32x4*)(res + (size_t)row * 1024 + col) = acc[ai][bj][m][n] + xv * alpha; } }
    }
};

template <class Epi, class Sched>
DI void gemm_phase(LAS unsigned char* lds, const Gemm g, const Sched& S, const Epi& E) {
    const int tid = otid(), wid = __builtin_amdgcn_readfirstlane(tid >> 6), lane = tid & 63, wr = wid >> 2, wc = wid & 3, fr = lane & 15, fq = lane >> 4;
    const int K = g.K, nt = K / BK;
    unsigned voffA[2], voffB[2];
#pragma unroll
    for (int i = 0; i < 2; ++i) { int R, C; stage_rc(tid * 16 + i * 8192, R, C); const int Rb = Epi::PERM ? ((R & ~31) + perm32(R & 31)) : R;
        voffA[i] = (unsigned)(R * K + C) * 2u; voffB[i] = (unsigned)(Rb * K + C) * 2u; }
    const size_t kstep = (size_t)(BK * 2);
    const size_t hstep = (size_t)HALF * K * 2;
    const size_t tstep = 2 * hstep;
    const unsigned ldsw = (unsigned)wid * 1024u;
    const int aoff = lds_byte(wr * 64 + fr, fq * 8), boff = lds_byte(wc * 32 + fr, fq * 8);
#define PG8_SA(b, h) (((b) * 2 + (h)) * HTB)
#define PG8_SB(b, h) ((4 + (b) * 2 + (h)) * HTB)
#define PG8_STAGE(bufoff, gbase, voff) do { _Pragma("unroll") for (int _i = 0; _i < 2; ++_i) \
        __builtin_amdgcn_global_load_lds((const unsigned*)((const char*)(gbase) + (voff)[_i]), (LAS unsigned*)(lds + (bufoff) + ldsw + _i * 8192), 16, 0, 0); } while (0)
#define PG8_LDA(dst, b, h) do { _Pragma("unroll") for (int m = 0; m < 4; ++m) _Pragma("unroll") for (int k = 0; k < 2; ++k) dst[m][k] = *(const LAS bf16x8*)(lds + PG8_SA(b, h) + aoff + m * 2048 + k * 1024); } while (0)
#define PG8_LDB(dst, b, h) do { _Pragma("unroll") for (int n = 0; n < 2; ++n) _Pragma("unroll") for (int k = 0; k < 2; ++k) dst[n][k] = *(const LAS bf16x8*)(lds + PG8_SB(b, h) + boff + n * 2048 + k * 1024); } while (0)
#define PG8_MMA(ai, bj, At, Bt) do { __builtin_amdgcn_s_setprio(1); _Pragma("unroll") for (int m = 0; m < 4; ++m) _Pragma("unroll") for (int n = 0; n < 2; ++n) _Pragma("unroll") for (int k = 0; k < 2; ++k) \
        acc[ai][bj][m][n] = __builtin_amdgcn_mfma_f32_16x16x32_bf16(Bt[n][k], At[m][k], acc[ai][bj][m][n], 0, 0, 0); __builtin_amdgcn_s_setprio(0); } while (0)
#define PG8_WAIT_V(n) asm volatile("s_waitcnt vmcnt(" #n ")" ::: "memory")
#define PG8_WAIT_L(n) asm volatile("s_waitcnt lgkmcnt(" #n ")" ::: "memory")
#define PG8_BAR __builtin_amdgcn_s_barrier()
#define PG8_SCHED __builtin_amdgcn_sched_barrier(0)
    Unit cur, nxt; int ui = 0;
    if (!S.next(0, cur)) return;
    f32x4 acc[2][2][4][2];
#pragma unroll
    for (int a = 0; a < 2; ++a)
#pragma unroll
        for (int b = 0; b < 2; ++b)
#pragma unroll
            for (int m = 0; m < 4; ++m)
#pragma unroll
                for (int n = 0; n < 2; ++n) acc[a][b][m][n] = (f32x4){0.f, 0.f, 0.f, 0.f};
    bf16x8 At[4][2], B0[2][2], B1[2][2];
    const char* cA = (const char*)g.A + (size_t)cur.pm * tstep; const char* cB = (const char*)g.Bt + (size_t)cur.pn * tstep;
    PG8_STAGE(PG8_SB(0, 0), cB, voffB); PG8_STAGE(PG8_SA(0, 0), cA, voffA); PG8_STAGE(PG8_SB(0, 1), cB + hstep, voffB); PG8_STAGE(PG8_SA(0, 1), cA + hstep, voffA);
    if (wr == 1) PG8_BAR;
    PG8_WAIT_V(4); PG8_BAR;
    PG8_STAGE(PG8_SB(1, 0), cB + kstep, voffB); PG8_STAGE(PG8_SA(1, 0), cA + kstep, voffA); PG8_STAGE(PG8_SB(1, 1), cB + hstep + kstep, voffB);
    PG8_WAIT_V(6); PG8_BAR;
    for (;;) {
        const bool has_next = S.next(ui + 1, nxt);
        const char* nA = has_next ? (const char*)g.A + (size_t)nxt.pm * tstep : cA; const char* nB = has_next ? (const char*)g.Bt + (size_t)nxt.pn * tstep : cB;
        for (int t = 0; t < nt; t += 2) {
            const bool last = (t == nt - 2);
            const char* a1 = cA + (size_t)(t + 1) * kstep;
            const char* a2 = last ? nA : cA + (size_t)(t + 2) * kstep; const char* b2 = last ? nB : cB + (size_t)(t + 2) * kstep;
            const char* a3 = a2 + kstep; const char* b3 = b2 + kstep;
            PG8_LDB(B0, 0, 0); PG8_SCHED; PG8_LDA(At, 0, 0); PG8_STAGE(PG8_SA(1, 1), a1 + hstep, voffA);
            PG8_WAIT_L(8); PG8_BAR; PG8_WAIT_L(0); PG8_MMA(0, 0, At, B0); PG8_BAR; PG8_SCHED;
            PG8_LDB(B1, 0, 1); PG8_STAGE(PG8_SB(0, 0), b2, voffB);
            PG8_BAR; PG8_WAIT_L(0); PG8_MMA(0, 1, At, B1); PG8_BAR;
            PG8_LDA(At, 0, 1); PG8_STAGE(PG8_SA(0, 0), a2, voffA);
            PG8_BAR; PG8_WAIT_L(0); PG8_MMA(1, 0, At, B0); PG8_BAR; PG8_SCHED;
            PG8_STAGE(PG8_SB(0, 1), b2 + hstep, voffB);
            PG8_WAIT_V(6); PG8_BAR; PG8_MMA(1, 1, At, B1); PG8_BAR;
            PG8_LDB(B0, 1, 0); PG8_SCHED; PG8_LDA(At, 1, 0); PG8_STAGE(PG8_SA(0, 1), a2 + hstep, voffA);
            PG8_WAIT_L(8); PG8_BAR; PG8_WAIT_L(0); PG8_MMA(0, 0, At, B0); PG8_BAR; PG8_SCHED;
            PG8_LDB(B1, 1, 1); PG8_STAGE(PG8_SB(1, 0), b3, voffB);
            PG8_BAR; PG8_WAIT_L(0); PG8_MMA(0, 1, At, B1); PG8_BAR;
            PG8_LDA(At, 1, 1); PG8_STAGE(PG8_SA(1, 0), a3, voffA);
            PG8_BAR; PG8_WAIT_L(0); PG8_MMA(1, 0, At, B0); PG8_BAR; PG8_SCHED;
            PG8_STAGE(PG8_SB(1, 1), b3 + hstep, voffB);
            PG8_WAIT_V(6); PG8_BAR; PG8_MMA(1, 1, At, B1); PG8_BAR;
        }
        E(acc, cur, wr, wc, fr, fq);
        if (!has_next) break;
#pragma unroll
        for (int a = 0; a < 2; ++a)
#pragma unroll
            for (int b = 0; b < 2; ++b)
#pragma unroll
                for (int m = 0; m < 4; ++m)
#pragma unroll
                    for (int n = 0; n < 2; ++n) acc[a][b][m][n] = (f32x4){0.f, 0.f, 0.f, 0.f};
        cur = nxt; cA = nA; cB = nB; ++ui;
    }
    PG8_WAIT_V(0);
    if (wr == 0) PG8_BAR;
    PG8_BAR;
#undef PG8_SA
#undef PG8_SB
#undef PG8_STAGE
#undef PG8_LDA
#undef PG8_LDB
#undef PG8_MMA
#undef PG8_WAIT_V
#undef PG8_WAIT_L
#undef PG8_BAR
#undef PG8_SCHED
}
}

DI void tr_tile(const float* src, int ld_src, int k0, int c0, bf16_t* dst, int ld_dst, int n0, float* lds) {
    const int tid = otid();
#pragma unroll
    for (int pass = 0; pass < 2; ++pass) { const int r = pass * 32 + (tid >> 4), c4 = (tid & 15) * 4;
        const f32x4 v = *(const f32x4*)(src + (size_t)(k0 + r) * ld_src + c0 + c4);
        lds[r * 65 + c4 + 0] = v[0]; lds[r * 65 + c4 + 1] = v[1]; lds[r * 65 + c4 + 2] = v[2]; lds[r * 65 + c4 + 3] = v[3]; }
    __syncthreads();
    const int nn = tid >> 3, kc = (tid & 7) * 8;
    float o[8];
#pragma unroll
    for (int e = 0; e < 8; ++e) o[e] = lds[(kc + e) * 65 + nn];
    *(u32x4*)(dst + (size_t)(n0 + nn) * ld_dst + k0 + kc) = pack8(o);
    __syncthreads();
}

DI void phase_prep(KP pk_in, unsigned char* lds) {
    KP pk = pk_in; asm volatile("" : "+s"(pk));
    unsigned char* ws = pk->ws;
    const int bidx_ = obid(); const size_t gtid = (size_t)bidx_ * 512 + otid(), nthr = (size_t)gridDim.x * 512;
    { bf16_t* xb = (bf16_t*)(ws + W_XB);
      for (size_t v = gtid; v < (size_t)NTOK * 128; v += nthr) { const float* s = v < (size_t)NTOKP * 128 ? pk->x_prompt + v * 8 : pk->x_sample + (v - (size_t)NTOKP * 128) * 8;
          const f32x4 a = *(const f32x4*)s, b = *(const f32x4*)(s + 4); float o[8] = {a[0], a[1], a[2], a[3], b[0], b[1], b[2], b[3]}; *(u32x4*)(xb + v * 8) = pack8(o); } }
    { bf16_t* mb = (bf16_t*)(ws + W_MEMB);
      for (size_t v = gtid; v < (size_t)2048 * 128; v += nthr) { const float* s = pk->mem_prompt + v * 8;
          const f32x4 a = *(const f32x4*)s, b = *(const f32x4*)(s + 4); float o[8] = {a[0], a[1], a[2], a[3], b[0], b[1], b[2], b[3]}; *(u32x4*)(mb + v * 8) = pack8(o); } }
    { bf16_t* wd = (bf16_t*)(ws + W_WDTT); float* wf = (float*)(ws + W_WDTF);
      for (size_t i = gtid; i < 16 * 1024; i += nthr) { const int h = (int)(i >> 10), k = (int)(i & 1023); const float v = pk->w_in[(size_t)k * DIN + 4608 + h]; wd[i] = f2bf(v); wf[i] = v; } }
    { bf16_t* wg = (bf16_t*)(ws + W_WGT);
      for (size_t i = gtid; i < (size_t)8 * 4 * 64 * 128; i += nthr) { const int k = (int)(i >> 15), qd = (int)(i >> 13) & 3, nn = (int)(i >> 7) & 63, ii = (int)(i & 127);
          const float v = nn < 32 ? pk->w_rg_a[((size_t)k * 128 + ii) * 128 + qd * 32 + nn] : pk->w_rg_i[((size_t)k * 128 + ii) * 128 + qd * 32 + nn - 32]; wg[i] = f2bf(v); } }
    float* tl = (float*)lds;
    for (int t = bidx_; t < 1664 + 768 + 512; t += gridDim.x) {
        if (t < 1664) { const int kt = t & 15, ntile = t >> 4; const int n0 = ntile * 64, c0 = n0 < 4608 ? n0 : n0 + 16;
            tr_tile(pk->w_in, DIN, kt * 64, c0, (bf16_t*)(ws + W_WINT), 1024, n0, tl); }
        else if (t < 1664 + 768) { const int u = t - 1664; const int kt = u % 48, ntile = u / 48;
            tr_tile(pk->w_out, 1024, kt * 64, ntile * 64, (bf16_t*)(ws + W_WOUTT), 3072, ntile * 64, tl); }
        else { const int u = t - 1664 - 768; const int kt = u & 15, ntile = u >> 4; const int n0 = ntile * 64;
            if (n0 < 1024) tr_tile(pk->w_mem_k, 1024, kt * 64, n0, (bf16_t*)(ws + W_WKVT), 1024, n0, tl);
            else tr_tile(pk->w_mem_v, 1024, kt * 64, n0 - 1024, (bf16_t*)(ws + W_WKVT), 1024, n0, tl); }
    }
}

DI void conv8_ssd_prompt(KP pk, const bf16_t* proj, int rowbase, int t, int ch, float (&o)[8]) {
    const f32x4 b0 = *(const f32x4*)(pk->ssd_conv_b + ch), b1 = *(const f32x4*)(pk->ssd_conv_b + ch + 4);
    float acc[8] = {b0[0], b0[1], b0[2], b0[3], b1[0], b1[1], b1[2], b1[3]};
    u32x4 vv[4];
#pragma unroll
    for (int kk = 0; kk < 4; ++kk) { const int tt = t - 3 + kk; vv[kk] = *(const u32x4*)(proj + (size_t)(rowbase + (tt < 0 ? 0 : tt)) * NPROJ + C_XBC + ch); }
#pragma unroll
    for (int kk = 0; kk < 4; ++kk) { const int tt = t - 3 + kk; const float msk = tt >= 0 ? 1.f : 0.f; float x[8]; unpack8(vv[kk], x);
            const f32x4 w0 = *(const f32x4*)(pk->ssd_conv_w + kk * 1536 + ch) * msk, w1 = *(const f32x4*)(pk->ssd_conv_w + kk * 1536 + ch + 4) * msk;
            acc[0] += x[0] * w0[0]; acc[1] += x[1] * w0[1]; acc[2] += x[2] * w0[2]; acc[3] += x[3] * w0[3];
            acc[4] += x[4] * w1[0]; acc[5] += x[5] * w1[1]; acc[6] += x[6] * w1[2]; acc[7] += x[7] * w1[3]; }
#pragma unroll
    for (int e = 0; e < 8; ++e) o[e] = siluf(acc[e]);
}

DI void ssd1_item(KP pk_in, unsigned char* lds, int b, int c, int g) {
    KP pk = pk_in; asm volatile("" : "+s"(pk));
    unsigned char* ws = pk->ws;
    const int tid = otid(), w = tid >> 6, lane = tid & 63, l15 = lane & 15, q = lane >> 4;
    float* dt_s = (float*)lds; float* acum_s = dt_s + 2048; float* w_s = acum_s + 2048;
    bf16_t* BT = (bf16_t*)(lds + 20480); bf16_t* xsT = (bf16_t*)(lds + 20480 + 34816);
    const bf16_t* xb = (const bf16_t*)(ws + W_XB); const bf16_t* wdt = (const bf16_t*)(ws + W_WDTT); const bf16_t* proj = (const bf16_t*)(ws + W_PROJ);
    bf16_t* xact = (bf16_t*)(ws + W_XACT); float* dt_g = (float*)(ws + W_DT); float* acum_g = (float*)(ws + W_ACUM); float* cd_g = (float*)(ws + W_CD); float* st_g = (float*)(ws + W_ST);
    const int tok0 = b * 2048 + c * 128;
    __syncthreads();
    { f32x4 acc = {0.f, 0.f, 0.f, 0.f}; const bf16_t* ap = xb + (size_t)(tok0 + 16 * w + l15) * 1024 + q * 8; const bf16_t* bp = wdt + l15 * 1024 + q * 8;
#pragma unroll 8
      for (int ks = 0; ks < 32; ++ks) { const bf16x8 a = *(const bf16x8*)(ap + ks * 32); const bf16x8 bb = *(const bf16x8*)(bp + ks * 32); acc = MFMA16(a, bb, acc); }
      const float bias = pk->ssd_dt_bias[l15];
#pragma unroll
      for (int r = 0; r < 4; ++r) { const int i = 16 * w + 4 * q + r; const float dt = softplusf(acc[r] + bias); dt_s[i * 16 + l15] = dt; dt_g[(size_t)(tok0 + i) * 16 + l15] = dt; } }
    __syncthreads();
    if (tid < 16) { const float ah = -__expf(pk->ssd_a_log[tid]); float run = 0.f;
        for (int i = 0; i < 128; ++i) { run += dt_s[i * 16 + tid] * ah; acum_s[i * 16 + tid] = run; acum_g[(size_t)(tok0 + i) * 16 + tid] = run; } }
    __syncthreads();
    if (tid < 8) cd_g[(b * 16 + c) * 16 + 8 * g + tid] = __expf(acum_s[127 * 16 + 8 * g + tid]);
    for (int idx = tid; idx < 1024; idx += 512) { const int j = idx >> 3, hl = idx & 7, h = 8 * g + hl; w_s[idx] = dt_s[j * 16 + h] * __expf(acum_s[127 * 16 + h] - acum_s[j * 16 + h]); }
    for (int idx = tid; idx < 4096; idx += 512) { const int which = idx >> 11, rem = idx & 2047, j = rem >> 4, cv = (rem & 15) * 8; const int ch = 1024 + which * 256 + g * 128 + cv;
        float o[8]; conv8_ssd_prompt(pk, proj, b * 2048, c * 128 + j, ch, o); const u32x4 pk = pack8(o);
        *(u32x4*)(xact + (size_t)(tok0 + j) * 1536 + ch) = pk;
        if (which == 0) { const bf16_t* e16 = (const bf16_t*)&pk;
#pragma unroll
            for (int e = 0; e < 8; ++e) BT[(cv + e) * 136 + j] = f2bf(o[e]); (void)e16; } }
    for (int hl = 0; hl < 8; ++hl) {
        __syncthreads();
        for (int idx = tid; idx < 1024; idx += 512) { const int j = idx >> 3, pv = (idx & 7) * 8; const int ch = g * 512 + hl * 64 + pv;
            float o[8]; conv8_ssd_prompt(pk, proj, b * 2048, c * 128 + j, ch, o);
            *(u32x4*)(xact + (size_t)(tok0 + j) * 1536 + ch) = pack8(o);
            const float wj = w_s[j * 8 + hl];
#pragma unroll
            for (int e = 0; e < 8; ++e) xsT[(pv + e) * 136 + j] = f2bf(o[e] * wj); }
        __syncthreads();
        const int pt = w & 3, nh = w >> 2;
        f32x4 acc[4];
#pragma unroll
        for (int nt = 0; nt < 4; ++nt) acc[nt] = (f32x4){0.f, 0.f, 0.f, 0.f};
#pragma unroll
        for (int ks = 0; ks < 4; ++ks) { const bf16x8 a = *(const bf16x8*)(xsT + (pt * 16 + l15) * 136 + ks * 32 + q * 8);
#pragma unroll
            for (int nt = 0; nt < 4; ++nt) { const bf16x8 bb = *(const bf16x8*)(BT + (nh * 64 + nt * 16 + l15) * 136 + ks * 32 + q * 8); acc[nt] = MFMA16(a, bb, acc[nt]); } }
        float* sp = st_g + (size_t)(((b * 16 + c) * 16 + 8 * g + hl)) * 8192;
#pragma unroll
        for (int nt = 0; nt < 4; ++nt)
#pragma unroll
            for (int r = 0; r < 4; ++r) sp[(pt * 16 + 4 * q + r) * 128 + nh * 64 + nt * 16 + l15] = acc[nt][r];
    }
    if (c == 15) {
        for (int idx = tid; idx < 3 * 768; idx += 512) { const int jj = idx / 768, cc = idx % 768; const int ch = cc < 512 ? g * 512 + cc : (cc < 640 ? 1024 + g * 128 + (cc - 512) : 1280 + g * 128 + (cc - 640));
            pk->out[O_SCP + (size_t)(b * 3 + jj) * 1536 + ch] = bf2f(proj[(size_t)(b * 2048 + 2045 + jj) * NPROJ + C_XBC + ch]); }
    }
}

DI void statepass_item(KP pk_in, int sp) {
    KP pk = pk_in; asm volatile("" : "+s"(pk));
    const int b = sp >> 5, h = (sp >> 1) & 15, half = sp & 1; const int e0 = half * 4096 + otid() * 8;
    float* st_g = (float*)(pk->ws + W_ST); const float* cd_g = (const float*)(pk->ws + W_CD);
    f32x4 r0 = {0.f, 0.f, 0.f, 0.f}, r1 = {0.f, 0.f, 0.f, 0.f};
    for (int c0 = 0; c0 < 16; c0 += 8) { f32x4 v0[8], v1[8]; float cd[8];
#pragma unroll
        for (int i = 0; i < 8; ++i) { const float* ptr = st_g + (size_t)((b * 16 + c0 + i) * 16 + h) * 8192 + e0; v0[i] = *(const f32x4*)ptr; v1[i] = *(const f32x4*)(ptr + 4); cd[i] = cd_g[(b * 16 + c0 + i) * 16 + h]; }
#pragma unroll
        for (int i = 0; i < 8; ++i) { float* ptr = st_g + (size_t)((b * 16 + c0 + i) * 16 + h) * 8192 + e0; *(f32x4*)ptr = r0; *(f32x4*)(ptr + 4) = r1; r0 = r0 * cd[i] + v0[i]; r1 = r1 * cd[i] + v1[i]; } }
    float* o = pk->out + O_SHP + (size_t)(b * 16 + h) * 8192 + e0; *(f32x4*)o = r0; *(f32x4*)(o + 4) = r1;
}

DI void rg_item(KP pk_in, unsigned char* lds, const bool sample, int bidx, int k, int qd) {
    KP pk = pk_in; asm volatile("" : "+s"(pk));
    unsigned char* ws = pk->ws;
    const int tid = otid(), w = tid >> 6, lane = tid & 63, l15 = lane & 15, q = lane >> 4;
    bf16_t* uA = (bf16_t*)lds;
    float* sa = (float*)(lds + 34816); float* sb = sa + 4096;
    float* segA = sb + 4096; float* segB = segA + 512; float* hcar = segB + 512;
    const bf16_t* proj = (const bf16_t*)(ws + W_PROJ); bf16_t* mix = (bf16_t*)(ws + W_MIX);
    const bf16_t* wg = (const bf16_t*)(ws + W_WGT) + (size_t)((k * 4 + qd) * 64) * 128;
    bf16_t* wS = (bf16_t*)(lds + 73728);
    __syncthreads();
    for (int idx = tid; idx < 1024; idx += 512) { const int n = idx >> 4, c8 = (idx & 15) * 8; *(u32x4*)(wS + n * 136 + c8) = *(const u32x4*)(wg + n * 128 + c8); }
    float ba[2], bi[2], spl[2];
#pragma unroll
    for (int ntl = 0; ntl < 2; ++ntl) { const int ch = k * 128 + qd * 32 + ntl * 16 + l15; ba[ntl] = pk->b_rg_a[ch]; bi[ntl] = pk->b_rg_i[ch]; spl[ntl] = softplusf(-pk->rg_lambda[ch]); }
    __syncthreads();
    if (tid < 32) hcar[tid] = 0.f;
    const int ntiles = sample ? 1 : 16;
    const int crow = tid >> 2, cg0 = (tid & 3) * 32;
    const int cl_s = tid & 31, seg_s = tid >> 5;
    u32x4 rv[4][4];
#define RG_LOADP(TILE) do { _Pragma("unroll") for (int v = 0; v < 4; ++v) _Pragma("unroll") for (int kk = 0; kk < 4; ++kk) { const int tt = (TILE) * 128 + crow - 3 + kk; \
        rv[v][kk] = *(const u32x4*)(proj + (size_t)(bidx * 2048 + (tt < 0 ? 0 : tt)) * NPROJ + C_RGX + k * 128 + cg0 + v * 8); } } while (0)
    if (!sample) RG_LOADP(0);
    for (int tile = 0; tile < ntiles; ++tile) {
        __syncthreads();
        float gts[8];
        if (!sample) {
#pragma unroll
          for (int v = 0; v < 4; ++v) { const int c8 = cg0 + v * 8, ch = k * 128 + c8;
              const f32x4 b0 = *(const f32x4*)(pk->rg_conv_b + ch), b1 = *(const f32x4*)(pk->rg_conv_b + ch + 4);
              float acc[8] = {b0[0], b0[1], b0[2], b0[3], b1[0], b1[1], b1[2], b1[3]};
#pragma unroll
              for (int kk = 0; kk < 4; ++kk) { float x[8]; const float have = (tile * 128 + crow - 3 + kk) >= 0 ? 1.f : 0.f; unpack8(rv[v][kk], x);
                  const f32x4 w0 = *(const f32x4*)(pk->rg_conv_w + kk * 1024 + ch) * have, w1 = *(const f32x4*)(pk->rg_conv_w + kk * 1024 + ch + 4) * have;
                  acc[0] += x[0] * w0[0]; acc[1] += x[1] * w0[1]; acc[2] += x[2] * w0[2]; acc[3] += x[3] * w0[3];
                  acc[4] += x[4] * w1[0]; acc[5] += x[5] * w1[1]; acc[6] += x[6] * w1[2]; acc[7] += x[7] * w1[3]; }
              *(u32x4*)(uA + crow * 136 + c8) = pack8(acc); }
          if (tile + 1 < 16) RG_LOADP(tile + 1);
#pragma unroll
          for (int j = 0; j < 8; ++j) gts[j] = bf2f(proj[(size_t)(bidx * 2048 + tile * 128 + seg_s * 8 + j) * NPROJ + C_RGG + k * 128 + qd * 32 + cl_s]);
        } else { const int row = crow;
#pragma unroll
          for (int v = 0; v < 4; ++v) { const int c8 = cg0 + v * 8, ch = k * 128 + c8;
              const f32x4 b0 = *(const f32x4*)(pk->rg_conv_b + ch), b1 = *(const f32x4*)(pk->rg_conv_b + ch + 4);
              float acc[8] = {b0[0], b0[1], b0[2], b0[3], b1[0], b1[1], b1[2], b1[3]};
#pragma unroll
              for (int kk = 0; kk < 4; ++kk) { float x[8];
                  { const int sbi = bidx * 32 + (row >> 2), ui = (row & 3) + kk;
                      if (ui < 3) { const float* s = pk->state_rg_conv + (size_t)(sbi * 3 + ui) * 1024 + ch; const f32x4 s0 = *(const f32x4*)s, s1 = *(const f32x4*)(s + 4);
                          x[0] = s0[0]; x[1] = s0[1]; x[2] = s0[2]; x[3] = s0[3]; x[4] = s1[0]; x[5] = s1[1]; x[6] = s1[2]; x[7] = s1[3]; }
                      else { const u32x4 vv = *(const u32x4*)(proj + (size_t)(NTOKP + sbi * 4 + ui - 3) * NPROJ + C_RGX + ch); unpack8(vv, x); } }
                  { const f32x4 w0 = *(const f32x4*)(pk->rg_conv_w + kk * 1024 + ch), w1 = *(const f32x4*)(pk->rg_conv_w + kk * 1024 + ch + 4);
                      acc[0] += x[0] * w0[0]; acc[1] += x[1] * w0[1]; acc[2] += x[2] * w0[2]; acc[3] += x[3] * w0[3];
                      acc[4] += x[4] * w1[0]; acc[5] += x[5] * w1[1]; acc[6] += x[6] * w1[2]; acc[7] += x[7] * w1[3]; } }
              *(u32x4*)(uA + row * 136 + c8) = pack8(acc); }
#pragma unroll
          for (int j = 0; j < 8; ++j) gts[j] = bf2f(proj[(size_t)(NTOKP + bidx * 128 + seg_s * 8 + j) * NPROJ + C_RGG + k * 128 + qd * 32 + cl_s]);
        }
        __syncthreads();
        { f32x4 acc[4];
#pragma unroll
          for (int nt = 0; nt < 4; ++nt) acc[nt] = (f32x4){0.f, 0.f, 0.f, 0.f};
#pragma unroll
          for (int ks = 0; ks < 4; ++ks) { const bf16x8 a = *(const bf16x8*)(uA + (16 * w + l15) * 136 + ks * 32 + q * 8);
#pragma unroll
              for (int nt = 0; nt < 4; ++nt) { const bf16x8 bb = *(const bf16x8*)(wS + (nt * 16 + l15) * 136 + ks * 32 + q * 8); acc[nt] = MFMA16(a, bb, acc[nt]); } }
#pragma unroll
          for (int ntl = 0; ntl < 2; ++ntl)
#pragma unroll
              for (int r = 0; r < 4; ++r) { const int row = 16 * w + 4 * q + r, cl = ntl * 16 + l15;
                  const float rr = sigmf(acc[ntl][r] + ba[ntl]), ii = sigmf(acc[2 + ntl][r] + bi[ntl]);
                  const float la = -8.f * rr * spl[ntl]; float a = __expf(la); const float uval = bf2f(uA[row * 136 + qd * 32 + cl]);
                  float bt = sqrtf(fmaxf(1.f - a * a, 0.f)) * ii * uval;
                  const bool first = sample ? ((row & 3) == 0) : (tile == 0 && row == 0);
                  if (first) { const float h0 = sample ? pk->state_rg_h[(size_t)(bidx * 32 + (row >> 2)) * 1024 + k * 128 + qd * 32 + cl] : 0.f; bt += a * h0; a = 0.f; }
                  sa[row * 32 + cl] = a; sb[row * 32 + cl] = bt; } }
        __syncthreads();
        const int cl = tid & 31, seg = tid >> 5;
        { float A = 1.f, B = 0.f;
#pragma unroll
          for (int j = 0; j < 8; ++j) { const int row = seg * 8 + j; const float a = sa[row * 32 + cl], bb = sb[row * 32 + cl]; B = a * B + bb; A = a * A; }
          segA[seg * 32 + cl] = A; segB[seg * 32 + cl] = B; }
        __syncthreads();
        float h = hcar[cl];
        for (int s = 0; s < seg; ++s) h = segA[s * 32 + cl] * h + segB[s * 32 + cl];
        const int chg = k * 128 + qd * 32 + cl;
#pragma unroll
        for (int j = 0; j < 8; ++j) { const int row = seg * 8 + j; h = sa[row * 32 + cl] * h + sb[row * 32 + cl];
            const size_t grow = sample ? (size_t)(NTOKP + bidx * 128 + row) : (size_t)(bidx * 2048 + tile * 128 + row);
            mix[grow * DMIX + chg] = f2bf(h * siluf(gts[j]));
            if (sample) { if ((row & 3) == 3) pk->out[O_RGHS + (size_t)(bidx * 32 + (row >> 2)) * 1024 + chg] = h; }
            else if (tile == 15 && row == 127) pk->out[O_RGHP + (size_t)bidx * 1024 + chg] = h; }
        __syncthreads();
        if (seg == 15) hcar[cl] = h;
    }
    if (!sample) { if (tid < 96) { const int jj = tid >> 5, cl = tid & 31, chg = k * 128 + qd * 32 + cl;
            pk->out[O_RGCP + (size_t)(bidx * 3 + jj) * 1024 + chg] = bf2f(proj[(size_t)(bidx * 2048 + 2045 + jj) * NPROJ + C_RGX + chg]); } }
    else { for (int idx = tid; idx < 32 * 3 * 32; idx += 512) { const int cl = idx & 31, jj = (idx >> 5) % 3, sl = idx / 96; const int sbi = bidx * 32 + sl, chg = k * 128 + qd * 32 + cl;
            pk->out[O_RGCS + (size_t)(sbi * 3 + jj) * 1024 + chg] = bf2f(proj[(size_t)(NTOKP + sbi * 4 + 1 + jj) * NPROJ + C_RGX + chg]); } }
}

DI void attnp_item(KP pk_in, int b, int head, int qt) {
    KP pk = pk_in; asm volatile("" : "+s"(pk));
    unsigned char* ws = pk->ws;
    const int tid = otid(), w = tid >> 6, lane = tid & 63, l15 = lane & 15, q = lane >> 4;
    const bf16_t* proj = (const bf16_t*)(ws + W_PROJ); const bf16_t* kb = (const bf16_t*)(ws + W_KB); const bf16_t* vt = (const bf16_t*)(ws + W_VT); bf16_t* mix = (bf16_t*)(ws + W_MIX);
    const int tokb = b * 2048 + qt * 128 + 16 * w;
    bf16x8 qf[8];
#pragma unroll
    for (int ks = 0; ks < 8; ++ks) qf[ks] = *(const bf16x8*)(proj + (size_t)(tokb + l15) * NPROJ + C_Q + head * 256 + ks * 32 + q * 8);
    f32x4 st[16];
#pragma unroll
    for (int mt = 0; mt < 16; ++mt) { st[mt] = (f32x4){0.f, 0.f, 0.f, 0.f}; const bf16_t* kp = kb + (size_t)(b * 256 + 16 * mt + l15) * 1024 + head * 256 + q * 8;
#pragma unroll
        for (int ks = 0; ks < 8; ++ks) { const bf16x8 kf = *(const bf16x8*)(kp + ks * 32); st[mt] = MFMA16(kf, qf[ks], st[mt]); } }
    float mx = -3.0e38f;
#pragma unroll
    for (int mt = 0; mt < 16; ++mt)
#pragma unroll
        for (int r = 0; r < 4; ++r) { st[mt][r] *= 0.0625f; mx = fmaxf(mx, st[mt][r]); }
    mx = fmaxf(mx, shx(mx, 16, lane)); mx = fmaxf(mx, shx(mx, 32, lane));
    float l = 0.f;
#pragma unroll
    for (int mt = 0; mt < 16; ++mt)
#pragma unroll
        for (int r = 0; r < 4; ++r) { const float e = __expf(st[mt][r] - mx); st[mt][r] = e; l += e; }
    l += shx(l, 16, lane); l += shx(l, 32, lane);
    bf16x8 pf[8];
#pragma unroll
    for (int s = 0; s < 8; ++s) { float m8[8] = {st[2 * s][0], st[2 * s][1], st[2 * s][2], st[2 * s][3], st[2 * s + 1][0], st[2 * s + 1][1], st[2 * s + 1][2], st[2 * s + 1][3]}; pf[s] = as_frag(pack8(m8)); }
    float linv[4];
#pragma unroll
    for (int r = 0; r < 4; ++r) linv[r] = 1.f / shl(l, 4 * q + r);
#pragma unroll 2
    for (int dt = 0; dt < 16; ++dt) { f32x4 o = {0.f, 0.f, 0.f, 0.f}; const bf16_t* vp = vt + ((size_t)((b * 4 + head) * 256 + 16 * dt + l15)) * 256 + 4 * q;
        float gt[4];
#pragma unroll
        for (int r = 0; r < 4; ++r) gt[r] = bf2f(proj[(size_t)(tokb + 4 * q + r) * NPROJ + C_XG + head * 256 + 16 * dt + l15]);
#pragma unroll
        for (int s = 0; s < 8; ++s) { const u32x2 lo = *(const u32x2*)(vp + 32 * s), hi = *(const u32x2*)(vp + 32 * s + 16); o = MFMA16(pf[s], frag2(lo, hi), o); }
#pragma unroll
        for (int r = 0; r < 4; ++r) { const size_t tok = (size_t)(tokb + 4 * q + r); const int d = 16 * dt + l15;
            mix[tok * DMIX + 2048 + head * 256 + d] = f2bf(o[r] * linv[r] * siluf(gt[r])); } }
}

DI float wave_sum(float v, int lane) { v += shx(v, 32, lane); v += shx(v, 16, lane); v += shx(v, 8, lane); v += shx(v, 4, lane); v += shx(v, 2, lane); v += shx(v, 1, lane); return v; }
DI float wave_max(float v, int lane) { v = fmaxf(v, shx(v, 32, lane)); v = fmaxf(v, shx(v, 16, lane)); v = fmaxf(v, shx(v, 8, lane)); v = fmaxf(v, shx(v, 4, lane)); v = fmaxf(v, shx(v, 2, lane)); v = fmaxf(v, shx(v, 1, lane)); return v; }

DI void attns_item(KP pk_in, unsigned char* lds, int sbi, int head) {
    KP pk = pk_in; asm volatile("" : "+s"(pk));
    unsigned char* ws = pk->ws;
    const int tid = otid(), w = tid >> 6, lane = tid & 63;
    const bf16_t* proj = (const bf16_t*)(ws + W_PROJ); bf16_t* mix = (bf16_t*)(ws + W_MIX);
    float* qs = (float*)lds; float* sc = qs + 1024; float* ored = sc + 1024;
    __syncthreads();
    for (int idx = tid; idx < 1024; idx += 512) { const int t = idx >> 8, d = idx & 255; qs[idx] = bf2f(proj[(size_t)(NTOKP + sbi * 4 + t) * NPROJ + C_Q + head * 256 + d]); }
    __syncthreads();
    f32x4 qv[4];
#pragma unroll
    for (int t = 0; t < 4; ++t) qv[t] = *(const f32x4*)(qs + t * 256 + lane * 4);
    for (int m0 = w; m0 < 256; m0 += 64) { f32x4 kv[8];
#pragma unroll
        for (int i = 0; i < 8; ++i) kv[i] = *(const f32x4*)(pk->cache_k + ((size_t)(sbi * 256 + m0 + 8 * i) * 4 + head) * 256 + lane * 4);
        float v32[32];
#pragma unroll
        for (int i = 0; i < 8; ++i)
#pragma unroll
            for (int t = 0; t < 4; ++t) v32[i * 4 + t] = kv[i][0] * qv[t][0] + kv[i][1] * qv[t][1] + kv[i][2] * qv[t][2] + kv[i][3] * qv[t][3];
        float v16[16], v8[8], v4[4], v2[2];
        { const bool up = (lane & 32) != 0;
#pragma unroll
          for (int i = 0; i < 16; ++i) { const float keep = up ? v32[i + 16] : v32[i], send = up ? v32[i] : v32[i + 16]; v16[i] = keep + shx(send, 32, lane); } }
        { const bool up = (lane & 16) != 0;
#pragma unroll
          for (int i = 0; i < 8; ++i) { const float keep = up ? v16[i + 8] : v16[i], send = up ? v16[i] : v16[i + 8]; v8[i] = keep + shx(send, 16, lane); } }
        { const bool up = (lane & 8) != 0;
#pragma unroll
          for (int i = 0; i < 4; ++i) { const float keep = up ? v8[i + 4] : v8[i], send = up ? v8[i] : v8[i + 4]; v4[i] = keep + shx(send, 8, lane); } }
        { const bool up = (lane & 4) != 0;
#pragma unroll
          for (int i = 0; i < 2; ++i) { const float keep = up ? v4[i + 2] : v4[i], send = up ? v4[i] : v4[i + 2]; v2[i] = keep + shx(send, 4, lane); } }
        float v1; { const bool up = (lane & 2) != 0; const float keep = up ? v2[1] : v2[0], send = up ? v2[0] : v2[1]; v1 = keep + shx(send, 2, lane); }
        v1 += shx(v1, 1, lane);
        if ((lane & 1) == 0) { const int ii = lane >> 1; sc[(ii & 3) * 256 + m0 + 8 * (ii >> 2)] = v1 * 0.0625f; } }
    __syncthreads();
    if (w < 4) { const f32x4 v = *(const f32x4*)(sc + w * 256 + lane * 4); float mx = fmaxf(fmaxf(v[0], v[1]), fmaxf(v[2], v[3])); mx = wave_max(mx, lane);
        f32x4 e; e[0] = __expf(v[0] - mx); e[1] = __expf(v[1] - mx); e[2] = __expf(v[2] - mx); e[3] = __expf(v[3] - mx); float s = wave_sum(e[0] + e[1] + e[2] + e[3], lane); const float inv = 1.f / s;
        *(f32x4*)(sc + w * 256 + lane * 4) = e * inv; }
    __syncthreads();
    f32x4 acc[4];
#pragma unroll
    for (int t = 0; t < 4; ++t) acc[t] = (f32x4){0.f, 0.f, 0.f, 0.f};
    for (int m0 = w; m0 < 256; m0 += 64) { f32x4 vv[8];
#pragma unroll
        for (int i = 0; i < 8; ++i) vv[i] = *(const f32x4*)(pk->cache_v + ((size_t)(sbi * 256 + m0 + 8 * i) * 4 + head) * 256 + lane * 4);
#pragma unroll
        for (int i = 0; i < 8; ++i)
#pragma unroll
            for (int t = 0; t < 4; ++t) acc[t] += vv[i] * sc[t * 256 + m0 + 8 * i]; }
#pragma unroll
    for (int t = 0; t < 4; ++t) *(f32x4*)(ored + (w * 4 + t) * 256 + lane * 4) = acc[t];
    __syncthreads();
    for (int idx = tid; idx < 1024; idx += 512) { const int t = idx >> 8, d = idx & 255; float s = 0.f;
#pragma unroll
        for (int ww = 0; ww < 8; ++ww) s += ored[(ww * 4 + t) * 256 + d];
        const size_t tok = (size_t)(NTOKP + sbi * 4 + t); const float gate = bf2f(proj[tok * NPROJ + C_XG + head * 256 + d]); mix[tok * DMIX + 2048 + head * 256 + d] = f2bf(s * siluf(gate)); }
}

DI void ssds_item(KP pk_in, unsigned char* lds, int sbi, int g) {
    KP pk = pk_in; asm volatile("" : "+s"(pk));
    unsigned char* ws = pk->ws;
    const int tid = otid(), w = tid >> 6, lane = tid & 63;
    const bf16_t* proj = (const bf16_t*)(ws + W_PROJ); bf16_t* mix = (bf16_t*)(ws + W_MIX); const float* wdf = (const float*)(ws + W_WDTF);
    float* xs = (float*)lds; float* Bs = xs + 2048; float* Cs = Bs + 512; float* yg = Cs + 512; float* dts = yg + 2048; float* decs = dts + 32;
    __syncthreads();
#pragma unroll
    for (int d = 0; d < 4; ++d) { const int pi = w * 4 + d, t = pi & 3, hl = pi >> 2, h = 8 * g + hl; float s = 0.f;
#pragma unroll
        for (int i = 0; i < 4; ++i) { const f32x4 xv = *(const f32x4*)(pk->x_sample + (size_t)(sbi * 4 + t) * 1024 + i * 256 + lane * 4), wv = *(const f32x4*)(wdf + h * 1024 + i * 256 + lane * 4);
            s += xv[0] * wv[0] + xv[1] * wv[1] + xv[2] * wv[2] + xv[3] * wv[3]; }
        s = wave_sum(s, lane);
        if (lane == 0) { const float dt = softplusf(s + pk->ssd_dt_bias[h]); dts[t * 8 + hl] = dt; decs[t * 8 + hl] = __expf(-dt * __expf(pk->ssd_a_log[h])); } }
    for (int idx = tid; idx < 4 * 768; idx += 512) { const int t = idx / 768, cc = idx % 768; const int ch = cc < 512 ? g * 512 + cc : (cc < 640 ? 1024 + g * 128 + (cc - 512) : 1280 + g * 128 + (cc - 640));
        float acc = pk->ssd_conv_b[ch];
#pragma unroll
        for (int kk = 0; kk < 4; ++kk) { const int ui = t + kk; const float x = ui < 3 ? pk->state_ssd_conv[(size_t)(sbi * 3 + ui) * 1536 + ch] : bf2f(proj[(size_t)(NTOKP + sbi * 4 + ui - 3) * NPROJ + C_XBC + ch]);
            acc += x * pk->ssd_conv_w[kk * 1536 + ch]; }
        const float a = siluf(acc);
        if (cc < 512) xs[t * 512 + cc] = a; else if (cc < 640) Bs[t * 128 + cc - 512] = a; else Cs[t * 128 + cc - 640] = a; }
    for (int idx = tid; idx < 3 * 768; idx += 512) { const int jj = idx / 768, cc = idx % 768; const int ch = cc < 512 ? g * 512 + cc : (cc < 640 ? 1024 + g * 128 + (cc - 512) : 1280 + g * 128 + (cc - 640));
        pk->out[O_SCS + (size_t)(sbi * 3 + jj) * 1536 + ch] = bf2f(proj[(size_t)(NTOKP + sbi * 4 + 1 + jj) * NPROJ + C_XBC + ch]); }
    __syncthreads();
    const int pp = tid >> 3, n0 = (tid & 7) * 16;
    f32x4 hs[4], hn[4];
#pragma unroll
    for (int v = 0; v < 4; ++v) hn[v] = *(const f32x4*)(pk->state_ssd_h + ((size_t)(sbi * 16 + 8 * g) * 64 + pp) * 128 + n0 + v * 4);
    for (int hl = 0; hl < 8; ++hl) { const int h = 8 * g + hl; const size_t so = ((size_t)(sbi * 16 + h) * 64 + pp) * 128 + n0;
#pragma unroll
        for (int v = 0; v < 4; ++v) hs[v] = hn[v];
        if (hl < 7) {
#pragma unroll
            for (int v = 0; v < 4; ++v) hn[v] = *(const f32x4*)(pk->state_ssd_h + so + 8192 + v * 4); }
        const float dsk = pk->ssd_d[h];
#pragma unroll
        for (int t = 0; t < 4; ++t) { const float dec = decs[t * 8 + hl], xv = xs[t * 512 + hl * 64 + pp], dtx = dts[t * 8 + hl] * xv; float part = 0.f;
#pragma unroll
            for (int v = 0; v < 4; ++v) { const f32x4 bv = *(const f32x4*)(Bs + t * 128 + n0 + v * 4), cv = *(const f32x4*)(Cs + t * 128 + n0 + v * 4);
                hs[v] = hs[v] * dec + bv * dtx; part += cv[0] * hs[v][0] + cv[1] * hs[v][1] + cv[2] * hs[v][2] + cv[3] * hs[v][3]; }
            part += shx(part, 1, lane); part += shx(part, 2, lane); part += shx(part, 4, lane);
            if ((tid & 7) == 0) { const float y = part + dsk * xv; const float z = bf2f(proj[(size_t)(NTOKP + sbi * 4 + t) * NPROJ + C_Z + h * 64 + pp]); yg[t * 512 + hl * 64 + pp] = y * siluf(z); } }
#pragma unroll
        for (int v = 0; v < 4; ++v) *(f32x4*)(pk->out + O_SHS + so + v * 4) = hs[v];
    }
    __syncthreads();
    if (w < 4) { const int t = w; float ss = 0.f; float v[8];
#pragma unroll
        for (int e = 0; e < 8; ++e) { v[e] = yg[t * 512 + e * 64 + lane]; ss += v[e] * v[e]; }
        ss = wave_sum(ss, lane); const float rstd = rsqrtf(ss * (1.f / 512.f) + 1e-5f);
#pragma unroll
        for (int e = 0; e < 8; ++e) { const int cc = e * 64 + lane; mix[(size_t)(NTOKP + sbi * 4 + t) * DMIX + 1024 + g * 512 + cc] = f2bf(v[e] * rstd * pk->ssd_norm_g[g * 512 + cc]); } }
}

DI void ssd3_item(KP pk_in, unsigned char* lds, int b, int c, int g) {
    KP pk = pk_in; asm volatile("" : "+s"(pk));
    unsigned char* ws = pk->ws;
    const int tid = otid(), w = tid >> 6, lane = tid & 63, l15 = lane & 15, q = lane >> 4;
    float* acum_s = (float*)lds; float* dt_s = acum_s + 1024;
    bf16_t* xT = (bf16_t*)(lds + 8192);
    const bf16_t* proj = (const bf16_t*)(ws + W_PROJ); const bf16_t* xact = (const bf16_t*)(ws + W_XACT); bf16_t* mix = (bf16_t*)(ws + W_MIX);
    const float* dt_g = (const float*)(ws + W_DT); const float* acum_g = (const float*)(ws + W_ACUM); const float* st_g = (const float*)(ws + W_ST);
    const int tok0 = b * 2048 + c * 128;
    __syncthreads();
    for (int idx = tid; idx < 1024; idx += 512) { const int j = idx >> 3, hl = idx & 7; acum_s[idx] = acum_g[(size_t)(tok0 + j) * 16 + 8 * g + hl]; dt_s[idx] = dt_g[(size_t)(tok0 + j) * 16 + 8 * g + hl]; }
    bf16x8 cf[4];
#pragma unroll
    for (int ks = 0; ks < 4; ++ks) cf[ks] = *(const bf16x8*)(xact + (size_t)(tok0 + 16 * w + l15) * 1536 + 1280 + g * 128 + ks * 32 + q * 8);
    f32x4 cbt[8];
#pragma unroll
    for (int jt = 0; jt < 8; ++jt) { cbt[jt] = (f32x4){0.f, 0.f, 0.f, 0.f};
        if (jt <= w) {
#pragma unroll
            for (int ks = 0; ks < 4; ++ks) { const bf16x8 bfr = *(const bf16x8*)(xact + (size_t)(tok0 + 16 * jt + l15) * 1536 + 1024 + g * 128 + ks * 32 + q * 8); cbt[jt] = MFMA16(bfr, cf[ks], cbt[jt]); } } }
    float ssq[4] = {0.f, 0.f, 0.f, 0.f};
    const int irow = 16 * w + l15;
    for (int hl = 0; hl < 8; ++hl) { const int h = 8 * g + hl;
        __syncthreads();
        for (int idx = tid; idx < 1024; idx += 512) { const int j = idx >> 3, pv = (idx & 7) * 8; const u32x4 v = *(const u32x4*)(xact + (size_t)(tok0 + j) * 1536 + g * 512 + hl * 64 + pv);
            const bf16_t* e16 = (const bf16_t*)&v; (void)e16;
            xT[(pv + 0) * 136 + j] = (bf16_t)(v.x & 0xFFFF); xT[(pv + 1) * 136 + j] = (bf16_t)(v.x >> 16); xT[(pv + 2) * 136 + j] = (bf16_t)(v.y & 0xFFFF); xT[(pv + 3) * 136 + j] = (bf16_t)(v.y >> 16);
            xT[(pv + 4) * 136 + j] = (bf16_t)(v.z & 0xFFFF); xT[(pv + 5) * 136 + j] = (bf16_t)(v.z >> 16); xT[(pv + 6) * 136 + j] = (bf16_t)(v.w & 0xFFFF); xT[(pv + 7) * 136 + j] = (bf16_t)(v.w >> 16); }
        __syncthreads();
        const float ai = acum_s[irow * 8 + hl];
        bf16x8 af[4];
#pragma unroll
        for (int s = 0; s < 4; ++s) { float m8[8];
#pragma unroll
            for (int hf = 0; hf < 2; ++hf) { const int jt = 2 * s + hf;
#pragma unroll
                for (int r = 0; r < 4; ++r) { const int j = 16 * jt + 4 * q + r; float val = 0.f;
                    if (jt <= w && j <= irow) val = cbt[jt][r] * __expf(ai - acum_s[j * 8 + hl]) * dt_s[j * 8 + hl];
                    m8[hf * 4 + r] = val; } }
            af[s] = as_frag(pack8(m8)); }
        const float dsk = pk->ssd_d[h];
        float ea[4];
#pragma unroll
        for (int r = 0; r < 4; ++r) ea[r] = __expf(acum_s[(16 * w + 4 * q + r) * 8 + hl]);
        float zz[4][4];
#pragma unroll
        for (int pt = 0; pt < 4; ++pt)
#pragma unroll
            for (int r = 0; r < 4; ++r) zz[pt][r] = bf2f(proj[(size_t)(tok0 + 16 * w + 4 * q + r) * NPROJ + C_Z + h * 64 + 16 * pt + l15]);
#pragma unroll
        for (int pt = 0; pt < 4; ++pt) { f32x4 yd = {0.f, 0.f, 0.f, 0.f}, yo = {0.f, 0.f, 0.f, 0.f};
            const bf16_t* xr = xT + (16 * pt + l15) * 136;
#pragma unroll
            for (int s = 0; s < 4; ++s) if (2 * s <= w) { const u32x2 lo = *(const u32x2*)(xr + 32 * s + 4 * q), hi = *(const u32x2*)(xr + 32 * s + 16 + 4 * q); yd = MFMA16(af[s], frag2(lo, hi), yd); }
            const float* hp = st_g + ((size_t)((b * 16 + c) * 16 + h) * 64 + 16 * pt + l15) * 128 + q * 8;
#pragma unroll
            for (int ks = 0; ks < 4; ++ks) { const f32x4 f0 = *(const f32x4*)(hp + ks * 32), f1 = *(const f32x4*)(hp + ks * 32 + 4); float m8[8] = {f0[0], f0[1], f0[2], f0[3], f1[0], f1[1], f1[2], f1[3]};
                yo = MFMA16(cf[ks], as_frag(pack8(m8)), yo); }
            const u32x2 xv2 = *(const u32x2*)(xr + 16 * w + 4 * q); const float xv[4] = {bflo(xv2.x), bfhi(xv2.x), bflo(xv2.y), bfhi(xv2.y)};
#pragma unroll
            for (int r = 0; r < 4; ++r) { const size_t tok = (size_t)(tok0 + 16 * w + 4 * q + r); const int pp = 16 * pt + l15;
                const float y = yd[r] + ea[r] * yo[r] + dsk * xv[r]; const float val = y * siluf(zz[pt][r]);
                ssq[r] += val * val; mix[tok * DMIX + 1024 + g * 512 + hl * 64 + pp] = f2bf(val); } }
    }
    float rstd[4];
#pragma unroll
    for (int r = 0; r < 4; ++r) { float s = ssq[r]; s += shx(s, 1, lane); s += shx(s, 2, lane); s += shx(s, 4, lane); s += shx(s, 8, lane); rstd[r] = rsqrtf(s * (1.f / 512.f) + 1e-5f); }
    for (int hl = 0; hl < 8; ++hl)
#pragma unroll
        for (int pt = 0; pt < 4; ++pt) { const int cc = hl * 64 + 16 * pt + l15; const float gn = pk->ssd_norm_g[g * 512 + cc];
#pragma unroll
            for (int r = 0; r < 4; ++r) { bf16_t* mp = mix + (size_t)(tok0 + 16 * w + 4 * q + r) * DMIX + 1024 + g * 512 + cc; *mp = f2bf(bf2f(*mp) * rstd[r] * gn); } }
}

DI void ln_rows(KP pk_in) {
    KP pk = pk_in; asm volatile("" : "+s"(pk));
    const float* res = (const float*)(pk->ws + W_RES);
    const int tid = otid(); const int lane = tid & 63; const int gw = obid() * 8 + (tid >> 6), nw = gridDim.x * 8;
    f32x4 gg[4], bb[4];
#pragma unroll
    for (int i = 0; i < 4; ++i) { gg[i] = *(const f32x4*)(pk->ln_g + i * 256 + lane * 4); bb[i] = *(const f32x4*)(pk->ln_b + i * 256 + lane * 4); }
    for (int row = gw; row < NTOK; row += nw) { f32x4 v[4]; float s = 0.f;
#pragma unroll
        for (int i = 0; i < 4; ++i) { v[i] = *(const f32x4*)(res + (size_t)row * 1024 + i * 256 + lane * 4); s += v[i][0] + v[i][1] + v[i][2] + v[i][3]; }
        const float mu = wave_sum(s, lane) * (1.f / 1024.f); float s2 = 0.f;
#pragma unroll
        for (int i = 0; i < 4; ++i) { v[i] = v[i] - mu; s2 += v[i][0] * v[i][0] + v[i][1] * v[i][1] + v[i][2] * v[i][2] + v[i][3] * v[i][3]; }
        const float rstd = rsqrtf(wave_sum(s2, lane) * (1.f / 1024.f) + 1e-5f);
#pragma unroll
        for (int i = 0; i < 4; ++i) *(f32x4*)(pk->out + (size_t)row * 1024 + i * 256 + lane * 4) = v[i] * rstd * gg[i] + bb[i]; }
}

__global__ void __launch_bounds__(512, 2) hymba_fwd(Params p_unused) {
    KP pk = kparams();
    extern __shared__ __attribute__((aligned(16))) unsigned char shm[];
    cg::grid_group grid = cg::this_grid();
    const int G = gridDim.x;
    if (threadIdx.x < 4) ((volatile LAS unsigned*)(LAS unsigned char*)shm)[32768 + threadIdx.x] = 0u;
    __syncthreads();
    const int ph_lo_chk = pk->ph_lo;
    XcdBarrier xb = xcd_barrier_post((unsigned*)(pk->ws + W_BAR), (volatile LAS unsigned*)(LAS unsigned char*)shm + 32768);
    if (ph_lo_chk < 0) grid.sync();
    { KP pk = kparams(); for (int rep = 0; rep < REP0; ++rep) phase_prep(pk, shm); }
    xcd_barrier(xb);
    { KP pk = kparams(); const int bid = obid();
      for (int rep = 0; rep < REP1; ++rep) {
        { pg8::Gemm g; g.A = (const bf16_t*)(pk->ws + W_XB); g.Bt = (const bf16_t*)(pk->ws + W_WINT); g.M = NTOK; g.N = NPROJ; g.K = 1024;
          pg8::StaticOrder S; S.init(g.M, g.N, G, bid); pg8::EpiBf16 E; E.O = (bf16_t*)(pk->ws + W_PROJ); E.ldc = NPROJ;
          pg8::gemm_phase<pg8::EpiBf16, pg8::StaticOrder>((LAS unsigned char*)shm, g, S, E); }
        { pg8::Gemm g; g.A = (const bf16_t*)(pk->ws + W_MEMB); g.Bt = (const bf16_t*)(pk->ws + W_WKVT); g.M = 2048; g.N = 2048; g.K = 1024;
          const int shift = (66 * 26) % G; pg8::StaticOrder S; S.init(g.M, g.N, G, (bid + G - shift) % G);
          pg8::EpiKV E; E.mk = pk->out + O_MKP; E.mv = pk->out + O_MVP; E.kb = (bf16_t*)(pk->ws + W_KB); E.vt = (bf16_t*)(pk->ws + W_VT);
          pg8::gemm_phase<pg8::EpiKV, pg8::StaticOrder>((LAS unsigned char*)shm, g, S, E); } } }
    xcd_barrier(xb);
    { KP pk = kparams(); const int bid = obid();
      for (int rep = 0; rep < REP2; ++rep) for (int it = bid; it < 256; it += G) ssd1_item(pk, shm, it >> 5, (it >> 1) & 15, it & 1); }
    xcd_barrier(xb);
    { KP pk = kparams(); const int bid = obid();
      for (int rep = 0; rep < REP3; ++rep) for (int it = bid; it < 1920; it += G) {
          if (rep > 0 && (it < R3LO || it >= R3HI)) continue;
          if (it < 256) rg_item(pk, shm, false, it >> 5, (it >> 2) & 7, it & 3);
          else if (it < 512) statepass_item(pk, it - 256);
          else if (it < 640) { const int u = it - 512; rg_item(pk, shm, true, u >> 5, (u >> 2) & 7, u & 3); }
          else if (it < 896) { const int u = it - 640; ssds_item(pk, shm, u >> 1, u & 1); }
          else if (it < 1408) { const int u = it - 896; attns_item(pk, shm, u >> 2, u & 3); }
          else { const int u = it - 1408; attnp_item(pk, u >> 6, (u >> 4) & 3, u & 15); } } }
    xcd_barrier(xb);
    { KP pk = kparams(); const int bid = obid();
      for (int rep = 0; rep < REP4; ++rep) for (int it = bid; it < 256; it += G) ssd3_item(pk, shm, it >> 5, (it >> 1) & 15, it & 1); }
    xcd_barrier(xb);
    { KP pk = kparams(); const int bid = obid();
      for (int rep = 0; rep < REP5; ++rep) {
        pg8::Gemm g; g.A = (const bf16_t*)(pk->ws + W_MIX); g.Bt = (const bf16_t*)(pk->ws + W_WOUTT); g.M = NTOK; g.N = 1024; g.K = 3072;
        pg8::StaticOrder S; S.init(g.M, g.N, G, bid); pg8::EpiRes E; E.res = (float*)(pk->ws + W_RES); E.xp = pk->x_prompt; E.xs = pk->x_sample; E.alpha = 1.189207115002721f;
        pg8::gemm_phase<pg8::EpiRes, pg8::StaticOrder>((LAS unsigned char*)shm, g, S, E); } }
    xcd_barrier(xb);
    { KP pk = kparams(); for (int rep = 0; rep < REP6; ++rep) ln_rows(pk); }
}

extern "C" void kernel_launch(void* const* d_in, const int* in_sizes, int n_in, void* d_out, int out_size, void* d_ws, size_t ws_size, hipStream_t stream) {
    static int grid_blocks = 0;
    if (!grid_blocks) {
        int dev = 0, cus = 0, per_cu = 0;
        hipGetDevice(&dev);
        hipDeviceGetAttribute(&cus, hipDeviceAttributeMultiprocessorCount, dev);
        if (hipFuncSetAttribute((const void*)hymba_fwd, hipFuncAttributeMaxDynamicSharedMemorySize, LDS_BYTES) != hipSuccess) fprintf(stderr, "hipFuncSetAttribute failed\n");
        hipOccupancyMaxActiveBlocksPerMultiprocessor(&per_cu, (const void*)hymba_fwd, 512, LDS_BYTES);
        if (per_cu < 1) { fprintf(stderr, "occupancy query says %d blocks per CU\n", per_cu); per_cu = 1; }
        grid_blocks = cus * 1;
        if (ws_size < W_END) fprintf(stderr, "workspace too small: %zu < %zu\n", ws_size, (size_t)W_END);
    }
    if (hipMemsetAsync((char*)d_ws + W_BAR, 0, 3456 * 4, stream) != hipSuccess) fprintf(stderr, "memset failed\n");
    Params p{};
    const float** fp = (const float**)&p;
    for (int i = 0; i < 28; ++i) fp[i] = (const float*)d_in[i];
    p.out = (float*)d_out; p.ws = (unsigned char*)d_ws;
    p.ph_lo = 0; p.ph_hi = NPHASE;
    void* args[] = {&p};
    hipError_t e = hipLaunchCooperativeKernel((const void*)hymba_fwd, dim3(grid_blocks), dim3(512), args, LDS_BYTES, stream);
    if (e != hipSuccess) fprintf(stderr, "cooperative launch failed: %s (grid %d)\n", hipGetErrorString(e), grid_blocks);
}
```

```cpp
#include <hip/hip_runtime.h>
#include <hip/hip_cooperative_groups.h>
#include <cstdio>
namespace cg = cooperative_groups;

#ifndef REP2
#define REP2 1
#endif
#ifndef REP3
#define REP3 1
#endif
#ifndef REP4
#define REP4 1
#endif
#ifndef R3LO
#define R3LO 0
#define R3HI 256
#endif
#ifndef REP0
#define REP0 1
#endif
#ifndef REP1
#define REP1 1
#endif
#ifndef REP5
#define REP5 1
#endif
#ifndef REP6
#define REP6 1
#endif
#ifndef REPS
#define REPS 1
#endif
#ifndef PHM
#define PHM 127
#endif
#ifndef N_LAUNCH_PER_PHASE
#define N_LAUNCH_PER_PHASE 0
#endif

#define DI __device__ __forceinline__
#define LAS __attribute__((address_space(3)))
typedef unsigned short bf16_t;
typedef short bf16x8 __attribute__((ext_vector_type(8)));
typedef float f32x4 __attribute__((ext_vector_type(4)));
typedef unsigned u32x4 __attribute__((ext_vector_type(4)));
typedef unsigned u32x2 __attribute__((ext_vector_type(2)));

constexpr int NTOKP = 16384, NTOKS = 512, NTOK = 16896, DM = 1024, NPROJ = 6656, DMIX = 3072, DIN = 6672;
constexpr int C_RGX = 0, C_RGG = 1024, C_XBC = 2048, C_Z = 3584, C_Q = 4608, C_XG = 5632;
constexpr int NPHASE = 7;
constexpr int LDS_BYTES = 131072 + 64;

constexpr size_t O_YP = 0, O_YS = O_YP + (size_t)NTOKP * DM, O_RGCP = O_YS + (size_t)NTOKS * DM, O_RGHP = O_RGCP + 8 * 3 * 1024, O_SCP = O_RGHP + 8 * 1024,
                 O_SHP = O_SCP + 8 * 3 * 1536, O_MKP = O_SHP + (size_t)8 * 16 * 64 * 128, O_MVP = O_MKP + (size_t)2048 * 1024, O_RGCS = O_MVP + (size_t)2048 * 1024,
                 O_RGHS = O_RGCS + (size_t)128 * 3 * 1024, O_SCS = O_RGHS + 128 * 1024, O_SHS = O_SCS + (size_t)128 * 3 * 1536;

constexpr size_t al256(size_t x) { return (x + 255) & ~(size_t)255; }
constexpr size_t W_XB = 0;
constexpr size_t W_WINT = al256(W_XB + (size_t)NTOK * DM * 2);
constexpr size_t W_WDTT = al256(W_WINT + (size_t)NPROJ * DM * 2);
constexpr size_t W_WDTF = al256(W_WDTT + 16 * 1024 * 2);
constexpr size_t W_WOUTT = al256(W_WDTF + 16 * 1024 * 4);
constexpr size_t W_WKVT = al256(W_WOUTT + (size_t)1024 * 3072 * 2);
constexpr size_t W_MEMB = al256(W_WKVT + (size_t)2048 * 1024 * 2);
constexpr size_t W_WGT = al256(W_MEMB + (size_t)2048 * 1024 * 2);
constexpr size_t W_KB = al256(W_WGT + (size_t)8 * 4 * 64 * 128 * 2);
constexpr size_t W_VT = al256(W_KB + (size_t)2048 * 1024 * 2);
constexpr size_t W_XACT = al256(W_VT + (size_t)2048 * 1024 * 2);
constexpr size_t W_DT = al256(W_XACT + (size_t)NTOKP * 1536 * 2);
constexpr size_t W_ACUM = al256(W_DT + (size_t)NTOKP * 16 * 4);
constexpr size_t W_CD = al256(W_ACUM + (size_t)NTOKP * 16 * 4);
constexpr size_t W_ST = al256(W_CD + 8 * 16 * 16 * 4);
constexpr size_t W_MIX = al256(W_ST + (size_t)8 * 16 * 16 * 8192 * 4);
constexpr size_t W_PROJ = al256(W_MIX + (size_t)NTOK * DMIX * 2);
constexpr size_t W_RES = W_PROJ;
constexpr size_t W_BAR = al256(W_PROJ + (size_t)NTOK * NPROJ * 2);
constexpr size_t W_END = al256(W_BAR + 3456 * 4);

struct Params {
    const float *x_prompt, *x_sample, *mem_prompt, *state_rg_conv, *state_rg_h, *state_ssd_conv, *state_ssd_h, *cache_k, *cache_v;
    const float *w_in, *rg_conv_w, *rg_conv_b, *w_rg_a, *b_rg_a, *w_rg_i, *b_rg_i, *rg_lambda, *ssd_conv_w, *ssd_conv_b, *ssd_dt_bias, *ssd_a_log, *ssd_d, *ssd_norm_g,
        *w_mem_k, *w_mem_v, *w_out, *ln_g, *ln_b;
    float* out; unsigned char* ws;
    int ph_lo, ph_hi;
};
typedef const __attribute__((address_space(4))) Params* KP;
DI KP kparams() { KP k = (KP)__builtin_amdgcn_kernarg_segment_ptr(); asm volatile("" : "+s"(k)); return k; }

DI int otid() { int t = threadIdx.x; asm volatile("" : "+v"(t)); return t; }
DI int obid() { int t = blockIdx.x; asm volatile("" : "+s"(t)); return t; }
DI float bf2f(bf16_t b) { return __uint_as_float(((unsigned)b) << 16); }
DI bf16_t f2bf(float f) { unsigned u = __float_as_uint(f); u += 0x7FFFu + ((u >> 16) & 1u); return (bf16_t)(u >> 16); }
DI unsigned pack2(float lo, float hi) { return (unsigned)f2bf(lo) | ((unsigned)f2bf(hi) << 16); }
DI float bflo(unsigned w) { return __uint_as_float(w << 16); }
DI float bfhi(unsigned w) { return __uint_as_float(w & 0xFFFF0000u); }
DI void unpack8(const u32x4 v, float (&o)[8]) { o[0] = bflo(v.x); o[1] = bfhi(v.x); o[2] = bflo(v.y); o[3] = bfhi(v.y); o[4] = bflo(v.z); o[5] = bfhi(v.z); o[6] = bflo(v.w); o[7] = bfhi(v.w); }
DI u32x4 pack8(const float (&o)[8]) { u32x4 w; w.x = pack2(o[0], o[1]); w.y = pack2(o[2], o[3]); w.z = pack2(o[4], o[5]); w.w = pack2(o[6], o[7]); return w; }
DI bf16x8 as_frag(u32x4 w) { return __builtin_bit_cast(bf16x8, w); }
DI bf16x8 frag2(u32x2 lo, u32x2 hi) { u32x4 w; w.x = lo.x; w.y = lo.y; w.z = hi.x; w.w = hi.y; return __builtin_bit_cast(bf16x8, w); }
DI float shx(float v, int m, int lane) { return __int_as_float(__builtin_amdgcn_ds_bpermute((lane ^ m) << 2, __float_as_int(v))); }
DI float shl(float v, int src) { return __int_as_float(__builtin_amdgcn_ds_bpermute(src << 2, __float_as_int(v))); }
DI float siluf(float x) { return x / (1.f + __expf(-x)); }
DI float sigmf(float x) { return 1.f / (1.f + __expf(-x)); }
DI float softplusf(float v) { return v > 20.f ? v : __logf(1.f + __expf(v)); }
#define MFMA16(a, b, c) __builtin_amdgcn_mfma_f32_16x16x32_bf16((a), (b), (c), 0, 0, 0)

#define XB_TMO      128
#define XB_XCNT(j)  (256  + 64 * (j))
#define XB_XSUB(j)  (1280 + 64 * (j))
#define XB_XGEN(j)  (2304 + 64 * (j))
#define XB_TOP      3328
#define XB_TOPGEN   3392
#define XCD_BAR_WORDS 3456
#define XB_SPIN_CAP (1u << 20)
DI unsigned xb_ld(unsigned* ptr)              { return __hip_atomic_load(ptr, __ATOMIC_RELAXED, __HIP_MEMORY_SCOPE_AGENT); }
DI unsigned xb_add(unsigned* ptr, unsigned v) { return __hip_atomic_fetch_add(ptr, v, __ATOMIC_RELAXED, __HIP_MEMORY_SCOPE_AGENT); }
DI unsigned xb_xcc_id() { return (unsigned)__builtin_amdgcn_s_getreg((3 << 11) | 20) & 0xFu; }
#define XB_SPIN(cond, bar) do { unsigned _sp = 0; while (cond) { __builtin_amdgcn_s_sleep(1); \
    if ((++_sp & 255u) == 0u) { if (xb_ld(&(bar)[XB_TMO])) break; if (_sp > XB_SPIN_CAP) { atomicAdd(&(bar)[XB_TMO], 1u); break; } } } } while (0)
struct XcdBarrier { unsigned* bar; unsigned x; volatile LAS unsigned* st; };
DI XcdBarrier xcd_barrier_post(unsigned* bar, volatile LAS unsigned* st) {
    XcdBarrier b; b.bar = bar; b.x = xb_xcc_id(); b.st = st;
    if (threadIdx.x == 0) (void)xb_add(&bar[XB_XCNT(b.x)], 1u);
    return b;
}
DI void xcd_barrier_complete(unsigned* bar, unsigned x, unsigned& nloc, unsigned& nx) {
    const unsigned G = gridDim.x * gridDim.y * gridDim.z;
    unsigned sum, cnt, mine, sp = 0u;
    for (;;) {
        sum = 0u; cnt = 0u; mine = 0u;
#pragma unroll
        for (unsigned j = 0; j < 16; ++j) { const unsigned c = xb_ld(&bar[XB_XCNT(j)]); sum += c; cnt += (c > 0u) ? 1u : 0u; mine = (j == x) ? c : mine; }
        if (sum == G) break;
        __builtin_amdgcn_s_sleep(1);
        if ((++sp & 255u) == 0u) { if (xb_ld(&bar[XB_TMO])) break; if (sp > XB_SPIN_CAP) { atomicAdd(&bar[XB_TMO], 1u); break; } }
    }
    nloc = mine > 0u ? mine : 1u; nx = cnt > 0u ? cnt : 1u;
}
DI void xcd_barrier(const XcdBarrier& b) {
    asm volatile("s_waitcnt vmcnt(0)" ::: "memory");
    __syncthreads();
    if (threadIdx.x == 0) {
        unsigned* bar = b.bar;
        __builtin_amdgcn_s_waitcnt(0);
        unsigned nloc = b.st[0], nx = b.st[1];
        if (nloc == 0u) { xcd_barrier_complete(bar, b.x, nloc, nx); b.st[0] = nloc; b.st[1] = nx; }
        const unsigned old = xb_add(&bar[XB_XSUB(b.x)], 1u);
        const unsigned gen = old / nloc;
        if (old + 1u == (gen + 1u) * nloc) {
            __builtin_amdgcn_fence(__ATOMIC_RELEASE, "agent");
            asm volatile("s_waitcnt vmcnt(0)" ::: "memory");
            const unsigned og = xb_add(&bar[XB_TOP], 1u);
            const unsigned tg = og / nx;
            if (og + 1u == (tg + 1u) * nx) xb_add(&bar[XB_TOPGEN], 1u);
            else XB_SPIN(xb_ld(&bar[XB_TOPGEN]) == tg, bar);
            __builtin_amdgcn_fence(__ATOMIC_ACQUIRE, "agent");
            xb_add(&bar[XB_XGEN(b.x)], 1u);
            asm volatile("s_waitcnt vmcnt(0)" ::: "memory");
        } else {
            XB_SPIN(xb_ld(&bar[XB_XGEN(b.x)]) == gen, bar);
            __builtin_amdgcn_fence(__ATOMIC_ACQUIRE, "agent");
            asm volatile("s_waitcnt vmcnt(0)" ::: "memory");
        }
    }
    __syncthreads();
}

namespace pg8 {
constexpr int BM = 256, BK = 64, HALF = 128, HTB = HALF * BK * 2, STAGE_BYTES = 8 * HTB, NXCD = 8, WGM = 8;
DI int lds_byte(int r, int c) { const int st = (r >> 4) * 2 + (c >> 5), rr = r & 15, cc = c & 31, ob = rr * 64 + cc * 2; return st * 1024 + (ob ^ (((ob >> 9) & 1) << 5)); }
DI void stage_rc(int b, int& R, int& C) { const int st = b / 1024, sb = b % 1024, swz = sb ^ (((sb >> 9) & 1) << 5); R = (st >> 1) * 16 + swz / 64; C = (st & 1) * 32 + (swz % 64) / 2; }
DI int perm32(int rho) { const int n = rho >> 4, i = rho & 15; return 8 * (i >> 2) + 4 * n + (i & 3); }
struct Unit { int pm, pn; };
struct Gemm { const bf16_t* A; const bf16_t* Bt; int M, N, K; };
struct StaticOrder {
    int nM, nN, nwg, G, c;
    DI void init(int M, int N, int G_, int c_) { nM = M / BM; nN = N / BM; nwg = nM * nN; G = G_; c = c_; }
    DI bool next(int i, Unit& u) const {
        const long L = (long)i * G + c; if (L >= nwg) return false;
        int wgid = (int)L; { const int q = nwg / NXCD, r = nwg % NXCD, xcd = wgid % NXCD, off = wgid / NXCD; wgid = (xcd < r ? xcd * (q + 1) : r * (q + 1) + (xcd - r) * q) + off; }
        const int nig = WGM * nN, gid = wgid / nig, fm = gid * WGM, gsz = (nM - fm) < WGM ? (nM - fm) : WGM;
        u.pm = fm + ((wgid % nig) % gsz); u.pn = (wgid % nig) / gsz; return true;
    }
};
DI unsigned cvt_pk_bf16(float lo, float hi) { unsigned r; asm volatile("v_cvt_pk_bf16_f32 %0, %1, %2" : "=v"(r) : "v"(lo), "v"(hi)); return r; }

struct EpiBf16 {
    static constexpr bool PERM = true;
    bf16_t* O; int ldc;
    DI void operator()(const f32x4 (&acc)[2][2][4][2], const Unit& u, int wr, int wc, int fr, int fq) const {
        const int row0 = u.pm * BM + wr * 64 + fr; const int col0 = u.pn * BM + wc * 32 + 8 * fq;
#pragma unroll
        for (int ai = 0; ai < 2; ++ai)
#pragma unroll
            for (int m = 0; m < 4; ++m) { bf16_t* rowp = O + (size_t)(row0 + ai * HALF + m * 16) * ldc + col0;
#pragma unroll
                for (int bj = 0; bj < 2; ++bj) { const f32x4 v0 = acc[ai][bj][m][0], v1 = acc[ai][bj][m][1];
                    u32x4 w; w.x = cvt_pk_bf16(v0[0], v0[1]); w.y = cvt_pk_bf16(v0[2], v0[3]); w.z = cvt_pk_bf16(v1[0], v1[1]); w.w = cvt_pk_bf16(v1[2], v1[3]);
                    *(u32x4*)(rowp + bj * HALF) = w; } }
    }
};
struct EpiKV {
    static constexpr bool PERM = false;
    float* mk; float* mv; bf16_t* kb; bf16_t* vt;
    DI void operator()(const f32x4 (&acc)[2][2][4][2], const Unit& u, int wr, int wc, int fr, int fq) const {
        const int row0 = u.pm * BM + wr * 64 + fr, col0 = u.pn * BM + wc * 32 + 4 * fq;
#pragma unroll
        for (int ai = 0; ai < 2; ++ai)
#pragma unroll
            for (int m = 0; m < 4; ++m) { const int row = row0 + ai * HALF + m * 16;
#pragma unroll
                for (int bj = 0; bj < 2; ++bj)
#pragma unroll
                    for (int n = 0; n < 2; ++n) { const int col = col0 + bj * HALF + n * 16; const f32x4 v = acc[ai][bj][m][n];
                        if (col < 1024) { *(f32x4*)(mk + (size_t)row * 1024 + col) = v; u32x2 w; w.x = cvt_pk_bf16(v[0], v[1]); w.y = cvt_pk_bf16(v[2], v[3]); *(u32x2*)(kb + (size_t)row * 1024 + col) = w; }
                        else { const int cc = col - 1024; *(f32x4*)(mv + (size_t)row * 1024 + cc) = v; const int bb = row >> 8, mt = row & 255;
#pragma unroll
                            for (int j = 0; j < 4; ++j) { const int c2 = cc + j, head = c2 >> 8, d = c2 & 255; vt[((size_t)((bb * 4 + head) * 256 + d)) * 256 + mt] = f2bf(v[j]); } } } }
    }
};
struct EpiRes {
    static constexpr bool PERM = false;
    float* res; const float* xp; const float* xs; float alpha;
    DI void operator()(const f32x4 (&acc)[2][2][4][2], const Unit& u, int wr, int wc, int fr, int fq) const {
        const int row0 = u.pm * BM + wr * 64 + fr, col0 = u.pn * BM + wc * 32 + 4 * fq;
#pragma unroll
        for (int ai = 0; ai < 2; ++ai)
#pragma unroll
            for (int m = 0; m < 4; ++m) { const int row = row0 + ai * HALF + m * 16; const float* xr = row < NTOKP ? xp + (size_t)row * 1024 : xs + (size_t)(row - NTOKP) * 1024;
#pragma unroll
                for (int bj = 0; bj < 2; ++bj)
#pragma unroll
                    for (int n = 0; n < 2; ++n) { const int col = col0 + bj * HALF + n * 16; const f32x4 xv = *(const f32x4*)(xr + col);
                        *(f32x4*)(res + (size_t)row * 1024 + col) = acc[ai][bj][m][n] + xv * alpha; } }
    }
};

template <class Epi, class Sched>
DI void gemm_phase(LAS unsigned char* lds, const Gemm g, const Sched& S, const Epi& E) {
    const int tid = otid(), wid = __builtin_amdgcn_readfirstlane(tid >> 6), lane = tid & 63, wr = wid >> 2, wc = wid & 3, fr = lane & 15, fq = lane >> 4;
    const int K = g.K, nt = K / BK;
    unsigned voffA[2], voffB[2];
#pragma unroll
    for (int i = 0; i < 2; ++i) { int R, C; stage_rc(tid * 16 + i * 8192, R, C); const int Rb = Epi::PERM ? ((R & ~31) + perm32(R & 31)) : R;
        voffA[i] = (unsigned)(R * K + C) * 2u; voffB[i] = (unsigned)(Rb * K + C) * 2u; }
    const size_t kstep = (size_t)(BK * 2);
    const size_t hstep = (size_t)HALF * K * 2;
    const size_t tstep = 2 * hstep;
    const unsigned ldsw = (unsigned)wid * 1024u;
    const int aoff = lds_byte(wr * 64 + fr, fq * 8), boff = lds_byte(wc * 32 + fr, fq * 8);
#define PG8_SA(b, h) (((b) * 2 + (h)) * HTB)
#define PG8_SB(b, h) ((4 + (b) * 2 + (h)) * HTB)
#define PG8_STAGE(bufoff, gbase, voff) do { _Pragma("unroll") for (int _i = 0; _i < 2; ++_i) \
        __builtin_amdgcn_global_load_lds((const unsigned*)((const char*)(gbase) + (voff)[_i]), (LAS unsigned*)(lds + (bufoff) + ldsw + _i * 8192), 16, 0, 0); } while (0)
#define PG8_LDA(dst, b, h) do { _Pragma("unroll") for (int m = 0; m < 4; ++m) _Pragma("unroll") for (int k = 0; k < 2; ++k) dst[m][k] = *(const LAS bf16x8*)(lds + PG8_SA(b, h) + aoff + m * 2048 + k * 1024); } while (0)
#define PG8_LDB(dst, b, h) do { _Pragma("unroll") for (int n = 0; n < 2; ++n) _Pragma("unroll") for (int k = 0; k < 2; ++k) dst[n][k] = *(const LAS bf16x8*)(lds + PG8_SB(b, h) + boff + n * 2048 + k * 1024); } while (0)
#define PG8_MMA(ai, bj, At, Bt) do { __builtin_amdgcn_s_setprio(1); _Pragma("unroll") for (int m = 0; m < 4; ++m) _Pragma("unroll") for (int n = 0; n < 2; ++n) _Pragma("unroll") for (int k = 0; k < 2; ++k) \
        acc[ai][bj][m][n] = __builtin_amdgcn_mfma_f32_16x16x32_bf16(Bt[n][k], At[m][k], acc[ai][bj][m][n], 0, 0, 0); __builtin_amdgcn_s_setprio(0); } while (0)
#define PG8_WAIT_V(n) asm volatile("s_waitcnt vmcnt(" #n ")" ::: "memory")
#define PG8_WAIT_L(n) asm volatile("s_waitcnt lgkmcnt(" #n ")" ::: "memory")
#define PG8_BAR __builtin_amdgcn_s_barrier()
#define PG8_SCHED __builtin_amdgcn_sched_barrier(0)
    Unit cur, nxt; int ui = 0;
    if (!S.next(0, cur)) return;
    f32x4 acc[2][2][4][2];
#pragma unroll
    for (int a = 0; a < 2; ++a)
#pragma unroll
        for (int b = 0; b < 2; ++b)
#pragma unroll
            for (int m = 0; m < 4; ++m)
#pragma unroll
                for (int n = 0; n < 2; ++n) acc[a][b][m][n] = (f32x4){0.f, 0.f, 0.f, 0.f};
    bf16x8 At[4][2], B0[2][2], B1[2][2];
    const char* cA = (const char*)g.A + (size_t)cur.pm * tstep; const char* cB = (const char*)g.Bt + (size_t)cur.pn * tstep;
    PG8_STAGE(PG8_SB(0, 0), cB, voffB); PG8_STAGE(PG8_SA(0, 0), cA, voffA); PG8_STAGE(PG8_SB(0, 1), cB + hstep, voffB); PG8_STAGE(PG8_SA(0, 1), cA + hstep, voffA);
    if (wr == 1) PG8_BAR;
    PG8_WAIT_V(4); PG8_BAR;
    PG8_STAGE(PG8_SB(1, 0), cB + kstep, voffB); PG8_STAGE(PG8_SA(1, 0), cA + kstep, voffA); PG8_STAGE(PG8_SB(1, 1), cB + hstep + kstep, voffB);
    PG8_WAIT_V(6); PG8_BAR;
    for (;;) {
        const bool has_next = S.next(ui + 1, nxt);
        const char* nA = has_next ? (const char*)g.A + (size_t)nxt.pm * tstep : cA; const char* nB = has_next ? (const char*)g.Bt + (size_t)nxt.pn * tstep : cB;
        for (int t = 0; t < nt; t += 2) {
            const bool last = (t == nt - 2);
            const char* a1 = cA + (size_t)(t + 1) * kstep;
            const char* a2 = last ? nA : cA + (size_t)(t + 2) * kstep; const char* b2 = last ? nB : cB + (size_t)(t + 2) * kstep;
            const char* a3 = a2 + kstep; const char* b3 = b2 + kstep;
            PG8_LDB(B0, 0, 0); PG8_SCHED; PG8_LDA(At, 0, 0); PG8_STAGE(PG8_SA(1, 1), a1 + hstep, voffA);
            PG8_WAIT_L(8); PG8_BAR; PG8_WAIT_L(0); PG8_MMA(0, 0, At, B0); PG8_BAR; PG8_SCHED;
            PG8_LDB(B1, 0, 1); PG8_STAGE(PG8_SB(0, 0), b2, voffB);
            PG8_BAR; PG8_WAIT_L(0); PG8_MMA(0, 1, At, B1); PG8_BAR;
            PG8_LDA(At, 0, 1); PG8_STAGE(PG8_SA(0, 0), a2, voffA);
            PG8_BAR; PG8_WAIT_L(0); PG8_MMA(1, 0, At, B0); PG8_BAR; PG8_SCHED;
            PG8_STAGE(PG8_SB(0, 1), b2 + hstep, voffB);
            PG8_WAIT_V(6); PG8_BAR; PG8_MMA(1, 1, At, B1); PG8_BAR;
            PG8_LDB(B0, 1, 0); PG8_SCHED; PG8_LDA(At, 1, 0); PG8_STAGE(PG8_SA(0, 1), a2 + hstep, voffA);
            PG8_WAIT_L(8); PG8_BAR; PG8_WAIT_L(0); PG8_MMA(0, 0, At, B0); PG8_BAR; PG8_SCHED;
            PG8_LDB(B1, 1, 1); PG8_STAGE(PG8_SB(1, 0), b3, voffB);
            PG8_BAR; PG8_WAIT_L(0); PG8_MMA(0, 1, At, B1); PG8_BAR;
            PG8_LDA(At, 1, 1); PG8_STAGE(PG8_SA(1, 0), a3, voffA);
            PG8_BAR; PG8_WAIT_L(0); PG8_MMA(1, 0, At, B0); PG8_BAR; PG8_SCHED;
            PG8_STAGE(PG8_SB(1, 1), b3 + hstep, voffB);
            PG8_WAIT_V(6); PG8_BAR; PG8_MMA(1, 1, At, B1); PG8_BAR;
        }
        E(acc, cur, wr, wc, fr, fq);
        if (!has_next) break;
#pragma unroll
        for (int a = 0; a < 2; ++a)
#pragma unroll
            for (int b = 0; b < 2; ++b)
#pragma unroll
                for (int m = 0; m < 4; ++m)
#pragma unroll
                    for (int n = 0; n < 2; ++n) acc[a][b][m][n] = (f32x4){0.f, 0.f, 0.f, 0.f};
        cur = nxt; cA = nA; cB = nB; ++ui;
    }
    PG8_WAIT_V(0);
    if (wr == 0) PG8_BAR;
    PG8_BAR;
#undef PG8_SA
#undef PG8_SB
#undef PG8_STAGE
#undef PG8_LDA
#undef PG8_LDB
#undef PG8_MMA
#undef PG8_WAIT_V
#undef PG8_WAIT_L
#undef PG8_BAR
#undef PG8_SCHED
}
}

DI void tr_tile(const float* src, int ld_src, int k0, int c0, bf16_t* dst, int ld_dst, int n0, float* lds) {
    const int tid = otid();
#pragma unroll
    for (int pass = 0; pass < 2; ++pass) { const int r = pass * 32 + (tid >> 4), c4 = (tid & 15) * 4;
        const f32x4 v = *(const f32x4*)(src + (size_t)(k0 + r) * ld_src + c0 + c4);
        lds[r * 65 + c4 + 0] = v[0]; lds[r * 65 + c4 + 1] = v[1]; lds[r * 65 + c4 + 2] = v[2]; lds[r * 65 + c4 + 3] = v[3]; }
    __syncthreads();
    const int nn = tid >> 3, kc = (tid & 7) * 8;
    float o[8];
#pragma unroll
    for (int e = 0; e < 8; ++e) o[e] = lds[(kc + e) * 65 + nn];
    *(u32x4*)(dst + (size_t)(n0 + nn) * ld_dst + k0 + kc) = pack8(o);
    __syncthreads();
}

DI void phase_prep(KP pk_in, unsigned char* lds) {
    KP pk = pk_in; asm volatile("" : "+s"(pk));
    unsigned char* ws = pk->ws;
    const int bidx_ = obid(); const size_t gtid = (size_t)bidx_ * 512 + otid(), nthr = (size_t)gridDim.x * 512;
    { bf16_t* xb = (bf16_t*)(ws + W_XB);
      for (size_t v = gtid; v < (size_t)NTOK * 128; v += nthr) { const float* s = v < (size_t)NTOKP * 128 ? pk->x_prompt + v * 8 : pk->x_sample + (v - (size_t)NTOKP * 128) * 8;
          const f32x4 a = *(const f32x4*)s, b = *(const f32x4*)(s + 4); float o[8] = {a[0], a[1], a[2], a[3], b[0], b[1], b[2], b[3]}; *(u32x4*)(xb + v * 8) = pack8(o); } }
    { bf16_t* mb = (bf16_t*)(ws + W_MEMB);
      for (size_t v = gtid; v < (size_t)2048 * 128; v += nthr) { const float* s = pk->mem_prompt + v * 8;
          const f32x4 a = *(const f32x4*)s, b = *(const f32x4*)(s + 4); float o[8] = {a[0], a[1], a[2], a[3], b[0], b[1], b[2], b[3]}; *(u32x4*)(mb + v * 8) = pack8(o); } }
    { bf16_t* wd = (bf16_t*)(ws + W_WDTT); float* wf = (float*)(ws + W_WDTF);
      for (size_t i = gtid; i < 16 * 1024; i += nthr) { const int h = (int)(i >> 10), k = (int)(i & 1023); const float v = pk->w_in[(size_t)k * DIN + 4608 + h]; wd[i] = f2bf(v); wf[i] = v; } }
    { bf16_t* wg = (bf16_t*)(ws + W_WGT);
      for (size_t i = gtid; i < (size_t)8 * 4 * 64 * 128; i += nthr) { const int k = (int)(i >> 15), qd = (int)(i >> 13) & 3, nn = (int)(i >> 7) & 63, ii = (int)(i & 127);
          const float v = nn < 32 ? pk->w_rg_a[((size_t)k * 128 + ii) * 128 + qd * 32 + nn] : pk->w_rg_i[((size_t)k * 128 + ii) * 128 + qd * 32 + nn - 32]; wg[i] = f2bf(v); } }
    float* tl = (float*)lds;
    for (int t = bidx_; t < 1664 + 768 + 512; t += gridDim.x) {
        if (t < 1664) { const int kt = t & 15, ntile = t >> 4; const int n0 = ntile * 64, c0 = n0 < 4608 ? n0 : n0 + 16;
            tr_tile(pk->w_in, DIN, kt * 64, c0, (bf16_t*)(ws + W_WINT), 1024, n0, tl); }
        else if (t < 1664 + 768) { const int u = t - 1664; const int kt = u % 48, ntile = u / 48;
            tr_tile(pk->w_out, 1024, kt * 64, ntile * 64, (bf16_t*)(ws + W_WOUTT), 3072, ntile * 64, tl); }
        else { const int u = t - 1664 - 768; const int kt = u & 15, ntile = u >> 4; const int n0 = ntile * 64;
            if (n0 < 1024) tr_tile(pk->w_mem_k, 1024, kt * 64, n0, (bf16_t*)(ws + W_WKVT), 1024, n0, tl);
            else tr_tile(pk->w_mem_v, 1024, kt * 64, n0 - 1024, (bf16_t*)(ws + W_WKVT), 1024, n0, tl); }
    }
}

DI void conv8_ssd_prompt(KP pk, const bf16_t* proj, int rowbase, int t, int ch, float (&o)[8]) {
    const f32x4 b0 = *(const f32x4*)(pk->ssd_conv_b + ch), b1 = *(const f32x4*)(pk->ssd_conv_b + ch + 4);
    float acc[8] = {b0[0], b0[1], b0[2], b0[3], b1[0], b1[1], b1[2], b1[3]};
    u32x4 vv[4];
#pragma unroll
    for (int kk = 0; kk < 4; ++kk) { const int tt = t - 3 + kk; vv[kk] = *(const u32x4*)(proj + (size_t)(rowbase + (tt < 0 ? 0 : tt)) * NPROJ + C_XBC + ch); }
#pragma unroll
    for (int kk = 0; kk < 4; ++kk) { const int tt = t - 3 + kk; const float msk = tt >= 0 ? 1.f : 0.f; float x[8]; unpack8(vv[kk], x);
            const f32x4 w0 = *(const f32x4*)(pk->ssd_conv_w + kk * 1536 + ch) * msk, w1 = *(const f32x4*)(pk->ssd_conv_w + kk * 1536 + ch + 4) * msk;
            acc[0] += x[0] * w0[0]; acc[1] += x[1] * w0[1]; acc[2] += x[2] * w0[2]; acc[3] += x[3] * w0[3];
            acc[4] += x[4] * w1[0]; acc[5] += x[5] * w1[1]; acc[6] += x[6] * w1[2]; acc[7] += x[7] * w1[3]; }
#pragma unroll
    for (int e = 0; e < 8; ++e) o[e] = siluf(acc[e]);
}

DI void ssd1_item(KP pk_in, unsigned char* lds, int b, int c, int g) {
    KP pk = pk_in; asm volatile("" : "+s"(pk));
    unsigned char* ws = pk->ws;
    const int tid = otid(), w = tid >> 6, lane = tid & 63, l15 = lane & 15, q = lane >> 4;
    float* dt_s = (float*)lds; float* acum_s = dt_s + 2048; float* w_s = acum_s + 2048;
    bf16_t* BT = (bf16_t*)(lds + 20480); bf16_t* xsT = (bf16_t*)(lds + 20480 + 34816);
    const bf16_t* xb = (const bf16_t*)(ws + W_XB); const bf16_t* wdt = (const bf16_t*)(ws + W_WDTT); const bf16_t* proj = (const bf16_t*)(ws + W_PROJ);
    bf16_t* xact = (bf16_t*)(ws + W_XACT); float* dt_g = (float*)(ws + W_DT); float* acum_g = (float*)(ws + W_ACUM); float* cd_g = (float*)(ws + W_CD); float* st_g = (float*)(ws + W_ST);
    const int tok0 = b * 2048 + c * 128;
    __syncthreads();
    { f32x4 acc = {0.f, 0.f, 0.f, 0.f}; const bf16_t* ap = xb + (size_t)(tok0 + 16 * w + l15) * 1024 + q * 8; const bf16_t* bp = wdt + l15 * 1024 + q * 8;
#pragma unroll 8
      for (int ks = 0; ks < 32; ++ks) { const bf16x8 a = *(const bf16x8*)(ap + ks * 32); const bf16x8 bb = *(const bf16x8*)(bp + ks * 32); acc = MFMA16(a, bb, acc); }
      const float bias = pk->ssd_dt_bias[l15];
#pragma unroll
      for (int r = 0; r < 4; ++r) { const int i = 16 * w + 4 * q + r; const float dt = softplusf(acc[r] + bias); dt_s[i * 16 + l15] = dt; dt_g[(size_t)(tok0 + i) * 16 + l15] = dt; } }
    __syncthreads();
    if (tid < 16) { const float ah = -__expf(pk->ssd_a_log[tid]); float run = 0.f;
        for (int i = 0; i < 128; ++i) { run += dt_s[i * 16 + tid] * ah; acum_s[i * 16 + tid] = run; acum_g[(size_t)(tok0 + i) * 16 + tid] = run; } }
    __syncthreads();
    if (tid < 8) cd_g[(b * 16 + c) * 16 + 8 * g + tid] = __expf(acum_s[127 * 16 + 8 * g + tid]);
    for (int idx = tid; idx < 1024; idx += 512) { const int j = idx >> 3, hl = idx & 7, h = 8 * g + hl; w_s[idx] = dt_s[j * 16 + h] * __expf(acum_s[127 * 16 + h] - acum_s[j * 16 + h]); }
    for (int idx = tid; idx < 4096; idx += 512) { const int which = idx >> 11, rem = idx & 2047, j = rem >> 4, cv = (rem & 15) * 8; const int ch = 1024 + which * 256 + g * 128 + cv;
        float o[8]; conv8_ssd_prompt(pk, proj, b * 2048, c * 128 + j, ch, o); const u32x4 pk = pack8(o);
        *(u32x4*)(xact + (size_t)(tok0 + j) * 1536 + ch) = pk;
        if (which == 0) { const bf16_t* e16 = (const bf16_t*)&pk;
#pragma unroll
            for (int e = 0; e < 8; ++e) BT[(cv + e) * 136 + j] = f2bf(o[e]); (void)e16; } }
    for (int hl = 0; hl < 8; ++hl) {
        __syncthreads();
        for (int idx = tid; idx < 1024; idx += 512) { const int j = idx >> 3, pv = (idx & 7) * 8; const int ch = g * 512 + hl * 64 + pv;
            float o[8]; conv8_ssd_prompt(pk, proj, b * 2048, c * 128 + j, ch, o);
            *(u32x4*)(xact + (size_t)(tok0 + j) * 1536 + ch) = pack8(o);
            const float wj = w_s[j * 8 + hl];
#pragma unroll
            for (int e = 0; e < 8; ++e) xsT[(pv + e) * 136 + j] = f2bf(o[e] * wj); }
        __syncthreads();
        const int pt = w & 3, nh = w >> 2;
        f32x4 acc[4];
#pragma unroll
        for (int nt = 0; nt < 4; ++nt) acc[nt] = (f32x4){0.f, 0.f, 0.f, 0.f};
#pragma unroll
        for (int ks = 0; ks < 4; ++ks) { const bf16x8 a = *(const bf16x8*)(xsT + (pt * 16 + l15) * 136 + ks * 32 + q * 8);
#pragma unroll
            for (int nt = 0; nt < 4; ++nt) { const bf16x8 bb = *(const bf16x8*)(BT + (nh * 64 + nt * 16 + l15) * 136 + ks * 32 + q * 8); acc[nt] = MFMA16(a, bb, acc[nt]); } }
        float* sp = st_g + (size_t)(((b * 16 + c) * 16 + 8 * g + hl)) * 8192;
#pragma unroll
        for (int nt = 0; nt < 4; ++nt)
#pragma unroll
            for (int r = 0; r < 4; ++r) sp[(pt * 16 + 4 * q + r) * 128 + nh * 64 + nt * 16 + l15] = acc[nt][r];
    }
    if (c == 15) {
        for (int idx = tid; idx < 3 * 768; idx += 512) { const int jj = idx / 768, cc = idx % 768; const int ch = cc < 512 ? g * 512 + cc : (cc < 640 ? 1024 + g * 128 + (cc - 512) : 1280 + g * 128 + (cc - 640));
            pk->out[O_SCP + (size_t)(b * 3 + jj) * 1536 + ch] = bf2f(proj[(size_t)(b * 2048 + 2045 + jj) * NPROJ + C_XBC + ch]); }
    }
}

DI void statepass_item(KP pk_in, int sp) {
    KP pk = pk_in; asm volatile("" : "+s"(pk));
    const int b = sp >> 5, h = (sp >> 1) & 15, half = sp & 1; const int e0 = half * 4096 + otid() * 8;
    float* st_g = (float*)(pk->ws + W_ST); const float* cd_g = (const float*)(pk->ws + W_CD);
    f32x4 r0 = {0.f, 0.f, 0.f, 0.f}, r1 = {0.f, 0.f, 0.f, 0.f};
    for (int c0 = 0; c0 < 16; c0 += 8) { f32x4 v0[8], v1[8]; float cd[8];
#pragma unroll
        for (int i = 0; i < 8; ++i) { const float* ptr = st_g + (size_t)((b * 16 + c0 + i) * 16 + h) * 8192 + e0; v0[i] = *(const f32x4*)ptr; v1[i] = *(const f32x4*)(ptr + 4); cd[i] = cd_g[(b * 16 + c0 + i) * 16 + h]; }
#pragma unroll
        for (int i = 0; i < 8; ++i) { float* ptr = st_g + (size_t)((b * 16 + c0 + i) * 16 + h) * 8192 + e0; *(f32x4*)ptr = r0; *(f32x4*)(ptr + 4) = r1; r0 = r0 * cd[i] + v0[i]; r1 = r1 * cd[i] + v1[i]; } }
    float* o = pk->out + O_SHP + (size_t)(b * 16 + h) * 8192 + e0; *(f32x4*)o = r0; *(f32x4*)(o + 4) = r1;
}

DI void rg_item(KP pk_in, unsigned char* lds, const bool sample, int bidx, int k, int qd) {
    KP pk = pk_in; asm volatile("" : "+s"(pk));
    unsigned char* ws = pk->ws;
    const int tid = otid(), w = tid >> 6, lane = tid & 63, l15 = lane & 15, q = lane >> 4;
    bf16_t* uA = (bf16_t*)lds;
    float* sa = (float*)(lds + 34816); float* sb = sa + 4096;
    float* segA = sb + 4096; float* segB = segA + 512; float* hcar = segB + 512;
    const bf16_t* proj = (const bf16_t*)(ws + W_PROJ); bf16_t* mix = (bf16_t*)(ws + W_MIX);
    const bf16_t* wg = (const bf16_t*)(ws + W_WGT) + (size_t)((k * 4 + qd) * 64) * 128;
    bf16_t* wS = (bf16_t*)(lds + 73728);
    __syncthreads();
    for (int idx = tid; idx < 1024; idx += 512) { const int n = idx >> 4, c8 = (idx & 15) * 8; *(u32x4*)(wS + n * 136 + c8) = *(const u32x4*)(wg + n * 128 + c8); }
    float ba[2], bi[2], spl[2];
#pragma unroll
    for (int ntl = 0; ntl < 2; ++ntl) { const int ch = k * 128 + qd * 32 + ntl * 16 + l15; ba[ntl] = pk->b_rg_a[ch]; bi[ntl] = pk->b_rg_i[ch]; spl[ntl] = softplusf(-pk->rg_lambda[ch]); }
    __syncthreads();
    if (tid < 32) hcar[tid] = 0.f;
    const int ntiles = sample ? 1 : 16;
    const int crow = tid >> 2, cg0 = (tid & 3) * 32;
    const int cl_s = tid & 31, seg_s = tid >> 5;
    u32x4 rv[4][4];
#define RG_LOADP(TILE) do { _Pragma("unroll") for (int v = 0; v < 4; ++v) _Pragma("unroll") for (int kk = 0; kk < 4; ++kk) { const int tt = (TILE) * 128 + crow - 3 + kk; \
        rv[v][kk] = *(const u32x4*)(proj + (size_t)(bidx * 2048 + (tt < 0 ? 0 : tt)) * NPROJ + C_RGX + k * 128 + cg0 + v * 8); } } while (0)
    if (!sample) RG_LOADP(0);
    for (int tile = 0; tile < ntiles; ++tile) {
        __syncthreads();
        float gts[8];
        if (!sample) {
#pragma unroll
          for (int v = 0; v < 4; ++v) { const int c8 = cg0 + v * 8, ch = k * 128 + c8;
              const f32x4 b0 = *(const f32x4*)(pk->rg_conv_b + ch), b1 = *(const f32x4*)(pk->rg_conv_b + ch + 4);
              float acc[8] = {b0[0], b0[1], b0[2], b0[3], b1[0], b1[1], b1[2], b1[3]};
#pragma unroll
              for (int kk = 0; kk < 4; ++kk) { float x[8]; const float have = (tile * 128 + crow - 3 + kk) >= 0 ? 1.f : 0.f; unpack8(rv[v][kk], x);
                  const f32x4 w0 = *(const f32x4*)(pk->rg_conv_w + kk * 1024 + ch) * have, w1 = *(const f32x4*)(pk->rg_conv_w + kk * 1024 + ch + 4) * have;
                  acc[0] += x[0] * w0[0]; acc[1] += x[1] * w0[1]; acc[2] += x[2] * w0[2]; acc[3] += x[3] * w0[3];
                  acc[4] += x[4] * w1[0]; acc[5] += x[5] * w1[1]; acc[6] += x[6] * w1[2]; acc[7] += x[7] * w1[3]; }
              *(u32x4*)(uA + crow * 136 + c8) = pack8(acc); }
          if (tile + 1 < 16) RG_LOADP(tile + 1);
#pragma unroll
          for (int j = 0; j < 8; ++j) gts[j] = bf2f(proj[(size_t)(bidx * 2048 + tile * 128 + seg_s * 8 + j) * NPROJ + C_RGG + k * 128 + qd * 32 + cl_s]);
        } else { const int row = crow;
#pragma unroll
          for (int v = 0; v < 4; ++v) { const int c8 = cg0 + v * 8, ch = k * 128 + c8;
              const f32x4 b0 = *(const f32x4*)(pk->rg_conv_b + ch), b1 = *(const f32x4*)(pk->rg_conv_b + ch + 4);
              float acc[8] = {b0[0], b0[1], b0[2], b0[3], b1[0], b1[1], b1[2], b1[3]};
#pragma unroll
              for (int kk = 0; kk < 4; ++kk) { float x[8];
                  { const int sbi = bidx * 32 + (row >> 2), ui = (row & 3) + kk;
                      if (ui < 3) { const float* s = pk->state_rg_conv + (size_t)(sbi * 3 + ui) * 1024 + ch; const f32x4 s0 = *(const f32x4*)s, s1 = *(const f32x4*)(s + 4);
                          x[0] = s0[0]; x[1] = s0[1]; x[2] = s0[2]; x[3] = s0[3]; x[4] = s1[0]; x[5] = s1[1]; x[6] = s1[2]; x[7] = s1[3]; }
                      else { const u32x4 vv = *(const u32x4*)(proj + (size_t)(NTOKP + sbi * 4 + ui - 3) * NPROJ + C_RGX + ch); unpack8(vv, x); } }
                  { const f32x4 w0 = *(const f32x4*)(pk->rg_conv_w + kk * 1024 + ch), w1 = *(const f32x4*)(pk->rg_conv_w + kk * 1024 + ch + 4);
                      acc[0] += x[0] * w0[0]; acc[1] += x[1] * w0[1]; acc[2] += x[2] * w0[2]; acc[3] += x[3] * w0[3];
                      acc[4] += x[4] * w1[0]; acc[5] += x[5] * w1[1]; acc[6] += x[6] * w1[2]; acc[7] += x[7] * w1[3]; } }
              *(u32x4*)(uA + row * 136 + c8) = pack8(acc); }
#pragma unroll
          for (int j = 0; j < 8; ++j) gts[j] = bf2f(proj[(size_t)(NTOKP + bidx * 128 + seg_s * 8 + j) * NPROJ + C_RGG + k * 128 + qd * 32 + cl_s]);
        }
        __syncthreads();
        { f32x4 acc[4];
#pragma unroll
          for (int nt = 0; nt < 4; ++nt) acc[nt] = (f32x4){0.f, 0.f, 0.f, 0.f};
#pragma unroll
          for (int ks = 0; ks < 4; ++ks) { const bf16x8 a = *(const bf16x8*)(uA + (16 * w + l15) * 136 + ks * 32 + q * 8);
#pragma unroll
              for (int nt = 0; nt < 4; ++nt) { const bf16x8 bb = *(const bf16x8*)(wS + (nt * 16 + l15) * 136 + ks * 32 + q * 8); acc[nt] = MFMA16(a, bb, acc[nt]); } }
#pragma unroll
          for (int ntl = 0; ntl < 2; ++ntl)
#pragma unroll
              for (int r = 0; r < 4; ++r) { const int row = 16 * w + 4 * q + r, cl = ntl * 16 + l15;
                  const float rr = sigmf(acc[ntl][r] + ba[ntl]), ii = sigmf(acc[2 + ntl][r] + bi[ntl]);
                  const float la = -8.f * rr * spl[ntl]; float a = __expf(la); const float uval = bf2f(uA[row * 136 + qd * 32 + cl]);
                  float bt = sqrtf(fmaxf(1.f - a * a, 0.f)) * ii * uval;
                  const bool first = sample ? ((row & 3) == 0) : (tile == 0 && row == 0);
                  if (first) { const float h0 = sample ? pk->state_rg_h[(size_t)(bidx * 32 + (row >> 2)) * 1024 + k * 128 + qd * 32 + cl] : 0.f; bt += a * h0; a = 0.f; }
                  sa[row * 32 + cl] = a; sb[row * 32 + cl] = bt; } }
        __syncthreads();
        const int cl = tid & 31, seg = tid >> 5;
        { float A = 1.f, B = 0.f;
#pragma unroll
          for (int j = 0; j < 8; ++j) { const int row = seg * 8 + j; const float a = sa[row * 32 + cl], bb = sb[row * 32 + cl]; B = a * B + bb; A = a * A; }
          segA[seg * 32 + cl] = A; segB[seg * 32 + cl] = B; }
        __syncthreads();
        float h = hcar[cl];
        for (int s = 0; s < seg; ++s) h = segA[s * 32 + cl] * h + segB[s * 32 + cl];
        const int chg = k * 128 + qd * 32 + cl;
#pragma unroll
        for (int j = 0; j < 8; ++j) { const int row = seg * 8 + j; h = sa[row * 32 + cl] * h + sb[row * 32 + cl];
            const size_t grow = sample ? (size_t)(NTOKP + bidx * 128 + row) : (size_t)(bidx * 2048 + tile * 128 + row);
            mix[grow * DMIX + chg] = f2bf(h * siluf(gts[j]));
            if (sample) { if ((row & 3) == 3) pk->out[O_RGHS + (size_t)(bidx * 32 + (row >> 2)) * 1024 + chg] = h; }
            else if (tile == 15 && row == 127) pk->out[O_RGHP + (size_t)bidx * 1024 + chg] = h; }
        __syncthreads();
        if (seg == 15) hcar[cl] = h;
    }
    if (!sample) { if (tid < 96) { const int jj = tid >> 5, cl = tid & 31, chg = k * 128 + qd * 32 + cl;
            pk->out[O_RGCP + (size_t)(bidx * 3 + jj) * 1024 + chg] = bf2f(proj[(size_t)(bidx * 2048 + 2045 + jj) * NPROJ + C_RGX + chg]); } }
    else { for (int idx = tid; idx < 32 * 3 * 32; idx += 512) { const int cl = idx & 31, jj = (idx >> 5) % 3, sl = idx / 96; const int sbi = bidx * 32 + sl, chg = k * 128 + qd * 32 + cl;
            pk->out[O_RGCS + (size_t)(sbi * 3 + jj) * 1024 + chg] = bf2f(proj[(size_t)(NTOKP + sbi * 4 + 1 + jj) * NPROJ + C_RGX + chg]); } }
}

DI void attnp_item(KP pk_in, unsigned char* lds, int b, int head, int qt) {
    KP pk = pk_in; asm volatile("" : "+s"(pk));
    unsigned char* ws = pk->ws;
    const int tid = otid(), w = tid >> 6, lane = tid & 63, l15 = lane & 15, q = lane >> 4;
    const bf16_t* proj = (const bf16_t*)(ws + W_PROJ); const bf16_t* kb = (const bf16_t*)(ws + W_KB); const bf16_t* vt = (const bf16_t*)(ws + W_VT); bf16_t* mix = (bf16_t*)(ws + W_MIX);
    const int tokb = b * 2048 + qt * 128 + 16 * w;
    constexpr int RS = 264;
    bf16_t* sm = (bf16_t*)lds;
    const int lr = tid >> 5, lc = (tid & 31) * 8;
    const bf16_t* kbase = kb + (size_t)(b * 256) * 1024 + head * 256; const bf16_t* vbase = vt + (size_t)((b * 4 + head) * 256) * 256;
    u32x4 pre[8];
#define AT_LOAD(S) do { _Pragma("unroll") for (int i = 0; i < 8; ++i) { const int r = lr + 16 * i; \
        pre[i] = (S) < 2 ? *(const u32x4*)(kbase + (size_t)(128 * (S) + r) * 1024 + lc) : *(const u32x4*)(vbase + (size_t)(128 * ((S) - 2) + r) * 256 + lc); } } while (0)
#define AT_STORE() do { _Pragma("unroll") for (int i = 0; i < 8; ++i) *(u32x4*)(sm + (lr + 16 * i) * RS + lc) = pre[i]; } while (0)
    AT_LOAD(0);
    bf16x8 qf[8];
#pragma unroll
    for (int ks = 0; ks < 8; ++ks) qf[ks] = *(const bf16x8*)(proj + (size_t)(tokb + l15) * NPROJ + C_Q + head * 256 + ks * 32 + q * 8);
    f32x4 st[16];
#pragma unroll
    for (int s = 0; s < 2; ++s) {
        __syncthreads(); AT_STORE(); __syncthreads(); AT_LOAD(s + 1);
#pragma unroll
        for (int mtl = 0; mtl < 8; ++mtl) { const int mt = 8 * s + mtl; st[mt] = (f32x4){0.f, 0.f, 0.f, 0.f}; const bf16_t* kp = sm + (16 * mtl + l15) * RS + q * 8;
#pragma unroll
            for (int ks = 0; ks < 8; ++ks) { const bf16x8 kf = *(const bf16x8*)(kp + ks * 32); st[mt] = MFMA16(kf, qf[ks], st[mt]); } }
    }
    float mx = -3.0e38f;
#pragma unroll
    for (int mt = 0; mt < 16; ++mt)
#pragma unroll
        for (int r = 0; r < 4; ++r) { st[mt][r] *= 0.0625f; mx = fmaxf(mx, st[mt][r]); }
    mx = fmaxf(mx, shx(mx, 16, lane)); mx = fmaxf(mx, shx(mx, 32, lane));
    float l = 0.f;
#pragma unroll
    for (int mt = 0; mt < 16; ++mt)
#pragma unroll
        for (int r = 0; r < 4; ++r) { const float e = __expf(st[mt][r] - mx); st[mt][r] = e; l += e; }
    l += shx(l, 16, lane); l += shx(l, 32, lane);
    bf16x8 pf[8];
#pragma unroll
    for (int s = 0; s < 8; ++s) { float m8[8] = {st[2 * s][0], st[2 * s][1], st[2 * s][2], st[2 * s][3], st[2 * s + 1][0], st[2 * s + 1][1], st[2 * s + 1][2], st[2 * s + 1][3]}; pf[s] = as_frag(pack8(m8)); }
    float linv[4];
#pragma unroll
    for (int r = 0; r < 4; ++r) linv[r] = 1.f / shl(l, 4 * q + r);
#pragma unroll
    for (int s2 = 0; s2 < 2; ++s2) {
        __syncthreads(); AT_STORE(); __syncthreads(); if (s2 == 0) AT_LOAD(3);
#pragma unroll
        for (int dtl = 0; dtl < 8; ++dtl) { const int dt = 8 * s2 + dtl; f32x4 o = {0.f, 0.f, 0.f, 0.f}; const bf16_t* vp = sm + (16 * dtl + l15) * RS + 4 * q;
            float gt[4];
#pragma unroll
            for (int r = 0; r < 4; ++r) gt[r] = bf2f(proj[(size_t)(tokb + 4 * q + r) * NPROJ + C_XG + head * 256 + 16 * dt + l15]);
#pragma unroll
            for (int s = 0; s < 8; ++s) { const u32x2 lo = *(const u32x2*)(vp + 32 * s), hi = *(const u32x2*)(vp + 32 * s + 16); o = MFMA16(pf[s], frag2(lo, hi), o); }
#pragma unroll
            for (int r = 0; r < 4; ++r) { const size_t tok = (size_t)(tokb + 4 * q + r); const int d = 16 * dt + l15;
                mix[tok * DMIX + 2048 + head * 256 + d] = f2bf(o[r] * linv[r] * siluf(gt[r])); } }
    }
#undef AT_LOAD
#undef AT_STORE
}

DI float wave_sum(float v, int lane) { v += shx(v, 32, lane); v += shx(v, 16, lane); v += shx(v, 8, lane); v += shx(v, 4, lane); v += shx(v, 2, lane); v += shx(v, 1, lane); return v; }
DI float wave_max(float v, int lane) { v = fmaxf(v, shx(v, 32, lane)); v = fmaxf(v, shx(v, 16, lane)); v = fmaxf(v, shx(v, 8, lane)); v = fmaxf(v, shx(v, 4, lane)); v = fmaxf(v, shx(v, 2, lane)); v = fmaxf(v, shx(v, 1, lane)); return v; }

DI void attns_item(KP pk_in, unsigned char* lds, int sbi, int head) {
    KP pk = pk_in; asm volatile("" : "+s"(pk));
    unsigned char* ws = pk->ws;
    const int tid = otid(), w = tid >> 6, lane = tid & 63;
    const bf16_t* proj = (const bf16_t*)(ws + W_PROJ); bf16_t* mix = (bf16_t*)(ws + W_MIX);
    float* qs = (float*)lds; float* sc = qs + 1024; float* ored = sc + 1024;
    __syncthreads();
    for (int idx = tid; idx < 1024; idx += 512) { const int t = idx >> 8, d = idx & 255; qs[idx] = bf2f(proj[(size_t)(NTOKP + sbi * 4 + t) * NPROJ + C_Q + head * 256 + d]); }
    __syncthreads();
    f32x4 qv[4];
#pragma unroll
    for (int t = 0; t < 4; ++t) qv[t] = *(const f32x4*)(qs + t * 256 + lane * 4);
    for (int m0 = w; m0 < 256; m0 += 64) { f32x4 kv[8];
#pragma unroll
        for (int i = 0; i < 8; ++i) kv[i] = *(const f32x4*)(pk->cache_k + ((size_t)(sbi * 256 + m0 + 8 * i) * 4 + head) * 256 + lane * 4);
        float v32[32];
#pragma unroll
        for (int i = 0; i < 8; ++i)
#pragma unroll
            for (int t = 0; t < 4; ++t) v32[i * 4 + t] = kv[i][0] * qv[t][0] + kv[i][1] * qv[t][1] + kv[i][2] * qv[t][2] + kv[i][3] * qv[t][3];
        float v16[16], v8[8], v4[4], v2[2];
        { const bool up = (lane & 32) != 0;
#pragma unroll
          for (int i = 0; i < 16; ++i) { const float keep = up ? v32[i + 16] : v32[i], send = up ? v32[i] : v32[i + 16]; v16[i] = keep + shx(send, 32, lane); } }
        { const bool up = (lane & 16) != 0;
#pragma unroll
          for (int i = 0; i < 8; ++i) { const float keep = up ? v16[i + 8] : v16[i], send = up ? v16[i] : v16[i + 8]; v8[i] = keep + shx(send, 16, lane); } }
        { const bool up = (lane & 8) != 0;
#pragma unroll
          for (int i = 0; i < 4; ++i) { const float keep = up ? v8[i + 4] : v8[i], send = up ? v8[i] : v8[i + 4]; v4[i] = keep + shx(send, 8, lane); } }
        { const bool up = (lane & 4) != 0;
#pragma unroll
          for (int i = 0; i < 2; ++i) { const float keep = up ? v4[i + 2] : v4[i], send = up ? v4[i] : v4[i + 2]; v2[i] = keep + shx(send, 4, lane); } }
        float v1; { const bool up = (lane & 2) != 0; const float keep = up ? v2[1] : v2[0], send = up ? v2[0] : v2[1]; v1 = keep + shx(send, 2, lane); }
        v1 += shx(v1, 1, lane);
        if ((lane & 1) == 0) { const int ii = lane >> 1; sc[(ii & 3) * 256 + m0 + 8 * (ii >> 2)] = v1 * 0.0625f; } }
    __syncthreads();
    if (w < 4) { const f32x4 v = *(const f32x4*)(sc + w * 256 + lane * 4); float mx = fmaxf(fmaxf(v[0], v[1]), fmaxf(v[2], v[3])); mx = wave_max(mx, lane);
        f32x4 e; e[0] = __expf(v[0] - mx); e[1] = __expf(v[1] - mx); e[2] = __expf(v[2] - mx); e[3] = __expf(v[3] - mx); float s = wave_sum(e[0] + e[1] + e[2] + e[3], lane); const float inv = 1.f / s;
        *(f32x4*)(sc + w * 256 + lane * 4) = e * inv; }
    __syncthreads();
    f32x4 acc[4];
#pragma unroll
    for (int t = 0; t < 4; ++t) acc[t] = (f32x4){0.f, 0.f, 0.f, 0.f};
    for (int m0 = w; m0 < 256; m0 += 64) { f32x4 vv[8];
#pragma unroll
        for (int i = 0; i < 8; ++i) vv[i] = *(const f32x4*)(pk->cache_v + ((size_t)(sbi * 256 + m0 + 8 * i) * 4 + head) * 256 + lane * 4);
#pragma unroll
        for (int i = 0; i < 8; ++i)
#pragma unroll
            for (int t = 0; t < 4; ++t) acc[t] += vv[i] * sc[t * 256 + m0 + 8 * i]; }
#pragma unroll
    for (int t = 0; t < 4; ++t) *(f32x4*)(ored + (w * 4 + t) * 256 + lane * 4) = acc[t];
    __syncthreads();
    for (int idx = tid; idx < 1024; idx += 512) { const int t = idx >> 8, d = idx & 255; float s = 0.f;
#pragma unroll
        for (int ww = 0; ww < 8; ++ww) s += ored[(ww * 4 + t) * 256 + d];
        const size_t tok = (size_t)(NTOKP + sbi * 4 + t); const float gate = bf2f(proj[tok * NPROJ + C_XG + head * 256 + d]); mix[tok * DMIX + 2048 + head * 256 + d] = f2bf(s * siluf(gate)); }
}

DI void ssds_item(KP pk_in, unsigned char* lds, int sbi, int g) {
    KP pk = pk_in; asm volatile("" : "+s"(pk));
    unsigned char* ws = pk->ws;
    const int tid = otid(), w = tid >> 6, lane = tid & 63;
    const bf16_t* proj = (const bf16_t*)(ws + W_PROJ); bf16_t* mix = (bf16_t*)(ws + W_MIX); const float* wdf = (const float*)(ws + W_WDTF);
    float* xs = (float*)lds; float* Bs = xs + 2048; float* Cs = Bs + 512; float* yg = Cs + 512; float* dts = yg + 2048; float* decs = dts + 32;
    __syncthreads();
#pragma unroll
    for (int d = 0; d < 4; ++d) { const int pi = w * 4 + d, t = pi & 3, hl = pi >> 2, h = 8 * g + hl; float s = 0.f;
#pragma unroll
        for (int i = 0; i < 4; ++i) { const f32x4 xv = *(const f32x4*)(pk->x_sample + (size_t)(sbi * 4 + t) * 1024 + i * 256 + lane * 4), wv = *(const f32x4*)(wdf + h * 1024 + i * 256 + lane * 4);
            s += xv[0] * wv[0] + xv[1] * wv[1] + xv[2] * wv[2] + xv[3] * wv[3]; }
        s = wave_sum(s, lane);
        if (lane == 0) { const float dt = softplusf(s + pk->ssd_dt_bias[h]); dts[t * 8 + hl] = dt; decs[t * 8 + hl] = __expf(-dt * __expf(pk->ssd_a_log[h])); } }
    for (int idx = tid; idx < 4 * 768; idx += 512) { const int t = idx / 768, cc = idx % 768; const int ch = cc < 512 ? g * 512 + cc : (cc < 640 ? 1024 + g * 128 + (cc - 512) : 1280 + g * 128 + (cc - 640));
        float acc = pk->ssd_conv_b[ch];
#pragma unroll
        for (int kk = 0; kk < 4; ++kk) { const int ui = t + kk; const float x = ui < 3 ? pk->state_ssd_conv[(size_t)(sbi * 3 + ui) * 1536 + ch] : bf2f(proj[(size_t)(NTOKP + sbi * 4 + ui - 3) * NPROJ + C_XBC + ch]);
            acc += x * pk->ssd_conv_w[kk * 1536 + ch]; }
        const float a = siluf(acc);
        if (cc < 512) xs[t * 512 + cc] = a; else if (cc < 640) Bs[t * 128 + cc - 512] = a; else Cs[t * 128 + cc - 640] = a; }
    for (int idx = tid; idx < 3 * 768; idx += 512) { const int jj = idx / 768, cc = idx % 768; const int ch = cc < 512 ? g * 512 + cc : (cc < 640 ? 1024 + g * 128 + (cc - 512) : 1280 + g * 128 + (cc - 640));
        pk->out[O_SCS + (size_t)(sbi * 3 + jj) * 1536 + ch] = bf2f(proj[(size_t)(NTOKP + sbi * 4 + 1 + jj) * NPROJ + C_XBC + ch]); }
    __syncthreads();
    const int pp = tid >> 3, n0 = (tid & 7) * 16;
    f32x4 hs[4], hn[4];
#pragma unroll
    for (int v = 0; v < 4; ++v) hn[v] = *(const f32x4*)(pk->state_ssd_h + ((size_t)(sbi * 16 + 8 * g) * 64 + pp) * 128 + n0 + v * 4);
    for (int hl = 0; hl < 8; ++hl) { const int h = 8 * g + hl; const size_t so = ((size_t)(sbi * 16 + h) * 64 + pp) * 128 + n0;
#pragma unroll
        for (int v = 0; v < 4; ++v) hs[v] = hn[v];
        if (hl < 7) {
#pragma unroll
            for (int v = 0; v < 4; ++v) hn[v] = *(const f32x4*)(pk->state_ssd_h + so + 8192 + v * 4); }
        const float dsk = pk->ssd_d[h];
#pragma unroll
        for (int t = 0; t < 4; ++t) { const float dec = decs[t * 8 + hl], xv = xs[t * 512 + hl * 64 + pp], dtx = dts[t * 8 + hl] * xv; float part = 0.f;
#pragma unroll
            for (int v = 0; v < 4; ++v) { const f32x4 bv = *(const f32x4*)(Bs + t * 128 + n0 + v * 4), cv = *(const f32x4*)(Cs + t * 128 + n0 + v * 4);
                hs[v] = hs[v] * dec + bv * dtx; part += cv[0] * hs[v][0] + cv[1] * hs[v][1] + cv[2] * hs[v][2] + cv[3] * hs[v][3]; }
            part += shx(part, 1, lane); part += shx(part, 2, lane); part += shx(part, 4, lane);
            if ((tid & 7) == 0) { const float y = part + dsk * xv; const float z = bf2f(proj[(size_t)(NTOKP + sbi * 4 + t) * NPROJ + C_Z + h * 64 + pp]); yg[t * 512 + hl * 64 + pp] = y * siluf(z); } }
#pragma unroll
        for (int v = 0; v < 4; ++v) *(f32x4*)(pk->out + O_SHS + so + v * 4) = hs[v];
    }
    __syncthreads();
    if (w < 4) { const int t = w; float ss = 0.f; float v[8];
#pragma unroll
        for (int e = 0; e < 8; ++e) { v[e] = yg[t * 512 + e * 64 + lane]; ss += v[e] * v[e]; }
        ss = wave_sum(ss, lane); const float rstd = rsqrtf(ss * (1.f / 512.f) + 1e-5f);
#pragma unroll
        for (int e = 0; e < 8; ++e) { const int cc = e * 64 + lane; mix[(size_t)(NTOKP + sbi * 4 + t) * DMIX + 1024 + g * 512 + cc] = f2bf(v[e] * rstd * pk->ssd_norm_g[g * 512 + cc]); } }
}

DI void ssd3_item(KP pk_in, unsigned char* lds, int b, int c, int g) {
    KP pk = pk_in; asm volatile("" : "+s"(pk));
    unsigned char* ws = pk->ws;
    const int tid = otid(), w = tid >> 6, lane = tid & 63, l15 = lane & 15, q = lane >> 4;
    float* acum_s = (float*)lds; float* dt_s = acum_s + 1024;
    bf16_t* xT = (bf16_t*)(lds + 8192);
    const bf16_t* proj = (const bf16_t*)(ws + W_PROJ); const bf16_t* xact = (const bf16_t*)(ws + W_XACT); bf16_t* mix = (bf16_t*)(ws + W_MIX);
    const float* dt_g = (const float*)(ws + W_DT); const float* acum_g = (const float*)(ws + W_ACUM); const float* st_g = (const float*)(ws + W_ST);
    const int tok0 = b * 2048 + c * 128;
    __syncthreads();
    for (int idx = tid; idx < 1024; idx += 512) { const int j = idx >> 3, hl = idx & 7; acum_s[idx] = acum_g[(size_t)(tok0 + j) * 16 + 8 * g + hl]; dt_s[idx] = dt_g[(size_t)(tok0 + j) * 16 + 8 * g + hl]; }
    bf16x8 cf[4];
#pragma unroll
    for (int ks = 0; ks < 4; ++ks) cf[ks] = *(const bf16x8*)(xact + (size_t)(tok0 + 16 * w + l15) * 1536 + 1280 + g * 128 + ks * 32 + q * 8);
    f32x4 cbt[8];
#pragma unroll
    for (int jt = 0; jt < 8; ++jt) { cbt[jt] = (f32x4){0.f, 0.f, 0.f, 0.f};
        if (jt <= w) {
#pragma unroll
            for (int ks = 0; ks < 4; ++ks) { const bf16x8 bfr = *(const bf16x8*)(xact + (size_t)(tok0 + 16 * jt + l15) * 1536 + 1024 + g * 128 + ks * 32 + q * 8); cbt[jt] = MFMA16(bfr, cf[ks], cbt[jt]); } } }
    float ssq[4] = {0.f, 0.f, 0.f, 0.f};
    const int irow = 16 * w + l15;
    for (int hl = 0; hl < 8; ++hl) { const int h = 8 * g + hl;
        __syncthreads();
        for (int idx = tid; idx < 1024; idx += 512) { const int j = idx >> 3, pv = (idx & 7) * 8; const u32x4 v = *(const u32x4*)(xact + (size_t)(tok0 + j) * 1536 + g * 512 + hl * 64 + pv);
            const bf16_t* e16 = (const bf16_t*)&v; (void)e16;
            xT[(pv + 0) * 136 + j] = (bf16_t)(v.x & 0xFFFF); xT[(pv + 1) * 136 + j] = (bf16_t)(v.x >> 16); xT[(pv + 2) * 136 + j] = (bf16_t)(v.y & 0xFFFF); xT[(pv + 3) * 136 + j] = (bf16_t)(v.y >> 16);
            xT[(pv + 4) * 136 + j] = (bf16_t)(v.z & 0xFFFF); xT[(pv + 5) * 136 + j] = (bf16_t)(v.z >> 16); xT[(pv + 6) * 136 + j] = (bf16_t)(v.w & 0xFFFF); xT[(pv + 7) * 136 + j] = (bf16_t)(v.w >> 16); }
        __syncthreads();
        const float ai = acum_s[irow * 8 + hl];
        bf16x8 af[4];
#pragma unroll
        for (int s = 0; s < 4; ++s) { float m8[8];
#pragma unroll
            for (int hf = 0; hf < 2; ++hf) { const int jt = 2 * s + hf;
#pragma unroll
                for (int r = 0; r < 4; ++r) { const int j = 16 * jt + 4 * q + r; float val = 0.f;
                    if (jt <= w && j <= irow) val = cbt[jt][r] * __expf(ai - acum_s[j * 8 + hl]) * dt_s[j * 8 + hl];
                    m8[hf * 4 + r] = val; } }
            af[s] = as_frag(pack8(m8)); }
        const float dsk = pk->ssd_d[h];
        float ea[4];
#pragma unroll
        for (int r = 0; r < 4; ++r) ea[r] = __expf(acum_s[(16 * w + 4 * q + r) * 8 + hl]);
        float zz[4][4];
#pragma unroll
        for (int pt = 0; pt < 4; ++pt)
#pragma unroll
            for (int r = 0; r < 4; ++r) zz[pt][r] = bf2f(proj[(size_t)(tok0 + 16 * w + 4 * q + r) * NPROJ + C_Z + h * 64 + 16 * pt + l15]);
#pragma unroll
        for (int pt = 0; pt < 4; ++pt) { f32x4 yd = {0.f, 0.f, 0.f, 0.f}, yo = {0.f, 0.f, 0.f, 0.f};
            const bf16_t* xr = xT + (16 * pt + l15) * 136;
#pragma unroll
            for (int s = 0; s < 4; ++s) if (2 * s <= w) { const u32x2 lo = *(const u32x2*)(xr + 32 * s + 4 * q), hi = *(const u32x2*)(xr + 32 * s + 16 + 4 * q); yd = MFMA16(af[s], frag2(lo, hi), yd); }
            const float* hp = st_g + ((size_t)((b * 16 + c) * 16 + h) * 64 + 16 * pt + l15) * 128 + q * 8;
#pragma unroll
            for (int ks = 0; ks < 4; ++ks) { const f32x4 f0 = *(const f32x4*)(hp + ks * 32), f1 = *(const f32x4*)(hp + ks * 32 + 4); float m8[8] = {f0[0], f0[1], f0[2], f0[3], f1[0], f1[1], f1[2], f1[3]};
                yo = MFMA16(cf[ks], as_frag(pack8(m8)), yo); }
            const u32x2 xv2 = *(const u32x2*)(xr + 16 * w + 4 * q); const float xv[4] = {bflo(xv2.x), bfhi(xv2.x), bflo(xv2.y), bfhi(xv2.y)};
#pragma unroll
            for (int r = 0; r < 4; ++r) { const size_t tok = (size_t)(tok0 + 16 * w + 4 * q + r); const int pp = 16 * pt + l15;
                const float y = yd[r] + ea[r] * yo[r] + dsk * xv[r]; const float val = y * siluf(zz[pt][r]);
                ssq[r] += val * val; mix[tok * DMIX + 1024 + g * 512 + hl * 64 + pp] = f2bf(val); } }
    }
    float rstd[4];
#pragma unroll
    for (int r = 0; r < 4; ++r) { float s = ssq[r]; s += shx(s, 1, lane); s += shx(s, 2, lane); s += shx(s, 4, lane); s += shx(s, 8, lane); rstd[r] = rsqrtf(s * (1.f / 512.f) + 1e-5f); }
    for (int hl = 0; hl < 8; ++hl)
#pragma unroll
        for (int pt = 0; pt < 4; ++pt) { const int cc = hl * 64 + 16 * pt + l15; const float gn = pk->ssd_norm_g[g * 512 + cc];
#pragma unroll
            for (int r = 0; r < 4; ++r) { bf16_t* mp = mix + (size_t)(tok0 + 16 * w + 4 * q + r) * DMIX + 1024 + g * 512 + cc; *mp = f2bf(bf2f(*mp) * rstd[r] * gn); } }
}

DI void ln_rows(KP pk_in) {
    KP pk = pk_in; asm volatile("" : "+s"(pk));
    const float* res = (const float*)(pk->ws + W_RES);
    const int tid = otid(); const int lane = tid & 63; const int gw = obid() * 8 + (tid >> 6), nw = gridDim.x * 8;
    f32x4 gg[4], bb[4];
#pragma unroll
    for (int i = 0; i < 4; ++i) { gg[i] = *(const f32x4*)(pk->ln_g + i * 256 + lane * 4); bb[i] = *(const f32x4*)(pk->ln_b + i * 256 + lane * 4); }
    for (int row = gw; row < NTOK; row += nw) { f32x4 v[4]; float s = 0.f;
#pragma unroll
        for (int i = 0; i < 4; ++i) { v[i] = *(const f32x4*)(res + (size_t)row * 1024 + i * 256 + lane * 4); s += v[i][0] + v[i][1] + v[i][2] + v[i][3]; }
        const float mu = wave_sum(s, lane) * (1.f / 1024.f); float s2 = 0.f;
#pragma unroll
        for (int i = 0; i < 4; ++i) { v[i] = v[i] - mu; s2 += v[i][0] * v[i][0] + v[i][1] * v[i][1] + v[i][2] * v[i][2] + v[i][3] * v[i][3]; }
        const float rstd = rsqrtf(wave_sum(s2, lane) * (1.f / 1024.f) + 1e-5f);
#pragma unroll
        for (int i = 0; i < 4; ++i) *(f32x4*)(pk->out + (size_t)row * 1024 + i * 256 + lane * 4) = v[i] * rstd * gg[i] + bb[i]; }
}

__global__ void __launch_bounds__(512, 2) hymba_fwd(Params p_unused) {
    KP pk = kparams();
    extern __shared__ __attribute__((aligned(16))) unsigned char shm[];
    cg::grid_group grid = cg::this_grid();
    const int G = gridDim.x;
    if (threadIdx.x < 4) ((volatile LAS unsigned*)(LAS unsigned char*)shm)[32768 + threadIdx.x] = 0u;
    __syncthreads();
    const int ph_lo_chk = pk->ph_lo;
    XcdBarrier xb = xcd_barrier_post((unsigned*)(pk->ws + W_BAR), (volatile LAS unsigned*)(LAS unsigned char*)shm + 32768);
    if (ph_lo_chk < 0) grid.sync();
    { KP pk = kparams(); for (int rep = 0; rep < REP0; ++rep) phase_prep(pk, shm); }
    xcd_barrier(xb);
    { KP pk = kparams(); const int bid = obid();
      for (int rep = 0; rep < REP1; ++rep) {
        { pg8::Gemm g; g.A = (const bf16_t*)(pk->ws + W_XB); g.Bt = (const bf16_t*)(pk->ws + W_WINT); g.M = NTOK; g.N = NPROJ; g.K = 1024;
          pg8::StaticOrder S; S.init(g.M, g.N, G, bid); pg8::EpiBf16 E; E.O = (bf16_t*)(pk->ws + W_PROJ); E.ldc = NPROJ;
          pg8::gemm_phase<pg8::EpiBf16, pg8::StaticOrder>((LAS unsigned char*)shm, g, S, E); }
        { pg8::Gemm g; g.A = (const bf16_t*)(pk->ws + W_MEMB); g.Bt = (const bf16_t*)(pk->ws + W_WKVT); g.M = 2048; g.N = 2048; g.K = 1024;
          const int shift = (66 * 26) % G; pg8::StaticOrder S; S.init(g.M, g.N, G, (bid + G - shift) % G);
          pg8::EpiKV E; E.mk = pk->out + O_MKP; E.mv = pk->out + O_MVP; E.kb = (bf16_t*)(pk->ws + W_KB); E.vt = (bf16_t*)(pk->ws + W_VT);
          pg8::gemm_phase<pg8::EpiKV, pg8::StaticOrder>((LAS unsigned char*)shm, g, S, E); } } }
    xcd_barrier(xb);
    { KP pk = kparams(); const int bid = obid();
      for (int rep = 0; rep < REP2; ++rep) for (int it = bid; it < 256; it += G) ssd1_item(pk, shm, it >> 5, (it >> 1) & 15, it & 1); }
    xcd_barrier(xb);
    { KP pk = kparams(); const int bid = obid();
      for (int rep = 0; rep < REP3; ++rep) for (int it = bid; it < 1920; it += G) {
          if (rep > 0 && (it < R3LO || it >= R3HI)) continue;
          if (it < 256) rg_item(pk, shm, false, it >> 5, (it >> 2) & 7, it & 3);
          else if (it < 512) statepass_item(pk, it - 256);
          else if (it < 640) { const int u = it - 512; rg_item(pk, shm, true, u >> 5, (u >> 2) & 7, u & 3); }
          else if (it < 896) { const int u = it - 640; ssds_item(pk, shm, u >> 1, u & 1); }
          else if (it < 1408) { const int u = it - 896; attns_item(pk, shm, u >> 2, u & 3); }
          else { const int u = it - 1408; attnp_item(pk, shm, u >> 6, (u >> 4) & 3, u & 15); } } }
    xcd_barrier(xb);
    { KP pk = kparams(); const int bid = obid();
      for (int rep = 0; rep < REP4; ++rep) for (int it = bid; it < 256; it += G) ssd3_item(pk, shm, it >> 5, (it >> 1) & 15, it & 1); }
    xcd_barrier(xb);
    { KP pk = kparams(); const int bid = obid();
      for (int rep = 0; rep < REP5; ++rep) {
        pg8::Gemm g; g.A = (const bf16_t*)(pk->ws + W_MIX); g.Bt = (const bf16_t*)(pk->ws + W_WOUTT); g.M = NTOK; g.N = 1024; g.K = 3072;
        pg8::StaticOrder S; S.init(g.M, g.N, G, bid); pg8::EpiRes E; E.res = (float*)(pk->ws + W_RES); E.xp = pk->x_prompt; E.xs = pk->x_sample; E.alpha = 1.189207115002721f;
        pg8::gemm_phase<pg8::EpiRes, pg8::StaticOrder>((LAS unsigned char*)shm, g, S, E); } }
    xcd_barrier(xb);
    { KP pk = kparams(); for (int rep = 0; rep < REP6; ++rep) ln_rows(pk); }
}

extern "C" void kernel_launch(void* const* d_in, const int* in_sizes, int n_in, void* d_out, int out_size, void* d_ws, size_t ws_size, hipStream_t stream) {
    static int grid_blocks = 0;
    if (!grid_blocks) {
        int dev = 0, cus = 0, per_cu = 0;
        hipGetDevice(&dev);
        hipDeviceGetAttribute(&cus, hipDeviceAttributeMultiprocessorCount, dev);
        if (hipFuncSetAttribute((const void*)hymba_fwd, hipFuncAttributeMaxDynamicSharedMemorySize, LDS_BYTES) != hipSuccess) fprintf(stderr, "hipFuncSetAttribute failed\n");
        hipOccupancyMaxActiveBlocksPerMultiprocessor(&per_cu, (const void*)hymba_fwd, 512, LDS_BYTES);
        if (per_cu < 1) { fprintf(stderr, "occupancy query says %d blocks per CU\n", per_cu); per_cu = 1; }
        grid_blocks = cus * 1;
        if (ws_size < W_END) fprintf(stderr, "workspace too small: %zu < %zu\n", ws_size, (size_t)W_END);
    }
    if (hipMemsetAsync((char*)d_ws + W_BAR, 0, 3456 * 4, stream) != hipSuccess) fprintf(stderr, "memset failed\n");
    Params p{};
    const float** fp = (const float**)&p;
    for (int i = 0; i < 28; ++i) fp[i] = (const float*)d_in[i];
    p.out = (float*)d_out; p.ws = (unsigned char*)d_ws;
    p.ph_lo = 0; p.ph_hi = NPHASE;
    void* args[] = {&p};
    hipError_t e = hipLaunchCooperativeKernel((const void*)hymba_fwd, dim3(grid_blocks), dim3(512), args, LDS_BYTES, stream);
    if (e != hipSuccess) fprintf(stderr, "cooperative launch failed: %s (grid %d)\n", hipGetErrorString(e), grid_blocks);
}
```

```cpp
#include <hip/hip_runtime.h>
#include <hip/hip_cooperative_groups.h>
#include <cstdio>
namespace cg = cooperative_groups;

#ifndef REP2
#define REP2 1
#endif
#ifndef REP3
#define REP3 1
#endif
#ifndef REP4
#define REP4 1
#endif
#ifndef R3LO
#define R3LO 0
#define R3HI 256
#endif
#ifndef REP0
#define REP0 1
#endif
#ifndef REP1
#define REP1 1
#endif
#ifndef REP5
#define REP5 1
#endif
#ifndef REP6
#define REP6 1
#endif
#ifndef REPS
#define REPS 1
#endif
#ifndef PHM
#define PHM 127
#endif
#ifndef N_LAUNCH_PER_PHASE
#define N_LAUNCH_PER_PHASE 0
#endif

#define DI __device__ __forceinline__
#define LAS __attribute__((address_space(3)))
typedef unsigned short bf16_t;
typedef short bf16x8 __attribute__((ext_vector_type(8)));
typedef float f32x4 __attribute__((ext_vector_type(4)));
typedef unsigned u32x4 __attribute__((ext_vector_type(4)));
typedef unsigned u32x2 __attribute__((ext_vector_type(2)));

constexpr int NTOKP = 16384, NTOKS = 512, NTOK = 16896, DM = 1024, NPROJ = 6656, DMIX = 3072, DIN = 6672;
constexpr int C_RGX = 0, C_RGG = 1024, C_XBC = 2048, C_Z = 3584, C_Q = 4608, C_XG = 5632;
constexpr int NPHASE = 7;
constexpr int LDS_BYTES = 131072 + 64;

constexpr size_t O_YP = 0, O_YS = O_YP + (size_t)NTOKP * DM, O_RGCP = O_YS + (size_t)NTOKS * DM, O_RGHP = O_RGCP + 8 * 3 * 1024, O_SCP = O_RGHP + 8 * 1024,
                 O_SHP = O_SCP + 8 * 3 * 1536, O_MKP = O_SHP + (size_t)8 * 16 * 64 * 128, O_MVP = O_MKP + (size_t)2048 * 1024, O_RGCS = O_MVP + (size_t)2048 * 1024,
                 O_RGHS = O_RGCS + (size_t)128 * 3 * 1024, O_SCS = O_RGHS + 128 * 1024, O_SHS = O_SCS + (size_t)128 * 3 * 1536;

constexpr size_t al256(size_t x) { return (x + 255) & ~(size_t)255; }
constexpr size_t W_XB = 0;
constexpr size_t W_WINT = al256(W_XB + (size_t)NTOK * DM * 2);
constexpr size_t W_WDTT = al256(W_WINT + (size_t)NPROJ * DM * 2);
constexpr size_t W_WDTF = al256(W_WDTT + 16 * 1024 * 2);
constexpr size_t W_WOUTT = al256(W_WDTF + 16 * 1024 * 4);
constexpr size_t W_WKVT = al256(W_WOUTT + (size_t)1024 * 3072 * 2);
constexpr size_t W_MEMB = al256(W_WKVT + (size_t)2048 * 1024 * 2);
constexpr size_t W_WGT = al256(W_MEMB + (size_t)2048 * 1024 * 2);
constexpr size_t W_KB = al256(W_WGT + (size_t)8 * 4 * 64 * 128 * 2);
constexpr size_t W_VT = al256(W_KB + (size_t)2048 * 1024 * 2);
constexpr size_t W_XACT = al256(W_VT + (size_t)2048 * 1024 * 2);
constexpr size_t W_DT = al256(W_XACT + (size_t)NTOKP * 1536 * 2);
constexpr size_t W_ACUM = al256(W_DT + (size_t)NTOKP * 16 * 4);
constexpr size_t W_CD = al256(W_ACUM + (size_t)NTOKP * 16 * 4);
constexpr size_t W_ST = al256(W_CD + 8 * 16 * 16 * 4);
constexpr size_t W_MIX = al256(W_ST + (size_t)8 * 16 * 16 * 8192 * 4);
constexpr size_t W_PROJ = al256(W_MIX + (size_t)NTOK * DMIX * 2);
constexpr size_t W_RES = W_PROJ;
constexpr size_t W_BAR = al256(W_PROJ + (size_t)NTOK * NPROJ * 2);
constexpr size_t W_END = al256(W_BAR + 3456 * 4);

struct Params {
    const float *x_prompt, *x_sample, *mem_prompt, *state_rg_conv, *state_rg_h, *state_ssd_conv, *state_ssd_h, *cache_k, *cache_v;
    const float *w_in, *rg_conv_w, *rg_conv_b, *w_rg_a, *b_rg_a, *w_rg_i, *b_rg_i, *rg_lambda, *ssd_conv_w, *ssd_conv_b, *ssd_dt_bias, *ssd_a_log, *ssd_d, *ssd_norm_g,
        *w_mem_k, *w_mem_v, *w_out, *ln_g, *ln_b;
    float* out; unsigned char* ws;
    int ph_lo, ph_hi;
};
typedef const __attribute__((address_space(4))) Params* KP;
DI KP kparams() { KP k = (KP)__builtin_amdgcn_kernarg_segment_ptr(); asm volatile("" : "+s"(k)); return k; }

DI int otid() { int t = threadIdx.x; asm volatile("" : "+v"(t)); return t; }
DI int obid() { int t = blockIdx.x; asm volatile("" : "+s"(t)); return t; }
DI float bf2f(bf16_t b) { return __uint_as_float(((unsigned)b) << 16); }
typedef __bf16 hbf2 __attribute__((ext_vector_type(2)));
typedef float f32x2 __attribute__((ext_vector_type(2)));
DI unsigned pack2(float lo, float hi) { const f32x2 v = {lo, hi}; return __builtin_bit_cast(unsigned, __builtin_convertvector(v, hbf2)); }
DI bf16_t f2bf(float f) { return (bf16_t)(pack2(f, 0.f) & 0xFFFFu); }
DI float bflo(unsigned w) { return __uint_as_float(w << 16); }
DI float bfhi(unsigned w) { return __uint_as_float(w & 0xFFFF0000u); }
DI void unpack8(const u32x4 v, float (&o)[8]) { o[0] = bflo(v.x); o[1] = bfhi(v.x); o[2] = bflo(v.y); o[3] = bfhi(v.y); o[4] = bflo(v.z); o[5] = bfhi(v.z); o[6] = bflo(v.w); o[7] = bfhi(v.w); }
DI u32x4 pack8(const float (&o)[8]) { u32x4 w; w.x = pack2(o[0], o[1]); w.y = pack2(o[2], o[3]); w.z = pack2(o[4], o[5]); w.w = pack2(o[6], o[7]); return w; }
DI bf16x8 as_frag(u32x4 w) { return __builtin_bit_cast(bf16x8, w); }
DI bf16x8 frag2(u32x2 lo, u32x2 hi) { u32x4 w; w.x = lo.x; w.y = lo.y; w.z = hi.x; w.w = hi.y; return __builtin_bit_cast(bf16x8, w); }
DI float shx(float v, int m, int lane) { return __int_as_float(__builtin_amdgcn_ds_bpermute((lane ^ m) << 2, __float_as_int(v))); }
DI float shl(float v, int src) { return __int_as_float(__builtin_amdgcn_ds_bpermute(src << 2, __float_as_int(v))); }
DI float siluf(float x) { return x * __builtin_amdgcn_rcpf(1.f + __expf(-x)); }
DI float sigmf(float x) { return __builtin_amdgcn_rcpf(1.f + __expf(-x)); }
DI float softplusf(float v) { return v > 20.f ? v : __logf(1.f + __expf(v)); }
#define MFMA16(a, b, c) __builtin_amdgcn_mfma_f32_16x16x32_bf16((a), (b), (c), 0, 0, 0)

#define XB_TMO      128
#define XB_XCNT(j)  (256  + 64 * (j))
#define XB_XSUB(j)  (1280 + 64 * (j))
#define XB_XGEN(j)  (2304 + 64 * (j))
#define XB_TOP      3328
#define XB_TOPGEN   3392
#define XCD_BAR_WORDS 3456
#define XB_SPIN_CAP (1u << 20)
DI unsigned xb_ld(unsigned* ptr)              { return __hip_atomic_load(ptr, __ATOMIC_RELAXED, __HIP_MEMORY_SCOPE_AGENT); }
DI unsigned xb_add(unsigned* ptr, unsigned v) { return __hip_atomic_fetch_add(ptr, v, __ATOMIC_RELAXED, __HIP_MEMORY_SCOPE_AGENT); }
DI unsigned xb_xcc_id() { return (unsigned)__builtin_amdgcn_s_getreg((3 << 11) | 20) & 0xFu; }
#define XB_SPIN(cond, bar) do { unsigned _sp = 0; while (cond) { __builtin_amdgcn_s_sleep(1); \
    if ((++_sp & 255u) == 0u) { if (xb_ld(&(bar)[XB_TMO])) break; if (_sp > XB_SPIN_CAP) { atomicAdd(&(bar)[XB_TMO], 1u); break; } } } } while (0)
struct XcdBarrier { unsigned* bar; unsigned x; volatile LAS unsigned* st; };
DI XcdBarrier xcd_barrier_post(unsigned* bar, volatile LAS unsigned* st) {
    XcdBarrier b; b.bar = bar; b.x = xb_xcc_id(); b.st = st;
    if (threadIdx.x == 0) (void)xb_add(&bar[XB_XCNT(b.x)], 1u);
    return b;
}
DI void xcd_barrier_complete(unsigned* bar, unsigned x, unsigned& nloc, unsigned& nx) {
    const unsigned G = gridDim.x * gridDim.y * gridDim.z;
    unsigned sum, cnt, mine, sp = 0u;
    for (;;) {
        sum = 0u; cnt = 0u; mine = 0u;
#pragma unroll
        for (unsigned j = 0; j < 16; ++j) { const unsigned c = xb_ld(&bar[XB_XCNT(j)]); sum += c; cnt += (c > 0u) ? 1u : 0u; mine = (j == x) ? c : mine; }
        if (sum == G) break;
        __builtin_amdgcn_s_sleep(1);
        if ((++sp & 255u) == 0u) { if (xb_ld(&bar[XB_TMO])) break; if (sp > XB_SPIN_CAP) { atomicAdd(&bar[XB_TMO], 1u); break; } }
    }
    nloc = mine > 0u ? mine : 1u; nx = cnt > 0u ? cnt : 1u;
}
DI void xcd_barrier(const XcdBarrier& b) {
    asm volatile("s_waitcnt vmcnt(0)" ::: "memory");
    __syncthreads();
    if (threadIdx.x == 0) {
        unsigned* bar = b.bar;
        __builtin_amdgcn_s_waitcnt(0);
        unsigned nloc = b.st[0], nx = b.st[1];
        if (nloc == 0u) { xcd_barrier_complete(bar, b.x, nloc, nx); b.st[0] = nloc; b.st[1] = nx; }
        const unsigned old = xb_add(&bar[XB_XSUB(b.x)], 1u);
        const unsigned gen = old / nloc;
        if (old + 1u == (gen + 1u) * nloc) {
            __builtin_amdgcn_fence(__ATOMIC_RELEASE, "agent");
            asm volatile("s_waitcnt vmcnt(0)" ::: "memory");
            const unsigned og = xb_add(&bar[XB_TOP], 1u);
            const unsigned tg = og / nx;
            if (og + 1u == (tg + 1u) * nx) xb_add(&bar[XB_TOPGEN], 1u);
            else XB_SPIN(xb_ld(&bar[XB_TOPGEN]) == tg, bar);
            __builtin_amdgcn_fence(__ATOMIC_ACQUIRE, "agent");
            xb_add(&bar[XB_XGEN(b.x)], 1u);
            asm volatile("s_waitcnt vmcnt(0)" ::: "memory");
        } else {
            XB_SPIN(xb_ld(&bar[XB_XGEN(b.x)]) == gen, bar);
            __builtin_amdgcn_fence(__ATOMIC_ACQUIRE, "agent");
            asm volatile("s_waitcnt vmcnt(0)" ::: "memory");
        }
    }
    __syncthreads();
}

namespace pg8 {
constexpr int BM = 256, BK = 64, HALF = 128, HTB = HALF * BK * 2, STAGE_BYTES = 8 * HTB, NXCD = 8, WGM = 8;
DI int lds_byte(int r, int c) { const int st = (r >> 4) * 2 + (c >> 5), rr = r & 15, cc = c & 31, ob = rr * 64 + cc * 2; return st * 1024 + (ob ^ (((ob >> 9) & 1) << 5)); }
DI void stage_rc(int b, int& R, int& C) { const int st = b / 1024, sb = b % 1024, swz = sb ^ (((sb >> 9) & 1) << 5); R = (st >> 1) * 16 + swz / 64; C = (st & 1) * 32 + (swz % 64) / 2; }
DI int perm32(int rho) { const int n = rho >> 4, i = rho & 15; return 8 * (i >> 2) + 4 * n + (i & 3); }
struct Unit { int pm, pn; };
struct Gemm { const bf16_t* A; const bf16_t* Bt; int M, N, K; };
struct StaticOrder {
    int nM, nN, nwg, G, c;
    DI void init(int M, int N, int G_, int c_) { nM = M / BM; nN = N / BM; nwg = nM * nN; G = G_; c = c_; }
    DI bool next(int i, Unit& u) const {
        const long L = (long)i * G + c; if (L >= nwg) return false;
        int wgid = (int)L; { const int q = nwg / NXCD, r = nwg % NXCD, xcd = wgid % NXCD, off = wgid / NXCD; wgid = (xcd < r ? xcd * (q + 1) : r * (q + 1) + (xcd - r) * q) + off; }
        const int nig = WGM * nN, gid = wgid / nig, fm = gid * WGM, gsz = (nM - fm) < WGM ? (nM - fm) : WGM;
        u.pm = fm + ((wgid % nig) % gsz); u.pn = (wgid % nig) / gsz; return true;
    }
};
DI unsigned cvt_pk_bf16(float lo, float hi) { unsigned r; asm volatile("v_cvt_pk_bf16_f32 %0, %1, %2" : "=v"(r) : "v"(lo), "v"(hi)); return r; }

struct EpiBf16 {
    static constexpr bool PERM = true;
    bf16_t* O; int ldc;
    DI void operator()(const f32x4 (&acc)[2][2][4][2], const Unit& u, int wr, int wc, int fr, int fq) const {
        const int row0 = u.pm * BM + wr * 64 + fr; const int col0 = u.pn * BM + wc * 32 + 8 * fq;
#pragma unroll
        for (int ai = 0; ai < 2; ++ai)
#pragma unroll
            for (int m = 0; m < 4; ++m) { bf16_t* rowp = O + (size_t)(row0 + ai * HALF + m * 16) * ldc + col0;
#pragma unroll
                for (int bj = 0; bj < 2; ++bj) { const f32x4 v0 = acc[ai][bj][m][0], v1 = acc[ai][bj][m][1];
                    u32x4 w; w.x = cvt_pk_bf16(v0[0], v0[1]); w.y = cvt_pk_bf16(v0[2], v0[3]); w.z = cvt_pk_bf16(v1[0], v1[1]); w.w = cvt_pk_bf16(v1[2], v1[3]);
                    *(u32x4*)(rowp + bj * HALF) = w; } }
    }
};
struct EpiKV {
    static constexpr bool PERM = false;
    float* mk; float* mv; bf16_t* kb; bf16_t* vt;
    DI void operator()(const f32x4 (&acc)[2][2][4][2], const Unit& u, int wr, int wc, int fr, int fq) const {
        const int row0 = u.pm * BM + wr * 64 + fr, col0 = u.pn * BM + wc * 32 + 4 * fq;
#pragma unroll
        for (int ai = 0; ai < 2; ++ai)
#pragma unroll
            for (int m = 0; m < 4; ++m) { const int row = row0 + ai * HALF + m * 16;
#pragma unroll
                for (int bj = 0; bj < 2; ++bj)
#pragma unroll
                    for (int n = 0; n < 2; ++n) { const int col = col0 + bj * HALF + n * 16; const f32x4 v = acc[ai][bj][m][n];
                        if (col < 1024) { *(f32x4*)(mk + (size_t)row * 1024 + col) = v; u32x2 w; w.x = cvt_pk_bf16(v[0], v[1]); w.y = cvt_pk_bf16(v[2], v[3]); *(u32x2*)(kb + (size_t)row * 1024 + col) = w; }
                        else { const int cc = col - 1024; *(f32x4*)(mv + (size_t)row * 1024 + cc) = v; const int bb = row >> 8, mt = row & 255;
#pragma unroll
                            for (int j = 0; j < 4; ++j) { const int c2 = cc + j, head = c2 >> 8, d = c2 & 255; vt[((size_t)((bb * 4 + head) * 256 + d)) * 256 + mt] = f2bf(v[j]); } } } }
    }
};
struct EpiRes {
    static constexpr bool PERM = false;
    float* res; const float* xp; const float* xs; float alpha;
    DI void operator()(const f32x4 (&acc)[2][2][4][2], const Unit& u, int wr, int wc, int fr, int fq) const {
        const int row0 = u.pm * BM + wr * 64 + fr, col0 = u.pn * BM + wc * 32 + 4 * fq;
#pragma unroll
        for (int ai = 0; ai < 2; ++ai)
#pragma unroll
            for (int m = 0; m < 4; ++m) { const int row = row0 + ai * HALF + m * 16; const float* xr = row < NTOKP ? xp + (size_t)row * 1024 : xs + (size_t)(row - NTOKP) * 1024;
#pragma unroll
                for (int bj = 0; bj < 2; ++bj)
#pragma unroll
                    for (int n = 0; n < 2; ++n) { const int col = col0 + bj * HALF + n * 16; const f32x4 xv = *(const f32x4*)(xr + col);
                        *(f32x4*)(res + (size_t)row * 1024 + col) = acc[ai][bj][m][n] + xv * alpha; } }
    }
};

template <class Epi, class Sched>
DI void gemm_phase(LAS unsigned char* lds, const Gemm g, const Sched& S, const Epi& E) {
    const int tid = otid(), wid = __builtin_amdgcn_readfirstlane(tid >> 6), lane = tid & 63, wr = wid >> 2, wc = wid & 3, fr = lane & 15, fq = lane >> 4;
    const int K = g.K, nt = K / BK;
    unsigned voffA[2], voffB[2];
#pragma unroll
    for (int i = 0; i < 2; ++i) { int R, C; stage_rc(tid * 16 + i * 8192, R, C); const int Rb = Epi::PERM ? ((R & ~31) + perm32(R & 31)) : R;
        voffA[i] = (unsigned)(R * K + C) * 2u; voffB[i] = (unsigned)(Rb * K + C) * 2u; }
    const size_t kstep = (size_t)(BK * 2);
    const size_t hstep = (size_t)HALF * K * 2;
    const size_t tstep = 2 * hstep;
    const unsigned ldsw = (unsigned)wid * 1024u;
    const int aoff = lds_byte(wr * 64 + fr, fq * 8), boff = lds_byte(wc * 32 + fr, fq * 8);
#define PG8_SA(b, h) (((b) * 2 + (h)) * HTB)
#define PG8_SB(b, h) ((4 + (b) * 2 + (h)) * HTB)
#define PG8_STAGE(bufoff, gbase, voff) do { _Pragma("unroll") for (int _i = 0; _i < 2; ++_i) \
        __builtin_amdgcn_global_load_lds((const unsigned*)((const char*)(gbase) + (voff)[_i]), (LAS unsigned*)(lds + (bufoff) + ldsw + _i * 8192), 16, 0, 0); } while (0)
#define PG8_LDA(dst, b, h) do { _Pragma("unroll") for (int m = 0; m < 4; ++m) _Pragma("unroll") for (int k = 0; k < 2; ++k) dst[m][k] = *(const LAS bf16x8*)(lds + PG8_SA(b, h) + aoff + m * 2048 + k * 1024); } while (0)
#define PG8_LDB(dst, b, h) do { _Pragma("unroll") for (int n = 0; n < 2; ++n) _Pragma("unroll") for (int k = 0; k < 2; ++k) dst[n][k] = *(const LAS bf16x8*)(lds + PG8_SB(b, h) + boff + n * 2048 + k * 1024); } while (0)
#define PG8_MMA(ai, bj, At, Bt) do { __builtin_amdgcn_s_setprio(1); _Pragma("unroll") for (int m = 0; m < 4; ++m) _Pragma("unroll") for (int n = 0; n < 2; ++n) _Pragma("unroll") for (int k = 0; k < 2; ++k) \
        acc[ai][bj][m][n] = __builtin_amdgcn_mfma_f32_16x16x32_bf16(Bt[n][k], At[m][k], acc[ai][bj][m][n], 0, 0, 0); __builtin_amdgcn_s_setprio(0); } while (0)
#define PG8_WAIT_V(n) asm volatile("s_waitcnt vmcnt(" #n ")" ::: "memory")
#define PG8_WAIT_L(n) asm volatile("s_waitcnt lgkmcnt(" #n ")" ::: "memory")
#define PG8_BAR __builtin_amdgcn_s_barrier()
#define PG8_SCHED __builtin_amdgcn_sched_barrier(0)
    Unit cur, nxt; int ui = 0;
    if (!S.next(0, cur)) return;
    f32x4 acc[2][2][4][2];
#pragma unroll
    for (int a = 0; a < 2; ++a)
#pragma unroll
        for (int b = 0; b < 2; ++b)
#pragma unroll
            for (int m = 0; m < 4; ++m)
#pragma unroll
                for (int n = 0; n < 2; ++n) acc[a][b][m][n] = (f32x4){0.f, 0.f, 0.f, 0.f};
    bf16x8 At[4][2], B0[2][2], B1[2][2];
    const char* cA = (const char*)g.A + (size_t)cur.pm * tstep; const char* cB = (const char*)g.Bt + (size_t)cur.pn * tstep;
    PG8_STAGE(PG8_SB(0, 0), cB, voffB); PG8_STAGE(PG8_SA(0, 0), cA, voffA); PG8_STAGE(PG8_SB(0, 1), cB + hstep, voffB); PG8_STAGE(PG8_SA(0, 1), cA + hstep, voffA);
    if (wr == 1) PG8_BAR;
    PG8_WAIT_V(4); PG8_BAR;
    PG8_STAGE(PG8_SB(1, 0), cB + kstep, voffB); PG8_STAGE(PG8_SA(1, 0), cA + kstep, voffA); PG8_STAGE(PG8_SB(1, 1), cB + hstep + kstep, voffB);
    PG8_WAIT_V(6); PG8_BAR;
    for (;;) {
        const bool has_next = S.next(ui + 1, nxt);
        const char* nA = has_next ? (const char*)g.A + (size_t)nxt.pm * tstep : cA; const char* nB = has_next ? (const char*)g.Bt + (size_t)nxt.pn * tstep : cB;
        for (int t = 0; t < nt; t += 2) {
            const bool last = (t == nt - 2);
            const char* a1 = cA + (size_t)(t + 1) * kstep;
            const char* a2 = last ? nA : cA + (size_t)(t + 2) * kstep; const char* b2 = last ? nB : cB + (size_t)(t + 2) * kstep;
            const char* a3 = a2 + kstep; const char* b3 = b2 + kstep;
            PG8_LDB(B0, 0, 0); PG8_SCHED; PG8_LDA(At, 0, 0); PG8_STAGE(PG8_SA(1, 1), a1 + hstep, voffA);
            PG8_WAIT_L(8); PG8_BAR; PG8_WAIT_L(0); PG8_MMA(0, 0, At, B0); PG8_BAR; PG8_SCHED;
            PG8_LDB(B1, 0, 1); PG8_STAGE(PG8_SB(0, 0), b2, voffB);
            PG8_BAR; PG8_WAIT_L(0); PG8_MMA(0, 1, At, B1); PG8_BAR;
            PG8_LDA(At, 0, 1); PG8_STAGE(PG8_SA(0, 0), a2, voffA);
            PG8_BAR; PG8_WAIT_L(0); PG8_MMA(1, 0, At, B0); PG8_BAR; PG8_SCHED;
            PG8_STAGE(PG8_SB(0, 1), b2 + hstep, voffB);
            PG8_WAIT_V(6); PG8_BAR; PG8_MMA(1, 1, At, B1); PG8_BAR;
            PG8_LDB(B0, 1, 0); PG8_SCHED; PG8_LDA(At, 1, 0); PG8_STAGE(PG8_SA(0, 1), a2 + hstep, voffA);
            PG8_WAIT_L(8); PG8_BAR; PG8_WAIT_L(0); PG8_MMA(0, 0, At, B0); PG8_BAR; PG8_SCHED;
            PG8_LDB(B1, 1, 1); PG8_STAGE(PG8_SB(1, 0), b3, voffB);
            PG8_BAR; PG8_WAIT_L(0); PG8_MMA(0, 1, At, B1); PG8_BAR;
            PG8_LDA(At, 1, 1); PG8_STAGE(PG8_SA(1, 0), a3, voffA);
            PG8_BAR; PG8_WAIT_L(0); PG8_MMA(1, 0, At, B0); PG8_BAR; PG8_SCHED;
            PG8_STAGE(PG8_SB(1, 1), b3 + hstep, voffB);
            PG8_WAIT_V(6); PG8_BAR; PG8_MMA(1, 1, At, B1); PG8_BAR;
        }
        E(acc, cur, wr, wc, fr, fq);
        if (!has_next) break;
#pragma unroll
        for (int a = 0; a < 2; ++a)
#pragma unroll
            for (int b = 0; b < 2; ++b)
#pragma unroll
                for (int m = 0; m < 4; ++m)
#pragma unroll
                    for (int n = 0; n < 2; ++n) acc[a][b][m][n] = (f32x4){0.f, 0.f, 0.f, 0.f};
        cur = nxt; cA = nA; cB = nB; ++ui;
    }
    PG8_WAIT_V(0);
    if (wr == 0) PG8_BAR;
    PG8_BAR;
#undef PG8_SA
#undef PG8_SB
#undef PG8_STAGE
#undef PG8_LDA
#undef PG8_LDB
#undef PG8_MMA
#undef PG8_WAIT_V
#undef PG8_WAIT_L
#undef PG8_BAR
#undef PG8_SCHED
}
}

DI void tr_tile(const float* src, int ld_src, int k0, int c0, bf16_t* dst, int ld_dst, int n0, float* lds) {
    const int tid = otid();
#pragma unroll
    for (int pass = 0; pass < 2; ++pass) { const int r = pass * 32 + (tid >> 4), c4 = (tid & 15) * 4;
        const f32x4 v = *(const f32x4*)(src + (size_t)(k0 + r) * ld_src + c0 + c4);
        lds[r * 65 + c4 + 0] = v[0]; lds[r * 65 + c4 + 1] = v[1]; lds[r * 65 + c4 + 2] = v[2]; lds[r * 65 + c4 + 3] = v[3]; }
    __syncthreads();
    const int nn = tid >> 3, kc = (tid & 7) * 8;
    float o[8];
#pragma unroll
    for (int e = 0; e < 8; ++e) o[e] = lds[(kc + e) * 65 + nn];
    *(u32x4*)(dst + (size_t)(n0 + nn) * ld_dst + k0 + kc) = pack8(o);
    __syncthreads();
}

DI void phase_prep(KP pk_in, unsigned char* lds) {
    KP pk = pk_in; asm volatile("" : "+s"(pk));
    unsigned char* ws = pk->ws;
    const int bidx_ = obid(); const size_t gtid = (size_t)bidx_ * 512 + otid(), nthr = (size_t)gridDim.x * 512;
    { bf16_t* xb = (bf16_t*)(ws + W_XB);
      for (size_t v = gtid; v < (size_t)NTOK * 128; v += nthr) { const float* s = v < (size_t)NTOKP * 128 ? pk->x_prompt + v * 8 : pk->x_sample + (v - (size_t)NTOKP * 128) * 8;
          const f32x4 a = *(const f32x4*)s, b = *(const f32x4*)(s + 4); float o[8] = {a[0], a[1], a[2], a[3], b[0], b[1], b[2], b[3]}; *(u32x4*)(xb + v * 8) = pack8(o); } }
    { bf16_t* mb = (bf16_t*)(ws + W_MEMB);
      for (size_t v = gtid; v < (size_t)2048 * 128; v += nthr) { const float* s = pk->mem_prompt + v * 8;
          const f32x4 a = *(const f32x4*)s, b = *(const f32x4*)(s + 4); float o[8] = {a[0], a[1], a[2], a[3], b[0], b[1], b[2], b[3]}; *(u32x4*)(mb + v * 8) = pack8(o); } }
    { bf16_t* wd = (bf16_t*)(ws + W_WDTT); float* wf = (float*)(ws + W_WDTF);
      for (size_t i = gtid; i < 16 * 1024; i += nthr) { const int h = (int)(i >> 10), k = (int)(i & 1023); const float v = pk->w_in[(size_t)k * DIN + 4608 + h]; wd[i] = f2bf(v); wf[i] = v; } }
    { bf16_t* wg = (bf16_t*)(ws + W_WGT);
      for (size_t i = gtid; i < (size_t)8 * 4 * 64 * 128; i += nthr) { const int k = (int)(i >> 15), qd = (int)(i >> 13) & 3, nn = (int)(i >> 7) & 63, ii = (int)(i & 127);
          const float v = nn < 32 ? pk->w_rg_a[((size_t)k * 128 + ii) * 128 + qd * 32 + nn] : pk->w_rg_i[((size_t)k * 128 + ii) * 128 + qd * 32 + nn - 32]; wg[i] = f2bf(v); } }
    float* tl = (float*)lds;
    for (int t = bidx_; t < 1664 + 768 + 512; t += gridDim.x) {
        if (t < 1664) { const int kt = t & 15, ntile = t >> 4; const int n0 = ntile * 64, c0 = n0 < 4608 ? n0 : n0 + 16;
            tr_tile(pk->w_in, DIN, kt * 64, c0, (bf16_t*)(ws + W_WINT), 1024, n0, tl); }
        else if (t < 1664 + 768) { const int u = t - 1664; const int kt = u % 48, ntile = u / 48;
            tr_tile(pk->w_out, 1024, kt * 64, ntile * 64, (bf16_t*)(ws + W_WOUTT), 3072, ntile * 64, tl); }
        else { const int u = t - 1664 - 768; const int kt = u & 15, ntile = u >> 4; const int n0 = ntile * 64;
            if (n0 < 1024) tr_tile(pk->w_mem_k, 1024, kt * 64, n0, (bf16_t*)(ws + W_WKVT), 1024, n0, tl);
            else tr_tile(pk->w_mem_v, 1024, kt * 64, n0 - 1024, (bf16_t*)(ws + W_WKVT), 1024, n0, tl); }
    }
}

DI void conv8_ssd_prompt(KP pk, const bf16_t* proj, int rowbase, int t, int ch, float (&o)[8]) {
    const f32x4 b0 = *(const f32x4*)(pk->ssd_conv_b + ch), b1 = *(const f32x4*)(pk->ssd_conv_b + ch + 4);
    float acc[8] = {b0[0], b0[1], b0[2], b0[3], b1[0], b1[1], b1[2], b1[3]};
    u32x4 vv[4];
#pragma unroll
    for (int kk = 0; kk < 4; ++kk) { const int tt = t - 3 + kk; vv[kk] = *(const u32x4*)(proj + (size_t)(rowbase + (tt < 0 ? 0 : tt)) * NPROJ + C_XBC + ch); }
#pragma unroll
    for (int kk = 0; kk < 4; ++kk) { const int tt = t - 3 + kk; const float msk = tt >= 0 ? 1.f : 0.f; float x[8]; unpack8(vv[kk], x);
            const f32x4 w0 = *(const f32x4*)(pk->ssd_conv_w + kk * 1536 + ch) * msk, w1 = *(const f32x4*)(pk->ssd_conv_w + kk * 1536 + ch + 4) * msk;
            acc[0] += x[0] * w0[0]; acc[1] += x[1] * w0[1]; acc[2] += x[2] * w0[2]; acc[3] += x[3] * w0[3];
            acc[4] += x[4] * w1[0]; acc[5] += x[5] * w1[1]; acc[6] += x[6] * w1[2]; acc[7] += x[7] * w1[3]; }
#pragma unroll
    for (int e = 0; e < 8; ++e) o[e] = siluf(acc[e]);
}

DI void ssd1_item(KP pk_in, unsigned char* lds, int b, int c, int g) {
    KP pk = pk_in; asm volatile("" : "+s"(pk));
    unsigned char* ws = pk->ws;
    const int tid = otid(), w = tid >> 6, lane = tid & 63, l15 = lane & 15, q = lane >> 4;
    float* dt_s = (float*)lds; float* acum_s = dt_s + 2048; float* w_s = acum_s + 2048;
    bf16_t* BT = (bf16_t*)(lds + 20480); bf16_t* xsT = (bf16_t*)(lds + 20480 + 34816);
    const bf16_t* xb = (const bf16_t*)(ws + W_XB); const bf16_t* wdt = (const bf16_t*)(ws + W_WDTT); const bf16_t* proj = (const bf16_t*)(ws + W_PROJ);
    bf16_t* xact = (bf16_t*)(ws + W_XACT); float* dt_g = (float*)(ws + W_DT); float* acum_g = (float*)(ws + W_ACUM); float* cd_g = (float*)(ws + W_CD); float* st_g = (float*)(ws + W_ST);
    const int tok0 = b * 2048 + c * 128;
    __syncthreads();
    { f32x4 acc = {0.f, 0.f, 0.f, 0.f}; const bf16_t* ap = xb + (size_t)(tok0 + 16 * w + l15) * 1024 + q * 8; const bf16_t* bp = wdt + l15 * 1024 + q * 8;
#pragma unroll 8
      for (int ks = 0; ks < 32; ++ks) { const bf16x8 a = *(const bf16x8*)(ap + ks * 32); const bf16x8 bb = *(const bf16x8*)(bp + ks * 32); acc = MFMA16(a, bb, acc); }
      const float bias = pk->ssd_dt_bias[l15];
#pragma unroll
      for (int r = 0; r < 4; ++r) { const int i = 16 * w + 4 * q + r; const float dt = softplusf(acc[r] + bias); dt_s[i * 16 + l15] = dt; dt_g[(size_t)(tok0 + i) * 16 + l15] = dt; } }
    __syncthreads();
    if (tid < 16) { const float ah = -__expf(pk->ssd_a_log[tid]); float run = 0.f;
        for (int i = 0; i < 128; ++i) { run += dt_s[i * 16 + tid] * ah; acum_s[i * 16 + tid] = run; acum_g[(size_t)(tok0 + i) * 16 + tid] = run; } }
    __syncthreads();
    if (tid < 8) cd_g[(b * 16 + c) * 16 + 8 * g + tid] = __expf(acum_s[127 * 16 + 8 * g + tid]);
    for (int idx = tid; idx < 1024; idx += 512) { const int j = idx >> 3, hl = idx & 7, h = 8 * g + hl; w_s[idx] = dt_s[j * 16 + h] * __expf(acum_s[127 * 16 + h] - acum_s[j * 16 + h]); }
    for (int idx = tid; idx < 4096; idx += 512) { const int which = idx >> 11, rem = idx & 2047, j = rem >> 4, cv = (rem & 15) * 8; const int ch = 1024 + which * 256 + g * 128 + cv;
        float o[8]; conv8_ssd_prompt(pk, proj, b * 2048, c * 128 + j, ch, o); const u32x4 pk = pack8(o);
        *(u32x4*)(xact + (size_t)(tok0 + j) * 1536 + ch) = pk;
        if (which == 0) { const bf16_t* e16 = (const bf16_t*)&pk;
#pragma unroll
            for (int e = 0; e < 8; ++e) BT[(cv + e) * 136 + j] = f2bf(o[e]); (void)e16; } }
    for (int hl = 0; hl < 8; ++hl) {
        __syncthreads();
        for (int idx = tid; idx < 1024; idx += 512) { const int j = idx >> 3, pv = (idx & 7) * 8; const int ch = g * 512 + hl * 64 + pv;
            float o[8]; conv8_ssd_prompt(pk, proj, b * 2048, c * 128 + j, ch, o);
            *(u32x4*)(xact + (size_t)(tok0 + j) * 1536 + ch) = pack8(o);
            const float wj = w_s[j * 8 + hl];
#pragma unroll
            for (int e = 0; e < 8; ++e) xsT[(pv + e) * 136 + j] = f2bf(o[e] * wj); }
        __syncthreads();
        const int pt = w & 3, nh = w >> 2;
        f32x4 acc[4];
#pragma unroll
        for (int nt = 0; nt < 4; ++nt) acc[nt] = (f32x4){0.f, 0.f, 0.f, 0.f};
#pragma unroll
        for (int ks = 0; ks < 4; ++ks) { const bf16x8 a = *(const bf16x8*)(xsT + (pt * 16 + l15) * 136 + ks * 32 + q * 8);
#pragma unroll
            for (int nt = 0; nt < 4; ++nt) { const bf16x8 bb = *(const bf16x8*)(BT + (nh * 64 + nt * 16 + l15) * 136 + ks * 32 + q * 8); acc[nt] = MFMA16(a, bb, acc[nt]); } }
        float* sp = st_g + (size_t)(((b * 16 + c) * 16 + 8 * g + hl)) * 8192;
#pragma unroll
        for (int nt = 0; nt < 4; ++nt)
#pragma unroll
            for (int r = 0; r < 4; ++r) sp[(pt * 16 + 4 * q + r) * 128 + nh * 64 + nt * 16 + l15] = acc[nt][r];
    }
    if (c == 15) {
        for (int idx = tid; idx < 3 * 768; idx += 512) { const int jj = idx / 768, cc = idx % 768; const int ch = cc < 512 ? g * 512 + cc : (cc < 640 ? 1024 + g * 128 + (cc - 512) : 1280 + g * 128 + (cc - 640));
            pk->out[O_SCP + (size_t)(b * 3 + jj) * 1536 + ch] = bf2f(proj[(size_t)(b * 2048 + 2045 + jj) * NPROJ + C_XBC + ch]); }
    }
}

DI void rgconv_item(KP pk_in, int b, int tile) {
    KP pk = pk_in; asm volatile("" : "+s"(pk));
    const int tid = otid();
    const bf16_t* proj = (const bf16_t*)(pk->ws + W_PROJ); bf16_t* mix = (bf16_t*)(pk->ws + W_MIX);
    for (int idx = tid; idx < 128 * 128; idx += 512) { const int j = idx >> 7, ch = (idx & 127) * 8; const int t = tile * 128 + j;
        u32x4 vv[4];
#pragma unroll
        for (int kk = 0; kk < 4; ++kk) { const int tt = t - 3 + kk; vv[kk] = *(const u32x4*)(proj + (size_t)(b * 2048 + (tt < 0 ? 0 : tt)) * NPROJ + C_RGX + ch); }
        const f32x4 b0 = *(const f32x4*)(pk->rg_conv_b + ch), b1 = *(const f32x4*)(pk->rg_conv_b + ch + 4);
        float acc[8] = {b0[0], b0[1], b0[2], b0[3], b1[0], b1[1], b1[2], b1[3]};
#pragma unroll
        for (int kk = 0; kk < 4; ++kk) { const float have = (t - 3 + kk) >= 0 ? 1.f : 0.f; float x[8]; unpack8(vv[kk], x);
            const f32x4 w0 = *(const f32x4*)(pk->rg_conv_w + kk * 1024 + ch) * have, w1 = *(const f32x4*)(pk->rg_conv_w + kk * 1024 + ch + 4) * have;
            acc[0] += x[0] * w0[0]; acc[1] += x[1] * w0[1]; acc[2] += x[2] * w0[2]; acc[3] += x[3] * w0[3];
            acc[4] += x[4] * w1[0]; acc[5] += x[5] * w1[1]; acc[6] += x[6] * w1[2]; acc[7] += x[7] * w1[3]; }
        *(u32x4*)(mix + (size_t)(b * 2048 + t) * DMIX + 1024 + ch) = pack8(acc); }
}

DI void statepass_item(KP pk_in, int sp) {
    KP pk = pk_in; asm volatile("" : "+s"(pk));
    const int b = sp >> 5, h = (sp >> 1) & 15, half = sp & 1; const int e0 = half * 4096 + otid() * 8;
    float* st_g = (float*)(pk->ws + W_ST); const float* cd_g = (const float*)(pk->ws + W_CD);
    f32x4 r0 = {0.f, 0.f, 0.f, 0.f}, r1 = {0.f, 0.f, 0.f, 0.f};
    for (int c0 = 0; c0 < 16; c0 += 8) { f32x4 v0[8], v1[8]; float cd[8];
#pragma unroll
        for (int i = 0; i < 8; ++i) { const float* ptr = st_g + (size_t)((b * 16 + c0 + i) * 16 + h) * 8192 + e0; v0[i] = *(const f32x4*)ptr; v1[i] = *(const f32x4*)(ptr + 4); cd[i] = cd_g[(b * 16 + c0 + i) * 16 + h]; }
#pragma unroll
        for (int i = 0; i < 8; ++i) { float* ptr = st_g + (size_t)((b * 16 + c0 + i) * 16 + h) * 8192 + e0; *(f32x4*)ptr = r0; *(f32x4*)(ptr + 4) = r1; r0 = r0 * cd[i] + v0[i]; r1 = r1 * cd[i] + v1[i]; } }
    float* o = pk->out + O_SHP + (size_t)(b * 16 + h) * 8192 + e0; *(f32x4*)o = r0; *(f32x4*)(o + 4) = r1;
}

DI void rg_item(KP pk_in, unsigned char* lds, const bool sample, int bidx, int k, int qd) {
    KP pk = pk_in; asm volatile("" : "+s"(pk));
    unsigned char* ws = pk->ws;
    const int tid = otid(), w = tid >> 6, lane = tid & 63, l15 = lane & 15, q = lane >> 4;
    bf16_t* uA = (bf16_t*)lds;
    float* sa = (float*)(lds + 34816); float* sb = sa + 4096;
    float* segA = sb + 4096; float* segB = segA + 512; float* hcar = segB + 512;
    const bf16_t* proj = (const bf16_t*)(ws + W_PROJ); bf16_t* mix = (bf16_t*)(ws + W_MIX);
    const bf16_t* wg = (const bf16_t*)(ws + W_WGT) + (size_t)((k * 4 + qd) * 64) * 128;
    bf16_t* wS = (bf16_t*)(lds + 73728);
    __syncthreads();
    for (int idx = tid; idx < 1024; idx += 512) { const int n = idx >> 4, c8 = (idx & 15) * 8; *(u32x4*)(wS + n * 136 + c8) = *(const u32x4*)(wg + n * 128 + c8); }
    float ba[2], bi[2], spl[2];
#pragma unroll
    for (int ntl = 0; ntl < 2; ++ntl) { const int ch = k * 128 + qd * 32 + ntl * 16 + l15; ba[ntl] = pk->b_rg_a[ch]; bi[ntl] = pk->b_rg_i[ch]; spl[ntl] = softplusf(-pk->rg_lambda[ch]); }
    __syncthreads();
    if (tid < 32) hcar[tid] = 0.f;
    const int ntiles = sample ? 1 : 16;
    const int crow = tid >> 2, cg0 = (tid & 3) * 32;
    const int cl_s = tid & 31, seg_s = tid >> 5;
    const bf16_t* ug = mix + 1024;
    u32x4 av[4]; bf16_t uv[8];
#define RG_LOADP(TILE) do { const size_t r0 = (size_t)(bidx * 2048 + (TILE) * 128 + 16 * w); \
        _Pragma("unroll") for (int ks = 0; ks < 4; ++ks) av[ks] = *(const u32x4*)(ug + (r0 + l15) * DMIX + k * 128 + ks * 32 + q * 8); \
        _Pragma("unroll") for (int ntl = 0; ntl < 2; ++ntl) _Pragma("unroll") for (int r = 0; r < 4; ++r) uv[ntl * 4 + r] = ug[(r0 + 4 * q + r) * DMIX + k * 128 + qd * 32 + ntl * 16 + l15]; } while (0)
    if (!sample) RG_LOADP(0);
    bf16x8 afr[4]; float uvf[8];
    for (int tile = 0; tile < ntiles; ++tile) {
        __syncthreads();
        float gts[8];
        if (!sample) {
#pragma unroll
          for (int ks = 0; ks < 4; ++ks) afr[ks] = as_frag(av[ks]);
#pragma unroll
          for (int e = 0; e < 8; ++e) uvf[e] = bf2f(uv[e]);
          if (tile + 1 < 16) RG_LOADP(tile + 1);
#pragma unroll
          for (int j = 0; j < 8; ++j) gts[j] = bf2f(proj[(size_t)(bidx * 2048 + tile * 128 + seg_s * 8 + j) * NPROJ + C_RGG + k * 128 + qd * 32 + cl_s]);
        } else { const int row = crow;
#pragma unroll
          for (int v = 0; v < 4; ++v) { const int c8 = cg0 + v * 8, ch = k * 128 + c8;
              const f32x4 b0 = *(const f32x4*)(pk->rg_conv_b + ch), b1 = *(const f32x4*)(pk->rg_conv_b + ch + 4);
              float acc[8] = {b0[0], b0[1], b0[2], b0[3], b1[0], b1[1], b1[2], b1[3]};
#pragma unroll
              for (int kk = 0; kk < 4; ++kk) { float x[8];
                  { const int sbi = bidx * 32 + (row >> 2), ui = (row & 3) + kk;
                      if (ui < 3) { const float* s = pk->state_rg_conv + (size_t)(sbi * 3 + ui) * 1024 + ch; const f32x4 s0 = *(const f32x4*)s, s1 = *(const f32x4*)(s + 4);
                          x[0] = s0[0]; x[1] = s0[1]; x[2] = s0[2]; x[3] = s0[3]; x[4] = s1[0]; x[5] = s1[1]; x[6] = s1[2]; x[7] = s1[3]; }
                      else { const u32x4 vv = *(const u32x4*)(proj + (size_t)(NTOKP + sbi * 4 + ui - 3) * NPROJ + C_RGX + ch); unpack8(vv, x); } }
                  { const f32x4 w0 = *(const f32x4*)(pk->rg_conv_w + kk * 1024 + ch), w1 = *(const f32x4*)(pk->rg_conv_w + kk * 1024 + ch + 4);
                      acc[0] += x[0] * w0[0]; acc[1] += x[1] * w0[1]; acc[2] += x[2] * w0[2]; acc[3] += x[3] * w0[3];
                      acc[4] += x[4] * w1[0]; acc[5] += x[5] * w1[1]; acc[6] += x[6] * w1[2]; acc[7] += x[7] * w1[3]; } }
              *(u32x4*)(uA + row * 136 + c8) = pack8(acc); }
#pragma unroll
          for (int j = 0; j < 8; ++j) gts[j] = bf2f(proj[(size_t)(NTOKP + bidx * 128 + seg_s * 8 + j) * NPROJ + C_RGG + k * 128 + qd * 32 + cl_s]);
        }
        __syncthreads();
        { f32x4 acc[4];
#pragma unroll
          for (int nt = 0; nt < 4; ++nt) acc[nt] = (f32x4){0.f, 0.f, 0.f, 0.f};
#pragma unroll
          for (int ks = 0; ks < 4; ++ks) { const bf16x8 a = sample ? *(const bf16x8*)(uA + (16 * w + l15) * 136 + ks * 32 + q * 8) : afr[ks];
#pragma unroll
              for (int nt = 0; nt < 4; ++nt) { const bf16x8 bb = *(const bf16x8*)(wS + (nt * 16 + l15) * 136 + ks * 32 + q * 8); acc[nt] = MFMA16(a, bb, acc[nt]); } }
#pragma unroll
          for (int ntl = 0; ntl < 2; ++ntl)
#pragma unroll
              for (int r = 0; r < 4; ++r) { const int row = 16 * w + 4 * q + r, cl = ntl * 16 + l15;
                  const float rr = sigmf(acc[ntl][r] + ba[ntl]), ii = sigmf(acc[2 + ntl][r] + bi[ntl]);
                  const float la = -8.f * rr * spl[ntl]; float a = __expf(la); const float uval = sample ? bf2f(uA[row * 136 + qd * 32 + cl]) : uvf[ntl * 4 + r];
                  float bt = __builtin_amdgcn_sqrtf(fmaxf(1.f - a * a, 0.f)) * ii * uval;
                  const bool first = sample ? ((row & 3) == 0) : (tile == 0 && row == 0);
                  if (first) { const float h0 = sample ? pk->state_rg_h[(size_t)(bidx * 32 + (row >> 2)) * 1024 + k * 128 + qd * 32 + cl] : 0.f; bt += a * h0; a = 0.f; }
                  sa[row * 32 + cl] = a; sb[row * 32 + cl] = bt; } }
        __syncthreads();
        const int cl = tid & 31, seg = tid >> 5;
        { float A = 1.f, B = 0.f;
#pragma unroll
          for (int j = 0; j < 8; ++j) { const int row = seg * 8 + j; const float a = sa[row * 32 + cl], bb = sb[row * 32 + cl]; B = a * B + bb; A = a * A; }
          segA[seg * 32 + cl] = A; segB[seg * 32 + cl] = B; }
        __syncthreads();
        float h = hcar[cl];
        for (int s = 0; s < seg; ++s) h = segA[s * 32 + cl] * h + segB[s * 32 + cl];
        const int chg = k * 128 + qd * 32 + cl;
#pragma unroll
        for (int j = 0; j < 8; ++j) { const int row = seg * 8 + j; h = sa[row * 32 + cl] * h + sb[row * 32 + cl];
            const size_t grow = sample ? (size_t)(NTOKP + bidx * 128 + row) : (size_t)(bidx * 2048 + tile * 128 + row);
            mix[grow * DMIX + chg] = f2bf(h * siluf(gts[j]));
            if (sample) { if ((row & 3) == 3) pk->out[O_RGHS + (size_t)(bidx * 32 + (row >> 2)) * 1024 + chg] = h; }
            else if (tile == 15 && row == 127) pk->out[O_RGHP + (size_t)bidx * 1024 + chg] = h; }
        __syncthreads();
        if (seg == 15) hcar[cl] = h;
    }
    if (!sample) { if (tid < 96) { const int jj = tid >> 5, cl = tid & 31, chg = k * 128 + qd * 32 + cl;
            pk->out[O_RGCP + (size_t)(bidx * 3 + jj) * 1024 + chg] = bf2f(proj[(size_t)(bidx * 2048 + 2045 + jj) * NPROJ + C_RGX + chg]); } }
    else { for (int idx = tid; idx < 32 * 3 * 32; idx += 512) { const int cl = idx & 31, jj = (idx >> 5) % 3, sl = idx / 96; const int sbi = bidx * 32 + sl, chg = k * 128 + qd * 32 + cl;
            pk->out[O_RGCS + (size_t)(sbi * 3 + jj) * 1024 + chg] = bf2f(proj[(size_t)(NTOKP + sbi * 4 + 1 + jj) * NPROJ + C_RGX + chg]); } }
}

DI void attnp_item(KP pk_in, unsigned char* lds, int b, int head, int qt) {
    KP pk = pk_in; asm volatile("" : "+s"(pk));
    unsigned char* ws = pk->ws;
    const int tid = otid(), w = tid >> 6, lane = tid & 63, l15 = lane & 15, q = lane >> 4;
    const bf16_t* proj = (const bf16_t*)(ws + W_PROJ); const bf16_t* kb = (const bf16_t*)(ws + W_KB); const bf16_t* vt = (const bf16_t*)(ws + W_VT); bf16_t* mix = (bf16_t*)(ws + W_MIX);
    const int tokb = b * 2048 + qt * 128 + 16 * w;
    constexpr int RS = 264;
    bf16_t* sm = (bf16_t*)lds;
    const int lr = tid >> 5, lc = (tid & 31) * 8;
    const bf16_t* kbase = kb + (size_t)(b * 256) * 1024 + head * 256; const bf16_t* vbase = vt + (size_t)((b * 4 + head) * 256) * 256;
    u32x4 pre[8];
#define AT_LOAD(S) do { _Pragma("unroll") for (int i = 0; i < 8; ++i) { const int r = lr + 16 * i; \
        pre[i] = (S) < 2 ? *(const u32x4*)(kbase + (size_t)(128 * (S) + r) * 1024 + lc) : *(const u32x4*)(vbase + (size_t)(128 * ((S) - 2) + r) * 256 + lc); } } while (0)
#define AT_STORE() do { _Pragma("unroll") for (int i = 0; i < 8; ++i) *(u32x4*)(sm + (lr + 16 * i) * RS + lc) = pre[i]; } while (0)
    AT_LOAD(0);
    bf16x8 qf[8];
#pragma unroll
    for (int ks = 0; ks < 8; ++ks) qf[ks] = *(const bf16x8*)(proj + (size_t)(tokb + l15) * NPROJ + C_Q + head * 256 + ks * 32 + q * 8);
    f32x4 st[16];
#pragma unroll
    for (int s = 0; s < 2; ++s) {
        __syncthreads(); AT_STORE(); __syncthreads(); AT_LOAD(s + 1);
#pragma unroll
        for (int mtl = 0; mtl < 8; ++mtl) { const int mt = 8 * s + mtl; st[mt] = (f32x4){0.f, 0.f, 0.f, 0.f}; const bf16_t* kp = sm + (16 * mtl + l15) * RS + q * 8;
#pragma unroll
            for (int ks = 0; ks < 8; ++ks) { const bf16x8 kf = *(const bf16x8*)(kp + ks * 32); st[mt] = MFMA16(kf, qf[ks], st[mt]); } }
    }
    float mx = -3.0e38f;
#pragma unroll
    for (int mt = 0; mt < 16; ++mt)
#pragma unroll
        for (int r = 0; r < 4; ++r) { st[mt][r] *= 0.0625f; mx = fmaxf(mx, st[mt][r]); }
    mx = fmaxf(mx, shx(mx, 16, lane)); mx = fmaxf(mx, shx(mx, 32, lane));
    float l = 0.f;
#pragma unroll
    for (int mt = 0; mt < 16; ++mt)
#pragma unroll
        for (int r = 0; r < 4; ++r) { const float e = __expf(st[mt][r] - mx); st[mt][r] = e; l += e; }
    l += shx(l, 16, lane); l += shx(l, 32, lane);
    bf16x8 pf[8];
#pragma unroll
    for (int s = 0; s < 8; ++s) { float m8[8] = {st[2 * s][0], st[2 * s][1], st[2 * s][2], st[2 * s][3], st[2 * s + 1][0], st[2 * s + 1][1], st[2 * s + 1][2], st[2 * s + 1][3]}; pf[s] = as_frag(pack8(m8)); }
    float linv[4];
#pragma unroll
    for (int r = 0; r < 4; ++r) linv[r] = 1.f / shl(l, 4 * q + r);
#pragma unroll
    for (int s2 = 0; s2 < 2; ++s2) {
        __syncthreads(); AT_STORE(); __syncthreads(); if (s2 == 0) AT_LOAD(3);
#pragma unroll
        for (int dtl = 0; dtl < 8; ++dtl) { const int dt = 8 * s2 + dtl; f32x4 o = {0.f, 0.f, 0.f, 0.f}; const bf16_t* vp = sm + (16 * dtl + l15) * RS + 4 * q;
            float gt[4];
#pragma unroll
            for (int r = 0; r < 4; ++r) gt[r] = bf2f(proj[(size_t)(tokb + 4 * q + r) * NPROJ + C_XG + head * 256 + 16 * dt + l15]);
#pragma unroll
            for (int s = 0; s < 8; ++s) { const u32x2 lo = *(const u32x2*)(vp + 32 * s), hi = *(const u32x2*)(vp + 32 * s + 16); o = MFMA16(pf[s], frag2(lo, hi), o); }
#pragma unroll
            for (int r = 0; r < 4; ++r) { const size_t tok = (size_t)(tokb + 4 * q + r); const int d = 16 * dt + l15;
                mix[tok * DMIX + 2048 + head * 256 + d] = f2bf(o[r] * linv[r] * siluf(gt[r])); } }
    }
#undef AT_LOAD
#undef AT_STORE
}

DI float wave_sum(float v, int lane) { v += shx(v, 32, lane); v += shx(v, 16, lane); v += shx(v, 8, lane); v += shx(v, 4, lane); v += shx(v, 2, lane); v += shx(v, 1, lane); return v; }
DI float wave_max(float v, int lane) { v = fmaxf(v, shx(v, 32, lane)); v = fmaxf(v, shx(v, 16, lane)); v = fmaxf(v, shx(v, 8, lane)); v = fmaxf(v, shx(v, 4, lane)); v = fmaxf(v, shx(v, 2, lane)); v = fmaxf(v, shx(v, 1, lane)); return v; }

DI void attns_item(KP pk_in, unsigned char* lds, int sbi, int head) {
    KP pk = pk_in; asm volatile("" : "+s"(pk));
    unsigned char* ws = pk->ws;
    const int tid = otid(), w = tid >> 6, lane = tid & 63;
    const bf16_t* proj = (const bf16_t*)(ws + W_PROJ); bf16_t* mix = (bf16_t*)(ws + W_MIX);
    float* qs = (float*)lds; float* sc = qs + 1024; float* ored = sc + 1024;
    __syncthreads();
    for (int idx = tid; idx < 1024; idx += 512) { const int t = idx >> 8, d = idx & 255; qs[idx] = bf2f(proj[(size_t)(NTOKP + sbi * 4 + t) * NPROJ + C_Q + head * 256 + d]); }
    __syncthreads();
    f32x4 qv[4];
#pragma unroll
    for (int t = 0; t < 4; ++t) qv[t] = *(const f32x4*)(qs + t * 256 + lane * 4);
    for (int m0 = w; m0 < 256; m0 += 64) { f32x4 kv[8];
#pragma unroll
        for (int i = 0; i < 8; ++i) kv[i] = *(const f32x4*)(pk->cache_k + ((size_t)(sbi * 256 + m0 + 8 * i) * 4 + head) * 256 + lane * 4);
        float v32[32];
#pragma unroll
        for (int i = 0; i < 8; ++i)
#pragma unroll
            for (int t = 0; t < 4; ++t) v32[i * 4 + t] = kv[i][0] * qv[t][0] + kv[i][1] * qv[t][1] + kv[i][2] * qv[t][2] + kv[i][3] * qv[t][3];
        float v16[16], v8[8], v4[4], v2[2];
        { const bool up = (lane & 32) != 0;
#pragma unroll
          for (int i = 0; i < 16; ++i) { const float keep = up ? v32[i + 16] : v32[i], send = up ? v32[i] : v32[i + 16]; v16[i] = keep + shx(send, 32, lane); } }
        { const bool up = (lane & 16) != 0;
#pragma unroll
          for (int i = 0; i < 8; ++i) { const float keep = up ? v16[i + 8] : v16[i], send = up ? v16[i] : v16[i + 8]; v8[i] = keep + shx(send, 16, lane); } }
        { const bool up = (lane & 8) != 0;
#pragma unroll
          for (int i = 0; i < 4; ++i) { const float keep = up ? v8[i + 4] : v8[i], send = up ? v8[i] : v8[i + 4]; v4[i] = keep + shx(send, 8, lane); } }
        { const bool up = (lane & 4) != 0;
#pragma unroll
          for (int i = 0; i < 2; ++i) { const float keep = up ? v4[i + 2] : v4[i], send = up ? v4[i] : v4[i + 2]; v2[i] = keep + shx(send, 4, lane); } }
        float v1; { const bool up = (lane & 2) != 0; const float keep = up ? v2[1] : v2[0], send = up ? v2[0] : v2[1]; v1 = keep + shx(send, 2, lane); }
        v1 += shx(v1, 1, lane);
        if ((lane & 1) == 0) { const int ii = lane >> 1; sc[(ii & 3) * 256 + m0 + 8 * (ii >> 2)] = v1 * 0.0625f; } }
    __syncthreads();
    if (w < 4) { const f32x4 v = *(const f32x4*)(sc + w * 256 + lane * 4); float mx = fmaxf(fmaxf(v[0], v[1]), fmaxf(v[2], v[3])); mx = wave_max(mx, lane);
        f32x4 e; e[0] = __expf(v[0] - mx); e[1] = __expf(v[1] - mx); e[2] = __expf(v[2] - mx); e[3] = __expf(v[3] - mx); float s = wave_sum(e[0] + e[1] + e[2] + e[3], lane); const float inv = 1.f / s;
        *(f32x4*)(sc + w * 256 + lane * 4) = e * inv; }
    __syncthreads();
    f32x4 acc[4];
#pragma unroll
    for (int t = 0; t < 4; ++t) acc[t] = (f32x4){0.f, 0.f, 0.f, 0.f};
    for (int m0 = w; m0 < 256; m0 += 64) { f32x4 vv[8];
#pragma unroll
        for (int i = 0; i < 8; ++i) vv[i] = *(const f32x4*)(pk->cache_v + ((size_t)(sbi * 256 + m0 + 8 * i) * 4 + head) * 256 + lane * 4);
#pragma unroll
        for (int i = 0; i < 8; ++i)
#pragma unroll
            for (int t = 0; t < 4; ++t) acc[t] += vv[i] * sc[t * 256 + m0 + 8 * i]; }
#pragma unroll
    for (int t = 0; t < 4; ++t) *(f32x4*)(ored + (w * 4 + t) * 256 + lane * 4) = acc[t];
    __syncthreads();
    for (int idx = tid; idx < 1024; idx += 512) { const int t = idx >> 8, d = idx & 255; float s = 0.f;
#pragma unroll
        for (int ww = 0; ww < 8; ++ww) s += ored[(ww * 4 + t) * 256 + d];
        const size_t tok = (size_t)(NTOKP + sbi * 4 + t); const float gate = bf2f(proj[tok * NPROJ + C_XG + head * 256 + d]); mix[tok * DMIX + 2048 + head * 256 + d] = f2bf(s * siluf(gate)); }
}

DI void ssds_item(KP pk_in, unsigned char* lds, int sbi, int g) {
    KP pk = pk_in; asm volatile("" : "+s"(pk));
    unsigned char* ws = pk->ws;
    const int tid = otid(), w = tid >> 6, lane = tid & 63;
    const bf16_t* proj = (const bf16_t*)(ws + W_PROJ); bf16_t* mix = (bf16_t*)(ws + W_MIX); const float* wdf = (const float*)(ws + W_WDTF);
    float* xs = (float*)lds; float* Bs = xs + 2048; float* Cs = Bs + 512; float* yg = Cs + 512; float* dts = yg + 2048; float* decs = dts + 32;
    __syncthreads();
#pragma unroll
    for (int d = 0; d < 4; ++d) { const int pi = w * 4 + d, t = pi & 3, hl = pi >> 2, h = 8 * g + hl; float s = 0.f;
#pragma unroll
        for (int i = 0; i < 4; ++i) { const f32x4 xv = *(const f32x4*)(pk->x_sample + (size_t)(sbi * 4 + t) * 1024 + i * 256 + lane * 4), wv = *(const f32x4*)(wdf + h * 1024 + i * 256 + lane * 4);
            s += xv[0] * wv[0] + xv[1] * wv[1] + xv[2] * wv[2] + xv[3] * wv[3]; }
        s = wave_sum(s, lane);
        if (lane == 0) { const float dt = softplusf(s + pk->ssd_dt_bias[h]); dts[t * 8 + hl] = dt; decs[t * 8 + hl] = __expf(-dt * __expf(pk->ssd_a_log[h])); } }
    for (int idx = tid; idx < 4 * 768; idx += 512) { const int t = idx / 768, cc = idx % 768; const int ch = cc < 512 ? g * 512 + cc : (cc < 640 ? 1024 + g * 128 + (cc - 512) : 1280 + g * 128 + (cc - 640));
        float acc = pk->ssd_conv_b[ch];
#pragma unroll
        for (int kk = 0; kk < 4; ++kk) { const int ui = t + kk; const float x = ui < 3 ? pk->state_ssd_conv[(size_t)(sbi * 3 + ui) * 1536 + ch] : bf2f(proj[(size_t)(NTOKP + sbi * 4 + ui - 3) * NPROJ + C_XBC + ch]);
            acc += x * pk->ssd_conv_w[kk * 1536 + ch]; }
        const float a = siluf(acc);
        if (cc < 512) xs[t * 512 + cc] = a; else if (cc < 640) Bs[t * 128 + cc - 512] = a; else Cs[t * 128 + cc - 640] = a; }
    for (int idx = tid; idx < 3 * 768; idx += 512) { const int jj = idx / 768, cc = idx % 768; const int ch = cc < 512 ? g * 512 + cc : (cc < 640 ? 1024 + g * 128 + (cc - 512) : 1280 + g * 128 + (cc - 640));
        pk->out[O_SCS + (size_t)(sbi * 3 + jj) * 1536 + ch] = bf2f(proj[(size_t)(NTOKP + sbi * 4 + 1 + jj) * NPROJ + C_XBC + ch]); }
    __syncthreads();
    const int pp = tid >> 3, n0 = (tid & 7) * 16;
    f32x4 hs[4], hn[4];
#pragma unroll
    for (int v = 0; v < 4; ++v) hn[v] = *(const f32x4*)(pk->state_ssd_h + ((size_t)(sbi * 16 + 8 * g) * 64 + pp) * 128 + n0 + v * 4);
    for (int hl = 0; hl < 8; ++hl) { const int h = 8 * g + hl; const size_t so = ((size_t)(sbi * 16 + h) * 64 + pp) * 128 + n0;
#pragma unroll
        for (int v = 0; v < 4; ++v) hs[v] = hn[v];
        if (hl < 7) {
#pragma unroll
            for (int v = 0; v < 4; ++v) hn[v] = *(const f32x4*)(pk->state_ssd_h + so + 8192 + v * 4); }
        const float dsk = pk->ssd_d[h];
#pragma unroll
        for (int t = 0; t < 4; ++t) { const float dec = decs[t * 8 + hl], xv = xs[t * 512 + hl * 64 + pp], dtx = dts[t * 8 + hl] * xv; float part = 0.f;
#pragma unroll
            for (int v = 0; v < 4; ++v) { const f32x4 bv = *(const f32x4*)(Bs + t * 128 + n0 + v * 4), cv = *(const f32x4*)(Cs + t * 128 + n0 + v * 4);
                hs[v] = hs[v] * dec + bv * dtx; part += cv[0] * hs[v][0] + cv[1] * hs[v][1] + cv[2] * hs[v][2] + cv[3] * hs[v][3]; }
            part += shx(part, 1, lane); part += shx(part, 2, lane); part += shx(part, 4, lane);
            if ((tid & 7) == 0) { const float y = part + dsk * xv; const float z = bf2f(proj[(size_t)(NTOKP + sbi * 4 + t) * NPROJ + C_Z + h * 64 + pp]); yg[t * 512 + hl * 64 + pp] = y * siluf(z); } }
#pragma unroll
        for (int v = 0; v < 4; ++v) *(f32x4*)(pk->out + O_SHS + so + v * 4) = hs[v];
    }
    __syncthreads();
    if (w < 4) { const int t = w; float ss = 0.f; float v[8];
#pragma unroll
        for (int e = 0; e < 8; ++e) { v[e] = yg[t * 512 + e * 64 + lane]; ss += v[e] * v[e]; }
        ss = wave_sum(ss, lane); const float rstd = rsqrtf(ss * (1.f / 512.f) + 1e-5f);
#pragma unroll
        for (int e = 0; e < 8; ++e) { const int cc = e * 64 + lane; mix[(size_t)(NTOKP + sbi * 4 + t) * DMIX + 1024 + g * 512 + cc] = f2bf(v[e] * rstd * pk->ssd_norm_g[g * 512 + cc]); } }
}

DI void ssd3_item(KP pk_in, unsigned char* lds, int b, int c, int g) {
    KP pk = pk_in; asm volatile("" : "+s"(pk));
    unsigned char* ws = pk->ws;
    const int tid = otid(), w = tid >> 6, lane = tid & 63, l15 = lane & 15, q = lane >> 4;
    float* acum_s = (float*)lds; float* dt_s = acum_s + 1024;
    bf16_t* xT = (bf16_t*)(lds + 8192);
    const bf16_t* proj = (const bf16_t*)(ws + W_PROJ); const bf16_t* xact = (const bf16_t*)(ws + W_XACT); bf16_t* mix = (bf16_t*)(ws + W_MIX);
    const float* dt_g = (const float*)(ws + W_DT); const float* acum_g = (const float*)(ws + W_ACUM); const float* st_g = (const float*)(ws + W_ST);
    const int tok0 = b * 2048 + c * 128;
    __syncthreads();
    for (int idx = tid; idx < 1024; idx += 512) { const int j = idx >> 3, hl = idx & 7; acum_s[idx] = acum_g[(size_t)(tok0 + j) * 16 + 8 * g + hl]; dt_s[idx] = dt_g[(size_t)(tok0 + j) * 16 + 8 * g + hl]; }
    bf16x8 cf[4];
#pragma unroll
    for (int ks = 0; ks < 4; ++ks) cf[ks] = *(const bf16x8*)(xact + (size_t)(tok0 + 16 * w + l15) * 1536 + 1280 + g * 128 + ks * 32 + q * 8);
    f32x4 cbt[8];
#pragma unroll
    for (int jt = 0; jt < 8; ++jt) { cbt[jt] = (f32x4){0.f, 0.f, 0.f, 0.f};
        if (jt <= w) {
#pragma unroll
            for (int ks = 0; ks < 4; ++ks) { const bf16x8 bfr = *(const bf16x8*)(xact + (size_t)(tok0 + 16 * jt + l15) * 1536 + 1024 + g * 128 + ks * 32 + q * 8); cbt[jt] = MFMA16(bfr, cf[ks], cbt[jt]); } } }
    float ssq[4] = {0.f, 0.f, 0.f, 0.f};
    const int irow = 16 * w + l15;
    for (int hl = 0; hl < 8; ++hl) { const int h = 8 * g + hl;
        __syncthreads();
        for (int idx = tid; idx < 1024; idx += 512) { const int j = idx >> 3, pv = (idx & 7) * 8; const u32x4 v = *(const u32x4*)(xact + (size_t)(tok0 + j) * 1536 + g * 512 + hl * 64 + pv);
            const bf16_t* e16 = (const bf16_t*)&v; (void)e16;
            xT[(pv + 0) * 136 + j] = (bf16_t)(v.x & 0xFFFF); xT[(pv + 1) * 136 + j] = (bf16_t)(v.x >> 16); xT[(pv + 2) * 136 + j] = (bf16_t)(v.y & 0xFFFF); xT[(pv + 3) * 136 + j] = (bf16_t)(v.y >> 16);
            xT[(pv + 4) * 136 + j] = (bf16_t)(v.z & 0xFFFF); xT[(pv + 5) * 136 + j] = (bf16_t)(v.z >> 16); xT[(pv + 6) * 136 + j] = (bf16_t)(v.w & 0xFFFF); xT[(pv + 7) * 136 + j] = (bf16_t)(v.w >> 16); }
        __syncthreads();
        const float ai = acum_s[irow * 8 + hl];
        bf16x8 af[4];
#pragma unroll
        for (int s = 0; s < 4; ++s) { float m8[8];
#pragma unroll
            for (int hf = 0; hf < 2; ++hf) { const int jt = 2 * s + hf;
#pragma unroll
                for (int r = 0; r < 4; ++r) { const int j = 16 * jt + 4 * q + r; float val = 0.f;
                    if (jt <= w && j <= irow) val = cbt[jt][r] * __expf(ai - acum_s[j * 8 + hl]) * dt_s[j * 8 + hl];
                    m8[hf * 4 + r] = val; } }
            af[s] = as_frag(pack8(m8)); }
        const float dsk = pk->ssd_d[h];
        float ea[4];
#pragma unroll
        for (int r = 0; r < 4; ++r) ea[r] = __expf(acum_s[(16 * w + 4 * q + r) * 8 + hl]);
        float zz[4][4];
#pragma unroll
        for (int pt = 0; pt < 4; ++pt)
#pragma unroll
            for (int r = 0; r < 4; ++r) zz[pt][r] = bf2f(proj[(size_t)(tok0 + 16 * w + 4 * q + r) * NPROJ + C_Z + h * 64 + 16 * pt + l15]);
#pragma unroll
        for (int pt = 0; pt < 4; ++pt) { f32x4 yd = {0.f, 0.f, 0.f, 0.f}, yo = {0.f, 0.f, 0.f, 0.f};
            const bf16_t* xr = xT + (16 * pt + l15) * 136;
#pragma unroll
            for (int s = 0; s < 4; ++s) if (2 * s <= w) { const u32x2 lo = *(const u32x2*)(xr + 32 * s + 4 * q), hi = *(const u32x2*)(xr + 32 * s + 16 + 4 * q); yd = MFMA16(af[s], frag2(lo, hi), yd); }
            const float* hp = st_g + ((size_t)((b * 16 + c) * 16 + h) * 64 + 16 * pt + l15) * 128 + q * 8;
#pragma unroll
            for (int ks = 0; ks < 4; ++ks) { const f32x4 f0 = *(const f32x4*)(hp + ks * 32), f1 = *(const f32x4*)(hp + ks * 32 + 4); float m8[8] = {f0[0], f0[1], f0[2], f0[3], f1[0], f1[1], f1[2], f1[3]};
                yo = MFMA16(cf[ks], as_frag(pack8(m8)), yo); }
            const u32x2 xv2 = *(const u32x2*)(xr + 16 * w + 4 * q); const float xv[4] = {bflo(xv2.x), bfhi(xv2.x), bflo(xv2.y), bfhi(xv2.y)};
#pragma unroll
            for (int r = 0; r < 4; ++r) { const size_t tok = (size_t)(tok0 + 16 * w + 4 * q + r); const int pp = 16 * pt + l15;
                const float y = yd[r] + ea[r] * yo[r] + dsk * xv[r]; const float val = y * siluf(zz[pt][r]);
                ssq[r] += val * val; mix[tok * DMIX + 1024 + g * 512 + hl * 64 + pp] = f2bf(val); } }
    }
    float rstd[4];
#pragma unroll
    for (int r = 0; r < 4; ++r) { float s = ssq[r]; s += shx(s, 1, lane); s += shx(s, 2, lane); s += shx(s, 4, lane); s += shx(s, 8, lane); rstd[r] = rsqrtf(s * (1.f / 512.f) + 1e-5f); }
    for (int hl = 0; hl < 8; ++hl)
#pragma unroll
        for (int pt = 0; pt < 4; ++pt) { const int cc = hl * 64 + 16 * pt + l15; const float gn = pk->ssd_norm_g[g * 512 + cc];
#pragma unroll
            for (int r = 0; r < 4; ++r) { bf16_t* mp = mix + (size_t)(tok0 + 16 * w + 4 * q + r) * DMIX + 1024 + g * 512 + cc; *mp = f2bf(bf2f(*mp) * rstd[r] * gn); } }
}

DI void ln_rows(KP pk_in) {
    KP pk = pk_in; asm volatile("" : "+s"(pk));
    const float* res = (const float*)(pk->ws + W_RES);
    const int tid = otid(); const int lane = tid & 63; const int gw = obid() * 8 + (tid >> 6), nw = gridDim.x * 8;
    f32x4 gg[4], bb[4];
#pragma unroll
    for (int i = 0; i < 4; ++i) { gg[i] = *(const f32x4*)(pk->ln_g + i * 256 + lane * 4); bb[i] = *(const f32x4*)(pk->ln_b + i * 256 + lane * 4); }
    for (int row = gw; row < NTOK; row += nw) { f32x4 v[4]; float s = 0.f;
#pragma unroll
        for (int i = 0; i < 4; ++i) { v[i] = *(const f32x4*)(res + (size_t)row * 1024 + i * 256 + lane * 4); s += v[i][0] + v[i][1] + v[i][2] + v[i][3]; }
        const float mu = wave_sum(s, lane) * (1.f / 1024.f); float s2 = 0.f;
#pragma unroll
        for (int i = 0; i < 4; ++i) { v[i] = v[i] - mu; s2 += v[i][0] * v[i][0] + v[i][1] * v[i][1] + v[i][2] * v[i][2] + v[i][3] * v[i][3]; }
        const float rstd = rsqrtf(wave_sum(s2, lane) * (1.f / 1024.f) + 1e-5f);
#pragma unroll
        for (int i = 0; i < 4; ++i) *(f32x4*)(pk->out + (size_t)row * 1024 + i * 256 + lane * 4) = v[i] * rstd * gg[i] + bb[i]; }
}

__global__ void __launch_bounds__(512, 2) hymba_fwd(Params p_unused) {
    KP pk = kparams();
    extern __shared__ __attribute__((aligned(16))) unsigned char shm[];
    cg::grid_group grid = cg::this_grid();
    const int G = gridDim.x;
    if (threadIdx.x < 4) ((volatile LAS unsigned*)(LAS unsigned char*)shm)[32768 + threadIdx.x] = 0u;
    __syncthreads();
    const int ph_lo_chk = pk->ph_lo;
    XcdBarrier xb = xcd_barrier_post((unsigned*)(pk->ws + W_BAR), (volatile LAS unsigned*)(LAS unsigned char*)shm + 32768);
    if (ph_lo_chk < 0) grid.sync();
    { KP pk = kparams(); for (int rep = 0; rep < REP0; ++rep) phase_prep(pk, shm); }
    xcd_barrier(xb);
    { KP pk = kparams(); const int bid = obid();
      for (int rep = 0; rep < REP1; ++rep) {
        { pg8::Gemm g; g.A = (const bf16_t*)(pk->ws + W_XB); g.Bt = (const bf16_t*)(pk->ws + W_WINT); g.M = NTOK; g.N = NPROJ; g.K = 1024;
          pg8::StaticOrder S; S.init(g.M, g.N, G, bid); pg8::EpiBf16 E; E.O = (bf16_t*)(pk->ws + W_PROJ); E.ldc = NPROJ;
          pg8::gemm_phase<pg8::EpiBf16, pg8::StaticOrder>((LAS unsigned char*)shm, g, S, E); }
        { pg8::Gemm g; g.A = (const bf16_t*)(pk->ws + W_MEMB); g.Bt = (const bf16_t*)(pk->ws + W_WKVT); g.M = 2048; g.N = 2048; g.K = 1024;
          const int shift = (66 * 26) % G; pg8::StaticOrder S; S.init(g.M, g.N, G, (bid + G - shift) % G);
          pg8::EpiKV E; E.mk = pk->out + O_MKP; E.mv = pk->out + O_MVP; E.kb = (bf16_t*)(pk->ws + W_KB); E.vt = (bf16_t*)(pk->ws + W_VT);
          pg8::gemm_phase<pg8::EpiKV, pg8::StaticOrder>((LAS unsigned char*)shm, g, S, E); } } }
    xcd_barrier(xb);
    { KP pk = kparams(); const int bid = obid();
      for (int rep = 0; rep < REP2; ++rep) for (int it = bid; it < 384; it += G) { if (it < 256) ssd1_item(pk, shm, it >> 5, (it >> 1) & 15, it & 1); else rgconv_item(pk, (it - 256) >> 4, (it - 256) & 15); } }
    xcd_barrier(xb);
    { KP pk = kparams(); const int bid = obid();
      for (int rep = 0; rep < REP3; ++rep) for (int it = bid; it < 1920; it += G) {
          if (rep > 0 && (it < R3LO || it >= R3HI)) continue;
          if (it < 256) rg_item(pk, shm, false, it >> 5, (it >> 2) & 7, it & 3);
          else if (it < 512) statepass_item(pk, it - 256);
          else if (it < 640) { const int u = it - 512; rg_item(pk, shm, true, u >> 5, (u >> 2) & 7, u & 3); }
          else if (it < 896) { const int u = it - 640; ssds_item(pk, shm, u >> 1, u & 1); }
          else if (it < 1408) { const int u = it - 896; attns_item(pk, shm, u >> 2, u & 3); }
          else { const int u = it - 1408; attnp_item(pk, shm, u >> 6, (u >> 4) & 3, u & 15); } } }
    xcd_barrier(xb);
    { KP pk = kparams(); const int bid = obid();
      for (int rep = 0; rep < REP4; ++rep) for (int it = bid; it < 256; it += G) ssd3_item(pk, shm, it >> 5, (it >> 1) & 15, it & 1); }
    xcd_barrier(xb);
    { KP pk = kparams(); const int bid = obid();
      for (int rep = 0; rep < REP5; ++rep) {
        pg8::Gemm g; g.A = (const bf16_t*)(pk->ws + W_MIX); g.Bt = (const bf16_t*)(pk->ws + W_WOUTT); g.M = NTOK; g.N = 1024; g.K = 3072;
        pg8::StaticOrder S; S.init(g.M, g.N, G, bid); pg8::EpiRes E; E.res = (float*)(pk->ws + W_RES); E.xp = pk->x_prompt; E.xs = pk->x_sample; E.alpha = 1.189207115002721f;
        pg8::gemm_phase<pg8::EpiRes, pg8::StaticOrder>((LAS unsigned char*)shm, g, S, E); } }
    xcd_barrier(xb);
    { KP pk = kparams(); for (int rep = 0; rep < REP6; ++rep) ln_rows(pk); }
}

extern "C" void kernel_launch(void* const* d_in, const int* in_sizes, int n_in, void* d_out, int out_size, void* d_ws, size_t ws_size, hipStream_t stream) {
    static int grid_blocks = 0;
    if (!grid_blocks) {
        int dev = 0, cus = 0, per_cu = 0;
        hipGetDevice(&dev);
        hipDeviceGetAttribute(&cus, hipDeviceAttributeMultiprocessorCount, dev);
        if (hipFuncSetAttribute((const void*)hymba_fwd, hipFuncAttributeMaxDynamicSharedMemorySize, LDS_BYTES) != hipSuccess) fprintf(stderr, "hipFuncSetAttribute failed\n");
        hipOccupancyMaxActiveBlocksPerMultiprocessor(&per_cu, (const void*)hymba_fwd, 512, LDS_BYTES);
        if (per_cu < 1) { fprintf(stderr, "occupancy query says %d blocks per CU\n", per_cu); per_cu = 1; }
        grid_blocks = cus * 1;
        if (ws_size < W_END) fprintf(stderr, "workspace too small: %zu < %zu\n", ws_size, (size_t)W_END);
    }
    if (hipMemsetAsync((char*)d_ws + W_BAR, 0, 3456 * 4, stream) != hipSuccess) fprintf(stderr, "memset failed\n");
    Params p{};
    const float** fp = (const float**)&p;
    for (int i = 0; i < 28; ++i) fp[i] = (const float*)d_in[i];
    p.out = (float*)d_out; p.ws = (unsigned char*)d_ws;
    p.ph_lo = 0; p.ph_hi = NPHASE;
    void* args[] = {&p};
    hipError_t e = hipLaunchCooperativeKernel((const void*)hymba_fwd, dim3(grid_blocks), dim3(512), args, LDS_BYTES, stream);
    if (e != hipSuccess) fprintf(stderr, "cooperative launch failed: %s (grid %d)\n", hipGetErrorString(e), grid_blocks);
}
```

```cpp
#include <hip/hip_runtime.h>
#include <hip/hip_cooperative_groups.h>
#include <cstdio>
namespace cg = cooperative_groups;

#ifndef REP2
#define REP2 1
#endif
#ifndef REP3
#define REP3 1
#endif
#ifndef REP4
#define REP4 1
#endif
#ifndef R3LO
#define R3LO 0
#define R3HI 256
#endif
#ifndef REP0
#define REP0 1
#endif
#ifndef REP1
#define REP1 1
#endif
#ifndef REP5
#define REP5 1
#endif
#ifndef REP6
#define REP6 1
#endif
#ifndef REPS
#define REPS 1
#endif
#ifndef PHM
#define PHM 127
#endif
#ifndef N_LAUNCH_PER_PHASE
#define N_LAUNCH_PER_PHASE 0
#endif

#define DI __device__ __forceinline__
#define LAS __attribute__((address_space(3)))
typedef unsigned short bf16_t;
typedef short bf16x8 __attribute__((ext_vector_type(8)));
typedef float f32x4 __attribute__((ext_vector_type(4)));
typedef unsigned u32x4 __attribute__((ext_vector_type(4)));
typedef unsigned u32x2 __attribute__((ext_vector_type(2)));

constexpr int NTOKP = 16384, NTOKS = 512, NTOK = 16896, DM = 1024, NPROJ = 6656, DMIX = 3072, DIN = 6672;
constexpr int C_RGX = 0, C_RGG = 1024, C_XBC = 2048, C_Z = 3584, C_Q = 4608, C_XG = 5632;
constexpr int NPHASE = 7;
constexpr int LDS_BYTES = 131072 + 64;

constexpr size_t O_YP = 0, O_YS = O_YP + (size_t)NTOKP * DM, O_RGCP = O_YS + (size_t)NTOKS * DM, O_RGHP = O_RGCP + 8 * 3 * 1024, O_SCP = O_RGHP + 8 * 1024,
                 O_SHP = O_SCP + 8 * 3 * 1536, O_MKP = O_SHP + (size_t)8 * 16 * 64 * 128, O_MVP = O_MKP + (size_t)2048 * 1024, O_RGCS = O_MVP + (size_t)2048 * 1024,
                 O_RGHS = O_RGCS + (size_t)128 * 3 * 1024, O_SCS = O_RGHS + 128 * 1024, O_SHS = O_SCS + (size_t)128 * 3 * 1536;

constexpr size_t al256(size_t x) { return (x + 255) & ~(size_t)255; }
constexpr size_t W_XB = 0;
constexpr size_t W_WINT = al256(W_XB + (size_t)NTOK * DM * 2);
constexpr size_t W_WDTT = al256(W_WINT + (size_t)NPROJ * DM * 2);
constexpr size_t W_WDTF = al256(W_WDTT + 16 * 1024 * 2);
constexpr size_t W_WOUTT = al256(W_WDTF + 16 * 1024 * 4);
constexpr size_t W_WKVT = al256(W_WOUTT + (size_t)1024 * 3072 * 2);
constexpr size_t W_MEMB = al256(W_WKVT + (size_t)2048 * 1024 * 2);
constexpr size_t W_WGT = al256(W_MEMB + (size_t)2048 * 1024 * 2);
constexpr size_t W_KB = al256(W_WGT + (size_t)8 * 4 * 64 * 128 * 2);
constexpr size_t W_VT = al256(W_KB + (size_t)2048 * 1024 * 2);
constexpr size_t W_XACT = al256(W_VT + (size_t)2048 * 1024 * 2);
constexpr size_t W_DT = al256(W_XACT + (size_t)NTOKP * 1536 * 2);
constexpr size_t W_ACUM = al256(W_DT + (size_t)NTOKP * 16 * 4);
constexpr size_t W_CD = al256(W_ACUM + (size_t)NTOKP * 16 * 4);
constexpr size_t W_ST = al256(W_CD + 8 * 16 * 16 * 4);
constexpr size_t W_MIX = al256(W_ST + (size_t)8 * 16 * 16 * 8192 * 4);
constexpr size_t W_PROJ = al256(W_MIX + (size_t)NTOK * DMIX * 2);
constexpr size_t W_RES = W_PROJ;
constexpr size_t W_BAR = al256(W_PROJ + (size_t)NTOK * NPROJ * 2);
constexpr size_t W_END = al256(W_BAR + 3456 * 4);

struct Params {
    const float *x_prompt, *x_sample, *mem_prompt, *state_rg_conv, *state_rg_h, *state_ssd_conv, *state_ssd_h, *cache_k, *cache_v;
    const float *w_in, *rg_conv_w, *rg_conv_b, *w_rg_a, *b_rg_a, *w_rg_i, *b_rg_i, *rg_lambda, *ssd_conv_w, *ssd_conv_b, *ssd_dt_bias, *ssd_a_log, *ssd_d, *ssd_norm_g,
        *w_mem_k, *w_mem_v, *w_out, *ln_g, *ln_b;
    float* out; unsigned char* ws;
    int ph_lo, ph_hi;
};
typedef const __attribute__((address_space(4))) Params* KP;
DI KP kparams() { KP k = (KP)__builtin_amdgcn_kernarg_segment_ptr(); asm volatile("" : "+s"(k)); return k; }

DI int otid() { int t = threadIdx.x; asm volatile("" : "+v"(t)); return t; }
DI int obid() { int t = blockIdx.x; asm volatile("" : "+s"(t)); return t; }
DI float bf2f(bf16_t b) { return __uint_as_float(((unsigned)b) << 16); }
typedef __bf16 hbf2 __attribute__((ext_vector_type(2)));
typedef float f32x2 __attribute__((ext_vector_type(2)));
DI unsigned pack2(float lo, float hi) { const f32x2 v = {lo, hi}; return __builtin_bit_cast(unsigned, __builtin_convertvector(v, hbf2)); }
DI bf16_t f2bf(float f) { return (bf16_t)(pack2(f, 0.f) & 0xFFFFu); }
DI float bflo(unsigned w) { return __uint_as_float(w << 16); }
DI float bfhi(unsigned w) { return __uint_as_float(w & 0xFFFF0000u); }
DI void unpack8(const u32x4 v, float (&o)[8]) { o[0] = bflo(v.x); o[1] = bfhi(v.x); o[2] = bflo(v.y); o[3] = bfhi(v.y); o[4] = bflo(v.z); o[5] = bfhi(v.z); o[6] = bflo(v.w); o[7] = bfhi(v.w); }
DI u32x4 pack8(const float (&o)[8]) { u32x4 w; w.x = pack2(o[0], o[1]); w.y = pack2(o[2], o[3]); w.z = pack2(o[4], o[5]); w.w = pack2(o[6], o[7]); return w; }
DI bf16x8 as_frag(u32x4 w) { return __builtin_bit_cast(bf16x8, w); }
DI bf16x8 frag2(u32x2 lo, u32x2 hi) { u32x4 w; w.x = lo.x; w.y = lo.y; w.z = hi.x; w.w = hi.y; return __builtin_bit_cast(bf16x8, w); }
DI float shx(float v, int m, int lane) { return __int_as_float(__builtin_amdgcn_ds_bpermute((lane ^ m) << 2, __float_as_int(v))); }
DI float shl(float v, int src) { return __int_as_float(__builtin_amdgcn_ds_bpermute(src << 2, __float_as_int(v))); }
DI float siluf(float x) { return x * __builtin_amdgcn_rcpf(1.f + __expf(-x)); }
DI float sigmf(float x) { return __builtin_amdgcn_rcpf(1.f + __expf(-x)); }
DI float softplusf(float v) { return v > 20.f ? v : __logf(1.f + __expf(v)); }
#define MFMA16(a, b, c) __builtin_amdgcn_mfma_f32_16x16x32_bf16((a), (b), (c), 0, 0, 0)

#define XB_TMO      128
#define XB_XCNT(j)  (256  + 64 * (j))
#define XB_XSUB(j)  (1280 + 64 * (j))
#define XB_XGEN(j)  (2304 + 64 * (j))
#define XB_TOP      3328
#define XB_TOPGEN   3392
#define XCD_BAR_WORDS 3456
#define XB_SPIN_CAP (1u << 20)
DI unsigned xb_ld(unsigned* ptr)              { return __hip_atomic_load(ptr, __ATOMIC_RELAXED, __HIP_MEMORY_SCOPE_AGENT); }
DI unsigned xb_add(unsigned* ptr, unsigned v) { return __hip_atomic_fetch_add(ptr, v, __ATOMIC_RELAXED, __HIP_MEMORY_SCOPE_AGENT); }
DI unsigned xb_xcc_id() { return (unsigned)__builtin_amdgcn_s_getreg((3 << 11) | 20) & 0xFu; }
#define XB_SPIN(cond, bar) do { unsigned _sp = 0; while (cond) { __builtin_amdgcn_s_sleep(1); \
    if ((++_sp & 255u) == 0u) { if (xb_ld(&(bar)[XB_TMO])) break; if (_sp > XB_SPIN_CAP) { atomicAdd(&(bar)[XB_TMO], 1u); break; } } } } while (0)
struct XcdBarrier { unsigned* bar; unsigned x; volatile LAS unsigned* st; };
DI XcdBarrier xcd_barrier_post(unsigned* bar, volatile LAS unsigned* st) {
    XcdBarrier b; b.bar = bar; b.x = xb_xcc_id(); b.st = st;
    if (threadIdx.x == 0) (void)xb_add(&bar[XB_XCNT(b.x)], 1u);
    return b;
}
DI void xcd_barrier_complete(unsigned* bar, unsigned x, unsigned& nloc, unsigned& nx) {
    const unsigned G = gridDim.x * gridDim.y * gridDim.z;
    unsigned sum, cnt, mine, sp = 0u;
    for (;;) {
        sum = 0u; cnt = 0u; mine = 0u;
#pragma unroll
        for (unsigned j = 0; j < 16; ++j) { const unsigned c = xb_ld(&bar[XB_XCNT(j)]); sum += c; cnt += (c > 0u) ? 1u : 0u; mine = (j == x) ? c : mine; }
        if (sum == G) break;
        __builtin_amdgcn_s_sleep(1);
        if ((++sp & 255u) == 0u) { if (xb_ld(&bar[XB_TMO])) break; if (sp > XB_SPIN_CAP) { atomicAdd(&bar[XB_TMO], 1u); break; } }
    }
    nloc = mine > 0u ? mine : 1u; nx = cnt > 0u ? cnt : 1u;
}
DI void xcd_barrier(const XcdBarrier& b) {
    asm volatile("s_waitcnt vmcnt(0)" ::: "memory");
    __syncthreads();
    if (threadIdx.x == 0) {
        unsigned* bar = b.bar;
        __builtin_amdgcn_s_waitcnt(0);
        unsigned nloc = b.st[0], nx = b.st[1];
        if (nloc == 0u) { xcd_barrier_complete(bar, b.x, nloc, nx); b.st[0] = nloc; b.st[1] = nx; }
        const unsigned old = xb_add(&bar[XB_XSUB(b.x)], 1u);
        const unsigned gen = old / nloc;
        if (old + 1u == (gen + 1u) * nloc) {
            __builtin_amdgcn_fence(__ATOMIC_RELEASE, "agent");
            asm volatile("s_waitcnt vmcnt(0)" ::: "memory");
            const unsigned og = xb_add(&bar[XB_TOP], 1u);
            const unsigned tg = og / nx;
            if (og + 1u == (tg + 1u) * nx) xb_add(&bar[XB_TOPGEN], 1u);
            else XB_SPIN(xb_ld(&bar[XB_TOPGEN]) == tg, bar);
            __builtin_amdgcn_fence(__ATOMIC_ACQUIRE, "agent");
            xb_add(&bar[XB_XGEN(b.x)], 1u);
            asm volatile("s_waitcnt vmcnt(0)" ::: "memory");
        } else {
            XB_SPIN(xb_ld(&bar[XB_XGEN(b.x)]) == gen, bar);
            __builtin_amdgcn_fence(__ATOMIC_ACQUIRE, "agent");
            asm volatile("s_waitcnt vmcnt(0)" ::: "memory");
        }
    }
    __syncthreads();
}

namespace pg8 {
constexpr int BM = 256, BK = 64, HALF = 128, HTB = HALF * BK * 2, STAGE_BYTES = 8 * HTB, NXCD = 8, WGM = 8;
DI int lds_byte(int r, int c) { const int st = (r >> 4) * 2 + (c >> 5), rr = r & 15, cc = c & 31, ob = rr * 64 + cc * 2; return st * 1024 + (ob ^ (((ob >> 9) & 1) << 5)); }
DI void stage_rc(int b, int& R, int& C) { const int st = b / 1024, sb = b % 1024, swz = sb ^ (((sb >> 9) & 1) << 5); R = (st >> 1) * 16 + swz / 64; C = (st & 1) * 32 + (swz % 64) / 2; }
DI int perm32(int rho) { const int n = rho >> 4, i = rho & 15; return 8 * (i >> 2) + 4 * n + (i & 3); }
struct Unit { int pm, pn; };
struct Gemm { const bf16_t* A; const bf16_t* Bt; int M, N, K; };
struct StaticOrder {
    int nM, nN, nwg, G, c;
    DI void init(int M, int N, int G_, int c_) { nM = M / BM; nN = N / BM; nwg = nM * nN; G = G_; c = c_; }
    DI bool next(int i, Unit& u) const {
        const long L = (long)i * G + c; if (L >= nwg) return false;
        int wgid = (int)L; { const int q = nwg / NXCD, r = nwg % NXCD, xcd = wgid % NXCD, off = wgid / NXCD; wgid = (xcd < r ? xcd * (q + 1) : r * (q + 1) + (xcd - r) * q) + off; }
        const int nig = WGM * nN, gid = wgid / nig, fm = gid * WGM, gsz = (nM - fm) < WGM ? (nM - fm) : WGM;
        u.pm = fm + ((wgid % nig) % gsz); u.pn = (wgid % nig) / gsz; return true;
    }
};
DI unsigned cvt_pk_bf16(float lo, float hi) { unsigned r; asm volatile("v_cvt_pk_bf16_f32 %0, %1, %2" : "=v"(r) : "v"(lo), "v"(hi)); return r; }

struct EpiBf16 {
    static constexpr bool PERM = true;
    bf16_t* O; int ldc;
    DI void operator()(const f32x4 (&acc)[2][2][4][2], const Unit& u, int wr, int wc, int fr, int fq) const {
        const int row0 = u.pm * BM + wr * 64 + fr; const int col0 = u.pn * BM + wc * 32 + 8 * fq;
#pragma unroll
        for (int ai = 0; ai < 2; ++ai)
#pragma unroll
            for (int m = 0; m < 4; ++m) { bf16_t* rowp = O + (size_t)(row0 + ai * HALF + m * 16) * ldc + col0;
#pragma unroll
                for (int bj = 0; bj < 2; ++bj) { const f32x4 v0 = acc[ai][bj][m][0], v1 = acc[ai][bj][m][1];
                    u32x4 w; w.x = cvt_pk_bf16(v0[0], v0[1]); w.y = cvt_pk_bf16(v0[2], v0[3]); w.z = cvt_pk_bf16(v1[0], v1[1]); w.w = cvt_pk_bf16(v1[2], v1[3]);
                    *(u32x4*)(rowp + bj * HALF) = w; } }
    }
};
struct EpiKV {
    static constexpr bool PERM = false;
    float* mk; float* mv; bf16_t* kb; bf16_t* vt;
    DI void operator()(const f32x4 (&acc)[2][2][4][2], const Unit& u, int wr, int wc, int fr, int fq) const {
        const int row0 = u.pm * BM + wr * 64 + fr, col0 = u.pn * BM + wc * 32 + 4 * fq;
#pragma unroll
        for (int ai = 0; ai < 2; ++ai)
#pragma unroll
            for (int m = 0; m < 4; ++m) { const int row = row0 + ai * HALF + m * 16;
#pragma unroll
                for (int bj = 0; bj < 2; ++bj)
#pragma unroll
                    for (int n = 0; n < 2; ++n) { const int col = col0 + bj * HALF + n * 16; const f32x4 v = acc[ai][bj][m][n];
                        if (col < 1024) { *(f32x4*)(mk + (size_t)row * 1024 + col) = v; u32x2 w; w.x = cvt_pk_bf16(v[0], v[1]); w.y = cvt_pk_bf16(v[2], v[3]); *(u32x2*)(kb + (size_t)row * 1024 + col) = w; }
                        else { const int cc = col - 1024; *(f32x4*)(mv + (size_t)row * 1024 + cc) = v; const int bb = row >> 8, mt = row & 255;
#pragma unroll
                            for (int j = 0; j < 4; ++j) { const int c2 = cc + j, head = c2 >> 8, d = c2 & 255; vt[((size_t)((bb * 4 + head) * 256 + d)) * 256 + mt] = f2bf(v[j]); } } } }
    }
};
struct EpiRes {
    static constexpr bool PERM = false;
    float* res; const float* xp; const float* xs; float alpha;
    DI void operator()(const f32x4 (&acc)[2][2][4][2], const Unit& u, int wr, int wc, int fr, int fq) const {
        const int row0 = u.pm * BM + wr * 64 + fr, col0 = u.pn * BM + wc * 32 + 4 * fq;
#pragma unroll
        for (int ai = 0; ai < 2; ++ai)
#pragma unroll
            for (int m = 0; m < 4; ++m) { const int row = row0 + ai * HALF + m * 16; const float* xr = row < NTOKP ? xp + (size_t)row * 1024 : xs + (size_t)(row - NTOKP) * 1024;
#pragma unroll
                for (int bj = 0; bj < 2; ++bj)
#pragma unroll
                    for (int n = 0; n < 2; ++n) { const int col = col0 + bj * HALF + n * 16; const f32x4 xv = *(const f32x4*)(xr + col);
                        *(f32x4*)(res + (size_t)row * 1024 + col) = acc[ai][bj][m][n] + xv * alpha; } }
    }
};

template <class Epi, class Sched>
DI void gemm_phase(LAS unsigned char* lds, const Gemm g, const Sched& S, const Epi& E) {
    const int tid = otid(), wid = __builtin_amdgcn_readfirstlane(tid >> 6), lane = tid & 63, wr = wid >> 2, wc = wid & 3, fr = lane & 15, fq = lane >> 4;
    const int K = g.K, nt = K / BK;
    unsigned voffA[2], voffB[2];
#pragma unroll
    for (int i = 0; i < 2; ++i) { int R, C; stage_rc(tid * 16 + i * 8192, R, C); const int Rb = Epi::PERM ? ((R & ~31) + perm32(R & 31)) : R;
        voffA[i] = (unsigned)(R * K + C) * 2u; voffB[i] = (unsigned)(Rb * K + C) * 2u; }
    const size_t kstep = (size_t)(BK * 2);
    const size_t hstep = (size_t)HALF * K * 2;
    const size_t tstep = 2 * hstep;
    const unsigned ldsw = (unsigned)wid * 1024u;
    const int aoff = lds_byte(wr * 64 + fr, fq * 8), boff = lds_byte(wc * 32 + fr, fq * 8);
#define PG8_SA(b, h) (((b) * 2 + (h)) * HTB)
#define PG8_SB(b, h) ((4 + (b) * 2 + (h)) * HTB)
#define PG8_STAGE(bufoff, gbase, voff) do { _Pragma("unroll") for (int _i = 0; _i < 2; ++_i) \
        __builtin_amdgcn_global_load_lds((const unsigned*)((const char*)(gbase) + (voff)[_i]), (LAS unsigned*)(lds + (bufoff) + ldsw + _i * 8192), 16, 0, 0); } while (0)
#define PG8_LDA(dst, b, h) do { _Pragma("unroll") for (int m = 0; m < 4; ++m) _Pragma("unroll") for (int k = 0; k < 2; ++k) dst[m][k] = *(const LAS bf16x8*)(lds + PG8_SA(b, h) + aoff + m * 2048 + k * 1024); } while (0)
#define PG8_LDB(dst, b, h) do { _Pragma("unroll") for (int n = 0; n < 2; ++n) _Pragma("unroll") for (int k = 0; k < 2; ++k) dst[n][k] = *(const LAS bf16x8*)(lds + PG8_SB(b, h) + boff + n * 2048 + k * 1024); } while (0)
#define PG8_MMA(ai, bj, At, Bt) do { __builtin_amdgcn_s_setprio(1); _Pragma("unroll") for (int m = 0; m < 4; ++m) _Pragma("unroll") for (int n = 0; n < 2; ++n) _Pragma("unroll") for (int k = 0; k < 2; ++k) \
        acc[ai][bj][m][n] = __builtin_amdgcn_mfma_f32_16x16x32_bf16(Bt[n][k], At[m][k], acc[ai][bj][m][n], 0, 0, 0); __builtin_amdgcn_s_setprio(0); } while (0)
#define PG8_WAIT_V(n) asm volatile("s_waitcnt vmcnt(" #n ")" ::: "memory")
#define PG8_WAIT_L(n) asm volatile("s_waitcnt lgkmcnt(" #n ")" ::: "memory")
#define PG8_BAR __builtin_amdgcn_s_barrier()
#define PG8_SCHED __builtin_amdgcn_sched_barrier(0)
    Unit cur, nxt; int ui = 0;
    if (!S.next(0, cur)) return;
    f32x4 acc[2][2][4][2];
#pragma unroll
    for (int a = 0; a < 2; ++a)
#pragma unroll
        for (int b = 0; b < 2; ++b)
#pragma unroll
            for (int m = 0; m < 4; ++m)
#pragma unroll
                for (int n = 0; n < 2; ++n) acc[a][b][m][n] = (f32x4){0.f, 0.f, 0.f, 0.f};
    bf16x8 At[4][2], B0[2][2], B1[2][2];
    const char* cA = (const char*)g.A + (size_t)cur.pm * tstep; const char* cB = (const char*)g.Bt + (size_t)cur.pn * tstep;
    PG8_STAGE(PG8_SB(0, 0), cB, voffB); PG8_STAGE(PG8_SA(0, 0), cA, voffA); PG8_STAGE(PG8_SB(0, 1), cB + hstep, voffB); PG8_STAGE(PG8_SA(0, 1), cA + hstep, voffA);
    if (wr == 1) PG8_BAR;
    PG8_WAIT_V(4); PG8_BAR;
    PG8_STAGE(PG8_SB(1, 0), cB + kstep, voffB); PG8_STAGE(PG8_SA(1, 0), cA + kstep, voffA); PG8_STAGE(PG8_SB(1, 1), cB + hstep + kstep, voffB);
    PG8_WAIT_V(6); PG8_BAR;
    for (;;) {
        const bool has_next = S.next(ui + 1, nxt);
        const char* nA = has_next ? (const char*)g.A + (size_t)nxt.pm * tstep : cA; const char* nB = has_next ? (const char*)g.Bt + (size_t)nxt.pn * tstep : cB;
        for (int t = 0; t < nt; t += 2) {
            const bool last = (t == nt - 2);
            const char* a1 = cA + (size_t)(t + 1) * kstep;
            const char* a2 = last ? nA : cA + (size_t)(t + 2) * kstep; const char* b2 = last ? nB : cB + (size_t)(t + 2) * kstep;
            const char* a3 = a2 + kstep; const char* b3 = b2 + kstep;
            PG8_LDB(B0, 0, 0); PG8_SCHED; PG8_LDA(At, 0, 0); PG8_STAGE(PG8_SA(1, 1), a1 + hstep, voffA);
            PG8_WAIT_L(8); PG8_BAR; PG8_WAIT_L(0); PG8_MMA(0, 0, At, B0); PG8_BAR; PG8_SCHED;
            PG8_LDB(B1, 0, 1); PG8_STAGE(PG8_SB(0, 0), b2, voffB);
            PG8_BAR; PG8_WAIT_L(0); PG8_MMA(0, 1, At, B1); PG8_BAR;
            PG8_LDA(At, 0, 1); PG8_STAGE(PG8_SA(0, 0), a2, voffA);
            PG8_BAR; PG8_WAIT_L(0); PG8_MMA(1, 0, At, B0); PG8_BAR; PG8_SCHED;
            PG8_STAGE(PG8_SB(0, 1), b2 + hstep, voffB);
            PG8_WAIT_V(6); PG8_BAR; PG8_MMA(1, 1, At, B1); PG8_BAR;
            PG8_LDB(B0, 1, 0); PG8_SCHED; PG8_LDA(At, 1, 0); PG8_STAGE(PG8_SA(0, 1), a2 + hstep, voffA);
            PG8_WAIT_L(8); PG8_BAR; PG8_WAIT_L(0); PG8_MMA(0, 0, At, B0); PG8_BAR; PG8_SCHED;
            PG8_LDB(B1, 1, 1); PG8_STAGE(PG8_SB(1, 0), b3, voffB);
            PG8_BAR; PG8_WAIT_L(0); PG8_MMA(0, 1, At, B1); PG8_BAR;
            PG8_LDA(At, 1, 1); PG8_STAGE(PG8_SA(1, 0), a3, voffA);
            PG8_BAR; PG8_WAIT_L(0); PG8_MMA(1, 0, At, B0); PG8_BAR; PG8_SCHED;
            PG8_STAGE(PG8_SB(1, 1), b3 + hstep, voffB);
            PG8_WAIT_V(6); PG8_BAR; PG8_MMA(1, 1, At, B1); PG8_BAR;
        }
        E(acc, cur, wr, wc, fr, fq);
        if (!has_next) break;
#pragma unroll
        for (int a = 0; a < 2; ++a)
#pragma unroll
            for (int b = 0; b < 2; ++b)
#pragma unroll
                for (int m = 0; m < 4; ++m)
#pragma unroll
                    for (int n = 0; n < 2; ++n) acc[a][b][m][n] = (f32x4){0.f, 0.f, 0.f, 0.f};
        cur = nxt; cA = nA; cB = nB; ++ui;
    }
    PG8_WAIT_V(0);
    if (wr == 0) PG8_BAR;
    PG8_BAR;
#undef PG8_SA
#undef PG8_SB
#undef PG8_STAGE
#undef PG8_LDA
#undef PG8_LDB
#undef PG8_MMA
#undef PG8_WAIT_V
#undef PG8_WAIT_L
#undef PG8_BAR
#undef PG8_SCHED
}
}

DI void tr_tile(const float* src, int ld_src, int k0, int c0, bf16_t* dst, int ld_dst, int n0, float* lds) {
    const int tid = otid();
#pragma unroll
    for (int pass = 0; pass < 2; ++pass) { const int r = pass * 32 + (tid >> 4), c4 = (tid & 15) * 4;
        const f32x4 v = *(const f32x4*)(src + (size_t)(k0 + r) * ld_src + c0 + c4);
        lds[r * 65 + c4 + 0] = v[0]; lds[r * 65 + c4 + 1] = v[1]; lds[r * 65 + c4 + 2] = v[2]; lds[r * 65 + c4 + 3] = v[3]; }
    __syncthreads();
    const int nn = tid >> 3, kc = (tid & 7) * 8;
    float o[8];
#pragma unroll
    for (int e = 0; e < 8; ++e) o[e] = lds[(kc + e) * 65 + nn];
    *(u32x4*)(dst + (size_t)(n0 + nn) * ld_dst + k0 + kc) = pack8(o);
    __syncthreads();
}

DI void phase_prep(KP pk_in, unsigned char* lds) {
    KP pk = pk_in; asm volatile("" : "+s"(pk));
    unsigned char* ws = pk->ws;
    const int bidx_ = obid(); const size_t gtid = (size_t)bidx_ * 512 + otid(), nthr = (size_t)gridDim.x * 512;
    { bf16_t* xb = (bf16_t*)(ws + W_XB);
      for (size_t v = gtid; v < (size_t)NTOK * 128; v += nthr) { const float* s = v < (size_t)NTOKP * 128 ? pk->x_prompt + v * 8 : pk->x_sample + (v - (size_t)NTOKP * 128) * 8;
          const f32x4 a = *(const f32x4*)s, b = *(const f32x4*)(s + 4); float o[8] = {a[0], a[1], a[2], a[3], b[0], b[1], b[2], b[3]}; *(u32x4*)(xb + v * 8) = pack8(o); } }
    { bf16_t* mb = (bf16_t*)(ws + W_MEMB);
      for (size_t v = gtid; v < (size_t)2048 * 128; v += nthr) { const float* s = pk->mem_prompt + v * 8;
          const f32x4 a = *(const f32x4*)s, b = *(const f32x4*)(s + 4); float o[8] = {a[0], a[1], a[2], a[3], b[0], b[1], b[2], b[3]}; *(u32x4*)(mb + v * 8) = pack8(o); } }
    { bf16_t* wd = (bf16_t*)(ws + W_WDTT); float* wf = (float*)(ws + W_WDTF);
      for (size_t i = gtid; i < 16 * 1024; i += nthr) { const int h = (int)(i >> 10), k = (int)(i & 1023); const float v = pk->w_in[(size_t)k * DIN + 4608 + h]; wd[i] = f2bf(v); wf[i] = v; } }
    { bf16_t* wg = (bf16_t*)(ws + W_WGT);
      for (size_t i = gtid; i < (size_t)8 * 4 * 64 * 128; i += nthr) { const int k = (int)(i >> 15), qd = (int)(i >> 13) & 3, nn = (int)(i >> 7) & 63, ii = (int)(i & 127);
          const float v = nn < 32 ? pk->w_rg_a[((size_t)k * 128 + ii) * 128 + qd * 32 + nn] : pk->w_rg_i[((size_t)k * 128 + ii) * 128 + qd * 32 + nn - 32]; wg[i] = f2bf(v); } }
    float* tl = (float*)lds;
    for (int t = bidx_; t < 1664 + 768 + 512; t += gridDim.x) {
        if (t < 1664) { const int kt = t & 15, ntile = t >> 4; const int n0 = ntile * 64, c0 = n0 < 4608 ? n0 : n0 + 16;
            tr_tile(pk->w_in, DIN, kt * 64, c0, (bf16_t*)(ws + W_WINT), 1024, n0, tl); }
        else if (t < 1664 + 768) { const int u = t - 1664; const int kt = u % 48, ntile = u / 48;
            tr_tile(pk->w_out, 1024, kt * 64, ntile * 64, (bf16_t*)(ws + W_WOUTT), 3072, ntile * 64, tl); }
        else { const int u = t - 1664 - 768; const int kt = u & 15, ntile = u >> 4; const int n0 = ntile * 64;
            if (n0 < 1024) tr_tile(pk->w_mem_k, 1024, kt * 64, n0, (bf16_t*)(ws + W_WKVT), 1024, n0, tl);
            else tr_tile(pk->w_mem_v, 1024, kt * 64, n0 - 1024, (bf16_t*)(ws + W_WKVT), 1024, n0, tl); }
    }
}

DI void conv8_ssd_prompt(KP pk, const bf16_t* proj, int rowbase, int t, int ch, float (&o)[8]) {
    const f32x4 b0 = *(const f32x4*)(pk->ssd_conv_b + ch), b1 = *(const f32x4*)(pk->ssd_conv_b + ch + 4);
    float acc[8] = {b0[0], b0[1], b0[2], b0[3], b1[0], b1[1], b1[2], b1[3]};
    u32x4 vv[4];
#pragma unroll
    for (int kk = 0; kk < 4; ++kk) { const int tt = t - 3 + kk; vv[kk] = *(const u32x4*)(proj + (size_t)(rowbase + (tt < 0 ? 0 : tt)) * NPROJ + C_XBC + ch); }
#pragma unroll
    for (int kk = 0; kk < 4; ++kk) { const int tt = t - 3 + kk; const float msk = tt >= 0 ? 1.f : 0.f; float x[8]; unpack8(vv[kk], x);
            const f32x4 w0 = *(const f32x4*)(pk->ssd_conv_w + kk * 1536 + ch) * msk, w1 = *(const f32x4*)(pk->ssd_conv_w + kk * 1536 + ch + 4) * msk;
            acc[0] += x[0] * w0[0]; acc[1] += x[1] * w0[1]; acc[2] += x[2] * w0[2]; acc[3] += x[3] * w0[3];
            acc[4] += x[4] * w1[0]; acc[5] += x[5] * w1[1]; acc[6] += x[6] * w1[2]; acc[7] += x[7] * w1[3]; }
#pragma unroll
    for (int e = 0; e < 8; ++e) o[e] = siluf(acc[e]);
}

DI void ssd1_item(KP pk_in, unsigned char* lds, int b, int c, int g) {
    KP pk = pk_in; asm volatile("" : "+s"(pk));
    unsigned char* ws = pk->ws;
    const int tid = otid(), w = tid >> 6, lane = tid & 63, l15 = lane & 15, q = lane >> 4;
    float* dt_s = (float*)lds; float* acum_s = dt_s + 2048; float* w_s = acum_s + 2048;
    bf16_t* BT = (bf16_t*)(lds + 20480); bf16_t* xsT = (bf16_t*)(lds + 20480 + 34816);
    const bf16_t* xb = (const bf16_t*)(ws + W_XB); const bf16_t* wdt = (const bf16_t*)(ws + W_WDTT); const bf16_t* proj = (const bf16_t*)(ws + W_PROJ);
    bf16_t* xact = (bf16_t*)(ws + W_XACT); float* dt_g = (float*)(ws + W_DT); float* acum_g = (float*)(ws + W_ACUM); float* cd_g = (float*)(ws + W_CD); float* st_g = (float*)(ws + W_ST);
    const int tok0 = b * 2048 + c * 128;
    __syncthreads();
    { f32x4 acc = {0.f, 0.f, 0.f, 0.f}; const bf16_t* ap = xb + (size_t)(tok0 + 16 * w + l15) * 1024 + q * 8; const bf16_t* bp = wdt + l15 * 1024 + q * 8;
#pragma unroll 8
      for (int ks = 0; ks < 32; ++ks) { const bf16x8 a = *(const bf16x8*)(ap + ks * 32); const bf16x8 bb = *(const bf16x8*)(bp + ks * 32); acc = MFMA16(a, bb, acc); }
      const float bias = pk->ssd_dt_bias[l15];
#pragma unroll
      for (int r = 0; r < 4; ++r) { const int i = 16 * w + 4 * q + r; const float dt = softplusf(acc[r] + bias); dt_s[i * 16 + l15] = dt; dt_g[(size_t)(tok0 + i) * 16 + l15] = dt; } }
    __syncthreads();
    if (tid < 16) { const float ah = -__expf(pk->ssd_a_log[tid]); float run = 0.f;
        for (int i = 0; i < 128; ++i) { run += dt_s[i * 16 + tid] * ah; acum_s[i * 16 + tid] = run; acum_g[(size_t)(tok0 + i) * 16 + tid] = run; } }
    __syncthreads();
    if (tid < 8) cd_g[(b * 16 + c) * 16 + 8 * g + tid] = __expf(acum_s[127 * 16 + 8 * g + tid]);
    for (int idx = tid; idx < 1024; idx += 512) { const int j = idx >> 3, hl = idx & 7, h = 8 * g + hl; w_s[idx] = dt_s[j * 16 + h] * __expf(acum_s[127 * 16 + h] - acum_s[j * 16 + h]); }
    for (int idx = tid; idx < 4096; idx += 512) { const int which = idx >> 11, rem = idx & 2047, j = rem >> 4, cv = (rem & 15) * 8; const int ch = 1024 + which * 256 + g * 128 + cv;
        float o[8]; conv8_ssd_prompt(pk, proj, b * 2048, c * 128 + j, ch, o); const u32x4 pk = pack8(o);
        *(u32x4*)(xact + (size_t)(tok0 + j) * 1536 + ch) = pk;
        if (which == 0) { const bf16_t* e16 = (const bf16_t*)&pk;
#pragma unroll
            for (int e = 0; e < 8; ++e) BT[(cv + e) * 136 + j] = f2bf(o[e]); (void)e16; } }
    for (int hl = 0; hl < 8; ++hl) {
        __syncthreads();
        for (int idx = tid; idx < 1024; idx += 512) { const int j = idx >> 3, pv = (idx & 7) * 8; const int ch = g * 512 + hl * 64 + pv;
            float o[8]; conv8_ssd_prompt(pk, proj, b * 2048, c * 128 + j, ch, o);
            *(u32x4*)(xact + (size_t)(tok0 + j) * 1536 + ch) = pack8(o);
            const float wj = w_s[j * 8 + hl];
#pragma unroll
            for (int e = 0; e < 8; ++e) xsT[(pv + e) * 136 + j] = f2bf(o[e] * wj); }
        __syncthreads();
        const int pt = w & 3, nh = w >> 2;
        f32x4 acc[4];
#pragma unroll
        for (int nt = 0; nt < 4; ++nt) acc[nt] = (f32x4){0.f, 0.f, 0.f, 0.f};
#pragma unroll
        for (int ks = 0; ks < 4; ++ks) { const bf16x8 a = *(const bf16x8*)(xsT + (pt * 16 + l15) * 136 + ks * 32 + q * 8);
#pragma unroll
            for (int nt = 0; nt < 4; ++nt) { const bf16x8 bb = *(const bf16x8*)(BT + (nh * 64 + nt * 16 + l15) * 136 + ks * 32 + q * 8); acc[nt] = MFMA16(a, bb, acc[nt]); } }
        float* sp = st_g + (size_t)(((b * 16 + c) * 16 + 8 * g + hl)) * 8192;
#pragma unroll
        for (int nt = 0; nt < 4; ++nt)
#pragma unroll
            for (int r = 0; r < 4; ++r) sp[(pt * 16 + 4 * q + r) * 128 + nh * 64 + nt * 16 + l15] = acc[nt][r];
    }
    if (c == 15) {
        for (int idx = tid; idx < 3 * 768; idx += 512) { const int jj = idx / 768, cc = idx % 768; const int ch = cc < 512 ? g * 512 + cc : (cc < 640 ? 1024 + g * 128 + (cc - 512) : 1280 + g * 128 + (cc - 640));
            pk->out[O_SCP + (size_t)(b * 3 + jj) * 1536 + ch] = bf2f(proj[(size_t)(b * 2048 + 2045 + jj) * NPROJ + C_XBC + ch]); }
    }
}

DI void rgconv_item(KP pk_in, int b, int tile) {
    KP pk = pk_in; asm volatile("" : "+s"(pk));
    const int tid = otid();
    const bf16_t* proj = (const bf16_t*)(pk->ws + W_PROJ); bf16_t* mix = (bf16_t*)(pk->ws + W_MIX);
    const int ch = (tid & 127) * 8, t0 = tile * 128 + (tid >> 7) * 32;
    float wgt[4][8], bs[8];
    { const f32x4 b0 = *(const f32x4*)(pk->rg_conv_b + ch), b1 = *(const f32x4*)(pk->rg_conv_b + ch + 4);
      bs[0] = b0[0]; bs[1] = b0[1]; bs[2] = b0[2]; bs[3] = b0[3]; bs[4] = b1[0]; bs[5] = b1[1]; bs[6] = b1[2]; bs[7] = b1[3];
#pragma unroll
      for (int kk = 0; kk < 4; ++kk) { const f32x4 w0 = *(const f32x4*)(pk->rg_conv_w + kk * 1024 + ch), w1 = *(const f32x4*)(pk->rg_conv_w + kk * 1024 + ch + 4);
          wgt[kk][0] = w0[0]; wgt[kk][1] = w0[1]; wgt[kk][2] = w0[2]; wgt[kk][3] = w0[3]; wgt[kk][4] = w1[0]; wgt[kk][5] = w1[1]; wgt[kk][6] = w1[2]; wgt[kk][7] = w1[3]; } }
    const bf16_t* src = proj + (size_t)(b * 2048) * NPROJ + C_RGX + ch;
    u32x4 hist[3];
#pragma unroll
    for (int i = 0; i < 3; ++i) { const int tt = t0 - 3 + i; const u32x4 v = *(const u32x4*)(src + (size_t)(tt < 0 ? 0 : tt) * NPROJ); hist[i] = tt < 0 ? (u32x4){0u, 0u, 0u, 0u} : v; }
    for (int c8 = 0; c8 < 32; c8 += 8) { u32x4 nv[8];
#pragma unroll
        for (int i = 0; i < 8; ++i) nv[i] = *(const u32x4*)(src + (size_t)(t0 + c8 + i) * NPROJ);
#pragma unroll
        for (int i = 0; i < 8; ++i) { float x0[8], x1[8], x2[8], x3[8]; unpack8(hist[0], x0); unpack8(hist[1], x1); unpack8(hist[2], x2); unpack8(nv[i], x3); float acc[8];
#pragma unroll
            for (int e = 0; e < 8; ++e) acc[e] = bs[e] + x0[e] * wgt[0][e] + x1[e] * wgt[1][e] + x2[e] * wgt[2][e] + x3[e] * wgt[3][e];
            *(u32x4*)(mix + (size_t)(b * 2048 + t0 + c8 + i) * DMIX + 1024 + ch) = pack8(acc);
            hist[0] = hist[1]; hist[1] = hist[2]; hist[2] = nv[i]; } }
}

DI void statepass_item(KP pk_in, int sp) {
    KP pk = pk_in; asm volatile("" : "+s"(pk));
    const int b = sp >> 5, h = (sp >> 1) & 15, half = sp & 1; const int e0 = half * 4096 + otid() * 8;
    float* st_g = (float*)(pk->ws + W_ST); const float* cd_g = (const float*)(pk->ws + W_CD);
    f32x4 r0 = {0.f, 0.f, 0.f, 0.f}, r1 = {0.f, 0.f, 0.f, 0.f};
    for (int c0 = 0; c0 < 16; c0 += 8) { f32x4 v0[8], v1[8]; float cd[8];
#pragma unroll
        for (int i = 0; i < 8; ++i) { const float* ptr = st_g + (size_t)((b * 16 + c0 + i) * 16 + h) * 8192 + e0; v0[i] = *(const f32x4*)ptr; v1[i] = *(const f32x4*)(ptr + 4); cd[i] = cd_g[(b * 16 + c0 + i) * 16 + h]; }
#pragma unroll
        for (int i = 0; i < 8; ++i) { float* ptr = st_g + (size_t)((b * 16 + c0 + i) * 16 + h) * 8192 + e0; *(f32x4*)ptr = r0; *(f32x4*)(ptr + 4) = r1; r0 = r0 * cd[i] + v0[i]; r1 = r1 * cd[i] + v1[i]; } }
    float* o = pk->out + O_SHP + (size_t)(b * 16 + h) * 8192 + e0; *(f32x4*)o = r0; *(f32x4*)(o + 4) = r1;
}

DI void rg_item(KP pk_in, unsigned char* lds, const bool sample, int bidx, int k, int qd) {
    KP pk = pk_in; asm volatile("" : "+s"(pk));
    unsigned char* ws = pk->ws;
    const int tid = otid(), w = tid >> 6, lane = tid & 63, l15 = lane & 15, q = lane >> 4;
    bf16_t* uA = (bf16_t*)lds;
    float* sa = (float*)(lds + 34816); float* sb = sa + 4096;
    float* segA = sb + 4096; float* segB = segA + 512; float* hcar = segB + 512;
    const bf16_t* proj = (const bf16_t*)(ws + W_PROJ); bf16_t* mix = (bf16_t*)(ws + W_MIX);
    const bf16_t* wg = (const bf16_t*)(ws + W_WGT) + (size_t)((k * 4 + qd) * 64) * 128;
    bf16_t* wS = (bf16_t*)(lds + 73728);
    __syncthreads();
    for (int idx = tid; idx < 1024; idx += 512) { const int n = idx >> 4, c8 = (idx & 15) * 8; *(u32x4*)(wS + n * 136 + c8) = *(const u32x4*)(wg + n * 128 + c8); }
    float ba[2], bi[2], spl[2];
#pragma unroll
    for (int ntl = 0; ntl < 2; ++ntl) { const int ch = k * 128 + qd * 32 + ntl * 16 + l15; ba[ntl] = pk->b_rg_a[ch]; bi[ntl] = pk->b_rg_i[ch]; spl[ntl] = softplusf(-pk->rg_lambda[ch]); }
    __syncthreads();
    if (tid < 32) hcar[tid] = 0.f;
    const int ntiles = sample ? 1 : 16;
    const int crow = tid >> 2, cg0 = (tid & 3) * 32;
    const int cl_s = tid & 31, seg_s = tid >> 5;
    const bf16_t* ug = mix + 1024;
    u32x4 av[4]; bf16_t uv[8];
#define RG_LOADP(TILE) do { const size_t r0 = (size_t)(bidx * 2048 + (TILE) * 128 + 16 * w); \
        _Pragma("unroll") for (int ks = 0; ks < 4; ++ks) av[ks] = *(const u32x4*)(ug + (r0 + l15) * DMIX + k * 128 + ks * 32 + q * 8); \
        _Pragma("unroll") for (int ntl = 0; ntl < 2; ++ntl) _Pragma("unroll") for (int r = 0; r < 4; ++r) uv[ntl * 4 + r] = ug[(r0 + 4 * q + r) * DMIX + k * 128 + qd * 32 + ntl * 16 + l15]; } while (0)
    if (!sample) RG_LOADP(0);
    bf16x8 afr[4]; float uvf[8];
    for (int tile = 0; tile < ntiles; ++tile) {
        __syncthreads();
        float gts[8];
        if (!sample) {
#pragma unroll
          for (int ks = 0; ks < 4; ++ks) afr[ks] = as_frag(av[ks]);
#pragma unroll
          for (int e = 0; e < 8; ++e) uvf[e] = bf2f(uv[e]);
          if (tile + 1 < 16) RG_LOADP(tile + 1);
#pragma unroll
          for (int j = 0; j < 8; ++j) gts[j] = bf2f(proj[(size_t)(bidx * 2048 + tile * 128 + seg_s * 8 + j) * NPROJ + C_RGG + k * 128 + qd * 32 + cl_s]);
        } else { const int row = crow;
#pragma unroll
          for (int v = 0; v < 4; ++v) { const int c8 = cg0 + v * 8, ch = k * 128 + c8;
              const f32x4 b0 = *(const f32x4*)(pk->rg_conv_b + ch), b1 = *(const f32x4*)(pk->rg_conv_b + ch + 4);
              float acc[8] = {b0[0], b0[1], b0[2], b0[3], b1[0], b1[1], b1[2], b1[3]};
#pragma unroll
              for (int kk = 0; kk < 4; ++kk) { float x[8];
                  { const int sbi = bidx * 32 + (row >> 2), ui = (row & 3) + kk;
                      if (ui < 3) { const float* s = pk->state_rg_conv + (size_t)(sbi * 3 + ui) * 1024 + ch; const f32x4 s0 = *(const f32x4*)s, s1 = *(const f32x4*)(s + 4);
                          x[0] = s0[0]; x[1] = s0[1]; x[2] = s0[2]; x[3] = s0[3]; x[4] = s1[0]; x[5] = s1[1]; x[6] = s1[2]; x[7] = s1[3]; }
                      else { const u32x4 vv = *(const u32x4*)(proj + (size_t)(NTOKP + sbi * 4 + ui - 3) * NPROJ + C_RGX + ch); unpack8(vv, x); } }
                  { const f32x4 w0 = *(const f32x4*)(pk->rg_conv_w + kk * 1024 + ch), w1 = *(const f32x4*)(pk->rg_conv_w + kk * 1024 + ch + 4);
                      acc[0] += x[0] * w0[0]; acc[1] += x[1] * w0[1]; acc[2] += x[2] * w0[2]; acc[3] += x[3] * w0[3];
                      acc[4] += x[4] * w1[0]; acc[5] += x[5] * w1[1]; acc[6] += x[6] * w1[2]; acc[7] += x[7] * w1[3]; } }
              *(u32x4*)(uA + row * 136 + c8) = pack8(acc); }
#pragma unroll
          for (int j = 0; j < 8; ++j) gts[j] = bf2f(proj[(size_t)(NTOKP + bidx * 128 + seg_s * 8 + j) * NPROJ + C_RGG + k * 128 + qd * 32 + cl_s]);
        }
        __syncthreads();
        { f32x4 acc[4];
#pragma unroll
          for (int nt = 0; nt < 4; ++nt) acc[nt] = (f32x4){0.f, 0.f, 0.f, 0.f};
#pragma unroll
          for (int ks = 0; ks < 4; ++ks) { const bf16x8 a = sample ? *(const bf16x8*)(uA + (16 * w + l15) * 136 + ks * 32 + q * 8) : afr[ks];
#pragma unroll
              for (int nt = 0; nt < 4; ++nt) { const bf16x8 bb = *(const bf16x8*)(wS + (nt * 16 + l15) * 136 + ks * 32 + q * 8); acc[nt] = MFMA16(a, bb, acc[nt]); } }
#pragma unroll
          for (int ntl = 0; ntl < 2; ++ntl)
#pragma unroll
              for (int r = 0; r < 4; ++r) { const int row = 16 * w + 4 * q + r, cl = ntl * 16 + l15;
                  const float rr = sigmf(acc[ntl][r] + ba[ntl]), ii = sigmf(acc[2 + ntl][r] + bi[ntl]);
                  const float la = -8.f * rr * spl[ntl]; float a = __expf(la); const float uval = sample ? bf2f(uA[row * 136 + qd * 32 + cl]) : uvf[ntl * 4 + r];
                  float bt = __builtin_amdgcn_sqrtf(fmaxf(1.f - a * a, 0.f)) * ii * uval;
                  const bool first = sample ? ((row & 3) == 0) : (tile == 0 && row == 0);
                  if (first) { const float h0 = sample ? pk->state_rg_h[(size_t)(bidx * 32 + (row >> 2)) * 1024 + k * 128 + qd * 32 + cl] : 0.f; bt += a * h0; a = 0.f; }
                  sa[row * 32 + cl] = a; sb[row * 32 + cl] = bt; } }
        __syncthreads();
        const int cl = tid & 31, seg = tid >> 5;
        { float A = 1.f, B = 0.f;
#pragma unroll
          for (int j = 0; j < 8; ++j) { const int row = seg * 8 + j; const float a = sa[row * 32 + cl], bb = sb[row * 32 + cl]; B = a * B + bb; A = a * A; }
          segA[seg * 32 + cl] = A; segB[seg * 32 + cl] = B; }
        __syncthreads();
        float h = hcar[cl];
        for (int s = 0; s < seg; ++s) h = segA[s * 32 + cl] * h + segB[s * 32 + cl];
        const int chg = k * 128 + qd * 32 + cl;
#pragma unroll
        for (int j = 0; j < 8; ++j) { const int row = seg * 8 + j; h = sa[row * 32 + cl] * h + sb[row * 32 + cl];
            const size_t grow = sample ? (size_t)(NTOKP + bidx * 128 + row) : (size_t)(bidx * 2048 + tile * 128 + row);
            mix[grow * DMIX + chg] = f2bf(h * siluf(gts[j]));
            if (sample) { if ((row & 3) == 3) pk->out[O_RGHS + (size_t)(bidx * 32 + (row >> 2)) * 1024 + chg] = h; }
            else if (tile == 15 && row == 127) pk->out[O_RGHP + (size_t)bidx * 1024 + chg] = h; }
        __syncthreads();
        if (seg == 15) hcar[cl] = h;
    }
    if (!sample) { if (tid < 96) { const int jj = tid >> 5, cl = tid & 31, chg = k * 128 + qd * 32 + cl;
            pk->out[O_RGCP + (size_t)(bidx * 3 + jj) * 1024 + chg] = bf2f(proj[(size_t)(bidx * 2048 + 2045 + jj) * NPROJ + C_RGX + chg]); } }
    else { for (int idx = tid; idx < 32 * 3 * 32; idx += 512) { const int cl = idx & 31, jj = (idx >> 5) % 3, sl = idx / 96; const int sbi = bidx * 32 + sl, chg = k * 128 + qd * 32 + cl;
            pk->out[O_RGCS + (size_t)(sbi * 3 + jj) * 1024 + chg] = bf2f(proj[(size_t)(NTOKP + sbi * 4 + 1 + jj) * NPROJ + C_RGX + chg]); } }
}

DI void attnp_item(KP pk_in, unsigned char* lds, int b, int head, int qt) {
    KP pk = pk_in; asm volatile("" : "+s"(pk));
    unsigned char* ws = pk->ws;
    const int tid = otid(), w = tid >> 6, lane = tid & 63, l15 = lane & 15, q = lane >> 4;
    const bf16_t* proj = (const bf16_t*)(ws + W_PROJ); const bf16_t* kb = (const bf16_t*)(ws + W_KB); const bf16_t* vt = (const bf16_t*)(ws + W_VT); bf16_t* mix = (bf16_t*)(ws + W_MIX);
    const int tokb = b * 2048 + qt * 128 + 16 * w;
    constexpr int RS = 264;
    bf16_t* sm = (bf16_t*)lds;
    const int lr = tid >> 5, lc = (tid & 31) * 8;
    const bf16_t* kbase = kb + (size_t)(b * 256) * 1024 + head * 256; const bf16_t* vbase = vt + (size_t)((b * 4 + head) * 256) * 256;
    u32x4 pre[8];
#define AT_LOAD(S) do { _Pragma("unroll") for (int i = 0; i < 8; ++i) { const int r = lr + 16 * i; \
        pre[i] = (S) < 2 ? *(const u32x4*)(kbase + (size_t)(128 * (S) + r) * 1024 + lc) : *(const u32x4*)(vbase + (size_t)(128 * ((S) - 2) + r) * 256 + lc); } } while (0)
#define AT_STORE() do { _Pragma("unroll") for (int i = 0; i < 8; ++i) *(u32x4*)(sm + (lr + 16 * i) * RS + lc) = pre[i]; } while (0)
    AT_LOAD(0);
    bf16x8 qf[8];
#pragma unroll
    for (int ks = 0; ks < 8; ++ks) qf[ks] = *(const bf16x8*)(proj + (size_t)(tokb + l15) * NPROJ + C_Q + head * 256 + ks * 32 + q * 8);
    f32x4 st[16];
#pragma unroll
    for (int s = 0; s < 2; ++s) {
        __syncthreads(); AT_STORE(); __syncthreads(); AT_LOAD(s + 1);
#pragma unroll
        for (int mtl = 0; mtl < 8; ++mtl) { const int mt = 8 * s + mtl; st[mt] = (f32x4){0.f, 0.f, 0.f, 0.f}; const bf16_t* kp = sm + (16 * mtl + l15) * RS + q * 8;
#pragma unroll
            for (int ks = 0; ks < 8; ++ks) { const bf16x8 kf = *(const bf16x8*)(kp + ks * 32); st[mt] = MFMA16(kf, qf[ks], st[mt]); } }
    }
    float mx = -3.0e38f;
#pragma unroll
    for (int mt = 0; mt < 16; ++mt)
#pragma unroll
        for (int r = 0; r < 4; ++r) { st[mt][r] *= 0.0625f; mx = fmaxf(mx, st[mt][r]); }
    mx = fmaxf(mx, shx(mx, 16, lane)); mx = fmaxf(mx, shx(mx, 32, lane));
    float l = 0.f;
#pragma unroll
    for (int mt = 0; mt < 16; ++mt)
#pragma unroll
        for (int r = 0; r < 4; ++r) { const float e = __expf(st[mt][r] - mx); st[mt][r] = e; l += e; }
    l += shx(l, 16, lane); l += shx(l, 32, lane);
    bf16x8 pf[8];
#pragma unroll
    for (int s = 0; s < 8; ++s) { float m8[8] = {st[2 * s][0], st[2 * s][1], st[2 * s][2], st[2 * s][3], st[2 * s + 1][0], st[2 * s + 1][1], st[2 * s + 1][2], st[2 * s + 1][3]}; pf[s] = as_frag(pack8(m8)); }
    float linv[4];
#pragma unroll
    for (int r = 0; r < 4; ++r) linv[r] = 1.f / shl(l, 4 * q + r);
#pragma unroll
    for (int s2 = 0; s2 < 2; ++s2) {
        __syncthreads(); AT_STORE(); __syncthreads(); if (s2 == 0) AT_LOAD(3);
#pragma unroll
        for (int dtl = 0; dtl < 8; ++dtl) { const int dt = 8 * s2 + dtl; f32x4 o = {0.f, 0.f, 0.f, 0.f}; const bf16_t* vp = sm + (16 * dtl + l15) * RS + 4 * q;
            float gt[4];
#pragma unroll
            for (int r = 0; r < 4; ++r) gt[r] = bf2f(proj[(size_t)(tokb + 4 * q + r) * NPROJ + C_XG + head * 256 + 16 * dt + l15]);
#pragma unroll
            for (int s = 0; s < 8; ++s) { const u32x2 lo = *(const u32x2*)(vp + 32 * s), hi = *(const u32x2*)(vp + 32 * s + 16); o = MFMA16(pf[s], frag2(lo, hi), o); }
#pragma unroll
            for (int r = 0; r < 4; ++r) { const size_t tok = (size_t)(tokb + 4 * q + r); const int d = 16 * dt + l15;
                mix[tok * DMIX + 2048 + head * 256 + d] = f2bf(o[r] * linv[r] * siluf(gt[r])); } }
    }
#undef AT_LOAD
#undef AT_STORE
}

DI float wave_sum(float v, int lane) { v += shx(v, 32, lane); v += shx(v, 16, lane); v += shx(v, 8, lane); v += shx(v, 4, lane); v += shx(v, 2, lane); v += shx(v, 1, lane); return v; }
DI float wave_max(float v, int lane) { v = fmaxf(v, shx(v, 32, lane)); v = fmaxf(v, shx(v, 16, lane)); v = fmaxf(v, shx(v, 8, lane)); v = fmaxf(v, shx(v, 4, lane)); v = fmaxf(v, shx(v, 2, lane)); v = fmaxf(v, shx(v, 1, lane)); return v; }

DI void attns_item(KP pk_in, unsigned char* lds, int sbi, int head) {
    KP pk = pk_in; asm volatile("" : "+s"(pk));
    unsigned char* ws = pk->ws;
    const int tid = otid(), w = tid >> 6, lane = tid & 63;
    const bf16_t* proj = (const bf16_t*)(ws + W_PROJ); bf16_t* mix = (bf16_t*)(ws + W_MIX);
    float* qs = (float*)lds; float* sc = qs + 1024; float* ored = sc + 1024;
    __syncthreads();
    for (int idx = tid; idx < 1024; idx += 512) { const int t = idx >> 8, d = idx & 255; qs[idx] = bf2f(proj[(size_t)(NTOKP + sbi * 4 + t) * NPROJ + C_Q + head * 256 + d]); }
    __syncthreads();
    f32x4 qv[4];
#pragma unroll
    for (int t = 0; t < 4; ++t) qv[t] = *(const f32x4*)(qs + t * 256 + lane * 4);
    for (int m0 = w; m0 < 256; m0 += 64) { f32x4 kv[8];
#pragma unroll
        for (int i = 0; i < 8; ++i) kv[i] = *(const f32x4*)(pk->cache_k + ((size_t)(sbi * 256 + m0 + 8 * i) * 4 + head) * 256 + lane * 4);
        float v32[32];
#pragma unroll
        for (int i = 0; i < 8; ++i)
#pragma unroll
            for (int t = 0; t < 4; ++t) v32[i * 4 + t] = kv[i][0] * qv[t][0] + kv[i][1] * qv[t][1] + kv[i][2] * qv[t][2] + kv[i][3] * qv[t][3];
        float v16[16], v8[8], v4[4], v2[2];
        { const bool up = (lane & 32) != 0;
#pragma unroll
          for (int i = 0; i < 16; ++i) { const float keep = up ? v32[i + 16] : v32[i], send = up ? v32[i] : v32[i + 16]; v16[i] = keep + shx(send, 32, lane); } }
        { const bool up = (lane & 16) != 0;
#pragma unroll
          for (int i = 0; i < 8; ++i) { const float keep = up ? v16[i + 8] : v16[i], send = up ? v16[i] : v16[i + 8]; v8[i] = keep + shx(send, 16, lane); } }
        { const bool up = (lane & 8) != 0;
#pragma unroll
          for (int i = 0; i < 4; ++i) { const float keep = up ? v8[i + 4] : v8[i], send = up ? v8[i] : v8[i + 4]; v4[i] = keep + shx(send, 8, lane); } }
        { const bool up = (lane & 4) != 0;
#pragma unroll
          for (int i = 0; i < 2; ++i) { const float keep = up ? v4[i + 2] : v4[i], send = up ? v4[i] : v4[i + 2]; v2[i] = keep + shx(send, 4, lane); } }
        float v1; { const bool up = (lane & 2) != 0; const float keep = up ? v2[1] : v2[0], send = up ? v2[0] : v2[1]; v1 = keep + shx(send, 2, lane); }
        v1 += shx(v1, 1, lane);
        if ((lane & 1) == 0) { const int ii = lane >> 1; sc[(ii & 3) * 256 + m0 + 8 * (ii >> 2)] = v1 * 0.0625f; } }
    __syncthreads();
    if (w < 4) { const f32x4 v = *(const f32x4*)(sc + w * 256 + lane * 4); float mx = fmaxf(fmaxf(v[0], v[1]), fmaxf(v[2], v[3])); mx = wave_max(mx, lane);
        f32x4 e; e[0] = __expf(v[0] - mx); e[1] = __expf(v[1] - mx); e[2] = __expf(v[2] - mx); e[3] = __expf(v[3] - mx); float s = wave_sum(e[0] + e[1] + e[2] + e[3], lane); const float inv = 1.f / s;
        *(f32x4*)(sc + w * 256 + lane * 4) = e * inv; }
    __syncthreads();
    f32x4 acc[4];
#pragma unroll
    for (int t = 0; t < 4; ++t) acc[t] = (f32x4){0.f, 0.f, 0.f, 0.f};
    for (int m0 = w; m0 < 256; m0 += 64) { f32x4 vv[8];
#pragma unroll
        for (int i = 0; i < 8; ++i) vv[i] = *(const f32x4*)(pk->cache_v + ((size_t)(sbi * 256 + m0 + 8 * i) * 4 + head) * 256 + lane * 4);
#pragma unroll
        for (int i = 0; i < 8; ++i)
#pragma unroll
            for (int t = 0; t < 4; ++t) acc[t] += vv[i] * sc[t * 256 + m0 + 8 * i]; }
#pragma unroll
    for (int t = 0; t < 4; ++t) *(f32x4*)(ored + (w * 4 + t) * 256 + lane * 4) = acc[t];
    __syncthreads();
    for (int idx = tid; idx < 1024; idx += 512) { const int t = idx >> 8, d = idx & 255; float s = 0.f;
#pragma unroll
        for (int ww = 0; ww < 8; ++ww) s += ored[(ww * 4 + t) * 256 + d];
        const size_t tok = (size_t)(NTOKP + sbi * 4 + t); const float gate = bf2f(proj[tok * NPROJ + C_XG + head * 256 + d]); mix[tok * DMIX + 2048 + head * 256 + d] = f2bf(s * siluf(gate)); }
}

DI void ssds_item(KP pk_in, unsigned char* lds, int sbi, int g) {
    KP pk = pk_in; asm volatile("" : "+s"(pk));
    unsigned char* ws = pk->ws;
    const int tid = otid(), w = tid >> 6, lane = tid & 63;
    const bf16_t* proj = (const bf16_t*)(ws + W_PROJ); bf16_t* mix = (bf16_t*)(ws + W_MIX); const float* wdf = (const float*)(ws + W_WDTF);
    float* xs = (float*)lds; float* Bs = xs + 2048; float* Cs = Bs + 512; float* yg = Cs + 512; float* dts = yg + 2048; float* decs = dts + 32;
    __syncthreads();
#pragma unroll
    for (int d = 0; d < 4; ++d) { const int pi = w * 4 + d, t = pi & 3, hl = pi >> 2, h = 8 * g + hl; float s = 0.f;
#pragma unroll
        for (int i = 0; i < 4; ++i) { const f32x4 xv = *(const f32x4*)(pk->x_sample + (size_t)(sbi * 4 + t) * 1024 + i * 256 + lane * 4), wv = *(const f32x4*)(wdf + h * 1024 + i * 256 + lane * 4);
            s += xv[0] * wv[0] + xv[1] * wv[1] + xv[2] * wv[2] + xv[3] * wv[3]; }
        s = wave_sum(s, lane);
        if (lane == 0) { const float dt = softplusf(s + pk->ssd_dt_bias[h]); dts[t * 8 + hl] = dt; decs[t * 8 + hl] = __expf(-dt * __expf(pk->ssd_a_log[h])); } }
    for (int idx = tid; idx < 4 * 768; idx += 512) { const int t = idx / 768, cc = idx % 768; const int ch = cc < 512 ? g * 512 + cc : (cc < 640 ? 1024 + g * 128 + (cc - 512) : 1280 + g * 128 + (cc - 640));
        float acc = pk->ssd_conv_b[ch];
#pragma unroll
        for (int kk = 0; kk < 4; ++kk) { const int ui = t + kk; const float x = ui < 3 ? pk->state_ssd_conv[(size_t)(sbi * 3 + ui) * 1536 + ch] : bf2f(proj[(size_t)(NTOKP + sbi * 4 + ui - 3) * NPROJ + C_XBC + ch]);
            acc += x * pk->ssd_conv_w[kk * 1536 + ch]; }
        const float a = siluf(acc);
        if (cc < 512) xs[t * 512 + cc] = a; else if (cc < 640) Bs[t * 128 + cc - 512] = a; else Cs[t * 128 + cc - 640] = a; }
    for (int idx = tid; idx < 3 * 768; idx += 512) { const int jj = idx / 768, cc = idx % 768; const int ch = cc < 512 ? g * 512 + cc : (cc < 640 ? 1024 + g * 128 + (cc - 512) : 1280 + g * 128 + (cc - 640));
        pk->out[O_SCS + (size_t)(sbi * 3 + jj) * 1536 + ch] = bf2f(proj[(size_t)(NTOKP + sbi * 4 + 1 + jj) * NPROJ + C_XBC + ch]); }
    __syncthreads();
    const int pp = tid >> 3, n0 = (tid & 7) * 16;
    f32x4 hs[4], hn[4];
#pragma unroll
    for (int v = 0; v < 4; ++v) hn[v] = *(const f32x4*)(pk->state_ssd_h + ((size_t)(sbi * 16 + 8 * g) * 64 + pp) * 128 + n0 + v * 4);
    for (int hl = 0; hl < 8; ++hl) { const int h = 8 * g + hl; const size_t so = ((size_t)(sbi * 16 + h) * 64 + pp) * 128 + n0;
#pragma unroll
        for (int v = 0; v < 4; ++v) hs[v] = hn[v];
        if (hl < 7) {
#pragma unroll
            for (int v = 0; v < 4; ++v) hn[v] = *(const f32x4*)(pk->state_ssd_h + so + 8192 + v * 4); }
        const float dsk = pk->ssd_d[h];
#pragma unroll
        for (int t = 0; t < 4; ++t) { const float dec = decs[t * 8 + hl], xv = xs[t * 512 + hl * 64 + pp], dtx = dts[t * 8 + hl] * xv; float part = 0.f;
#pragma unroll
            for (int v = 0; v < 4; ++v) { const f32x4 bv = *(const f32x4*)(Bs + t * 128 + n0 + v * 4), cv = *(const f32x4*)(Cs + t * 128 + n0 + v * 4);
                hs[v] = hs[v] * dec + bv * dtx; part += cv[0] * hs[v][0] + cv[1] * hs[v][1] + cv[2] * hs[v][2] + cv[3] * hs[v][3]; }
            part += shx(part, 1, lane); part += shx(part, 2, lane); part += shx(part, 4, lane);
            if ((tid & 7) == 0) { const float y = part + dsk * xv; const float z = bf2f(proj[(size_t)(NTOKP + sbi * 4 + t) * NPROJ + C_Z + h * 64 + pp]); yg[t * 512 + hl * 64 + pp] = y * siluf(z); } }
#pragma unroll
        for (int v = 0; v < 4; ++v) *(f32x4*)(pk->out + O_SHS + so + v * 4) = hs[v];
    }
    __syncthreads();
    if (w < 4) { const int t = w; float ss = 0.f; float v[8];
#pragma unroll
        for (int e = 0; e < 8; ++e) { v[e] = yg[t * 512 + e * 64 + lane]; ss += v[e] * v[e]; }
        ss = wave_sum(ss, lane); const float rstd = rsqrtf(ss * (1.f / 512.f) + 1e-5f);
#pragma unroll
        for (int e = 0; e < 8; ++e) { const int cc = e * 64 + lane; mix[(size_t)(NTOKP + sbi * 4 + t) * DMIX + 1024 + g * 512 + cc] = f2bf(v[e] * rstd * pk->ssd_norm_g[g * 512 + cc]); } }
}

DI void ssd3_item(KP pk_in, unsigned char* lds, int b, int c, int g) {
    KP pk = pk_in; asm volatile("" : "+s"(pk));
    unsigned char* ws = pk->ws;
    const int tid = otid(), w = tid >> 6, lane = tid & 63, l15 = lane & 15, q = lane >> 4;
    float* acum_s = (float*)lds; float* dt_s = acum_s + 1024;
    bf16_t* xT = (bf16_t*)(lds + 8192);
    const bf16_t* proj = (const bf16_t*)(ws + W_PROJ); const bf16_t* xact = (const bf16_t*)(ws + W_XACT); bf16_t* mix = (bf16_t*)(ws + W_MIX);
    const float* dt_g = (const float*)(ws + W_DT); const float* acum_g = (const float*)(ws + W_ACUM); const float* st_g = (const float*)(ws + W_ST);
    const int tok0 = b * 2048 + c * 128;
    __syncthreads();
    for (int idx = tid; idx < 1024; idx += 512) { const int j = idx >> 3, hl = idx & 7; acum_s[idx] = acum_g[(size_t)(tok0 + j) * 16 + 8 * g + hl]; dt_s[idx] = dt_g[(size_t)(tok0 + j) * 16 + 8 * g + hl]; }
    bf16x8 cf[4];
#pragma unroll
    for (int ks = 0; ks < 4; ++ks) cf[ks] = *(const bf16x8*)(xact + (size_t)(tok0 + 16 * w + l15) * 1536 + 1280 + g * 128 + ks * 32 + q * 8);
    f32x4 cbt[8];
#pragma unroll
    for (int jt = 0; jt < 8; ++jt) { cbt[jt] = (f32x4){0.f, 0.f, 0.f, 0.f};
        if (jt <= w) {
#pragma unroll
            for (int ks = 0; ks < 4; ++ks) { const bf16x8 bfr = *(const bf16x8*)(xact + (size_t)(tok0 + 16 * jt + l15) * 1536 + 1024 + g * 128 + ks * 32 + q * 8); cbt[jt] = MFMA16(bfr, cf[ks], cbt[jt]); } } }
    float ssq[4] = {0.f, 0.f, 0.f, 0.f};
    const int irow = 16 * w + l15;
    for (int hl = 0; hl < 8; ++hl) { const int h = 8 * g + hl;
        __syncthreads();
        for (int idx = tid; idx < 1024; idx += 512) { const int j = idx >> 3, pv = (idx & 7) * 8; const u32x4 v = *(const u32x4*)(xact + (size_t)(tok0 + j) * 1536 + g * 512 + hl * 64 + pv);
            const bf16_t* e16 = (const bf16_t*)&v; (void)e16;
            xT[(pv + 0) * 136 + j] = (bf16_t)(v.x & 0xFFFF); xT[(pv + 1) * 136 + j] = (bf16_t)(v.x >> 16); xT[(pv + 2) * 136 + j] = (bf16_t)(v.y & 0xFFFF); xT[(pv + 3) * 136 + j] = (bf16_t)(v.y >> 16);
            xT[(pv + 4) * 136 + j] = (bf16_t)(v.z & 0xFFFF); xT[(pv + 5) * 136 + j] = (bf16_t)(v.z >> 16); xT[(pv + 6) * 136 + j] = (bf16_t)(v.w & 0xFFFF); xT[(pv + 7) * 136 + j] = (bf16_t)(v.w >> 16); }
        __syncthreads();
        const float ai = acum_s[irow * 8 + hl];
        bf16x8 af[4];
#pragma unroll
        for (int s = 0; s < 4; ++s) { float m8[8];
#pragma unroll
            for (int hf = 0; hf < 2; ++hf) { const int jt = 2 * s + hf;
#pragma unroll
                for (int r = 0; r < 4; ++r) { const int j = 16 * jt + 4 * q + r; float val = 0.f;
                    if (jt <= w && j <= irow) val = cbt[jt][r] * __expf(ai - acum_s[j * 8 + hl]) * dt_s[j * 8 + hl];
                    m8[hf * 4 + r] = val; } }
            af[s] = as_frag(pack8(m8)); }
        const float dsk = pk->ssd_d[h];
        float ea[4];
#pragma unroll
        for (int r = 0; r < 4; ++r) ea[r] = __expf(acum_s[(16 * w + 4 * q + r) * 8 + hl]);
        float zz[4][4];
#pragma unroll
        for (int pt = 0; pt < 4; ++pt)
#pragma unroll
            for (int r = 0; r < 4; ++r) zz[pt][r] = bf2f(proj[(size_t)(tok0 + 16 * w + 4 * q + r) * NPROJ + C_Z + h * 64 + 16 * pt + l15]);
#pragma unroll
        for (int pt = 0; pt < 4; ++pt) { f32x4 yd = {0.f, 0.f, 0.f, 0.f}, yo = {0.f, 0.f, 0.f, 0.f};
            const bf16_t* xr = xT + (16 * pt + l15) * 136;
#pragma unroll
            for (int s = 0; s < 4; ++s) if (2 * s <= w) { const u32x2 lo = *(const u32x2*)(xr + 32 * s + 4 * q), hi = *(const u32x2*)(xr + 32 * s + 16 + 4 * q); yd = MFMA16(af[s], frag2(lo, hi), yd); }
            const float* hp = st_g + ((size_t)((b * 16 + c) * 16 + h) * 64 + 16 * pt + l15) * 128 + q * 8;
#pragma unroll
            for (int ks = 0; ks < 4; ++ks) { const f32x4 f0 = *(const f32x4*)(hp + ks * 32), f1 = *(const f32x4*)(hp + ks * 32 + 4); float m8[8] = {f0[0], f0[1], f0[2], f0[3], f1[0], f1[1], f1[2], f1[3]};
                yo = MFMA16(cf[ks], as_frag(pack8(m8)), yo); }
            const u32x2 xv2 = *(const u32x2*)(xr + 16 * w + 4 * q); const float xv[4] = {bflo(xv2.x), bfhi(xv2.x), bflo(xv2.y), bfhi(xv2.y)};
#pragma unroll
            for (int r = 0; r < 4; ++r) { const size_t tok = (size_t)(tok0 + 16 * w + 4 * q + r); const int pp = 16 * pt + l15;
                const float y = yd[r] + ea[r] * yo[r] + dsk * xv[r]; const float val = y * siluf(zz[pt][r]);
                ssq[r] += val * val; mix[tok * DMIX + 1024 + g * 512 + hl * 64 + pp] = f2bf(val); } }
    }
    float rstd[4];
#pragma unroll
    for (int r = 0; r < 4; ++r) { float s = ssq[r]; s += shx(s, 1, lane); s += shx(s, 2, lane); s += shx(s, 4, lane); s += shx(s, 8, lane); rstd[r] = rsqrtf(s * (1.f / 512.f) + 1e-5f); }
    for (int hl = 0; hl < 8; ++hl)
#pragma unroll
        for (int pt = 0; pt < 4; ++pt) { const int cc = hl * 64 + 16 * pt + l15; const float gn = pk->ssd_norm_g[g * 512 + cc];
#pragma unroll
            for (int r = 0; r < 4; ++r) { bf16_t* mp = mix + (size_t)(tok0 + 16 * w + 4 * q + r) * DMIX + 1024 + g * 512 + cc; *mp = f2bf(bf2f(*mp) * rstd[r] * gn); } }
}

DI void outs_item(KP pk_in, unsigned char* lds, int piece) {
    KP pk = pk_in; asm volatile("" : "+s"(pk));
    const int tid = otid(), w = tid >> 6, lane = tid & 63, l15 = lane & 15, q = lane >> 4;
    const int rg = piece >> 4, cgp = piece & 15;
    const bf16_t* mix = (const bf16_t*)(pk->ws + W_MIX); const bf16_t* wo = (const bf16_t*)(pk->ws + W_WOUTT); float* res = (float*)(pk->ws + W_RES);
    float* part = (float*)lds;
    f32x4 acc[2][4];
#pragma unroll
    for (int mt = 0; mt < 2; ++mt)
#pragma unroll
        for (int nt = 0; nt < 4; ++nt) acc[mt][nt] = (f32x4){0.f, 0.f, 0.f, 0.f};
    const bf16_t* ap = mix + (size_t)(NTOKP + rg * 32 + l15) * DMIX + w * 384 + q * 8;
    const bf16_t* bp = wo + (size_t)(cgp * 64 + l15) * 3072 + w * 384 + q * 8;
#pragma unroll 4
    for (int ks = 0; ks < 12; ++ks) { bf16x8 a[2], bb[4];
#pragma unroll
        for (int mt = 0; mt < 2; ++mt) a[mt] = *(const bf16x8*)(ap + (size_t)mt * 16 * DMIX + ks * 32);
#pragma unroll
        for (int nt = 0; nt < 4; ++nt) bb[nt] = *(const bf16x8*)(bp + (size_t)nt * 16 * 3072 + ks * 32);
#pragma unroll
        for (int mt = 0; mt < 2; ++mt)
#pragma unroll
            for (int nt = 0; nt < 4; ++nt) acc[mt][nt] = MFMA16(a[mt], bb[nt], acc[mt][nt]); }
    __syncthreads();
#pragma unroll
    for (int mt = 0; mt < 2; ++mt)
#pragma unroll
        for (int nt = 0; nt < 4; ++nt)
#pragma unroll
            for (int r = 0; r < 4; ++r) part[(w * 32 + mt * 16 + 4 * q + r) * 64 + nt * 16 + l15] = acc[mt][nt][r];
    __syncthreads();
    { const int row = tid >> 4, c4 = (tid & 15) * 4; f32x4 sum = {0.f, 0.f, 0.f, 0.f};
#pragma unroll
      for (int ww = 0; ww < 8; ++ww) sum += *(const f32x4*)(part + (ww * 32 + row) * 64 + c4);
      const int srow = rg * 32 + row, col = cgp * 64 + c4; const f32x4 xv = *(const f32x4*)(pk->x_sample + (size_t)srow * 1024 + col);
      *(f32x4*)(res + (size_t)(NTOKP + srow) * 1024 + col) = sum + xv * 1.189207115002721f; }
    __syncthreads();
}

DI void ln_rows(KP pk_in) {
    KP pk = pk_in; asm volatile("" : "+s"(pk));
    const float* res = (const float*)(pk->ws + W_RES);
    const int tid = otid(); const int lane = tid & 63; const int gw = obid() * 8 + (tid >> 6), nw = gridDim.x * 8;
    f32x4 gg[4], bb[4];
#pragma unroll
    for (int i = 0; i < 4; ++i) { gg[i] = *(const f32x4*)(pk->ln_g + i * 256 + lane * 4); bb[i] = *(const f32x4*)(pk->ln_b + i * 256 + lane * 4); }
    for (int row = gw; row < NTOK; row += nw) { f32x4 v[4]; float s = 0.f;
#pragma unroll
        for (int i = 0; i < 4; ++i) { v[i] = *(const f32x4*)(res + (size_t)row * 1024 + i * 256 + lane * 4); s += v[i][0] + v[i][1] + v[i][2] + v[i][3]; }
        const float mu = wave_sum(s, lane) * (1.f / 1024.f); float s2 = 0.f;
#pragma unroll
        for (int i = 0; i < 4; ++i) { v[i] = v[i] - mu; s2 += v[i][0] * v[i][0] + v[i][1] * v[i][1] + v[i][2] * v[i][2] + v[i][3] * v[i][3]; }
        const float rstd = rsqrtf(wave_sum(s2, lane) * (1.f / 1024.f) + 1e-5f);
#pragma unroll
        for (int i = 0; i < 4; ++i) *(f32x4*)(pk->out + (size_t)row * 1024 + i * 256 + lane * 4) = v[i] * rstd * gg[i] + bb[i]; }
}

__global__ void __launch_bounds__(512, 2) hymba_fwd(Params p_unused) {
    KP pk = kparams();
    extern __shared__ __attribute__((aligned(16))) unsigned char shm[];
    cg::grid_group grid = cg::this_grid();
    const int G = gridDim.x;
    if (threadIdx.x < 4) ((volatile LAS unsigned*)(LAS unsigned char*)shm)[32768 + threadIdx.x] = 0u;
    __syncthreads();
    const int ph_lo_chk = pk->ph_lo;
    XcdBarrier xb = xcd_barrier_post((unsigned*)(pk->ws + W_BAR), (volatile LAS unsigned*)(LAS unsigned char*)shm + 32768);
    if (ph_lo_chk < 0) grid.sync();
    { KP pk = kparams(); for (int rep = 0; rep < REP0; ++rep) phase_prep(pk, shm); }
    xcd_barrier(xb);
    { KP pk = kparams(); const int bid = obid();
      for (int rep = 0; rep < REP1; ++rep) {
        { pg8::Gemm g; g.A = (const bf16_t*)(pk->ws + W_XB); g.Bt = (const bf16_t*)(pk->ws + W_WINT); g.M = NTOK; g.N = NPROJ; g.K = 1024;
          pg8::StaticOrder S; S.init(g.M, g.N, G, bid); pg8::EpiBf16 E; E.O = (bf16_t*)(pk->ws + W_PROJ); E.ldc = NPROJ;
          pg8::gemm_phase<pg8::EpiBf16, pg8::StaticOrder>((LAS unsigned char*)shm, g, S, E); }
        { pg8::Gemm g; g.A = (const bf16_t*)(pk->ws + W_MEMB); g.Bt = (const bf16_t*)(pk->ws + W_WKVT); g.M = 2048; g.N = 2048; g.K = 1024;
          const int shift = (66 * 26) % G; pg8::StaticOrder S; S.init(g.M, g.N, G, (bid + G - shift) % G);
          pg8::EpiKV E; E.mk = pk->out + O_MKP; E.mv = pk->out + O_MVP; E.kb = (bf16_t*)(pk->ws + W_KB); E.vt = (bf16_t*)(pk->ws + W_VT);
          pg8::gemm_phase<pg8::EpiKV, pg8::StaticOrder>((LAS unsigned char*)shm, g, S, E); } } }
    xcd_barrier(xb);
    { KP pk = kparams(); const int bid = obid();
      for (int rep = 0; rep < REP2; ++rep) for (int it = bid; it < 384; it += G) { if (it < 256) ssd1_item(pk, shm, it >> 5, (it >> 1) & 15, it & 1); else rgconv_item(pk, (it - 256) >> 4, (it - 256) & 15); } }
    xcd_barrier(xb);
    { KP pk = kparams(); const int bid = obid();
      for (int rep = 0; rep < REP3; ++rep) for (int it = bid; it < 1920; it += G) {
          if (rep > 0 && (it < R3LO || it >= R3HI)) continue;
          if (it < 256) rg_item(pk, shm, false, it >> 5, (it >> 2) & 7, it & 3);
          else if (it < 512) statepass_item(pk, it - 256);
          else if (it < 640) { const int u = it - 512; rg_item(pk, shm, true, u >> 5, (u >> 2) & 7, u & 3); }
          else if (it < 896) { const int u = it - 640; ssds_item(pk, shm, u >> 1, u & 1); }
          else if (it < 1408) { const int u = it - 896; attns_item(pk, shm, u >> 2, u & 3); }
          else { const int u = it - 1408; attnp_item(pk, shm, u >> 6, (u >> 4) & 3, u & 15); } } }
    xcd_barrier(xb);
    { KP pk = kparams(); const int bid = obid();
      for (int rep = 0; rep < REP4; ++rep) for (int it = bid; it < 256; it += G) ssd3_item(pk, shm, it >> 5, (it >> 1) & 15, it & 1); }
    xcd_barrier(xb);
    { KP pk = kparams(); const int bid = obid();
      for (int rep = 0; rep < REP5; ++rep) {
        for (int it = bid; it < 256; it += G) outs_item(pk, shm, it);
        pg8::Gemm g; g.A = (const bf16_t*)(pk->ws + W_MIX); g.Bt = (const bf16_t*)(pk->ws + W_WOUTT); g.M = NTOKP; g.N = 1024; g.K = 3072;
        pg8::StaticOrder S; S.init(g.M, g.N, G, bid); pg8::EpiRes E; E.res = (float*)(pk->ws + W_RES); E.xp = pk->x_prompt; E.xs = pk->x_sample; E.alpha = 1.189207115002721f;
        pg8::gemm_phase<pg8::EpiRes, pg8::StaticOrder>((LAS unsigned char*)shm, g, S, E); } }
    xcd_barrier(xb);
    { KP pk = kparams(); for (int rep = 0; rep < REP6; ++rep) ln_rows(pk); }
}

extern "C" void kernel_launch(void* const* d_in, const int* in_sizes, int n_in, void* d_out, int out_size, void* d_ws, size_t ws_size, hipStream_t stream) {
    static int grid_blocks = 0;
    if (!grid_blocks) {
        int dev = 0, cus = 0, per_cu = 0;
        hipGetDevice(&dev);
        hipDeviceGetAttribute(&cus, hipDeviceAttributeMultiprocessorCount, dev);
        if (hipFuncSetAttribute((const void*)hymba_fwd, hipFuncAttributeMaxDynamicSharedMemorySize, LDS_BYTES) != hipSuccess) fprintf(stderr, "hipFuncSetAttribute failed\n");
        hipOccupancyMaxActiveBlocksPerMultiprocessor(&per_cu, (const void*)hymba_fwd, 512, LDS_BYTES);
        if (per_cu < 1) { fprintf(stderr, "occupancy query says %d blocks per CU\n", per_cu); per_cu = 1; }
        grid_blocks = cus * 1;
        if (ws_size < W_END) fprintf(stderr, "workspace too small: %zu < %zu\n", ws_size, (size_t)W_END);
    }
    if (hipMemsetAsync((char*)d_ws + W_BAR, 0, 3456 * 4, stream) != hipSuccess) fprintf(stderr, "memset failed\n");
    Params p{};
    const float** fp = (const float**)&p;
    for (int i = 0; i < 28; ++i) fp[i] = (const float*)d_in[i];
    p.out = (float*)d_out; p.ws = (unsigned char*)d_ws;
    p.ph_lo = 0; p.ph_hi = NPHASE;
    void* args[] = {&p};
    hipError_t e = hipLaunchCooperativeKernel((const void*)hymba_fwd, dim3(grid_blocks), dim3(512), args, LDS_BYTES, stream);
    if (e != hipSuccess) fprintf(stderr, "cooperative launch failed: %s (grid %d)\n", hipGetErrorString(e), grid_blocks);
}
```

```cpp
#include <hip/hip_runtime.h>
#include <hip/hip_cooperative_groups.h>
#include <cstdio>
namespace cg = cooperative_groups;

#ifndef REP2
#define REP2 1
#endif
#ifndef REP3
#define REP3 1
#endif
#ifndef REP4
#define REP4 1
#endif
#ifndef R3LO
#define R3LO 0
#define R3HI 256
#endif
#ifndef REP0
#define REP0 1
#endif
#ifndef REP1
#define REP1 1
#endif
#ifndef REP5
#define REP5 1
#endif
#ifndef REP6
#define REP6 1
#endif
#ifndef REPS
#define REPS 1
#endif
#ifndef PHM
#define PHM 127
#endif
#ifndef N_LAUNCH_PER_PHASE
#define N_LAUNCH_PER_PHASE 0
#endif

#define DI __device__ __forceinline__
#define LAS __attribute__((address_space(3)))
typedef unsigned short bf16_t;
typedef short bf16x8 __attribute__((ext_vector_type(8)));
typedef float f32x4 __attribute__((ext_vector_type(4)));
typedef unsigned u32x4 __attribute__((ext_vector_type(4)));
typedef unsigned u32x2 __attribute__((ext_vector_type(2)));

constexpr int NTOKP = 16384, NTOKS = 512, NTOK = 16896, DM = 1024, NPROJ = 6656, DMIX = 3072, DIN = 6672;
constexpr int C_RGX = 0, C_RGG = 1024, C_XBC = 2048, C_Z = 3584, C_Q = 4608, C_XG = 5632;
constexpr int NPHASE = 7;
constexpr int LDS_BYTES = 131072 + 64;

constexpr size_t O_YP = 0, O_YS = O_YP + (size_t)NTOKP * DM, O_RGCP = O_YS + (size_t)NTOKS * DM, O_RGHP = O_RGCP + 8 * 3 * 1024, O_SCP = O_RGHP + 8 * 1024,
                 O_SHP = O_SCP + 8 * 3 * 1536, O_MKP = O_SHP + (size_t)8 * 16 * 64 * 128, O_MVP = O_MKP + (size_t)2048 * 1024, O_RGCS = O_MVP + (size_t)2048 * 1024,
                 O_RGHS = O_RGCS + (size_t)128 * 3 * 1024, O_SCS = O_RGHS + 128 * 1024, O_SHS = O_SCS + (size_t)128 * 3 * 1536;

constexpr size_t al256(size_t x) { return (x + 255) & ~(size_t)255; }
constexpr size_t W_XB = 0;
constexpr size_t W_WINT = al256(W_XB + (size_t)NTOK * DM * 2);
constexpr size_t W_WDTT = al256(W_WINT + (size_t)NPROJ * DM * 2);
constexpr size_t W_WDTF = al256(W_WDTT + 16 * 1024 * 2);
constexpr size_t W_WOUTT = al256(W_WDTF + 16 * 1024 * 4);
constexpr size_t W_WKVT = al256(W_WOUTT + (size_t)1024 * 3072 * 2);
constexpr size_t W_MEMB = al256(W_WKVT + (size_t)2048 * 1024 * 2);
constexpr size_t W_WGT = al256(W_MEMB + (size_t)2048 * 1024 * 2);
constexpr size_t W_KB = al256(W_WGT + (size_t)8 * 4 * 64 * 128 * 2);
constexpr size_t W_VT = al256(W_KB + (size_t)2048 * 1024 * 2);
constexpr size_t W_XACT = al256(W_VT + (size_t)2048 * 1024 * 2);
constexpr size_t W_DT = al256(W_XACT + (size_t)NTOKP * 1536 * 2);
constexpr size_t W_ACUM = al256(W_DT + (size_t)NTOKP * 16 * 4);
constexpr size_t W_CD = al256(W_ACUM + (size_t)NTOKP * 16 * 4);
constexpr size_t W_ST = al256(W_CD + 8 * 16 * 16 * 4);
constexpr size_t W_MIX = al256(W_ST + (size_t)8 * 16 * 16 * 8192 * 4);
constexpr size_t W_PROJ = al256(W_MIX + (size_t)NTOK * DMIX * 2);
constexpr size_t W_RES = W_PROJ;
constexpr size_t W_BAR = al256(W_PROJ + (size_t)NTOK * NPROJ * 2);
constexpr size_t W_END = al256(W_BAR + 3456 * 4);

struct Params {
    const float *x_prompt, *x_sample, *mem_prompt, *state_rg_conv, *state_rg_h, *state_ssd_conv, *state_ssd_h, *cache_k, *cache_v;
    const float *w_in, *rg_conv_w, *rg_conv_b, *w_rg_a, *b_rg_a, *w_rg_i, *b_rg_i, *rg_lambda, *ssd_conv_w, *ssd_conv_b, *ssd_dt_bias, *ssd_a_log, *ssd_d, *ssd_norm_g,
        *w_mem_k, *w_mem_v, *w_out, *ln_g, *ln_b;
    float* out; unsigned char* ws;
    int ph_lo, ph_hi;
};
typedef const __attribute__((address_space(4))) Params* KP;
DI KP kparams() { KP k = (KP)__builtin_amdgcn_kernarg_segment_ptr(); asm volatile("" : "+s"(k)); return k; }

DI int otid() { int t = threadIdx.x; asm volatile("" : "+v"(t)); return t; }
DI int obid() { int t = blockIdx.x; asm volatile("" : "+s"(t)); return t; }
DI float bf2f(bf16_t b) { return __uint_as_float(((unsigned)b) << 16); }
typedef __bf16 hbf2 __attribute__((ext_vector_type(2)));
typedef float f32x2 __attribute__((ext_vector_type(2)));
DI unsigned pack2(float lo, float hi) { const f32x2 v = {lo, hi}; return __builtin_bit_cast(unsigned, __builtin_convertvector(v, hbf2)); }
DI bf16_t f2bf(float f) { return (bf16_t)(pack2(f, 0.f) & 0xFFFFu); }
DI float bflo(unsigned w) { return __uint_as_float(w << 16); }
DI float bfhi(unsigned w) { return __uint_as_float(w & 0xFFFF0000u); }
DI void unpack8(const u32x4 v, float (&o)[8]) { o[0] = bflo(v.x); o[1] = bfhi(v.x); o[2] = bflo(v.y); o[3] = bfhi(v.y); o[4] = bflo(v.z); o[5] = bfhi(v.z); o[6] = bflo(v.w); o[7] = bfhi(v.w); }
DI u32x4 pack8(const float (&o)[8]) { u32x4 w; w.x = pack2(o[0], o[1]); w.y = pack2(o[2], o[3]); w.z = pack2(o[4], o[5]); w.w = pack2(o[6], o[7]); return w; }
DI bf16x8 as_frag(u32x4 w) { return __builtin_bit_cast(bf16x8, w); }
DI bf16x8 frag2(u32x2 lo, u32x2 hi) { u32x4 w; w.x = lo.x; w.y = lo.y; w.z = hi.x; w.w = hi.y; return __builtin_bit_cast(bf16x8, w); }
DI float shx(float v, int m, int lane) { return __int_as_float(__builtin_amdgcn_ds_bpermute((lane ^ m) << 2, __float_as_int(v))); }
DI float shl(float v, int src) { return __int_as_float(__builtin_amdgcn_ds_bpermute(src << 2, __float_as_int(v))); }
DI float siluf(float x) { return x * __builtin_amdgcn_rcpf(1.f + __expf(-x)); }
DI float sigmf(float x) { return __builtin_amdgcn_rcpf(1.f + __expf(-x)); }
DI float softplusf(float v) { return v > 20.f ? v : __logf(1.f + __expf(v)); }
#define MFMA16(a, b, c) __builtin_amdgcn_mfma_f32_16x16x32_bf16((a), (b), (c), 0, 0, 0)

#define XB_TMO      128
#define XB_XCNT(j)  (256  + 64 * (j))
#define XB_XSUB(j)  (1280 + 64 * (j))
#define XB_XGEN(j)  (2304 + 64 * (j))
#define XB_TOP      3328
#define XB_TOPGEN   3392
#define XCD_BAR_WORDS 3456
#define XB_SPIN_CAP (1u << 20)
DI unsigned xb_ld(unsigned* ptr)              { return __hip_atomic_load(ptr, __ATOMIC_RELAXED, __HIP_MEMORY_SCOPE_AGENT); }
DI unsigned xb_add(unsigned* ptr, unsigned v) { return __hip_atomic_fetch_add(ptr, v, __ATOMIC_RELAXED, __HIP_MEMORY_SCOPE_AGENT); }
DI unsigned xb_xcc_id() { return (unsigned)__builtin_amdgcn_s_getreg((3 << 11) | 20) & 0xFu; }
#define XB_SPIN(cond, bar) do { unsigned _sp = 0; while (cond) { __builtin_amdgcn_s_sleep(1); \
    if ((++_sp & 255u) == 0u) { if (xb_ld(&(bar)[XB_TMO])) break; if (_sp > XB_SPIN_CAP) { atomicAdd(&(bar)[XB_TMO], 1u); break; } } } } while (0)
struct XcdBarrier { unsigned* bar; unsigned x; volatile LAS unsigned* st; };
DI XcdBarrier xcd_barrier_post(unsigned* bar, volatile LAS unsigned* st) {
    XcdBarrier b; b.bar = bar; b.x = xb_xcc_id(); b.st = st;
    if (threadIdx.x == 0) (void)xb_add(&bar[XB_XCNT(b.x)], 1u);
    return b;
}
DI void xcd_barrier_complete(unsigned* bar, unsigned x, unsigned& nloc, unsigned& nx) {
    const unsigned G = gridDim.x * gridDim.y * gridDim.z;
    unsigned sum, cnt, mine, sp = 0u;
    for (;;) {
        sum = 0u; cnt = 0u; mine = 0u;
#pragma unroll
        for (unsigned j = 0; j < 16; ++j) { const unsigned c = xb_ld(&bar[XB_XCNT(j)]); sum += c; cnt += (c > 0u) ? 1u : 0u; mine = (j == x) ? c : mine; }
        if (sum == G) break;
        __builtin_amdgcn_s_sleep(1);
        if ((++sp & 255u) == 0u) { if (xb_ld(&bar[XB_TMO])) break; if (sp > XB_SPIN_CAP) { atomicAdd(&bar[XB_TMO], 1u); break; } }
    }
    nloc = mine > 0u ? mine : 1u; nx = cnt > 0u ? cnt : 1u;
}
DI void xcd_barrier(const XcdBarrier& b) {
    asm volatile("s_waitcnt vmcnt(0)" ::: "memory");
    __syncthreads();
    if (threadIdx.x == 0) {
        unsigned* bar = b.bar;
        __builtin_amdgcn_s_waitcnt(0);
        unsigned nloc = b.st[0], nx = b.st[1];
        if (nloc == 0u) { xcd_barrier_complete(bar, b.x, nloc, nx); b.st[0] = nloc; b.st[1] = nx; }
        const unsigned old = xb_add(&bar[XB_XSUB(b.x)], 1u);
        const unsigned gen = old / nloc;
        if (old + 1u == (gen + 1u) * nloc) {
            __builtin_amdgcn_fence(__ATOMIC_RELEASE, "agent");
            asm volatile("s_waitcnt vmcnt(0)" ::: "memory");
            const unsigned og = xb_add(&bar[XB_TOP], 1u);
            const unsigned tg = og / nx;
            if (og + 1u == (tg + 1u) * nx) xb_add(&bar[XB_TOPGEN], 1u);
            else XB_SPIN(xb_ld(&bar[XB_TOPGEN]) == tg, bar);
            __builtin_amdgcn_fence(__ATOMIC_ACQUIRE, "agent");
            xb_add(&bar[XB_XGEN(b.x)], 1u);
            asm volatile("s_waitcnt vmcnt(0)" ::: "memory");
        } else {
            XB_SPIN(xb_ld(&bar[XB_XGEN(b.x)]) == gen, bar);
            __builtin_amdgcn_fence(__ATOMIC_ACQUIRE, "agent");
            asm volatile("s_waitcnt vmcnt(0)" ::: "memory");
        }
    }
    __syncthreads();
}

namespace pg8 {
constexpr int BM = 256, BK = 64, HALF = 128, HTB = HALF * BK * 2, STAGE_BYTES = 8 * HTB, NXCD = 8, WGM = 8;
DI int lds_byte(int r, int c) { const int st = (r >> 4) * 2 + (c >> 5), rr = r & 15, cc = c & 31, ob = rr * 64 + cc * 2; return st * 1024 + (ob ^ (((ob >> 9) & 1) << 5)); }
DI void stage_rc(int b, int& R, int& C) { const int st = b / 1024, sb = b % 1024, swz = sb ^ (((sb >> 9) & 1) << 5); R = (st >> 1) * 16 + swz / 64; C = (st & 1) * 32 + (swz % 64) / 2; }
DI int perm32(int rho) { const int n = rho >> 4, i = rho & 15; return 8 * (i >> 2) + 4 * n + (i & 3); }
struct Unit { int pm, pn; };
struct Gemm { const bf16_t* A; const bf16_t* Bt; int M, N, K; };
struct StaticOrder {
    int nM, nN, nwg, G, c;
    DI void init(int M, int N, int G_, int c_) { nM = M / BM; nN = N / BM; nwg = nM * nN; G = G_; c = c_; }
    DI bool next(int i, Unit& u) const {
        const long L = (long)i * G + c; if (L >= nwg) return false;
        int wgid = (int)L; { const int q = nwg / NXCD, r = nwg % NXCD, xcd = wgid % NXCD, off = wgid / NXCD; wgid = (xcd < r ? xcd * (q + 1) : r * (q + 1) + (xcd - r) * q) + off; }
        const int nig = WGM * nN, gid = wgid / nig, fm = gid * WGM, gsz = (nM - fm) < WGM ? (nM - fm) : WGM;
        u.pm = fm + ((wgid % nig) % gsz); u.pn = (wgid % nig) / gsz; return true;
    }
};
DI unsigned cvt_pk_bf16(float lo, float hi) { unsigned r; asm volatile("v_cvt_pk_bf16_f32 %0, %1, %2" : "=v"(r) : "v"(lo), "v"(hi)); return r; }

struct EpiBf16 {
    static constexpr bool PERM = true;
    bf16_t* O; int ldc;
    DI void operator()(const f32x4 (&acc)[2][2][4][2], const Unit& u, int wr, int wc, int fr, int fq) const {
        const int row0 = u.pm * BM + wr * 64 + fr; const int col0 = u.pn * BM + wc * 32 + 8 * fq;
#pragma unroll
        for (int ai = 0; ai < 2; ++ai)
#pragma unroll
            for (int m = 0; m < 4; ++m) { bf16_t* rowp = O + (size_t)(row0 + ai * HALF + m * 16) * ldc + col0;
#pragma unroll
                for (int bj = 0; bj < 2; ++bj) { const f32x4 v0 = acc[ai][bj][m][0], v1 = acc[ai][bj][m][1];
                    u32x4 w; w.x = cvt_pk_bf16(v0[0], v0[1]); w.y = cvt_pk_bf16(v0[2], v0[3]); w.z = cvt_pk_bf16(v1[0], v1[1]); w.w = cvt_pk_bf16(v1[2], v1[3]);
                    *(u32x4*)(rowp + bj * HALF) = w; } }
    }
};
struct EpiKV {
    static constexpr bool PERM = false;
    float* mk; float* mv; bf16_t* kb; bf16_t* vt;
    DI void operator()(const f32x4 (&acc)[2][2][4][2], const Unit& u, int wr, int wc, int fr, int fq) const {
        const int row0 = u.pm * BM + wr * 64 + fr, col0 = u.pn * BM + wc * 32 + 4 * fq;
#pragma unroll
        for (int ai = 0; ai < 2; ++ai)
#pragma unroll
            for (int m = 0; m < 4; ++m) { const int row = row0 + ai * HALF + m * 16;
#pragma unroll
                for (int bj = 0; bj < 2; ++bj)
#pragma unroll
                    for (int n = 0; n < 2; ++n) { const int col = col0 + bj * HALF + n * 16; const f32x4 v = acc[ai][bj][m][n];
                        if (col < 1024) { *(f32x4*)(mk + (size_t)row * 1024 + col) = v; u32x2 w; w.x = cvt_pk_bf16(v[0], v[1]); w.y = cvt_pk_bf16(v[2], v[3]); *(u32x2*)(kb + (size_t)row * 1024 + col) = w; }
                        else { const int cc = col - 1024; *(f32x4*)(mv + (size_t)row * 1024 + cc) = v; const int bb = row >> 8, mt = row & 255;
#pragma unroll
                            for (int j = 0; j < 4; ++j) { const int c2 = cc + j, head = c2 >> 8, d = c2 & 255; vt[((size_t)((bb * 4 + head) * 256 + d)) * 256 + mt] = f2bf(v[j]); } } } }
    }
};
struct EpiRes {
    static constexpr bool PERM = false;
    float* res; const float* xp; const float* xs; float alpha;
    DI void operator()(const f32x4 (&acc)[2][2][4][2], const Unit& u, int wr, int wc, int fr, int fq) const {
        const int row0 = u.pm * BM + wr * 64 + fr, col0 = u.pn * BM + wc * 32 + 4 * fq;
#pragma unroll
        for (int ai = 0; ai < 2; ++ai)
#pragma unroll
            for (int m = 0; m < 4; ++m) { const int row = row0 + ai * HALF + m * 16; const float* xr = row < NTOKP ? xp + (size_t)row * 1024 : xs + (size_t)(row - NTOKP) * 1024;
#pragma unroll
                for (int bj = 0; bj < 2; ++bj)
#pragma unroll
                    for (int n = 0; n < 2; ++n) { const int col = col0 + bj * HALF + n * 16; const f32x4 xv = *(const f32x4*)(xr + col);
                        *(f32x4*)(res + (size_t)row * 1024 + col) = acc[ai][bj][m][n] + xv * alpha; } }
    }
};

template <class Epi, class Sched>
DI void gemm_phase(LAS unsigned char* lds, const Gemm g, const Sched& S, const Epi& E) {
    const int tid = otid(), wid = __builtin_amdgcn_readfirstlane(tid >> 6), lane = tid & 63, wr = wid >> 2, wc = wid & 3, fr = lane & 15, fq = lane >> 4;
    const int K = g.K, nt = K / BK;
    unsigned voffA[2], voffB[2];
#pragma unroll
    for (int i = 0; i < 2; ++i) { int R, C; stage_rc(tid * 16 + i * 8192, R, C); const int Rb = Epi::PERM ? ((R & ~31) + perm32(R & 31)) : R;
        voffA[i] = (unsigned)(R * K + C) * 2u; voffB[i] = (unsigned)(Rb * K + C) * 2u; }
    const size_t kstep = (size_t)(BK * 2);
    const size_t hstep = (size_t)HALF * K * 2;
    const size_t tstep = 2 * hstep;
    const unsigned ldsw = (unsigned)wid * 1024u;
    const int aoff = lds_byte(wr * 64 + fr, fq * 8), boff = lds_byte(wc * 32 + fr, fq * 8);
#define PG8_SA(b, h) (((b) * 2 + (h)) * HTB)
#define PG8_SB(b, h) ((4 + (b) * 2 + (h)) * HTB)
#define PG8_STAGE(bufoff, gbase, voff) do { _Pragma("unroll") for (int _i = 0; _i < 2; ++_i) \
        __builtin_amdgcn_global_load_lds((const unsigned*)((const char*)(gbase) + (voff)[_i]), (LAS unsigned*)(lds + (bufoff) + ldsw + _i * 8192), 16, 0, 0); } while (0)
#define PG8_LDA(dst, b, h) do { _Pragma("unroll") for (int m = 0; m < 4; ++m) _Pragma("unroll") for (int k = 0; k < 2; ++k) dst[m][k] = *(const LAS bf16x8*)(lds + PG8_SA(b, h) + aoff + m * 2048 + k * 1024); } while (0)
#define PG8_LDB(dst, b, h) do { _Pragma("unroll") for (int n = 0; n < 2; ++n) _Pragma("unroll") for (int k = 0; k < 2; ++k) dst[n][k] = *(const LAS bf16x8*)(lds + PG8_SB(b, h) + boff + n * 2048 + k * 1024); } while (0)
#define PG8_MMA(ai, bj, At, Bt) do { __builtin_amdgcn_s_setprio(1); _Pragma("unroll") for (int m = 0; m < 4; ++m) _Pragma("unroll") for (int n = 0; n < 2; ++n) _Pragma("unroll") for (int k = 0; k < 2; ++k) \
        acc[ai][bj][m][n] = __builtin_amdgcn_mfma_f32_16x16x32_bf16(Bt[n][k], At[m][k], acc[ai][bj][m][n], 0, 0, 0); __builtin_amdgcn_s_setprio(0); } while (0)
#define PG8_WAIT_V(n) asm volatile("s_waitcnt vmcnt(" #n ")" ::: "memory")
#define PG8_WAIT_L(n) asm volatile("s_waitcnt lgkmcnt(" #n ")" ::: "memory")
#define PG8_BAR __builtin_amdgcn_s_barrier()
#define PG8_SCHED __builtin_amdgcn_sched_barrier(0)
    Unit cur, nxt; int ui = 0;
    if (!S.next(0, cur)) return;
    f32x4 acc[2][2][4][2];
#pragma unroll
    for (int a = 0; a < 2; ++a)
#pragma unroll
        for (int b = 0; b < 2; ++b)
#pragma unroll
            for (int m = 0; m < 4; ++m)
#pragma unroll
                for (int n = 0; n < 2; ++n) acc[a][b][m][n] = (f32x4){0.f, 0.f, 0.f, 0.f};
    bf16x8 At[4][2], B0[2][2], B1[2][2];
    const char* cA = (const char*)g.A + (size_t)cur.pm * tstep; const char* cB = (const char*)g.Bt + (size_t)cur.pn * tstep;
    PG8_STAGE(PG8_SB(0, 0), cB, voffB); PG8_STAGE(PG8_SA(0, 0), cA, voffA); PG8_STAGE(PG8_SB(0, 1), cB + hstep, voffB); PG8_STAGE(PG8_SA(0, 1), cA + hstep, voffA);
    if (wr == 1) PG8_BAR;
    PG8_WAIT_V(4); PG8_BAR;
    PG8_STAGE(PG8_SB(1, 0), cB + kstep, voffB); PG8_STAGE(PG8_SA(1, 0), cA + kstep, voffA); PG8_STAGE(PG8_SB(1, 1), cB + hstep + kstep, voffB);
    PG8_WAIT_V(6); PG8_BAR;
    for (;;) {
        const bool has_next = S.next(ui + 1, nxt);
        const char* nA = has_next ? (const char*)g.A + (size_t)nxt.pm * tstep : cA; const char* nB = has_next ? (const char*)g.Bt + (size_t)nxt.pn * tstep : cB;
        for (int t = 0; t < nt; t += 2) {
            const bool last = (t == nt - 2);
            const char* a1 = cA + (size_t)(t + 1) * kstep;
            const char* a2 = last ? nA : cA + (size_t)(t + 2) * kstep; const char* b2 = last ? nB : cB + (size_t)(t + 2) * kstep;
            const char* a3 = a2 + kstep; const char* b3 = b2 + kstep;
            PG8_LDB(B0, 0, 0); PG8_SCHED; PG8_LDA(At, 0, 0); PG8_STAGE(PG8_SA(1, 1), a1 + hstep, voffA);
            PG8_WAIT_L(8); PG8_BAR; PG8_WAIT_L(0); PG8_MMA(0, 0, At, B0); PG8_BAR; PG8_SCHED;
            PG8_LDB(B1, 0, 1); PG8_STAGE(PG8_SB(0, 0), b2, voffB);
            PG8_BAR; PG8_WAIT_L(0); PG8_MMA(0, 1, At, B1); PG8_BAR;
            PG8_LDA(At, 0, 1); PG8_STAGE(PG8_SA(0, 0), a2, voffA);
            PG8_BAR; PG8_WAIT_L(0); PG8_MMA(1, 0, At, B0); PG8_BAR; PG8_SCHED;
            PG8_STAGE(PG8_SB(0, 1), b2 + hstep, voffB);
            PG8_WAIT_V(6); PG8_BAR; PG8_MMA(1, 1, At, B1); PG8_BAR;
            PG8_LDB(B0, 1, 0); PG8_SCHED; PG8_LDA(At, 1, 0); PG8_STAGE(PG8_SA(0, 1), a2 + hstep, voffA);
            PG8_WAIT_L(8); PG8_BAR; PG8_WAIT_L(0); PG8_MMA(0, 0, At, B0); PG8_BAR; PG8_SCHED;
            PG8_LDB(B1, 1, 1); PG8_STAGE(PG8_SB(1, 0), b3, voffB);
            PG8_BAR; PG8_WAIT_L(0); PG8_MMA(0, 1, At, B1); PG8_BAR;
            PG8_LDA(At, 1, 1); PG8_STAGE(PG8_SA(1, 0), a3, voffA);
            PG8_BAR; PG8_WAIT_L(0); PG8_MMA(1, 0, At, B0); PG8_BAR; PG8_SCHED;
            PG8_STAGE(PG8_SB(1, 1), b3 + hstep, voffB);
            PG8_WAIT_V(6); PG8_BAR; PG8_MMA(1, 1, At, B1); PG8_BAR;
        }
        E(acc, cur, wr, wc, fr, fq);
        if (!has_next) break;
#pragma unroll
        for (int a = 0; a < 2; ++a)
#pragma unroll
            for (int b = 0; b < 2; ++b)
#pragma unroll
                for (int m = 0; m < 4; ++m)
#pragma unroll
                    for (int n = 0; n < 2; ++n) acc[a][b][m][n] = (f32x4){0.f, 0.f, 0.f, 0.f};
        cur = nxt; cA = nA; cB = nB; ++ui;
    }
    PG8_WAIT_V(0);
    if (wr == 0) PG8_BAR;
    PG8_BAR;
#undef PG8_SA
#undef PG8_SB
#undef PG8_STAGE
#undef PG8_LDA
#undef PG8_LDB
#undef PG8_MMA
#undef PG8_WAIT_V
#undef PG8_WAIT_L
#undef PG8_BAR
#undef PG8_SCHED
}
}

DI void tr_tile(const float* src, int ld_src, int k0, int c0, bf16_t* dst, int ld_dst, int n0, float* lds) {
    const int tid = otid();
#pragma unroll
    for (int pass = 0; pass < 2; ++pass) { const int r = pass * 32 + (tid >> 4), c4 = (tid & 15) * 4;
        const f32x4 v = *(const f32x4*)(src + (size_t)(k0 + r) * ld_src + c0 + c4);
        lds[r * 65 + c4 + 0] = v[0]; lds[r * 65 + c4 + 1] = v[1]; lds[r * 65 + c4 + 2] = v[2]; lds[r * 65 + c4 + 3] = v[3]; }
    __syncthreads();
    const int nn = tid >> 3, kc = (tid & 7) * 8;
    float o[8];
#pragma unroll
    for (int e = 0; e < 8; ++e) o[e] = lds[(kc + e) * 65 + nn];
    *(u32x4*)(dst + (size_t)(n0 + nn) * ld_dst + k0 + kc) = pack8(o);
    __syncthreads();
}

DI void phase_prep(KP pk_in, unsigned char* lds) {
    KP pk = pk_in; asm volatile("" : "+s"(pk));
    unsigned char* ws = pk->ws;
    const int bidx_ = obid(); const size_t gtid = (size_t)bidx_ * 512 + otid(), nthr = (size_t)gridDim.x * 512;
    { bf16_t* xb = (bf16_t*)(ws + W_XB);
      for (size_t v = gtid; v < (size_t)NTOK * 128; v += nthr) { const float* s = v < (size_t)NTOKP * 128 ? pk->x_prompt + v * 8 : pk->x_sample + (v - (size_t)NTOKP * 128) * 8;
          const f32x4 a = *(const f32x4*)s, b = *(const f32x4*)(s + 4); float o[8] = {a[0], a[1], a[2], a[3], b[0], b[1], b[2], b[3]}; *(u32x4*)(xb + v * 8) = pack8(o); } }
    { bf16_t* mb = (bf16_t*)(ws + W_MEMB);
      for (size_t v = gtid; v < (size_t)2048 * 128; v += nthr) { const float* s = pk->mem_prompt + v * 8;
          const f32x4 a = *(const f32x4*)s, b = *(const f32x4*)(s + 4); float o[8] = {a[0], a[1], a[2], a[3], b[0], b[1], b[2], b[3]}; *(u32x4*)(mb + v * 8) = pack8(o); } }
    { bf16_t* wd = (bf16_t*)(ws + W_WDTT); float* wf = (float*)(ws + W_WDTF);
      for (size_t i = gtid; i < 16 * 1024; i += nthr) { const int h = (int)(i >> 10), k = (int)(i & 1023); const float v = pk->w_in[(size_t)k * DIN + 4608 + h]; wd[i] = f2bf(v); wf[i] = v; } }
    { bf16_t* wg = (bf16_t*)(ws + W_WGT);
      for (size_t i = gtid; i < (size_t)8 * 4 * 64 * 128; i += nthr) { const int k = (int)(i >> 15), qd = (int)(i >> 13) & 3, nn = (int)(i >> 7) & 63, ii = (int)(i & 127);
          const float v = nn < 32 ? pk->w_rg_a[((size_t)k * 128 + ii) * 128 + qd * 32 + nn] : pk->w_rg_i[((size_t)k * 128 + ii) * 128 + qd * 32 + nn - 32]; wg[i] = f2bf(v); } }
    float* tl = (float*)lds;
    for (int t = bidx_; t < 1664 + 768 + 512; t += gridDim.x) {
        if (t < 1664) { const int kt = t & 15, ntile = t >> 4; const int n0 = ntile * 64, c0 = n0 < 4608 ? n0 : n0 + 16;
            tr_tile(pk->w_in, DIN, kt * 64, c0, (bf16_t*)(ws + W_WINT), 1024, n0, tl); }
        else if (t < 1664 + 768) { const int u = t - 1664; const int kt = u % 48, ntile = u / 48;
            tr_tile(pk->w_out, 1024, kt * 64, ntile * 64, (bf16_t*)(ws + W_WOUTT), 3072, ntile * 64, tl); }
        else { const int u = t - 1664 - 768; const int kt = u & 15, ntile = u >> 4; const int n0 = ntile * 64;
            if (n0 < 1024) tr_tile(pk->w_mem_k, 1024, kt * 64, n0, (bf16_t*)(ws + W_WKVT), 1024, n0, tl);
            else tr_tile(pk->w_mem_v, 1024, kt * 64, n0 - 1024, (bf16_t*)(ws + W_WKVT), 1024, n0, tl); }
    }
}

DI void conv8_ssd_prompt(KP pk, const bf16_t* proj, int rowbase, int t, int ch, float (&o)[8]) {
    const f32x4 b0 = *(const f32x4*)(pk->ssd_conv_b + ch), b1 = *(const f32x4*)(pk->ssd_conv_b + ch + 4);
    float acc[8] = {b0[0], b0[1], b0[2], b0[3], b1[0], b1[1], b1[2], b1[3]};
    u32x4 vv[4];
#pragma unroll
    for (int kk = 0; kk < 4; ++kk) { const int tt = t - 3 + kk; vv[kk] = *(const u32x4*)(proj + (size_t)(rowbase + (tt < 0 ? 0 : tt)) * NPROJ + C_XBC + ch); }
#pragma unroll
    for (int kk = 0; kk < 4; ++kk) { const int tt = t - 3 + kk; const float msk = tt >= 0 ? 1.f : 0.f; float x[8]; unpack8(vv[kk], x);
            const f32x4 w0 = *(const f32x4*)(pk->ssd_conv_w + kk * 1536 + ch) * msk, w1 = *(const f32x4*)(pk->ssd_conv_w + kk * 1536 + ch + 4) * msk;
            acc[0] += x[0] * w0[0]; acc[1] += x[1] * w0[1]; acc[2] += x[2] * w0[2]; acc[3] += x[3] * w0[3];
            acc[4] += x[4] * w1[0]; acc[5] += x[5] * w1[1]; acc[6] += x[6] * w1[2]; acc[7] += x[7] * w1[3]; }
#pragma unroll
    for (int e = 0; e < 8; ++e) o[e] = siluf(acc[e]);
}

DI void ssd1_item(KP pk_in, unsigned char* lds, int b, int c, int g) {
    KP pk = pk_in; asm volatile("" : "+s"(pk));
    unsigned char* ws = pk->ws;
    const int tid = otid(), w = tid >> 6, lane = tid & 63, l15 = lane & 15, q = lane >> 4;
    float* dt_s = (float*)lds; float* acum_s = dt_s + 2048; float* w_s = acum_s + 2048;
    bf16_t* BT = (bf16_t*)(lds + 20480); bf16_t* xsT = (bf16_t*)(lds + 20480 + 34816);
    const bf16_t* xb = (const bf16_t*)(ws + W_XB); const bf16_t* wdt = (const bf16_t*)(ws + W_WDTT); const bf16_t* proj = (const bf16_t*)(ws + W_PROJ);
    bf16_t* xact = (bf16_t*)(ws + W_XACT); float* dt_g = (float*)(ws + W_DT); float* acum_g = (float*)(ws + W_ACUM); float* cd_g = (float*)(ws + W_CD); float* st_g = (float*)(ws + W_ST);
    const int tok0 = b * 2048 + c * 128;
    __syncthreads();
    { f32x4 acc = {0.f, 0.f, 0.f, 0.f}; const bf16_t* ap = xb + (size_t)(tok0 + 16 * w + l15) * 1024 + q * 8; const bf16_t* bp = wdt + l15 * 1024 + q * 8;
#pragma unroll 8
      for (int ks = 0; ks < 32; ++ks) { const bf16x8 a = *(const bf16x8*)(ap + ks * 32); const bf16x8 bb = *(const bf16x8*)(bp + ks * 32); acc = MFMA16(a, bb, acc); }
      const float bias = pk->ssd_dt_bias[l15];
#pragma unroll
      for (int r = 0; r < 4; ++r) { const int i = 16 * w + 4 * q + r; const float dt = softplusf(acc[r] + bias); dt_s[i * 16 + l15] = dt; dt_g[(size_t)(tok0 + i) * 16 + l15] = dt; } }
    __syncthreads();
    if (tid < 16) { const float ah = -__expf(pk->ssd_a_log[tid]); float run = 0.f;
        for (int i = 0; i < 128; ++i) { run += dt_s[i * 16 + tid] * ah; acum_s[i * 16 + tid] = run; acum_g[(size_t)(tok0 + i) * 16 + tid] = run; } }
    __syncthreads();
    if (tid < 8) cd_g[(b * 16 + c) * 16 + 8 * g + tid] = __expf(acum_s[127 * 16 + 8 * g + tid]);
    for (int idx = tid; idx < 1024; idx += 512) { const int j = idx >> 3, hl = idx & 7, h = 8 * g + hl; w_s[idx] = dt_s[j * 16 + h] * __expf(acum_s[127 * 16 + h] - acum_s[j * 16 + h]); }
    for (int idx = tid; idx < 4096; idx += 512) { const int which = idx >> 11, rem = idx & 2047, j = rem >> 4, cv = (rem & 15) * 8; const int ch = 1024 + which * 256 + g * 128 + cv;
        float o[8]; conv8_ssd_prompt(pk, proj, b * 2048, c * 128 + j, ch, o); const u32x4 pk = pack8(o);
        *(u32x4*)(xact + (size_t)(tok0 + j) * 1536 + ch) = pk;
        if (which == 0) { const bf16_t* e16 = (const bf16_t*)&pk;
#pragma unroll
            for (int e = 0; e < 8; ++e) BT[(cv + e) * 136 + j] = f2bf(o[e]); (void)e16; } }
    for (int hl = 0; hl < 8; ++hl) {
        __syncthreads();
        for (int idx = tid; idx < 1024; idx += 512) { const int j = idx >> 3, pv = (idx & 7) * 8; const int ch = g * 512 + hl * 64 + pv;
            float o[8]; conv8_ssd_prompt(pk, proj, b * 2048, c * 128 + j, ch, o);
            *(u32x4*)(xact + (size_t)(tok0 + j) * 1536 + ch) = pack8(o);
            const float wj = w_s[j * 8 + hl];
#pragma unroll
            for (int e = 0; e < 8; ++e) xsT[(pv + e) * 136 + j] = f2bf(o[e] * wj); }
        __syncthreads();
        const int pt = w & 3, nh = w >> 2;
        f32x4 acc[4];
#pragma unroll
        for (int nt = 0; nt < 4; ++nt) acc[nt] = (f32x4){0.f, 0.f, 0.f, 0.f};
#pragma unroll
        for (int ks = 0; ks < 4; ++ks) { const bf16x8 a = *(const bf16x8*)(xsT + (pt * 16 + l15) * 136 + ks * 32 + q * 8);
#pragma unroll
            for (int nt = 0; nt < 4; ++nt) { const bf16x8 bb = *(const bf16x8*)(BT + (nh * 64 + nt * 16 + l15) * 136 + ks * 32 + q * 8); acc[nt] = MFMA16(a, bb, acc[nt]); } }
        float* sp = st_g + (size_t)(((b * 16 + c) * 16 + 8 * g + hl)) * 8192;
#pragma unroll
        for (int nt = 0; nt < 4; ++nt)
#pragma unroll
            for (int r = 0; r < 4; ++r) sp[(pt * 16 + 4 * q + r) * 128 + nh * 64 + nt * 16 + l15] = acc[nt][r];
    }
    if (c == 15) {
        for (int idx = tid; idx < 3 * 768; idx += 512) { const int jj = idx / 768, cc = idx % 768; const int ch = cc < 512 ? g * 512 + cc : (cc < 640 ? 1024 + g * 128 + (cc - 512) : 1280 + g * 128 + (cc - 640));
            pk->out[O_SCP + (size_t)(b * 3 + jj) * 1536 + ch] = bf2f(proj[(size_t)(b * 2048 + 2045 + jj) * NPROJ + C_XBC + ch]); }
    }
}

DI void rgconv_item(KP pk_in, int b, int tile) {
    KP pk = pk_in; asm volatile("" : "+s"(pk));
    const int tid = otid();
    const bf16_t* proj = (const bf16_t*)(pk->ws + W_PROJ); bf16_t* mix = (bf16_t*)(pk->ws + W_MIX);
    const int ch = (tid & 127) * 8, t0 = tile * 128 + (tid >> 7) * 32;
    float wgt[4][8], bs[8];
    { const f32x4 b0 = *(const f32x4*)(pk->rg_conv_b + ch), b1 = *(const f32x4*)(pk->rg_conv_b + ch + 4);
      bs[0] = b0[0]; bs[1] = b0[1]; bs[2] = b0[2]; bs[3] = b0[3]; bs[4] = b1[0]; bs[5] = b1[1]; bs[6] = b1[2]; bs[7] = b1[3];
#pragma unroll
      for (int kk = 0; kk < 4; ++kk) { const f32x4 w0 = *(const f32x4*)(pk->rg_conv_w + kk * 1024 + ch), w1 = *(const f32x4*)(pk->rg_conv_w + kk * 1024 + ch + 4);
          wgt[kk][0] = w0[0]; wgt[kk][1] = w0[1]; wgt[kk][2] = w0[2]; wgt[kk][3] = w0[3]; wgt[kk][4] = w1[0]; wgt[kk][5] = w1[1]; wgt[kk][6] = w1[2]; wgt[kk][7] = w1[3]; } }
    const bf16_t* src = proj + (size_t)(b * 2048) * NPROJ + C_RGX + ch;
    u32x4 hist[3];
#pragma unroll
    for (int i = 0; i < 3; ++i) { const int tt = t0 - 3 + i; const u32x4 v = *(const u32x4*)(src + (size_t)(tt < 0 ? 0 : tt) * NPROJ); hist[i] = tt < 0 ? (u32x4){0u, 0u, 0u, 0u} : v; }
    for (int c8 = 0; c8 < 32; c8 += 8) { u32x4 nv[8];
#pragma unroll
        for (int i = 0; i < 8; ++i) nv[i] = *(const u32x4*)(src + (size_t)(t0 + c8 + i) * NPROJ);
#pragma unroll
        for (int i = 0; i < 8; ++i) { float x0[8], x1[8], x2[8], x3[8]; unpack8(hist[0], x0); unpack8(hist[1], x1); unpack8(hist[2], x2); unpack8(nv[i], x3); float acc[8];
#pragma unroll
            for (int e = 0; e < 8; ++e) acc[e] = bs[e] + x0[e] * wgt[0][e] + x1[e] * wgt[1][e] + x2[e] * wgt[2][e] + x3[e] * wgt[3][e];
            *(u32x4*)(mix + (size_t)(b * 2048 + t0 + c8 + i) * DMIX + 1024 + ch) = pack8(acc);
            hist[0] = hist[1]; hist[1] = hist[2]; hist[2] = nv[i]; } }
}

DI void statepass_item(KP pk_in, int sp) {
    KP pk = pk_in; asm volatile("" : "+s"(pk));
    const int b = sp >> 5, h = (sp >> 1) & 15, half = sp & 1; const int e0 = half * 4096 + otid() * 8;
    float* st_g = (float*)(pk->ws + W_ST); const float* cd_g = (const float*)(pk->ws + W_CD);
    f32x4 r0 = {0.f, 0.f, 0.f, 0.f}, r1 = {0.f, 0.f, 0.f, 0.f};
    for (int c0 = 0; c0 < 16; c0 += 8) { f32x4 v0[8], v1[8]; float cd[8];
#pragma unroll
        for (int i = 0; i < 8; ++i) { const float* ptr = st_g + (size_t)((b * 16 + c0 + i) * 16 + h) * 8192 + e0; v0[i] = *(const f32x4*)ptr; v1[i] = *(const f32x4*)(ptr + 4); cd[i] = cd_g[(b * 16 + c0 + i) * 16 + h]; }
#pragma unroll
        for (int i = 0; i < 8; ++i) { float* ptr = st_g + (size_t)((b * 16 + c0 + i) * 16 + h) * 8192 + e0; *(f32x4*)ptr = r0; *(f32x4*)(ptr + 4) = r1; r0 = r0 * cd[i] + v0[i]; r1 = r1 * cd[i] + v1[i]; } }
    float* o = pk->out + O_SHP + (size_t)(b * 16 + h) * 8192 + e0; *(f32x4*)o = r0; *(f32x4*)(o + 4) = r1;
}

DI void rg_item(KP pk_in, unsigned char* lds, const bool sample, int bidx, int k, int qd) {
    KP pk = pk_in; asm volatile("" : "+s"(pk));
    unsigned char* ws = pk->ws;
    const int tid = otid(), w = tid >> 6, lane = tid & 63, l15 = lane & 15, q = lane >> 4;
    bf16_t* uA = (bf16_t*)lds;
    float* sa = (float*)(lds + 34816); float* sb = sa + 4096;
    float* segA = sb + 4096; float* segB = segA + 512; float* hcar = segB + 512;
    const bf16_t* proj = (const bf16_t*)(ws + W_PROJ); bf16_t* mix = (bf16_t*)(ws + W_MIX);
    const bf16_t* wg = (const bf16_t*)(ws + W_WGT) + (size_t)((k * 4 + qd) * 64) * 128;
    bf16_t* wS = (bf16_t*)(lds + 73728);
    __syncthreads();
    for (int idx = tid; idx < 1024; idx += 512) { const int n = idx >> 4, c8 = (idx & 15) * 8; *(u32x4*)(wS + n * 136 + c8) = *(const u32x4*)(wg + n * 128 + c8); }
    float ba[2], bi[2], spl[2];
#pragma unroll
    for (int ntl = 0; ntl < 2; ++ntl) { const int ch = k * 128 + qd * 32 + ntl * 16 + l15; ba[ntl] = pk->b_rg_a[ch]; bi[ntl] = pk->b_rg_i[ch]; spl[ntl] = softplusf(-pk->rg_lambda[ch]); }
    __syncthreads();
    if (tid < 32) hcar[tid] = 0.f;
    const int ntiles = sample ? 1 : 16;
    const int crow = tid >> 2, cg0 = (tid & 3) * 32;
    const int cl_s = tid & 31, seg_s = tid >> 5;
    const bf16_t* ug = mix + 1024;
    u32x4 av[4]; bf16_t uv[8];
#define RG_LOADP(TILE) do { const size_t r0 = (size_t)(bidx * 2048 + (TILE) * 128 + 16 * w); \
        _Pragma("unroll") for (int ks = 0; ks < 4; ++ks) av[ks] = *(const u32x4*)(ug + (r0 + l15) * DMIX + k * 128 + ks * 32 + q * 8); \
        _Pragma("unroll") for (int ntl = 0; ntl < 2; ++ntl) _Pragma("unroll") for (int r = 0; r < 4; ++r) uv[ntl * 4 + r] = ug[(r0 + 4 * q + r) * DMIX + k * 128 + qd * 32 + ntl * 16 + l15]; } while (0)
    if (!sample) RG_LOADP(0);
    bf16x8 afr[4]; float uvf[8];
    for (int tile = 0; tile < ntiles; ++tile) {
        __syncthreads();
        float gts[8];
        if (!sample) {
#pragma unroll
          for (int ks = 0; ks < 4; ++ks) afr[ks] = as_frag(av[ks]);
#pragma unroll
          for (int e = 0; e < 8; ++e) uvf[e] = bf2f(uv[e]);
          if (tile + 1 < 16) RG_LOADP(tile + 1);
#pragma unroll
          for (int j = 0; j < 8; ++j) gts[j] = bf2f(proj[(size_t)(bidx * 2048 + tile * 128 + seg_s * 8 + j) * NPROJ + C_RGG + k * 128 + qd * 32 + cl_s]);
        } else { const int row = crow;
#pragma unroll
          for (int v = 0; v < 4; ++v) { const int c8 = cg0 + v * 8, ch = k * 128 + c8;
              const f32x4 b0 = *(const f32x4*)(pk->rg_conv_b + ch), b1 = *(const f32x4*)(pk->rg_conv_b + ch + 4);
              float acc[8] = {b0[0], b0[1], b0[2], b0[3], b1[0], b1[1], b1[2], b1[3]};
#pragma unroll
              for (int kk = 0; kk < 4; ++kk) { float x[8];
                  { const int sbi = bidx * 32 + (row >> 2), ui = (row & 3) + kk; const bool st = ui < 3;
                      const float* s = pk->state_rg_conv + (size_t)(sbi * 3 + (st ? ui : 2)) * 1024 + ch; const f32x4 s0 = *(const f32x4*)s, s1 = *(const f32x4*)(s + 4);
                      const u32x4 vv = *(const u32x4*)(proj + (size_t)(NTOKP + sbi * 4 + (st ? 0 : ui - 3)) * NPROJ + C_RGX + ch); unpack8(vv, x);
                      x[0] = st ? s0[0] : x[0]; x[1] = st ? s0[1] : x[1]; x[2] = st ? s0[2] : x[2]; x[3] = st ? s0[3] : x[3];
                      x[4] = st ? s1[0] : x[4]; x[5] = st ? s1[1] : x[5]; x[6] = st ? s1[2] : x[6]; x[7] = st ? s1[3] : x[7]; }
                  { const f32x4 w0 = *(const f32x4*)(pk->rg_conv_w + kk * 1024 + ch), w1 = *(const f32x4*)(pk->rg_conv_w + kk * 1024 + ch + 4);
                      acc[0] += x[0] * w0[0]; acc[1] += x[1] * w0[1]; acc[2] += x[2] * w0[2]; acc[3] += x[3] * w0[3];
                      acc[4] += x[4] * w1[0]; acc[5] += x[5] * w1[1]; acc[6] += x[6] * w1[2]; acc[7] += x[7] * w1[3]; } }
              *(u32x4*)(uA + row * 136 + c8) = pack8(acc); }
#pragma unroll
          for (int j = 0; j < 8; ++j) gts[j] = bf2f(proj[(size_t)(NTOKP + bidx * 128 + seg_s * 8 + j) * NPROJ + C_RGG + k * 128 + qd * 32 + cl_s]);
        }
        __syncthreads();
        { f32x4 acc[4];
#pragma unroll
          for (int nt = 0; nt < 4; ++nt) acc[nt] = (f32x4){0.f, 0.f, 0.f, 0.f};
#pragma unroll
          for (int ks = 0; ks < 4; ++ks) { const bf16x8 a = sample ? *(const bf16x8*)(uA + (16 * w + l15) * 136 + ks * 32 + q * 8) : afr[ks];
#pragma unroll
              for (int nt = 0; nt < 4; ++nt) { const bf16x8 bb = *(const bf16x8*)(wS + (nt * 16 + l15) * 136 + ks * 32 + q * 8); acc[nt] = MFMA16(a, bb, acc[nt]); } }
#pragma unroll
          for (int ntl = 0; ntl < 2; ++ntl)
#pragma unroll
              for (int r = 0; r < 4; ++r) { const int row = 16 * w + 4 * q + r, cl = ntl * 16 + l15;
                  const float rr = sigmf(acc[ntl][r] + ba[ntl]), ii = sigmf(acc[2 + ntl][r] + bi[ntl]);
                  const float la = -8.f * rr * spl[ntl]; float a = __expf(la); const float uval = sample ? bf2f(uA[row * 136 + qd * 32 + cl]) : uvf[ntl * 4 + r];
                  float bt = __builtin_amdgcn_sqrtf(fmaxf(1.f - a * a, 0.f)) * ii * uval;
                  const bool first = sample ? ((row & 3) == 0) : (tile == 0 && row == 0);
                  if (first) { const float h0 = sample ? pk->state_rg_h[(size_t)(bidx * 32 + (row >> 2)) * 1024 + k * 128 + qd * 32 + cl] : 0.f; bt += a * h0; a = 0.f; }
                  sa[row * 32 + cl] = a; sb[row * 32 + cl] = bt; } }
        __syncthreads();
        const int cl = tid & 31, seg = tid >> 5;
        { float A = 1.f, B = 0.f;
#pragma unroll
          for (int j = 0; j < 8; ++j) { const int row = seg * 8 + j; const float a = sa[row * 32 + cl], bb = sb[row * 32 + cl]; B = a * B + bb; A = a * A; }
          segA[seg * 32 + cl] = A; segB[seg * 32 + cl] = B; }
        __syncthreads();
        float h = hcar[cl];
        for (int s = 0; s < seg; ++s) h = segA[s * 32 + cl] * h + segB[s * 32 + cl];
        const int chg = k * 128 + qd * 32 + cl;
#pragma unroll
        for (int j = 0; j < 8; ++j) { const int row = seg * 8 + j; h = sa[row * 32 + cl] * h + sb[row * 32 + cl];
            const size_t grow = sample ? (size_t)(NTOKP + bidx * 128 + row) : (size_t)(bidx * 2048 + tile * 128 + row);
            mix[grow * DMIX + chg] = f2bf(h * siluf(gts[j]));
            if (sample) { if ((row & 3) == 3) pk->out[O_RGHS + (size_t)(bidx * 32 + (row >> 2)) * 1024 + chg] = h; }
            else if (tile == 15 && row == 127) pk->out[O_RGHP + (size_t)bidx * 1024 + chg] = h; }
        __syncthreads();
        if (seg == 15) hcar[cl] = h;
    }
    if (!sample) { if (tid < 96) { const int jj = tid >> 5, cl = tid & 31, chg = k * 128 + qd * 32 + cl;
            pk->out[O_RGCP + (size_t)(bidx * 3 + jj) * 1024 + chg] = bf2f(proj[(size_t)(bidx * 2048 + 2045 + jj) * NPROJ + C_RGX + chg]); } }
    else { for (int idx = tid; idx < 32 * 3 * 32; idx += 512) { const int cl = idx & 31, jj = (idx >> 5) % 3, sl = idx / 96; const int sbi = bidx * 32 + sl, chg = k * 128 + qd * 32 + cl;
            pk->out[O_RGCS + (size_t)(sbi * 3 + jj) * 1024 + chg] = bf2f(proj[(size_t)(NTOKP + sbi * 4 + 1 + jj) * NPROJ + C_RGX + chg]); } }
}

DI void attnp_item(KP pk_in, unsigned char* lds, int b, int head, int qt) {
    KP pk = pk_in; asm volatile("" : "+s"(pk));
    unsigned char* ws = pk->ws;
    const int tid = otid(), w = tid >> 6, lane = tid & 63, l15 = lane & 15, q = lane >> 4;
    const bf16_t* proj = (const bf16_t*)(ws + W_PROJ); const bf16_t* kb = (const bf16_t*)(ws + W_KB); const bf16_t* vt = (const bf16_t*)(ws + W_VT); bf16_t* mix = (bf16_t*)(ws + W_MIX);
    const int tokb = b * 2048 + qt * 128 + 16 * w;
    constexpr int RS = 264;
    bf16_t* sm = (bf16_t*)lds;
    const int lr = tid >> 5, lc = (tid & 31) * 8;
    const bf16_t* kbase = kb + (size_t)(b * 256) * 1024 + head * 256; const bf16_t* vbase = vt + (size_t)((b * 4 + head) * 256) * 256;
    u32x4 pre[8];
#define AT_LOAD(S) do { _Pragma("unroll") for (int i = 0; i < 8; ++i) { const int r = lr + 16 * i; \
        pre[i] = (S) < 2 ? *(const u32x4*)(kbase + (size_t)(128 * (S) + r) * 1024 + lc) : *(const u32x4*)(vbase + (size_t)(128 * ((S) - 2) + r) * 256 + lc); } } while (0)
#define AT_STORE() do { _Pragma("unroll") for (int i = 0; i < 8; ++i) *(u32x4*)(sm + (lr + 16 * i) * RS + lc) = pre[i]; } while (0)
    AT_LOAD(0);
    bf16x8 qf[8];
#pragma unroll
    for (int ks = 0; ks < 8; ++ks) qf[ks] = *(const bf16x8*)(proj + (size_t)(tokb + l15) * NPROJ + C_Q + head * 256 + ks * 32 + q * 8);
    f32x4 st[16];
#pragma unroll
    for (int s = 0; s < 2; ++s) {
        __syncthreads(); AT_STORE(); __syncthreads(); AT_LOAD(s + 1);
#pragma unroll
        for (int mtl = 0; mtl < 8; ++mtl) { const int mt = 8 * s + mtl; st[mt] = (f32x4){0.f, 0.f, 0.f, 0.f}; const bf16_t* kp = sm + (16 * mtl + l15) * RS + q * 8;
#pragma unroll
            for (int ks = 0; ks < 8; ++ks) { const bf16x8 kf = *(const bf16x8*)(kp + ks * 32); st[mt] = MFMA16(kf, qf[ks], st[mt]); } }
    }
    float mx = -3.0e38f;
#pragma unroll
    for (int mt = 0; mt < 16; ++mt)
#pragma unroll
        for (int r = 0; r < 4; ++r) { st[mt][r] *= 0.0625f; mx = fmaxf(mx, st[mt][r]); }
    mx = fmaxf(mx, shx(mx, 16, lane)); mx = fmaxf(mx, shx(mx, 32, lane));
    float l = 0.f;
#pragma unroll
    for (int mt = 0; mt < 16; ++mt)
#pragma unroll
        for (int r = 0; r < 4; ++r) { const float e = __expf(st[mt][r] - mx); st[mt][r] = e; l += e; }
    l += shx(l, 16, lane); l += shx(l, 32, lane);
    bf16x8 pf[8];
#pragma unroll
    for (int s = 0; s < 8; ++s) { float m8[8] = {st[2 * s][0], st[2 * s][1], st[2 * s][2], st[2 * s][3], st[2 * s + 1][0], st[2 * s + 1][1], st[2 * s + 1][2], st[2 * s + 1][3]}; pf[s] = as_frag(pack8(m8)); }
    float linv[4];
#pragma unroll
    for (int r = 0; r < 4; ++r) linv[r] = 1.f / shl(l, 4 * q + r);
#pragma unroll
    for (int s2 = 0; s2 < 2; ++s2) {
        __syncthreads(); AT_STORE(); __syncthreads(); if (s2 == 0) AT_LOAD(3);
#pragma unroll
        for (int dtl = 0; dtl < 8; ++dtl) { const int dt = 8 * s2 + dtl; f32x4 o = {0.f, 0.f, 0.f, 0.f}; const bf16_t* vp = sm + (16 * dtl + l15) * RS + 4 * q;
            float gt[4];
#pragma unroll
            for (int r = 0; r < 4; ++r) gt[r] = bf2f(proj[(size_t)(tokb + 4 * q + r) * NPROJ + C_XG + head * 256 + 16 * dt + l15]);
#pragma unroll
            for (int s = 0; s < 8; ++s) { const u32x2 lo = *(const u32x2*)(vp + 32 * s), hi = *(const u32x2*)(vp + 32 * s + 16); o = MFMA16(pf[s], frag2(lo, hi), o); }
#pragma unroll
            for (int r = 0; r < 4; ++r) { const size_t tok = (size_t)(tokb + 4 * q + r); const int d = 16 * dt + l15;
                mix[tok * DMIX + 2048 + head * 256 + d] = f2bf(o[r] * linv[r] * siluf(gt[r])); } }
    }
#undef AT_LOAD
#undef AT_STORE
}

DI float wave_sum(float v, int lane) { v += shx(v, 32, lane); v += shx(v, 16, lane); v += shx(v, 8, lane); v += shx(v, 4, lane); v += shx(v, 2, lane); v += shx(v, 1, lane); return v; }
DI float wave_max(float v, int lane) { v = fmaxf(v, shx(v, 32, lane)); v = fmaxf(v, shx(v, 16, lane)); v = fmaxf(v, shx(v, 8, lane)); v = fmaxf(v, shx(v, 4, lane)); v = fmaxf(v, shx(v, 2, lane)); v = fmaxf(v, shx(v, 1, lane)); return v; }

DI void attns_item(KP pk_in, unsigned char* lds, int sbi, int head) {
    KP pk = pk_in; asm volatile("" : "+s"(pk));
    unsigned char* ws = pk->ws;
    const int tid = otid(), w = tid >> 6, lane = tid & 63;
    const bf16_t* proj = (const bf16_t*)(ws + W_PROJ); bf16_t* mix = (bf16_t*)(ws + W_MIX);
    float* qs = (float*)lds; float* sc = qs + 1024; float* ored = sc + 1024;
    __syncthreads();
    for (int idx = tid; idx < 1024; idx += 512) { const int t = idx >> 8, d = idx & 255; qs[idx] = bf2f(proj[(size_t)(NTOKP + sbi * 4 + t) * NPROJ + C_Q + head * 256 + d]); }
    __syncthreads();
    f32x4 qv[4];
#pragma unroll
    for (int t = 0; t < 4; ++t) qv[t] = *(const f32x4*)(qs + t * 256 + lane * 4);
    for (int m0 = w; m0 < 256; m0 += 64) { f32x4 kv[8];
#pragma unroll
        for (int i = 0; i < 8; ++i) kv[i] = *(const f32x4*)(pk->cache_k + ((size_t)(sbi * 256 + m0 + 8 * i) * 4 + head) * 256 + lane * 4);
        float v32[32];
#pragma unroll
        for (int i = 0; i < 8; ++i)
#pragma unroll
            for (int t = 0; t < 4; ++t) v32[i * 4 + t] = kv[i][0] * qv[t][0] + kv[i][1] * qv[t][1] + kv[i][2] * qv[t][2] + kv[i][3] * qv[t][3];
        float v16[16], v8[8], v4[4], v2[2];
        { const bool up = (lane & 32) != 0;
#pragma unroll
          for (int i = 0; i < 16; ++i) { const float keep = up ? v32[i + 16] : v32[i], send = up ? v32[i] : v32[i + 16]; v16[i] = keep + shx(send, 32, lane); } }
        { const bool up = (lane & 16) != 0;
#pragma unroll
          for (int i = 0; i < 8; ++i) { const float keep = up ? v16[i + 8] : v16[i], send = up ? v16[i] : v16[i + 8]; v8[i] = keep + shx(send, 16, lane); } }
        { const bool up = (lane & 8) != 0;
#pragma unroll
          for (int i = 0; i < 4; ++i) { const float keep = up ? v8[i + 4] : v8[i], send = up ? v8[i] : v8[i + 4]; v4[i] = keep + shx(send, 8, lane); } }
        { const bool up = (lane & 4) != 0;
#pragma unroll
          for (int i = 0; i < 2; ++i) { const float keep = up ? v4[i + 2] : v4[i], send = up ? v4[i] : v4[i + 2]; v2[i] = keep + shx(send, 4, lane); } }
        float v1; { const bool up = (lane & 2) != 0; const float keep = up ? v2[1] : v2[0], send = up ? v2[0] : v2[1]; v1 = keep + shx(send, 2, lane); }
        v1 += shx(v1, 1, lane);
        if ((lane & 1) == 0) { const int ii = lane >> 1; sc[(ii & 3) * 256 + m0 + 8 * (ii >> 2)] = v1 * 0.0625f; } }
    __syncthreads();
    if (w < 4) { const f32x4 v = *(const f32x4*)(sc + w * 256 + lane * 4); float mx = fmaxf(fmaxf(v[0], v[1]), fmaxf(v[2], v[3])); mx = wave_max(mx, lane);
        f32x4 e; e[0] = __expf(v[0] - mx); e[1] = __expf(v[1] - mx); e[2] = __expf(v[2] - mx); e[3] = __expf(v[3] - mx); float s = wave_sum(e[0] + e[1] + e[2] + e[3], lane); const float inv = 1.f / s;
        *(f32x4*)(sc + w * 256 + lane * 4) = e * inv; }
    __syncthreads();
    f32x4 acc[4];
#pragma unroll
    for (int t = 0; t < 4; ++t) acc[t] = (f32x4){0.f, 0.f, 0.f, 0.f};
    for (int m0 = w; m0 < 256; m0 += 64) { f32x4 vv[8];
#pragma unroll
        for (int i = 0; i < 8; ++i) vv[i] = *(const f32x4*)(pk->cache_v + ((size_t)(sbi * 256 + m0 + 8 * i) * 4 + head) * 256 + lane * 4);
#pragma unroll
        for (int i = 0; i < 8; ++i)
#pragma unroll
            for (int t = 0; t < 4; ++t) acc[t] += vv[i] * sc[t * 256 + m0 + 8 * i]; }
#pragma unroll
    for (int t = 0; t < 4; ++t) *(f32x4*)(ored + (w * 4 + t) * 256 + lane * 4) = acc[t];
    __syncthreads();
    for (int idx = tid; idx < 1024; idx += 512) { const int t = idx >> 8, d = idx & 255; float s = 0.f;
#pragma unroll
        for (int ww = 0; ww < 8; ++ww) s += ored[(ww * 4 + t) * 256 + d];
        const size_t tok = (size_t)(NTOKP + sbi * 4 + t); const float gate = bf2f(proj[tok * NPROJ + C_XG + head * 256 + d]); mix[tok * DMIX + 2048 + head * 256 + d] = f2bf(s * siluf(gate)); }
}

DI void ssds_item(KP pk_in, unsigned char* lds, int sbi, int g) {
    KP pk = pk_in; asm volatile("" : "+s"(pk));
    unsigned char* ws = pk->ws;
    const int tid = otid(), w = tid >> 6, lane = tid & 63;
    const bf16_t* proj = (const bf16_t*)(ws + W_PROJ); bf16_t* mix = (bf16_t*)(ws + W_MIX); const float* wdf = (const float*)(ws + W_WDTF);
    float* xs = (float*)lds; float* Bs = xs + 2048; float* Cs = Bs + 512; float* yg = Cs + 512; float* dts = yg + 2048; float* decs = dts + 32;
    __syncthreads();
#pragma unroll
    for (int d = 0; d < 4; ++d) { const int pi = w * 4 + d, t = pi & 3, hl = pi >> 2, h = 8 * g + hl; float s = 0.f;
#pragma unroll
        for (int i = 0; i < 4; ++i) { const f32x4 xv = *(const f32x4*)(pk->x_sample + (size_t)(sbi * 4 + t) * 1024 + i * 256 + lane * 4), wv = *(const f32x4*)(wdf + h * 1024 + i * 256 + lane * 4);
            s += xv[0] * wv[0] + xv[1] * wv[1] + xv[2] * wv[2] + xv[3] * wv[3]; }
        s = wave_sum(s, lane);
        if (lane == 0) { const float dt = softplusf(s + pk->ssd_dt_bias[h]); dts[t * 8 + hl] = dt; decs[t * 8 + hl] = __expf(-dt * __expf(pk->ssd_a_log[h])); } }
    for (int idx = tid; idx < 4 * 768; idx += 512) { const int t = idx / 768, cc = idx % 768; const int ch = cc < 512 ? g * 512 + cc : (cc < 640 ? 1024 + g * 128 + (cc - 512) : 1280 + g * 128 + (cc - 640));
        float acc = pk->ssd_conv_b[ch];
#pragma unroll
        for (int kk = 0; kk < 4; ++kk) { const int ui = t + kk; const bool st = ui < 3;
            const float xs_ = pk->state_ssd_conv[(size_t)(sbi * 3 + (st ? ui : 2)) * 1536 + ch]; const float xp_ = bf2f(proj[(size_t)(NTOKP + sbi * 4 + (st ? 0 : ui - 3)) * NPROJ + C_XBC + ch]);
            acc += (st ? xs_ : xp_) * pk->ssd_conv_w[kk * 1536 + ch]; }
        const float a = siluf(acc);
        if (cc < 512) xs[t * 512 + cc] = a; else if (cc < 640) Bs[t * 128 + cc - 512] = a; else Cs[t * 128 + cc - 640] = a; }
    for (int idx = tid; idx < 3 * 768; idx += 512) { const int jj = idx / 768, cc = idx % 768; const int ch = cc < 512 ? g * 512 + cc : (cc < 640 ? 1024 + g * 128 + (cc - 512) : 1280 + g * 128 + (cc - 640));
        pk->out[O_SCS + (size_t)(sbi * 3 + jj) * 1536 + ch] = bf2f(proj[(size_t)(NTOKP + sbi * 4 + 1 + jj) * NPROJ + C_XBC + ch]); }
    __syncthreads();
    const int pp = tid >> 3, n0 = (tid & 7) * 16;
    f32x4 hs[4], hn[4];
#pragma unroll
    for (int v = 0; v < 4; ++v) hn[v] = *(const f32x4*)(pk->state_ssd_h + ((size_t)(sbi * 16 + 8 * g) * 64 + pp) * 128 + n0 + v * 4);
    for (int hl = 0; hl < 8; ++hl) { const int h = 8 * g + hl; const size_t so = ((size_t)(sbi * 16 + h) * 64 + pp) * 128 + n0;
#pragma unroll
        for (int v = 0; v < 4; ++v) hs[v] = hn[v];
        if (hl < 7) {
#pragma unroll
            for (int v = 0; v < 4; ++v) hn[v] = *(const f32x4*)(pk->state_ssd_h + so + 8192 + v * 4); }
        const float dsk = pk->ssd_d[h];
#pragma unroll
        for (int t = 0; t < 4; ++t) { const float dec = decs[t * 8 + hl], xv = xs[t * 512 + hl * 64 + pp], dtx = dts[t * 8 + hl] * xv; float part = 0.f;
#pragma unroll
            for (int v = 0; v < 4; ++v) { const f32x4 bv = *(const f32x4*)(Bs + t * 128 + n0 + v * 4), cv = *(const f32x4*)(Cs + t * 128 + n0 + v * 4);
                hs[v] = hs[v] * dec + bv * dtx; part += cv[0] * hs[v][0] + cv[1] * hs[v][1] + cv[2] * hs[v][2] + cv[3] * hs[v][3]; }
            part += shx(part, 1, lane); part += shx(part, 2, lane); part += shx(part, 4, lane);
            if ((tid & 7) == 0) { const float y = part + dsk * xv; const float z = bf2f(proj[(size_t)(NTOKP + sbi * 4 + t) * NPROJ + C_Z + h * 64 + pp]); yg[t * 512 + hl * 64 + pp] = y * siluf(z); } }
#pragma unroll
        for (int v = 0; v < 4; ++v) *(f32x4*)(pk->out + O_SHS + so + v * 4) = hs[v];
    }
    __syncthreads();
    if (w < 4) { const int t = w; float ss = 0.f; float v[8];
#pragma unroll
        for (int e = 0; e < 8; ++e) { v[e] = yg[t * 512 + e * 64 + lane]; ss += v[e] * v[e]; }
        ss = wave_sum(ss, lane); const float rstd = rsqrtf(ss * (1.f / 512.f) + 1e-5f);
#pragma unroll
        for (int e = 0; e < 8; ++e) { const int cc = e * 64 + lane; mix[(size_t)(NTOKP + sbi * 4 + t) * DMIX + 1024 + g * 512 + cc] = f2bf(v[e] * rstd * pk->ssd_norm_g[g * 512 + cc]); } }
}

DI void ssd3_item(KP pk_in, unsigned char* lds, int b, int c, int g) {
    KP pk = pk_in; asm volatile("" : "+s"(pk));
    unsigned char* ws = pk->ws;
    const int tid = otid(), w = tid >> 6, lane = tid & 63, l15 = lane & 15, q = lane >> 4;
    float* acum_s = (float*)lds; float* cf_s = acum_s + 1024; float* dt_s = cf_s + 1024; float* rstd_s = dt_s + 1024;
    bf16_t* xT = (bf16_t*)(lds + 12800);
    bf16_t* hS = (bf16_t*)(lds + 30208);
    const bf16_t* proj = (const bf16_t*)(ws + W_PROJ); const bf16_t* xact = (const bf16_t*)(ws + W_XACT); bf16_t* mix = (bf16_t*)(ws + W_MIX);
    const float* dt_g = (const float*)(ws + W_DT); const float* acum_g = (const float*)(ws + W_ACUM); const float* st_g = (const float*)(ws + W_ST);
    const int tok0 = b * 2048 + c * 128;
    __syncthreads();
    for (int idx = tid; idx < 1024; idx += 512) { const int j = idx >> 3, hl = idx & 7; acum_s[idx] = acum_g[(size_t)(tok0 + j) * 16 + 8 * g + hl]; }
    const int xj = tid >> 3, xpv = (tid & 7) * 8;
    const int hp_ = tid >> 3, hn0 = (tid & 7) * 16;
    u32x4 xr[2]; f32x4 hr[4]; bf16_t zr[16];
#define S3_LOAD(HL) do { const int h_ = 8 * g + (HL); \
        xr[0] = *(const u32x4*)(xact + (size_t)(tok0 + xj) * 1536 + g * 512 + (HL) * 64 + xpv); xr[1] = *(const u32x4*)(xact + (size_t)(tok0 + xj + 64) * 1536 + g * 512 + (HL) * 64 + xpv); \
        { const float* hp0 = st_g + ((size_t)((b * 16 + c) * 16 + h_) * 64 + hp_) * 128 + hn0; _Pragma("unroll") for (int v = 0; v < 4; ++v) hr[v] = *(const f32x4*)(hp0 + 4 * v); } \
        _Pragma("unroll") for (int pt = 0; pt < 4; ++pt) _Pragma("unroll") for (int r = 0; r < 4; ++r) zr[pt * 4 + r] = proj[(size_t)(tok0 + 16 * w + 4 * q + r) * NPROJ + C_Z + h_ * 64 + 16 * pt + l15]; } while (0)
    S3_LOAD(0);
    bf16x8 cf[4];
#pragma unroll
    for (int ks = 0; ks < 4; ++ks) cf[ks] = *(const bf16x8*)(xact + (size_t)(tok0 + 16 * w + l15) * 1536 + 1280 + g * 128 + ks * 32 + q * 8);
    f32x4 cbt[8];
#pragma unroll
    for (int jt = 0; jt < 8; ++jt) { cbt[jt] = (f32x4){0.f, 0.f, 0.f, 0.f};
        if (jt <= w) {
#pragma unroll
            for (int ks = 0; ks < 4; ++ks) { const bf16x8 bfr = *(const bf16x8*)(xact + (size_t)(tok0 + 16 * jt + l15) * 1536 + 1024 + g * 128 + ks * 32 + q * 8); cbt[jt] = MFMA16(bfr, cf[ks], cbt[jt]); } } }
    __syncthreads();
    for (int idx = tid; idx < 1024; idx += 512) { const int j = idx >> 3, hl = idx & 7; const float dtv = dt_g[(size_t)(tok0 + j) * 16 + 8 * g + hl]; dt_s[idx] = dtv; cf_s[idx] = __expf(acum_s[(j | 15) * 8 + hl] - acum_s[idx]) * dtv; }
    float ssq[4] = {0.f, 0.f, 0.f, 0.f};
    const int irow = 16 * w + l15;
    for (int hl = 0; hl < 8; ++hl) { const int h = 8 * g + hl;
        __syncthreads();
        { const bf16_t* e0 = (const bf16_t*)&xr[0]; const bf16_t* e1 = (const bf16_t*)&xr[1]; (void)e0; (void)e1;
          const unsigned xw[2][4] = {{xr[0].x, xr[0].y, xr[0].z, xr[0].w}, {xr[1].x, xr[1].y, xr[1].z, xr[1].w}};
#pragma unroll
          for (int hh = 0; hh < 2; ++hh)
#pragma unroll
              for (int e = 0; e < 4; ++e) { xT[(xpv + 2 * e) * 136 + xj + 64 * hh] = (bf16_t)(xw[hh][e] & 0xFFFF); xT[(xpv + 2 * e + 1) * 136 + xj + 64 * hh] = (bf16_t)(xw[hh][e] >> 16); }
          float m0[8] = {hr[0][0], hr[0][1], hr[0][2], hr[0][3], hr[1][0], hr[1][1], hr[1][2], hr[1][3]}, m1[8] = {hr[2][0], hr[2][1], hr[2][2], hr[2][3], hr[3][0], hr[3][1], hr[3][2], hr[3][3]};
          *(u32x4*)(hS + hp_ * 136 + hn0) = pack8(m0); *(u32x4*)(hS + hp_ * 136 + hn0 + 8) = pack8(m1); }
        float zz[16];
#pragma unroll
        for (int e = 0; e < 16; ++e) zz[e] = bf2f(zr[e]);
        __syncthreads();
        if (hl < 7) S3_LOAD(hl + 1);
        const float ai = acum_s[irow * 8 + hl];
        bf16x8 af[4];
#pragma unroll
        for (int s = 0; s < 4; ++s) { float m8[8];
#pragma unroll
            for (int hf = 0; hf < 2; ++hf) { const int jt = 2 * s + hf;
                const float rf = jt < w ? __expf(ai - acum_s[(16 * jt + 15) * 8 + hl]) : 0.f;
#pragma unroll
                for (int r = 0; r < 4; ++r) { const int j = 16 * jt + 4 * q + r; float val = 0.f;
                    if (jt < w) val = cbt[jt][r] * rf * cf_s[j * 8 + hl];
                    else if (jt == w && j <= irow) val = cbt[jt][r] * __expf(ai - acum_s[j * 8 + hl]) * dt_s[j * 8 + hl];
                    m8[hf * 4 + r] = val; } }
            af[s] = as_frag(pack8(m8)); }
        const float dsk = pk->ssd_d[h];
        float ea[4];
#pragma unroll
        for (int r = 0; r < 4; ++r) ea[r] = __expf(acum_s[(16 * w + 4 * q + r) * 8 + hl]);
#pragma unroll
        for (int pt = 0; pt < 4; ++pt) { f32x4 yd = {0.f, 0.f, 0.f, 0.f}, yo = {0.f, 0.f, 0.f, 0.f};
            const bf16_t* xrw = xT + (16 * pt + l15) * 136;
#pragma unroll
            for (int s = 0; s < 4; ++s) if (2 * s <= w) { const u32x2 lo = *(const u32x2*)(xrw + 32 * s + 4 * q), hi = *(const u32x2*)(xrw + 32 * s + 16 + 4 * q); yd = MFMA16(af[s], frag2(lo, hi), yd); }
            const bf16_t* hrw = hS + (16 * pt + l15) * 136 + q * 8;
#pragma unroll
            for (int ks = 0; ks < 4; ++ks) { const bf16x8 hf = *(const bf16x8*)(hrw + ks * 32); yo = MFMA16(cf[ks], hf, yo); }
            const u32x2 xv2 = *(const u32x2*)(xrw + 16 * w + 4 * q); const float xv[4] = {bflo(xv2.x), bfhi(xv2.x), bflo(xv2.y), bfhi(xv2.y)};
#pragma unroll
            for (int r = 0; r < 4; ++r) { const size_t tok = (size_t)(tok0 + 16 * w + 4 * q + r); const int pp = 16 * pt + l15;
                const float y = yd[r] + ea[r] * yo[r] + dsk * xv[r]; const float val = y * siluf(zz[pt * 4 + r]);
                ssq[r] += val * val; mix[tok * DMIX + 1024 + g * 512 + hl * 64 + pp] = f2bf(val); } }
    }
#pragma unroll
    for (int r = 0; r < 4; ++r) { float sv = ssq[r]; sv += shx(sv, 1, lane); sv += shx(sv, 2, lane); sv += shx(sv, 4, lane); sv += shx(sv, 8, lane); if (l15 == 0) rstd_s[16 * w + 4 * q + r] = rsqrtf(sv * (1.f / 512.f) + 1e-5f); }
    asm volatile("s_waitcnt vmcnt(0)" ::: "memory");
    __syncthreads();
    for (int idx = tid; idx < 128 * 64; idx += 512) { const int row = idx >> 6, c8 = (idx & 63) * 8; bf16_t* mp = mix + (size_t)(tok0 + row) * DMIX + 1024 + g * 512 + c8;
        const u32x4 v = *(const u32x4*)mp; float x[8]; unpack8(v, x); const float rs = rstd_s[row];
        const f32x4 g0 = *(const f32x4*)(pk->ssd_norm_g + g * 512 + c8), g1 = *(const f32x4*)(pk->ssd_norm_g + g * 512 + c8 + 4);
        x[0] *= rs * g0[0]; x[1] *= rs * g0[1]; x[2] *= rs * g0[2]; x[3] *= rs * g0[3]; x[4] *= rs * g1[0]; x[5] *= rs * g1[1]; x[6] *= rs * g1[2]; x[7] *= rs * g1[3];
        *(u32x4*)mp = pack8(x); }
#undef S3_LOAD
}

DI void outs_item(KP pk_in, unsigned char* lds, int piece) {
    KP pk = pk_in; asm volatile("" : "+s"(pk));
    const int tid = otid(), w = tid >> 6, lane = tid & 63, l15 = lane & 15, q = lane >> 4;
    const int rg = piece >> 4, cgp = piece & 15;
    const bf16_t* mix = (const bf16_t*)(pk->ws + W_MIX); const bf16_t* wo = (const bf16_t*)(pk->ws + W_WOUTT); float* res = (float*)(pk->ws + W_RES);
    float* part = (float*)lds;
    f32x4 acc[2][4];
#pragma unroll
    for (int mt = 0; mt < 2; ++mt)
#pragma unroll
        for (int nt = 0; nt < 4; ++nt) acc[mt][nt] = (f32x4){0.f, 0.f, 0.f, 0.f};
    const bf16_t* ap = mix + (size_t)(NTOKP + rg * 32 + l15) * DMIX + w * 384 + q * 8;
    const bf16_t* bp = wo + (size_t)(cgp * 64 + l15) * 3072 + w * 384 + q * 8;
#pragma unroll 4
    for (int ks = 0; ks < 12; ++ks) { bf16x8 a[2], bb[4];
#pragma unroll
        for (int mt = 0; mt < 2; ++mt) a[mt] = *(const bf16x8*)(ap + (size_t)mt * 16 * DMIX + ks * 32);
#pragma unroll
        for (int nt = 0; nt < 4; ++nt) bb[nt] = *(const bf16x8*)(bp + (size_t)nt * 16 * 3072 + ks * 32);
#pragma unroll
        for (int mt = 0; mt < 2; ++mt)
#pragma unroll
            for (int nt = 0; nt < 4; ++nt) acc[mt][nt] = MFMA16(a[mt], bb[nt], acc[mt][nt]); }
    __syncthreads();
#pragma unroll
    for (int mt = 0; mt < 2; ++mt)
#pragma unroll
        for (int nt = 0; nt < 4; ++nt)
#pragma unroll
            for (int r = 0; r < 4; ++r) part[(w * 32 + mt * 16 + 4 * q + r) * 64 + nt * 16 + l15] = acc[mt][nt][r];
    __syncthreads();
    { const int row = tid >> 4, c4 = (tid & 15) * 4; f32x4 sum = {0.f, 0.f, 0.f, 0.f};
#pragma unroll
      for (int ww = 0; ww < 8; ++ww) sum += *(const f32x4*)(part + (ww * 32 + row) * 64 + c4);
      const int srow = rg * 32 + row, col = cgp * 64 + c4; const f32x4 xv = *(const f32x4*)(pk->x_sample + (size_t)srow * 1024 + col);
      *(f32x4*)(res + (size_t)(NTOKP + srow) * 1024 + col) = sum + xv * 1.189207115002721f; }
    __syncthreads();
}

DI void ln_rows(KP pk_in) {
    KP pk = pk_in; asm volatile("" : "+s"(pk));
    const float* res = (const float*)(pk->ws + W_RES);
    const int tid = otid(); const int lane = tid & 63; const int gw = obid() * 8 + (tid >> 6), nw = gridDim.x * 8;
    f32x4 gg[4], bb[4];
#pragma unroll
    for (int i = 0; i < 4; ++i) { gg[i] = *(const f32x4*)(pk->ln_g + i * 256 + lane * 4); bb[i] = *(const f32x4*)(pk->ln_b + i * 256 + lane * 4); }
    for (int row = gw; row < NTOK; row += nw) { f32x4 v[4]; float s = 0.f;
#pragma unroll
        for (int i = 0; i < 4; ++i) { v[i] = *(const f32x4*)(res + (size_t)row * 1024 + i * 256 + lane * 4); s += v[i][0] + v[i][1] + v[i][2] + v[i][3]; }
        const float mu = wave_sum(s, lane) * (1.f / 1024.f); float s2 = 0.f;
#pragma unroll
        for (int i = 0; i < 4; ++i) { v[i] = v[i] - mu; s2 += v[i][0] * v[i][0] + v[i][1] * v[i][1] + v[i][2] * v[i][2] + v[i][3] * v[i][3]; }
        const float rstd = rsqrtf(wave_sum(s2, lane) * (1.f / 1024.f) + 1e-5f);
#pragma unroll
        for (int i = 0; i < 4; ++i) *(f32x4*)(pk->out + (size_t)row * 1024 + i * 256 + lane * 4) = v[i] * rstd * gg[i] + bb[i]; }
}

__global__ void __launch_bounds__(512, 2) hymba_fwd(Params p_unused) {
    KP pk = kparams();
    extern __shared__ __attribute__((aligned(16))) unsigned char shm[];
    cg::grid_group grid = cg::this_grid();
    const int G = gridDim.x;
    if (threadIdx.x < 4) ((volatile LAS unsigned*)(LAS unsigned char*)shm)[32768 + threadIdx.x] = 0u;
    __syncthreads();
    const int ph_lo_chk = pk->ph_lo;
    XcdBarrier xb = xcd_barrier_post((unsigned*)(pk->ws + W_BAR), (volatile LAS unsigned*)(LAS unsigned char*)shm + 32768);
    if (ph_lo_chk < 0) grid.sync();
    { KP pk = kparams(); for (int rep = 0; rep < REP0; ++rep) phase_prep(pk, shm); }
    xcd_barrier(xb);
    { KP pk = kparams(); const int bid = obid();
      for (int rep = 0; rep < REP1; ++rep) {
        { pg8::Gemm g; g.A = (const bf16_t*)(pk->ws + W_XB); g.Bt = (const bf16_t*)(pk->ws + W_WINT); g.M = NTOK; g.N = NPROJ; g.K = 1024;
          pg8::StaticOrder S; S.init(g.M, g.N, G, bid); pg8::EpiBf16 E; E.O = (bf16_t*)(pk->ws + W_PROJ); E.ldc = NPROJ;
          pg8::gemm_phase<pg8::EpiBf16, pg8::StaticOrder>((LAS unsigned char*)shm, g, S, E); }
        { pg8::Gemm g; g.A = (const bf16_t*)(pk->ws + W_MEMB); g.Bt = (const bf16_t*)(pk->ws + W_WKVT); g.M = 2048; g.N = 2048; g.K = 1024;
          const int shift = (66 * 26) % G; pg8::StaticOrder S; S.init(g.M, g.N, G, (bid + G - shift) % G);
          pg8::EpiKV E; E.mk = pk->out + O_MKP; E.mv = pk->out + O_MVP; E.kb = (bf16_t*)(pk->ws + W_KB); E.vt = (bf16_t*)(pk->ws + W_VT);
          pg8::gemm_phase<pg8::EpiKV, pg8::StaticOrder>((LAS unsigned char*)shm, g, S, E); } } }
    xcd_barrier(xb);
    { KP pk = kparams(); const int bid = obid();
      for (int rep = 0; rep < REP2; ++rep) for (int it = bid; it < 384; it += G) { if (it < 256) ssd1_item(pk, shm, it >> 5, (it >> 1) & 15, it & 1); else rgconv_item(pk, (it - 256) >> 4, (it - 256) & 15); } }
    xcd_barrier(xb);
    { KP pk = kparams(); const int bid = obid();
      for (int rep = 0; rep < REP3; ++rep) for (int kk = 0; kk < 8; ++kk) { const int kq = kk; const int it = bid + kq * G;
          if (it >= 1920) continue;
          if (rep > 0 && (it < R3LO || it >= R3HI)) continue;
          if (it < 256) rg_item(pk, shm, false, it >> 5, (it >> 2) & 7, it & 3);
          else if (it < 512) statepass_item(pk, it - 256);
          else if (it < 640) { const int u = it - 512; rg_item(pk, shm, true, u >> 5, (u >> 2) & 7, u & 3); }
          else if (it < 896) { const int u = it - 640; ssds_item(pk, shm, u >> 1, u & 1); }
          else if (it < 1408) { const int u = it - 896; attns_item(pk, shm, u >> 2, u & 3); }
          else { const int u = it - 1408; attnp_item(pk, shm, u >> 6, (u >> 4) & 3, u & 15); } } }
    xcd_barrier(xb);
    { KP pk = kparams(); const int bid = obid();
      for (int rep = 0; rep < REP4; ++rep) for (int it = bid; it < 256; it += G) ssd3_item(pk, shm, it >> 5, (it >> 1) & 15, it & 1); }
    xcd_barrier(xb);
    { KP pk = kparams(); const int bid = obid();
      for (int rep = 0; rep < REP5; ++rep) {
        for (int it = bid; it < 256; it += G) outs_item(pk, shm, it);
        pg8::Gemm g; g.A = (const bf16_t*)(pk->ws + W_MIX); g.Bt = (const bf16_t*)(pk->ws + W_WOUTT); g.M = NTOKP; g.N = 1024; g.K = 3072;
        pg8::StaticOrder S; S.init(g.M, g.N, G, bid); pg8::EpiRes E; E.res = (float*)(pk->ws + W_RES); E.xp = pk->x_prompt; E.xs = pk->x_sample; E.alpha = 1.189207115002721f;
        pg8::gemm_phase<pg8::EpiRes, pg8::StaticOrder>((LAS unsigned char*)shm, g, S, E); } }
    xcd_barrier(xb);
    { KP pk = kparams(); for (int rep = 0; rep < REP6; ++rep) ln_rows(pk); }
}

extern "C" void kernel_launch(void* const* d_in, const int* in_sizes, int n_in, void* d_out, int out_size, void* d_ws, size_t ws_size, hipStream_t stream) {
    static int grid_blocks = 0;
    if (!grid_blocks) {
        int dev = 0, cus = 0, per_cu = 0;
        hipGetDevice(&dev);
        hipDeviceGetAttribute(&cus, hipDeviceAttributeMultiprocessorCount, dev);
        if (hipFuncSetAttribute((const void*)hymba_fwd, hipFuncAttributeMaxDynamicSharedMemorySize, LDS_BYTES) != hipSuccess) fprintf(stderr, "hipFuncSetAttribute failed\n");
        hipOccupancyMaxActiveBlocksPerMultiprocessor(&per_cu, (const void*)hymba_fwd, 512, LDS_BYTES);
        if (per_cu < 1) { fprintf(stderr, "occupancy query says %d blocks per CU\n", per_cu); per_cu = 1; }
        grid_blocks = cus * 1;
        if (ws_size < W_END) fprintf(stderr, "workspace too small: %zu < %zu\n", ws_size, (size_t)W_END);
    }
    if (hipMemsetAsync((char*)d_ws + W_BAR, 0, 3456 * 4, stream) != hipSuccess) fprintf(stderr, "memset failed\n");
    Params p{};
    const float** fp = (const float**)&p;
    for (int i = 0; i < 28; ++i) fp[i] = (const float*)d_in[i];
    p.out = (float*)d_out; p.ws = (unsigned char*)d_ws;
    p.ph_lo = 0; p.ph_hi = NPHASE;
    void* args[] = {&p};
    hipError_t e = hipLaunchCooperativeKernel((const void*)hymba_fwd, dim3(grid_blocks), dim3(512), args, LDS_BYTES, stream);
    if (e != hipSuccess) fprintf(stderr, "cooperative launch failed: %s (grid %d)\n", hipGetErrorString(e), grid_blocks);
}
```

```cpp
#include <hip/hip_runtime.h>
#include <hip/hip_cooperative_groups.h>
#include <cstdio>
namespace cg = cooperative_groups;

#ifndef REP2
#define REP2 1
#endif
#ifndef REP3
#define REP3 1
#endif
#ifndef REP4
#define REP4 1
#endif
#ifndef R3LO
#define R3LO 0
#define R3HI 256
#endif
#ifndef REP0
#define REP0 1
#endif
#ifndef REP1
#define REP1 1
#endif
#ifndef REP5
#define REP5 1
#endif
#ifndef REP6
#define REP6 1
#endif
#ifndef REPS
#define REPS 1
#endif
#ifndef PHM
#define PHM 127
#endif
#ifndef N_LAUNCH_PER_PHASE
#define N_LAUNCH_PER_PHASE 0
#endif

#define DI __device__ __forceinline__
#define LAS __attribute__((address_space(3)))
typedef unsigned short bf16_t;
typedef short bf16x8 __attribute__((ext_vector_type(8)));
typedef float f32x4 __attribute__((ext_vector_type(4)));
typedef unsigned u32x4 __attribute__((ext_vector_type(4)));
typedef unsigned u32x2 __attribute__((ext_vector_type(2)));

constexpr int NTOKP = 16384, NTOKS = 512, NTOK = 16896, DM = 1024, NPROJ = 6656, DMIX = 3072, DIN = 6672;
constexpr int C_RGX = 0, C_RGG = 1024, C_XBC = 2048, C_Z = 3584, C_Q = 4608, C_XG = 5632;
constexpr int NPHASE = 7;
constexpr int LDS_BYTES = 131072 + 64;

constexpr size_t O_YP = 0, O_YS = O_YP + (size_t)NTOKP * DM, O_RGCP = O_YS + (size_t)NTOKS * DM, O_RGHP = O_RGCP + 8 * 3 * 1024, O_SCP = O_RGHP + 8 * 1024,
                 O_SHP = O_SCP + 8 * 3 * 1536, O_MKP = O_SHP + (size_t)8 * 16 * 64 * 128, O_MVP = O_MKP + (size_t)2048 * 1024, O_RGCS = O_MVP + (size_t)2048 * 1024,
                 O_RGHS = O_RGCS + (size_t)128 * 3 * 1024, O_SCS = O_RGHS + 128 * 1024, O_SHS = O_SCS + (size_t)128 * 3 * 1536;

constexpr size_t al256(size_t x) { return (x + 255) & ~(size_t)255; }
constexpr size_t W_XB = 0;
constexpr size_t W_WINT = al256(W_XB + (size_t)NTOK * DM * 2);
constexpr size_t W_WDTT = al256(W_WINT + (size_t)NPROJ * DM * 2);
constexpr size_t W_WDTF = al256(W_WDTT + 16 * 1024 * 2);
constexpr size_t W_WOUTT = al256(W_WDTF + 16 * 1024 * 4);
constexpr size_t W_WKVT = al256(W_WOUTT + (size_t)1024 * 3072 * 2);
constexpr size_t W_MEMB = al256(W_WKVT + (size_t)2048 * 1024 * 2);
constexpr size_t W_WGT = al256(W_MEMB + (size_t)2048 * 1024 * 2);
constexpr size_t W_KB = al256(W_WGT + (size_t)8 * 4 * 64 * 128 * 2);
constexpr size_t W_VT = al256(W_KB + (size_t)2048 * 1024 * 2);
constexpr size_t W_XACT = al256(W_VT + (size_t)2048 * 1024 * 2);
constexpr size_t W_DT = al256(W_XACT + (size_t)NTOKP * 1536 * 2);
constexpr size_t W_ACUM = al256(W_DT + (size_t)NTOKP * 16 * 4);
constexpr size_t W_CD = al256(W_ACUM + (size_t)NTOKP * 16 * 4);
constexpr size_t W_ST = al256(W_CD + 8 * 16 * 16 * 4);
constexpr size_t W_MIX = al256(W_ST + (size_t)8 * 16 * 16 * 8192 * 4);
constexpr size_t W_PROJ = al256(W_MIX + (size_t)NTOK * DMIX * 2);
constexpr size_t W_RES = W_PROJ;
constexpr size_t W_BAR = al256(W_PROJ + (size_t)NTOK * NPROJ * 2);
constexpr size_t W_END = al256(W_BAR + 3456 * 4);

struct Params {
    const float *x_prompt, *x_sample, *mem_prompt, *state_rg_conv, *state_rg_h, *state_ssd_conv, *state_ssd_h, *cache_k, *cache_v;
    const float *w_in, *rg_conv_w, *rg_conv_b, *w_rg_a, *b_rg_a, *w_rg_i, *b_rg_i, *rg_lambda, *ssd_conv_w, *ssd_conv_b, *ssd_dt_bias, *ssd_a_log, *ssd_d, *ssd_norm_g,
        *w_mem_k, *w_mem_v, *w_out, *ln_g, *ln_b;
    float* out; unsigned char* ws;
    int ph_lo, ph_hi;
};
typedef const __attribute__((address_space(4))) Params* KP;
DI KP kparams() { KP k = (KP)__builtin_amdgcn_kernarg_segment_ptr(); asm volatile("" : "+s"(k)); return k; }

DI int otid() { int t = threadIdx.x; asm volatile("" : "+v"(t)); return t; }
DI int obid() { int t = blockIdx.x; asm volatile("" : "+s"(t)); return t; }
DI float bf2f(bf16_t b) { return __uint_as_float(((unsigned)b) << 16); }
typedef __bf16 hbf2 __attribute__((ext_vector_type(2)));
typedef float f32x2 __attribute__((ext_vector_type(2)));
DI unsigned pack2(float lo, float hi) { const f32x2 v = {lo, hi}; return __builtin_bit_cast(unsigned, __builtin_convertvector(v, hbf2)); }
DI bf16_t f2bf(float f) { return (bf16_t)(pack2(f, 0.f) & 0xFFFFu); }
DI float bflo(unsigned w) { return __uint_as_float(w << 16); }
DI float bfhi(unsigned w) { return __uint_as_float(w & 0xFFFF0000u); }
DI void unpack8(const u32x4 v, float (&o)[8]) { o[0] = bflo(v.x); o[1] = bfhi(v.x); o[2] = bflo(v.y); o[3] = bfhi(v.y); o[4] = bflo(v.z); o[5] = bfhi(v.z); o[6] = bflo(v.w); o[7] = bfhi(v.w); }
DI u32x4 pack8(const float (&o)[8]) { u32x4 w; w.x = pack2(o[0], o[1]); w.y = pack2(o[2], o[3]); w.z = pack2(o[4], o[5]); w.w = pack2(o[6], o[7]); return w; }
DI bf16x8 as_frag(u32x4 w) { return __builtin_bit_cast(bf16x8, w); }
DI bf16x8 frag2(u32x2 lo, u32x2 hi) { u32x4 w; w.x = lo.x; w.y = lo.y; w.z = hi.x; w.w = hi.y; return __builtin_bit_cast(bf16x8, w); }
DI float shx(float v, int m, int lane) { return __int_as_float(__builtin_amdgcn_ds_bpermute((lane ^ m) << 2, __float_as_int(v))); }
DI float shl(float v, int src) { return __int_as_float(__builtin_amdgcn_ds_bpermute(src << 2, __float_as_int(v))); }
DI float siluf(float x) { return x * __builtin_amdgcn_rcpf(1.f + __expf(-x)); }
DI float sigmf(float x) { return __builtin_amdgcn_rcpf(1.f + __expf(-x)); }
DI float softplusf(float v) { return v > 20.f ? v : __logf(1.f + __expf(v)); }
#define MFMA16(a, b, c) __builtin_amdgcn_mfma_f32_16x16x32_bf16((a), (b), (c), 0, 0, 0)

#define XB_TMO      128
#define XB_XCNT(j)  (256  + 64 * (j))
#define XB_XSUB(j)  (1280 + 64 * (j))
#define XB_XGEN(j)  (2304 + 64 * (j))
#define XB_TOP      3328
#define XB_TOPGEN   3392
#define XCD_BAR_WORDS 3456
#define XB_SPIN_CAP (1u << 20)
DI unsigned xb_ld(unsigned* ptr)              { return __hip_atomic_load(ptr, __ATOMIC_RELAXED, __HIP_MEMORY_SCOPE_AGENT); }
DI unsigned xb_add(unsigned* ptr, unsigned v) { return __hip_atomic_fetch_add(ptr, v, __ATOMIC_RELAXED, __HIP_MEMORY_SCOPE_AGENT); }
DI unsigned xb_xcc_id() { return (unsigned)__builtin_amdgcn_s_getreg((3 << 11) | 20) & 0xFu; }
#define XB_SPIN(cond, bar) do { unsigned _sp = 0; while (cond) { __builtin_amdgcn_s_sleep(1); \
    if ((++_sp & 255u) == 0u) { if (xb_ld(&(bar)[XB_TMO])) break; if (_sp > XB_SPIN_CAP) { atomicAdd(&(bar)[XB_TMO], 1u); break; } } } } while (0)
struct XcdBarrier { unsigned* bar; unsigned x; volatile LAS unsigned* st; };
DI XcdBarrier xcd_barrier_post(unsigned* bar, volatile LAS unsigned* st) {
    XcdBarrier b; b.bar = bar; b.x = xb_xcc_id(); b.st = st;
    if (threadIdx.x == 0) (void)xb_add(&bar[XB_XCNT(b.x)], 1u);
    return b;
}
DI void xcd_barrier_complete(unsigned* bar, unsigned x, unsigned& nloc, unsigned& nx) {
    const unsigned G = gridDim.x * gridDim.y * gridDim.z;
    unsigned sum, cnt, mine, sp = 0u;
    for (;;) {
        sum = 0u; cnt = 0u; mine = 0u;
#pragma unroll
        for (unsigned j = 0; j < 16; ++j) { const unsigned c = xb_ld(&bar[XB_XCNT(j)]); sum += c; cnt += (c > 0u) ? 1u : 0u; mine = (j == x) ? c : mine; }
        if (sum == G) break;
        __builtin_amdgcn_s_sleep(1);
        if ((++sp & 255u) == 0u) { if (xb_ld(&bar[XB_TMO])) break; if (sp > XB_SPIN_CAP) { atomicAdd(&bar[XB_TMO], 1u); break; } }
    }
    nloc = mine > 0u ? mine : 1u; nx = cnt > 0u ? cnt : 1u;
}
DI void xcd_barrier(const XcdBarrier& b) {
    asm volatile("s_waitcnt vmcnt(0)" ::: "memory");
    __syncthreads();
    if (threadIdx.x == 0) {
        unsigned* bar = b.bar;
        __builtin_amdgcn_s_waitcnt(0);
        unsigned nloc = b.st[0], nx = b.st[1];
        if (nloc == 0u) { xcd_barrier_complete(bar, b.x, nloc, nx); b.st[0] = nloc; b.st[1] = nx; }
        const unsigned old = xb_add(&bar[XB_XSUB(b.x)], 1u);
        const unsigned gen = old / nloc;
        if (old + 1u == (gen + 1u) * nloc) {
            __builtin_amdgcn_fence(__ATOMIC_RELEASE, "agent");
            asm volatile("s_waitcnt vmcnt(0)" ::: "memory");
            const unsigned og = xb_add(&bar[XB_TOP], 1u);
            const unsigned tg = og / nx;
            if (og + 1u == (tg + 1u) * nx) xb_add(&bar[XB_TOPGEN], 1u);
            else XB_SPIN(xb_ld(&bar[XB_TOPGEN]) == tg, bar);
            __builtin_amdgcn_fence(__ATOMIC_ACQUIRE, "agent");
            xb_add(&bar[XB_XGEN(b.x)], 1u);
            asm volatile("s_waitcnt vmcnt(0)" ::: "memory");
        } else {
            XB_SPIN(xb_ld(&bar[XB_XGEN(b.x)]) == gen, bar);
            __builtin_amdgcn_fence(__ATOMIC_ACQUIRE, "agent");
            asm volatile("s_waitcnt vmcnt(0)" ::: "memory");
        }
    }
    __syncthreads();
}

namespace pg8 {
constexpr int BM = 256, BK = 64, HALF = 128, HTB = HALF * BK * 2, STAGE_BYTES = 8 * HTB, NXCD = 8, WGM = 8;
DI int lds_byte(int r, int c) { const int st = (r >> 4) * 2 + (c >> 5), rr = r & 15, cc = c & 31, ob = rr * 64 + cc * 2; return st * 1024 + (ob ^ (((ob >> 9) & 1) << 5)); }
DI void stage_rc(int b, int& R, int& C) { const int st = b / 1024, sb = b % 1024, swz = sb ^ (((sb >> 9) & 1) << 5); R = (st >> 1) * 16 + swz / 64; C = (st & 1) * 32 + (swz % 64) / 2; }
DI int perm32(int rho) { const int n = rho >> 4, i = rho & 15; return 8 * (i >> 2) + 4 * n + (i & 3); }
struct Unit { int pm, pn; };
struct Gemm { const bf16_t* A; const bf16_t* Bt; int M, N, K; };
struct StaticOrder {
    int nM, nN, nwg, G, c;
    DI void init(int M, int N, int G_, int c_) { nM = M / BM; nN = N / BM; nwg = nM * nN; G = G_; c = c_; }
    DI bool next(int i, Unit& u) const {
        const long L = (long)i * G + c; if (L >= nwg) return false;
        int wgid = (int)L; { const int q = nwg / NXCD, r = nwg % NXCD, xcd = wgid % NXCD, off = wgid / NXCD; wgid = (xcd < r ? xcd * (q + 1) : r * (q + 1) + (xcd - r) * q) + off; }
        const int nig = WGM * nN, gid = wgid / nig, fm = gid * WGM, gsz = (nM - fm) < WGM ? (nM - fm) : WGM;
        u.pm = fm + ((wgid % nig) % gsz); u.pn = (wgid % nig) / gsz; return true;
    }
};
DI unsigned cvt_pk_bf16(float lo, float hi) { unsigned r; asm volatile("v_cvt_pk_bf16_f32 %0, %1, %2" : "=v"(r) : "v"(lo), "v"(hi)); return r; }

struct EpiBf16 {
    static constexpr bool PERM = true;
    bf16_t* O; int ldc;
    DI void operator()(const f32x4 (&acc)[2][2][4][2], const Unit& u, int wr, int wc, int fr, int fq) const {
        const int row0 = u.pm * BM + wr * 64 + fr; const int col0 = u.pn * BM + wc * 32 + 8 * fq;
#pragma unroll
        for (int ai = 0; ai < 2; ++ai)
#pragma unroll
            for (int m = 0; m < 4; ++m) { bf16_t* rowp = O + (size_t)(row0 + ai * HALF + m * 16) * ldc + col0;
#pragma unroll
                for (int bj = 0; bj < 2; ++bj) { const f32x4 v0 = acc[ai][bj][m][0], v1 = acc[ai][bj][m][1];
                    u32x4 w; w.x = cvt_pk_bf16(v0[0], v0[1]); w.y = cvt_pk_bf16(v0[2], v0[3]); w.z = cvt_pk_bf16(v1[0], v1[1]); w.w = cvt_pk_bf16(v1[2], v1[3]);
                    *(u32x4*)(rowp + bj * HALF) = w; } }
    }
};
struct EpiKV {
    static constexpr bool PERM = false;
    float* mk; float* mv; bf16_t* kb; bf16_t* vt;
    DI void operator()(const f32x4 (&acc)[2][2][4][2], const Unit& u, int wr, int wc, int fr, int fq) const {
        const int row0 = u.pm * BM + wr * 64 + fr, col0 = u.pn * BM + wc * 32 + 4 * fq;
#pragma unroll
        for (int ai = 0; ai < 2; ++ai)
#pragma unroll
            for (int m = 0; m < 4; ++m) { const int row = row0 + ai * HALF + m * 16;
#pragma unroll
                for (int bj = 0; bj < 2; ++bj)
#pragma unroll
                    for (int n = 0; n < 2; ++n) { const int col = col0 + bj * HALF + n * 16; const f32x4 v = acc[ai][bj][m][n];
                        if (col < 1024) { *(f32x4*)(mk + (size_t)row * 1024 + col) = v; u32x2 w; w.x = cvt_pk_bf16(v[0], v[1]); w.y = cvt_pk_bf16(v[2], v[3]); *(u32x2*)(kb + (size_t)row * 1024 + col) = w; }
                        else { const int cc = col - 1024; *(f32x4*)(mv + (size_t)row * 1024 + cc) = v; const int bb = row >> 8, mt = row & 255;
#pragma unroll
                            for (int j = 0; j < 4; ++j) { const int c2 = cc + j, head = c2 >> 8, d = c2 & 255; vt[((size_t)((bb * 4 + head) * 256 + d)) * 256 + mt] = f2bf(v[j]); } } } }
    }
};
struct EpiRes {
    static constexpr bool PERM = false;
    float* res; const float* xp; const float* xs; float alpha;
    DI void operator()(const f32x4 (&acc)[2][2][4][2], const Unit& u, int wr, int wc, int fr, int fq) const {
        const int row0 = u.pm * BM + wr * 64 + fr, col0 = u.pn * BM + wc * 32 + 4 * fq;
#pragma unroll
        for (int ai = 0; ai < 2; ++ai)
#pragma unroll
            for (int m = 0; m < 4; ++m) { const int row = row0 + ai * HALF + m * 16; const float* xr = row < NTOKP ? xp + (size_t)row * 1024 : xs + (size_t)(row - NTOKP) * 1024;
#pragma unroll
                for (int bj = 0; bj < 2; ++bj)
#pragma unroll
                    for (int n = 0; n < 2; ++n) { const int col = col0 + bj * HALF + n * 16; const f32x4 xv = *(const f32x4*)(xr + col);
                        *(f32x4*)(res + (size_t)row * 1024 + col) = acc[ai][bj][m][n] + xv * alpha; } }
    }
};

template <class Epi, class Sched>
DI void gemm_phase(LAS unsigned char* lds, const Gemm g, const Sched& S, const Epi& E) {
    const int tid = otid(), wid = __builtin_amdgcn_readfirstlane(tid >> 6), lane = tid & 63, wr = wid >> 2, wc = wid & 3, fr = lane & 15, fq = lane >> 4;
    const int K = g.K, nt = K / BK;
    unsigned voffA[2], voffB[2];
#pragma unroll
    for (int i = 0; i < 2; ++i) { int R, C; stage_rc(tid * 16 + i * 8192, R, C); const int Rb = Epi::PERM ? ((R & ~31) + perm32(R & 31)) : R;
        voffA[i] = (unsigned)(R * K + C) * 2u; voffB[i] = (unsigned)(Rb * K + C) * 2u; }
    const size_t kstep = (size_t)(BK * 2);
    const size_t hstep = (size_t)HALF * K * 2;
    const size_t tstep = 2 * hstep;
    const unsigned ldsw = (unsigned)wid * 1024u;
    const int aoff = lds_byte(wr * 64 + fr, fq * 8), boff = lds_byte(wc * 32 + fr, fq * 8);
#define PG8_SA(b, h) (((b) * 2 + (h)) * HTB)
#define PG8_SB(b, h) ((4 + (b) * 2 + (h)) * HTB)
#define PG8_STAGE(bufoff, gbase, voff) do { _Pragma("unroll") for (int _i = 0; _i < 2; ++_i) \
        __builtin_amdgcn_global_load_lds((const unsigned*)((const char*)(gbase) + (voff)[_i]), (LAS unsigned*)(lds + (bufoff) + ldsw + _i * 8192), 16, 0, 0); } while (0)
#define PG8_LDA(dst, b, h) do { _Pragma("unroll") for (int m = 0; m < 4; ++m) _Pragma("unroll") for (int k = 0; k < 2; ++k) dst[m][k] = *(const LAS bf16x8*)(lds + PG8_SA(b, h) + aoff + m * 2048 + k * 1024); } while (0)
#define PG8_LDB(dst, b, h) do { _Pragma("unroll") for (int n = 0; n < 2; ++n) _Pragma("unroll") for (int k = 0; k < 2; ++k) dst[n][k] = *(const LAS bf16x8*)(lds + PG8_SB(b, h) + boff + n * 2048 + k * 1024); } while (0)
#define PG8_MMA(ai, bj, At, Bt) do { __builtin_amdgcn_s_setprio(1); _Pragma("unroll") for (int m = 0; m < 4; ++m) _Pragma("unroll") for (int n = 0; n < 2; ++n) _Pragma("unroll") for (int k = 0; k < 2; ++k) \
        acc[ai][bj][m][n] = __builtin_amdgcn_mfma_f32_16x16x32_bf16(Bt[n][k], At[m][k], acc[ai][bj][m][n], 0, 0, 0); __builtin_amdgcn_s_setprio(0); } while (0)
#define PG8_WAIT_V(n) asm volatile("s_waitcnt vmcnt(" #n ")" ::: "memory")
#define PG8_WAIT_L(n) asm volatile("s_waitcnt lgkmcnt(" #n ")" ::: "memory")
#define PG8_BAR __builtin_amdgcn_s_barrier()
#define PG8_SCHED __builtin_amdgcn_sched_barrier(0)
    Unit cur, nxt; int ui = 0;
    if (!S.next(0, cur)) return;
    f32x4 acc[2][2][4][2];
#pragma unroll
    for (int a = 0; a < 2; ++a)
#pragma unroll
        for (int b = 0; b < 2; ++b)
#pragma unroll
            for (int m = 0; m < 4; ++m)
#pragma unroll
                for (int n = 0; n < 2; ++n) acc[a][b][m][n] = (f32x4){0.f, 0.f, 0.f, 0.f};
    bf16x8 At[4][2], B0[2][2], B1[2][2];
    const char* cA = (const char*)g.A + (size_t)cur.pm * tstep; const char* cB = (const char*)g.Bt + (size_t)cur.pn * tstep;
    PG8_STAGE(PG8_SB(0, 0), cB, voffB); PG8_STAGE(PG8_SA(0, 0), cA, voffA); PG8_STAGE(PG8_SB(0, 1), cB + hstep, voffB); PG8_STAGE(PG8_SA(0, 1), cA + hstep, voffA);
    if (wr == 1) PG8_BAR;
    PG8_WAIT_V(4); PG8_BAR;
    PG8_STAGE(PG8_SB(1, 0), cB + kstep, voffB); PG8_STAGE(PG8_SA(1, 0), cA + kstep, voffA); PG8_STAGE(PG8_SB(1, 1), cB + hstep + kstep, voffB);
    PG8_WAIT_V(6); PG8_BAR;
    for (;;) {
        const bool has_next = S.next(ui + 1, nxt);
        const char* nA = has_next ? (const char*)g.A + (size_t)nxt.pm * tstep : cA; const char* nB = has_next ? (const char*)g.Bt + (size_t)nxt.pn * tstep : cB;
        for (int t = 0; t < nt; t += 2) {
            const bool last = (t == nt - 2);
            const char* a1 = cA + (size_t)(t + 1) * kstep;
            const char* a2 = last ? nA : cA + (size_t)(t + 2) * kstep; const char* b2 = last ? nB : cB + (size_t)(t + 2) * kstep;
            const char* a3 = a2 + kstep; const char* b3 = b2 + kstep;
            PG8_LDB(B0, 0, 0); PG8_SCHED; PG8_LDA(At, 0, 0); PG8_STAGE(PG8_SA(1, 1), a1 + hstep, voffA);
            PG8_WAIT_L(8); PG8_BAR; PG8_WAIT_L(0); PG8_MMA(0, 0, At, B0); PG8_BAR; PG8_SCHED;
            PG8_LDB(B1, 0, 1); PG8_STAGE(PG8_SB(0, 0), b2, voffB);
            PG8_BAR; PG8_WAIT_L(0); PG8_MMA(0, 1, At, B1); PG8_BAR;
            PG8_LDA(At, 0, 1); PG8_STAGE(PG8_SA(0, 0), a2, voffA);
            PG8_BAR; PG8_WAIT_L(0); PG8_MMA(1, 0, At, B0); PG8_BAR; PG8_SCHED;
            PG8_STAGE(PG8_SB(0, 1), b2 + hstep, voffB);
            PG8_WAIT_V(6); PG8_BAR; PG8_MMA(1, 1, At, B1); PG8_BAR;
            PG8_LDB(B0, 1, 0); PG8_SCHED; PG8_LDA(At, 1, 0); PG8_STAGE(PG8_SA(0, 1), a2 + hstep, voffA);
            PG8_WAIT_L(8); PG8_BAR; PG8_WAIT_L(0); PG8_MMA(0, 0, At, B0); PG8_BAR; PG8_SCHED;
            PG8_LDB(B1, 1, 1); PG8_STAGE(PG8_SB(1, 0), b3, voffB);
            PG8_BAR; PG8_WAIT_L(0); PG8_MMA(0, 1, At, B1); PG8_BAR;
            PG8_LDA(At, 1, 1); PG8_STAGE(PG8_SA(1, 0), a3, voffA);
            PG8_BAR; PG8_WAIT_L(0); PG8_MMA(1, 0, At, B0); PG8_BAR; PG8_SCHED;
            PG8_STAGE(PG8_SB(1, 1), b3 + hstep, voffB);
            PG8_WAIT_V(6); PG8_BAR; PG8_MMA(1, 1, At, B1); PG8_BAR;
        }
        E(acc, cur, wr, wc, fr, fq);
        if (!has_next) break;
#pragma unroll
        for (int a = 0; a < 2; ++a)
#pragma unroll
            for (int b = 0; b < 2; ++b)
#pragma unroll
                for (int m = 0; m < 4; ++m)
#pragma unroll
                    for (int n = 0; n < 2; ++n) acc[a][b][m][n] = (f32x4){0.f, 0.f, 0.f, 0.f};
        cur = nxt; cA = nA; cB = nB; ++ui;
    }
    PG8_WAIT_V(0);
    if (wr == 0) PG8_BAR;
    PG8_BAR;
#undef PG8_SA
#undef PG8_SB
#undef PG8_STAGE
#undef PG8_LDA
#undef PG8_LDB
#undef PG8_MMA
#undef PG8_WAIT_V
#undef PG8_WAIT_L
#undef PG8_BAR
#undef PG8_SCHED
}
}

DI void tr_tile(const float* src, int ld_src, int k0, int c0, bf16_t* dst, int ld_dst, int n0, float* lds) {
    const int tid = otid();
#pragma unroll
    for (int pass = 0; pass < 2; ++pass) { const int r = pass * 32 + (tid >> 4), c4 = (tid & 15) * 4;
        const f32x4 v = *(const f32x4*)(src + (size_t)(k0 + r) * ld_src + c0 + c4);
        lds[r * 65 + c4 + 0] = v[0]; lds[r * 65 + c4 + 1] = v[1]; lds[r * 65 + c4 + 2] = v[2]; lds[r * 65 + c4 + 3] = v[3]; }
    __syncthreads();
    const int nn = tid >> 3, kc = (tid & 7) * 8;
    float o[8];
#pragma unroll
    for (int e = 0; e < 8; ++e) o[e] = lds[(kc + e) * 65 + nn];
    *(u32x4*)(dst + (size_t)(n0 + nn) * ld_dst + k0 + kc) = pack8(o);
    __syncthreads();
}

DI void phase_prep(KP pk_in, unsigned char* lds) {
    KP pk = pk_in; asm volatile("" : "+s"(pk));
    unsigned char* ws = pk->ws;
    const int bidx_ = obid(); const size_t gtid = (size_t)bidx_ * 512 + otid(), nthr = (size_t)gridDim.x * 512;
    { bf16_t* xb = (bf16_t*)(ws + W_XB);
      for (size_t v = gtid; v < (size_t)NTOK * 128; v += nthr) { const float* s = v < (size_t)NTOKP * 128 ? pk->x_prompt + v * 8 : pk->x_sample + (v - (size_t)NTOKP * 128) * 8;
          const f32x4 a = *(const f32x4*)s, b = *(const f32x4*)(s + 4); float o[8] = {a[0], a[1], a[2], a[3], b[0], b[1], b[2], b[3]}; *(u32x4*)(xb + v * 8) = pack8(o); } }
    { bf16_t* mb = (bf16_t*)(ws + W_MEMB);
      for (size_t v = gtid; v < (size_t)2048 * 128; v += nthr) { const float* s = pk->mem_prompt + v * 8;
          const f32x4 a = *(const f32x4*)s, b = *(const f32x4*)(s + 4); float o[8] = {a[0], a[1], a[2], a[3], b[0], b[1], b[2], b[3]}; *(u32x4*)(mb + v * 8) = pack8(o); } }
    { bf16_t* wd = (bf16_t*)(ws + W_WDTT); float* wf = (float*)(ws + W_WDTF);
      for (size_t i = gtid; i < 16 * 1024; i += nthr) { const int h = (int)(i >> 10), k = (int)(i & 1023); const float v = pk->w_in[(size_t)k * DIN + 4608 + h]; wd[i] = f2bf(v); wf[i] = v; } }
    { bf16_t* wg = (bf16_t*)(ws + W_WGT);
      for (size_t i = gtid; i < (size_t)8 * 4 * 64 * 128; i += nthr) { const int k = (int)(i >> 15), qd = (int)(i >> 13) & 3, nn = (int)(i >> 7) & 63, ii = (int)(i & 127);
          const float v = nn < 32 ? pk->w_rg_a[((size_t)k * 128 + ii) * 128 + qd * 32 + nn] : pk->w_rg_i[((size_t)k * 128 + ii) * 128 + qd * 32 + nn - 32]; wg[i] = f2bf(v); } }
    float* tl = (float*)lds;
    for (int t = bidx_; t < 1664 + 768 + 512; t += gridDim.x) {
        if (t < 1664) { const int kt = t & 15, ntile = t >> 4; const int n0 = ntile * 64, c0 = n0 < 4608 ? n0 : n0 + 16;
            tr_tile(pk->w_in, DIN, kt * 64, c0, (bf16_t*)(ws + W_WINT), 1024, n0, tl); }
        else if (t < 1664 + 768) { const int u = t - 1664; const int kt = u % 48, ntile = u / 48;
            tr_tile(pk->w_out, 1024, kt * 64, ntile * 64, (bf16_t*)(ws + W_WOUTT), 3072, ntile * 64, tl); }
        else { const int u = t - 1664 - 768; const int kt = u & 15, ntile = u >> 4; const int n0 = ntile * 64;
            if (n0 < 1024) tr_tile(pk->w_mem_k, 1024, kt * 64, n0, (bf16_t*)(ws + W_WKVT), 1024, n0, tl);
            else tr_tile(pk->w_mem_v, 1024, kt * 64, n0 - 1024, (bf16_t*)(ws + W_WKVT), 1024, n0, tl); }
    }
}

DI void conv8_ssd_prompt(KP pk, const bf16_t* proj, int rowbase, int t, int ch, float (&o)[8]) {
    const f32x4 b0 = *(const f32x4*)(pk->ssd_conv_b + ch), b1 = *(const f32x4*)(pk->ssd_conv_b + ch + 4);
    float acc[8] = {b0[0], b0[1], b0[2], b0[3], b1[0], b1[1], b1[2], b1[3]};
    u32x4 vv[4];
#pragma unroll
    for (int kk = 0; kk < 4; ++kk) { const int tt = t - 3 + kk; vv[kk] = *(const u32x4*)(proj + (size_t)(rowbase + (tt < 0 ? 0 : tt)) * NPROJ + C_XBC + ch); }
#pragma unroll
    for (int kk = 0; kk < 4; ++kk) { const int tt = t - 3 + kk; const float msk = tt >= 0 ? 1.f : 0.f; float x[8]; unpack8(vv[kk], x);
            const f32x4 w0 = *(const f32x4*)(pk->ssd_conv_w + kk * 1536 + ch) * msk, w1 = *(const f32x4*)(pk->ssd_conv_w + kk * 1536 + ch + 4) * msk;
            acc[0] += x[0] * w0[0]; acc[1] += x[1] * w0[1]; acc[2] += x[2] * w0[2]; acc[3] += x[3] * w0[3];
            acc[4] += x[4] * w1[0]; acc[5] += x[5] * w1[1]; acc[6] += x[6] * w1[2]; acc[7] += x[7] * w1[3]; }
#pragma unroll
    for (int e = 0; e < 8; ++e) o[e] = siluf(acc[e]);
}

DI void ssd1_item(KP pk_in, unsigned char* lds, int b, int c, int g) {
    KP pk = pk_in; asm volatile("" : "+s"(pk));
    unsigned char* ws = pk->ws;
    const int tid = otid(), w = tid >> 6, lane = tid & 63, l15 = lane & 15, q = lane >> 4;
    float* dt_s = (float*)lds; float* acum_s = dt_s + 2048; float* w_s = acum_s + 2048; float* seg_s = w_s + 1024;
    bf16_t* BT = (bf16_t*)(lds + 22528); bf16_t* xsT = (bf16_t*)(lds + 22528 + 34816);
    const bf16_t* xb = (const bf16_t*)(ws + W_XB); const bf16_t* wdt = (const bf16_t*)(ws + W_WDTT); const bf16_t* proj = (const bf16_t*)(ws + W_PROJ);
    bf16_t* xact = (bf16_t*)(ws + W_XACT); float* dt_g = (float*)(ws + W_DT); float* acum_g = (float*)(ws + W_ACUM); float* cd_g = (float*)(ws + W_CD); bf16_t* st_g = (bf16_t*)(ws + W_ST);
    const int tok0 = b * 2048 + c * 128;
    __syncthreads();
    { f32x4 acc = {0.f, 0.f, 0.f, 0.f}; const bf16_t* ap = xb + (size_t)(tok0 + 16 * w + l15) * 1024 + q * 8; const bf16_t* bp = wdt + l15 * 1024 + q * 8;
#pragma unroll 8
      for (int ks = 0; ks < 32; ++ks) { const bf16x8 a = *(const bf16x8*)(ap + ks * 32); const bf16x8 bb = *(const bf16x8*)(bp + ks * 32); acc = MFMA16(a, bb, acc); }
      const float bias = pk->ssd_dt_bias[l15];
#pragma unroll
      for (int r = 0; r < 4; ++r) { const int i = 16 * w + 4 * q + r; const float dt = softplusf(acc[r] + bias); dt_s[i * 16 + l15] = dt; dt_g[(size_t)(tok0 + i) * 16 + l15] = dt; } }
    __syncthreads();
    { const int hd = tid & 15, sg = tid >> 4; const float ah = -__expf(pk->ssd_a_log[hd]); float loc[8]; float run = 0.f;
      if (tid < 256) {
#pragma unroll
          for (int i = 0; i < 8; ++i) { run += dt_s[(sg * 8 + i) * 16 + hd] * ah; loc[i] = run; }
          seg_s[sg * 16 + hd] = run; }
      __syncthreads();
      if (tid < 256) { float off = 0.f; for (int s2 = 0; s2 < sg; ++s2) off += seg_s[s2 * 16 + hd];
#pragma unroll
          for (int i = 0; i < 8; ++i) { const float v = loc[i] + off; acum_s[(sg * 8 + i) * 16 + hd] = v; acum_g[(size_t)(tok0 + sg * 8 + i) * 16 + hd] = v; } } }
    __syncthreads();
    if (tid < 8) cd_g[(b * 16 + c) * 16 + 8 * g + tid] = __expf(acum_s[127 * 16 + 8 * g + tid]);
    for (int idx = tid; idx < 1024; idx += 512) { const int j = idx >> 3, hl = idx & 7, h = 8 * g + hl; w_s[idx] = dt_s[j * 16 + h] * __expf(acum_s[127 * 16 + h] - acum_s[j * 16 + h]); }
    const int cv = (tid & 31) * 8, jg = tid >> 5;
    for (int pass = 0; pass < 3; ++pass) {
        const int ch = pass == 0 ? (cv < 128 ? 1024 + g * 128 + cv : 1280 + g * 128 + (cv - 128)) : g * 512 + (pass - 1) * 256 + cv;
        float wgt[4][8], bs[8];
        { const f32x4 b0 = *(const f32x4*)(pk->ssd_conv_b + ch), b1 = *(const f32x4*)(pk->ssd_conv_b + ch + 4);
          bs[0] = b0[0]; bs[1] = b0[1]; bs[2] = b0[2]; bs[3] = b0[3]; bs[4] = b1[0]; bs[5] = b1[1]; bs[6] = b1[2]; bs[7] = b1[3];
#pragma unroll
          for (int kk = 0; kk < 4; ++kk) { const f32x4 w0 = *(const f32x4*)(pk->ssd_conv_w + kk * 1536 + ch), w1 = *(const f32x4*)(pk->ssd_conv_w + kk * 1536 + ch + 4);
              wgt[kk][0] = w0[0]; wgt[kk][1] = w0[1]; wgt[kk][2] = w0[2]; wgt[kk][3] = w0[3]; wgt[kk][4] = w1[0]; wgt[kk][5] = w1[1]; wgt[kk][6] = w1[2]; wgt[kk][7] = w1[3]; } }
        const bf16_t* src = proj + (size_t)(b * 2048) * NPROJ + C_XBC + ch; const int t0 = c * 128 + jg * 8;
        u32x4 rows[11];
#pragma unroll
        for (int i = 0; i < 11; ++i) { const int tt = t0 - 3 + i; const u32x4 v = *(const u32x4*)(src + (size_t)(tt < 0 ? 0 : tt) * NPROJ); rows[i] = tt < 0 ? (u32x4){0u, 0u, 0u, 0u} : v; }
        if (pass > 0) __syncthreads();
#pragma unroll
        for (int i = 0; i < 8; ++i) { float x0[8], x1[8], x2[8], x3[8]; unpack8(rows[i], x0); unpack8(rows[i + 1], x1); unpack8(rows[i + 2], x2); unpack8(rows[i + 3], x3); float o[8];
#pragma unroll
            for (int e = 0; e < 8; ++e) o[e] = siluf(bs[e] + x0[e] * wgt[0][e] + x1[e] * wgt[1][e] + x2[e] * wgt[2][e] + x3[e] * wgt[3][e]);
            const int j = jg * 8 + i;
            *(u32x4*)(xact + (size_t)(tok0 + j) * 1536 + ch) = pack8(o);
            if (pass == 0) { if (cv < 128) {
#pragma unroll
                for (int e = 0; e < 8; ++e) BT[(cv + e) * 136 + j] = f2bf(o[e]); } }
            else { const float wj = w_s[j * 8 + (pass - 1) * 4 + (cv >> 6)];
#pragma unroll
                for (int e = 0; e < 8; ++e) xsT[(cv + e) * 136 + j] = f2bf(o[e] * wj); } }
        if (pass == 0) continue;
        __syncthreads();
        const int pt = w & 3, nh = w >> 2;
#pragma unroll 1
        for (int hq = 0; hq < 4; ++hq) { const int hl = (pass - 1) * 4 + hq;
            f32x4 acc[4];
#pragma unroll
            for (int nt = 0; nt < 4; ++nt) acc[nt] = (f32x4){0.f, 0.f, 0.f, 0.f};
#pragma unroll
            for (int ks = 0; ks < 4; ++ks) { const bf16x8 a = *(const bf16x8*)(xsT + (hq * 64 + pt * 16 + l15) * 136 + ks * 32 + q * 8);
#pragma unroll
                for (int nt = 0; nt < 4; ++nt) { const bf16x8 bb = *(const bf16x8*)(BT + (nh * 64 + nt * 16 + l15) * 136 + ks * 32 + q * 8); acc[nt] = MFMA16(a, bb, acc[nt]); } }
            bf16_t* sp = st_g + (size_t)(((b * 16 + c) * 16 + 8 * g + hl)) * 8192;
#pragma unroll
            for (int nt = 0; nt < 4; ++nt)
#pragma unroll
                for (int r = 0; r < 4; ++r) sp[(pt * 16 + 4 * q + r) * 128 + nh * 64 + nt * 16 + l15] = f2bf(acc[nt][r]); }
    }
    if (c == 15) {
        for (int idx = tid; idx < 3 * 768; idx += 512) { const int jj = idx / 768, cc = idx % 768; const int ch = cc < 512 ? g * 512 + cc : (cc < 640 ? 1024 + g * 128 + (cc - 512) : 1280 + g * 128 + (cc - 640));
            pk->out[O_SCP + (size_t)(b * 3 + jj) * 1536 + ch] = bf2f(proj[(size_t)(b * 2048 + 2045 + jj) * NPROJ + C_XBC + ch]); }
    }
}

DI void rgconv_item(KP pk_in, int b, int tile) {
    KP pk = pk_in; asm volatile("" : "+s"(pk));
    const int tid = otid();
    const bf16_t* proj = (const bf16_t*)(pk->ws + W_PROJ); bf16_t* mix = (bf16_t*)(pk->ws + W_MIX);
    const int ch = (tid & 127) * 8, t0 = tile * 128 + (tid >> 7) * 32;
    float wgt[4][8], bs[8];
    { const f32x4 b0 = *(const f32x4*)(pk->rg_conv_b + ch), b1 = *(const f32x4*)(pk->rg_conv_b + ch + 4);
      bs[0] = b0[0]; bs[1] = b0[1]; bs[2] = b0[2]; bs[3] = b0[3]; bs[4] = b1[0]; bs[5] = b1[1]; bs[6] = b1[2]; bs[7] = b1[3];
#pragma unroll
      for (int kk = 0; kk < 4; ++kk) { const f32x4 w0 = *(const f32x4*)(pk->rg_conv_w + kk * 1024 + ch), w1 = *(const f32x4*)(pk->rg_conv_w + kk * 1024 + ch + 4);
          wgt[kk][0] = w0[0]; wgt[kk][1] = w0[1]; wgt[kk][2] = w0[2]; wgt[kk][3] = w0[3]; wgt[kk][4] = w1[0]; wgt[kk][5] = w1[1]; wgt[kk][6] = w1[2]; wgt[kk][7] = w1[3]; } }
    const bf16_t* src = proj + (size_t)(b * 2048) * NPROJ + C_RGX + ch;
    u32x4 hist[3];
#pragma unroll
    for (int i = 0; i < 3; ++i) { const int tt = t0 - 3 + i; const u32x4 v = *(const u32x4*)(src + (size_t)(tt < 0 ? 0 : tt) * NPROJ); hist[i] = tt < 0 ? (u32x4){0u, 0u, 0u, 0u} : v; }
    for (int c8 = 0; c8 < 32; c8 += 8) { u32x4 nv[8];
#pragma unroll
        for (int i = 0; i < 8; ++i) nv[i] = *(const u32x4*)(src + (size_t)(t0 + c8 + i) * NPROJ);
#pragma unroll
        for (int i = 0; i < 8; ++i) { float x0[8], x1[8], x2[8], x3[8]; unpack8(hist[0], x0); unpack8(hist[1], x1); unpack8(hist[2], x2); unpack8(nv[i], x3); float acc[8];
#pragma unroll
            for (int e = 0; e < 8; ++e) acc[e] = bs[e] + x0[e] * wgt[0][e] + x1[e] * wgt[1][e] + x2[e] * wgt[2][e] + x3[e] * wgt[3][e];
            *(u32x4*)(mix + (size_t)(b * 2048 + t0 + c8 + i) * DMIX + 1024 + ch) = pack8(acc);
            hist[0] = hist[1]; hist[1] = hist[2]; hist[2] = nv[i]; } }
}

DI void statepass_item(KP pk_in, int sp) {
    KP pk = pk_in; asm volatile("" : "+s"(pk));
    const int b = sp >> 5, h = (sp >> 1) & 15, half = sp & 1; const int e0 = half * 4096 + otid() * 8;
    bf16_t* st_g = (bf16_t*)(pk->ws + W_ST); const float* cd_g = (const float*)(pk->ws + W_CD);
    float run[8] = {0.f, 0.f, 0.f, 0.f, 0.f, 0.f, 0.f, 0.f};
    u32x4 v[16]; float cd[16];
#pragma unroll
    for (int i = 0; i < 16; ++i) { v[i] = *(const u32x4*)(st_g + (size_t)((b * 16 + i) * 16 + h) * 8192 + e0); cd[i] = cd_g[(b * 16 + i) * 16 + h]; }
#pragma unroll
    for (int i = 0; i < 16; ++i) { *(u32x4*)(st_g + (size_t)((b * 16 + i) * 16 + h) * 8192 + e0) = pack8(run); float x[8]; unpack8(v[i], x);
#pragma unroll
        for (int e = 0; e < 8; ++e) run[e] = run[e] * cd[i] + x[e]; }
    float* o = pk->out + O_SHP + (size_t)(b * 16 + h) * 8192 + e0; *(f32x4*)o = (f32x4){run[0], run[1], run[2], run[3]}; *(f32x4*)(o + 4) = (f32x4){run[4], run[5], run[6], run[7]};
}

DI void rg_item(KP pk_in, unsigned char* lds, const bool sample, int bidx, int k, int qd) {
    KP pk = pk_in; asm volatile("" : "+s"(pk));
    unsigned char* ws = pk->ws;
    const int tid = otid(), w = tid >> 6, lane = tid & 63, l15 = lane & 15, q = lane >> 4;
    bf16_t* uA = (bf16_t*)lds;
    float* sa = (float*)(lds + 34816); float* sb = sa + 4096;
    float* segA = sb + 4096; float* segB = segA + 512; float* hcar = segB + 512;
    const bf16_t* proj = (const bf16_t*)(ws + W_PROJ); bf16_t* mix = (bf16_t*)(ws + W_MIX);
    const bf16_t* wg = (const bf16_t*)(ws + W_WGT) + (size_t)((k * 4 + qd) * 64) * 128;
    bf16_t* wS = (bf16_t*)(lds + 73728);
    __syncthreads();
    for (int idx = tid; idx < 1024; idx += 512) { const int n = idx >> 4, c8 = (idx & 15) * 8; *(u32x4*)(wS + n * 136 + c8) = *(const u32x4*)(wg + n * 128 + c8); }
    float ba[2], bi[2], spl[2];
#pragma unroll
    for (int ntl = 0; ntl < 2; ++ntl) { const int ch = k * 128 + qd * 32 + ntl * 16 + l15; ba[ntl] = pk->b_rg_a[ch]; bi[ntl] = pk->b_rg_i[ch]; spl[ntl] = softplusf(-pk->rg_lambda[ch]); }
    __syncthreads();
    if (tid < 32) hcar[tid] = 0.f;
    const int ntiles = sample ? 1 : 16;
    const int crow = tid >> 2, cg0 = (tid & 3) * 32;
    const int cl_s = tid & 31, seg_s = tid >> 5;
    const bf16_t* ug = mix + 1024;
    u32x4 av[4]; bf16_t uv[8];
#define RG_LOADP(TILE) do { const size_t r0 = (size_t)(bidx * 2048 + (TILE) * 128 + 16 * w); \
        _Pragma("unroll") for (int ks = 0; ks < 4; ++ks) av[ks] = *(const u32x4*)(ug + (r0 + l15) * DMIX + k * 128 + ks * 32 + q * 8); \
        _Pragma("unroll") for (int ntl = 0; ntl < 2; ++ntl) _Pragma("unroll") for (int r = 0; r < 4; ++r) uv[ntl * 4 + r] = ug[(r0 + 4 * q + r) * DMIX + k * 128 + qd * 32 + ntl * 16 + l15]; } while (0)
    if (!sample) RG_LOADP(0);
    bf16x8 afr[4]; float uvf[8];
    for (int tile = 0; tile < ntiles; ++tile) {
        __syncthreads();
        float gts[8];
        if (!sample) {
#pragma unroll
          for (int ks = 0; ks < 4; ++ks) afr[ks] = as_frag(av[ks]);
#pragma unroll
          for (int e = 0; e < 8; ++e) uvf[e] = bf2f(uv[e]);
          if (tile + 1 < 16) RG_LOADP(tile + 1);
#pragma unroll
          for (int j = 0; j < 8; ++j) gts[j] = bf2f(proj[(size_t)(bidx * 2048 + tile * 128 + seg_s * 8 + j) * NPROJ + C_RGG + k * 128 + qd * 32 + cl_s]);
        } else { const int row = crow;
#pragma unroll
          for (int v = 0; v < 4; ++v) { const int c8 = cg0 + v * 8, ch = k * 128 + c8;
              const f32x4 b0 = *(const f32x4*)(pk->rg_conv_b + ch), b1 = *(const f32x4*)(pk->rg_conv_b + ch + 4);
              float acc[8] = {b0[0], b0[1], b0[2], b0[3], b1[0], b1[1], b1[2], b1[3]};
#pragma unroll
              for (int kk = 0; kk < 4; ++kk) { float x[8];
                  { const int sbi = bidx * 32 + (row >> 2), ui = (row & 3) + kk; const bool st = ui < 3;
                      const float* s = pk->state_rg_conv + (size_t)(sbi * 3 + (st ? ui : 2)) * 1024 + ch; const f32x4 s0 = *(const f32x4*)s, s1 = *(const f32x4*)(s + 4);
                      const u32x4 vv = *(const u32x4*)(proj + (size_t)(NTOKP + sbi * 4 + (st ? 0 : ui - 3)) * NPROJ + C_RGX + ch); unpack8(vv, x);
                      x[0] = st ? s0[0] : x[0]; x[1] = st ? s0[1] : x[1]; x[2] = st ? s0[2] : x[2]; x[3] = st ? s0[3] : x[3];
                      x[4] = st ? s1[0] : x[4]; x[5] = st ? s1[1] : x[5]; x[6] = st ? s1[2] : x[6]; x[7] = st ? s1[3] : x[7]; }
                  { const f32x4 w0 = *(const f32x4*)(pk->rg_conv_w + kk * 1024 + ch), w1 = *(const f32x4*)(pk->rg_conv_w + kk * 1024 + ch + 4);
                      acc[0] += x[0] * w0[0]; acc[1] += x[1] * w0[1]; acc[2] += x[2] * w0[2]; acc[3] += x[3] * w0[3];
                      acc[4] += x[4] * w1[0]; acc[5] += x[5] * w1[1]; acc[6] += x[6] * w1[2]; acc[7] += x[7] * w1[3]; } }
              *(u32x4*)(uA + row * 136 + c8) = pack8(acc); }
#pragma unroll
          for (int j = 0; j < 8; ++j) gts[j] = bf2f(proj[(size_t)(NTOKP + bidx * 128 + seg_s * 8 + j) * NPROJ + C_RGG + k * 128 + qd * 32 + cl_s]);
        }
        __syncthreads();
        { f32x4 acc[4];
#pragma unroll
          for (int nt = 0; nt < 4; ++nt) acc[nt] = (f32x4){0.f, 0.f, 0.f, 0.f};
#pragma unroll
          for (int ks = 0; ks < 4; ++ks) { const bf16x8 a = sample ? *(const bf16x8*)(uA + (16 * w + l15) * 136 + ks * 32 + q * 8) : afr[ks];
#pragma unroll
              for (int nt = 0; nt < 4; ++nt) { const bf16x8 bb = *(const bf16x8*)(wS + (nt * 16 + l15) * 136 + ks * 32 + q * 8); acc[nt] = MFMA16(a, bb, acc[nt]); } }
#pragma unroll
          for (int ntl = 0; ntl < 2; ++ntl)
#pragma unroll
              for (int r = 0; r < 4; ++r) { const int row = 16 * w + 4 * q + r, cl = ntl * 16 + l15;
                  const float rr = sigmf(acc[ntl][r] + ba[ntl]), ii = sigmf(acc[2 + ntl][r] + bi[ntl]);
                  const float la = -8.f * rr * spl[ntl]; float a = __expf(la); const float uval = sample ? bf2f(uA[row * 136 + qd * 32 + cl]) : uvf[ntl * 4 + r];
                  float bt = __builtin_amdgcn_sqrtf(fmaxf(1.f - a * a, 0.f)) * ii * uval;
                  const bool first = sample ? ((row & 3) == 0) : (tile == 0 && row == 0);
                  if (first) { const float h0 = sample ? pk->state_rg_h[(size_t)(bidx * 32 + (row >> 2)) * 1024 + k * 128 + qd * 32 + cl] : 0.f; bt += a * h0; a = 0.f; }
                  sa[row * 32 + cl] = a; sb[row * 32 + cl] = bt; } }
        __syncthreads();
        const int cl = tid & 31, seg = tid >> 5;
        { float A = 1.f, B = 0.f;
#pragma unroll
          for (int j = 0; j < 8; ++j) { const int row = seg * 8 + j; const float a = sa[row * 32 + cl], bb = sb[row * 32 + cl]; B = a * B + bb; A = a * A; }
          segA[seg * 32 + cl] = A; segB[seg * 32 + cl] = B; }
        __syncthreads();
        float h = hcar[cl];
        for (int s = 0; s < seg; ++s) h = segA[s * 32 + cl] * h + segB[s * 32 + cl];
        const int chg = k * 128 + qd * 32 + cl;
#pragma unroll
        for (int j = 0; j < 8; ++j) { const int row = seg * 8 + j; h = sa[row * 32 + cl] * h + sb[row * 32 + cl];
            const size_t grow = sample ? (size_t)(NTOKP + bidx * 128 + row) : (size_t)(bidx * 2048 + tile * 128 + row);
            mix[grow * DMIX + chg] = f2bf(h * siluf(gts[j]));
            if (sample) { if ((row & 3) == 3) pk->out[O_RGHS + (size_t)(bidx * 32 + (row >> 2)) * 1024 + chg] = h; }
            else if (tile == 15 && row == 127) pk->out[O_RGHP + (size_t)bidx * 1024 + chg] = h; }
        __syncthreads();
        if (seg == 15) hcar[cl] = h;
    }
    if (!sample) { if (tid < 96) { const int jj = tid >> 5, cl = tid & 31, chg = k * 128 + qd * 32 + cl;
            pk->out[O_RGCP + (size_t)(bidx * 3 + jj) * 1024 + chg] = bf2f(proj[(size_t)(bidx * 2048 + 2045 + jj) * NPROJ + C_RGX + chg]); } }
    else { for (int idx = tid; idx < 32 * 3 * 32; idx += 512) { const int cl = idx & 31, jj = (idx >> 5) % 3, sl = idx / 96; const int sbi = bidx * 32 + sl, chg = k * 128 + qd * 32 + cl;
            pk->out[O_RGCS + (size_t)(sbi * 3 + jj) * 1024 + chg] = bf2f(proj[(size_t)(NTOKP + sbi * 4 + 1 + jj) * NPROJ + C_RGX + chg]); } }
}

DI void attnp_item(KP pk_in, unsigned char* lds, int b, int head, int qt) {
    KP pk = pk_in; asm volatile("" : "+s"(pk));
    unsigned char* ws = pk->ws;
    const int tid = otid(), w = tid >> 6, lane = tid & 63, l15 = lane & 15, q = lane >> 4;
    const bf16_t* proj = (const bf16_t*)(ws + W_PROJ); const bf16_t* kb = (const bf16_t*)(ws + W_KB); const bf16_t* vt = (const bf16_t*)(ws + W_VT); bf16_t* mix = (bf16_t*)(ws + W_MIX);
    const int tokb = b * 2048 + qt * 128 + 16 * w;
    constexpr int RS = 264;
    bf16_t* sm = (bf16_t*)lds;
    const int lr = tid >> 5, lc = (tid & 31) * 8;
    const bf16_t* kbase = kb + (size_t)(b * 256) * 1024 + head * 256; const bf16_t* vbase = vt + (size_t)((b * 4 + head) * 256) * 256;
    u32x4 pre[8];
#define AT_LOAD(S) do { _Pragma("unroll") for (int i = 0; i < 8; ++i) { const int r = lr + 16 * i; \
        pre[i] = (S) < 2 ? *(const u32x4*)(kbase + (size_t)(128 * (S) + r) * 1024 + lc) : *(const u32x4*)(vbase + (size_t)(128 * ((S) - 2) + r) * 256 + lc); } } while (0)
#define AT_STORE() do { _Pragma("unroll") for (int i = 0; i < 8; ++i) *(u32x4*)(sm + (lr + 16 * i) * RS + lc) = pre[i]; } while (0)
    AT_LOAD(0);
    bf16x8 qf[8];
#pragma unroll
    for (int ks = 0; ks < 8; ++ks) qf[ks] = *(const bf16x8*)(proj + (size_t)(tokb + l15) * NPROJ + C_Q + head * 256 + ks * 32 + q * 8);
    f32x4 st[16];
#pragma unroll
    for (int s = 0; s < 2; ++s) {
        __syncthreads(); AT_STORE(); __syncthreads(); AT_LOAD(s + 1);
#pragma unroll
        for (int mtl = 0; mtl < 8; ++mtl) { const int mt = 8 * s + mtl; st[mt] = (f32x4){0.f, 0.f, 0.f, 0.f}; const bf16_t* kp = sm + (16 * mtl + l15) * RS + q * 8;
#pragma unroll
            for (int ks = 0; ks < 8; ++ks) { const bf16x8 kf = *(const bf16x8*)(kp + ks * 32); st[mt] = MFMA16(kf, qf[ks], st[mt]); } }
    }
    float mx = -3.0e38f;
#pragma unroll
    for (int mt = 0; mt < 16; ++mt)
#pragma unroll
        for (int r = 0; r < 4; ++r) { st[mt][r] *= 0.0625f; mx = fmaxf(mx, st[mt][r]); }
    mx = fmaxf(mx, shx(mx, 16, lane)); mx = fmaxf(mx, shx(mx, 32, lane));
    float l = 0.f;
#pragma unroll
    for (int mt = 0; mt < 16; ++mt)
#pragma unroll
        for (int r = 0; r < 4; ++r) { const float e = __expf(st[mt][r] - mx); st[mt][r] = e; l += e; }
    l += shx(l, 16, lane); l += shx(l, 32, lane);
    bf16x8 pf[8];
#pragma unroll
    for (int s = 0; s < 8; ++s) { float m8[8] = {st[2 * s][0], st[2 * s][1], st[2 * s][2], st[2 * s][3], st[2 * s + 1][0], st[2 * s + 1][1], st[2 * s + 1][2], st[2 * s + 1][3]}; pf[s] = as_frag(pack8(m8)); }
    float linv[4];
#pragma unroll
    for (int r = 0; r < 4; ++r) linv[r] = 1.f / shl(l, 4 * q + r);
#pragma unroll
    for (int s2 = 0; s2 < 2; ++s2) {
        __syncthreads(); AT_STORE(); __syncthreads(); if (s2 == 0) AT_LOAD(3);
#pragma unroll
        for (int dtl = 0; dtl < 8; ++dtl) { const int dt = 8 * s2 + dtl; f32x4 o = {0.f, 0.f, 0.f, 0.f}; const bf16_t* vp = sm + (16 * dtl + l15) * RS + 4 * q;
            float gt[4];
#pragma unroll
            for (int r = 0; r < 4; ++r) gt[r] = bf2f(proj[(size_t)(tokb + 4 * q + r) * NPROJ + C_XG + head * 256 + 16 * dt + l15]);
#pragma unroll
            for (int s = 0; s < 8; ++s) { const u32x2 lo = *(const u32x2*)(vp + 32 * s), hi = *(const u32x2*)(vp + 32 * s + 16); o = MFMA16(pf[s], frag2(lo, hi), o); }
#pragma unroll
            for (int r = 0; r < 4; ++r) { const size_t tok = (size_t)(tokb + 4 * q + r); const int d = 16 * dt + l15;
                mix[tok * DMIX + 2048 + head * 256 + d] = f2bf(o[r] * linv[r] * siluf(gt[r])); } }
    }
#undef AT_LOAD
#undef AT_STORE
}

DI float wave_sum(float v, int lane) { v += shx(v, 32, lane); v += shx(v, 16, lane); v += shx(v, 8, lane); v += shx(v, 4, lane); v += shx(v, 2, lane); v += shx(v, 1, lane); return v; }
DI float wave_max(float v, int lane) { v = fmaxf(v, shx(v, 32, lane)); v = fmaxf(v, shx(v, 16, lane)); v = fmaxf(v, shx(v, 8, lane)); v = fmaxf(v, shx(v, 4, lane)); v = fmaxf(v, shx(v, 2, lane)); v = fmaxf(v, shx(v, 1, lane)); return v; }

DI void attns_item(KP pk_in, unsigned char* lds, int sbi, int head) {
    KP pk = pk_in; asm volatile("" : "+s"(pk));
    unsigned char* ws = pk->ws;
    const int tid = otid(), w = tid >> 6, lane = tid & 63;
    const bf16_t* proj = (const bf16_t*)(ws + W_PROJ); bf16_t* mix = (bf16_t*)(ws + W_MIX);
    float* qs = (float*)lds; float* sc = qs + 1024; float* ored = sc + 1024;
    __syncthreads();
    for (int idx = tid; idx < 1024; idx += 512) { const int t = idx >> 8, d = idx & 255; qs[idx] = bf2f(proj[(size_t)(NTOKP + sbi * 4 + t) * NPROJ + C_Q + head * 256 + d]); }
    __syncthreads();
    f32x4 qv[4];
#pragma unroll
    for (int t = 0; t < 4; ++t) qv[t] = *(const f32x4*)(qs + t * 256 + lane * 4);
    for (int m0 = w; m0 < 256; m0 += 64) { f32x4 kv[8];
#pragma unroll
        for (int i = 0; i < 8; ++i) kv[i] = *(const f32x4*)(pk->cache_k + ((size_t)(sbi * 256 + m0 + 8 * i) * 4 + head) * 256 + lane * 4);
        float v32[32];
#pragma unroll
        for (int i = 0; i < 8; ++i)
#pragma unroll
            for (int t = 0; t < 4; ++t) v32[i * 4 + t] = kv[i][0] * qv[t][0] + kv[i][1] * qv[t][1] + kv[i][2] * qv[t][2] + kv[i][3] * qv[t][3];
        float v16[16], v8[8], v4[4], v2[2];
        { const bool up = (lane & 32) != 0;
#pragma unroll
          for (int i = 0; i < 16; ++i) { const float keep = up ? v32[i + 16] : v32[i], send = up ? v32[i] : v32[i + 16]; v16[i] = keep + shx(send, 32, lane); } }
        { const bool up = (lane & 16) != 0;
#pragma unroll
          for (int i = 0; i < 8; ++i) { const float keep = up ? v16[i + 8] : v16[i], send = up ? v16[i] : v16[i + 8]; v8[i] = keep + shx(send, 16, lane); } }
        { const bool up = (lane & 8) != 0;
#pragma unroll
          for (int i = 0; i < 4; ++i) { const float keep = up ? v8[i + 4] : v8[i], send = up ? v8[i] : v8[i + 4]; v4[i] = keep + shx(send, 8, lane); } }
        { const bool up = (lane & 4) != 0;
#pragma unroll
          for (int i = 0; i < 2; ++i) { const float keep = up ? v4[i + 2] : v4[i], send = up ? v4[i] : v4[i + 2]; v2[i] = keep + shx(send, 4, lane); } }
        float v1; { const bool up = (lane & 2) != 0; const float keep = up ? v2[1] : v2[0], send = up ? v2[0] : v2[1]; v1 = keep + shx(send, 2, lane); }
        v1 += shx(v1, 1, lane);
        if ((lane & 1) == 0) { const int ii = lane >> 1; sc[(ii & 3) * 256 + m0 + 8 * (ii >> 2)] = v1 * 0.0625f; } }
    __syncthreads();
    if (w < 4) { const f32x4 v = *(const f32x4*)(sc + w * 256 + lane * 4); float mx = fmaxf(fmaxf(v[0], v[1]), fmaxf(v[2], v[3])); mx = wave_max(mx, lane);
        f32x4 e; e[0] = __expf(v[0] - mx); e[1] = __expf(v[1] - mx); e[2] = __expf(v[2] - mx); e[3] = __expf(v[3] - mx); float s = wave_sum(e[0] + e[1] + e[2] + e[3], lane); const float inv = 1.f / s;
        *(f32x4*)(sc + w * 256 + lane * 4) = e * inv; }
    __syncthreads();
    f32x4 acc[4];
#pragma unroll
    for (int t = 0; t < 4; ++t) acc[t] = (f32x4){0.f, 0.f, 0.f, 0.f};
    for (int m0 = w; m0 < 256; m0 += 64) { f32x4 vv[8];
#pragma unroll
        for (int i = 0; i < 8; ++i) vv[i] = *(const f32x4*)(pk->cache_v + ((size_t)(sbi * 256 + m0 + 8 * i) * 4 + head) * 256 + lane * 4);
#pragma unroll
        for (int i = 0; i < 8; ++i)
#pragma unroll
            for (int t = 0; t < 4; ++t) acc[t] += vv[i] * sc[t * 256 + m0 + 8 * i]; }
#pragma unroll
    for (int t = 0; t < 4; ++t) *(f32x4*)(ored + (w * 4 + t) * 256 + lane * 4) = acc[t];
    __syncthreads();
    for (int idx = tid; idx < 1024; idx += 512) { const int t = idx >> 8, d = idx & 255; float s = 0.f;
#pragma unroll
        for (int ww = 0; ww < 8; ++ww) s += ored[(ww * 4 + t) * 256 + d];
        const size_t tok = (size_t)(NTOKP + sbi * 4 + t); const float gate = bf2f(proj[tok * NPROJ + C_XG + head * 256 + d]); mix[tok * DMIX + 2048 + head * 256 + d] = f2bf(s * siluf(gate)); }
}

DI void ssds_item(KP pk_in, unsigned char* lds, int sbi, int g) {
    KP pk = pk_in; asm volatile("" : "+s"(pk));
    unsigned char* ws = pk->ws;
    const int tid = otid(), w = tid >> 6, lane = tid & 63;
    const bf16_t* proj = (const bf16_t*)(ws + W_PROJ); bf16_t* mix = (bf16_t*)(ws + W_MIX); const float* wdf = (const float*)(ws + W_WDTF);
    float* xs = (float*)lds; float* Bs = xs + 2048; float* Cs = Bs + 512; float* yg = Cs + 512; float* dts = yg + 2048; float* decs = dts + 32;
    __syncthreads();
#pragma unroll
    for (int d = 0; d < 4; ++d) { const int pi = w * 4 + d, t = pi & 3, hl = pi >> 2, h = 8 * g + hl; float s = 0.f;
#pragma unroll
        for (int i = 0; i < 4; ++i) { const f32x4 xv = *(const f32x4*)(pk->x_sample + (size_t)(sbi * 4 + t) * 1024 + i * 256 + lane * 4), wv = *(const f32x4*)(wdf + h * 1024 + i * 256 + lane * 4);
            s += xv[0] * wv[0] + xv[1] * wv[1] + xv[2] * wv[2] + xv[3] * wv[3]; }
        s = wave_sum(s, lane);
        if (lane == 0) { const float dt = softplusf(s + pk->ssd_dt_bias[h]); dts[t * 8 + hl] = dt; decs[t * 8 + hl] = __expf(-dt * __expf(pk->ssd_a_log[h])); } }
    for (int idx = tid; idx < 4 * 768; idx += 512) { const int t = idx / 768, cc = idx % 768; const int ch = cc < 512 ? g * 512 + cc : (cc < 640 ? 1024 + g * 128 + (cc - 512) : 1280 + g * 128 + (cc - 640));
        float acc = pk->ssd_conv_b[ch];
#pragma unroll
        for (int kk = 0; kk < 4; ++kk) { const int ui = t + kk; const bool st = ui < 3;
            const float xs_ = pk->state_ssd_conv[(size_t)(sbi * 3 + (st ? ui : 2)) * 1536 + ch]; const float xp_ = bf2f(proj[(size_t)(NTOKP + sbi * 4 + (st ? 0 : ui - 3)) * NPROJ + C_XBC + ch]);
            acc += (st ? xs_ : xp_) * pk->ssd_conv_w[kk * 1536 + ch]; }
        const float a = siluf(acc);
        if (cc < 512) xs[t * 512 + cc] = a; else if (cc < 640) Bs[t * 128 + cc - 512] = a; else Cs[t * 128 + cc - 640] = a; }
    for (int idx = tid; idx < 3 * 768; idx += 512) { const int jj = idx / 768, cc = idx % 768; const int ch = cc < 512 ? g * 512 + cc : (cc < 640 ? 1024 + g * 128 + (cc - 512) : 1280 + g * 128 + (cc - 640));
        pk->out[O_SCS + (size_t)(sbi * 3 + jj) * 1536 + ch] = bf2f(proj[(size_t)(NTOKP + sbi * 4 + 1 + jj) * NPROJ + C_XBC + ch]); }
    __syncthreads();
    const int pp = tid >> 3, n0 = (tid & 7) * 16;
    f32x4 hs[4], hn[4];
#pragma unroll
    for (int v = 0; v < 4; ++v) hn[v] = *(const f32x4*)(pk->state_ssd_h + ((size_t)(sbi * 16 + 8 * g) * 64 + pp) * 128 + n0 + v * 4);
    for (int hl = 0; hl < 8; ++hl) { const int h = 8 * g + hl; const size_t so = ((size_t)(sbi * 16 + h) * 64 + pp) * 128 + n0;
#pragma unroll
        for (int v = 0; v < 4; ++v) hs[v] = hn[v];
        if (hl < 7) {
#pragma unroll
            for (int v = 0; v < 4; ++v) hn[v] = *(const f32x4*)(pk->state_ssd_h + so + 8192 + v * 4); }
        const float dsk = pk->ssd_d[h];
#pragma unroll
        for (int t = 0; t < 4; ++t) { const float dec = decs[t * 8 + hl], xv = xs[t * 512 + hl * 64 + pp], dtx = dts[t * 8 + hl] * xv; float part = 0.f;
#pragma unroll
            for (int v = 0; v < 4; ++v) { const f32x4 bv = *(const f32x4*)(Bs + t * 128 + n0 + v * 4), cv = *(const f32x4*)(Cs + t * 128 + n0 + v * 4);
                hs[v] = hs[v] * dec + bv * dtx; part += cv[0] * hs[v][0] + cv[1] * hs[v][1] + cv[2] * hs[v][2] + cv[3] * hs[v][3]; }
            part += shx(part, 1, lane); part += shx(part, 2, lane); part += shx(part, 4, lane);
            if ((tid & 7) == 0) { const float y = part + dsk * xv; const float z = bf2f(proj[(size_t)(NTOKP + sbi * 4 + t) * NPROJ + C_Z + h * 64 + pp]); yg[t * 512 + hl * 64 + pp] = y * siluf(z); } }
#pragma unroll
        for (int v = 0; v < 4; ++v) *(f32x4*)(pk->out + O_SHS + so + v * 4) = hs[v];
    }
    __syncthreads();
    if (w < 4) { const int t = w; float ss = 0.f; float v[8];
#pragma unroll
        for (int e = 0; e < 8; ++e) { v[e] = yg[t * 512 + e * 64 + lane]; ss += v[e] * v[e]; }
        ss = wave_sum(ss, lane); const float rstd = rsqrtf(ss * (1.f / 512.f) + 1e-5f);
#pragma unroll
        for (int e = 0; e < 8; ++e) { const int cc = e * 64 + lane; mix[(size_t)(NTOKP + sbi * 4 + t) * DMIX + 1024 + g * 512 + cc] = f2bf(v[e] * rstd * pk->ssd_norm_g[g * 512 + cc]); } }
}

DI void ssd3_item(KP pk_in, unsigned char* lds, int b, int c, int g) {
    KP pk = pk_in; asm volatile("" : "+s"(pk));
    unsigned char* ws = pk->ws;
    const int tid = otid(), w = tid >> 6, lane = tid & 63, l15 = lane & 15, q = lane >> 4;
    float* acum_s = (float*)lds; float* cf_s = acum_s + 1024; float* dt_s = cf_s + 1024; float* rstd_s = dt_s + 1024;
    bf16_t* xT = (bf16_t*)(lds + 12800);
    bf16_t* hS = (bf16_t*)(lds + 30208);
    const bf16_t* proj = (const bf16_t*)(ws + W_PROJ); const bf16_t* xact = (const bf16_t*)(ws + W_XACT); bf16_t* mix = (bf16_t*)(ws + W_MIX);
    const float* dt_g = (const float*)(ws + W_DT); const float* acum_g = (const float*)(ws + W_ACUM); const bf16_t* st_g = (const bf16_t*)(ws + W_ST);
    const int tok0 = b * 2048 + c * 128;
    __syncthreads();
    for (int idx = tid; idx < 1024; idx += 512) { const int j = idx >> 3, hl = idx & 7; acum_s[idx] = acum_g[(size_t)(tok0 + j) * 16 + 8 * g + hl]; }
    const int xj = tid >> 3, xpv = (tid & 7) * 8;
    const int hp_ = tid >> 3, hn0 = (tid & 7) * 16;
    u32x4 xr[2]; u32x4 hr[2]; bf16_t zr[16];
#define S3_LOAD(HL) do { const int h_ = 8 * g + (HL); \
        xr[0] = *(const u32x4*)(xact + (size_t)(tok0 + xj) * 1536 + g * 512 + (HL) * 64 + xpv); xr[1] = *(const u32x4*)(xact + (size_t)(tok0 + xj + 64) * 1536 + g * 512 + (HL) * 64 + xpv); \
        { const bf16_t* hp0 = st_g + ((size_t)((b * 16 + c) * 16 + h_) * 64 + hp_) * 128 + hn0; hr[0] = *(const u32x4*)hp0; hr[1] = *(const u32x4*)(hp0 + 8); } \
        _Pragma("unroll") for (int pt = 0; pt < 4; ++pt) _Pragma("unroll") for (int r = 0; r < 4; ++r) zr[pt * 4 + r] = proj[(size_t)(tok0 + 16 * w + 4 * q + r) * NPROJ + C_Z + h_ * 64 + 16 * pt + l15]; } while (0)
    S3_LOAD(0);
    bf16x8 cf[4];
#pragma unroll
    for (int ks = 0; ks < 4; ++ks) cf[ks] = *(const bf16x8*)(xact + (size_t)(tok0 + 16 * w + l15) * 1536 + 1280 + g * 128 + ks * 32 + q * 8);
    f32x4 cbt[8];
#pragma unroll
    for (int jt = 0; jt < 8; ++jt) { cbt[jt] = (f32x4){0.f, 0.f, 0.f, 0.f};
        if (jt <= w) {
#pragma unroll
            for (int ks = 0; ks < 4; ++ks) { const bf16x8 bfr = *(const bf16x8*)(xact + (size_t)(tok0 + 16 * jt + l15) * 1536 + 1024 + g * 128 + ks * 32 + q * 8); cbt[jt] = MFMA16(bfr, cf[ks], cbt[jt]); } } }
    __syncthreads();
    for (int idx = tid; idx < 1024; idx += 512) { const int j = idx >> 3, hl = idx & 7; const float dtv = dt_g[(size_t)(tok0 + j) * 16 + 8 * g + hl]; dt_s[idx] = dtv; cf_s[idx] = __expf(acum_s[(j | 15) * 8 + hl] - acum_s[idx]) * dtv; }
    float ssq[4] = {0.f, 0.f, 0.f, 0.f};
    const int irow = 16 * w + l15;
    for (int hl = 0; hl < 8; ++hl) { const int h = 8 * g + hl;
        __syncthreads();
        { const bf16_t* e0 = (const bf16_t*)&xr[0]; const bf16_t* e1 = (const bf16_t*)&xr[1]; (void)e0; (void)e1;
          const unsigned xw[2][4] = {{xr[0].x, xr[0].y, xr[0].z, xr[0].w}, {xr[1].x, xr[1].y, xr[1].z, xr[1].w}};
#pragma unroll
          for (int hh = 0; hh < 2; ++hh)
#pragma unroll
              for (int e = 0; e < 4; ++e) { xT[(xpv + 2 * e) * 136 + xj + 64 * hh] = (bf16_t)(xw[hh][e] & 0xFFFF); xT[(xpv + 2 * e + 1) * 136 + xj + 64 * hh] = (bf16_t)(xw[hh][e] >> 16); }
          *(u32x4*)(hS + hp_ * 136 + hn0) = hr[0]; *(u32x4*)(hS + hp_ * 136 + hn0 + 8) = hr[1]; }
        float zz[16];
#pragma unroll
        for (int e = 0; e < 16; ++e) zz[e] = bf2f(zr[e]);
        __syncthreads();
        if (hl < 7) S3_LOAD(hl + 1);
        const float ai = acum_s[irow * 8 + hl];
        bf16x8 af[4];
#pragma unroll
        for (int s = 0; s < 4; ++s) { float m8[8];
#pragma unroll
            for (int hf = 0; hf < 2; ++hf) { const int jt = 2 * s + hf;
                const float rf = jt < w ? __expf(ai - acum_s[(16 * jt + 15) * 8 + hl]) : 0.f;
#pragma unroll
                for (int r = 0; r < 4; ++r) { const int j = 16 * jt + 4 * q + r; float val = 0.f;
                    if (jt < w) val = cbt[jt][r] * rf * cf_s[j * 8 + hl];
                    else if (jt == w && j <= irow) val = cbt[jt][r] * __expf(ai - acum_s[j * 8 + hl]) * dt_s[j * 8 + hl];
                    m8[hf * 4 + r] = val; } }
            af[s] = as_frag(pack8(m8)); }
        const float dsk = pk->ssd_d[h];
        float ea[4];
#pragma unroll
        for (int r = 0; r < 4; ++r) ea[r] = __expf(acum_s[(16 * w + 4 * q + r) * 8 + hl]);
#pragma unroll
        for (int pt = 0; pt < 4; ++pt) { f32x4 yd = {0.f, 0.f, 0.f, 0.f}, yo = {0.f, 0.f, 0.f, 0.f};
            const bf16_t* xrw = xT + (16 * pt + l15) * 136;
#pragma unroll
            for (int s = 0; s < 4; ++s) if (2 * s <= w) { const u32x2 lo = *(const u32x2*)(xrw + 32 * s + 4 * q), hi = *(const u32x2*)(xrw + 32 * s + 16 + 4 * q); yd = MFMA16(af[s], frag2(lo, hi), yd); }
            const bf16_t* hrw = hS + (16 * pt + l15) * 136 + q * 8;
#pragma unroll
            for (int ks = 0; ks < 4; ++ks) { const bf16x8 hf = *(const bf16x8*)(hrw + ks * 32); yo = MFMA16(cf[ks], hf, yo); }
            const u32x2 xv2 = *(const u32x2*)(xrw + 16 * w + 4 * q); const float xv[4] = {bflo(xv2.x), bfhi(xv2.x), bflo(xv2.y), bfhi(xv2.y)};
#pragma unroll
            for (int r = 0; r < 4; ++r) { const size_t tok = (size_t)(tok0 + 16 * w + 4 * q + r); const int pp = 16 * pt + l15;
                const float y = yd[r] + ea[r] * yo[r] + dsk * xv[r]; const float val = y * siluf(zz[pt * 4 + r]);
                ssq[r] += val * val; mix[tok * DMIX + 1024 + g * 512 + hl * 64 + pp] = f2bf(val); } }
    }
#pragma unroll
    for (int r = 0; r < 4; ++r) { float sv = ssq[r]; sv += shx(sv, 1, lane); sv += shx(sv, 2, lane); sv += shx(sv, 4, lane); sv += shx(sv, 8, lane); if (l15 == 0) rstd_s[16 * w + 4 * q + r] = rsqrtf(sv * (1.f / 512.f) + 1e-5f); }
    asm volatile("s_waitcnt vmcnt(0)" ::: "memory");
    __syncthreads();
    for (int idx = tid; idx < 128 * 64; idx += 512) { const int row = idx >> 6, c8 = (idx & 63) * 8; bf16_t* mp = mix + (size_t)(tok0 + row) * DMIX + 1024 + g * 512 + c8;
        const u32x4 v = *(const u32x4*)mp; float x[8]; unpack8(v, x); const float rs = rstd_s[row];
        const f32x4 g0 = *(const f32x4*)(pk->ssd_norm_g + g * 512 + c8), g1 = *(const f32x4*)(pk->ssd_norm_g + g * 512 + c8 + 4);
        x[0] *= rs * g0[0]; x[1] *= rs * g0[1]; x[2] *= rs * g0[2]; x[3] *= rs * g0[3]; x[4] *= rs * g1[0]; x[5] *= rs * g1[1]; x[6] *= rs * g1[2]; x[7] *= rs * g1[3];
        *(u32x4*)mp = pack8(x); }
#undef S3_LOAD
}

DI void outs_item(KP pk_in, unsigned char* lds, int piece) {
    KP pk = pk_in; asm volatile("" : "+s"(pk));
    const int tid = otid(), w = tid >> 6, lane = tid & 63, l15 = lane & 15, q = lane >> 4;
    const int rg = piece >> 4, cgp = piece & 15;
    const bf16_t* mix = (const bf16_t*)(pk->ws + W_MIX); const bf16_t* wo = (const bf16_t*)(pk->ws + W_WOUTT); float* res = (float*)(pk->ws + W_RES);
    float* part = (float*)lds;
    f32x4 acc[2][4];
#pragma unroll
    for (int mt = 0; mt < 2; ++mt)
#pragma unroll
        for (int nt = 0; nt < 4; ++nt) acc[mt][nt] = (f32x4){0.f, 0.f, 0.f, 0.f};
    const bf16_t* ap = mix + (size_t)(NTOKP + rg * 32 + l15) * DMIX + w * 384 + q * 8;
    const bf16_t* bp = wo + (size_t)(cgp * 64 + l15) * 3072 + w * 384 + q * 8;
#pragma unroll 4
    for (int ks = 0; ks < 12; ++ks) { bf16x8 a[2], bb[4];
#pragma unroll
        for (int mt = 0; mt < 2; ++mt) a[mt] = *(const bf16x8*)(ap + (size_t)mt * 16 * DMIX + ks * 32);
#pragma unroll
        for (int nt = 0; nt < 4; ++nt) bb[nt] = *(const bf16x8*)(bp + (size_t)nt * 16 * 3072 + ks * 32);
#pragma unroll
        for (int mt = 0; mt < 2; ++mt)
#pragma unroll
            for (int nt = 0; nt < 4; ++nt) acc[mt][nt] = MFMA16(a[mt], bb[nt], acc[mt][nt]); }
    __syncthreads();
#pragma unroll
    for (int mt = 0; mt < 2; ++mt)
#pragma unroll
        for (int nt = 0; nt < 4; ++nt)
#pragma unroll
            for (int r = 0; r < 4; ++r) part[(w * 32 + mt * 16 + 4 * q + r) * 64 + nt * 16 + l15] = acc[mt][nt][r];
    __syncthreads();
    { const int row = tid >> 4, c4 = (tid & 15) * 4; f32x4 sum = {0.f, 0.f, 0.f, 0.f};
#pragma unroll
      for (int ww = 0; ww < 8; ++ww) sum += *(const f32x4*)(part + (ww * 32 + row) * 64 + c4);
      const int srow = rg * 32 + row, col = cgp * 64 + c4; const f32x4 xv = *(const f32x4*)(pk->x_sample + (size_t)srow * 1024 + col);
      *(f32x4*)(res + (size_t)(NTOKP + srow) * 1024 + col) = sum + xv * 1.189207115002721f; }
    __syncthreads();
}

DI void ln_rows(KP pk_in) {
    KP pk = pk_in; asm volatile("" : "+s"(pk));
    const float* res = (const float*)(pk->ws + W_RES);
    const int tid = otid(); const int lane = tid & 63; const int gw = obid() * 8 + (tid >> 6), nw = gridDim.x * 8;
    f32x4 gg[4], bb[4];
#pragma unroll
    for (int i = 0; i < 4; ++i) { gg[i] = *(const f32x4*)(pk->ln_g + i * 256 + lane * 4); bb[i] = *(const f32x4*)(pk->ln_b + i * 256 + lane * 4); }
    for (int row = gw; row < NTOK; row += nw) { f32x4 v[4]; float s = 0.f;
#pragma unroll
        for (int i = 0; i < 4; ++i) { v[i] = *(const f32x4*)(res + (size_t)row * 1024 + i * 256 + lane * 4); s += v[i][0] + v[i][1] + v[i][2] + v[i][3]; }
        const float mu = wave_sum(s, lane) * (1.f / 1024.f); float s2 = 0.f;
#pragma unroll
        for (int i = 0; i < 4; ++i) { v[i] = v[i] - mu; s2 += v[i][0] * v[i][0] + v[i][1] * v[i][1] + v[i][2] * v[i][2] + v[i][3] * v[i][3]; }
        const float rstd = rsqrtf(wave_sum(s2, lane) * (1.f / 1024.f) + 1e-5f);
#pragma unroll
        for (int i = 0; i < 4; ++i) *(f32x4*)(pk->out + (size_t)row * 1024 + i * 256 + lane * 4) = v[i] * rstd * gg[i] + bb[i]; }
}

__global__ void __launch_bounds__(512, 2) hymba_fwd(Params p_unused) {
    KP pk = kparams();
    extern __shared__ __attribute__((aligned(16))) unsigned char shm[];
    cg::grid_group grid = cg::this_grid();
    const int G = gridDim.x;
    if (threadIdx.x < 4) ((volatile LAS unsigned*)(LAS unsigned char*)shm)[32768 + threadIdx.x] = 0u;
    __syncthreads();
    const int ph_lo_chk = pk->ph_lo;
    XcdBarrier xb = xcd_barrier_post((unsigned*)(pk->ws + W_BAR), (volatile LAS unsigned*)(LAS unsigned char*)shm + 32768);
    if (ph_lo_chk < 0) grid.sync();
    { KP pk = kparams(); for (int rep = 0; rep < REP0; ++rep) phase_prep(pk, shm); }
    xcd_barrier(xb);
    for (int rep = 1; rep < REPS; ++rep) xcd_barrier(xb);
    { KP pk = kparams(); const int bid = obid();
      for (int rep = 0; rep < REP1; ++rep) {
        { pg8::Gemm g; g.A = (const bf16_t*)(pk->ws + W_XB); g.Bt = (const bf16_t*)(pk->ws + W_WINT); g.M = NTOK; g.N = NPROJ; g.K = 1024;
          pg8::StaticOrder S; S.init(g.M, g.N, G, bid); pg8::EpiBf16 E; E.O = (bf16_t*)(pk->ws + W_PROJ); E.ldc = NPROJ;
          pg8::gemm_phase<pg8::EpiBf16, pg8::StaticOrder>((LAS unsigned char*)shm, g, S, E); }
        { pg8::Gemm g; g.A = (const bf16_t*)(pk->ws + W_MEMB); g.Bt = (const bf16_t*)(pk->ws + W_WKVT); g.M = 2048; g.N = 2048; g.K = 1024;
          const int shift = (66 * 26) % G; pg8::StaticOrder S; S.init(g.M, g.N, G, (bid + G - shift) % G);
          pg8::EpiKV E; E.mk = pk->out + O_MKP; E.mv = pk->out + O_MVP; E.kb = (bf16_t*)(pk->ws + W_KB); E.vt = (bf16_t*)(pk->ws + W_VT);
          pg8::gemm_phase<pg8::EpiKV, pg8::StaticOrder>((LAS unsigned char*)shm, g, S, E); } } }
    xcd_barrier(xb);
    { KP pk = kparams(); const int bid = obid();
      for (int rep = 0; rep < REP2; ++rep) for (int it = bid; it < 384; it += G) { if (it < 256) ssd1_item(pk, shm, it >> 5, (it >> 1) & 15, it & 1); else rgconv_item(pk, (it - 256) >> 4, (it - 256) & 15); } }
    xcd_barrier(xb);
    { KP pk = kparams(); const int bid = obid();
      for (int rep = 0; rep < REP3; ++rep) for (int kk = 0; kk < 8; ++kk) { const int kq = kk; const int it = bid + kq * G;
          if (it >= 1920) continue;
          if (rep > 0 && (it < R3LO || it >= R3HI)) continue;
          if (it < 256) rg_item(pk, shm, false, it >> 5, (it >> 2) & 7, it & 3);
          else if (it < 512) statepass_item(pk, it - 256);
          else if (it < 640) { const int u = it - 512; rg_item(pk, shm, true, u >> 5, (u >> 2) & 7, u & 3); }
          else if (it < 896) { const int u = it - 640; ssds_item(pk, shm, u >> 1, u & 1); }
          else if (it < 1408) { const int u = it - 896; attns_item(pk, shm, u >> 2, u & 3); }
          else { const int u = it - 1408; attnp_item(pk, shm, u >> 6, (u >> 4) & 3, u & 15); } } }
    xcd_barrier(xb);
    { KP pk = kparams(); const int bid = obid();
      for (int rep = 0; rep < REP4; ++rep) for (int it = bid; it < 256; it += G) ssd3_item(pk, shm, it >> 5, (it >> 1) & 15, it & 1); }
    xcd_barrier(xb);
    { KP pk = kparams(); const int bid = obid();
      for (int rep = 0; rep < REP5; ++rep) {
        for (int it = bid; it < 256; it += G) outs_item(pk, shm, it);
        pg8::Gemm g; g.A = (const bf16_t*)(pk->ws + W_MIX); g.Bt = (const bf16_t*)(pk->ws + W_WOUTT); g.M = NTOKP; g.N = 1024; g.K = 3072;
        pg8::StaticOrder S; S.init(g.M, g.N, G, bid); pg8::EpiRes E; E.res = (float*)(pk->ws + W_RES); E.xp = pk->x_prompt; E.xs = pk->x_sample; E.alpha = 1.189207115002721f;
        pg8::gemm_phase<pg8::EpiRes, pg8::StaticOrder>((LAS unsigned char*)shm, g, S, E); } }
    xcd_barrier(xb);
    { KP pk = kparams(); for (int rep = 0; rep < REP6; ++rep) ln_rows(pk); }
}

extern "C" void kernel_launch(void* const* d_in, const int* in_sizes, int n_in, void* d_out, int out_size, void* d_ws, size_t ws_size, hipStream_t stream) {
    static int grid_blocks = 0;
    if (!grid_blocks) {
        int dev = 0, cus = 0, per_cu = 0;
        hipGetDevice(&dev);
        hipDeviceGetAttribute(&cus, hipDeviceAttributeMultiprocessorCount, dev);
        if (hipFuncSetAttribute((const void*)hymba_fwd, hipFuncAttributeMaxDynamicSharedMemorySize, LDS_BYTES) != hipSuccess) fprintf(stderr, "hipFuncSetAttribute failed\n");
        hipOccupancyMaxActiveBlocksPerMultiprocessor(&per_cu, (const void*)hymba_fwd, 512, LDS_BYTES);
        if (per_cu < 1) { fprintf(stderr, "occupancy query says %d blocks per CU\n", per_cu); per_cu = 1; }
        grid_blocks = cus * 1;
        if (ws_size < W_END) fprintf(stderr, "workspace too small: %zu < %zu\n", ws_size, (size_t)W_END);
    }
    if (hipMemsetAsync((char*)d_ws + W_BAR, 0, 3456 * 4, stream) != hipSuccess) fprintf(stderr, "memset failed\n");
    Params p{};
    const float** fp = (const float**)&p;
    for (int i = 0; i < 28; ++i) fp[i] = (const float*)d_in[i];
    p.out = (float*)d_out; p.ws = (unsigned char*)d_ws;
    p.ph_lo = 0; p.ph_hi = NPHASE;
    void* args[] = {&p};
    hipError_t e = hipLaunchCooperativeKernel((const void*)hymba_fwd, dim3(grid_blocks), dim3(512), args, LDS_BYTES, stream);
    if (e != hipSuccess) fprintf(stderr, "cooperative launch failed: %s (grid %d)\n", hipGetErrorString(e), grid_blocks);
}
```

```cpp
#include <hip/hip_runtime.h>
#include <hip/hip_cooperative_groups.h>
#include <cstdio>
namespace cg = cooperative_groups;

#ifndef REP2
#define REP2 1
#endif
#ifndef REP3
#define REP3 1
#endif
#ifndef REP4
#define REP4 1
#endif
#ifndef R3LO
#define R3LO 0
#define R3HI 256
#endif
#ifndef REP0
#define REP0 1
#endif
#ifndef REP1
#define REP1 1
#endif
#ifndef REP5
#define REP5 1
#endif
#ifndef REP6
#define REP6 1
#endif
#ifndef REPS
#define REPS 1
#endif
#ifndef PHM
#define PHM 127
#endif
#ifndef N_LAUNCH_PER_PHASE
#define N_LAUNCH_PER_PHASE 0
#endif

#define DI __device__ __forceinline__
#define LAS __attribute__((address_space(3)))
typedef unsigned short bf16_t;
typedef short bf16x8 __attribute__((ext_vector_type(8)));
typedef float f32x4 __attribute__((ext_vector_type(4)));
typedef unsigned u32x4 __attribute__((ext_vector_type(4)));
typedef unsigned u32x2 __attribute__((ext_vector_type(2)));

constexpr int NTOKP = 16384, NTOKS = 512, NTOK = 16896, DM = 1024, NPROJ = 6656, DMIX = 3072, DIN = 6672;
constexpr int C_RGX = 0, C_RGG = 1024, C_XBC = 2048, C_Z = 3584, C_Q = 4608, C_XG = 5632;
constexpr int NPHASE = 7;
constexpr int LDS_BYTES = 131072 + 64;

constexpr size_t O_YP = 0, O_YS = O_YP + (size_t)NTOKP * DM, O_RGCP = O_YS + (size_t)NTOKS * DM, O_RGHP = O_RGCP + 8 * 3 * 1024, O_SCP = O_RGHP + 8 * 1024,
                 O_SHP = O_SCP + 8 * 3 * 1536, O_MKP = O_SHP + (size_t)8 * 16 * 64 * 128, O_MVP = O_MKP + (size_t)2048 * 1024, O_RGCS = O_MVP + (size_t)2048 * 1024,
                 O_RGHS = O_RGCS + (size_t)128 * 3 * 1024, O_SCS = O_RGHS + 128 * 1024, O_SHS = O_SCS + (size_t)128 * 3 * 1536;

constexpr size_t al256(size_t x) { return (x + 255) & ~(size_t)255; }
constexpr size_t W_XB = 0;
constexpr size_t W_WINT = al256(W_XB + (size_t)NTOK * DM * 2);
constexpr size_t W_WDTT = al256(W_WINT + (size_t)NPROJ * DM * 2);
constexpr size_t W_WDTF = al256(W_WDTT + 16 * 1024 * 2);
constexpr size_t W_WOUTT = al256(W_WDTF + 16 * 1024 * 4);
constexpr size_t W_WKVT = al256(W_WOUTT + (size_t)1024 * 3072 * 2);
constexpr size_t W_MEMB = al256(W_WKVT + (size_t)2048 * 1024 * 2);
constexpr size_t W_WGT = al256(W_MEMB + (size_t)2048 * 1024 * 2);
constexpr size_t W_KB = al256(W_WGT + (size_t)8 * 4 * 64 * 128 * 2);
constexpr size_t W_VT = al256(W_KB + (size_t)2048 * 1024 * 2);
constexpr size_t W_XACT = al256(W_VT + (size_t)2048 * 1024 * 2);
constexpr size_t W_DT = al256(W_XACT + (size_t)NTOKP * 1536 * 2);
constexpr size_t W_ACUM = al256(W_DT + (size_t)NTOKP * 16 * 4);
constexpr size_t W_CD = al256(W_ACUM + (size_t)NTOKP * 16 * 4);
constexpr size_t W_ST = al256(W_CD + 8 * 16 * 16 * 4);
constexpr size_t W_MIX = al256(W_ST + (size_t)8 * 16 * 16 * 8192 * 4);
constexpr size_t W_PROJ = al256(W_MIX + (size_t)NTOK * DMIX * 2);
constexpr size_t W_RES = W_PROJ;
constexpr size_t W_BAR = al256(W_PROJ + (size_t)NTOK * NPROJ * 2);
constexpr size_t W_END = al256(W_BAR + 3456 * 4);

struct Params {
    const float *x_prompt, *x_sample, *mem_prompt, *state_rg_conv, *state_rg_h, *state_ssd_conv, *state_ssd_h, *cache_k, *cache_v;
    const float *w_in, *rg_conv_w, *rg_conv_b, *w_rg_a, *b_rg_a, *w_rg_i, *b_rg_i, *rg_lambda, *ssd_conv_w, *ssd_conv_b, *ssd_dt_bias, *ssd_a_log, *ssd_d, *ssd_norm_g,
        *w_mem_k, *w_mem_v, *w_out, *ln_g, *ln_b;
    float* out; unsigned char* ws;
    int ph_lo, ph_hi;
};
typedef const __attribute__((address_space(4))) Params* KP;
DI KP kparams() { KP k = (KP)__builtin_amdgcn_kernarg_segment_ptr(); asm volatile("" : "+s"(k)); return k; }

DI int otid() { int t = threadIdx.x; asm volatile("" : "+v"(t)); return t; }
DI int obid() { int t = blockIdx.x; asm volatile("" : "+s"(t)); return t; }
DI float bf2f(bf16_t b) { return __uint_as_float(((unsigned)b) << 16); }
typedef __bf16 hbf2 __attribute__((ext_vector_type(2)));
typedef float f32x2 __attribute__((ext_vector_type(2)));
DI unsigned pack2(float lo, float hi) { const f32x2 v = {lo, hi}; return __builtin_bit_cast(unsigned, __builtin_convertvector(v, hbf2)); }
DI bf16_t f2bf(float f) { return (bf16_t)(pack2(f, 0.f) & 0xFFFFu); }
DI float bflo(unsigned w) { return __uint_as_float(w << 16); }
DI float bfhi(unsigned w) { return __uint_as_float(w & 0xFFFF0000u); }
DI void unpack8(const u32x4 v, float (&o)[8]) { o[0] = bflo(v.x); o[1] = bfhi(v.x); o[2] = bflo(v.y); o[3] = bfhi(v.y); o[4] = bflo(v.z); o[5] = bfhi(v.z); o[6] = bflo(v.w); o[7] = bfhi(v.w); }
DI u32x4 pack8(const float (&o)[8]) { u32x4 w; w.x = pack2(o[0], o[1]); w.y = pack2(o[2], o[3]); w.z = pack2(o[4], o[5]); w.w = pack2(o[6], o[7]); return w; }
DI bf16x8 as_frag(u32x4 w) { return __builtin_bit_cast(bf16x8, w); }
DI bf16x8 frag2(u32x2 lo, u32x2 hi) { u32x4 w; w.x = lo.x; w.y = lo.y; w.z = hi.x; w.w = hi.y; return __builtin_bit_cast(bf16x8, w); }
DI float shx(float v, int m, int lane) { return __int_as_float(__builtin_amdgcn_ds_bpermute((lane ^ m) << 2, __float_as_int(v))); }
DI float shl(float v, int src) { return __int_as_float(__builtin_amdgcn_ds_bpermute(src << 2, __float_as_int(v))); }
DI float siluf(float x) { return x * __builtin_amdgcn_rcpf(1.f + __expf(-x)); }
DI float sigmf(float x) { return __builtin_amdgcn_rcpf(1.f + __expf(-x)); }
DI float softplusf(float v) { return v > 20.f ? v : __logf(1.f + __expf(v)); }
#define MFMA16(a, b, c) __builtin_amdgcn_mfma_f32_16x16x32_bf16((a), (b), (c), 0, 0, 0)

#define XB_TMO      128
#define XB_XCNT(j)  (256  + 64 * (j))
#define XB_XSUB(j)  (1280 + 64 * (j))
#define XB_XGEN(j)  (2304 + 64 * (j))
#define XB_TOP      3328
#define XB_TOPGEN   3392
#define XCD_BAR_WORDS 3456
#define XB_SPIN_CAP (1u << 20)
DI unsigned xb_ld(unsigned* ptr)              { return __hip_atomic_load(ptr, __ATOMIC_RELAXED, __HIP_MEMORY_SCOPE_AGENT); }
DI unsigned xb_add(unsigned* ptr, unsigned v) { return __hip_atomic_fetch_add(ptr, v, __ATOMIC_RELAXED, __HIP_MEMORY_SCOPE_AGENT); }
DI unsigned xb_xcc_id() { return (unsigned)__builtin_amdgcn_s_getreg((3 << 11) | 20) & 0xFu; }
#define XB_SPIN(cond, bar) do { unsigned _sp = 0; while (cond) { __builtin_amdgcn_s_sleep(1); \
    if ((++_sp & 255u) == 0u) { if (xb_ld(&(bar)[XB_TMO])) break; if (_sp > XB_SPIN_CAP) { atomicAdd(&(bar)[XB_TMO], 1u); break; } } } } while (0)
struct XcdBarrier { unsigned* bar; unsigned x; volatile LAS unsigned* st; };
DI XcdBarrier xcd_barrier_post(unsigned* bar, volatile LAS unsigned* st) {
    XcdBarrier b; b.bar = bar; b.x = xb_xcc_id(); b.st = st;
    if (threadIdx.x == 0) (void)xb_add(&bar[XB_XCNT(b.x)], 1u);
    return b;
}
DI void xcd_barrier_complete(unsigned* bar, unsigned x, unsigned& nloc, unsigned& nx) {
    const unsigned G = gridDim.x * gridDim.y * gridDim.z;
    unsigned sum, cnt, mine, sp = 0u;
    for (;;) {
        sum = 0u; cnt = 0u; mine = 0u;
#pragma unroll
        for (unsigned j = 0; j < 16; ++j) { const unsigned c = xb_ld(&bar[XB_XCNT(j)]); sum += c; cnt += (c > 0u) ? 1u : 0u; mine = (j == x) ? c : mine; }
        if (sum == G) break;
        __builtin_amdgcn_s_sleep(1);
        if ((++sp & 255u) == 0u) { if (xb_ld(&bar[XB_TMO])) break; if (sp > XB_SPIN_CAP) { atomicAdd(&bar[XB_TMO], 1u); break; } }
    }
    nloc = mine > 0u ? mine : 1u; nx = cnt > 0u ? cnt : 1u;
}
DI void xcd_barrier(const XcdBarrier& b) {
    asm volatile("s_waitcnt vmcnt(0)" ::: "memory");
    __syncthreads();
    if (threadIdx.x == 0) {
        unsigned* bar = b.bar;
        __builtin_amdgcn_s_waitcnt(0);
        unsigned nloc = b.st[0], nx = b.st[1];
        if (nloc == 0u) { xcd_barrier_complete(bar, b.x, nloc, nx); b.st[0] = nloc; b.st[1] = nx; }
        const unsigned old = xb_add(&bar[XB_XSUB(b.x)], 1u);
        const unsigned gen = old / nloc;
        if (old + 1u == (gen + 1u) * nloc) {
            __builtin_amdgcn_fence(__ATOMIC_RELEASE, "agent");
            asm volatile("s_waitcnt vmcnt(0)" ::: "memory");
            const unsigned og = xb_add(&bar[XB_TOP], 1u);
            const unsigned tg = og / nx;
            if (og + 1u == (tg + 1u) * nx) xb_add(&bar[XB_TOPGEN], 1u);
            else XB_SPIN(xb_ld(&bar[XB_TOPGEN]) == tg, bar);
            __builtin_amdgcn_fence(__ATOMIC_ACQUIRE, "agent");
            xb_add(&bar[XB_XGEN(b.x)], 1u);
            asm volatile("s_waitcnt vmcnt(0)" ::: "memory");
        } else {
            XB_SPIN(xb_ld(&bar[XB_XGEN(b.x)]) == gen, bar);
            __builtin_amdgcn_fence(__ATOMIC_ACQUIRE, "agent");
            asm volatile("s_waitcnt vmcnt(0)" ::: "memory");
        }
    }
    __syncthreads();
}

namespace pg8 {
constexpr int BM = 256, BK = 64, HALF = 128, HTB = HALF * BK * 2, STAGE_BYTES = 8 * HTB, NXCD = 8, WGM = 8;
DI int lds_byte(int r, int c) { const int st = (r >> 4) * 2 + (c >> 5), rr = r & 15, cc = c & 31, ob = rr * 64 + cc * 2; return st * 1024 + (ob ^ (((ob >> 9) & 1) << 5)); }
DI void stage_rc(int b, int& R, int& C) { const int st = b / 1024, sb = b % 1024, swz = sb ^ (((sb >> 9) & 1) << 5); R = (st >> 1) * 16 + swz / 64; C = (st & 1) * 32 + (swz % 64) / 2; }
DI int perm32(int rho) { const int n = rho >> 4, i = rho & 15; return 8 * (i >> 2) + 4 * n + (i & 3); }
struct Unit { int pm, pn; };
struct Gemm { const bf16_t* A; const bf16_t* Bt; int M, N, K; };
struct StaticOrder {
    int nM, nN, nwg, G, c;
    DI void init(int M, int N, int G_, int c_) { nM = M / BM; nN = N / BM; nwg = nM * nN; G = G_; c = c_; }
    DI bool next(int i, Unit& u) const {
        const long L = (long)i * G + c; if (L >= nwg) return false;
        int wgid = (int)L; { const int q = nwg / NXCD, r = nwg % NXCD, xcd = wgid % NXCD, off = wgid / NXCD; wgid = (xcd < r ? xcd * (q + 1) : r * (q + 1) + (xcd - r) * q) + off; }
        const int nig = WGM * nN, gid = wgid / nig, fm = gid * WGM, gsz = (nM - fm) < WGM ? (nM - fm) : WGM;
        u.pm = fm + ((wgid % nig) % gsz); u.pn = (wgid % nig) / gsz; return true;
    }
};
DI unsigned cvt_pk_bf16(float lo, float hi) { unsigned r; asm volatile("v_cvt_pk_bf16_f32 %0, %1, %2" : "=v"(r) : "v"(lo), "v"(hi)); return r; }

struct EpiBf16 {
    static constexpr bool PERM = true;
    bf16_t* O; int ldc;
    DI void operator()(const f32x4 (&acc)[2][2][4][2], const Unit& u, int wr, int wc, int fr, int fq) const {
        const int row0 = u.pm * BM + wr * 64 + fr; const int col0 = u.pn * BM + wc * 32 + 8 * fq;
#pragma unroll
        for (int ai = 0; ai < 2; ++ai)
#pragma unroll
            for (int m = 0; m < 4; ++m) { bf16_t* rowp = O + (size_t)(row0 + ai * HALF + m * 16) * ldc + col0;
#pragma unroll
                for (int bj = 0; bj < 2; ++bj) { const f32x4 v0 = acc[ai][bj][m][0], v1 = acc[ai][bj][m][1];
                    u32x4 w; w.x = cvt_pk_bf16(v0[0], v0[1]); w.y = cvt_pk_bf16(v0[2], v0[3]); w.z = cvt_pk_bf16(v1[0], v1[1]); w.w = cvt_pk_bf16(v1[2], v1[3]);
                    *(u32x4*)(rowp + bj * HALF) = w; } }
    }
};
struct EpiKV {
    static constexpr bool PERM = false;
    float* mk; float* mv; bf16_t* kb; bf16_t* vt;
    DI void operator()(const f32x4 (&acc)[2][2][4][2], const Unit& u, int wr, int wc, int fr, int fq) const {
        const int row0 = u.pm * BM + wr * 64 + fr, col0 = u.pn * BM + wc * 32 + 4 * fq;
#pragma unroll
        for (int ai = 0; ai < 2; ++ai)
#pragma unroll
            for (int m = 0; m < 4; ++m) { const int row = row0 + ai * HALF + m * 16;
#pragma unroll
                for (int bj = 0; bj < 2; ++bj)
#pragma unroll
                    for (int n = 0; n < 2; ++n) { const int col = col0 + bj * HALF + n * 16; const f32x4 v = acc[ai][bj][m][n];
                        if (col < 1024) { *(f32x4*)(mk + (size_t)row * 1024 + col) = v; u32x2 w; w.x = cvt_pk_bf16(v[0], v[1]); w.y = cvt_pk_bf16(v[2], v[3]); *(u32x2*)(kb + (size_t)row * 1024 + col) = w; }
                        else { const int cc = col - 1024; *(f32x4*)(mv + (size_t)row * 1024 + cc) = v; const int bb = row >> 8, mt = row & 255;
#pragma unroll
                            for (int j = 0; j < 4; ++j) { const int c2 = cc + j, head = c2 >> 8, d = c2 & 255; vt[((size_t)((bb * 4 + head) * 256 + d)) * 256 + mt] = f2bf(v[j]); } } } }
    }
};
struct EpiRes {
    static constexpr bool PERM = false;
    float* res; const float* xp; const float* xs; float alpha;
    DI void operator()(const f32x4 (&acc)[2][2][4][2], const Unit& u, int wr, int wc, int fr, int fq) const {
        const int row0 = u.pm * BM + wr * 64 + fr, col0 = u.pn * BM + wc * 32 + 4 * fq;
#pragma unroll
        for (int ai = 0; ai < 2; ++ai)
#pragma unroll
            for (int m = 0; m < 4; ++m) { const int row = row0 + ai * HALF + m * 16; const float* xr = row < NTOKP ? xp + (size_t)row * 1024 : xs + (size_t)(row - NTOKP) * 1024;
#pragma unroll
                for (int bj = 0; bj < 2; ++bj)
#pragma unroll
                    for (int n = 0; n < 2; ++n) { const int col = col0 + bj * HALF + n * 16; const f32x4 xv = *(const f32x4*)(xr + col);
                        *(f32x4*)(res + (size_t)row * 1024 + col) = acc[ai][bj][m][n] + xv * alpha; } }
    }
};

template <class Epi, class Sched>
DI void gemm_phase(LAS unsigned char* lds, const Gemm g, const Sched& S, const Epi& E) {
    const int tid = otid(), wid = __builtin_amdgcn_readfirstlane(tid >> 6), lane = tid & 63, wr = wid >> 2, wc = wid & 3, fr = lane & 15, fq = lane >> 4;
    const int K = g.K, nt = K / BK;
    unsigned voffA[2], voffB[2];
#pragma unroll
    for (int i = 0; i < 2; ++i) { int R, C; stage_rc(tid * 16 + i * 8192, R, C); const int Rb = Epi::PERM ? ((R & ~31) + perm32(R & 31)) : R;
        voffA[i] = (unsigned)(R * K + C) * 2u; voffB[i] = (unsigned)(Rb * K + C) * 2u; }
    const size_t kstep = (size_t)(BK * 2);
    const size_t hstep = (size_t)HALF * K * 2;
    const size_t tstep = 2 * hstep;
    const unsigned ldsw = (unsigned)wid * 1024u;
    const int aoff = lds_byte(wr * 64 + fr, fq * 8), boff = lds_byte(wc * 32 + fr, fq * 8);
#define PG8_SA(b, h) (((b) * 2 + (h)) * HTB)
#define PG8_SB(b, h) ((4 + (b) * 2 + (h)) * HTB)
#define PG8_STAGE(bufoff, gbase, voff) do { _Pragma("unroll") for (int _i = 0; _i < 2; ++_i) \
        __builtin_amdgcn_global_load_lds((const unsigned*)((const char*)(gbase) + (voff)[_i]), (LAS unsigned*)(lds + (bufoff) + ldsw + _i * 8192), 16, 0, 0); } while (0)
#define PG8_LDA(dst, b, h) do { _Pragma("unroll") for (int m = 0; m < 4; ++m) _Pragma("unroll") for (int k = 0; k < 2; ++k) dst[m][k] = *(const LAS bf16x8*)(lds + PG8_SA(b, h) + aoff + m * 2048 + k * 1024); } while (0)
#define PG8_LDB(dst, b, h) do { _Pragma("unroll") for (int n = 0; n < 2; ++n) _Pragma("unroll") for (int k = 0; k < 2; ++k) dst[n][k] = *(const LAS bf16x8*)(lds + PG8_SB(b, h) + boff + n * 2048 + k * 1024); } while (0)
#define PG8_MMA(ai, bj, At, Bt) do { __builtin_amdgcn_s_setprio(1); _Pragma("unroll") for (int m = 0; m < 4; ++m) _Pragma("unroll") for (int n = 0; n < 2; ++n) _Pragma("unroll") for (int k = 0; k < 2; ++k) \
        acc[ai][bj][m][n] = __builtin_amdgcn_mfma_f32_16x16x32_bf16(Bt[n][k], At[m][k], acc[ai][bj][m][n], 0, 0, 0); __builtin_amdgcn_s_setprio(0); } while (0)
#define PG8_WAIT_V(n) asm volatile("s_waitcnt vmcnt(" #n ")" ::: "memory")
#define PG8_WAIT_L(n) asm volatile("s_waitcnt lgkmcnt(" #n ")" ::: "memory")
#define PG8_BAR __builtin_amdgcn_s_barrier()
#define PG8_SCHED __builtin_amdgcn_sched_barrier(0)
    Unit cur, nxt; int ui = 0;
    if (!S.next(0, cur)) return;
    f32x4 acc[2][2][4][2];
#pragma unroll
    for (int a = 0; a < 2; ++a)
#pragma unroll
        for (int b = 0; b < 2; ++b)
#pragma unroll
            for (int m = 0; m < 4; ++m)
#pragma unroll
                for (int n = 0; n < 2; ++n) acc[a][b][m][n] = (f32x4){0.f, 0.f, 0.f, 0.f};
    bf16x8 At[4][2], B0[2][2], B1[2][2];
    const char* cA = (const char*)g.A + (size_t)cur.pm * tstep; const char* cB = (const char*)g.Bt + (size_t)cur.pn * tstep;
    PG8_STAGE(PG8_SB(0, 0), cB, voffB); PG8_STAGE(PG8_SA(0, 0), cA, voffA); PG8_STAGE(PG8_SB(0, 1), cB + hstep, voffB); PG8_STAGE(PG8_SA(0, 1), cA + hstep, voffA);
    if (wr == 1) PG8_BAR;
    PG8_WAIT_V(4); PG8_BAR;
    PG8_STAGE(PG8_SB(1, 0), cB + kstep, voffB); PG8_STAGE(PG8_SA(1, 0), cA + kstep, voffA); PG8_STAGE(PG8_SB(1, 1), cB + hstep + kstep, voffB);
    PG8_WAIT_V(6); PG8_BAR;
    for (;;) {
        const bool has_next = S.next(ui + 1, nxt);
        const char* nA = has_next ? (const char*)g.A + (size_t)nxt.pm * tstep : cA; const char* nB = has_next ? (const char*)g.Bt + (size_t)nxt.pn * tstep : cB;
        for (int t = 0; t < nt; t += 2) {
            const bool last = (t == nt - 2);
            const char* a1 = cA + (size_t)(t + 1) * kstep;
            const char* a2 = last ? nA : cA + (size_t)(t + 2) * kstep; const char* b2 = last ? nB : cB + (size_t)(t + 2) * kstep;
            const char* a3 = a2 + kstep; const char* b3 = b2 + kstep;
            PG8_LDB(B0, 0, 0); PG8_SCHED; PG8_LDA(At, 0, 0); PG8_STAGE(PG8_SA(1, 1), a1 + hstep, voffA);
            PG8_WAIT_L(8); PG8_BAR; PG8_WAIT_L(0); PG8_MMA(0, 0, At, B0); PG8_BAR; PG8_SCHED;
            PG8_LDB(B1, 0, 1); PG8_STAGE(PG8_SB(0, 0), b2, voffB);
            PG8_BAR; PG8_WAIT_L(0); PG8_MMA(0, 1, At, B1); PG8_BAR;
            PG8_LDA(At, 0, 1); PG8_STAGE(PG8_SA(0, 0), a2, voffA);
            PG8_BAR; PG8_WAIT_L(0); PG8_MMA(1, 0, At, B0); PG8_BAR; PG8_SCHED;
            PG8_STAGE(PG8_SB(0, 1), b2 + hstep, voffB);
            PG8_WAIT_V(6); PG8_BAR; PG8_MMA(1, 1, At, B1); PG8_BAR;
            PG8_LDB(B0, 1, 0); PG8_SCHED; PG8_LDA(At, 1, 0); PG8_STAGE(PG8_SA(0, 1), a2 + hstep, voffA);
            PG8_WAIT_L(8); PG8_BAR; PG8_WAIT_L(0); PG8_MMA(0, 0, At, B0); PG8_BAR; PG8_SCHED;
            PG8_LDB(B1, 1, 1); PG8_STAGE(PG8_SB(1, 0), b3, voffB);
            PG8_BAR; PG8_WAIT_L(0); PG8_MMA(0, 1, At, B1); PG8_BAR;
            PG8_LDA(At, 1, 1); PG8_STAGE(PG8_SA(1, 0), a3, voffA);
            PG8_BAR; PG8_WAIT_L(0); PG8_MMA(1, 0, At, B0); PG8_BAR; PG8_SCHED;
            PG8_STAGE(PG8_SB(1, 1), b3 + hstep, voffB);
            PG8_WAIT_V(6); PG8_BAR; PG8_MMA(1, 1, At, B1); PG8_BAR;
        }
        E(acc, cur, wr, wc, fr, fq);
        if (!has_next) break;
#pragma unroll
        for (int a = 0; a < 2; ++a)
#pragma unroll
            for (int b = 0; b < 2; ++b)
#pragma unroll
                for (int m = 0; m < 4; ++m)
#pragma unroll
                    for (int n = 0; n < 2; ++n) acc[a][b][m][n] = (f32x4){0.f, 0.f, 0.f, 0.f};
        cur = nxt; cA = nA; cB = nB; ++ui;
    }
    PG8_WAIT_V(0);
    if (wr == 0) PG8_BAR;
    PG8_BAR;
#undef PG8_SA
#undef PG8_SB
#undef PG8_STAGE
#undef PG8_LDA
#undef PG8_LDB
#undef PG8_MMA
#undef PG8_WAIT_V
#undef PG8_WAIT_L
#undef PG8_BAR
#undef PG8_SCHED
}
}

DI void tr_tile(const float* src, int ld_src, int k0, int c0, bf16_t* dst, int ld_dst, int n0, float* lds) {
    const int tid = otid();
#pragma unroll
    for (int pass = 0; pass < 2; ++pass) { const int r = pass * 32 + (tid >> 4), c4 = (tid & 15) * 4;
        const f32x4 v = *(const f32x4*)(src + (size_t)(k0 + r) * ld_src + c0 + c4);
        lds[r * 65 + c4 + 0] = v[0]; lds[r * 65 + c4 + 1] = v[1]; lds[r * 65 + c4 + 2] = v[2]; lds[r * 65 + c4 + 3] = v[3]; }
    __syncthreads();
    const int nn = tid >> 3, kc = (tid & 7) * 8;
    float o[8];
#pragma unroll
    for (int e = 0; e < 8; ++e) o[e] = lds[(kc + e) * 65 + nn];
    *(u32x4*)(dst + (size_t)(n0 + nn) * ld_dst + k0 + kc) = pack8(o);
    __syncthreads();
}

DI void phase_prep(KP pk_in, unsigned char* lds) {
    KP pk = pk_in; asm volatile("" : "+s"(pk));
    unsigned char* ws = pk->ws;
    const int bidx_ = obid(); const size_t gtid = (size_t)bidx_ * 512 + otid(), nthr = (size_t)gridDim.x * 512;
    { bf16_t* xb = (bf16_t*)(ws + W_XB);
      for (size_t v = gtid; v < (size_t)NTOK * 128; v += nthr) { const float* s = v < (size_t)NTOKP * 128 ? pk->x_prompt + v * 8 : pk->x_sample + (v - (size_t)NTOKP * 128) * 8;
          const f32x4 a = *(const f32x4*)s, b = *(const f32x4*)(s + 4); float o[8] = {a[0], a[1], a[2], a[3], b[0], b[1], b[2], b[3]}; *(u32x4*)(xb + v * 8) = pack8(o); } }
    { bf16_t* mb = (bf16_t*)(ws + W_MEMB);
      for (size_t v = gtid; v < (size_t)2048 * 128; v += nthr) { const float* s = pk->mem_prompt + v * 8;
          const f32x4 a = *(const f32x4*)s, b = *(const f32x4*)(s + 4); float o[8] = {a[0], a[1], a[2], a[3], b[0], b[1], b[2], b[3]}; *(u32x4*)(mb + v * 8) = pack8(o); } }
    { bf16_t* wd = (bf16_t*)(ws + W_WDTT); float* wf = (float*)(ws + W_WDTF);
      for (size_t i = gtid; i < 16 * 1024; i += nthr) { const int h = (int)(i >> 10), k = (int)(i & 1023); const float v = pk->w_in[(size_t)k * DIN + 4608 + h]; wd[i] = f2bf(v); wf[i] = v; } }
    { bf16_t* wg = (bf16_t*)(ws + W_WGT);
      for (size_t i = gtid; i < (size_t)8 * 4 * 64 * 128; i += nthr) { const int k = (int)(i >> 15), qd = (int)(i >> 13) & 3, nn = (int)(i >> 7) & 63, ii = (int)(i & 127);
          const float v = nn < 32 ? pk->w_rg_a[((size_t)k * 128 + ii) * 128 + qd * 32 + nn] : pk->w_rg_i[((size_t)k * 128 + ii) * 128 + qd * 32 + nn - 32]; wg[i] = f2bf(v); } }
    float* tl = (float*)lds;
    for (int t = bidx_; t < 1664 + 768 + 512; t += gridDim.x) {
        if (t < 1664) { const int kt = t & 15, ntile = t >> 4; const int n0 = ntile * 64, c0 = n0 < 4608 ? n0 : n0 + 16;
            tr_tile(pk->w_in, DIN, kt * 64, c0, (bf16_t*)(ws + W_WINT), 1024, n0, tl); }
        else if (t < 1664 + 768) { const int u = t - 1664; const int kt = u % 48, ntile = u / 48;
            tr_tile(pk->w_out, 1024, kt * 64, ntile * 64, (bf16_t*)(ws + W_WOUTT), 3072, ntile * 64, tl); }
        else { const int u = t - 1664 - 768; const int kt = u & 15, ntile = u >> 4; const int n0 = ntile * 64;
            if (n0 < 1024) tr_tile(pk->w_mem_k, 1024, kt * 64, n0, (bf16_t*)(ws + W_WKVT), 1024, n0, tl);
            else tr_tile(pk->w_mem_v, 1024, kt * 64, n0 - 1024, (bf16_t*)(ws + W_WKVT), 1024, n0, tl); }
    }
}

DI void conv8_ssd_prompt(KP pk, const bf16_t* proj, int rowbase, int t, int ch, float (&o)[8]) {
    const f32x4 b0 = *(const f32x4*)(pk->ssd_conv_b + ch), b1 = *(const f32x4*)(pk->ssd_conv_b + ch + 4);
    float acc[8] = {b0[0], b0[1], b0[2], b0[3], b1[0], b1[1], b1[2], b1[3]};
    u32x4 vv[4];
#pragma unroll
    for (int kk = 0; kk < 4; ++kk) { const int tt = t - 3 + kk; vv[kk] = *(const u32x4*)(proj + (size_t)(rowbase + (tt < 0 ? 0 : tt)) * NPROJ + C_XBC + ch); }
#pragma unroll
    for (int kk = 0; kk < 4; ++kk) { const int tt = t - 3 + kk; const float msk = tt >= 0 ? 1.f : 0.f; float x[8]; unpack8(vv[kk], x);
            const f32x4 w0 = *(const f32x4*)(pk->ssd_conv_w + kk * 1536 + ch) * msk, w1 = *(const f32x4*)(pk->ssd_conv_w + kk * 1536 + ch + 4) * msk;
            acc[0] += x[0] * w0[0]; acc[1] += x[1] * w0[1]; acc[2] += x[2] * w0[2]; acc[3] += x[3] * w0[3];
            acc[4] += x[4] * w1[0]; acc[5] += x[5] * w1[1]; acc[6] += x[6] * w1[2]; acc[7] += x[7] * w1[3]; }
#pragma unroll
    for (int e = 0; e < 8; ++e) o[e] = siluf(acc[e]);
}

DI void ssd1_item(KP pk_in, unsigned char* lds, int b, int c, int g) {
    KP pk = pk_in; asm volatile("" : "+s"(pk));
    unsigned char* ws = pk->ws;
    const int tid = otid(), w = tid >> 6, lane = tid & 63, l15 = lane & 15, q = lane >> 4;
    float* dt_s = (float*)lds; float* acum_s = dt_s + 2048; float* w_s = acum_s + 2048; float* seg_s = w_s + 1024;
    bf16_t* BT = (bf16_t*)(lds + 22528); bf16_t* xsT = (bf16_t*)(lds + 22528 + 34816);
    const bf16_t* xb = (const bf16_t*)(ws + W_XB); const bf16_t* wdt = (const bf16_t*)(ws + W_WDTT); const bf16_t* proj = (const bf16_t*)(ws + W_PROJ);
    bf16_t* xact = (bf16_t*)(ws + W_XACT); float* dt_g = (float*)(ws + W_DT); float* acum_g = (float*)(ws + W_ACUM); float* cd_g = (float*)(ws + W_CD); bf16_t* st_g = (bf16_t*)(ws + W_ST);
    const int tok0 = b * 2048 + c * 128;
    __syncthreads();
    { f32x4 acc = {0.f, 0.f, 0.f, 0.f}; const bf16_t* ap = xb + (size_t)(tok0 + 16 * w + l15) * 1024 + q * 8; const bf16_t* bp = wdt + l15 * 1024 + q * 8;
#pragma unroll 8
      for (int ks = 0; ks < 32; ++ks) { const bf16x8 a = *(const bf16x8*)(ap + ks * 32); const bf16x8 bb = *(const bf16x8*)(bp + ks * 32); acc = MFMA16(a, bb, acc); }
      const float bias = pk->ssd_dt_bias[l15];
#pragma unroll
      for (int r = 0; r < 4; ++r) { const int i = 16 * w + 4 * q + r; const float dt = softplusf(acc[r] + bias); dt_s[i * 16 + l15] = dt; dt_g[(size_t)(tok0 + i) * 16 + l15] = dt; } }
    __syncthreads();
    { const int hd = tid & 15, sg = tid >> 4; const float ah = -__expf(pk->ssd_a_log[hd]); float loc[8]; float run = 0.f;
      if (tid < 256) {
#pragma unroll
          for (int i = 0; i < 8; ++i) { run += dt_s[(sg * 8 + i) * 16 + hd] * ah; loc[i] = run; }
          seg_s[sg * 16 + hd] = run; }
      __syncthreads();
      if (tid < 256) { float off = 0.f; for (int s2 = 0; s2 < sg; ++s2) off += seg_s[s2 * 16 + hd];
#pragma unroll
          for (int i = 0; i < 8; ++i) { const float v = loc[i] + off; acum_s[(sg * 8 + i) * 16 + hd] = v; acum_g[(size_t)(tok0 + sg * 8 + i) * 16 + hd] = v; } } }
    __syncthreads();
    if (tid < 8) cd_g[(b * 16 + c) * 16 + 8 * g + tid] = __expf(acum_s[127 * 16 + 8 * g + tid]);
    for (int idx = tid; idx < 1024; idx += 512) { const int j = idx >> 3, hl = idx & 7, h = 8 * g + hl; w_s[idx] = dt_s[j * 16 + h] * __expf(acum_s[127 * 16 + h] - acum_s[j * 16 + h]); }
    const int cv = (tid & 31) * 8, jg = tid >> 5;
    for (int pass = 0; pass < 3; ++pass) {
        const int ch = pass == 0 ? (cv < 128 ? 1024 + g * 128 + cv : 1280 + g * 128 + (cv - 128)) : g * 512 + (pass - 1) * 256 + cv;
        float wgt[4][8], bs[8];
        { const f32x4 b0 = *(const f32x4*)(pk->ssd_conv_b + ch), b1 = *(const f32x4*)(pk->ssd_conv_b + ch + 4);
          bs[0] = b0[0]; bs[1] = b0[1]; bs[2] = b0[2]; bs[3] = b0[3]; bs[4] = b1[0]; bs[5] = b1[1]; bs[6] = b1[2]; bs[7] = b1[3];
#pragma unroll
          for (int kk = 0; kk < 4; ++kk) { const f32x4 w0 = *(const f32x4*)(pk->ssd_conv_w + kk * 1536 + ch), w1 = *(const f32x4*)(pk->ssd_conv_w + kk * 1536 + ch + 4);
              wgt[kk][0] = w0[0]; wgt[kk][1] = w0[1]; wgt[kk][2] = w0[2]; wgt[kk][3] = w0[3]; wgt[kk][4] = w1[0]; wgt[kk][5] = w1[1]; wgt[kk][6] = w1[2]; wgt[kk][7] = w1[3]; } }
        const bf16_t* src = proj + (size_t)(b * 2048) * NPROJ + C_XBC + ch; const int t0 = c * 128 + jg * 8;
        u32x4 rows[11];
#pragma unroll
        for (int i = 0; i < 11; ++i) { const int tt = t0 - 3 + i; const u32x4 v = *(const u32x4*)(src + (size_t)(tt < 0 ? 0 : tt) * NPROJ); rows[i] = tt < 0 ? (u32x4){0u, 0u, 0u, 0u} : v; }
        if (pass > 0) __syncthreads();
#pragma unroll
        for (int i = 0; i < 8; ++i) { float x0[8], x1[8], x2[8], x3[8]; unpack8(rows[i], x0); unpack8(rows[i + 1], x1); unpack8(rows[i + 2], x2); unpack8(rows[i + 3], x3); float o[8];
#pragma unroll
            for (int e = 0; e < 8; ++e) o[e] = siluf(bs[e] + x0[e] * wgt[0][e] + x1[e] * wgt[1][e] + x2[e] * wgt[2][e] + x3[e] * wgt[3][e]);
            const int j = jg * 8 + i;
            *(u32x4*)(xact + (size_t)(tok0 + j) * 1536 + ch) = pack8(o);
            if (pass == 0) { if (cv < 128) {
#pragma unroll
                for (int e = 0; e < 8; ++e) BT[(cv + e) * 136 + j] = f2bf(o[e]); } }
            else { const float wj = w_s[j * 8 + (pass - 1) * 4 + (cv >> 6)];
#pragma unroll
                for (int e = 0; e < 8; ++e) xsT[(cv + e) * 136 + j] = f2bf(o[e] * wj); } }
        if (pass == 0) continue;
        __syncthreads();
        const int pt = w & 3, nh = w >> 2;
#pragma unroll 1
        for (int hq = 0; hq < 4; ++hq) { const int hl = (pass - 1) * 4 + hq;
            f32x4 acc[4];
#pragma unroll
            for (int nt = 0; nt < 4; ++nt) acc[nt] = (f32x4){0.f, 0.f, 0.f, 0.f};
#pragma unroll
            for (int ks = 0; ks < 4; ++ks) { const bf16x8 a = *(const bf16x8*)(xsT + (hq * 64 + pt * 16 + l15) * 136 + ks * 32 + q * 8);
#pragma unroll
                for (int nt = 0; nt < 4; ++nt) { const bf16x8 bb = *(const bf16x8*)(BT + (nh * 64 + nt * 16 + l15) * 136 + ks * 32 + q * 8); acc[nt] = MFMA16(a, bb, acc[nt]); } }
            bf16_t* sp = st_g + (size_t)(((b * 16 + c) * 16 + 8 * g + hl)) * 8192;
#pragma unroll
            for (int nt = 0; nt < 4; ++nt)
#pragma unroll
                for (int r = 0; r < 4; ++r) sp[(pt * 16 + 4 * q + r) * 128 + nh * 64 + nt * 16 + l15] = f2bf(acc[nt][r]); }
    }
    if (c == 15) {
        for (int idx = tid; idx < 3 * 768; idx += 512) { const int jj = idx / 768, cc = idx % 768; const int ch = cc < 512 ? g * 512 + cc : (cc < 640 ? 1024 + g * 128 + (cc - 512) : 1280 + g * 128 + (cc - 640));
            pk->out[O_SCP + (size_t)(b * 3 + jj) * 1536 + ch] = bf2f(proj[(size_t)(b * 2048 + 2045 + jj) * NPROJ + C_XBC + ch]); }
    }
}

DI void rgconv_item(KP pk_in, int b, int tile) {
    KP pk = pk_in; asm volatile("" : "+s"(pk));
    const int tid = otid();
    const bf16_t* proj = (const bf16_t*)(pk->ws + W_PROJ); bf16_t* mix = (bf16_t*)(pk->ws + W_MIX);
    const int ch = (tid & 127) * 8, t0 = tile * 128 + (tid >> 7) * 32;
    float wgt[4][8], bs[8];
    { const f32x4 b0 = *(const f32x4*)(pk->rg_conv_b + ch), b1 = *(const f32x4*)(pk->rg_conv_b + ch + 4);
      bs[0] = b0[0]; bs[1] = b0[1]; bs[2] = b0[2]; bs[3] = b0[3]; bs[4] = b1[0]; bs[5] = b1[1]; bs[6] = b1[2]; bs[7] = b1[3];
#pragma unroll
      for (int kk = 0; kk < 4; ++kk) { const f32x4 w0 = *(const f32x4*)(pk->rg_conv_w + kk * 1024 + ch), w1 = *(const f32x4*)(pk->rg_conv_w + kk * 1024 + ch + 4);
          wgt[kk][0] = w0[0]; wgt[kk][1] = w0[1]; wgt[kk][2] = w0[2]; wgt[kk][3] = w0[3]; wgt[kk][4] = w1[0]; wgt[kk][5] = w1[1]; wgt[kk][6] = w1[2]; wgt[kk][7] = w1[3]; } }
    const bf16_t* src = proj + (size_t)(b * 2048) * NPROJ + C_RGX + ch;
    u32x4 hist[3];
#pragma unroll
    for (int i = 0; i < 3; ++i) { const int tt = t0 - 3 + i; const u32x4 v = *(const u32x4*)(src + (size_t)(tt < 0 ? 0 : tt) * NPROJ); hist[i] = tt < 0 ? (u32x4){0u, 0u, 0u, 0u} : v; }
    for (int c8 = 0; c8 < 32; c8 += 8) { u32x4 nv[8];
#pragma unroll
        for (int i = 0; i < 8; ++i) nv[i] = *(const u32x4*)(src + (size_t)(t0 + c8 + i) * NPROJ);
#pragma unroll
        for (int i = 0; i < 8; ++i) { float x0[8], x1[8], x2[8], x3[8]; unpack8(hist[0], x0); unpack8(hist[1], x1); unpack8(hist[2], x2); unpack8(nv[i], x3); float acc[8];
#pragma unroll
            for (int e = 0; e < 8; ++e) acc[e] = bs[e] + x0[e] * wgt[0][e] + x1[e] * wgt[1][e] + x2[e] * wgt[2][e] + x3[e] * wgt[3][e];
            *(u32x4*)(mix + (size_t)(b * 2048 + t0 + c8 + i) * DMIX + 1024 + ch) = pack8(acc);
            hist[0] = hist[1]; hist[1] = hist[2]; hist[2] = nv[i]; } }
}

DI void statepass_item(KP pk_in, int sp) {
    KP pk = pk_in; asm volatile("" : "+s"(pk));
    const int b = sp >> 5, h = (sp >> 1) & 15, half = sp & 1; const int e0 = half * 4096 + otid() * 8;
    bf16_t* st_g = (bf16_t*)(pk->ws + W_ST); const float* cd_g = (const float*)(pk->ws + W_CD);
    float run[8] = {0.f, 0.f, 0.f, 0.f, 0.f, 0.f, 0.f, 0.f};
    u32x4 v[16]; float cd[16];
#pragma unroll
    for (int i = 0; i < 16; ++i) { v[i] = *(const u32x4*)(st_g + (size_t)((b * 16 + i) * 16 + h) * 8192 + e0); cd[i] = cd_g[(b * 16 + i) * 16 + h]; }
#pragma unroll
    for (int i = 0; i < 16; ++i) { *(u32x4*)(st_g + (size_t)((b * 16 + i) * 16 + h) * 8192 + e0) = pack8(run); float x[8]; unpack8(v[i], x);
#pragma unroll
        for (int e = 0; e < 8; ++e) run[e] = run[e] * cd[i] + x[e]; }
    float* o = pk->out + O_SHP + (size_t)(b * 16 + h) * 8192 + e0; *(f32x4*)o = (f32x4){run[0], run[1], run[2], run[3]}; *(f32x4*)(o + 4) = (f32x4){run[4], run[5], run[6], run[7]};
}

DI void rg_item(KP pk_in, unsigned char* lds, const bool sample, int bidx, int k, int qd) {
    KP pk = pk_in; asm volatile("" : "+s"(pk));
    unsigned char* ws = pk->ws;
    const int tid = otid(), w = tid >> 6, lane = tid & 63, l15 = lane & 15, q = lane >> 4;
    bf16_t* uA = (bf16_t*)lds;
    float* wagg = (float*)(lds + 34816);
    float* hcar = wagg + 1024;
    bf16_t* wS = (bf16_t*)(lds + 73728);
    const bf16_t* proj = (const bf16_t*)(ws + W_PROJ); bf16_t* mix = (bf16_t*)(ws + W_MIX);
    const bf16_t* wg = (const bf16_t*)(ws + W_WGT) + (size_t)((k * 4 + qd) * 64) * 128;
    __syncthreads();
    for (int idx = tid; idx < 1024; idx += 512) { const int n = idx >> 4, c8 = (idx & 15) * 8; *(u32x4*)(wS + n * 136 + c8) = *(const u32x4*)(wg + n * 128 + c8); }
    if (tid < 64) hcar[tid] = 0.f;
    float ba[2], bi[2], spl[2];
#pragma unroll
    for (int ntl = 0; ntl < 2; ++ntl) { const int ch = k * 128 + qd * 32 + ntl * 16 + l15; ba[ntl] = pk->b_rg_a[ch]; bi[ntl] = pk->b_rg_i[ch]; spl[ntl] = softplusf(-pk->rg_lambda[ch]); }
    const int ntiles = sample ? 1 : 16;
    const int crow = tid >> 2, cg0 = (tid & 3) * 32;
    const bf16_t* ug = mix + 1024;
    u32x4 av[4]; bf16_t uv[8];
#define RG_LOADP(TILE) do { const size_t r0 = (size_t)(bidx * 2048 + (TILE) * 128 + 16 * w); \
        _Pragma("unroll") for (int ks = 0; ks < 4; ++ks) av[ks] = *(const u32x4*)(ug + (r0 + l15) * DMIX + k * 128 + ks * 32 + q * 8); \
        _Pragma("unroll") for (int ntl = 0; ntl < 2; ++ntl) _Pragma("unroll") for (int r = 0; r < 4; ++r) uv[ntl * 4 + r] = ug[(r0 + 4 * q + r) * DMIX + k * 128 + qd * 32 + ntl * 16 + l15]; } while (0)
    if (!sample) RG_LOADP(0);
    bf16x8 afr[4]; float uvf[8];
    for (int tile = 0; tile < ntiles; ++tile) {
        const int par = tile & 1;
        bf16_t gtr[8];
        const size_t rowb = sample ? (size_t)(NTOKP + bidx * 128 + 16 * w + 4 * q) : (size_t)(bidx * 2048 + tile * 128 + 16 * w + 4 * q);
        if (!sample) {
#pragma unroll
          for (int ks = 0; ks < 4; ++ks) afr[ks] = as_frag(av[ks]);
#pragma unroll
          for (int e = 0; e < 8; ++e) uvf[e] = bf2f(uv[e]);
          if (tile + 1 < 16) RG_LOADP(tile + 1);
        } else { const int row = crow;
          __syncthreads();
#pragma unroll
          for (int v = 0; v < 4; ++v) { const int c8 = cg0 + v * 8, ch = k * 128 + c8;
              const f32x4 b0 = *(const f32x4*)(pk->rg_conv_b + ch), b1 = *(const f32x4*)(pk->rg_conv_b + ch + 4);
              float acc[8] = {b0[0], b0[1], b0[2], b0[3], b1[0], b1[1], b1[2], b1[3]};
#pragma unroll
              for (int kk = 0; kk < 4; ++kk) { float x[8];
                  { const int sbi = bidx * 32 + (row >> 2), ui = (row & 3) + kk; const bool st = ui < 3;
                      const float* sp_ = pk->state_rg_conv + (size_t)(sbi * 3 + (st ? ui : 2)) * 1024 + ch; const f32x4 s0 = *(const f32x4*)sp_, s1 = *(const f32x4*)(sp_ + 4);
                      const u32x4 vv = *(const u32x4*)(proj + (size_t)(NTOKP + sbi * 4 + (st ? 0 : ui - 3)) * NPROJ + C_RGX + ch); unpack8(vv, x);
                      x[0] = st ? s0[0] : x[0]; x[1] = st ? s0[1] : x[1]; x[2] = st ? s0[2] : x[2]; x[3] = st ? s0[3] : x[3];
                      x[4] = st ? s1[0] : x[4]; x[5] = st ? s1[1] : x[5]; x[6] = st ? s1[2] : x[6]; x[7] = st ? s1[3] : x[7]; }
                  { const f32x4 w0 = *(const f32x4*)(pk->rg_conv_w + kk * 1024 + ch), w1 = *(const f32x4*)(pk->rg_conv_w + kk * 1024 + ch + 4);
                      acc[0] += x[0] * w0[0]; acc[1] += x[1] * w0[1]; acc[2] += x[2] * w0[2]; acc[3] += x[3] * w0[3];
                      acc[4] += x[4] * w1[0]; acc[5] += x[5] * w1[1]; acc[6] += x[6] * w1[2]; acc[7] += x[7] * w1[3]; } }
              *(u32x4*)(uA + row * 136 + c8) = pack8(acc); }
        }
#pragma unroll
        for (int ntl = 0; ntl < 2; ++ntl)
#pragma unroll
            for (int r = 0; r < 4; ++r) gtr[ntl * 4 + r] = proj[(rowb + r) * NPROJ + C_RGG + k * 128 + qd * 32 + ntl * 16 + l15];
        __syncthreads();
        f32x4 acc[4];
#pragma unroll
        for (int nt = 0; nt < 4; ++nt) acc[nt] = (f32x4){0.f, 0.f, 0.f, 0.f};
#pragma unroll
        for (int ks = 0; ks < 4; ++ks) { const bf16x8 a = sample ? *(const bf16x8*)(uA + (16 * w + l15) * 136 + ks * 32 + q * 8) : afr[ks];
#pragma unroll
            for (int nt = 0; nt < 4; ++nt) { const bf16x8 bb = *(const bf16x8*)(wS + (nt * 16 + l15) * 136 + ks * 32 + q * 8); acc[nt] = MFMA16(a, bb, acc[nt]); } }
        float Ap[2][4], Bp[2][4];
#pragma unroll
        for (int ntl = 0; ntl < 2; ++ntl) { float A = 1.f, B = 0.f;
#pragma unroll
            for (int r = 0; r < 4; ++r) { const int row = 16 * w + 4 * q + r, cl = ntl * 16 + l15;
                const float rr = sigmf(acc[ntl][r] + ba[ntl]), ii = sigmf(acc[2 + ntl][r] + bi[ntl]);
                const float la = -8.f * rr * spl[ntl]; float a = __expf(la); const float uval = sample ? bf2f(uA[row * 136 + qd * 32 + cl]) : uvf[ntl * 4 + r];
                float bt = __builtin_amdgcn_sqrtf(fmaxf(1.f - a * a, 0.f)) * ii * uval;
                const bool first = sample ? (r == 0) : (tile == 0 && row == 0);
                if (first) { const float h0 = sample ? pk->state_rg_h[(size_t)(bidx * 32 + (row >> 2)) * 1024 + k * 128 + qd * 32 + cl] : 0.f; bt += a * h0; a = 0.f; }
                B = a * B + bt; A = a * A; Ap[ntl][r] = A; Bp[ntl][r] = B; } }
        float hq[2], Aex[2], Bex[2];
#pragma unroll
        for (int ntl = 0; ntl < 2; ++ntl) { float A = Ap[ntl][3], B = Bp[ntl][3];
            { const float Ao = shl(A, lane - 16), Bo = shl(B, lane - 16); if (q >= 1) { B = A * Bo + B; A = A * Ao; } }
            { const float Ao = shl(A, lane - 32), Bo = shl(B, lane - 32); if (q >= 2) { B = A * Bo + B; A = A * Ao; } }
            if (q == 3) { wagg[((par * 2 + 0) * 8 + w) * 32 + ntl * 16 + l15] = A; wagg[((par * 2 + 1) * 8 + w) * 32 + ntl * 16 + l15] = B; }
            float Ae = shl(A, lane - 16), Be = shl(B, lane - 16); if (q == 0) { Ae = 1.f; Be = 0.f; }
            Aex[ntl] = Ae; Bex[ntl] = Be; }
        __syncthreads();
#pragma unroll
        for (int ntl = 0; ntl < 2; ++ntl) { const int cl = ntl * 16 + l15; float hin = hcar[par * 32 + cl];
            for (int ww = 0; ww < w; ++ww) hin = wagg[((par * 2 + 0) * 8 + ww) * 32 + cl] * hin + wagg[((par * 2 + 1) * 8 + ww) * 32 + cl];
            hq[ntl] = Aex[ntl] * hin + Bex[ntl];
            if (w == 7 && q == 3) hcar[(par ^ 1) * 32 + cl] = Ap[ntl][3] * hq[ntl] + Bp[ntl][3]; }
#pragma unroll
        for (int ntl = 0; ntl < 2; ++ntl)
#pragma unroll
            for (int r = 0; r < 4; ++r) { const float h = Ap[ntl][r] * hq[ntl] + Bp[ntl][r]; const int chg = k * 128 + qd * 32 + ntl * 16 + l15;
                mix[(rowb + r) * DMIX + chg] = f2bf(h * siluf(bf2f(gtr[ntl * 4 + r])));
                if (sample) { if (r == 3) pk->out[O_RGHS + (size_t)(bidx * 32 + 4 * w + q) * 1024 + chg] = h; }
                else if (tile == 15 && w == 7 && q == 3 && r == 3) pk->out[O_RGHP + (size_t)bidx * 1024 + chg] = h; }
    }
#undef RG_LOADP
    if (!sample) { if (tid < 96) { const int jj = tid >> 5, cl = tid & 31, chg = k * 128 + qd * 32 + cl;
            pk->out[O_RGCP + (size_t)(bidx * 3 + jj) * 1024 + chg] = bf2f(proj[(size_t)(bidx * 2048 + 2045 + jj) * NPROJ + C_RGX + chg]); } }
    else { for (int idx = tid; idx < 32 * 3 * 32; idx += 512) { const int cl = idx & 31, jj = (idx >> 5) % 3, sl = idx / 96; const int sbi = bidx * 32 + sl, chg = k * 128 + qd * 32 + cl;
            pk->out[O_RGCS + (size_t)(sbi * 3 + jj) * 1024 + chg] = bf2f(proj[(size_t)(NTOKP + sbi * 4 + 1 + jj) * NPROJ + C_RGX + chg]); } }
}

DI void attnp_item(KP pk_in, unsigned char* lds, int b, int head, int qt) {
    KP pk = pk_in; asm volatile("" : "+s"(pk));
    unsigned char* ws = pk->ws;
    const int tid = otid(), w = tid >> 6, lane = tid & 63, l15 = lane & 15, q = lane >> 4;
    const bf16_t* proj = (const bf16_t*)(ws + W_PROJ); const bf16_t* kb = (const bf16_t*)(ws + W_KB); const bf16_t* vt = (const bf16_t*)(ws + W_VT); bf16_t* mix = (bf16_t*)(ws + W_MIX);
    const int tokb = b * 2048 + qt * 128 + 16 * w;
    constexpr int RS = 264;
    bf16_t* sm = (bf16_t*)lds;
    const int lr = tid >> 5, lc = (tid & 31) * 8;
    const bf16_t* kbase = kb + (size_t)(b * 256) * 1024 + head * 256; const bf16_t* vbase = vt + (size_t)((b * 4 + head) * 256) * 256;
    u32x4 pre[8];
#define AT_LOAD(S) do { _Pragma("unroll") for (int i = 0; i < 8; ++i) { const int r = lr + 16 * i; \
        pre[i] = (S) < 2 ? *(const u32x4*)(kbase + (size_t)(128 * (S) + r) * 1024 + lc) : *(const u32x4*)(vbase + (size_t)(128 * ((S) - 2) + r) * 256 + lc); } } while (0)
#define AT_STORE() do { _Pragma("unroll") for (int i = 0; i < 8; ++i) *(u32x4*)(sm + (lr + 16 * i) * RS + lc) = pre[i]; } while (0)
    AT_LOAD(0);
    bf16x8 qf[8];
#pragma unroll
    for (int ks = 0; ks < 8; ++ks) qf[ks] = *(const bf16x8*)(proj + (size_t)(tokb + l15) * NPROJ + C_Q + head * 256 + ks * 32 + q * 8);
    f32x4 st[16];
#pragma unroll
    for (int s = 0; s < 2; ++s) {
        __syncthreads(); AT_STORE(); __syncthreads(); AT_LOAD(s + 1);
#pragma unroll
        for (int mtl = 0; mtl < 8; ++mtl) { const int mt = 8 * s + mtl; st[mt] = (f32x4){0.f, 0.f, 0.f, 0.f}; const bf16_t* kp = sm + (16 * mtl + l15) * RS + q * 8;
#pragma unroll
            for (int ks = 0; ks < 8; ++ks) { const bf16x8 kf = *(const bf16x8*)(kp + ks * 32); st[mt] = MFMA16(kf, qf[ks], st[mt]); } }
    }
    float mx = -3.0e38f;
#pragma unroll
    for (int mt = 0; mt < 16; ++mt)
#pragma unroll
        for (int r = 0; r < 4; ++r) { st[mt][r] *= 0.0625f; mx = fmaxf(mx, st[mt][r]); }
    mx = fmaxf(mx, shx(mx, 16, lane)); mx = fmaxf(mx, shx(mx, 32, lane));
    float l = 0.f;
#pragma unroll
    for (int mt = 0; mt < 16; ++mt)
#pragma unroll
        for (int r = 0; r < 4; ++r) { const float e = __expf(st[mt][r] - mx); st[mt][r] = e; l += e; }
    l += shx(l, 16, lane); l += shx(l, 32, lane);
    bf16x8 pf[8];
#pragma unroll
    for (int s = 0; s < 8; ++s) { float m8[8] = {st[2 * s][0], st[2 * s][1], st[2 * s][2], st[2 * s][3], st[2 * s + 1][0], st[2 * s + 1][1], st[2 * s + 1][2], st[2 * s + 1][3]}; pf[s] = as_frag(pack8(m8)); }
    float linv[4];
#pragma unroll
    for (int r = 0; r < 4; ++r) linv[r] = 1.f / shl(l, 4 * q + r);
#pragma unroll
    for (int s2 = 0; s2 < 2; ++s2) {
        __syncthreads(); AT_STORE(); __syncthreads(); if (s2 == 0) AT_LOAD(3);
#pragma unroll
        for (int dtl = 0; dtl < 8; ++dtl) { const int dt = 8 * s2 + dtl; f32x4 o = {0.f, 0.f, 0.f, 0.f}; const bf16_t* vp = sm + (16 * dtl + l15) * RS + 4 * q;
            float gt[4];
#pragma unroll
            for (int r = 0; r < 4; ++r) gt[r] = bf2f(proj[(size_t)(tokb + 4 * q + r) * NPROJ + C_XG + head * 256 + 16 * dt + l15]);
#pragma unroll
            for (int s = 0; s < 8; ++s) { const u32x2 lo = *(const u32x2*)(vp + 32 * s), hi = *(const u32x2*)(vp + 32 * s + 16); o = MFMA16(pf[s], frag2(lo, hi), o); }
#pragma unroll
            for (int r = 0; r < 4; ++r) { const size_t tok = (size_t)(tokb + 4 * q + r); const int d = 16 * dt + l15;
                mix[tok * DMIX + 2048 + head * 256 + d] = f2bf(o[r] * linv[r] * siluf(gt[r])); } }
    }
#undef AT_LOAD
#undef AT_STORE
}

DI float wave_sum(float v, int lane) { v += shx(v, 32, lane); v += shx(v, 16, lane); v += shx(v, 8, lane); v += shx(v, 4, lane); v += shx(v, 2, lane); v += shx(v, 1, lane); return v; }
DI float wave_max(float v, int lane) { v = fmaxf(v, shx(v, 32, lane)); v = fmaxf(v, shx(v, 16, lane)); v = fmaxf(v, shx(v, 8, lane)); v = fmaxf(v, shx(v, 4, lane)); v = fmaxf(v, shx(v, 2, lane)); v = fmaxf(v, shx(v, 1, lane)); return v; }

DI void attns_item(KP pk_in, unsigned char* lds, int sbi, int head) {
    KP pk = pk_in; asm volatile("" : "+s"(pk));
    unsigned char* ws = pk->ws;
    const int tid = otid(), w = tid >> 6, lane = tid & 63;
    const bf16_t* proj = (const bf16_t*)(ws + W_PROJ); bf16_t* mix = (bf16_t*)(ws + W_MIX);
    float* qs = (float*)lds; float* sc = qs + 1024; float* ored = sc + 1024;
    __syncthreads();
    for (int idx = tid; idx < 1024; idx += 512) { const int t = idx >> 8, d = idx & 255; qs[idx] = bf2f(proj[(size_t)(NTOKP + sbi * 4 + t) * NPROJ + C_Q + head * 256 + d]); }
    __syncthreads();
    f32x4 qv[4];
#pragma unroll
    for (int t = 0; t < 4; ++t) qv[t] = *(const f32x4*)(qs + t * 256 + lane * 4);
    for (int m0 = w; m0 < 256; m0 += 64) { f32x4 kv[8];
#pragma unroll
        for (int i = 0; i < 8; ++i) kv[i] = *(const f32x4*)(pk->cache_k + ((size_t)(sbi * 256 + m0 + 8 * i) * 4 + head) * 256 + lane * 4);
        float v32[32];
#pragma unroll
        for (int i = 0; i < 8; ++i)
#pragma unroll
            for (int t = 0; t < 4; ++t) v32[i * 4 + t] = kv[i][0] * qv[t][0] + kv[i][1] * qv[t][1] + kv[i][2] * qv[t][2] + kv[i][3] * qv[t][3];
        float v16[16], v8[8], v4[4], v2[2];
        { const bool up = (lane & 32) != 0;
#pragma unroll
          for (int i = 0; i < 16; ++i) { const float keep = up ? v32[i + 16] : v32[i], send = up ? v32[i] : v32[i + 16]; v16[i] = keep + shx(send, 32, lane); } }
        { const bool up = (lane & 16) != 0;
#pragma unroll
          for (int i = 0; i < 8; ++i) { const float keep = up ? v16[i + 8] : v16[i], send = up ? v16[i] : v16[i + 8]; v8[i] = keep + shx(send, 16, lane); } }
        { const bool up = (lane & 8) != 0;
#pragma unroll
          for (int i = 0; i < 4; ++i) { const float keep = up ? v8[i + 4] : v8[i], send = up ? v8[i] : v8[i + 4]; v4[i] = keep + shx(send, 8, lane); } }
        { const bool up = (lane & 4) != 0;
#pragma unroll
          for (int i = 0; i < 2; ++i) { const float keep = up ? v4[i + 2] : v4[i], send = up ? v4[i] : v4[i + 2]; v2[i] = keep + shx(send, 4, lane); } }
        float v1; { const bool up = (lane & 2) != 0; const float keep = up ? v2[1] : v2[0], send = up ? v2[0] : v2[1]; v1 = keep + shx(send, 2, lane); }
        v1 += shx(v1, 1, lane);
        if ((lane & 1) == 0) { const int ii = lane >> 1; sc[(ii & 3) * 256 + m0 + 8 * (ii >> 2)] = v1 * 0.0625f; } }
    __syncthreads();
    if (w < 4) { const f32x4 v = *(const f32x4*)(sc + w * 256 + lane * 4); float mx = fmaxf(fmaxf(v[0], v[1]), fmaxf(v[2], v[3])); mx = wave_max(mx, lane);
        f32x4 e; e[0] = __expf(v[0] - mx); e[1] = __expf(v[1] - mx); e[2] = __expf(v[2] - mx); e[3] = __expf(v[3] - mx); float s = wave_sum(e[0] + e[1] + e[2] + e[3], lane); const float inv = 1.f / s;
        *(f32x4*)(sc + w * 256 + lane * 4) = e * inv; }
    __syncthreads();
    f32x4 acc[4];
#pragma unroll
    for (int t = 0; t < 4; ++t) acc[t] = (f32x4){0.f, 0.f, 0.f, 0.f};
    for (int m0 = w; m0 < 256; m0 += 64) { f32x4 vv[8];
#pragma unroll
        for (int i = 0; i < 8; ++i) vv[i] = *(const f32x4*)(pk->cache_v + ((size_t)(sbi * 256 + m0 + 8 * i) * 4 + head) * 256 + lane * 4);
#pragma unroll
        for (int i = 0; i < 8; ++i)
#pragma unroll
            for (int t = 0; t < 4; ++t) acc[t] += vv[i] * sc[t * 256 + m0 + 8 * i]; }
#pragma unroll
    for (int t = 0; t < 4; ++t) *(f32x4*)(ored + (w * 4 + t) * 256 + lane * 4) = acc[t];
    __syncthreads();
    for (int idx = tid; idx < 1024; idx += 512) { const int t = idx >> 8, d = idx & 255; float s = 0.f;
#pragma unroll
        for (int ww = 0; ww < 8; ++ww) s += ored[(ww * 4 + t) * 256 + d];
        const size_t tok = (size_t)(NTOKP + sbi * 4 + t); const float gate = bf2f(proj[tok * NPROJ + C_XG + head * 256 + d]); mix[tok * DMIX + 2048 + head * 256 + d] = f2bf(s * siluf(gate)); }
}

DI void ssds_item(KP pk_in, unsigned char* lds, int sbi, int g) {
    KP pk = pk_in; asm volatile("" : "+s"(pk));
    unsigned char* ws = pk->ws;
    const int tid = otid(), w = tid >> 6, lane = tid & 63;
    const bf16_t* proj = (const bf16_t*)(ws + W_PROJ); bf16_t* mix = (bf16_t*)(ws + W_MIX); const float* wdf = (const float*)(ws + W_WDTF);
    float* xs = (float*)lds; float* Bs = xs + 2048; float* Cs = Bs + 512; float* yg = Cs + 512; float* dts = yg + 2048; float* decs = dts + 32;
    __syncthreads();
#pragma unroll
    for (int d = 0; d < 4; ++d) { const int pi = w * 4 + d, t = pi & 3, hl = pi >> 2, h = 8 * g + hl; float s = 0.f;
#pragma unroll
        for (int i = 0; i < 4; ++i) { const f32x4 xv = *(const f32x4*)(pk->x_sample + (size_t)(sbi * 4 + t) * 1024 + i * 256 + lane * 4), wv = *(const f32x4*)(wdf + h * 1024 + i * 256 + lane * 4);
            s += xv[0] * wv[0] + xv[1] * wv[1] + xv[2] * wv[2] + xv[3] * wv[3]; }
        s = wave_sum(s, lane);
        if (lane == 0) { const float dt = softplusf(s + pk->ssd_dt_bias[h]); dts[t * 8 + hl] = dt; decs[t * 8 + hl] = __expf(-dt * __expf(pk->ssd_a_log[h])); } }
    for (int idx = tid; idx < 4 * 768; idx += 512) { const int t = idx / 768, cc = idx % 768; const int ch = cc < 512 ? g * 512 + cc : (cc < 640 ? 1024 + g * 128 + (cc - 512) : 1280 + g * 128 + (cc - 640));
        float acc = pk->ssd_conv_b[ch];
#pragma unroll
        for (int kk = 0; kk < 4; ++kk) { const int ui = t + kk; const bool st = ui < 3;
            const float xs_ = pk->state_ssd_conv[(size_t)(sbi * 3 + (st ? ui : 2)) * 1536 + ch]; const float xp_ = bf2f(proj[(size_t)(NTOKP + sbi * 4 + (st ? 0 : ui - 3)) * NPROJ + C_XBC + ch]);
            acc += (st ? xs_ : xp_) * pk->ssd_conv_w[kk * 1536 + ch]; }
        const float a = siluf(acc);
        if (cc < 512) xs[t * 512 + cc] = a; else if (cc < 640) Bs[t * 128 + cc - 512] = a; else Cs[t * 128 + cc - 640] = a; }
    for (int idx = tid; idx < 3 * 768; idx += 512) { const int jj = idx / 768, cc = idx % 768; const int ch = cc < 512 ? g * 512 + cc : (cc < 640 ? 1024 + g * 128 + (cc - 512) : 1280 + g * 128 + (cc - 640));
        pk->out[O_SCS + (size_t)(sbi * 3 + jj) * 1536 + ch] = bf2f(proj[(size_t)(NTOKP + sbi * 4 + 1 + jj) * NPROJ + C_XBC + ch]); }
    __syncthreads();
    const int pp = tid >> 3, n0 = (tid & 7) * 16;
    f32x4 bvr[4][4], cvr[4][4];
#pragma unroll
    for (int t = 0; t < 4; ++t)
#pragma unroll
        for (int v = 0; v < 4; ++v) { bvr[t][v] = *(const f32x4*)(Bs + t * 128 + n0 + v * 4); cvr[t][v] = *(const f32x4*)(Cs + t * 128 + n0 + v * 4); }
    f32x4 hs[4], hn[4];
#pragma unroll
    for (int v = 0; v < 4; ++v) hn[v] = *(const f32x4*)(pk->state_ssd_h + ((size_t)(sbi * 16 + 8 * g) * 64 + pp) * 128 + n0 + v * 4);
    for (int hl = 0; hl < 8; ++hl) { const int h = 8 * g + hl; const size_t so = ((size_t)(sbi * 16 + h) * 64 + pp) * 128 + n0;
#pragma unroll
        for (int v = 0; v < 4; ++v) hs[v] = hn[v];
        if (hl < 7) {
#pragma unroll
            for (int v = 0; v < 4; ++v) hn[v] = *(const f32x4*)(pk->state_ssd_h + so + 8192 + v * 4); }
        const float dsk = pk->ssd_d[h];
#pragma unroll
        for (int t = 0; t < 4; ++t) { const float dec = decs[t * 8 + hl], xv = xs[t * 512 + hl * 64 + pp], dtx = dts[t * 8 + hl] * xv; float part = 0.f;
#pragma unroll
            for (int v = 0; v < 4; ++v) { const f32x4 bv = bvr[t][v], cv = cvr[t][v];
                hs[v] = hs[v] * dec + bv * dtx; part += cv[0] * hs[v][0] + cv[1] * hs[v][1] + cv[2] * hs[v][2] + cv[3] * hs[v][3]; }
            part += shx(part, 1, lane); part += shx(part, 2, lane); part += shx(part, 4, lane);
            if ((tid & 7) == 0) { const float y = part + dsk * xv; const float z = bf2f(proj[(size_t)(NTOKP + sbi * 4 + t) * NPROJ + C_Z + h * 64 + pp]); yg[t * 512 + hl * 64 + pp] = y * siluf(z); } }
#pragma unroll
        for (int v = 0; v < 4; ++v) *(f32x4*)(pk->out + O_SHS + so + v * 4) = hs[v];
    }
    __syncthreads();
    if (w < 4) { const int t = w; float ss = 0.f; float v[8];
#pragma unroll
        for (int e = 0; e < 8; ++e) { v[e] = yg[t * 512 + e * 64 + lane]; ss += v[e] * v[e]; }
        ss = wave_sum(ss, lane); const float rstd = rsqrtf(ss * (1.f / 512.f) + 1e-5f);
#pragma unroll
        for (int e = 0; e < 8; ++e) { const int cc = e * 64 + lane; mix[(size_t)(NTOKP + sbi * 4 + t) * DMIX + 1024 + g * 512 + cc] = f2bf(v[e] * rstd * pk->ssd_norm_g[g * 512 + cc]); } }
}

DI void ssd3_item(KP pk_in, unsigned char* lds, int b, int c, int g) {
    KP pk = pk_in; asm volatile("" : "+s"(pk));
    unsigned char* ws = pk->ws;
    const int tid = otid(), w = tid >> 6, lane = tid & 63, l15 = lane & 15, q = lane >> 4;
    float* acum_s = (float*)lds; float* cf_s = acum_s + 1024; float* dt_s = cf_s + 1024; float* rstd_s = dt_s + 1024;
    bf16_t* xT = (bf16_t*)(lds + 12800);
    bf16_t* hS = (bf16_t*)(lds + 30208);
    const bf16_t* proj = (const bf16_t*)(ws + W_PROJ); const bf16_t* xact = (const bf16_t*)(ws + W_XACT); bf16_t* mix = (bf16_t*)(ws + W_MIX);
    const float* dt_g = (const float*)(ws + W_DT); const float* acum_g = (const float*)(ws + W_ACUM); const bf16_t* st_g = (const bf16_t*)(ws + W_ST);
    const int tok0 = b * 2048 + c * 128;
    __syncthreads();
    for (int idx = tid; idx < 1024; idx += 512) { const int j = idx >> 3, hl = idx & 7; acum_s[idx] = acum_g[(size_t)(tok0 + j) * 16 + 8 * g + hl]; }
    const int xj = tid >> 3, xpv = (tid & 7) * 8;
    const int hp_ = tid >> 3, hn0 = (tid & 7) * 16;
    u32x4 xr[2]; u32x4 hr[2]; bf16_t zr[16];
#define S3_LOAD(HL) do { const int h_ = 8 * g + (HL); \
        xr[0] = *(const u32x4*)(xact + (size_t)(tok0 + xj) * 1536 + g * 512 + (HL) * 64 + xpv); xr[1] = *(const u32x4*)(xact + (size_t)(tok0 + xj + 64) * 1536 + g * 512 + (HL) * 64 + xpv); \
        { const bf16_t* hp0 = st_g + ((size_t)((b * 16 + c) * 16 + h_) * 64 + hp_) * 128 + hn0; hr[0] = *(const u32x4*)hp0; hr[1] = *(const u32x4*)(hp0 + 8); } \
        _Pragma("unroll") for (int pt = 0; pt < 4; ++pt) _Pragma("unroll") for (int r = 0; r < 4; ++r) zr[pt * 4 + r] = proj[(size_t)(tok0 + 16 * w + 4 * q + r) * NPROJ + C_Z + h_ * 64 + 16 * pt + l15]; } while (0)
    S3_LOAD(0);
    bf16x8 cf[4];
#pragma unroll
    for (int ks = 0; ks < 4; ++ks) cf[ks] = *(const bf16x8*)(xact + (size_t)(tok0 + 16 * w + l15) * 1536 + 1280 + g * 128 + ks * 32 + q * 8);
    f32x4 cbt[8];
#pragma unroll
    for (int jt = 0; jt < 8; ++jt) { cbt[jt] = (f32x4){0.f, 0.f, 0.f, 0.f};
        if (jt <= w) {
#pragma unroll
            for (int ks = 0; ks < 4; ++ks) { const bf16x8 bfr = *(const bf16x8*)(xact + (size_t)(tok0 + 16 * jt + l15) * 1536 + 1024 + g * 128 + ks * 32 + q * 8); cbt[jt] = MFMA16(bfr, cf[ks], cbt[jt]); } } }
    __syncthreads();
    for (int idx = tid; idx < 1024; idx += 512) { const int j = idx >> 3, hl = idx & 7; const float dtv = dt_g[(size_t)(tok0 + j) * 16 + 8 * g + hl]; dt_s[idx] = dtv; cf_s[idx] = __expf(acum_s[(j | 15) * 8 + hl] - acum_s[idx]) * dtv; }
    float ssq[4] = {0.f, 0.f, 0.f, 0.f};
    const int irow = 16 * w + l15;
    for (int hl = 0; hl < 8; ++hl) { const int h = 8 * g + hl;
        __syncthreads();
        { const bf16_t* e0 = (const bf16_t*)&xr[0]; const bf16_t* e1 = (const bf16_t*)&xr[1]; (void)e0; (void)e1;
          const unsigned xw[2][4] = {{xr[0].x, xr[0].y, xr[0].z, xr[0].w}, {xr[1].x, xr[1].y, xr[1].z, xr[1].w}};
#pragma unroll
          for (int hh = 0; hh < 2; ++hh)
#pragma unroll
              for (int e = 0; e < 4; ++e) { xT[(xpv + 2 * e) * 136 + xj + 64 * hh] = (bf16_t)(xw[hh][e] & 0xFFFF); xT[(xpv + 2 * e + 1) * 136 + xj + 64 * hh] = (bf16_t)(xw[hh][e] >> 16); }
          *(u32x4*)(hS + hp_ * 136 + hn0) = hr[0]; *(u32x4*)(hS + hp_ * 136 + hn0 + 8) = hr[1]; }
        float zz[16];
#pragma unroll
        for (int e = 0; e < 16; ++e) zz[e] = bf2f(zr[e]);
        __syncthreads();
        if (hl < 7) S3_LOAD(hl + 1);
        const float ai = acum_s[irow * 8 + hl];
        bf16x8 af[4];
#pragma unroll
        for (int s = 0; s < 4; ++s) { float m8[8];
#pragma unroll
            for (int hf = 0; hf < 2; ++hf) { const int jt = 2 * s + hf;
                const float rf = jt < w ? __expf(ai - acum_s[(16 * jt + 15) * 8 + hl]) : 0.f;
#pragma unroll
                for (int r = 0; r < 4; ++r) { const int j = 16 * jt + 4 * q + r; float val = 0.f;
                    if (jt < w) val = cbt[jt][r] * rf * cf_s[j * 8 + hl];
                    else if (jt == w && j <= irow) val = cbt[jt][r] * __expf(ai - acum_s[j * 8 + hl]) * dt_s[j * 8 + hl];
                    m8[hf * 4 + r] = val; } }
            af[s] = as_frag(pack8(m8)); }
        const float dsk = pk->ssd_d[h];
        float ea[4];
#pragma unroll
        for (int r = 0; r < 4; ++r) ea[r] = __expf(acum_s[(16 * w + 4 * q + r) * 8 + hl]);
#pragma unroll
        for (int pt = 0; pt < 4; ++pt) { f32x4 yd = {0.f, 0.f, 0.f, 0.f}, yo = {0.f, 0.f, 0.f, 0.f};
            const bf16_t* xrw = xT + (16 * pt + l15) * 136;
#pragma unroll
            for (int s = 0; s < 4; ++s) if (2 * s <= w) { const u32x2 lo = *(const u32x2*)(xrw + 32 * s + 4 * q), hi = *(const u32x2*)(xrw + 32 * s + 16 + 4 * q); yd = MFMA16(af[s], frag2(lo, hi), yd); }
            const bf16_t* hrw = hS + (16 * pt + l15) * 136 + q * 8;
#pragma unroll
            for (int ks = 0; ks < 4; ++ks) { const bf16x8 hf = *(const bf16x8*)(hrw + ks * 32); yo = MFMA16(cf[ks], hf, yo); }
            const u32x2 xv2 = *(const u32x2*)(xrw + 16 * w + 4 * q); const float xv[4] = {bflo(xv2.x), bfhi(xv2.x), bflo(xv2.y), bfhi(xv2.y)};
#pragma unroll
            for (int r = 0; r < 4; ++r) { const size_t tok = (size_t)(tok0 + 16 * w + 4 * q + r); const int pp = 16 * pt + l15;
                const float y = yd[r] + ea[r] * yo[r] + dsk * xv[r]; const float val = y * siluf(zz[pt * 4 + r]);
                ssq[r] += val * val; mix[tok * DMIX + 1024 + g * 512 + hl * 64 + pp] = f2bf(val); } }
    }
#pragma unroll
    for (int r = 0; r < 4; ++r) { float sv = ssq[r]; sv += shx(sv, 1, lane); sv += shx(sv, 2, lane); sv += shx(sv, 4, lane); sv += shx(sv, 8, lane); if (l15 == 0) rstd_s[16 * w + 4 * q + r] = rsqrtf(sv * (1.f / 512.f) + 1e-5f); }
    asm volatile("s_waitcnt vmcnt(0)" ::: "memory");
    __syncthreads();
    for (int idx = tid; idx < 128 * 64; idx += 512) { const int row = idx >> 6, c8 = (idx & 63) * 8; bf16_t* mp = mix + (size_t)(tok0 + row) * DMIX + 1024 + g * 512 + c8;
        const u32x4 v = *(const u32x4*)mp; float x[8]; unpack8(v, x); const float rs = rstd_s[row];
        const f32x4 g0 = *(const f32x4*)(pk->ssd_norm_g + g * 512 + c8), g1 = *(const f32x4*)(pk->ssd_norm_g + g * 512 + c8 + 4);
        x[0] *= rs * g0[0]; x[1] *= rs * g0[1]; x[2] *= rs * g0[2]; x[3] *= rs * g0[3]; x[4] *= rs * g1[0]; x[5] *= rs * g1[1]; x[6] *= rs * g1[2]; x[7] *= rs * g1[3];
        *(u32x4*)mp = pack8(x); }
#undef S3_LOAD
}

DI void outs_item(KP pk_in, unsigned char* lds, int piece) {
    KP pk = pk_in; asm volatile("" : "+s"(pk));
    const int tid = otid(), w = tid >> 6, lane = tid & 63, l15 = lane & 15, q = lane >> 4;
    const int rg = piece >> 4, cgp = piece & 15;
    const bf16_t* mix = (const bf16_t*)(pk->ws + W_MIX); const bf16_t* wo = (const bf16_t*)(pk->ws + W_WOUTT); float* res = (float*)(pk->ws + W_RES);
    float* part = (float*)lds;
    f32x4 acc[2][4];
#pragma unroll
    for (int mt = 0; mt < 2; ++mt)
#pragma unroll
        for (int nt = 0; nt < 4; ++nt) acc[mt][nt] = (f32x4){0.f, 0.f, 0.f, 0.f};
    const bf16_t* ap = mix + (size_t)(NTOKP + rg * 32 + l15) * DMIX + w * 384 + q * 8;
    const bf16_t* bp = wo + (size_t)(cgp * 64 + l15) * 3072 + w * 384 + q * 8;
#pragma unroll 4
    for (int ks = 0; ks < 12; ++ks) { bf16x8 a[2], bb[4];
#pragma unroll
        for (int mt = 0; mt < 2; ++mt) a[mt] = *(const bf16x8*)(ap + (size_t)mt * 16 * DMIX + ks * 32);
#pragma unroll
        for (int nt = 0; nt < 4; ++nt) bb[nt] = *(const bf16x8*)(bp + (size_t)nt * 16 * 3072 + ks * 32);
#pragma unroll
        for (int mt = 0; mt < 2; ++mt)
#pragma unroll
            for (int nt = 0; nt < 4; ++nt) acc[mt][nt] = MFMA16(a[mt], bb[nt], acc[mt][nt]); }
    __syncthreads();
#pragma unroll
    for (int mt = 0; mt < 2; ++mt)
#pragma unroll
        for (int nt = 0; nt < 4; ++nt)
#pragma unroll
            for (int r = 0; r < 4; ++r) part[(w * 32 + mt * 16 + 4 * q + r) * 64 + nt * 16 + l15] = acc[mt][nt][r];
    __syncthreads();
    { const int row = tid >> 4, c4 = (tid & 15) * 4; f32x4 sum = {0.f, 0.f, 0.f, 0.f};
#pragma unroll
      for (int ww = 0; ww < 8; ++ww) sum += *(const f32x4*)(part + (ww * 32 + row) * 64 + c4);
      const int srow = rg * 32 + row, col = cgp * 64 + c4; const f32x4 xv = *(const f32x4*)(pk->x_sample + (size_t)srow * 1024 + col);
      *(f32x4*)(res + (size_t)(NTOKP + srow) * 1024 + col) = sum + xv * 1.189207115002721f; }
    __syncthreads();
}

DI void ln_rows(KP pk_in) {
    KP pk = pk_in; asm volatile("" : "+s"(pk));
    const float* res = (const float*)(pk->ws + W_RES);
    const int tid = otid(); const int lane = tid & 63; const int gw = obid() * 8 + (tid >> 6), nw = gridDim.x * 8;
    f32x4 gg[4], bb[4];
#pragma unroll
    for (int i = 0; i < 4; ++i) { gg[i] = *(const f32x4*)(pk->ln_g + i * 256 + lane * 4); bb[i] = *(const f32x4*)(pk->ln_b + i * 256 + lane * 4); }
    for (int row = gw; row < NTOK; row += nw) { f32x4 v[4]; float s = 0.f;
#pragma unroll
        for (int i = 0; i < 4; ++i) { v[i] = *(const f32x4*)(res + (size_t)row * 1024 + i * 256 + lane * 4); s += v[i][0] + v[i][1] + v[i][2] + v[i][3]; }
        const float mu = wave_sum(s, lane) * (1.f / 1024.f); float s2 = 0.f;
#pragma unroll
        for (int i = 0; i < 4; ++i) { v[i] = v[i] - mu; s2 += v[i][0] * v[i][0] + v[i][1] * v[i][1] + v[i][2] * v[i][2] + v[i][3] * v[i][3]; }
        const float rstd = rsqrtf(wave_sum(s2, lane) * (1.f / 1024.f) + 1e-5f);
#pragma unroll
        for (int i = 0; i < 4; ++i) *(f32x4*)(pk->out + (size_t)row * 1024 + i * 256 + lane * 4) = v[i] * rstd * gg[i] + bb[i]; }
}

__global__ void __launch_bounds__(512, 2) hymba_fwd(Params p_unused) {
    KP pk = kparams();
    extern __shared__ __attribute__((aligned(16))) unsigned char shm[];
    cg::grid_group grid = cg::this_grid();
    const int G = gridDim.x;
    if (threadIdx.x < 4) ((volatile LAS unsigned*)(LAS unsigned char*)shm)[32768 + threadIdx.x] = 0u;
    __syncthreads();
    const int ph_lo_chk = pk->ph_lo;
    XcdBarrier xb = xcd_barrier_post((unsigned*)(pk->ws + W_BAR), (volatile LAS unsigned*)(LAS unsigned char*)shm + 32768);
    if (ph_lo_chk < 0) grid.sync();
    { KP pk = kparams(); for (int rep = 0; rep < REP0; ++rep) phase_prep(pk, shm); }
    xcd_barrier(xb);
    for (int rep = 1; rep < REPS; ++rep) xcd_barrier(xb);
    { KP pk = kparams(); const int bid = obid();
      for (int rep = 0; rep < REP1; ++rep) {
        { pg8::Gemm g; g.A = (const bf16_t*)(pk->ws + W_XB); g.Bt = (const bf16_t*)(pk->ws + W_WINT); g.M = NTOK; g.N = NPROJ; g.K = 1024;
          pg8::StaticOrder S; S.init(g.M, g.N, G, bid); pg8::EpiBf16 E; E.O = (bf16_t*)(pk->ws + W_PROJ); E.ldc = NPROJ;
          pg8::gemm_phase<pg8::EpiBf16, pg8::StaticOrder>((LAS unsigned char*)shm, g, S, E); }
        { pg8::Gemm g; g.A = (const bf16_t*)(pk->ws + W_MEMB); g.Bt = (const bf16_t*)(pk->ws + W_WKVT); g.M = 2048; g.N = 2048; g.K = 1024;
          const int shift = (66 * 26) % G; pg8::StaticOrder S; S.init(g.M, g.N, G, (bid + G - shift) % G);
          pg8::EpiKV E; E.mk = pk->out + O_MKP; E.mv = pk->out + O_MVP; E.kb = (bf16_t*)(pk->ws + W_KB); E.vt = (bf16_t*)(pk->ws + W_VT);
          pg8::gemm_phase<pg8::EpiKV, pg8::StaticOrder>((LAS unsigned char*)shm, g, S, E); } } }
    xcd_barrier(xb);
    { KP pk = kparams(); const int bid = obid();
      for (int rep = 0; rep < REP2; ++rep) for (int it = bid; it < 512; it += G) { if (it < 256) ssd1_item(pk, shm, it >> 5, (it >> 1) & 15, it & 1); else if (it < 384) rgconv_item(pk, (it - 256) >> 4, (it - 256) & 15); else { const int u = it - 384; rg_item(pk, shm, true, u >> 5, (u >> 2) & 7, u & 3); } } }
    xcd_barrier(xb);
    { KP pk = kparams(); const int bid = obid();
      for (int rep = 0; rep < REP3; ++rep) for (int kk = 0; kk < 7; ++kk) { const int kq = kk; const int it = bid + kq * G;
          if (it >= 1792) continue;
          if (rep > 0 && (it < R3LO || it >= R3HI)) continue;
          if (it < 256) rg_item(pk, shm, false, it >> 5, (it >> 2) & 7, it & 3);
          else if (it < 512) statepass_item(pk, it - 256);
          else if (it < 768) { const int u = it - 512; ssds_item(pk, shm, u >> 1, u & 1); }
          else if (it < 1280) { const int u = it - 768; attns_item(pk, shm, u >> 2, u & 3); }
          else { const int u = it - 1280; attnp_item(pk, shm, u >> 6, (u >> 4) & 3, u & 15); } } }
    xcd_barrier(xb);
    { KP pk = kparams(); const int bid = obid();
      for (int rep = 0; rep < REP4; ++rep) for (int it = bid; it < 256; it += G) ssd3_item(pk, shm, it >> 5, (it >> 1) & 15, it & 1); }
    xcd_barrier(xb);
    { KP pk = kparams(); const int bid = obid();
      for (int rep = 0; rep < REP5; ++rep) {
        for (int it = bid; it < 256; it += G) outs_item(pk, shm, it);
        pg8::Gemm g; g.A = (const bf16_t*)(pk->ws + W_MIX); g.Bt = (const bf16_t*)(pk->ws + W_WOUTT); g.M = NTOKP; g.N = 1024; g.K = 3072;
        pg8::StaticOrder S; S.init(g.M, g.N, G, bid); pg8::EpiRes E; E.res = (float*)(pk->ws + W_RES); E.xp = pk->x_prompt; E.xs = pk->x_sample; E.alpha = 1.189207115002721f;
        pg8::gemm_phase<pg8::EpiRes, pg8::StaticOrder>((LAS unsigned char*)shm, g, S, E); } }
    xcd_barrier(xb);
    { KP pk = kparams(); for (int rep = 0; rep < REP6; ++rep) ln_rows(pk); }
}

extern "C" void kernel_launch(void* const* d_in, const int* in_sizes, int n_in, void* d_out, int out_size, void* d_ws, size_t ws_size, hipStream_t stream) {
    static int grid_blocks = 0;
    if (!grid_blocks) {
        int dev = 0, cus = 0, per_cu = 0;
        hipGetDevice(&dev);
        hipDeviceGetAttribute(&cus, hipDeviceAttributeMultiprocessorCount, dev);
        if (hipFuncSetAttribute((const void*)hymba_fwd, hipFuncAttributeMaxDynamicSharedMemorySize, LDS_BYTES) != hipSuccess) fprintf(stderr, "hipFuncSetAttribute failed\n");
        hipOccupancyMaxActiveBlocksPerMultiprocessor(&per_cu, (const void*)hymba_fwd, 512, LDS_BYTES);
        if (per_cu < 1) { fprintf(stderr, "occupancy query says %d blocks per CU\n", per_cu); per_cu = 1; }
        grid_blocks = cus * 1;
        if (ws_size < W_END) fprintf(stderr, "workspace too small: %zu < %zu\n", ws_size, (size_t)W_END);
    }
    if (hipMemsetAsync((char*)d_ws + W_BAR, 0, 3456 * 4, stream) != hipSuccess) fprintf(stderr, "memset failed\n");
    Params p{};
    const float** fp = (const float**)&p;
    for (int i = 0; i < 28; ++i) fp[i] = (const float*)d_in[i];
    p.out = (float*)d_out; p.ws = (unsigned char*)d_ws;
    p.ph_lo = 0; p.ph_hi = NPHASE;
    void* args[] = {&p};
    hipError_t e = hipLaunchCooperativeKernel((const void*)hymba_fwd, dim3(grid_blocks), dim3(512), args, LDS_BYTES, stream);
    if (e != hipSuccess) fprintf(stderr, "cooperative launch failed: %s (grid %d)\n", hipGetErrorString(e), grid_blocks);
}
```

```cpp
#include <hip/hip_runtime.h>
#include <hip/hip_cooperative_groups.h>
#include <cstdio>
namespace cg = cooperative_groups;

#ifndef REP2
#define REP2 1
#endif
#ifndef REP3
#define REP3 1
#endif
#ifndef REP4
#define REP4 1
#endif
#ifndef R3LO
#define R3LO 0
#define R3HI 256
#endif
#ifndef REP0
#define REP0 1
#endif
#ifndef REP1
#define REP1 1
#endif
#ifndef REP5
#define REP5 1
#endif
#ifndef REP6
#define REP6 1
#endif
#ifndef REPS
#define REPS 1
#endif
#ifndef PHM
#define PHM 127
#endif
#ifndef N_LAUNCH_PER_PHASE
#define N_LAUNCH_PER_PHASE 0
#endif

#define DI __device__ __forceinline__
#define LAS __attribute__((address_space(3)))
typedef unsigned short bf16_t;
typedef short bf16x8 __attribute__((ext_vector_type(8)));
typedef float f32x4 __attribute__((ext_vector_type(4)));
typedef unsigned u32x4 __attribute__((ext_vector_type(4)));
typedef unsigned u32x2 __attribute__((ext_vector_type(2)));

constexpr int NTOKP = 16384, NTOKS = 512, NTOK = 16896, DM = 1024, NPROJ = 6656, DMIX = 3072, DIN = 6672;
constexpr int C_RGX = 0, C_RGG = 1024, C_XBC = 2048, C_Z = 3584, C_Q = 4608, C_XG = 5632;
constexpr int NPHASE = 7;
constexpr int LDS_BYTES = 131072 + 64;

constexpr size_t O_YP = 0, O_YS = O_YP + (size_t)NTOKP * DM, O_RGCP = O_YS + (size_t)NTOKS * DM, O_RGHP = O_RGCP + 8 * 3 * 1024, O_SCP = O_RGHP + 8 * 1024,
                 O_SHP = O_SCP + 8 * 3 * 1536, O_MKP = O_SHP + (size_t)8 * 16 * 64 * 128, O_MVP = O_MKP + (size_t)2048 * 1024, O_RGCS = O_MVP + (size_t)2048 * 1024,
                 O_RGHS = O_RGCS + (size_t)128 * 3 * 1024, O_SCS = O_RGHS + 128 * 1024, O_SHS = O_SCS + (size_t)128 * 3 * 1536;

constexpr size_t al256(size_t x) { return (x + 255) & ~(size_t)255; }
constexpr size_t W_XB = 0;
constexpr size_t W_WINT = al256(W_XB + (size_t)NTOK * DM * 2);
constexpr size_t W_WDTT = al256(W_WINT + (size_t)NPROJ * DM * 2);
constexpr size_t W_WDTF = al256(W_WDTT + 16 * 1024 * 2);
constexpr size_t W_WOUTT = al256(W_WDTF + 16 * 1024 * 4);
constexpr size_t W_WKVT = al256(W_WOUTT + (size_t)1024 * 3072 * 2);
constexpr size_t W_MEMB = al256(W_WKVT + (size_t)2048 * 1024 * 2);
constexpr size_t W_WGT = al256(W_MEMB + (size_t)2048 * 1024 * 2);
constexpr size_t W_KB = al256(W_WGT + (size_t)8 * 4 * 64 * 128 * 2);
constexpr size_t W_VT = al256(W_KB + (size_t)2048 * 1024 * 2);
constexpr size_t W_XACT = al256(W_VT + (size_t)2048 * 1024 * 2);
constexpr size_t W_DT = al256(W_XACT + (size_t)NTOKP * 1536 * 2);
constexpr size_t W_ACUM = al256(W_DT + (size_t)NTOKP * 16 * 4);
constexpr size_t W_CD = al256(W_ACUM + (size_t)NTOKP * 16 * 4);
constexpr size_t W_ST = al256(W_CD + 8 * 16 * 16 * 4);
constexpr size_t W_MIX = al256(W_ST + (size_t)8 * 16 * 16 * 8192 * 4);
constexpr size_t W_PROJ = al256(W_MIX + (size_t)NTOK * DMIX * 2);
constexpr size_t W_RES = W_PROJ;
constexpr size_t W_BAR = al256(W_PROJ + (size_t)NTOK * NPROJ * 2);
constexpr size_t W_CNT = al256(W_BAR + 3456 * 4);
constexpr size_t W_STAT = al256(W_CNT + 80 * 256);
constexpr size_t W_ZERO_END = al256(W_STAT + (size_t)NTOKS * 2 * 4);
constexpr size_t W_SLOT = W_ZERO_END;
constexpr size_t W_END = al256(W_SLOT + (size_t)NTOKP * 8 * 4);

struct Params {
    const float *x_prompt, *x_sample, *mem_prompt, *state_rg_conv, *state_rg_h, *state_ssd_conv, *state_ssd_h, *cache_k, *cache_v;
    const float *w_in, *rg_conv_w, *rg_conv_b, *w_rg_a, *b_rg_a, *w_rg_i, *b_rg_i, *rg_lambda, *ssd_conv_w, *ssd_conv_b, *ssd_dt_bias, *ssd_a_log, *ssd_d, *ssd_norm_g,
        *w_mem_k, *w_mem_v, *w_out, *ln_g, *ln_b;
    float* out; unsigned char* ws;
    int ph_lo, ph_hi;
};
typedef const __attribute__((address_space(4))) Params* KP;
DI KP kparams() { KP k = (KP)__builtin_amdgcn_kernarg_segment_ptr(); asm volatile("" : "+s"(k)); return k; }

DI int otid() { int t = threadIdx.x; asm volatile("" : "+v"(t)); return t; }
DI int obid() { int t = blockIdx.x; asm volatile("" : "+s"(t)); return t; }
DI float bf2f(bf16_t b) { return __uint_as_float(((unsigned)b) << 16); }
typedef __bf16 hbf2 __attribute__((ext_vector_type(2)));
typedef float f32x2 __attribute__((ext_vector_type(2)));
DI unsigned pack2(float lo, float hi) { const f32x2 v = {lo, hi}; return __builtin_bit_cast(unsigned, __builtin_convertvector(v, hbf2)); }
DI bf16_t f2bf(float f) { return (bf16_t)(pack2(f, 0.f) & 0xFFFFu); }
DI float bflo(unsigned w) { return __uint_as_float(w << 16); }
DI float bfhi(unsigned w) { return __uint_as_float(w & 0xFFFF0000u); }
DI void unpack8(const u32x4 v, float (&o)[8]) { o[0] = bflo(v.x); o[1] = bfhi(v.x); o[2] = bflo(v.y); o[3] = bfhi(v.y); o[4] = bflo(v.z); o[5] = bfhi(v.z); o[6] = bflo(v.w); o[7] = bfhi(v.w); }
DI u32x4 pack8(const float (&o)[8]) { u32x4 w; w.x = pack2(o[0], o[1]); w.y = pack2(o[2], o[3]); w.z = pack2(o[4], o[5]); w.w = pack2(o[6], o[7]); return w; }
DI bf16x8 as_frag(u32x4 w) { return __builtin_bit_cast(bf16x8, w); }
DI bf16x8 frag2(u32x2 lo, u32x2 hi) { u32x4 w; w.x = lo.x; w.y = lo.y; w.z = hi.x; w.w = hi.y; return __builtin_bit_cast(bf16x8, w); }
DI float shx(float v, int m, int lane) { return __int_as_float(__builtin_amdgcn_ds_bpermute((lane ^ m) << 2, __float_as_int(v))); }
DI float shl(float v, int src) { return __int_as_float(__builtin_amdgcn_ds_bpermute(src << 2, __float_as_int(v))); }
DI float siluf(float x) { return x * __builtin_amdgcn_rcpf(1.f + __expf(-x)); }
DI float sigmf(float x) { return __builtin_amdgcn_rcpf(1.f + __expf(-x)); }
DI float softplusf(float v) { return v > 20.f ? v : __logf(1.f + __expf(v)); }
#define MFMA16(a, b, c) __builtin_amdgcn_mfma_f32_16x16x32_bf16((a), (b), (c), 0, 0, 0)

#define XB_TMO      128
#define XB_XCNT(j)  (256  + 64 * (j))
#define XB_XSUB(j)  (1280 + 64 * (j))
#define XB_XGEN(j)  (2304 + 64 * (j))
#define XB_TOP      3328
#define XB_TOPGEN   3392
#define XCD_BAR_WORDS 3456
#define XB_SPIN_CAP (1u << 20)
DI unsigned xb_ld(unsigned* ptr)              { return __hip_atomic_load(ptr, __ATOMIC_RELAXED, __HIP_MEMORY_SCOPE_AGENT); }
DI unsigned xb_add(unsigned* ptr, unsigned v) { return __hip_atomic_fetch_add(ptr, v, __ATOMIC_RELAXED, __HIP_MEMORY_SCOPE_AGENT); }
DI unsigned xb_xcc_id() { return (unsigned)__builtin_amdgcn_s_getreg((3 << 11) | 20) & 0xFu; }
#define XB_SPIN(cond, bar) do { unsigned _sp = 0; while (cond) { __builtin_amdgcn_s_sleep(1); \
    if ((++_sp & 255u) == 0u) { if (xb_ld(&(bar)[XB_TMO])) break; if (_sp > XB_SPIN_CAP) { atomicAdd(&(bar)[XB_TMO], 1u); break; } } } } while (0)
struct XcdBarrier { unsigned* bar; unsigned x; volatile LAS unsigned* st; };
DI XcdBarrier xcd_barrier_post(unsigned* bar, volatile LAS unsigned* st) {
    XcdBarrier b; b.bar = bar; b.x = xb_xcc_id(); b.st = st;
    if (threadIdx.x == 0) (void)xb_add(&bar[XB_XCNT(b.x)], 1u);
    return b;
}
DI void xcd_barrier_complete(unsigned* bar, unsigned x, unsigned& nloc, unsigned& nx) {
    const unsigned G = gridDim.x * gridDim.y * gridDim.z;
    unsigned sum, cnt, mine, sp = 0u;
    for (;;) {
        sum = 0u; cnt = 0u; mine = 0u;
#pragma unroll
        for (unsigned j = 0; j < 16; ++j) { const unsigned c = xb_ld(&bar[XB_XCNT(j)]); sum += c; cnt += (c > 0u) ? 1u : 0u; mine = (j == x) ? c : mine; }
        if (sum == G) break;
        __builtin_amdgcn_s_sleep(1);
        if ((++sp & 255u) == 0u) { if (xb_ld(&bar[XB_TMO])) break; if (sp > XB_SPIN_CAP) { atomicAdd(&bar[XB_TMO], 1u); break; } }
    }
    nloc = mine > 0u ? mine : 1u; nx = cnt > 0u ? cnt : 1u;
}
DI void xcd_barrier(const XcdBarrier& b) {
    asm volatile("s_waitcnt vmcnt(0)" ::: "memory");
    __syncthreads();
    if (threadIdx.x == 0) {
        unsigned* bar = b.bar;
        __builtin_amdgcn_s_waitcnt(0);
        unsigned nloc = b.st[0], nx = b.st[1];
        if (nloc == 0u) { xcd_barrier_complete(bar, b.x, nloc, nx); b.st[0] = nloc; b.st[1] = nx; }
        const unsigned old = xb_add(&bar[XB_XSUB(b.x)], 1u);
        const unsigned gen = old / nloc;
        if (old + 1u == (gen + 1u) * nloc) {
            __builtin_amdgcn_fence(__ATOMIC_RELEASE, "agent");
            asm volatile("s_waitcnt vmcnt(0)" ::: "memory");
            const unsigned og = xb_add(&bar[XB_TOP], 1u);
            const unsigned tg = og / nx;
            if (og + 1u == (tg + 1u) * nx) xb_add(&bar[XB_TOPGEN], 1u);
            else XB_SPIN(xb_ld(&bar[XB_TOPGEN]) == tg, bar);
            __builtin_amdgcn_fence(__ATOMIC_ACQUIRE, "agent");
            xb_add(&bar[XB_XGEN(b.x)], 1u);
            asm volatile("s_waitcnt vmcnt(0)" ::: "memory");
        } else {
            XB_SPIN(xb_ld(&bar[XB_XGEN(b.x)]) == gen, bar);
            __builtin_amdgcn_fence(__ATOMIC_ACQUIRE, "agent");
            asm volatile("s_waitcnt vmcnt(0)" ::: "memory");
        }
    }
    __syncthreads();
}

namespace pg8 {
constexpr int BM = 256, BK = 64, HALF = 128, HTB = HALF * BK * 2, STAGE_BYTES = 8 * HTB, NXCD = 8, WGM = 8;
DI int lds_byte(int r, int c) { const int st = (r >> 4) * 2 + (c >> 5), rr = r & 15, cc = c & 31, ob = rr * 64 + cc * 2; return st * 1024 + (ob ^ (((ob >> 9) & 1) << 5)); }
DI void stage_rc(int b, int& R, int& C) { const int st = b / 1024, sb = b % 1024, swz = sb ^ (((sb >> 9) & 1) << 5); R = (st >> 1) * 16 + swz / 64; C = (st & 1) * 32 + (swz % 64) / 2; }
DI int perm32(int rho) { const int n = rho >> 4, i = rho & 15; return 8 * (i >> 2) + 4 * n + (i & 3); }
struct Unit { int pm, pn; };
struct Gemm { const bf16_t* A; const bf16_t* Bt; int M, N, K; };
struct StaticOrder {
    int nM, nN, nwg, G, c;
    DI void init(int M, int N, int G_, int c_) { nM = M / BM; nN = N / BM; nwg = nM * nN; G = G_; c = c_; }
    DI bool next(int i, Unit& u) const {
        const long L = (long)i * G + c; if (L >= nwg) return false;
        int wgid = (int)L; { const int q = nwg / NXCD, r = nwg % NXCD, xcd = wgid % NXCD, off = wgid / NXCD; wgid = (xcd < r ? xcd * (q + 1) : r * (q + 1) + (xcd - r) * q) + off; }
        const int nig = WGM * nN, gid = wgid / nig, fm = gid * WGM, gsz = (nM - fm) < WGM ? (nM - fm) : WGM;
        u.pm = fm + ((wgid % nig) % gsz); u.pn = (wgid % nig) / gsz; return true;
    }
};
DI unsigned cvt_pk_bf16(float lo, float hi) { unsigned r; asm volatile("v_cvt_pk_bf16_f32 %0, %1, %2" : "=v"(r) : "v"(lo), "v"(hi)); return r; }

struct EpiBf16 {
    static constexpr bool PERM = true, AFTER_DRAIN = false;
    bf16_t* O; int ldc;
    DI void operator()(const f32x4 (&acc)[2][2][4][2], const Unit& u, int wr, int wc, int fr, int fq) const {
        const int row0 = u.pm * BM + wr * 64 + fr; const int col0 = u.pn * BM + wc * 32 + 8 * fq;
#pragma unroll
        for (int ai = 0; ai < 2; ++ai)
#pragma unroll
            for (int m = 0; m < 4; ++m) { bf16_t* rowp = O + (size_t)(row0 + ai * HALF + m * 16) * ldc + col0;
#pragma unroll
                for (int bj = 0; bj < 2; ++bj) { const f32x4 v0 = acc[ai][bj][m][0], v1 = acc[ai][bj][m][1];
                    u32x4 w; w.x = cvt_pk_bf16(v0[0], v0[1]); w.y = cvt_pk_bf16(v0[2], v0[3]); w.z = cvt_pk_bf16(v1[0], v1[1]); w.w = cvt_pk_bf16(v1[2], v1[3]);
                    *(u32x4*)(rowp + bj * HALF) = w; } }
    }
};
struct EpiKV {
    static constexpr bool PERM = false, AFTER_DRAIN = false;
    float* mk; float* mv; bf16_t* kb; bf16_t* vt;
    DI void operator()(const f32x4 (&acc)[2][2][4][2], const Unit& u, int wr, int wc, int fr, int fq) const {
        const int row0 = u.pm * BM + wr * 64 + fr, col0 = u.pn * BM + wc * 32 + 4 * fq;
#pragma unroll
        for (int ai = 0; ai < 2; ++ai)
#pragma unroll
            for (int m = 0; m < 4; ++m) { const int row = row0 + ai * HALF + m * 16;
#pragma unroll
                for (int bj = 0; bj < 2; ++bj)
#pragma unroll
                    for (int n = 0; n < 2; ++n) { const int col = col0 + bj * HALF + n * 16; const f32x4 v = acc[ai][bj][m][n];
                        if (col < 1024) { *(f32x4*)(mk + (size_t)row * 1024 + col) = v; u32x2 w; w.x = cvt_pk_bf16(v[0], v[1]); w.y = cvt_pk_bf16(v[2], v[3]); *(u32x2*)(kb + (size_t)row * 1024 + col) = w; }
                        else { const int cc = col - 1024; *(f32x4*)(mv + (size_t)row * 1024 + cc) = v; const int bb = row >> 8, mt = row & 255;
#pragma unroll
                            for (int j = 0; j < 4; ++j) { const int c2 = cc + j, head = c2 >> 8, d = c2 & 255; vt[((size_t)((bb * 4 + head) * 256 + d)) * 256 + mt] = f2bf(v[j]); } } } }
    }
};
DI void ln_wait(unsigned* cnt, unsigned target) { unsigned sp = 0; while (__hip_atomic_load(cnt, __ATOMIC_RELAXED, __HIP_MEMORY_SCOPE_AGENT) < target) { __builtin_amdgcn_s_sleep(1); if (++sp > (1u << 22)) break; } }
struct EpiLn {
    static constexpr bool PERM = false, AFTER_DRAIN = true;
    float* out; const float* xp; const float* lng; const float* lnb; float* stat; unsigned* cnt; float alpha; LAS float* red;
    DI void operator()(f32x4 (&acc)[2][2][4][2], const Unit& u, int wr, int wc, int fr, int fq) const {
        const int row0 = u.pm * BM + wr * 64 + fr, col0 = u.pn * BM + wc * 32 + 4 * fq; const int lane = fq * 16 + fr; const int tid = (wr * 4 + wc) * 64 + lane;
#pragma unroll
        for (int ai = 0; ai < 2; ++ai)
#pragma unroll
            for (int m = 0; m < 4; ++m) { const int row = row0 + ai * HALF + m * 16; const float* xr = xp + (size_t)row * 1024; float s1 = 0.f, s2 = 0.f;
#pragma unroll
                for (int bj = 0; bj < 2; ++bj)
#pragma unroll
                    for (int n = 0; n < 2; ++n) { const int col = col0 + bj * HALF + n * 16; const f32x4 xv = *(const f32x4*)(xr + col); const f32x4 v = acc[ai][bj][m][n] + xv * alpha; acc[ai][bj][m][n] = v;
                        s1 += v[0] + v[1] + v[2] + v[3]; s2 += v[0] * v[0] + v[1] * v[1] + v[2] * v[2] + v[3] * v[3]; }
                s1 += shx(s1, 16, lane); s1 += shx(s1, 32, lane); s2 += shx(s2, 16, lane); s2 += shx(s2, 32, lane);
                if (fq == 0) { const int lr = wr * 64 + ai * HALF + m * 16 + fr; red[(lr * 4 + wc) * 2] = s1; red[(lr * 4 + wc) * 2 + 1] = s2; } }
        __syncthreads();
        if (tid < 256) { const int lr = tid; float t1 = 0.f, t2 = 0.f;
#pragma unroll
            for (int c = 0; c < 4; ++c) { t1 += red[(lr * 4 + c) * 2]; t2 += red[(lr * 4 + c) * 2 + 1]; }
            float* sp = stat + ((size_t)(u.pm * BM + lr) * 4 + u.pn) * 2;
            __hip_atomic_store(sp, t1, __ATOMIC_RELAXED, __HIP_MEMORY_SCOPE_AGENT); __hip_atomic_store(sp + 1, t2, __ATOMIC_RELAXED, __HIP_MEMORY_SCOPE_AGENT);
            asm volatile("s_waitcnt vmcnt(0)" ::: "memory"); }
        __syncthreads();
        unsigned* c = cnt + u.pm * 64;
        if (tid == 0) { __hip_atomic_fetch_add(c, 1u, __ATOMIC_RELAXED, __HIP_MEMORY_SCOPE_AGENT); ln_wait(c, 4u); }
        __syncthreads();
        if (tid < 256) { const int lr = tid; float t1 = 0.f, t2 = 0.f; const float* sp = stat + (size_t)(u.pm * BM + lr) * 8;
#pragma unroll
            for (int c2 = 0; c2 < 4; ++c2) { t1 += __hip_atomic_load(sp + c2 * 2, __ATOMIC_RELAXED, __HIP_MEMORY_SCOPE_AGENT); t2 += __hip_atomic_load(sp + c2 * 2 + 1, __ATOMIC_RELAXED, __HIP_MEMORY_SCOPE_AGENT); }
            const float mu = t1 * (1.f / 1024.f); red[lr * 2] = mu; red[lr * 2 + 1] = rsqrtf(fmaxf(t2 * (1.f / 1024.f) - mu * mu, 0.f) + 1e-5f); }
        __syncthreads();
#pragma unroll
        for (int ai = 0; ai < 2; ++ai)
#pragma unroll
            for (int m = 0; m < 4; ++m) { const int row = row0 + ai * HALF + m * 16; const int lr = wr * 64 + ai * HALF + m * 16 + fr; const float mu = red[lr * 2], rstd = red[lr * 2 + 1];
#pragma unroll
                for (int bj = 0; bj < 2; ++bj)
#pragma unroll
                    for (int n = 0; n < 2; ++n) { const int col = col0 + bj * HALF + n * 16; const f32x4 gv = *(const f32x4*)(lng + col), bv = *(const f32x4*)(lnb + col);
                        *(f32x4*)(out + (size_t)row * 1024 + col) = (acc[ai][bj][m][n] - mu) * rstd * gv + bv; } }
    }
};
struct EpiRes {
    static constexpr bool PERM = false, AFTER_DRAIN = false;
    float* res; const float* xp; const float* xs; float alpha;
    DI void operator()(const f32x4 (&acc)[2][2][4][2], const Unit& u, int wr, int wc, int fr, int fq) const {
        const int row0 = u.pm * BM + wr * 64 + fr, col0 = u.pn * BM + wc * 32 + 4 * fq;
#pragma unroll
        for (int ai = 0; ai < 2; ++ai)
#pragma unroll
            for (int m = 0; m < 4; ++m) { const int row = row0 + ai * HALF + m * 16; const float* xr = row < NTOKP ? xp + (size_t)row * 1024 : xs + (size_t)(row - NTOKP) * 1024;
#pragma unroll
                for (int bj = 0; bj < 2; ++bj)
#pragma unroll
                    for (int n = 0; n < 2; ++n) { const int col = col0 + bj * HALF + n * 16; const f32x4 xv = *(const f32x4*)(xr + col);
                        *(f32x4*)(res + (size_t)row * 1024 + col) = acc[ai][bj][m][n] + xv * alpha; } }
    }
};

template <class Epi, class Sched>
DI void gemm_phase(LAS unsigned char* lds, const Gemm g, const Sched& S, const Epi& E) {
    const int tid = otid(), wid = __builtin_amdgcn_readfirstlane(tid >> 6), lane = tid & 63, wr = wid >> 2, wc = wid & 3, fr = lane & 15, fq = lane >> 4;
    const int K = g.K, nt = K / BK;
    unsigned voffA[2], voffB[2];
#pragma unroll
    for (int i = 0; i < 2; ++i) { int R, C; stage_rc(tid * 16 + i * 8192, R, C); const int Rb = Epi::PERM ? ((R & ~31) + perm32(R & 31)) : R;
        voffA[i] = (unsigned)(R * K + C) * 2u; voffB[i] = (unsigned)(Rb * K + C) * 2u; }
    const size_t kstep = (size_t)(BK * 2);
    const size_t hstep = (size_t)HALF * K * 2;
    const size_t tstep = 2 * hstep;
    const unsigned ldsw = (unsigned)wid * 1024u;
    const int aoff = lds_byte(wr * 64 + fr, fq * 8), boff = lds_byte(wc * 32 + fr, fq * 8);
#define PG8_SA(b, h) (((b) * 2 + (h)) * HTB)
#define PG8_SB(b, h) ((4 + (b) * 2 + (h)) * HTB)
#define PG8_STAGE(bufoff, gbase, voff) do { _Pragma("unroll") for (int _i = 0; _i < 2; ++_i) \
        __builtin_amdgcn_global_load_lds((const unsigned*)((const char*)(gbase) + (voff)[_i]), (LAS unsigned*)(lds + (bufoff) + ldsw + _i * 8192), 16, 0, 0); } while (0)
#define PG8_LDA(dst, b, h) do { _Pragma("unroll") for (int m = 0; m < 4; ++m) _Pragma("unroll") for (int k = 0; k < 2; ++k) dst[m][k] = *(const LAS bf16x8*)(lds + PG8_SA(b, h) + aoff + m * 2048 + k * 1024); } while (0)
#define PG8_LDB(dst, b, h) do { _Pragma("unroll") for (int n = 0; n < 2; ++n) _Pragma("unroll") for (int k = 0; k < 2; ++k) dst[n][k] = *(const LAS bf16x8*)(lds + PG8_SB(b, h) + boff + n * 2048 + k * 1024); } while (0)
#define PG8_MMA(ai, bj, At, Bt) do { __builtin_amdgcn_s_setprio(1); _Pragma("unroll") for (int m = 0; m < 4; ++m) _Pragma("unroll") for (int n = 0; n < 2; ++n) _Pragma("unroll") for (int k = 0; k < 2; ++k) \
        acc[ai][bj][m][n] = __builtin_amdgcn_mfma_f32_16x16x32_bf16(Bt[n][k], At[m][k], acc[ai][bj][m][n], 0, 0, 0); __builtin_amdgcn_s_setprio(0); } while (0)
#define PG8_WAIT_V(n) asm volatile("s_waitcnt vmcnt(" #n ")" ::: "memory")
#define PG8_WAIT_L(n) asm volatile("s_waitcnt lgkmcnt(" #n ")" ::: "memory")
#define PG8_BAR __builtin_amdgcn_s_barrier()
#define PG8_SCHED __builtin_amdgcn_sched_barrier(0)
    Unit cur, nxt; int ui = 0;
    if (!S.next(0, cur)) return;
    f32x4 acc[2][2][4][2];
#pragma unroll
    for (int a = 0; a < 2; ++a)
#pragma unroll
        for (int b = 0; b < 2; ++b)
#pragma unroll
            for (int m = 0; m < 4; ++m)
#pragma unroll
                for (int n = 0; n < 2; ++n) acc[a][b][m][n] = (f32x4){0.f, 0.f, 0.f, 0.f};
    bf16x8 At[4][2], B0[2][2], B1[2][2];
    const char* cA = (const char*)g.A + (size_t)cur.pm * tstep; const char* cB = (const char*)g.Bt + (size_t)cur.pn * tstep;
    PG8_STAGE(PG8_SB(0, 0), cB, voffB); PG8_STAGE(PG8_SA(0, 0), cA, voffA); PG8_STAGE(PG8_SB(0, 1), cB + hstep, voffB); PG8_STAGE(PG8_SA(0, 1), cA + hstep, voffA);
    if (wr == 1) PG8_BAR;
    PG8_WAIT_V(4); PG8_BAR;
    PG8_STAGE(PG8_SB(1, 0), cB + kstep, voffB); PG8_STAGE(PG8_SA(1, 0), cA + kstep, voffA); PG8_STAGE(PG8_SB(1, 1), cB + hstep + kstep, voffB);
    PG8_WAIT_V(6); PG8_BAR;
    for (;;) {
        const bool has_next = S.next(ui + 1, nxt);
        const char* nA = has_next ? (const char*)g.A + (size_t)nxt.pm * tstep : cA; const char* nB = has_next ? (const char*)g.Bt + (size_t)nxt.pn * tstep : cB;
        for (int t = 0; t < nt; t += 2) {
            const bool last = (t == nt - 2);
            const char* a1 = cA + (size_t)(t + 1) * kstep;
            const char* a2 = last ? nA : cA + (size_t)(t + 2) * kstep; const char* b2 = last ? nB : cB + (size_t)(t + 2) * kstep;
            const char* a3 = a2 + kstep; const char* b3 = b2 + kstep;
            PG8_LDB(B0, 0, 0); PG8_SCHED; PG8_LDA(At, 0, 0); PG8_STAGE(PG8_SA(1, 1), a1 + hstep, voffA);
            PG8_WAIT_L(8); PG8_BAR; PG8_WAIT_L(0); PG8_MMA(0, 0, At, B0); PG8_BAR; PG8_SCHED;
            PG8_LDB(B1, 0, 1); PG8_STAGE(PG8_SB(0, 0), b2, voffB);
            PG8_BAR; PG8_WAIT_L(0); PG8_MMA(0, 1, At, B1); PG8_BAR;
            PG8_LDA(At, 0, 1); PG8_STAGE(PG8_SA(0, 0), a2, voffA);
            PG8_BAR; PG8_WAIT_L(0); PG8_MMA(1, 0, At, B0); PG8_BAR; PG8_SCHED;
            PG8_STAGE(PG8_SB(0, 1), b2 + hstep, voffB);
            PG8_WAIT_V(6); PG8_BAR; PG8_MMA(1, 1, At, B1); PG8_BAR;
            PG8_LDB(B0, 1, 0); PG8_SCHED; PG8_LDA(At, 1, 0); PG8_STAGE(PG8_SA(0, 1), a2 + hstep, voffA);
            PG8_WAIT_L(8); PG8_BAR; PG8_WAIT_L(0); PG8_MMA(0, 0, At, B0); PG8_BAR; PG8_SCHED;
            PG8_LDB(B1, 1, 1); PG8_STAGE(PG8_SB(1, 0), b3, voffB);
            PG8_BAR; PG8_WAIT_L(0); PG8_MMA(0, 1, At, B1); PG8_BAR;
            PG8_LDA(At, 1, 1); PG8_STAGE(PG8_SA(1, 0), a3, voffA);
            PG8_BAR; PG8_WAIT_L(0); PG8_MMA(1, 0, At, B0); PG8_BAR; PG8_SCHED;
            PG8_STAGE(PG8_SB(1, 1), b3 + hstep, voffB);
            PG8_WAIT_V(6); PG8_BAR; PG8_MMA(1, 1, At, B1); PG8_BAR;
        }
        if constexpr (!Epi::AFTER_DRAIN) E(acc, cur, wr, wc, fr, fq);
        if (!has_next) break;
#pragma unroll
        for (int a = 0; a < 2; ++a)
#pragma unroll
            for (int b = 0; b < 2; ++b)
#pragma unroll
                for (int m = 0; m < 4; ++m)
#pragma unroll
                    for (int n = 0; n < 2; ++n) acc[a][b][m][n] = (f32x4){0.f, 0.f, 0.f, 0.f};
        cur = nxt; cA = nA; cB = nB; ++ui;
    }
    PG8_WAIT_V(0);
    if (wr == 0) PG8_BAR;
    PG8_BAR;
    if constexpr (Epi::AFTER_DRAIN) E(acc, cur, wr, wc, fr, fq);
#undef PG8_SA
#undef PG8_SB
#undef PG8_STAGE
#undef PG8_LDA
#undef PG8_LDB
#undef PG8_MMA
#undef PG8_WAIT_V
#undef PG8_WAIT_L
#undef PG8_BAR
#undef PG8_SCHED
}
}

DI void tr_tile(const float* src, int ld_src, int k0, int c0, bf16_t* dst, int ld_dst, int n0, float* lds) {
    const int tid = otid();
#pragma unroll
    for (int pass = 0; pass < 2; ++pass) { const int r = pass * 32 + (tid >> 4), c4 = (tid & 15) * 4;
        const f32x4 v = *(const f32x4*)(src + (size_t)(k0 + r) * ld_src + c0 + c4);
        lds[r * 65 + c4 + 0] = v[0]; lds[r * 65 + c4 + 1] = v[1]; lds[r * 65 + c4 + 2] = v[2]; lds[r * 65 + c4 + 3] = v[3]; }
    __syncthreads();
    const int nn = tid >> 3, kc = (tid & 7) * 8;
    float o[8];
#pragma unroll
    for (int e = 0; e < 8; ++e) o[e] = lds[(kc + e) * 65 + nn];
    *(u32x4*)(dst + (size_t)(n0 + nn) * ld_dst + k0 + kc) = pack8(o);
    __syncthreads();
}

DI void phase_prep(KP pk_in, unsigned char* lds) {
    KP pk = pk_in; asm volatile("" : "+s"(pk));
    unsigned char* ws = pk->ws;
    const int bidx_ = obid(); const size_t gtid = (size_t)bidx_ * 512 + otid(), nthr = (size_t)gridDim.x * 512;
    { bf16_t* xb = (bf16_t*)(ws + W_XB);
      for (size_t v = gtid; v < (size_t)NTOK * 128; v += nthr) { const float* s = v < (size_t)NTOKP * 128 ? pk->x_prompt + v * 8 : pk->x_sample + (v - (size_t)NTOKP * 128) * 8;
          const f32x4 a = *(const f32x4*)s, b = *(const f32x4*)(s + 4); float o[8] = {a[0], a[1], a[2], a[3], b[0], b[1], b[2], b[3]}; *(u32x4*)(xb + v * 8) = pack8(o); } }
    { bf16_t* mb = (bf16_t*)(ws + W_MEMB);
      for (size_t v = gtid; v < (size_t)2048 * 128; v += nthr) { const float* s = pk->mem_prompt + v * 8;
          const f32x4 a = *(const f32x4*)s, b = *(const f32x4*)(s + 4); float o[8] = {a[0], a[1], a[2], a[3], b[0], b[1], b[2], b[3]}; *(u32x4*)(mb + v * 8) = pack8(o); } }
    { bf16_t* wd = (bf16_t*)(ws + W_WDTT); float* wf = (float*)(ws + W_WDTF);
      for (size_t i = gtid; i < 16 * 1024; i += nthr) { const int h = (int)(i >> 10), k = (int)(i & 1023); const float v = pk->w_in[(size_t)k * DIN + 4608 + h]; wd[i] = f2bf(v); wf[i] = v; } }
    { bf16_t* wg = (bf16_t*)(ws + W_WGT);
      for (size_t i = gtid; i < (size_t)8 * 4 * 64 * 128; i += nthr) { const int k = (int)(i >> 15), qd = (int)(i >> 13) & 3, nn = (int)(i >> 7) & 63, ii = (int)(i & 127);
          const float v = nn < 32 ? pk->w_rg_a[((size_t)k * 128 + ii) * 128 + qd * 32 + nn] : pk->w_rg_i[((size_t)k * 128 + ii) * 128 + qd * 32 + nn - 32]; wg[i] = f2bf(v); } }
    float* tl = (float*)lds;
    for (int t = bidx_; t < 1664 + 768 + 512; t += gridDim.x) {
        if (t < 1664) { const int kt = t & 15, ntile = t >> 4; const int n0 = ntile * 64, c0 = n0 < 4608 ? n0 : n0 + 16;
            tr_tile(pk->w_in, DIN, kt * 64, c0, (bf16_t*)(ws + W_WINT), 1024, n0, tl); }
        else if (t < 1664 + 768) { const int u = t - 1664; const int kt = u % 48, ntile = u / 48;
            tr_tile(pk->w_out, 1024, kt * 64, ntile * 64, (bf16_t*)(ws + W_WOUTT), 3072, ntile * 64, tl); }
        else { const int u = t - 1664 - 768; const int kt = u & 15, ntile = u >> 4; const int n0 = ntile * 64;
            if (n0 < 1024) tr_tile(pk->w_mem_k, 1024, kt * 64, n0, (bf16_t*)(ws + W_WKVT), 1024, n0, tl);
            else tr_tile(pk->w_mem_v, 1024, kt * 64, n0 - 1024, (bf16_t*)(ws + W_WKVT), 1024, n0, tl); }
    }
}

DI void conv8_ssd_prompt(KP pk, const bf16_t* proj, int rowbase, int t, int ch, float (&o)[8]) {
    const f32x4 b0 = *(const f32x4*)(pk->ssd_conv_b + ch), b1 = *(const f32x4*)(pk->ssd_conv_b + ch + 4);
    float acc[8] = {b0[0], b0[1], b0[2], b0[3], b1[0], b1[1], b1[2], b1[3]};
    u32x4 vv[4];
#pragma unroll
    for (int kk = 0; kk < 4; ++kk) { const int tt = t - 3 + kk; vv[kk] = *(const u32x4*)(proj + (size_t)(rowbase + (tt < 0 ? 0 : tt)) * NPROJ + C_XBC + ch); }
#pragma unroll
    for (int kk = 0; kk < 4; ++kk) { const int tt = t - 3 + kk; const float msk = tt >= 0 ? 1.f : 0.f; float x[8]; unpack8(vv[kk], x);
            const f32x4 w0 = *(const f32x4*)(pk->ssd_conv_w + kk * 1536 + ch) * msk, w1 = *(const f32x4*)(pk->ssd_conv_w + kk * 1536 + ch + 4) * msk;
            acc[0] += x[0] * w0[0]; acc[1] += x[1] * w0[1]; acc[2] += x[2] * w0[2]; acc[3] += x[3] * w0[3];
            acc[4] += x[4] * w1[0]; acc[5] += x[5] * w1[1]; acc[6] += x[6] * w1[2]; acc[7] += x[7] * w1[3]; }
#pragma unroll
    for (int e = 0; e < 8; ++e) o[e] = siluf(acc[e]);
}

DI void ssd1_item(KP pk_in, unsigned char* lds, int b, int c, int g) {
    KP pk = pk_in; asm volatile("" : "+s"(pk));
    unsigned char* ws = pk->ws;
    const int tid = otid(), w = tid >> 6, lane = tid & 63, l15 = lane & 15, q = lane >> 4;
    float* dt_s = (float*)lds; float* acum_s = dt_s + 2048; float* w_s = acum_s + 2048; float* seg_s = w_s + 1024;
    bf16_t* BT = (bf16_t*)(lds + 22528); bf16_t* xsT = (bf16_t*)(lds + 22528 + 34816);
    const bf16_t* xb = (const bf16_t*)(ws + W_XB); const bf16_t* wdt = (const bf16_t*)(ws + W_WDTT); const bf16_t* proj = (const bf16_t*)(ws + W_PROJ);
    bf16_t* xact = (bf16_t*)(ws + W_XACT); float* dt_g = (float*)(ws + W_DT); float* acum_g = (float*)(ws + W_ACUM); float* cd_g = (float*)(ws + W_CD); bf16_t* st_g = (bf16_t*)(ws + W_ST);
    const int tok0 = b * 2048 + c * 128;
    __syncthreads();
    { f32x4 acc = {0.f, 0.f, 0.f, 0.f}; const bf16_t* ap = xb + (size_t)(tok0 + 16 * w + l15) * 1024 + q * 8; const bf16_t* bp = wdt + l15 * 1024 + q * 8;
#pragma unroll 8
      for (int ks = 0; ks < 32; ++ks) { const bf16x8 a = *(const bf16x8*)(ap + ks * 32); const bf16x8 bb = *(const bf16x8*)(bp + ks * 32); acc = MFMA16(a, bb, acc); }
      const float bias = pk->ssd_dt_bias[l15];
#pragma unroll
      for (int r = 0; r < 4; ++r) { const int i = 16 * w + 4 * q + r; const float dt = softplusf(acc[r] + bias); dt_s[i * 16 + l15] = dt; dt_g[(size_t)(tok0 + i) * 16 + l15] = dt; } }
    __syncthreads();
    { const int hd = tid & 15, sg = tid >> 4; const float ah = -__expf(pk->ssd_a_log[hd]); float loc[8]; float run = 0.f;
      if (tid < 256) {
#pragma unroll
          for (int i = 0; i < 8; ++i) { run += dt_s[(sg * 8 + i) * 16 + hd] * ah; loc[i] = run; }
          seg_s[sg * 16 + hd] = run; }
      __syncthreads();
      if (tid < 256) { float off = 0.f; for (int s2 = 0; s2 < sg; ++s2) off += seg_s[s2 * 16 + hd];
#pragma unroll
          for (int i = 0; i < 8; ++i) { const float v = loc[i] + off; acum_s[(sg * 8 + i) * 16 + hd] = v; acum_g[(size_t)(tok0 + sg * 8 + i) * 16 + hd] = v; } } }
    __syncthreads();
    if (tid < 8) cd_g[(b * 16 + c) * 16 + 8 * g + tid] = __expf(acum_s[127 * 16 + 8 * g + tid]);
    for (int idx = tid; idx < 1024; idx += 512) { const int j = idx >> 3, hl = idx & 7, h = 8 * g + hl; w_s[idx] = dt_s[j * 16 + h] * __expf(acum_s[127 * 16 + h] - acum_s[j * 16 + h]); }
    const int cv = (tid & 31) * 8, jg = tid >> 5;
    for (int pass = 0; pass < 3; ++pass) {
        const int ch = pass == 0 ? (cv < 128 ? 1024 + g * 128 + cv : 1280 + g * 128 + (cv - 128)) : g * 512 + (pass - 1) * 256 + cv;
        float wgt[4][8], bs[8];
        { const f32x4 b0 = *(const f32x4*)(pk->ssd_conv_b + ch), b1 = *(const f32x4*)(pk->ssd_conv_b + ch + 4);
          bs[0] = b0[0]; bs[1] = b0[1]; bs[2] = b0[2]; bs[3] = b0[3]; bs[4] = b1[0]; bs[5] = b1[1]; bs[6] = b1[2]; bs[7] = b1[3];
#pragma unroll
          for (int kk = 0; kk < 4; ++kk) { const f32x4 w0 = *(const f32x4*)(pk->ssd_conv_w + kk * 1536 + ch), w1 = *(const f32x4*)(pk->ssd_conv_w + kk * 1536 + ch + 4);
              wgt[kk][0] = w0[0]; wgt[kk][1] = w0[1]; wgt[kk][2] = w0[2]; wgt[kk][3] = w0[3]; wgt[kk][4] = w1[0]; wgt[kk][5] = w1[1]; wgt[kk][6] = w1[2]; wgt[kk][7] = w1[3]; } }
        const bf16_t* src = proj + (size_t)(b * 2048) * NPROJ + C_XBC + ch; const int t0 = c * 128 + jg * 8;
        u32x4 rows[11];
#pragma unroll
        for (int i = 0; i < 11; ++i) { const int tt = t0 - 3 + i; const u32x4 v = *(const u32x4*)(src + (size_t)(tt < 0 ? 0 : tt) * NPROJ); rows[i] = tt < 0 ? (u32x4){0u, 0u, 0u, 0u} : v; }
        if (pass > 0) __syncthreads();
#pragma unroll
        for (int i = 0; i < 8; ++i) { float x0[8], x1[8], x2[8], x3[8]; unpack8(rows[i], x0); unpack8(rows[i + 1], x1); unpack8(rows[i + 2], x2); unpack8(rows[i + 3], x3); float o[8];
#pragma unroll
            for (int e = 0; e < 8; ++e) o[e] = siluf(bs[e] + x0[e] * wgt[0][e] + x1[e] * wgt[1][e] + x2[e] * wgt[2][e] + x3[e] * wgt[3][e]);
            const int j = jg * 8 + i;
            *(u32x4*)(xact + (size_t)(tok0 + j) * 1536 + ch) = pack8(o);
            if (pass == 0) { if (cv < 128) {
#pragma unroll
                for (int e = 0; e < 8; ++e) BT[(cv + e) * 136 + j] = f2bf(o[e]); } }
            else { const float wj = w_s[j * 8 + (pass - 1) * 4 + (cv >> 6)];
#pragma unroll
                for (int e = 0; e < 8; ++e) xsT[(cv + e) * 136 + j] = f2bf(o[e] * wj); } }
        if (pass == 0) continue;
        __syncthreads();
        const int pt = w & 3, nh = w >> 2;
#pragma unroll 1
        for (int hq = 0; hq < 4; ++hq) { const int hl = (pass - 1) * 4 + hq;
            f32x4 acc[4];
#pragma unroll
            for (int nt = 0; nt < 4; ++nt) acc[nt] = (f32x4){0.f, 0.f, 0.f, 0.f};
#pragma unroll
            for (int ks = 0; ks < 4; ++ks) { const bf16x8 a = *(const bf16x8*)(xsT + (hq * 64 + pt * 16 + l15) * 136 + ks * 32 + q * 8);
#pragma unroll
                for (int nt = 0; nt < 4; ++nt) { const bf16x8 bb = *(const bf16x8*)(BT + (nh * 64 + nt * 16 + l15) * 136 + ks * 32 + q * 8); acc[nt] = MFMA16(a, bb, acc[nt]); } }
            bf16_t* sp = st_g + (size_t)(((b * 16 + c) * 16 + 8 * g + hl)) * 8192;
#pragma unroll
            for (int nt = 0; nt < 4; ++nt)
#pragma unroll
                for (int r = 0; r < 4; ++r) sp[(pt * 16 + 4 * q + r) * 128 + nh * 64 + nt * 16 + l15] = f2bf(acc[nt][r]); }
    }
    if (c == 15) {
        for (int idx = tid; idx < 3 * 768; idx += 512) { const int jj = idx / 768, cc = idx % 768; const int ch = cc < 512 ? g * 512 + cc : (cc < 640 ? 1024 + g * 128 + (cc - 512) : 1280 + g * 128 + (cc - 640));
            pk->out[O_SCP + (size_t)(b * 3 + jj) * 1536 + ch] = bf2f(proj[(size_t)(b * 2048 + 2045 + jj) * NPROJ + C_XBC + ch]); }
    }
}

DI void rgconv_item(KP pk_in, int b, int tile) {
    KP pk = pk_in; asm volatile("" : "+s"(pk));
    const int tid = otid();
    const bf16_t* proj = (const bf16_t*)(pk->ws + W_PROJ); bf16_t* mix = (bf16_t*)(pk->ws + W_MIX);
    const int ch = (tid & 127) * 8, t0 = tile * 128 + (tid >> 7) * 32;
    float wgt[4][8], bs[8];
    { const f32x4 b0 = *(const f32x4*)(pk->rg_conv_b + ch), b1 = *(const f32x4*)(pk->rg_conv_b + ch + 4);
      bs[0] = b0[0]; bs[1] = b0[1]; bs[2] = b0[2]; bs[3] = b0[3]; bs[4] = b1[0]; bs[5] = b1[1]; bs[6] = b1[2]; bs[7] = b1[3];
#pragma unroll
      for (int kk = 0; kk < 4; ++kk) { const f32x4 w0 = *(const f32x4*)(pk->rg_conv_w + kk * 1024 + ch), w1 = *(const f32x4*)(pk->rg_conv_w + kk * 1024 + ch + 4);
          wgt[kk][0] = w0[0]; wgt[kk][1] = w0[1]; wgt[kk][2] = w0[2]; wgt[kk][3] = w0[3]; wgt[kk][4] = w1[0]; wgt[kk][5] = w1[1]; wgt[kk][6] = w1[2]; wgt[kk][7] = w1[3]; } }
    const bf16_t* src = proj + (size_t)(b * 2048) * NPROJ + C_RGX + ch;
    u32x4 hist[3];
#pragma unroll
    for (int i = 0; i < 3; ++i) { const int tt = t0 - 3 + i; const u32x4 v = *(const u32x4*)(src + (size_t)(tt < 0 ? 0 : tt) * NPROJ); hist[i] = tt < 0 ? (u32x4){0u, 0u, 0u, 0u} : v; }
    for (int c8 = 0; c8 < 32; c8 += 8) { u32x4 nv[8];
#pragma unroll
        for (int i = 0; i < 8; ++i) nv[i] = *(const u32x4*)(src + (size_t)(t0 + c8 + i) * NPROJ);
#pragma unroll
        for (int i = 0; i < 8; ++i) { float x0[8], x1[8], x2[8], x3[8]; unpack8(hist[0], x0); unpack8(hist[1], x1); unpack8(hist[2], x2); unpack8(nv[i], x3); float acc[8];
#pragma unroll
            for (int e = 0; e < 8; ++e) acc[e] = bs[e] + x0[e] * wgt[0][e] + x1[e] * wgt[1][e] + x2[e] * wgt[2][e] + x3[e] * wgt[3][e];
            *(u32x4*)(mix + (size_t)(b * 2048 + t0 + c8 + i) * DMIX + 1024 + ch) = pack8(acc);
            hist[0] = hist[1]; hist[1] = hist[2]; hist[2] = nv[i]; } }
}

DI void statepass_item(KP pk_in, int sp) {
    KP pk = pk_in; asm volatile("" : "+s"(pk));
    const int b = sp >> 5, h = (sp >> 1) & 15, half = sp & 1; const int e0 = half * 4096 + otid() * 8;
    bf16_t* st_g = (bf16_t*)(pk->ws + W_ST); const float* cd_g = (const float*)(pk->ws + W_CD);
    float run[8] = {0.f, 0.f, 0.f, 0.f, 0.f, 0.f, 0.f, 0.f};
    u32x4 v[16]; float cd[16];
#pragma unroll
    for (int i = 0; i < 16; ++i) { v[i] = *(const u32x4*)(st_g + (size_t)((b * 16 + i) * 16 + h) * 8192 + e0); cd[i] = cd_g[(b * 16 + i) * 16 + h]; }
#pragma unroll
    for (int i = 0; i < 16; ++i) { *(u32x4*)(st_g + (size_t)((b * 16 + i) * 16 + h) * 8192 + e0) = pack8(run); float x[8]; unpack8(v[i], x);
#pragma unroll
        for (int e = 0; e < 8; ++e) run[e] = run[e] * cd[i] + x[e]; }
    float* o = pk->out + O_SHP + (size_t)(b * 16 + h) * 8192 + e0; *(f32x4*)o = (f32x4){run[0], run[1], run[2], run[3]}; *(f32x4*)(o + 4) = (f32x4){run[4], run[5], run[6], run[7]};
}

DI void rg_item(KP pk_in, unsigned char* lds, const bool sample, int bidx, int k, int qd) {
    KP pk = pk_in; asm volatile("" : "+s"(pk));
    unsigned char* ws = pk->ws;
    const int tid = otid(), w = tid >> 6, lane = tid & 63, l15 = lane & 15, q = lane >> 4;
    bf16_t* uA = (bf16_t*)lds;
    float* wagg = (float*)(lds + 34816);
    float* hcar = wagg + 1024;
    bf16_t* wS = (bf16_t*)(lds + 73728);
    const bf16_t* proj = (const bf16_t*)(ws + W_PROJ); bf16_t* mix = (bf16_t*)(ws + W_MIX);
    const bf16_t* wg = (const bf16_t*)(ws + W_WGT) + (size_t)((k * 4 + qd) * 64) * 128;
    __syncthreads();
    for (int idx = tid; idx < 1024; idx += 512) { const int n = idx >> 4, c8 = (idx & 15) * 8; *(u32x4*)(wS + n * 136 + c8) = *(const u32x4*)(wg + n * 128 + c8); }
    if (tid < 64) hcar[tid] = 0.f;
    float ba[2], bi[2], spl[2];
#pragma unroll
    for (int ntl = 0; ntl < 2; ++ntl) { const int ch = k * 128 + qd * 32 + ntl * 16 + l15; ba[ntl] = pk->b_rg_a[ch]; bi[ntl] = pk->b_rg_i[ch]; spl[ntl] = softplusf(-pk->rg_lambda[ch]); }
    const int ntiles = sample ? 1 : 16;
    const int crow = tid >> 2, cg0 = (tid & 3) * 32;
    const bf16_t* ug = mix + 1024;
    u32x4 av[4]; bf16_t uv[8];
#define RG_LOADP(TILE) do { const size_t r0 = (size_t)(bidx * 2048 + (TILE) * 128 + 16 * w); \
        _Pragma("unroll") for (int ks = 0; ks < 4; ++ks) av[ks] = *(const u32x4*)(ug + (r0 + l15) * DMIX + k * 128 + ks * 32 + q * 8); \
        _Pragma("unroll") for (int ntl = 0; ntl < 2; ++ntl) _Pragma("unroll") for (int r = 0; r < 4; ++r) uv[ntl * 4 + r] = ug[(r0 + 4 * q + r) * DMIX + k * 128 + qd * 32 + ntl * 16 + l15]; } while (0)
    if (!sample) RG_LOADP(0);
    bf16x8 afr[4]; float uvf[8];
    for (int tile = 0; tile < ntiles; ++tile) {
        const int par = tile & 1;
        bf16_t gtr[8];
        const size_t rowb = sample ? (size_t)(NTOKP + bidx * 128 + 16 * w + 4 * q) : (size_t)(bidx * 2048 + tile * 128 + 16 * w + 4 * q);
        if (!sample) {
#pragma unroll
          for (int ks = 0; ks < 4; ++ks) afr[ks] = as_frag(av[ks]);
#pragma unroll
          for (int e = 0; e < 8; ++e) uvf[e] = bf2f(uv[e]);
          if (tile + 1 < 16) RG_LOADP(tile + 1);
        } else { const int row = crow;
          __syncthreads();
#pragma unroll
          for (int v = 0; v < 4; ++v) { const int c8 = cg0 + v * 8, ch = k * 128 + c8;
              const f32x4 b0 = *(const f32x4*)(pk->rg_conv_b + ch), b1 = *(const f32x4*)(pk->rg_conv_b + ch + 4);
              float acc[8] = {b0[0], b0[1], b0[2], b0[3], b1[0], b1[1], b1[2], b1[3]};
#pragma unroll
              for (int kk = 0; kk < 4; ++kk) { float x[8];
                  { const int sbi = bidx * 32 + (row >> 2), ui = (row & 3) + kk; const bool st = ui < 3;
                      const float* sp_ = pk->state_rg_conv + (size_t)(sbi * 3 + (st ? ui : 2)) * 1024 + ch; const f32x4 s0 = *(const f32x4*)sp_, s1 = *(const f32x4*)(sp_ + 4);
                      const u32x4 vv = *(const u32x4*)(proj + (size_t)(NTOKP + sbi * 4 + (st ? 0 : ui - 3)) * NPROJ + C_RGX + ch); unpack8(vv, x);
                      x[0] = st ? s0[0] : x[0]; x[1] = st ? s0[1] : x[1]; x[2] = st ? s0[2] : x[2]; x[3] = st ? s0[3] : x[3];
                      x[4] = st ? s1[0] : x[4]; x[5] = st ? s1[1] : x[5]; x[6] = st ? s1[2] : x[6]; x[7] = st ? s1[3] : x[7]; }
                  { const f32x4 w0 = *(const f32x4*)(pk->rg_conv_w + kk * 1024 + ch), w1 = *(const f32x4*)(pk->rg_conv_w + kk * 1024 + ch + 4);
                      acc[0] += x[0] * w0[0]; acc[1] += x[1] * w0[1]; acc[2] += x[2] * w0[2]; acc[3] += x[3] * w0[3];
                      acc[4] += x[4] * w1[0]; acc[5] += x[5] * w1[1]; acc[6] += x[6] * w1[2]; acc[7] += x[7] * w1[3]; } }
              *(u32x4*)(uA + row * 136 + c8) = pack8(acc); }
        }
#pragma unroll
        for (int ntl = 0; ntl < 2; ++ntl)
#pragma unroll
            for (int r = 0; r < 4; ++r) gtr[ntl * 4 + r] = proj[(rowb + r) * NPROJ + C_RGG + k * 128 + qd * 32 + ntl * 16 + l15];
        __syncthreads();
        f32x4 acc[4];
#pragma unroll
        for (int nt = 0; nt < 4; ++nt) acc[nt] = (f32x4){0.f, 0.f, 0.f, 0.f};
#pragma unroll
        for (int ks = 0; ks < 4; ++ks) { const bf16x8 a = sample ? *(const bf16x8*)(uA + (16 * w + l15) * 136 + ks * 32 + q * 8) : afr[ks];
#pragma unroll
            for (int nt = 0; nt < 4; ++nt) { const bf16x8 bb = *(const bf16x8*)(wS + (nt * 16 + l15) * 136 + ks * 32 + q * 8); acc[nt] = MFMA16(a, bb, acc[nt]); } }
        float Ap[2][4], Bp[2][4];
#pragma unroll
        for (int ntl = 0; ntl < 2; ++ntl) { float A = 1.f, B = 0.f;
#pragma unroll
            for (int r = 0; r < 4; ++r) { const int row = 16 * w + 4 * q + r, cl = ntl * 16 + l15;
                const float rr = sigmf(acc[ntl][r] + ba[ntl]), ii = sigmf(acc[2 + ntl][r] + bi[ntl]);
                const float la = -8.f * rr * spl[ntl]; float a = __expf(la); const float uval = sample ? bf2f(uA[row * 136 + qd * 32 + cl]) : uvf[ntl * 4 + r];
                float bt = __builtin_amdgcn_sqrtf(fmaxf(1.f - a * a, 0.f)) * ii * uval;
                const bool first = sample ? (r == 0) : (tile == 0 && row == 0);
                if (first) { const float h0 = sample ? pk->state_rg_h[(size_t)(bidx * 32 + (row >> 2)) * 1024 + k * 128 + qd * 32 + cl] : 0.f; bt += a * h0; a = 0.f; }
                B = a * B + bt; A = a * A; Ap[ntl][r] = A; Bp[ntl][r] = B; } }
        float hq[2], Aex[2], Bex[2];
#pragma unroll
        for (int ntl = 0; ntl < 2; ++ntl) { float A = Ap[ntl][3], B = Bp[ntl][3];
            { const float Ao = shl(A, lane - 16), Bo = shl(B, lane - 16); if (q >= 1) { B = A * Bo + B; A = A * Ao; } }
            { const float Ao = shl(A, lane - 32), Bo = shl(B, lane - 32); if (q >= 2) { B = A * Bo + B; A = A * Ao; } }
            if (q == 3) { wagg[((par * 2 + 0) * 8 + w) * 32 + ntl * 16 + l15] = A; wagg[((par * 2 + 1) * 8 + w) * 32 + ntl * 16 + l15] = B; }
            float Ae = shl(A, lane - 16), Be = shl(B, lane - 16); if (q == 0) { Ae = 1.f; Be = 0.f; }
            Aex[ntl] = Ae; Bex[ntl] = Be; }
        __syncthreads();
#pragma unroll
        for (int ntl = 0; ntl < 2; ++ntl) { const int cl = ntl * 16 + l15; float hin = hcar[par * 32 + cl];
            for (int ww = 0; ww < w; ++ww) hin = wagg[((par * 2 + 0) * 8 + ww) * 32 + cl] * hin + wagg[((par * 2 + 1) * 8 + ww) * 32 + cl];
            hq[ntl] = Aex[ntl] * hin + Bex[ntl];
            if (w == 7 && q == 3) hcar[(par ^ 1) * 32 + cl] = Ap[ntl][3] * hq[ntl] + Bp[ntl][3]; }
#pragma unroll
        for (int ntl = 0; ntl < 2; ++ntl)
#pragma unroll
            for (int r = 0; r < 4; ++r) { const float h = Ap[ntl][r] * hq[ntl] + Bp[ntl][r]; const int chg = k * 128 + qd * 32 + ntl * 16 + l15;
                mix[(rowb + r) * DMIX + chg] = f2bf(h * siluf(bf2f(gtr[ntl * 4 + r])));
                if (sample) { if (r == 3) pk->out[O_RGHS + (size_t)(bidx * 32 + 4 * w + q) * 1024 + chg] = h; }
                else if (tile == 15 && w == 7 && q == 3 && r == 3) pk->out[O_RGHP + (size_t)bidx * 1024 + chg] = h; }
    }
#undef RG_LOADP
    if (!sample) { if (tid < 96) { const int jj = tid >> 5, cl = tid & 31, chg = k * 128 + qd * 32 + cl;
            pk->out[O_RGCP + (size_t)(bidx * 3 + jj) * 1024 + chg] = bf2f(proj[(size_t)(bidx * 2048 + 2045 + jj) * NPROJ + C_RGX + chg]); } }
    else { for (int idx = tid; idx < 32 * 3 * 32; idx += 512) { const int cl = idx & 31, jj = (idx >> 5) % 3, sl = idx / 96; const int sbi = bidx * 32 + sl, chg = k * 128 + qd * 32 + cl;
            pk->out[O_RGCS + (size_t)(sbi * 3 + jj) * 1024 + chg] = bf2f(proj[(size_t)(NTOKP + sbi * 4 + 1 + jj) * NPROJ + C_RGX + chg]); } }
}

DI void attnp_item(KP pk_in, unsigned char* lds, int b, int head, int qt) {
    KP pk = pk_in; asm volatile("" : "+s"(pk));
    unsigned char* ws = pk->ws;
    const int tid = otid(), w = tid >> 6, lane = tid & 63, l15 = lane & 15, q = lane >> 4;
    const bf16_t* proj = (const bf16_t*)(ws + W_PROJ); const bf16_t* kb = (const bf16_t*)(ws + W_KB); const bf16_t* vt = (const bf16_t*)(ws + W_VT); bf16_t* mix = (bf16_t*)(ws + W_MIX);
    const int tokb = b * 2048 + qt * 128 + 16 * w;
    constexpr int RS = 264;
    bf16_t* sm = (bf16_t*)lds;
    const int lr = tid >> 5, lc = (tid & 31) * 8;
    const bf16_t* kbase = kb + (size_t)(b * 256) * 1024 + head * 256; const bf16_t* vbase = vt + (size_t)((b * 4 + head) * 256) * 256;
    u32x4 pre[8];
#define AT_LOAD(S) do { _Pragma("unroll") for (int i = 0; i < 8; ++i) { const int r = lr + 16 * i; \
        pre[i] = (S) < 2 ? *(const u32x4*)(kbase + (size_t)(128 * (S) + r) * 1024 + lc) : *(const u32x4*)(vbase + (size_t)(128 * ((S) - 2) + r) * 256 + lc); } } while (0)
#define AT_STORE() do { _Pragma("unroll") for (int i = 0; i < 8; ++i) *(u32x4*)(sm + (lr + 16 * i) * RS + lc) = pre[i]; } while (0)
    AT_LOAD(0);
    bf16x8 qf[8];
#pragma unroll
    for (int ks = 0; ks < 8; ++ks) qf[ks] = *(const bf16x8*)(proj + (size_t)(tokb + l15) * NPROJ + C_Q + head * 256 + ks * 32 + q * 8);
    f32x4 st[16];
#pragma unroll
    for (int s = 0; s < 2; ++s) {
        __syncthreads(); AT_STORE(); __syncthreads(); AT_LOAD(s + 1);
#pragma unroll
        for (int mtl = 0; mtl < 8; ++mtl) { const int mt = 8 * s + mtl; st[mt] = (f32x4){0.f, 0.f, 0.f, 0.f}; const bf16_t* kp = sm + (16 * mtl + l15) * RS + q * 8;
#pragma unroll
            for (int ks = 0; ks < 8; ++ks) { const bf16x8 kf = *(const bf16x8*)(kp + ks * 32); st[mt] = MFMA16(kf, qf[ks], st[mt]); } }
    }
    float mx = -3.0e38f;
#pragma unroll
    for (int mt = 0; mt < 16; ++mt)
#pragma unroll
        for (int r = 0; r < 4; ++r) { st[mt][r] *= 0.0625f; mx = fmaxf(mx, st[mt][r]); }
    mx = fmaxf(mx, shx(mx, 16, lane)); mx = fmaxf(mx, shx(mx, 32, lane));
    float l = 0.f;
#pragma unroll
    for (int mt = 0; mt < 16; ++mt)
#pragma unroll
        for (int r = 0; r < 4; ++r) { const float e = __expf(st[mt][r] - mx); st[mt][r] = e; l += e; }
    l += shx(l, 16, lane); l += shx(l, 32, lane);
    bf16x8 pf[8];
#pragma unroll
    for (int s = 0; s < 8; ++s) { float m8[8] = {st[2 * s][0], st[2 * s][1], st[2 * s][2], st[2 * s][3], st[2 * s + 1][0], st[2 * s + 1][1], st[2 * s + 1][2], st[2 * s + 1][3]}; pf[s] = as_frag(pack8(m8)); }
    float linv[4];
#pragma unroll
    for (int r = 0; r < 4; ++r) linv[r] = 1.f / shl(l, 4 * q + r);
#pragma unroll
    for (int s2 = 0; s2 < 2; ++s2) {
        __syncthreads(); AT_STORE(); __syncthreads(); if (s2 == 0) AT_LOAD(3);
#pragma unroll
        for (int dtl = 0; dtl < 8; ++dtl) { const int dt = 8 * s2 + dtl; f32x4 o = {0.f, 0.f, 0.f, 0.f}; const bf16_t* vp = sm + (16 * dtl + l15) * RS + 4 * q;
            float gt[4];
#pragma unroll
            for (int r = 0; r < 4; ++r) gt[r] = bf2f(proj[(size_t)(tokb + 4 * q + r) * NPROJ + C_XG + head * 256 + 16 * dt + l15]);
#pragma unroll
            for (int s = 0; s < 8; ++s) { const u32x2 lo = *(const u32x2*)(vp + 32 * s), hi = *(const u32x2*)(vp + 32 * s + 16); o = MFMA16(pf[s], frag2(lo, hi), o); }
#pragma unroll
            for (int r = 0; r < 4; ++r) { const size_t tok = (size_t)(tokb + 4 * q + r); const int d = 16 * dt + l15;
                mix[tok * DMIX + 2048 + head * 256 + d] = f2bf(o[r] * linv[r] * siluf(gt[r])); } }
    }
#undef AT_LOAD
#undef AT_STORE
}

DI float wave_sum(float v, int lane) { v += shx(v, 32, lane); v += shx(v, 16, lane); v += shx(v, 8, lane); v += shx(v, 4, lane); v += shx(v, 2, lane); v += shx(v, 1, lane); return v; }
DI float wave_max(float v, int lane) { v = fmaxf(v, shx(v, 32, lane)); v = fmaxf(v, shx(v, 16, lane)); v = fmaxf(v, shx(v, 8, lane)); v = fmaxf(v, shx(v, 4, lane)); v = fmaxf(v, shx(v, 2, lane)); v = fmaxf(v, shx(v, 1, lane)); return v; }

DI void attns_item(KP pk_in, unsigned char* lds, int sbi, int head) {
    KP pk = pk_in; asm volatile("" : "+s"(pk));
    unsigned char* ws = pk->ws;
    const int tid = otid(), w = tid >> 6, lane = tid & 63;
    const bf16_t* proj = (const bf16_t*)(ws + W_PROJ); bf16_t* mix = (bf16_t*)(ws + W_MIX);
    float* qs = (float*)lds; float* sc = qs + 1024; float* ored = sc + 1024;
    __syncthreads();
    for (int idx = tid; idx < 1024; idx += 512) { const int t = idx >> 8, d = idx & 255; qs[idx] = bf2f(proj[(size_t)(NTOKP + sbi * 4 + t) * NPROJ + C_Q + head * 256 + d]); }
    __syncthreads();
    f32x4 qv[4];
#pragma unroll
    for (int t = 0; t < 4; ++t) qv[t] = *(const f32x4*)(qs + t * 256 + lane * 4);
    for (int m0 = w; m0 < 256; m0 += 64) { f32x4 kv[8];
#pragma unroll
        for (int i = 0; i < 8; ++i) kv[i] = *(const f32x4*)(pk->cache_k + ((size_t)(sbi * 256 + m0 + 8 * i) * 4 + head) * 256 + lane * 4);
        float v32[32];
#pragma unroll
        for (int i = 0; i < 8; ++i)
#pragma unroll
            for (int t = 0; t < 4; ++t) v32[i * 4 + t] = kv[i][0] * qv[t][0] + kv[i][1] * qv[t][1] + kv[i][2] * qv[t][2] + kv[i][3] * qv[t][3];
        float v16[16], v8[8], v4[4], v2[2];
        { const bool up = (lane & 32) != 0;
#pragma unroll
          for (int i = 0; i < 16; ++i) { const float keep = up ? v32[i + 16] : v32[i], send = up ? v32[i] : v32[i + 16]; v16[i] = keep + shx(send, 32, lane); } }
        { const bool up = (lane & 16) != 0;
#pragma unroll
          for (int i = 0; i < 8; ++i) { const float keep = up ? v16[i + 8] : v16[i], send = up ? v16[i] : v16[i + 8]; v8[i] = keep + shx(send, 16, lane); } }
        { const bool up = (lane & 8) != 0;
#pragma unroll
          for (int i = 0; i < 4; ++i) { const float keep = up ? v8[i + 4] : v8[i], send = up ? v8[i] : v8[i + 4]; v4[i] = keep + shx(send, 8, lane); } }
        { const bool up = (lane & 4) != 0;
#pragma unroll
          for (int i = 0; i < 2; ++i) { const float keep = up ? v4[i + 2] : v4[i], send = up ? v4[i] : v4[i + 2]; v2[i] = keep + shx(send, 4, lane); } }
        float v1; { const bool up = (lane & 2) != 0; const float keep = up ? v2[1] : v2[0], send = up ? v2[0] : v2[1]; v1 = keep + shx(send, 2, lane); }
        v1 += shx(v1, 1, lane);
        if ((lane & 1) == 0) { const int ii = lane >> 1; sc[(ii & 3) * 256 + m0 + 8 * (ii >> 2)] = v1 * 0.0625f; } }
    __syncthreads();
    if (w < 4) { const f32x4 v = *(const f32x4*)(sc + w * 256 + lane * 4); float mx = fmaxf(fmaxf(v[0], v[1]), fmaxf(v[2], v[3])); mx = wave_max(mx, lane);
        f32x4 e; e[0] = __expf(v[0] - mx); e[1] = __expf(v[1] - mx); e[2] = __expf(v[2] - mx); e[3] = __expf(v[3] - mx); float s = wave_sum(e[0] + e[1] + e[2] + e[3], lane); const float inv = 1.f / s;
        *(f32x4*)(sc + w * 256 + lane * 4) = e * inv; }
    __syncthreads();
    f32x4 acc[4];
#pragma unroll
    for (int t = 0; t < 4; ++t) acc[t] = (f32x4){0.f, 0.f, 0.f, 0.f};
    for (int m0 = w; m0 < 256; m0 += 64) { f32x4 vv[8];
#pragma unroll
        for (int i = 0; i < 8; ++i) vv[i] = *(const f32x4*)(pk->cache_v + ((size_t)(sbi * 256 + m0 + 8 * i) * 4 + head) * 256 + lane * 4);
#pragma unroll
        for (int i = 0; i < 8; ++i)
#pragma unroll
            for (int t = 0; t < 4; ++t) acc[t] += vv[i] * sc[t * 256 + m0 + 8 * i]; }
#pragma unroll
    for (int t = 0; t < 4; ++t) *(f32x4*)(ored + (w * 4 + t) * 256 + lane * 4) = acc[t];
    __syncthreads();
    for (int idx = tid; idx < 1024; idx += 512) { const int t = idx >> 8, d = idx & 255; float s = 0.f;
#pragma unroll
        for (int ww = 0; ww < 8; ++ww) s += ored[(ww * 4 + t) * 256 + d];
        const size_t tok = (size_t)(NTOKP + sbi * 4 + t); const float gate = bf2f(proj[tok * NPROJ + C_XG + head * 256 + d]); mix[tok * DMIX + 2048 + head * 256 + d] = f2bf(s * siluf(gate)); }
}

DI void ssds_item(KP pk_in, unsigned char* lds, int sbi, int g) {
    KP pk = pk_in; asm volatile("" : "+s"(pk));
    unsigned char* ws = pk->ws;
    const int tid = otid(), w = tid >> 6, lane = tid & 63;
    const bf16_t* proj = (const bf16_t*)(ws + W_PROJ); bf16_t* mix = (bf16_t*)(ws + W_MIX); const float* wdf = (const float*)(ws + W_WDTF);
    float* xs = (float*)lds; float* Bs = xs + 2048; float* Cs = Bs + 512; float* yg = Cs + 512; float* dts = yg + 2048; float* decs = dts + 32;
    __syncthreads();
#pragma unroll
    for (int d = 0; d < 4; ++d) { const int pi = w * 4 + d, t = pi & 3, hl = pi >> 2, h = 8 * g + hl; float s = 0.f;
#pragma unroll
        for (int i = 0; i < 4; ++i) { const f32x4 xv = *(const f32x4*)(pk->x_sample + (size_t)(sbi * 4 + t) * 1024 + i * 256 + lane * 4), wv = *(const f32x4*)(wdf + h * 1024 + i * 256 + lane * 4);
            s += xv[0] * wv[0] + xv[1] * wv[1] + xv[2] * wv[2] + xv[3] * wv[3]; }
        s = wave_sum(s, lane);
        if (lane == 0) { const float dt = softplusf(s + pk->ssd_dt_bias[h]); dts[t * 8 + hl] = dt; decs[t * 8 + hl] = __expf(-dt * __expf(pk->ssd_a_log[h])); } }
    for (int idx = tid; idx < 4 * 768; idx += 512) { const int t = idx / 768, cc = idx % 768; const int ch = cc < 512 ? g * 512 + cc : (cc < 640 ? 1024 + g * 128 + (cc - 512) : 1280 + g * 128 + (cc - 640));
        float acc = pk->ssd_conv_b[ch];
#pragma unroll
        for (int kk = 0; kk < 4; ++kk) { const int ui = t + kk; const bool st = ui < 3;
            const float xs_ = pk->state_ssd_conv[(size_t)(sbi * 3 + (st ? ui : 2)) * 1536 + ch]; const float xp_ = bf2f(proj[(size_t)(NTOKP + sbi * 4 + (st ? 0 : ui - 3)) * NPROJ + C_XBC + ch]);
            acc += (st ? xs_ : xp_) * pk->ssd_conv_w[kk * 1536 + ch]; }
        const float a = siluf(acc);
        if (cc < 512) xs[t * 512 + cc] = a; else if (cc < 640) Bs[t * 128 + cc - 512] = a; else Cs[t * 128 + cc - 640] = a; }
    for (int idx = tid; idx < 3 * 768; idx += 512) { const int jj = idx / 768, cc = idx % 768; const int ch = cc < 512 ? g * 512 + cc : (cc < 640 ? 1024 + g * 128 + (cc - 512) : 1280 + g * 128 + (cc - 640));
        pk->out[O_SCS + (size_t)(sbi * 3 + jj) * 1536 + ch] = bf2f(proj[(size_t)(NTOKP + sbi * 4 + 1 + jj) * NPROJ + C_XBC + ch]); }
    __syncthreads();
    const int pp = tid >> 3, n0 = (tid & 7) * 16;
    f32x4 bvr[4][4], cvr[4][4];
#pragma unroll
    for (int t = 0; t < 4; ++t)
#pragma unroll
        for (int v = 0; v < 4; ++v) { bvr[t][v] = *(const f32x4*)(Bs + t * 128 + n0 + v * 4); cvr[t][v] = *(const f32x4*)(Cs + t * 128 + n0 + v * 4); }
    f32x4 hs[4], hn[4];
#pragma unroll
    for (int v = 0; v < 4; ++v) hn[v] = *(const f32x4*)(pk->state_ssd_h + ((size_t)(sbi * 16 + 8 * g) * 64 + pp) * 128 + n0 + v * 4);
    for (int hl = 0; hl < 8; ++hl) { const int h = 8 * g + hl; const size_t so = ((size_t)(sbi * 16 + h) * 64 + pp) * 128 + n0;
#pragma unroll
        for (int v = 0; v < 4; ++v) hs[v] = hn[v];
        if (hl < 7) {
#pragma unroll
            for (int v = 0; v < 4; ++v) hn[v] = *(const f32x4*)(pk->state_ssd_h + so + 8192 + v * 4); }
        const float dsk = pk->ssd_d[h];
#pragma unroll
        for (int t = 0; t < 4; ++t) { const float dec = decs[t * 8 + hl], xv = xs[t * 512 + hl * 64 + pp], dtx = dts[t * 8 + hl] * xv; float part = 0.f;
#pragma unroll
            for (int v = 0; v < 4; ++v) { const f32x4 bv = bvr[t][v], cv = cvr[t][v];
                hs[v] = hs[v] * dec + bv * dtx; part += cv[0] * hs[v][0] + cv[1] * hs[v][1] + cv[2] * hs[v][2] + cv[3] * hs[v][3]; }
            part += shx(part, 1, lane); part += shx(part, 2, lane); part += shx(part, 4, lane);
            if ((tid & 7) == 0) { const float y = part + dsk * xv; const float z = bf2f(proj[(size_t)(NTOKP + sbi * 4 + t) * NPROJ + C_Z + h * 64 + pp]); yg[t * 512 + hl * 64 + pp] = y * siluf(z); } }
#pragma unroll
        for (int v = 0; v < 4; ++v) *(f32x4*)(pk->out + O_SHS + so + v * 4) = hs[v];
    }
    __syncthreads();
    if (w < 4) { const int t = w; float ss = 0.f; float v[8];
#pragma unroll
        for (int e = 0; e < 8; ++e) { v[e] = yg[t * 512 + e * 64 + lane]; ss += v[e] * v[e]; }
        ss = wave_sum(ss, lane); const float rstd = rsqrtf(ss * (1.f / 512.f) + 1e-5f);
#pragma unroll
        for (int e = 0; e < 8; ++e) { const int cc = e * 64 + lane; mix[(size_t)(NTOKP + sbi * 4 + t) * DMIX + 1024 + g * 512 + cc] = f2bf(v[e] * rstd * pk->ssd_norm_g[g * 512 + cc]); } }
}

DI void ssd3_item(KP pk_in, unsigned char* lds, int b, int c, int g) {
    KP pk = pk_in; asm volatile("" : "+s"(pk));
    unsigned char* ws = pk->ws;
    const int tid = otid(), w = tid >> 6, lane = tid & 63, l15 = lane & 15, q = lane >> 4;
    float* acum_s = (float*)lds; float* cf_s = acum_s + 1024; float* dt_s = cf_s + 1024; float* rstd_s = dt_s + 1024;
    bf16_t* xT = (bf16_t*)(lds + 12800);
    bf16_t* hS = (bf16_t*)(lds + 30208);
    const bf16_t* proj = (const bf16_t*)(ws + W_PROJ); const bf16_t* xact = (const bf16_t*)(ws + W_XACT); bf16_t* mix = (bf16_t*)(ws + W_MIX);
    const float* dt_g = (const float*)(ws + W_DT); const float* acum_g = (const float*)(ws + W_ACUM); const bf16_t* st_g = (const bf16_t*)(ws + W_ST);
    const int tok0 = b * 2048 + c * 128;
    __syncthreads();
    for (int idx = tid; idx < 1024; idx += 512) { const int j = idx >> 3, hl = idx & 7; acum_s[idx] = acum_g[(size_t)(tok0 + j) * 16 + 8 * g + hl]; }
    const int xj = tid >> 3, xpv = (tid & 7) * 8;
    const int hp_ = tid >> 3, hn0 = (tid & 7) * 16;
    u32x4 xr[2]; u32x4 hr[2]; bf16_t zr[16];
#define S3_LOAD(HL) do { const int h_ = 8 * g + (HL); \
        xr[0] = *(const u32x4*)(xact + (size_t)(tok0 + xj) * 1536 + g * 512 + (HL) * 64 + xpv); xr[1] = *(const u32x4*)(xact + (size_t)(tok0 + xj + 64) * 1536 + g * 512 + (HL) * 64 + xpv); \
        { const bf16_t* hp0 = st_g + ((size_t)((b * 16 + c) * 16 + h_) * 64 + hp_) * 128 + hn0; hr[0] = *(const u32x4*)hp0; hr[1] = *(const u32x4*)(hp0 + 8); } \
        _Pragma("unroll") for (int pt = 0; pt < 4; ++pt) _Pragma("unroll") for (int r = 0; r < 4; ++r) zr[pt * 4 + r] = proj[(size_t)(tok0 + 16 * w + 4 * q + r) * NPROJ + C_Z + h_ * 64 + 16 * pt + l15]; } while (0)
    S3_LOAD(0);
    bf16x8 cf[4];
#pragma unroll
    for (int ks = 0; ks < 4; ++ks) cf[ks] = *(const bf16x8*)(xact + (size_t)(tok0 + 16 * w + l15) * 1536 + 1280 + g * 128 + ks * 32 + q * 8);
    f32x4 cbt[8];
#pragma unroll
    for (int jt = 0; jt < 8; ++jt) { cbt[jt] = (f32x4){0.f, 0.f, 0.f, 0.f};
        if (jt <= w) {
#pragma unroll
            for (int ks = 0; ks < 4; ++ks) { const bf16x8 bfr = *(const bf16x8*)(xact + (size_t)(tok0 + 16 * jt + l15) * 1536 + 1024 + g * 128 + ks * 32 + q * 8); cbt[jt] = MFMA16(bfr, cf[ks], cbt[jt]); } } }
    __syncthreads();
    for (int idx = tid; idx < 1024; idx += 512) { const int j = idx >> 3, hl = idx & 7; const float dtv = dt_g[(size_t)(tok0 + j) * 16 + 8 * g + hl]; dt_s[idx] = dtv; cf_s[idx] = __expf(acum_s[(j | 15) * 8 + hl] - acum_s[idx]) * dtv; }
    float ssq[4] = {0.f, 0.f, 0.f, 0.f};
    const int irow = 16 * w + l15;
    for (int hl = 0; hl < 8; ++hl) { const int h = 8 * g + hl;
        __syncthreads();
        { const bf16_t* e0 = (const bf16_t*)&xr[0]; const bf16_t* e1 = (const bf16_t*)&xr[1]; (void)e0; (void)e1;
          const unsigned xw[2][4] = {{xr[0].x, xr[0].y, xr[0].z, xr[0].w}, {xr[1].x, xr[1].y, xr[1].z, xr[1].w}};
#pragma unroll
          for (int hh = 0; hh < 2; ++hh)
#pragma unroll
              for (int e = 0; e < 4; ++e) { xT[(xpv + 2 * e) * 136 + xj + 64 * hh] = (bf16_t)(xw[hh][e] & 0xFFFF); xT[(xpv + 2 * e + 1) * 136 + xj + 64 * hh] = (bf16_t)(xw[hh][e] >> 16); }
          *(u32x4*)(hS + hp_ * 136 + hn0) = hr[0]; *(u32x4*)(hS + hp_ * 136 + hn0 + 8) = hr[1]; }
        float zz[16];
#pragma unroll
        for (int e = 0; e < 16; ++e) zz[e] = bf2f(zr[e]);
        __syncthreads();
        if (hl < 7) S3_LOAD(hl + 1);
        const float ai = acum_s[irow * 8 + hl];
        bf16x8 af[4];
#pragma unroll
        for (int s = 0; s < 4; ++s) { float m8[8];
#pragma unroll
            for (int hf = 0; hf < 2; ++hf) { const int jt = 2 * s + hf;
                const float rf = jt < w ? __expf(ai - acum_s[(16 * jt + 15) * 8 + hl]) : 0.f;
#pragma unroll
                for (int r = 0; r < 4; ++r) { const int j = 16 * jt + 4 * q + r; float val = 0.f;
                    if (jt < w) val = cbt[jt][r] * rf * cf_s[j * 8 + hl];
                    else if (jt == w && j <= irow) val = cbt[jt][r] * __expf(ai - acum_s[j * 8 + hl]) * dt_s[j * 8 + hl];
                    m8[hf * 4 + r] = val; } }
            af[s] = as_frag(pack8(m8)); }
        const float dsk = pk->ssd_d[h];
        float ea[4];
#pragma unroll
        for (int r = 0; r < 4; ++r) ea[r] = __expf(acum_s[(16 * w + 4 * q + r) * 8 + hl]);
#pragma unroll
        for (int pt = 0; pt < 4; ++pt) { f32x4 yd = {0.f, 0.f, 0.f, 0.f}, yo = {0.f, 0.f, 0.f, 0.f};
            const bf16_t* xrw = xT + (16 * pt + l15) * 136;
#pragma unroll
            for (int s = 0; s < 4; ++s) if (2 * s <= w) { const u32x2 lo = *(const u32x2*)(xrw + 32 * s + 4 * q), hi = *(const u32x2*)(xrw + 32 * s + 16 + 4 * q); yd = MFMA16(af[s], frag2(lo, hi), yd); }
            const bf16_t* hrw = hS + (16 * pt + l15) * 136 + q * 8;
#pragma unroll
            for (int ks = 0; ks < 4; ++ks) { const bf16x8 hf = *(const bf16x8*)(hrw + ks * 32); yo = MFMA16(cf[ks], hf, yo); }
            const u32x2 xv2 = *(const u32x2*)(xrw + 16 * w + 4 * q); const float xv[4] = {bflo(xv2.x), bfhi(xv2.x), bflo(xv2.y), bfhi(xv2.y)};
#pragma unroll
            for (int r = 0; r < 4; ++r) { const size_t tok = (size_t)(tok0 + 16 * w + 4 * q + r); const int pp = 16 * pt + l15;
                const float y = yd[r] + ea[r] * yo[r] + dsk * xv[r]; const float val = y * siluf(zz[pt * 4 + r]);
                ssq[r] += val * val; mix[tok * DMIX + 1024 + g * 512 + hl * 64 + pp] = f2bf(val); } }
    }
#pragma unroll
    for (int r = 0; r < 4; ++r) { float sv = ssq[r]; sv += shx(sv, 1, lane); sv += shx(sv, 2, lane); sv += shx(sv, 4, lane); sv += shx(sv, 8, lane); if (l15 == 0) rstd_s[16 * w + 4 * q + r] = rsqrtf(sv * (1.f / 512.f) + 1e-5f); }
    asm volatile("s_waitcnt vmcnt(0)" ::: "memory");
    __syncthreads();
    for (int idx = tid; idx < 128 * 64; idx += 512) { const int row = idx >> 6, c8 = (idx & 63) * 8; bf16_t* mp = mix + (size_t)(tok0 + row) * DMIX + 1024 + g * 512 + c8;
        const u32x4 v = *(const u32x4*)mp; float x[8]; unpack8(v, x); const float rs = rstd_s[row];
        const f32x4 g0 = *(const f32x4*)(pk->ssd_norm_g + g * 512 + c8), g1 = *(const f32x4*)(pk->ssd_norm_g + g * 512 + c8 + 4);
        x[0] *= rs * g0[0]; x[1] *= rs * g0[1]; x[2] *= rs * g0[2]; x[3] *= rs * g0[3]; x[4] *= rs * g1[0]; x[5] *= rs * g1[1]; x[6] *= rs * g1[2]; x[7] *= rs * g1[3];
        *(u32x4*)mp = pack8(x); }
#undef S3_LOAD
}

DI void outs_item(KP pk_in, unsigned char* lds, int piece) {
    KP pk = pk_in; asm volatile("" : "+s"(pk));
    const int tid = otid(), w = tid >> 6, lane = tid & 63, l15 = lane & 15, q = lane >> 4;
    const int rg = piece >> 4, cgp = piece & 15;
    const bf16_t* mix = (const bf16_t*)(pk->ws + W_MIX); const bf16_t* wo = (const bf16_t*)(pk->ws + W_WOUTT);
    float* part = (float*)lds;
    f32x4 acc[2][4];
#pragma unroll
    for (int mt = 0; mt < 2; ++mt)
#pragma unroll
        for (int nt = 0; nt < 4; ++nt) acc[mt][nt] = (f32x4){0.f, 0.f, 0.f, 0.f};
    const bf16_t* ap = mix + (size_t)(NTOKP + rg * 32 + l15) * DMIX + w * 384 + q * 8;
    const bf16_t* bp = wo + (size_t)(cgp * 64 + l15) * 3072 + w * 384 + q * 8;
#pragma unroll 4
    for (int ks = 0; ks < 12; ++ks) { bf16x8 a[2], bb[4];
#pragma unroll
        for (int mt = 0; mt < 2; ++mt) a[mt] = *(const bf16x8*)(ap + (size_t)mt * 16 * DMIX + ks * 32);
#pragma unroll
        for (int nt = 0; nt < 4; ++nt) bb[nt] = *(const bf16x8*)(bp + (size_t)nt * 16 * 3072 + ks * 32);
#pragma unroll
        for (int mt = 0; mt < 2; ++mt)
#pragma unroll
            for (int nt = 0; nt < 4; ++nt) acc[mt][nt] = MFMA16(a[mt], bb[nt], acc[mt][nt]); }
    __syncthreads();
#pragma unroll
    for (int mt = 0; mt < 2; ++mt)
#pragma unroll
        for (int nt = 0; nt < 4; ++nt)
#pragma unroll
            for (int r = 0; r < 4; ++r) part[(w * 32 + mt * 16 + 4 * q + r) * 64 + nt * 16 + l15] = acc[mt][nt][r];
    __syncthreads();
    { const int row = tid >> 4, c4 = (tid & 15) * 4; f32x4 sum = {0.f, 0.f, 0.f, 0.f};
#pragma unroll
      for (int ww = 0; ww < 8; ++ww) sum += *(const f32x4*)(part + (ww * 32 + row) * 64 + c4);
      const int srow = rg * 32 + row, col = cgp * 64 + c4; const f32x4 xv = *(const f32x4*)(pk->x_sample + (size_t)srow * 1024 + col);
      const f32x4 v = sum + xv * 1.189207115002721f;
      float s1 = v[0] + v[1] + v[2] + v[3], s2 = v[0] * v[0] + v[1] * v[1] + v[2] * v[2] + v[3] * v[3];
      s1 += shx(s1, 1, lane); s1 += shx(s1, 2, lane); s1 += shx(s1, 4, lane); s1 += shx(s1, 8, lane); s2 += shx(s2, 1, lane); s2 += shx(s2, 2, lane); s2 += shx(s2, 4, lane); s2 += shx(s2, 8, lane);
      float* stat = (float*)(pk->ws + W_STAT) + (size_t)srow * 2; unsigned* c = (unsigned*)(pk->ws + W_CNT) + (64 + rg) * 64;
      if (l15 == 0) { __hip_atomic_fetch_add(stat, s1, __ATOMIC_RELAXED, __HIP_MEMORY_SCOPE_AGENT); __hip_atomic_fetch_add(stat + 1, s2, __ATOMIC_RELAXED, __HIP_MEMORY_SCOPE_AGENT); }
      asm volatile("s_waitcnt vmcnt(0)" ::: "memory");
      if (lane == 0) __hip_atomic_fetch_add(c, 1u, __ATOMIC_RELAXED, __HIP_MEMORY_SCOPE_AGENT);
      pg8::ln_wait(c, 128u);
      const float t1 = __hip_atomic_load(stat, __ATOMIC_RELAXED, __HIP_MEMORY_SCOPE_AGENT), t2 = __hip_atomic_load(stat + 1, __ATOMIC_RELAXED, __HIP_MEMORY_SCOPE_AGENT);
      const float mu = t1 * (1.f / 1024.f); const float rstd = rsqrtf(fmaxf(t2 * (1.f / 1024.f) - mu * mu, 0.f) + 1e-5f);
      const f32x4 gv = *(const f32x4*)(pk->ln_g + col), bv = *(const f32x4*)(pk->ln_b + col);
      *(f32x4*)(pk->out + O_YS + (size_t)srow * 1024 + col) = (v - mu) * rstd * gv + bv; }
    __syncthreads();
}

DI void ln_rows(KP pk_in) {
    KP pk = pk_in; asm volatile("" : "+s"(pk));
    const float* res = (const float*)(pk->ws + W_RES);
    const int tid = otid(); const int lane = tid & 63; const int gw = obid() * 8 + (tid >> 6), nw = gridDim.x * 8;
    f32x4 gg[4], bb[4];
#pragma unroll
    for (int i = 0; i < 4; ++i) { gg[i] = *(const f32x4*)(pk->ln_g + i * 256 + lane * 4); bb[i] = *(const f32x4*)(pk->ln_b + i * 256 + lane * 4); }
    for (int row = gw; row < NTOK; row += nw) { f32x4 v[4]; float s = 0.f;
#pragma unroll
        for (int i = 0; i < 4; ++i) { v[i] = *(const f32x4*)(res + (size_t)row * 1024 + i * 256 + lane * 4); s += v[i][0] + v[i][1] + v[i][2] + v[i][3]; }
        const float mu = wave_sum(s, lane) * (1.f / 1024.f); float s2 = 0.f;
#pragma unroll
        for (int i = 0; i < 4; ++i) { v[i] = v[i] - mu; s2 += v[i][0] * v[i][0] + v[i][1] * v[i][1] + v[i][2] * v[i][2] + v[i][3] * v[i][3]; }
        const float rstd = rsqrtf(wave_sum(s2, lane) * (1.f / 1024.f) + 1e-5f);
#pragma unroll
        for (int i = 0; i < 4; ++i) *(f32x4*)(pk->out + (size_t)row * 1024 + i * 256 + lane * 4) = v[i] * rstd * gg[i] + bb[i]; }
}

__global__ void __launch_bounds__(512, 2) hymba_fwd(Params p_unused) {
    KP pk = kparams();
    extern __shared__ __attribute__((aligned(16))) unsigned char shm[];
    cg::grid_group grid = cg::this_grid();
    const int G = gridDim.x;
    if (threadIdx.x < 4) ((volatile LAS unsigned*)(LAS unsigned char*)shm)[32768 + threadIdx.x] = 0u;
    __syncthreads();
    const int ph_lo_chk = pk->ph_lo;
    XcdBarrier xb = xcd_barrier_post((unsigned*)(pk->ws + W_BAR), (volatile LAS unsigned*)(LAS unsigned char*)shm + 32768);
    if (ph_lo_chk < 0) grid.sync();
    { KP pk = kparams(); for (int rep = 0; rep < REP0; ++rep) phase_prep(pk, shm); }
    xcd_barrier(xb);
    for (int rep = 1; rep < REPS; ++rep) xcd_barrier(xb);
    { KP pk = kparams(); const int bid = obid();
      for (int rep = 0; rep < REP1; ++rep) {
        { pg8::Gemm g; g.A = (const bf16_t*)(pk->ws + W_XB); g.Bt = (const bf16_t*)(pk->ws + W_WINT); g.M = NTOK; g.N = NPROJ; g.K = 1024;
          pg8::StaticOrder S; S.init(g.M, g.N, G, bid); pg8::EpiBf16 E; E.O = (bf16_t*)(pk->ws + W_PROJ); E.ldc = NPROJ;
          pg8::gemm_phase<pg8::EpiBf16, pg8::StaticOrder>((LAS unsigned char*)shm, g, S, E); }
        { pg8::Gemm g; g.A = (const bf16_t*)(pk->ws + W_MEMB); g.Bt = (const bf16_t*)(pk->ws + W_WKVT); g.M = 2048; g.N = 2048; g.K = 1024;
          const int shift = (66 * 26) % G; pg8::StaticOrder S; S.init(g.M, g.N, G, (bid + G - shift) % G);
          pg8::EpiKV E; E.mk = pk->out + O_MKP; E.mv = pk->out + O_MVP; E.kb = (bf16_t*)(pk->ws + W_KB); E.vt = (bf16_t*)(pk->ws + W_VT);
          pg8::gemm_phase<pg8::EpiKV, pg8::StaticOrder>((LAS unsigned char*)shm, g, S, E); } } }
    xcd_barrier(xb);
    { KP pk = kparams(); const int bid = obid();
      for (int rep = 0; rep < REP2; ++rep) for (int it = bid; it < 512; it += G) { if (it < 256) ssd1_item(pk, shm, it >> 5, (it >> 1) & 15, it & 1); else if (it < 384) rgconv_item(pk, (it - 256) >> 4, (it - 256) & 15); else { const int u = it - 384; rg_item(pk, shm, true, u >> 5, (u >> 2) & 7, u & 3); } } }
    xcd_barrier(xb);
    { KP pk = kparams(); const int bid = obid();
      for (int rep = 0; rep < REP3; ++rep) for (int kk = 0; kk < 7; ++kk) { const int kq = kk; const int it = bid + kq * G;
          if (it >= 1792) continue;
          if (rep > 0 && (it < R3LO || it >= R3HI)) continue;
          if (it < 256) rg_item(pk, shm, false, it >> 5, (it >> 2) & 7, it & 3);
          else if (it < 512) statepass_item(pk, it - 256);
          else if (it < 768) { const int u = it - 512; ssds_item(pk, shm, u >> 1, u & 1); }
          else if (it < 1280) { const int u = it - 768; attns_item(pk, shm, u >> 2, u & 3); }
          else { const int u = it - 1280; attnp_item(pk, shm, u >> 6, (u >> 4) & 3, u & 15); } } }
    xcd_barrier(xb);
    { KP pk = kparams(); const int bid = obid();
      for (int rep = 0; rep < REP4; ++rep) for (int it = bid; it < 256; it += G) ssd3_item(pk, shm, it >> 5, (it >> 1) & 15, it & 1); }
    xcd_barrier(xb);
    { KP pk = kparams(); const int bid = obid();
      for (int rep = 0; rep < REP5; ++rep) {
        for (int it = bid; it < 256; it += G) outs_item(pk, shm, it);
        pg8::Gemm g; g.A = (const bf16_t*)(pk->ws + W_MIX); g.Bt = (const bf16_t*)(pk->ws + W_WOUTT); g.M = NTOKP; g.N = 1024; g.K = 3072;
        pg8::StaticOrder S; S.init(g.M, g.N, G, bid); pg8::EpiLn E; E.out = pk->out + O_YP; E.xp = pk->x_prompt; E.lng = pk->ln_g; E.lnb = pk->ln_b; E.stat = (float*)(pk->ws + W_SLOT); E.cnt = (unsigned*)(pk->ws + W_CNT); E.alpha = 1.189207115002721f; E.red = (LAS float*)(LAS unsigned char*)shm;
        pg8::gemm_phase<pg8::EpiLn, pg8::StaticOrder>((LAS unsigned char*)shm, g, S, E); } }
}

extern "C" void kernel_launch(void* const* d_in, const int* in_sizes, int n_in, void* d_out, int out_size, void* d_ws, size_t ws_size, hipStream_t stream) {
    static int grid_blocks = 0;
    if (!grid_blocks) {
        int dev = 0, cus = 0, per_cu = 0;
        hipGetDevice(&dev);
        hipDeviceGetAttribute(&cus, hipDeviceAttributeMultiprocessorCount, dev);
        if (hipFuncSetAttribute((const void*)hymba_fwd, hipFuncAttributeMaxDynamicSharedMemorySize, LDS_BYTES) != hipSuccess) fprintf(stderr, "hipFuncSetAttribute failed\n");
        hipOccupancyMaxActiveBlocksPerMultiprocessor(&per_cu, (const void*)hymba_fwd, 512, LDS_BYTES);
        if (per_cu < 1) { fprintf(stderr, "occupancy query says %d blocks per CU\n", per_cu); per_cu = 1; }
        grid_blocks = cus * 1;
        if (ws_size < W_END) fprintf(stderr, "workspace too small: %zu < %zu\n", ws_size, (size_t)W_END);
    }
    if (hipMemsetAsync((char*)d_ws + W_BAR, 0, W_ZERO_END - W_BAR, stream) != hipSuccess) fprintf(stderr, "memset failed\n");
    Params p{};
    const float** fp = (const float**)&p;
    for (int i = 0; i < 28; ++i) fp[i] = (const float*)d_in[i];
    p.out = (float*)d_out; p.ws = (unsigned char*)d_ws;
    p.ph_lo = 0; p.ph_hi = NPHASE;
    void* args[] = {&p};
    hipError_t e = hipLaunchCooperativeKernel((const void*)hymba_fwd, dim3(grid_blocks), dim3(512), args, LDS_BYTES, stream);
    if (e != hipSuccess) fprintf(stderr, "cooperative launch failed: %s (grid %d)\n", hipGetErrorString(e), grid_blocks);
}
```

```cpp
#include <hip/hip_runtime.h>
#include <hip/hip_cooperative_groups.h>
#include <cstdio>
namespace cg = cooperative_groups;

#ifndef REP2
#define REP2 1
#endif
#ifndef REP3
#define REP3 1
#endif
#ifndef REP4
#define REP4 1
#endif
#ifndef R3LO
#define R3LO 0
#define R3HI 256
#endif
#ifndef REP0
#define REP0 1
#endif
#ifndef REP1
#define REP1 1
#endif
#ifndef REP5
#define REP5 1
#endif
#ifndef REP6
#define REP6 1
#endif
#ifndef REPS
#define REPS 1
#endif
#ifndef PHM
#define PHM 127
#endif
#ifndef N_LAUNCH_PER_PHASE
#define N_LAUNCH_PER_PHASE 0
#endif

#define DI __device__ __forceinline__
#define LAS __attribute__((address_space(3)))
typedef unsigned short bf16_t;
typedef short bf16x8 __attribute__((ext_vector_type(8)));
typedef float f32x4 __attribute__((ext_vector_type(4)));
typedef unsigned u32x4 __attribute__((ext_vector_type(4)));
typedef unsigned u32x2 __attribute__((ext_vector_type(2)));

constexpr int NTOKP = 16384, NTOKS = 512, NTOK = 16896, DM = 1024, NPROJ = 6656, DMIX = 3072, DIN = 6672;
constexpr int C_RGX = 0, C_RGG = 1024, C_XBC = 2048, C_Z = 3584, C_Q = 4608, C_XG = 5632;
constexpr int NPHASE = 7;
constexpr int LDS_BYTES = 131072 + 64;

constexpr size_t O_YP = 0, O_YS = O_YP + (size_t)NTOKP * DM, O_RGCP = O_YS + (size_t)NTOKS * DM, O_RGHP = O_RGCP + 8 * 3 * 1024, O_SCP = O_RGHP + 8 * 1024,
                 O_SHP = O_SCP + 8 * 3 * 1536, O_MKP = O_SHP + (size_t)8 * 16 * 64 * 128, O_MVP = O_MKP + (size_t)2048 * 1024, O_RGCS = O_MVP + (size_t)2048 * 1024,
                 O_RGHS = O_RGCS + (size_t)128 * 3 * 1024, O_SCS = O_RGHS + 128 * 1024, O_SHS = O_SCS + (size_t)128 * 3 * 1536;

constexpr size_t al256(size_t x) { return (x + 255) & ~(size_t)255; }
constexpr size_t W_XB = 0;
constexpr size_t W_WINT = al256(W_XB + (size_t)NTOK * DM * 2);
constexpr size_t W_WDTT = al256(W_WINT + (size_t)NPROJ * DM * 2);
constexpr size_t W_WDTF = al256(W_WDTT + 16 * 1024 * 2);
constexpr size_t W_WOUTT = al256(W_WDTF + 16 * 1024 * 4);
constexpr size_t W_WKVT = al256(W_WOUTT + (size_t)1024 * 3072 * 2);
constexpr size_t W_MEMB = al256(W_WKVT + (size_t)2048 * 1024 * 2);
constexpr size_t W_WGT = al256(W_MEMB + (size_t)2048 * 1024 * 2);
constexpr size_t W_KB = al256(W_WGT + (size_t)8 * 4 * 64 * 128 * 2);
constexpr size_t W_VT = al256(W_KB + (size_t)2048 * 1024 * 2);
constexpr size_t W_XACT = al256(W_VT + (size_t)2048 * 1024 * 2);
constexpr size_t W_DT = al256(W_XACT + (size_t)NTOKP * 1536 * 2);
constexpr size_t W_ACUM = al256(W_DT + (size_t)NTOKP * 16 * 4);
constexpr size_t W_CD = al256(W_ACUM + (size_t)NTOKP * 16 * 4);
constexpr size_t W_ST = al256(W_CD + 8 * 16 * 16 * 4);
constexpr size_t W_MIX = al256(W_ST + (size_t)8 * 16 * 16 * 8192 * 4);
constexpr size_t W_PROJ = al256(W_MIX + (size_t)NTOK * DMIX * 2);
constexpr size_t W_RES = W_PROJ;
constexpr size_t W_BAR = al256(W_PROJ + (size_t)NTOK * NPROJ * 2);
constexpr size_t W_CNT = al256(W_BAR + 3456 * 4);
constexpr size_t W_STAT = al256(W_CNT + 80 * 256);
constexpr size_t W_ZERO_END = al256(W_STAT + (size_t)NTOKS * 2 * 4);
constexpr size_t W_SLOT = W_ZERO_END;
constexpr size_t W_END = al256(W_SLOT + (size_t)NTOKP * 8 * 4);

struct Params {
    const float *x_prompt, *x_sample, *mem_prompt, *state_rg_conv, *state_rg_h, *state_ssd_conv, *state_ssd_h, *cache_k, *cache_v;
    const float *w_in, *rg_conv_w, *rg_conv_b, *w_rg_a, *b_rg_a, *w_rg_i, *b_rg_i, *rg_lambda, *ssd_conv_w, *ssd_conv_b, *ssd_dt_bias, *ssd_a_log, *ssd_d, *ssd_norm_g,
        *w_mem_k, *w_mem_v, *w_out, *ln_g, *ln_b;
    float* out; unsigned char* ws;
    int ph_lo, ph_hi;
};
typedef const __attribute__((address_space(4))) Params* KP;
DI KP kparams() { KP k = (KP)__builtin_amdgcn_kernarg_segment_ptr(); asm volatile("" : "+s"(k)); return k; }

DI int otid() { int t = threadIdx.x; asm volatile("" : "+v"(t)); return t; }
DI int obid() { int t = blockIdx.x; asm volatile("" : "+s"(t)); return t; }
DI float bf2f(bf16_t b) { return __uint_as_float(((unsigned)b) << 16); }
typedef __bf16 hbf2 __attribute__((ext_vector_type(2)));
typedef float f32x2 __attribute__((ext_vector_type(2)));
DI unsigned pack2(float lo, float hi) { const f32x2 v = {lo, hi}; return __builtin_bit_cast(unsigned, __builtin_convertvector(v, hbf2)); }
DI bf16_t f2bf(float f) { return (bf16_t)(pack2(f, 0.f) & 0xFFFFu); }
DI float bflo(unsigned w) { return __uint_as_float(w << 16); }
DI float bfhi(unsigned w) { return __uint_as_float(w & 0xFFFF0000u); }
DI void unpack8(const u32x4 v, float (&o)[8]) { o[0] = bflo(v.x); o[1] = bfhi(v.x); o[2] = bflo(v.y); o[3] = bfhi(v.y); o[4] = bflo(v.z); o[5] = bfhi(v.z); o[6] = bflo(v.w); o[7] = bfhi(v.w); }
DI u32x4 pack8(const float (&o)[8]) { u32x4 w; w.x = pack2(o[0], o[1]); w.y = pack2(o[2], o[3]); w.z = pack2(o[4], o[5]); w.w = pack2(o[6], o[7]); return w; }
DI bf16x8 as_frag(u32x4 w) { return __builtin_bit_cast(bf16x8, w); }
DI bf16x8 frag2(u32x2 lo, u32x2 hi) { u32x4 w; w.x = lo.x; w.y = lo.y; w.z = hi.x; w.w = hi.y; return __builtin_bit_cast(bf16x8, w); }
DI float shx(float v, int m, int lane) { return __int_as_float(__builtin_amdgcn_ds_bpermute((lane ^ m) << 2, __float_as_int(v))); }
DI float shl(float v, int src) { return __int_as_float(__builtin_amdgcn_ds_bpermute(src << 2, __float_as_int(v))); }
DI float siluf(float x) { return x * __builtin_amdgcn_rcpf(1.f + __expf(-x)); }
DI float sigmf(float x) { return __builtin_amdgcn_rcpf(1.f + __expf(-x)); }
DI float softplusf(float v) { return v > 20.f ? v : __logf(1.f + __expf(v)); }
#define MFMA16(a, b, c) __builtin_amdgcn_mfma_f32_16x16x32_bf16((a), (b), (c), 0, 0, 0)

#define XB_TMO      128
#define XB_XCNT(j)  (256  + 64 * (j))
#define XB_XSUB(j)  (1280 + 64 * (j))
#define XB_XGEN(j)  (2304 + 64 * (j))
#define XB_TOP      3328
#define XB_TOPGEN   3392
#define XCD_BAR_WORDS 3456
#define XB_SPIN_CAP (1u << 20)
DI unsigned xb_ld(unsigned* ptr)              { return __hip_atomic_load(ptr, __ATOMIC_RELAXED, __HIP_MEMORY_SCOPE_AGENT); }
DI unsigned xb_add(unsigned* ptr, unsigned v) { return __hip_atomic_fetch_add(ptr, v, __ATOMIC_RELAXED, __HIP_MEMORY_SCOPE_AGENT); }
DI unsigned xb_xcc_id() { return (unsigned)__builtin_amdgcn_s_getreg((3 << 11) | 20) & 0xFu; }
#define XB_SPIN(cond, bar) do { unsigned _sp = 0; while (cond) { __builtin_amdgcn_s_sleep(1); \
    if ((++_sp & 255u) == 0u) { if (xb_ld(&(bar)[XB_TMO])) break; if (_sp > XB_SPIN_CAP) { atomicAdd(&(bar)[XB_TMO], 1u); break; } } } } while (0)
struct XcdBarrier { unsigned* bar; unsigned x; volatile LAS unsigned* st; };
DI XcdBarrier xcd_barrier_post(unsigned* bar, volatile LAS unsigned* st) {
    XcdBarrier b; b.bar = bar; b.x = xb_xcc_id(); b.st = st;
    if (threadIdx.x == 0) (void)xb_add(&bar[XB_XCNT(b.x)], 1u);
    return b;
}
DI void xcd_barrier_complete(unsigned* bar, unsigned x, unsigned& nloc, unsigned& nx) {
    const unsigned G = gridDim.x * gridDim.y * gridDim.z;
    unsigned sum, cnt, mine, sp = 0u;
    for (;;) {
        sum = 0u; cnt = 0u; mine = 0u;
#pragma unroll
        for (unsigned j = 0; j < 16; ++j) { const unsigned c = xb_ld(&bar[XB_XCNT(j)]); sum += c; cnt += (c > 0u) ? 1u : 0u; mine = (j == x) ? c : mine; }
        if (sum == G) break;
        __builtin_amdgcn_s_sleep(1);
        if ((++sp & 255u) == 0u) { if (xb_ld(&bar[XB_TMO])) break; if (sp > XB_SPIN_CAP) { atomicAdd(&bar[XB_TMO], 1u); break; } }
    }
    nloc = mine > 0u ? mine : 1u; nx = cnt > 0u ? cnt : 1u;
}
DI void xcd_barrier(const XcdBarrier& b) {
    asm volatile("s_waitcnt vmcnt(0)" ::: "memory");
    __syncthreads();
    if (threadIdx.x == 0) {
        unsigned* bar = b.bar;
        __builtin_amdgcn_s_waitcnt(0);
        unsigned nloc = b.st[0], nx = b.st[1];
        if (nloc == 0u) { xcd_barrier_complete(bar, b.x, nloc, nx); b.st[0] = nloc; b.st[1] = nx; }
        const unsigned old = xb_add(&bar[XB_XSUB(b.x)], 1u);
        const unsigned gen = old / nloc;
        if (old + 1u == (gen + 1u) * nloc) {
            __builtin_amdgcn_fence(__ATOMIC_RELEASE, "agent");
            asm volatile("s_waitcnt vmcnt(0)" ::: "memory");
            const unsigned og = xb_add(&bar[XB_TOP], 1u);
            const unsigned tg = og / nx;
            if (og + 1u == (tg + 1u) * nx) xb_add(&bar[XB_TOPGEN], 1u);
            else XB_SPIN(xb_ld(&bar[XB_TOPGEN]) == tg, bar);
            __builtin_amdgcn_fence(__ATOMIC_ACQUIRE, "agent");
            xb_add(&bar[XB_XGEN(b.x)], 1u);
            asm volatile("s_waitcnt vmcnt(0)" ::: "memory");
        } else {
            XB_SPIN(xb_ld(&bar[XB_XGEN(b.x)]) == gen, bar);
            __builtin_amdgcn_fence(__ATOMIC_ACQUIRE, "agent");
            asm volatile("s_waitcnt vmcnt(0)" ::: "memory");
        }
    }
    __syncthreads();
}

namespace pg8 {
constexpr int BM = 256, BK = 64, HALF = 128, HTB = HALF * BK * 2, STAGE_BYTES = 8 * HTB, NXCD = 8, WGM = 8;
DI int lds_byte(int r, int c) { const int st = (r >> 4) * 2 + (c >> 5), rr = r & 15, cc = c & 31, ob = rr * 64 + cc * 2; return st * 1024 + (ob ^ (((ob >> 9) & 1) << 5)); }
DI void stage_rc(int b, int& R, int& C) { const int st = b / 1024, sb = b % 1024, swz = sb ^ (((sb >> 9) & 1) << 5); R = (st >> 1) * 16 + swz / 64; C = (st & 1) * 32 + (swz % 64) / 2; }
DI int perm32(int rho) { const int n = rho >> 4, i = rho & 15; return 8 * (i >> 2) + 4 * n + (i & 3); }
struct Unit { int pm, pn; };
struct Gemm { const bf16_t* A; const bf16_t* Bt; int M, N, K; };
struct StaticOrder {
    int nM, nN, nwg, G, c;
    DI void init(int M, int N, int G_, int c_) { nM = M / BM; nN = N / BM; nwg = nM * nN; G = G_; c = c_; }
    DI bool next(int i, Unit& u) const {
        const long L = (long)i * G + c; if (L >= nwg) return false;
        int wgid = (int)L; { const int q = nwg / NXCD, r = nwg % NXCD, xcd = wgid % NXCD, off = wgid / NXCD; wgid = (xcd < r ? xcd * (q + 1) : r * (q + 1) + (xcd - r) * q) + off; }
        const int nig = WGM * nN, gid = wgid / nig, fm = gid * WGM, gsz = (nM - fm) < WGM ? (nM - fm) : WGM;
        u.pm = fm + ((wgid % nig) % gsz); u.pn = (wgid % nig) / gsz; return true;
    }
};
DI unsigned cvt_pk_bf16(float lo, float hi) { unsigned r; asm volatile("v_cvt_pk_bf16_f32 %0, %1, %2" : "=v"(r) : "v"(lo), "v"(hi)); return r; }

struct EpiBf16 {
    static constexpr bool PERM = true, AFTER_DRAIN = false;
    bf16_t* O; int ldc;
    DI void operator()(const f32x4 (&acc)[2][2][4][2], const Unit& u, int wr, int wc, int fr, int fq) const {
        const int row0 = u.pm * BM + wr * 64 + fr; const int col0 = u.pn * BM + wc * 32 + 8 * fq;
#pragma unroll
        for (int ai = 0; ai < 2; ++ai)
#pragma unroll
            for (int m = 0; m < 4; ++m) { bf16_t* rowp = O + (size_t)(row0 + ai * HALF + m * 16) * ldc + col0;
#pragma unroll
                for (int bj = 0; bj < 2; ++bj) { const f32x4 v0 = acc[ai][bj][m][0], v1 = acc[ai][bj][m][1];
                    u32x4 w; w.x = cvt_pk_bf16(v0[0], v0[1]); w.y = cvt_pk_bf16(v0[2], v0[3]); w.z = cvt_pk_bf16(v1[0], v1[1]); w.w = cvt_pk_bf16(v1[2], v1[3]);
                    *(u32x4*)(rowp + bj * HALF) = w; } }
    }
};
struct EpiKV {
    static constexpr bool PERM = false, AFTER_DRAIN = false;
    float* mk; float* mv; bf16_t* kb; bf16_t* vt;
    DI void operator()(const f32x4 (&acc)[2][2][4][2], const Unit& u, int wr, int wc, int fr, int fq) const {
        const int row0 = u.pm * BM + wr * 64 + fr, col0 = u.pn * BM + wc * 32 + 4 * fq;
#pragma unroll
        for (int ai = 0; ai < 2; ++ai)
#pragma unroll
            for (int m = 0; m < 4; ++m) { const int row = row0 + ai * HALF + m * 16;
#pragma unroll
                for (int bj = 0; bj < 2; ++bj)
#pragma unroll
                    for (int n = 0; n < 2; ++n) { const int col = col0 + bj * HALF + n * 16; const f32x4 v = acc[ai][bj][m][n];
                        if (col < 1024) { *(f32x4*)(mk + (size_t)row * 1024 + col) = v; u32x2 w; w.x = cvt_pk_bf16(v[0], v[1]); w.y = cvt_pk_bf16(v[2], v[3]); *(u32x2*)(kb + (size_t)row * 1024 + col) = w; }
                        else { const int cc = col - 1024; *(f32x4*)(mv + (size_t)row * 1024 + cc) = v; const int bb = row >> 8, mt = row & 255;
#pragma unroll
                            for (int j = 0; j < 4; ++j) { const int c2 = cc + j, head = c2 >> 8, d = c2 & 255; vt[((size_t)((bb * 4 + head) * 256 + d)) * 256 + mt] = f2bf(v[j]); } } } }
    }
};
DI void ln_wait(unsigned* cnt, unsigned target) { unsigned sp = 0; while (__hip_atomic_load(cnt, __ATOMIC_RELAXED, __HIP_MEMORY_SCOPE_AGENT) < target) { __builtin_amdgcn_s_sleep(1); if (++sp > (1u << 22)) break; } }
struct EpiLn {
    static constexpr bool PERM = false, AFTER_DRAIN = true;
    float* out; const float* xp; const float* lng; const float* lnb; float* stat; unsigned* cnt; float alpha; LAS float* red;
    DI void operator()(f32x4 (&acc)[2][2][4][2], const Unit& u, int wr, int wc, int fr, int fq) const {
        const int row0 = u.pm * BM + wr * 64 + fr, col0 = u.pn * BM + wc * 32 + 4 * fq; const int lane = fq * 16 + fr; const int tid = (wr * 4 + wc) * 64 + lane;
#pragma unroll
        for (int ai = 0; ai < 2; ++ai)
#pragma unroll
            for (int m = 0; m < 4; ++m) { const int row = row0 + ai * HALF + m * 16; const float* xr = xp + (size_t)row * 1024; float s1 = 0.f, s2 = 0.f;
#pragma unroll
                for (int bj = 0; bj < 2; ++bj)
#pragma unroll
                    for (int n = 0; n < 2; ++n) { const int col = col0 + bj * HALF + n * 16; const f32x4 xv = *(const f32x4*)(xr + col); const f32x4 v = acc[ai][bj][m][n] + xv * alpha; acc[ai][bj][m][n] = v;
                        s1 += v[0] + v[1] + v[2] + v[3]; s2 += v[0] * v[0] + v[1] * v[1] + v[2] * v[2] + v[3] * v[3]; }
                s1 += shx(s1, 16, lane); s1 += shx(s1, 32, lane); s2 += shx(s2, 16, lane); s2 += shx(s2, 32, lane);
                if (fq == 0) { const int lr = wr * 64 + ai * HALF + m * 16 + fr; red[(lr * 4 + wc) * 2] = s1; red[(lr * 4 + wc) * 2 + 1] = s2; } }
        __syncthreads();
        if (tid < 256) { const int lr = tid; float t1 = 0.f, t2 = 0.f;
#pragma unroll
            for (int c = 0; c < 4; ++c) { t1 += red[(lr * 4 + c) * 2]; t2 += red[(lr * 4 + c) * 2 + 1]; }
            float* sp = stat + ((size_t)(u.pm * BM + lr) * 4 + u.pn) * 2;
            __hip_atomic_store(sp, t1, __ATOMIC_RELAXED, __HIP_MEMORY_SCOPE_AGENT); __hip_atomic_store(sp + 1, t2, __ATOMIC_RELAXED, __HIP_MEMORY_SCOPE_AGENT);
            asm volatile("s_waitcnt vmcnt(0)" ::: "memory"); }
        __syncthreads();
        unsigned* c = cnt + u.pm * 64;
        if (tid == 0) { __hip_atomic_fetch_add(c, 1u, __ATOMIC_RELAXED, __HIP_MEMORY_SCOPE_AGENT); ln_wait(c, 4u); }
        __syncthreads();
        if (tid < 256) { const int lr = tid; float t1 = 0.f, t2 = 0.f; const float* sp = stat + (size_t)(u.pm * BM + lr) * 8;
#pragma unroll
            for (int c2 = 0; c2 < 4; ++c2) { t1 += __hip_atomic_load(sp + c2 * 2, __ATOMIC_RELAXED, __HIP_MEMORY_SCOPE_AGENT); t2 += __hip_atomic_load(sp + c2 * 2 + 1, __ATOMIC_RELAXED, __HIP_MEMORY_SCOPE_AGENT); }
            const float mu = t1 * (1.f / 1024.f); red[lr * 2] = mu; red[lr * 2 + 1] = rsqrtf(fmaxf(t2 * (1.f / 1024.f) - mu * mu, 0.f) + 1e-5f); }
        __syncthreads();
#pragma unroll
        for (int ai = 0; ai < 2; ++ai)
#pragma unroll
            for (int m = 0; m < 4; ++m) { const int row = row0 + ai * HALF + m * 16; const int lr = wr * 64 + ai * HALF + m * 16 + fr; const float mu = red[lr * 2], rstd = red[lr * 2 + 1];
#pragma unroll
                for (int bj = 0; bj < 2; ++bj)
#pragma unroll
                    for (int n = 0; n < 2; ++n) { const int col = col0 + bj * HALF + n * 16; const f32x4 gv = *(const f32x4*)(lng + col), bv = *(const f32x4*)(lnb + col);
                        *(f32x4*)(out + (size_t)row * 1024 + col) = (acc[ai][bj][m][n] - mu) * rstd * gv + bv; } }
    }
};
struct EpiRes {
    static constexpr bool PERM = false, AFTER_DRAIN = false;
    float* res; const float* xp; const float* xs; float alpha;
    DI void operator()(const f32x4 (&acc)[2][2][4][2], const Unit& u, int wr, int wc, int fr, int fq) const {
        const int row0 = u.pm * BM + wr * 64 + fr, col0 = u.pn * BM + wc * 32 + 4 * fq;
#pragma unroll
        for (int ai = 0; ai < 2; ++ai)
#pragma unroll
            for (int m = 0; m < 4; ++m) { const int row = row0 + ai * HALF + m * 16; const float* xr = row < NTOKP ? xp + (size_t)row * 1024 : xs + (size_t)(row - NTOKP) * 1024;
#pragma unroll
                for (int bj = 0; bj < 2; ++bj)
#pragma unroll
                    for (int n = 0; n < 2; ++n) { const int col = col0 + bj * HALF + n * 16; const f32x4 xv = *(const f32x4*)(xr + col);
                        *(f32x4*)(res + (size_t)row * 1024 + col) = acc[ai][bj][m][n] + xv * alpha; } }
    }
};

template <class Epi, class Sched>
DI void gemm_phase(LAS unsigned char* lds, const Gemm g, const Sched& S, const Epi& E) {
    const int tid = otid(), wid = __builtin_amdgcn_readfirstlane(tid >> 6), lane = tid & 63, wr = wid >> 2, wc = wid & 3, fr = lane & 15, fq = lane >> 4;
    const int K = g.K, nt = K / BK;
    unsigned voffA[2], voffB[2];
#pragma unroll
    for (int i = 0; i < 2; ++i) { int R, C; stage_rc(tid * 16 + i * 8192, R, C); const int Rb = Epi::PERM ? ((R & ~31) + perm32(R & 31)) : R;
        voffA[i] = (unsigned)(R * K + C) * 2u; voffB[i] = (unsigned)(Rb * K + C) * 2u; }
    const size_t kstep = (size_t)(BK * 2);
    const size_t hstep = (size_t)HALF * K * 2;
    const size_t tstep = 2 * hstep;
    const unsigned ldsw = (unsigned)wid * 1024u;
    const int aoff = lds_byte(wr * 64 + fr, fq * 8), boff = lds_byte(wc * 32 + fr, fq * 8);
#define PG8_SA(b, h) (((b) * 2 + (h)) * HTB)
#define PG8_SB(b, h) ((4 + (b) * 2 + (h)) * HTB)
#define PG8_STAGE(bufoff, gbase, voff) do { _Pragma("unroll") for (int _i = 0; _i < 2; ++_i) \
        __builtin_amdgcn_global_load_lds((const unsigned*)((const char*)(gbase) + (voff)[_i]), (LAS unsigned*)(lds + (bufoff) + ldsw + _i * 8192), 16, 0, 0); } while (0)
#define PG8_LDA(dst, b, h) do { _Pragma("unroll") for (int m = 0; m < 4; ++m) _Pragma("unroll") for (int k = 0; k < 2; ++k) dst[m][k] = *(const LAS bf16x8*)(lds + PG8_SA(b, h) + aoff + m * 2048 + k * 1024); } while (0)
#define PG8_LDB(dst, b, h) do { _Pragma("unroll") for (int n = 0; n < 2; ++n) _Pragma("unroll") for (int k = 0; k < 2; ++k) dst[n][k] = *(const LAS bf16x8*)(lds + PG8_SB(b, h) + boff + n * 2048 + k * 1024); } while (0)
#define PG8_MMA(ai, bj, At, Bt) do { __builtin_amdgcn_s_setprio(1); _Pragma("unroll") for (int m = 0; m < 4; ++m) _Pragma("unroll") for (int n = 0; n < 2; ++n) _Pragma("unroll") for (int k = 0; k < 2; ++k) \
        acc[ai][bj][m][n] = __builtin_amdgcn_mfma_f32_16x16x32_bf16(Bt[n][k], At[m][k], acc[ai][bj][m][n], 0, 0, 0); __builtin_amdgcn_s_setprio(0); } while (0)
#define PG8_WAIT_V(n) asm volatile("s_waitcnt vmcnt(" #n ")" ::: "memory")
#define PG8_WAIT_L(n) asm volatile("s_waitcnt lgkmcnt(" #n ")" ::: "memory")
#define PG8_BAR __builtin_amdgcn_s_barrier()
#define PG8_SCHED __builtin_amdgcn_sched_barrier(0)
    Unit cur, nxt; int ui = 0;
    if (!S.next(0, cur)) return;
    f32x4 acc[2][2][4][2];
#pragma unroll
    for (int a = 0; a < 2; ++a)
#pragma unroll
        for (int b = 0; b < 2; ++b)
#pragma unroll
            for (int m = 0; m < 4; ++m)
#pragma unroll
                for (int n = 0; n < 2; ++n) acc[a][b][m][n] = (f32x4){0.f, 0.f, 0.f, 0.f};
    bf16x8 At[4][2], B0[2][2], B1[2][2];
    const char* cA = (const char*)g.A + (size_t)cur.pm * tstep; const char* cB = (const char*)g.Bt + (size_t)cur.pn * tstep;
    PG8_STAGE(PG8_SB(0, 0), cB, voffB); PG8_STAGE(PG8_SA(0, 0), cA, voffA); PG8_STAGE(PG8_SB(0, 1), cB + hstep, voffB); PG8_STAGE(PG8_SA(0, 1), cA + hstep, voffA);
    if (wr == 1) PG8_BAR;
    PG8_WAIT_V(4); PG8_BAR;
    PG8_STAGE(PG8_SB(1, 0), cB + kstep, voffB); PG8_STAGE(PG8_SA(1, 0), cA + kstep, voffA); PG8_STAGE(PG8_SB(1, 1), cB + hstep + kstep, voffB);
    PG8_WAIT_V(6); PG8_BAR;
    for (;;) {
        const bool has_next = S.next(ui + 1, nxt);
        const char* nA = has_next ? (const char*)g.A + (size_t)nxt.pm * tstep : cA; const char* nB = has_next ? (const char*)g.Bt + (size_t)nxt.pn * tstep : cB;
        for (int t = 0; t < nt; t += 2) {
            const bool last = (t == nt - 2);
            const char* a1 = cA + (size_t)(t + 1) * kstep;
            const char* a2 = last ? nA : cA + (size_t)(t + 2) * kstep; const char* b2 = last ? nB : cB + (size_t)(t + 2) * kstep;
            const char* a3 = a2 + kstep; const char* b3 = b2 + kstep;
            PG8_LDB(B0, 0, 0); PG8_SCHED; PG8_LDA(At, 0, 0); PG8_STAGE(PG8_SA(1, 1), a1 + hstep, voffA);
            PG8_WAIT_L(8); PG8_BAR; PG8_WAIT_L(0); PG8_MMA(0, 0, At, B0); PG8_BAR; PG8_SCHED;
            PG8_LDB(B1, 0, 1); PG8_STAGE(PG8_SB(0, 0), b2, voffB);
            PG8_BAR; PG8_WAIT_L(0); PG8_MMA(0, 1, At, B1); PG8_BAR;
            PG8_LDA(At, 0, 1); PG8_STAGE(PG8_SA(0, 0), a2, voffA);
            PG8_BAR; PG8_WAIT_L(0); PG8_MMA(1, 0, At, B0); PG8_BAR; PG8_SCHED;
            PG8_STAGE(PG8_SB(0, 1), b2 + hstep, voffB);
            PG8_WAIT_V(6); PG8_BAR; PG8_MMA(1, 1, At, B1); PG8_BAR;
            PG8_LDB(B0, 1, 0); PG8_SCHED; PG8_LDA(At, 1, 0); PG8_STAGE(PG8_SA(0, 1), a2 + hstep, voffA);
            PG8_WAIT_L(8); PG8_BAR; PG8_WAIT_L(0); PG8_MMA(0, 0, At, B0); PG8_BAR; PG8_SCHED;
            PG8_LDB(B1, 1, 1); PG8_STAGE(PG8_SB(1, 0), b3, voffB);
            PG8_BAR; PG8_WAIT_L(0); PG8_MMA(0, 1, At, B1); PG8_BAR;
            PG8_LDA(At, 1, 1); PG8_STAGE(PG8_SA(1, 0), a3, voffA);
            PG8_BAR; PG8_WAIT_L(0); PG8_MMA(1, 0, At, B0); PG8_BAR; PG8_SCHED;
            PG8_STAGE(PG8_SB(1, 1), b3 + hstep, voffB);
            PG8_WAIT_V(6); PG8_BAR; PG8_MMA(1, 1, At, B1); PG8_BAR;
        }
        if constexpr (!Epi::AFTER_DRAIN) E(acc, cur, wr, wc, fr, fq);
        if (!has_next) break;
#pragma unroll
        for (int a = 0; a < 2; ++a)
#pragma unroll
            for (int b = 0; b < 2; ++b)
#pragma unroll
                for (int m = 0; m < 4; ++m)
#pragma unroll
                    for (int n = 0; n < 2; ++n) acc[a][b][m][n] = (f32x4){0.f, 0.f, 0.f, 0.f};
        cur = nxt; cA = nA; cB = nB; ++ui;
    }
    PG8_WAIT_V(0);
    if (wr == 0) PG8_BAR;
    PG8_BAR;
    if constexpr (Epi::AFTER_DRAIN) E(acc, cur, wr, wc, fr, fq);
#undef PG8_SA
#undef PG8_SB
#undef PG8_STAGE
#undef PG8_LDA
#undef PG8_LDB
#undef PG8_MMA
#undef PG8_WAIT_V
#undef PG8_WAIT_L
#undef PG8_BAR
#undef PG8_SCHED
}
}

DI void tr_tile(const float* src, int ld_src, int k0, int c0, bf16_t* dst, int ld_dst, int n0, float* lds) {
    const int tid = otid();
#pragma unroll
    for (int pass = 0; pass < 2; ++pass) { const int r = pass * 32 + (tid >> 4), c4 = (tid & 15) * 4;
        const f32x4 v = *(const f32x4*)(src + (size_t)(k0 + r) * ld_src + c0 + c4);
        lds[r * 65 + c4 + 0] = v[0]; lds[r * 65 + c4 + 1] = v[1]; lds[r * 65 + c4 + 2] = v[2]; lds[r * 65 + c4 + 3] = v[3]; }
    __syncthreads();
    const int nn = tid >> 3, kc = (tid & 7) * 8;
    float o[8];
#pragma unroll
    for (int e = 0; e < 8; ++e) o[e] = lds[(kc + e) * 65 + nn];
    *(u32x4*)(dst + (size_t)(n0 + nn) * ld_dst + k0 + kc) = pack8(o);
    __syncthreads();
}

DI void phase_prep(KP pk_in, unsigned char* lds) {
    KP pk = pk_in; asm volatile("" : "+s"(pk));
    unsigned char* ws = pk->ws;
    const int bidx_ = obid(); const size_t gtid = (size_t)bidx_ * 512 + otid(), nthr = (size_t)gridDim.x * 512;
    { bf16_t* xb = (bf16_t*)(ws + W_XB);
      for (size_t v = gtid; v < (size_t)NTOK * 128; v += nthr) { const float* s = v < (size_t)NTOKP * 128 ? pk->x_prompt + v * 8 : pk->x_sample + (v - (size_t)NTOKP * 128) * 8;
          const f32x4 a = *(const f32x4*)s, b = *(const f32x4*)(s + 4); float o[8] = {a[0], a[1], a[2], a[3], b[0], b[1], b[2], b[3]}; *(u32x4*)(xb + v * 8) = pack8(o); } }
    { bf16_t* mb = (bf16_t*)(ws + W_MEMB);
      for (size_t v = gtid; v < (size_t)2048 * 128; v += nthr) { const float* s = pk->mem_prompt + v * 8;
          const f32x4 a = *(const f32x4*)s, b = *(const f32x4*)(s + 4); float o[8] = {a[0], a[1], a[2], a[3], b[0], b[1], b[2], b[3]}; *(u32x4*)(mb + v * 8) = pack8(o); } }
    { bf16_t* wd = (bf16_t*)(ws + W_WDTT); float* wf = (float*)(ws + W_WDTF);
      for (size_t i = gtid; i < 16 * 1024; i += nthr) { const int h = (int)(i >> 10), k = (int)(i & 1023); const float v = pk->w_in[(size_t)k * DIN + 4608 + h]; wd[i] = f2bf(v); wf[i] = v; } }
    { bf16_t* wg = (bf16_t*)(ws + W_WGT);
      for (size_t i = gtid; i < (size_t)8 * 4 * 64 * 128; i += nthr) { const int k = (int)(i >> 15), qd = (int)(i >> 13) & 3, nn = (int)(i >> 7) & 63, ii = (int)(i & 127);
          const float v = nn < 32 ? pk->w_rg_a[((size_t)k * 128 + ii) * 128 + qd * 32 + nn] : pk->w_rg_i[((size_t)k * 128 + ii) * 128 + qd * 32 + nn - 32]; wg[i] = f2bf(v); } }
    float* tl = (float*)lds;
    for (int t = bidx_; t < 1664 + 768 + 512; t += gridDim.x) {
        if (t < 1664) { const int kt = t & 15, ntile = t >> 4; const int n0 = ntile * 64, c0 = n0 < 4608 ? n0 : n0 + 16;
            tr_tile(pk->w_in, DIN, kt * 64, c0, (bf16_t*)(ws + W_WINT), 1024, n0, tl); }
        else if (t < 1664 + 768) { const int u = t - 1664; const int kt = u % 48, ntile = u / 48;
            tr_tile(pk->w_out, 1024, kt * 64, ntile * 64, (bf16_t*)(ws + W_WOUTT), 3072, ntile * 64, tl); }
        else { const int u = t - 1664 - 768; const int kt = u & 15, ntile = u >> 4; const int n0 = ntile * 64;
            if (n0 < 1024) tr_tile(pk->w_mem_k, 1024, kt * 64, n0, (bf16_t*)(ws + W_WKVT), 1024, n0, tl);
            else tr_tile(pk->w_mem_v, 1024, kt * 64, n0 - 1024, (bf16_t*)(ws + W_WKVT), 1024, n0, tl); }
    }
}

DI void conv8_ssd_prompt(KP pk, const bf16_t* proj, int rowbase, int t, int ch, float (&o)[8]) {
    const f32x4 b0 = *(const f32x4*)(pk->ssd_conv_b + ch), b1 = *(const f32x4*)(pk->ssd_conv_b + ch + 4);
    float acc[8] = {b0[0], b0[1], b0[2], b0[3], b1[0], b1[1], b1[2], b1[3]};
    u32x4 vv[4];
#pragma unroll
    for (int kk = 0; kk < 4; ++kk) { const int tt = t - 3 + kk; vv[kk] = *(const u32x4*)(proj + (size_t)(rowbase + (tt < 0 ? 0 : tt)) * NPROJ + C_XBC + ch); }
#pragma unroll
    for (int kk = 0; kk < 4; ++kk) { const int tt = t - 3 + kk; const float msk = tt >= 0 ? 1.f : 0.f; float x[8]; unpack8(vv[kk], x);
            const f32x4 w0 = *(const f32x4*)(pk->ssd_conv_w + kk * 1536 + ch) * msk, w1 = *(const f32x4*)(pk->ssd_conv_w + kk * 1536 + ch + 4) * msk;
            acc[0] += x[0] * w0[0]; acc[1] += x[1] * w0[1]; acc[2] += x[2] * w0[2]; acc[3] += x[3] * w0[3];
            acc[4] += x[4] * w1[0]; acc[5] += x[5] * w1[1]; acc[6] += x[6] * w1[2]; acc[7] += x[7] * w1[3]; }
#pragma unroll
    for (int e = 0; e < 8; ++e) o[e] = siluf(acc[e]);
}

DI void ssd1_item(KP pk_in, unsigned char* lds, int b, int c, int g) {
    KP pk = pk_in; asm volatile("" : "+s"(pk));
    unsigned char* ws = pk->ws;
    const int tid = otid(), w = tid >> 6, lane = tid & 63, l15 = lane & 15, q = lane >> 4;
    float* dt_s = (float*)lds; float* acum_s = dt_s + 2048; float* w_s = acum_s + 2048; float* seg_s = w_s + 1024;
    bf16_t* BT = (bf16_t*)(lds + 22528); bf16_t* xsT = (bf16_t*)(lds + 22528 + 34816);
    const bf16_t* xb = (const bf16_t*)(ws + W_XB); const bf16_t* wdt = (const bf16_t*)(ws + W_WDTT); const bf16_t* proj = (const bf16_t*)(ws + W_PROJ);
    bf16_t* xact = (bf16_t*)(ws + W_XACT); float* dt_g = (float*)(ws + W_DT); float* acum_g = (float*)(ws + W_ACUM); float* cd_g = (float*)(ws + W_CD); bf16_t* st_g = (bf16_t*)(ws + W_ST);
    const int tok0 = b * 2048 + c * 128;
    __syncthreads();
    { f32x4 acc = {0.f, 0.f, 0.f, 0.f}; const bf16_t* ap = xb + (size_t)(tok0 + 16 * w + l15) * 1024 + q * 8; const bf16_t* bp = wdt + l15 * 1024 + q * 8;
#pragma unroll 8
      for (int ks = 0; ks < 32; ++ks) { const bf16x8 a = *(const bf16x8*)(ap + ks * 32); const bf16x8 bb = *(const bf16x8*)(bp + ks * 32); acc = MFMA16(a, bb, acc); }
      const float bias = pk->ssd_dt_bias[l15];
#pragma unroll
      for (int r = 0; r < 4; ++r) { const int i = 16 * w + 4 * q + r; const float dt = softplusf(acc[r] + bias); dt_s[i * 16 + l15] = dt; dt_g[(size_t)(tok0 + i) * 16 + l15] = dt; } }
    __syncthreads();
    { const int hd = tid & 15, sg = tid >> 4; const float ah = -__expf(pk->ssd_a_log[hd]); float loc[8]; float run = 0.f;
      if (tid < 256) {
#pragma unroll
          for (int i = 0; i < 8; ++i) { run += dt_s[(sg * 8 + i) * 16 + hd] * ah; loc[i] = run; }
          seg_s[sg * 16 + hd] = run; }
      __syncthreads();
      if (tid < 256) { float off = 0.f; for (int s2 = 0; s2 < sg; ++s2) off += seg_s[s2 * 16 + hd];
#pragma unroll
          for (int i = 0; i < 8; ++i) { const float v = loc[i] + off; acum_s[(sg * 8 + i) * 16 + hd] = v; acum_g[(size_t)(tok0 + sg * 8 + i) * 16 + hd] = v; } } }
    __syncthreads();
    if (tid < 8) cd_g[(b * 16 + c) * 16 + 8 * g + tid] = __expf(acum_s[127 * 16 + 8 * g + tid]);
    for (int idx = tid; idx < 1024; idx += 512) { const int j = idx >> 3, hl = idx & 7, h = 8 * g + hl; w_s[idx] = dt_s[j * 16 + h] * __expf(acum_s[127 * 16 + h] - acum_s[j * 16 + h]); }
    const int cv = (tid & 31) * 8, jg = tid >> 5;
    for (int pass = 0; pass < 3; ++pass) {
        const int ch = pass == 0 ? (cv < 128 ? 1024 + g * 128 + cv : 1280 + g * 128 + (cv - 128)) : g * 512 + (pass - 1) * 256 + cv;
        float wgt[4][8], bs[8];
        { const f32x4 b0 = *(const f32x4*)(pk->ssd_conv_b + ch), b1 = *(const f32x4*)(pk->ssd_conv_b + ch + 4);
          bs[0] = b0[0]; bs[1] = b0[1]; bs[2] = b0[2]; bs[3] = b0[3]; bs[4] = b1[0]; bs[5] = b1[1]; bs[6] = b1[2]; bs[7] = b1[3];
#pragma unroll
          for (int kk = 0; kk < 4; ++kk) { const f32x4 w0 = *(const f32x4*)(pk->ssd_conv_w + kk * 1536 + ch), w1 = *(const f32x4*)(pk->ssd_conv_w + kk * 1536 + ch + 4);
              wgt[kk][0] = w0[0]; wgt[kk][1] = w0[1]; wgt[kk][2] = w0[2]; wgt[kk][3] = w0[3]; wgt[kk][4] = w1[0]; wgt[kk][5] = w1[1]; wgt[kk][6] = w1[2]; wgt[kk][7] = w1[3]; } }
        const bf16_t* src = proj + (size_t)(b * 2048) * NPROJ + C_XBC + ch; const int t0 = c * 128 + jg * 8;
        u32x4 rows[11];
#pragma unroll
        for (int i = 0; i < 11; ++i) { const int tt = t0 - 3 + i; const u32x4 v = *(const u32x4*)(src + (size_t)(tt < 0 ? 0 : tt) * NPROJ); rows[i] = tt < 0 ? (u32x4){0u, 0u, 0u, 0u} : v; }
        if (pass > 0) __syncthreads();
        unsigned tp[8][4];
#pragma unroll
        for (int i = 0; i < 8; i += 2) { float oa[8], ob[8];
#pragma unroll
            for (int hh = 0; hh < 2; ++hh) { float x0[8], x1[8], x2[8], x3[8]; unpack8(rows[i + hh], x0); unpack8(rows[i + hh + 1], x1); unpack8(rows[i + hh + 2], x2); unpack8(rows[i + hh + 3], x3); float o[8];
#pragma unroll
                for (int e = 0; e < 8; ++e) o[e] = siluf(bs[e] + x0[e] * wgt[0][e] + x1[e] * wgt[1][e] + x2[e] * wgt[2][e] + x3[e] * wgt[3][e]);
                const int j = jg * 8 + i + hh;
                *(u32x4*)(xact + (size_t)(tok0 + j) * 1536 + ch) = pack8(o);
                const float wj = pass == 0 ? 1.f : w_s[j * 8 + (pass - 1) * 4 + (cv >> 6)];
#pragma unroll
                for (int e = 0; e < 8; ++e) { if (hh == 0) oa[e] = o[e] * wj; else ob[e] = o[e] * wj; } }
#pragma unroll
            for (int e = 0; e < 8; ++e) tp[e][i >> 1] = pack2(oa[e], ob[e]); }
        if (pass == 0) { if (cv < 128) {
#pragma unroll
            for (int e = 0; e < 8; ++e) { const int rr = cv + e; u32x4 wv; wv.x = tp[e][0]; wv.y = tp[e][1]; wv.z = tp[e][2]; wv.w = tp[e][3]; *(u32x4*)(BT + rr * 136 + ((jg * 8) ^ (((rr >> 3) & 15) << 3))) = wv; } } }
        else {
#pragma unroll
            for (int e = 0; e < 8; ++e) { const int rr = cv + e; u32x4 wv; wv.x = tp[e][0]; wv.y = tp[e][1]; wv.z = tp[e][2]; wv.w = tp[e][3]; *(u32x4*)(xsT + rr * 136 + ((jg * 8) ^ (((rr >> 3) & 15) << 3))) = wv; } }
        if (pass == 0) continue;
        __syncthreads();
        const int pt = w & 3, nh = w >> 2;
#pragma unroll 1
        for (int hq = 0; hq < 4; ++hq) { const int hl = (pass - 1) * 4 + hq;
            f32x4 acc[4];
#pragma unroll
            for (int nt = 0; nt < 4; ++nt) acc[nt] = (f32x4){0.f, 0.f, 0.f, 0.f};
#pragma unroll
            for (int ks = 0; ks < 4; ++ks) { const int ra = hq * 64 + pt * 16 + l15; const bf16x8 a = *(const bf16x8*)(xsT + ra * 136 + ((ks * 32 + q * 8) ^ (((ra >> 3) & 15) << 3)));
#pragma unroll
                for (int nt = 0; nt < 4; ++nt) { const int rb = nh * 64 + nt * 16 + l15; const bf16x8 bb = *(const bf16x8*)(BT + rb * 136 + ((ks * 32 + q * 8) ^ (((rb >> 3) & 15) << 3))); acc[nt] = MFMA16(a, bb, acc[nt]); } }
            bf16_t* sp = st_g + (size_t)(((b * 16 + c) * 16 + 8 * g + hl)) * 8192;
#pragma unroll
            for (int nt = 0; nt < 4; ++nt)
#pragma unroll
                for (int r = 0; r < 4; ++r) sp[(pt * 16 + 4 * q + r) * 128 + nh * 64 + nt * 16 + l15] = f2bf(acc[nt][r]); }
    }
    if (c == 15) {
        for (int idx = tid; idx < 3 * 768; idx += 512) { const int jj = idx / 768, cc = idx % 768; const int ch = cc < 512 ? g * 512 + cc : (cc < 640 ? 1024 + g * 128 + (cc - 512) : 1280 + g * 128 + (cc - 640));
            pk->out[O_SCP + (size_t)(b * 3 + jj) * 1536 + ch] = bf2f(proj[(size_t)(b * 2048 + 2045 + jj) * NPROJ + C_XBC + ch]); }
    }
}

DI void rgconv_item(KP pk_in, int b, int tile) {
    KP pk = pk_in; asm volatile("" : "+s"(pk));
    const int tid = otid();
    const bf16_t* proj = (const bf16_t*)(pk->ws + W_PROJ); bf16_t* mix = (bf16_t*)(pk->ws + W_MIX);
    const int ch = (tid & 127) * 8, t0 = tile * 128 + (tid >> 7) * 32;
    float wgt[4][8], bs[8];
    { const f32x4 b0 = *(const f32x4*)(pk->rg_conv_b + ch), b1 = *(const f32x4*)(pk->rg_conv_b + ch + 4);
      bs[0] = b0[0]; bs[1] = b0[1]; bs[2] = b0[2]; bs[3] = b0[3]; bs[4] = b1[0]; bs[5] = b1[1]; bs[6] = b1[2]; bs[7] = b1[3];
#pragma unroll
      for (int kk = 0; kk < 4; ++kk) { const f32x4 w0 = *(const f32x4*)(pk->rg_conv_w + kk * 1024 + ch), w1 = *(const f32x4*)(pk->rg_conv_w + kk * 1024 + ch + 4);
          wgt[kk][0] = w0[0]; wgt[kk][1] = w0[1]; wgt[kk][2] = w0[2]; wgt[kk][3] = w0[3]; wgt[kk][4] = w1[0]; wgt[kk][5] = w1[1]; wgt[kk][6] = w1[2]; wgt[kk][7] = w1[3]; } }
    const bf16_t* src = proj + (size_t)(b * 2048) * NPROJ + C_RGX + ch;
    u32x4 hist[3];
#pragma unroll
    for (int i = 0; i < 3; ++i) { const int tt = t0 - 3 + i; const u32x4 v = *(const u32x4*)(src + (size_t)(tt < 0 ? 0 : tt) * NPROJ); hist[i] = tt < 0 ? (u32x4){0u, 0u, 0u, 0u} : v; }
    for (int c8 = 0; c8 < 32; c8 += 8) { u32x4 nv[8];
#pragma unroll
        for (int i = 0; i < 8; ++i) nv[i] = *(const u32x4*)(src + (size_t)(t0 + c8 + i) * NPROJ);
#pragma unroll
        for (int i = 0; i < 8; ++i) { float x0[8], x1[8], x2[8], x3[8]; unpack8(hist[0], x0); unpack8(hist[1], x1); unpack8(hist[2], x2); unpack8(nv[i], x3); float acc[8];
#pragma unroll
            for (int e = 0; e < 8; ++e) acc[e] = bs[e] + x0[e] * wgt[0][e] + x1[e] * wgt[1][e] + x2[e] * wgt[2][e] + x3[e] * wgt[3][e];
            *(u32x4*)(mix + (size_t)(b * 2048 + t0 + c8 + i) * DMIX + 1024 + ch) = pack8(acc);
            hist[0] = hist[1]; hist[1] = hist[2]; hist[2] = nv[i]; } }
}

DI void statepass_item(KP pk_in, int sp) {
    KP pk = pk_in; asm volatile("" : "+s"(pk));
    const int b = sp >> 5, h = (sp >> 1) & 15, half = sp & 1; const int e0 = half * 4096 + otid() * 8;
    bf16_t* st_g = (bf16_t*)(pk->ws + W_ST); const float* cd_g = (const float*)(pk->ws + W_CD);
    float run[8] = {0.f, 0.f, 0.f, 0.f, 0.f, 0.f, 0.f, 0.f};
    u32x4 v[16]; float cd[16];
#pragma unroll
    for (int i = 0; i < 16; ++i) { v[i] = *(const u32x4*)(st_g + (size_t)((b * 16 + i) * 16 + h) * 8192 + e0); cd[i] = cd_g[(b * 16 + i) * 16 + h]; }
#pragma unroll
    for (int i = 0; i < 16; ++i) { *(u32x4*)(st_g + (size_t)((b * 16 + i) * 16 + h) * 8192 + e0) = pack8(run); float x[8]; unpack8(v[i], x);
#pragma unroll
        for (int e = 0; e < 8; ++e) run[e] = run[e] * cd[i] + x[e]; }
    float* o = pk->out + O_SHP + (size_t)(b * 16 + h) * 8192 + e0; *(f32x4*)o = (f32x4){run[0], run[1], run[2], run[3]}; *(f32x4*)(o + 4) = (f32x4){run[4], run[5], run[6], run[7]};
}

DI void rg_item(KP pk_in, unsigned char* lds, const bool sample, int bidx, int k, int qd) {
    KP pk = pk_in; asm volatile("" : "+s"(pk));
    unsigned char* ws = pk->ws;
    const int tid = otid(), w = tid >> 6, lane = tid & 63, l15 = lane & 15, q = lane >> 4;
    bf16_t* uA = (bf16_t*)lds;
    float* wagg = (float*)(lds + 34816);
    float* hcar = wagg + 1024;
    bf16_t* wS = (bf16_t*)(lds + 73728);
    const bf16_t* proj = (const bf16_t*)(ws + W_PROJ); bf16_t* mix = (bf16_t*)(ws + W_MIX);
    const bf16_t* wg = (const bf16_t*)(ws + W_WGT) + (size_t)((k * 4 + qd) * 64) * 128;
    __syncthreads();
    for (int idx = tid; idx < 1024; idx += 512) { const int n = idx >> 4, c8 = (idx & 15) * 8; *(u32x4*)(wS + n * 136 + c8) = *(const u32x4*)(wg + n * 128 + c8); }
    if (tid < 64) hcar[tid] = 0.f;
    float ba[2], bi[2], spl[2];
#pragma unroll
    for (int ntl = 0; ntl < 2; ++ntl) { const int ch = k * 128 + qd * 32 + ntl * 16 + l15; ba[ntl] = pk->b_rg_a[ch]; bi[ntl] = pk->b_rg_i[ch]; spl[ntl] = softplusf(-pk->rg_lambda[ch]); }
    const int ntiles = sample ? 1 : 16;
    const int crow = tid >> 2, cg0 = (tid & 3) * 32;
    const bf16_t* ug = mix + 1024;
    u32x4 av[4]; bf16_t uv[8];
#define RG_LOADP(TILE) do { const size_t r0 = (size_t)(bidx * 2048 + (TILE) * 128 + 16 * w); \
        _Pragma("unroll") for (int ks = 0; ks < 4; ++ks) av[ks] = *(const u32x4*)(ug + (r0 + l15) * DMIX + k * 128 + ks * 32 + q * 8); \
        _Pragma("unroll") for (int ntl = 0; ntl < 2; ++ntl) _Pragma("unroll") for (int r = 0; r < 4; ++r) uv[ntl * 4 + r] = ug[(r0 + 4 * q + r) * DMIX + k * 128 + qd * 32 + ntl * 16 + l15]; } while (0)
    if (!sample) RG_LOADP(0);
    bf16x8 afr[4]; float uvf[8];
    for (int tile = 0; tile < ntiles; ++tile) {
        const int par = tile & 1;
        bf16_t gtr[8];
        const size_t rowb = sample ? (size_t)(NTOKP + bidx * 128 + 16 * w + 4 * q) : (size_t)(bidx * 2048 + tile * 128 + 16 * w + 4 * q);
        if (!sample) {
#pragma unroll
          for (int ks = 0; ks < 4; ++ks) afr[ks] = as_frag(av[ks]);
#pragma unroll
          for (int e = 0; e < 8; ++e) uvf[e] = bf2f(uv[e]);
          if (tile + 1 < 16) RG_LOADP(tile + 1);
        } else { const int row = crow;
          __syncthreads();
#pragma unroll
          for (int v = 0; v < 4; ++v) { const int c8 = cg0 + v * 8, ch = k * 128 + c8;
              const f32x4 b0 = *(const f32x4*)(pk->rg_conv_b + ch), b1 = *(const f32x4*)(pk->rg_conv_b + ch + 4);
              float acc[8] = {b0[0], b0[1], b0[2], b0[3], b1[0], b1[1], b1[2], b1[3]};
#pragma unroll
              for (int kk = 0; kk < 4; ++kk) { float x[8];
                  { const int sbi = bidx * 32 + (row >> 2), ui = (row & 3) + kk; const bool st = ui < 3;
                      const float* sp_ = pk->state_rg_conv + (size_t)(sbi * 3 + (st ? ui : 2)) * 1024 + ch; const f32x4 s0 = *(const f32x4*)sp_, s1 = *(const f32x4*)(sp_ + 4);
                      const u32x4 vv = *(const u32x4*)(proj + (size_t)(NTOKP + sbi * 4 + (st ? 0 : ui - 3)) * NPROJ + C_RGX + ch); unpack8(vv, x);
                      x[0] = st ? s0[0] : x[0]; x[1] = st ? s0[1] : x[1]; x[2] = st ? s0[2] : x[2]; x[3] = st ? s0[3] : x[3];
                      x[4] = st ? s1[0] : x[4]; x[5] = st ? s1[1] : x[5]; x[6] = st ? s1[2] : x[6]; x[7] = st ? s1[3] : x[7]; }
                  { const f32x4 w0 = *(const f32x4*)(pk->rg_conv_w + kk * 1024 + ch), w1 = *(const f32x4*)(pk->rg_conv_w + kk * 1024 + ch + 4);
                      acc[0] += x[0] * w0[0]; acc[1] += x[1] * w0[1]; acc[2] += x[2] * w0[2]; acc[3] += x[3] * w0[3];
                      acc[4] += x[4] * w1[0]; acc[5] += x[5] * w1[1]; acc[6] += x[6] * w1[2]; acc[7] += x[7] * w1[3]; } }
              *(u32x4*)(uA + row * 136 + c8) = pack8(acc); }
        }
#pragma unroll
        for (int ntl = 0; ntl < 2; ++ntl)
#pragma unroll
            for (int r = 0; r < 4; ++r) gtr[ntl * 4 + r] = proj[(rowb + r) * NPROJ + C_RGG + k * 128 + qd * 32 + ntl * 16 + l15];
        __syncthreads();
        f32x4 acc[4];
#pragma unroll
        for (int nt = 0; nt < 4; ++nt) acc[nt] = (f32x4){0.f, 0.f, 0.f, 0.f};
#pragma unroll
        for (int ks = 0; ks < 4; ++ks) { const bf16x8 a = sample ? *(const bf16x8*)(uA + (16 * w + l15) * 136 + ks * 32 + q * 8) : afr[ks];
#pragma unroll
            for (int nt = 0; nt < 4; ++nt) { const bf16x8 bb = *(const bf16x8*)(wS + (nt * 16 + l15) * 136 + ks * 32 + q * 8); acc[nt] = MFMA16(a, bb, acc[nt]); } }
        float Ap[2][4], Bp[2][4];
#pragma unroll
        for (int ntl = 0; ntl < 2; ++ntl) { float A = 1.f, B = 0.f;
#pragma unroll
            for (int r = 0; r < 4; ++r) { const int row = 16 * w + 4 * q + r, cl = ntl * 16 + l15;
                const float rr = sigmf(acc[ntl][r] + ba[ntl]), ii = sigmf(acc[2 + ntl][r] + bi[ntl]);
                const float la = -8.f * rr * spl[ntl]; float a = __expf(la); const float uval = sample ? bf2f(uA[row * 136 + qd * 32 + cl]) : uvf[ntl * 4 + r];
                float bt = __builtin_amdgcn_sqrtf(fmaxf(1.f - a * a, 0.f)) * ii * uval;
                const bool first = sample ? (r == 0) : (tile == 0 && row == 0);
                if (first) { const float h0 = sample ? pk->state_rg_h[(size_t)(bidx * 32 + (row >> 2)) * 1024 + k * 128 + qd * 32 + cl] : 0.f; bt += a * h0; a = 0.f; }
                B = a * B + bt; A = a * A; Ap[ntl][r] = A; Bp[ntl][r] = B; } }
        float hq[2], Aex[2], Bex[2];
#pragma unroll
        for (int ntl = 0; ntl < 2; ++ntl) { float A = Ap[ntl][3], B = Bp[ntl][3];
            { const float Ao = shl(A, lane - 16), Bo = shl(B, lane - 16); if (q >= 1) { B = A * Bo + B; A = A * Ao; } }
            { const float Ao = shl(A, lane - 32), Bo = shl(B, lane - 32); if (q >= 2) { B = A * Bo + B; A = A * Ao; } }
            if (q == 3) { wagg[((par * 2 + 0) * 8 + w) * 32 + ntl * 16 + l15] = A; wagg[((par * 2 + 1) * 8 + w) * 32 + ntl * 16 + l15] = B; }
            float Ae = shl(A, lane - 16), Be = shl(B, lane - 16); if (q == 0) { Ae = 1.f; Be = 0.f; }
            Aex[ntl] = Ae; Bex[ntl] = Be; }
        __syncthreads();
#pragma unroll
        for (int ntl = 0; ntl < 2; ++ntl) { const int cl = ntl * 16 + l15; float hin = hcar[par * 32 + cl];
            for (int ww = 0; ww < w; ++ww) hin = wagg[((par * 2 + 0) * 8 + ww) * 32 + cl] * hin + wagg[((par * 2 + 1) * 8 + ww) * 32 + cl];
            hq[ntl] = Aex[ntl] * hin + Bex[ntl];
            if (w == 7 && q == 3) hcar[(par ^ 1) * 32 + cl] = Ap[ntl][3] * hq[ntl] + Bp[ntl][3]; }
#pragma unroll
        for (int ntl = 0; ntl < 2; ++ntl)
#pragma unroll
            for (int r = 0; r < 4; ++r) { const float h = Ap[ntl][r] * hq[ntl] + Bp[ntl][r]; const int chg = k * 128 + qd * 32 + ntl * 16 + l15;
                mix[(rowb + r) * DMIX + chg] = f2bf(h * siluf(bf2f(gtr[ntl * 4 + r])));
                if (sample) { if (r == 3) pk->out[O_RGHS + (size_t)(bidx * 32 + 4 * w + q) * 1024 + chg] = h; }
                else if (tile == 15 && w == 7 && q == 3 && r == 3) pk->out[O_RGHP + (size_t)bidx * 1024 + chg] = h; }
    }
#undef RG_LOADP
    if (!sample) { if (tid < 96) { const int jj = tid >> 5, cl = tid & 31, chg = k * 128 + qd * 32 + cl;
            pk->out[O_RGCP + (size_t)(bidx * 3 + jj) * 1024 + chg] = bf2f(proj[(size_t)(bidx * 2048 + 2045 + jj) * NPROJ + C_RGX + chg]); } }
    else { for (int idx = tid; idx < 32 * 3 * 32; idx += 512) { const int cl = idx & 31, jj = (idx >> 5) % 3, sl = idx / 96; const int sbi = bidx * 32 + sl, chg = k * 128 + qd * 32 + cl;
            pk->out[O_RGCS + (size_t)(sbi * 3 + jj) * 1024 + chg] = bf2f(proj[(size_t)(NTOKP + sbi * 4 + 1 + jj) * NPROJ + C_RGX + chg]); } }
}

DI void attnp_item(KP pk_in, unsigned char* lds, int b, int head, int qt) {
    KP pk = pk_in; asm volatile("" : "+s"(pk));
    unsigned char* ws = pk->ws;
    const int tid = otid(), w = tid >> 6, lane = tid & 63, l15 = lane & 15, q = lane >> 4;
    const bf16_t* proj = (const bf16_t*)(ws + W_PROJ); const bf16_t* kb = (const bf16_t*)(ws + W_KB); const bf16_t* vt = (const bf16_t*)(ws + W_VT); bf16_t* mix = (bf16_t*)(ws + W_MIX);
    const int tokb = b * 2048 + qt * 128 + 16 * w;
    constexpr int RS = 264;
    bf16_t* sm = (bf16_t*)lds;
    const int lr = tid >> 5, lc = (tid & 31) * 8;
    const bf16_t* kbase = kb + (size_t)(b * 256) * 1024 + head * 256; const bf16_t* vbase = vt + (size_t)((b * 4 + head) * 256) * 256;
    u32x4 pre[8];
#define AT_LOAD(S) do { _Pragma("unroll") for (int i = 0; i < 8; ++i) { const int r = lr + 16 * i; \
        pre[i] = (S) < 2 ? *(const u32x4*)(kbase + (size_t)(128 * (S) + r) * 1024 + lc) : *(const u32x4*)(vbase + (size_t)(128 * ((S) - 2) + r) * 256 + lc); } } while (0)
#define AT_STORE() do { _Pragma("unroll") for (int i = 0; i < 8; ++i) *(u32x4*)(sm + (lr + 16 * i) * RS + lc) = pre[i]; } while (0)
    AT_LOAD(0);
    bf16x8 qf[8];
#pragma unroll
    for (int ks = 0; ks < 8; ++ks) qf[ks] = *(const bf16x8*)(proj + (size_t)(tokb + l15) * NPROJ + C_Q + head * 256 + ks * 32 + q * 8);
    f32x4 st[16];
#pragma unroll
    for (int s = 0; s < 2; ++s) {
        __syncthreads(); AT_STORE(); __syncthreads(); AT_LOAD(s + 1);
#pragma unroll
        for (int mtl = 0; mtl < 8; ++mtl) { const int mt = 8 * s + mtl; st[mt] = (f32x4){0.f, 0.f, 0.f, 0.f}; const bf16_t* kp = sm + (16 * mtl + l15) * RS + q * 8;
#pragma unroll
            for (int ks = 0; ks < 8; ++ks) { const bf16x8 kf = *(const bf16x8*)(kp + ks * 32); st[mt] = MFMA16(kf, qf[ks], st[mt]); } }
    }
    float mx = -3.0e38f;
#pragma unroll
    for (int mt = 0; mt < 16; ++mt)
#pragma unroll
        for (int r = 0; r < 4; ++r) { st[mt][r] *= 0.0625f; mx = fmaxf(mx, st[mt][r]); }
    mx = fmaxf(mx, shx(mx, 16, lane)); mx = fmaxf(mx, shx(mx, 32, lane));
    float l = 0.f;
#pragma unroll
    for (int mt = 0; mt < 16; ++mt)
#pragma unroll
        for (int r = 0; r < 4; ++r) { const float e = __expf(st[mt][r] - mx); st[mt][r] = e; l += e; }
    l += shx(l, 16, lane); l += shx(l, 32, lane);
    bf16x8 pf[8];
#pragma unroll
    for (int s = 0; s < 8; ++s) { float m8[8] = {st[2 * s][0], st[2 * s][1], st[2 * s][2], st[2 * s][3], st[2 * s + 1][0], st[2 * s + 1][1], st[2 * s + 1][2], st[2 * s + 1][3]}; pf[s] = as_frag(pack8(m8)); }
    float linv[4];
#pragma unroll
    for (int r = 0; r < 4; ++r) linv[r] = 1.f / shl(l, 4 * q + r);
#pragma unroll
    for (int s2 = 0; s2 < 2; ++s2) {
        __syncthreads(); AT_STORE(); __syncthreads(); if (s2 == 0) AT_LOAD(3);
#pragma unroll
        for (int dtl = 0; dtl < 8; ++dtl) { const int dt = 8 * s2 + dtl; f32x4 o = {0.f, 0.f, 0.f, 0.f}; const bf16_t* vp = sm + (16 * dtl + l15) * RS + 4 * q;
            float gt[4];
#pragma unroll
            for (int r = 0; r < 4; ++r) gt[r] = bf2f(proj[(size_t)(tokb + 4 * q + r) * NPROJ + C_XG + head * 256 + 16 * dt + l15]);
#pragma unroll
            for (int s = 0; s < 8; ++s) { const u32x2 lo = *(const u32x2*)(vp + 32 * s), hi = *(const u32x2*)(vp + 32 * s + 16); o = MFMA16(pf[s], frag2(lo, hi), o); }
#pragma unroll
            for (int r = 0; r < 4; ++r) { const size_t tok = (size_t)(tokb + 4 * q + r); const int d = 16 * dt + l15;
                mix[tok * DMIX + 2048 + head * 256 + d] = f2bf(o[r] * linv[r] * siluf(gt[r])); } }
    }
#undef AT_LOAD
#undef AT_STORE
}

DI float wave_sum(float v, int lane) { v += shx(v, 32, lane); v += shx(v, 16, lane); v += shx(v, 8, lane); v += shx(v, 4, lane); v += shx(v, 2, lane); v += shx(v, 1, lane); return v; }
DI float wave_max(float v, int lane) { v = fmaxf(v, shx(v, 32, lane)); v = fmaxf(v, shx(v, 16, lane)); v = fmaxf(v, shx(v, 8, lane)); v = fmaxf(v, shx(v, 4, lane)); v = fmaxf(v, shx(v, 2, lane)); v = fmaxf(v, shx(v, 1, lane)); return v; }

DI void attns_item(KP pk_in, unsigned char* lds, int sbi, int head) {
    KP pk = pk_in; asm volatile("" : "+s"(pk));
    unsigned char* ws = pk->ws;
    const int tid = otid(), w = tid >> 6, lane = tid & 63;
    const bf16_t* proj = (const bf16_t*)(ws + W_PROJ); bf16_t* mix = (bf16_t*)(ws + W_MIX);
    float* qs = (float*)lds; float* sc = qs + 1024; float* ored = sc + 1024;
    __syncthreads();
    for (int idx = tid; idx < 1024; idx += 512) { const int t = idx >> 8, d = idx & 255; qs[idx] = bf2f(proj[(size_t)(NTOKP + sbi * 4 + t) * NPROJ + C_Q + head * 256 + d]); }
    __syncthreads();
    f32x4 qv[4];
#pragma unroll
    for (int t = 0; t < 4; ++t) qv[t] = *(const f32x4*)(qs + t * 256 + lane * 4);
    for (int m0 = w; m0 < 256; m0 += 64) { f32x4 kv[8];
#pragma unroll
        for (int i = 0; i < 8; ++i) kv[i] = *(const f32x4*)(pk->cache_k + ((size_t)(sbi * 256 + m0 + 8 * i) * 4 + head) * 256 + lane * 4);
        float v32[32];
#pragma unroll
        for (int i = 0; i < 8; ++i)
#pragma unroll
            for (int t = 0; t < 4; ++t) v32[i * 4 + t] = kv[i][0] * qv[t][0] + kv[i][1] * qv[t][1] + kv[i][2] * qv[t][2] + kv[i][3] * qv[t][3];
        float v16[16], v8[8], v4[4], v2[2];
        { const bool up = (lane & 32) != 0;
#pragma unroll
          for (int i = 0; i < 16; ++i) { const float keep = up ? v32[i + 16] : v32[i], send = up ? v32[i] : v32[i + 16]; v16[i] = keep + shx(send, 32, lane); } }
        { const bool up = (lane & 16) != 0;
#pragma unroll
          for (int i = 0; i < 8; ++i) { const float keep = up ? v16[i + 8] : v16[i], send = up ? v16[i] : v16[i + 8]; v8[i] = keep + shx(send, 16, lane); } }
        { const bool up = (lane & 8) != 0;
#pragma unroll
          for (int i = 0; i < 4; ++i) { const float keep = up ? v8[i + 4] : v8[i], send = up ? v8[i] : v8[i + 4]; v4[i] = keep + shx(send, 8, lane); } }
        { const bool up = (lane & 4) != 0;
#pragma unroll
          for (int i = 0; i < 2; ++i) { const float keep = up ? v4[i + 2] : v4[i], send = up ? v4[i] : v4[i + 2]; v2[i] = keep + shx(send, 4, lane); } }
        float v1; { const bool up = (lane & 2) != 0; const float keep = up ? v2[1] : v2[0], send = up ? v2[0] : v2[1]; v1 = keep + shx(send, 2, lane); }
        v1 += shx(v1, 1, lane);
        if ((lane & 1) == 0) { const int ii = lane >> 1; sc[(ii & 3) * 256 + m0 + 8 * (ii >> 2)] = v1 * 0.0625f; } }
    __syncthreads();
    if (w < 4) { const f32x4 v = *(const f32x4*)(sc + w * 256 + lane * 4); float mx = fmaxf(fmaxf(v[0], v[1]), fmaxf(v[2], v[3])); mx = wave_max(mx, lane);
        f32x4 e; e[0] = __expf(v[0] - mx); e[1] = __expf(v[1] - mx); e[2] = __expf(v[2] - mx); e[3] = __expf(v[3] - mx); float s = wave_sum(e[0] + e[1] + e[2] + e[3], lane); const float inv = 1.f / s;
        *(f32x4*)(sc + w * 256 + lane * 4) = e * inv; }
    __syncthreads();
    f32x4 acc[4];
#pragma unroll
    for (int t = 0; t < 4; ++t) acc[t] = (f32x4){0.f, 0.f, 0.f, 0.f};
    for (int m0 = w; m0 < 256; m0 += 64) { f32x4 vv[8];
#pragma unroll
        for (int i = 0; i < 8; ++i) vv[i] = *(const f32x4*)(pk->cache_v + ((size_t)(sbi * 256 + m0 + 8 * i) * 4 + head) * 256 + lane * 4);
#pragma unroll
        for (int i = 0; i < 8; ++i)
#pragma unroll
            for (int t = 0; t < 4; ++t) acc[t] += vv[i] * sc[t * 256 + m0 + 8 * i]; }
#pragma unroll
    for (int t = 0; t < 4; ++t) *(f32x4*)(ored + (w * 4 + t) * 256 + lane * 4) = acc[t];
    __syncthreads();
    for (int idx = tid; idx < 1024; idx += 512) { const int t = idx >> 8, d = idx & 255; float s = 0.f;
#pragma unroll
        for (int ww = 0; ww < 8; ++ww) s += ored[(ww * 4 + t) * 256 + d];
        const size_t tok = (size_t)(NTOKP + sbi * 4 + t); const float gate = bf2f(proj[tok * NPROJ + C_XG + head * 256 + d]); mix[tok * DMIX + 2048 + head * 256 + d] = f2bf(s * siluf(gate)); }
}

DI void ssds_item(KP pk_in, unsigned char* lds, int sbi, int g) {
    KP pk = pk_in; asm volatile("" : "+s"(pk));
    unsigned char* ws = pk->ws;
    const int tid = otid(), w = tid >> 6, lane = tid & 63;
    const bf16_t* proj = (const bf16_t*)(ws + W_PROJ); bf16_t* mix = (bf16_t*)(ws + W_MIX); const float* wdf = (const float*)(ws + W_WDTF);
    float* xs = (float*)lds; float* Bs = xs + 2048; float* Cs = Bs + 512; float* yg = Cs + 512; float* dts = yg + 2048; float* decs = dts + 32;
    __syncthreads();
#pragma unroll
    for (int d = 0; d < 4; ++d) { const int pi = w * 4 + d, t = pi & 3, hl = pi >> 2, h = 8 * g + hl; float s = 0.f;
#pragma unroll
        for (int i = 0; i < 4; ++i) { const f32x4 xv = *(const f32x4*)(pk->x_sample + (size_t)(sbi * 4 + t) * 1024 + i * 256 + lane * 4), wv = *(const f32x4*)(wdf + h * 1024 + i * 256 + lane * 4);
            s += xv[0] * wv[0] + xv[1] * wv[1] + xv[2] * wv[2] + xv[3] * wv[3]; }
        s = wave_sum(s, lane);
        if (lane == 0) { const float dt = softplusf(s + pk->ssd_dt_bias[h]); dts[t * 8 + hl] = dt; decs[t * 8 + hl] = __expf(-dt * __expf(pk->ssd_a_log[h])); } }
    for (int idx = tid; idx < 4 * 768; idx += 512) { const int t = idx / 768, cc = idx % 768; const int ch = cc < 512 ? g * 512 + cc : (cc < 640 ? 1024 + g * 128 + (cc - 512) : 1280 + g * 128 + (cc - 640));
        float acc = pk->ssd_conv_b[ch];
#pragma unroll
        for (int kk = 0; kk < 4; ++kk) { const int ui = t + kk; const bool st = ui < 3;
            const float xs_ = pk->state_ssd_conv[(size_t)(sbi * 3 + (st ? ui : 2)) * 1536 + ch]; const float xp_ = bf2f(proj[(size_t)(NTOKP + sbi * 4 + (st ? 0 : ui - 3)) * NPROJ + C_XBC + ch]);
            acc += (st ? xs_ : xp_) * pk->ssd_conv_w[kk * 1536 + ch]; }
        const float a = siluf(acc);
        if (cc < 512) xs[t * 512 + cc] = a; else if (cc < 640) Bs[t * 128 + cc - 512] = a; else Cs[t * 128 + cc - 640] = a; }
    for (int idx = tid; idx < 3 * 768; idx += 512) { const int jj = idx / 768, cc = idx % 768; const int ch = cc < 512 ? g * 512 + cc : (cc < 640 ? 1024 + g * 128 + (cc - 512) : 1280 + g * 128 + (cc - 640));
        pk->out[O_SCS + (size_t)(sbi * 3 + jj) * 1536 + ch] = bf2f(proj[(size_t)(NTOKP + sbi * 4 + 1 + jj) * NPROJ + C_XBC + ch]); }
    __syncthreads();
    const int pp = tid >> 3, n0 = (tid & 7) * 16;
    f32x4 bvr[4][4], cvr[4][4];
#pragma unroll
    for (int t = 0; t < 4; ++t)
#pragma unroll
        for (int v = 0; v < 4; ++v) { bvr[t][v] = *(const f32x4*)(Bs + t * 128 + n0 + v * 4); cvr[t][v] = *(const f32x4*)(Cs + t * 128 + n0 + v * 4); }
    f32x4 hs[4], hn[4];
#pragma unroll
    for (int v = 0; v < 4; ++v) hn[v] = *(const f32x4*)(pk->state_ssd_h + ((size_t)(sbi * 16 + 8 * g) * 64 + pp) * 128 + n0 + v * 4);
    for (int hl = 0; hl < 8; ++hl) { const int h = 8 * g + hl; const size_t so = ((size_t)(sbi * 16 + h) * 64 + pp) * 128 + n0;
#pragma unroll
        for (int v = 0; v < 4; ++v) hs[v] = hn[v];
        if (hl < 7) {
#pragma unroll
            for (int v = 0; v < 4; ++v) hn[v] = *(const f32x4*)(pk->state_ssd_h + so + 8192 + v * 4); }
        const float dsk = pk->ssd_d[h];
#pragma unroll
        for (int t = 0; t < 4; ++t) { const float dec = decs[t * 8 + hl], xv = xs[t * 512 + hl * 64 + pp], dtx = dts[t * 8 + hl] * xv; float part = 0.f;
#pragma unroll
            for (int v = 0; v < 4; ++v) { const f32x4 bv = bvr[t][v], cv = cvr[t][v];
                hs[v] = hs[v] * dec + bv * dtx; part += cv[0] * hs[v][0] + cv[1] * hs[v][1] + cv[2] * hs[v][2] + cv[3] * hs[v][3]; }
            part += shx(part, 1, lane); part += shx(part, 2, lane); part += shx(part, 4, lane);
            if ((tid & 7) == 0) { const float y = part + dsk * xv; const float z = bf2f(proj[(size_t)(NTOKP + sbi * 4 + t) * NPROJ + C_Z + h * 64 + pp]); yg[t * 512 + hl * 64 + pp] = y * siluf(z); } }
#pragma unroll
        for (int v = 0; v < 4; ++v) *(f32x4*)(pk->out + O_SHS + so + v * 4) = hs[v];
    }
    __syncthreads();
    if (w < 4) { const int t = w; float ss = 0.f; float v[8];
#pragma unroll
        for (int e = 0; e < 8; ++e) { v[e] = yg[t * 512 + e * 64 + lane]; ss += v[e] * v[e]; }
        ss = wave_sum(ss, lane); const float rstd = rsqrtf(ss * (1.f / 512.f) + 1e-5f);
#pragma unroll
        for (int e = 0; e < 8; ++e) { const int cc = e * 64 + lane; mix[(size_t)(NTOKP + sbi * 4 + t) * DMIX + 1024 + g * 512 + cc] = f2bf(v[e] * rstd * pk->ssd_norm_g[g * 512 + cc]); } }
}

DI void ssd3_item(KP pk_in, unsigned char* lds, int b, int c, int g) {
    KP pk = pk_in; asm volatile("" : "+s"(pk));
    unsigned char* ws = pk->ws;
    const int tid = otid(), w = tid >> 6, lane = tid & 63, l15 = lane & 15, q = lane >> 4;
    float* acum_s = (float*)lds; float* cf_s = acum_s + 1024; float* dt_s = cf_s + 1024; float* rstd_s = dt_s + 1024;
    bf16_t* xT = (bf16_t*)(lds + 12800);
    bf16_t* hS = (bf16_t*)(lds + 30208);
    const bf16_t* proj = (const bf16_t*)(ws + W_PROJ); const bf16_t* xact = (const bf16_t*)(ws + W_XACT); bf16_t* mix = (bf16_t*)(ws + W_MIX);
    const float* dt_g = (const float*)(ws + W_DT); const float* acum_g = (const float*)(ws + W_ACUM); const bf16_t* st_g = (const bf16_t*)(ws + W_ST);
    const int tok0 = b * 2048 + c * 128;
    __syncthreads();
    for (int idx = tid; idx < 1024; idx += 512) { const int j = idx >> 3, hl = idx & 7; acum_s[idx] = acum_g[(size_t)(tok0 + j) * 16 + 8 * g + hl]; }
    const int xpb = tid & 7, xjg = (tid >> 3) & 15;
    const int hp_ = tid >> 3, hn0 = (tid & 7) * 16;
    u32x4 xr[8]; u32x4 hr[2]; bf16_t zr[16];
#define S3_LOAD(HL) do { const int h_ = 8 * g + (HL); \
        if (tid < 128) { _Pragma("unroll") for (int i = 0; i < 8; ++i) xr[i] = *(const u32x4*)(xact + (size_t)(tok0 + xjg * 8 + i) * 1536 + g * 512 + (HL) * 64 + xpb * 8); } \
        { const bf16_t* hp0 = st_g + ((size_t)((b * 16 + c) * 16 + h_) * 64 + hp_) * 128 + hn0; hr[0] = *(const u32x4*)hp0; hr[1] = *(const u32x4*)(hp0 + 8); } \
        _Pragma("unroll") for (int pt = 0; pt < 4; ++pt) _Pragma("unroll") for (int r = 0; r < 4; ++r) zr[pt * 4 + r] = proj[(size_t)(tok0 + 16 * w + 4 * q + r) * NPROJ + C_Z + h_ * 64 + 16 * pt + l15]; } while (0)
    S3_LOAD(0);
    bf16x8 cf[4];
#pragma unroll
    for (int ks = 0; ks < 4; ++ks) cf[ks] = *(const bf16x8*)(xact + (size_t)(tok0 + 16 * w + l15) * 1536 + 1280 + g * 128 + ks * 32 + q * 8);
    f32x4 cbt[8];
#pragma unroll
    for (int jt = 0; jt < 8; ++jt) { cbt[jt] = (f32x4){0.f, 0.f, 0.f, 0.f};
        if (jt <= w) {
#pragma unroll
            for (int ks = 0; ks < 4; ++ks) { const bf16x8 bfr = *(const bf16x8*)(xact + (size_t)(tok0 + 16 * jt + l15) * 1536 + 1024 + g * 128 + ks * 32 + q * 8); cbt[jt] = MFMA16(bfr, cf[ks], cbt[jt]); } } }
    __syncthreads();
    for (int idx = tid; idx < 1024; idx += 512) { const int j = idx >> 3, hl = idx & 7; const float dtv = dt_g[(size_t)(tok0 + j) * 16 + 8 * g + hl]; dt_s[idx] = dtv; cf_s[idx] = __expf(acum_s[(j | 15) * 8 + hl] - acum_s[idx]) * dtv; }
    float ssq[4] = {0.f, 0.f, 0.f, 0.f};
    const int irow = 16 * w + l15;
    for (int hl = 0; hl < 8; ++hl) { const int h = 8 * g + hl;
        __syncthreads();
        { if (tid < 128) {
              const unsigned xw[8][4] = {{xr[0].x, xr[0].y, xr[0].z, xr[0].w}, {xr[1].x, xr[1].y, xr[1].z, xr[1].w}, {xr[2].x, xr[2].y, xr[2].z, xr[2].w}, {xr[3].x, xr[3].y, xr[3].z, xr[3].w},
                                         {xr[4].x, xr[4].y, xr[4].z, xr[4].w}, {xr[5].x, xr[5].y, xr[5].z, xr[5].w}, {xr[6].x, xr[6].y, xr[6].z, xr[6].w}, {xr[7].x, xr[7].y, xr[7].z, xr[7].w}};
#pragma unroll
              for (int e = 0; e < 8; ++e) { u32x4 wv;
                  if ((e & 1) == 0) { wv.x = (xw[0][e >> 1] & 0xFFFFu) | (xw[1][e >> 1] << 16); wv.y = (xw[2][e >> 1] & 0xFFFFu) | (xw[3][e >> 1] << 16); wv.z = (xw[4][e >> 1] & 0xFFFFu) | (xw[5][e >> 1] << 16); wv.w = (xw[6][e >> 1] & 0xFFFFu) | (xw[7][e >> 1] << 16); }
                  else { wv.x = (xw[0][e >> 1] >> 16) | (xw[1][e >> 1] & 0xFFFF0000u); wv.y = (xw[2][e >> 1] >> 16) | (xw[3][e >> 1] & 0xFFFF0000u); wv.z = (xw[4][e >> 1] >> 16) | (xw[5][e >> 1] & 0xFFFF0000u); wv.w = (xw[6][e >> 1] >> 16) | (xw[7][e >> 1] & 0xFFFF0000u); }
                  *(u32x4*)(xT + (xpb * 8 + e) * 136 + ((xjg * 8) ^ (xpb << 3))) = wv; } }
          *(u32x4*)(hS + hp_ * 136 + hn0) = hr[0]; *(u32x4*)(hS + hp_ * 136 + hn0 + 8) = hr[1]; }
        float zz[16];
#pragma unroll
        for (int e = 0; e < 16; ++e) zz[e] = bf2f(zr[e]);
        __syncthreads();
        if (hl < 7) S3_LOAD(hl + 1);
        const float ai = acum_s[irow * 8 + hl];
        bf16x8 af[4];
#pragma unroll
        for (int s = 0; s < 4; ++s) { float m8[8];
#pragma unroll
            for (int hf = 0; hf < 2; ++hf) { const int jt = 2 * s + hf;
                const float rf = jt < w ? __expf(ai - acum_s[(16 * jt + 15) * 8 + hl]) : 0.f;
#pragma unroll
                for (int r = 0; r < 4; ++r) { const int j = 16 * jt + 4 * q + r; float val = 0.f;
                    if (jt < w) val = cbt[jt][r] * rf * cf_s[j * 8 + hl];
                    else if (jt == w && j <= irow) val = cbt[jt][r] * __expf(ai - acum_s[j * 8 + hl]) * dt_s[j * 8 + hl];
                    m8[hf * 4 + r] = val; } }
            af[s] = as_frag(pack8(m8)); }
        const float dsk = pk->ssd_d[h];
        float ea[4];
#pragma unroll
        for (int r = 0; r < 4; ++r) ea[r] = __expf(acum_s[(16 * w + 4 * q + r) * 8 + hl]);
#pragma unroll
        for (int pt = 0; pt < 4; ++pt) { f32x4 yd = {0.f, 0.f, 0.f, 0.f}, yo = {0.f, 0.f, 0.f, 0.f};
            const bf16_t* xrw = xT + (16 * pt + l15) * 136; const int xsw = (((16 * pt + l15) >> 3) & 15) << 3;
#pragma unroll
            for (int s = 0; s < 4; ++s) if (2 * s <= w) { const u32x2 lo = *(const u32x2*)(xrw + ((32 * s + 4 * q) ^ xsw)), hi = *(const u32x2*)(xrw + ((32 * s + 16 + 4 * q) ^ xsw)); yd = MFMA16(af[s], frag2(lo, hi), yd); }
            const bf16_t* hrw = hS + (16 * pt + l15) * 136 + q * 8;
#pragma unroll
            for (int ks = 0; ks < 4; ++ks) { const bf16x8 hf = *(const bf16x8*)(hrw + ks * 32); yo = MFMA16(cf[ks], hf, yo); }
            const u32x2 xv2 = *(const u32x2*)(xrw + ((16 * w + 4 * q) ^ xsw)); const float xv[4] = {bflo(xv2.x), bfhi(xv2.x), bflo(xv2.y), bfhi(xv2.y)};
#pragma unroll
            for (int r = 0; r < 4; ++r) { const size_t tok = (size_t)(tok0 + 16 * w + 4 * q + r); const int pp = 16 * pt + l15;
                const float y = yd[r] + ea[r] * yo[r] + dsk * xv[r]; const float val = y * siluf(zz[pt * 4 + r]);
                ssq[r] += val * val; mix[tok * DMIX + 1024 + g * 512 + hl * 64 + pp] = f2bf(val); } }
    }
#pragma unroll
    for (int r = 0; r < 4; ++r) { float sv = ssq[r]; sv += shx(sv, 1, lane); sv += shx(sv, 2, lane); sv += shx(sv, 4, lane); sv += shx(sv, 8, lane); if (l15 == 0) rstd_s[16 * w + 4 * q + r] = rsqrtf(sv * (1.f / 512.f) + 1e-5f); }
    asm volatile("s_waitcnt vmcnt(0)" ::: "memory");
    __syncthreads();
    for (int idx = tid; idx < 128 * 64; idx += 512) { const int row = idx >> 6, c8 = (idx & 63) * 8; bf16_t* mp = mix + (size_t)(tok0 + row) * DMIX + 1024 + g * 512 + c8;
        const u32x4 v = *(const u32x4*)mp; float x[8]; unpack8(v, x); const float rs = rstd_s[row];
        const f32x4 g0 = *(const f32x4*)(pk->ssd_norm_g + g * 512 + c8), g1 = *(const f32x4*)(pk->ssd_norm_g + g * 512 + c8 + 4);
        x[0] *= rs * g0[0]; x[1] *= rs * g0[1]; x[2] *= rs * g0[2]; x[3] *= rs * g0[3]; x[4] *= rs * g1[0]; x[5] *= rs * g1[1]; x[6] *= rs * g1[2]; x[7] *= rs * g1[3];
        *(u32x4*)mp = pack8(x); }
#undef S3_LOAD
}

DI void outs_item(KP pk_in, unsigned char* lds, int piece) {
    KP pk = pk_in; asm volatile("" : "+s"(pk));
    const int tid = otid(), w = tid >> 6, lane = tid & 63, l15 = lane & 15, q = lane >> 4;
    const int rg = piece >> 4, cgp = piece & 15;
    const bf16_t* mix = (const bf16_t*)(pk->ws + W_MIX); const bf16_t* wo = (const bf16_t*)(pk->ws + W_WOUTT);
    float* part = (float*)lds;
    f32x4 acc[2][4];
#pragma unroll
    for (int mt = 0; mt < 2; ++mt)
#pragma unroll
        for (int nt = 0; nt < 4; ++nt) acc[mt][nt] = (f32x4){0.f, 0.f, 0.f, 0.f};
    const bf16_t* ap = mix + (size_t)(NTOKP + rg * 32 + l15) * DMIX + w * 384 + q * 8;
    const bf16_t* bp = wo + (size_t)(cgp * 64 + l15) * 3072 + w * 384 + q * 8;
#pragma unroll 4
    for (int ks = 0; ks < 12; ++ks) { bf16x8 a[2], bb[4];
#pragma unroll
        for (int mt = 0; mt < 2; ++mt) a[mt] = *(const bf16x8*)(ap + (size_t)mt * 16 * DMIX + ks * 32);
#pragma unroll
        for (int nt = 0; nt < 4; ++nt) bb[nt] = *(const bf16x8*)(bp + (size_t)nt * 16 * 3072 + ks * 32);
#pragma unroll
        for (int mt = 0; mt < 2; ++mt)
#pragma unroll
            for (int nt = 0; nt < 4; ++nt) acc[mt][nt] = MFMA16(a[mt], bb[nt], acc[mt][nt]); }
    __syncthreads();
#pragma unroll
    for (int mt = 0; mt < 2; ++mt)
#pragma unroll
        for (int nt = 0; nt < 4; ++nt)
#pragma unroll
            for (int r = 0; r < 4; ++r) part[(w * 32 + mt * 16 + 4 * q + r) * 64 + nt * 16 + l15] = acc[mt][nt][r];
    __syncthreads();
    { const int row = tid >> 4, c4 = (tid & 15) * 4; f32x4 sum = {0.f, 0.f, 0.f, 0.f};
#pragma unroll
      for (int ww = 0; ww < 8; ++ww) sum += *(const f32x4*)(part + (ww * 32 + row) * 64 + c4);
      const int srow = rg * 32 + row, col = cgp * 64 + c4; const f32x4 xv = *(const f32x4*)(pk->x_sample + (size_t)srow * 1024 + col);
      const f32x4 v = sum + xv * 1.189207115002721f;
      float s1 = v[0] + v[1] + v[2] + v[3], s2 = v[0] * v[0] + v[1] * v[1] + v[2] * v[2] + v[3] * v[3];
      s1 += shx(s1, 1, lane); s1 += shx(s1, 2, lane); s1 += shx(s1, 4, lane); s1 += shx(s1, 8, lane); s2 += shx(s2, 1, lane); s2 += shx(s2, 2, lane); s2 += shx(s2, 4, lane); s2 += shx(s2, 8, lane);
      float* stat = (float*)(pk->ws + W_STAT) + (size_t)srow * 2; unsigned* c = (unsigned*)(pk->ws + W_CNT) + (64 + rg) * 64;
      if (l15 == 0) { __hip_atomic_fetch_add(stat, s1, __ATOMIC_RELAXED, __HIP_MEMORY_SCOPE_AGENT); __hip_atomic_fetch_add(stat + 1, s2, __ATOMIC_RELAXED, __HIP_MEMORY_SCOPE_AGENT); }
      asm volatile("s_waitcnt vmcnt(0)" ::: "memory");
      if (lane == 0) __hip_atomic_fetch_add(c, 1u, __ATOMIC_RELAXED, __HIP_MEMORY_SCOPE_AGENT);
      pg8::ln_wait(c, 128u);
      const float t1 = __hip_atomic_load(stat, __ATOMIC_RELAXED, __HIP_MEMORY_SCOPE_AGENT), t2 = __hip_atomic_load(stat + 1, __ATOMIC_RELAXED, __HIP_MEMORY_SCOPE_AGENT);
      const float mu = t1 * (1.f / 1024.f); const float rstd = rsqrtf(fmaxf(t2 * (1.f / 1024.f) - mu * mu, 0.f) + 1e-5f);
      const f32x4 gv = *(const f32x4*)(pk->ln_g + col), bv = *(const f32x4*)(pk->ln_b + col);
      *(f32x4*)(pk->out + O_YS + (size_t)srow * 1024 + col) = (v - mu) * rstd * gv + bv; }
    __syncthreads();
}

DI void ln_rows(KP pk_in) {
    KP pk = pk_in; asm volatile("" : "+s"(pk));
    const float* res = (const float*)(pk->ws + W_RES);
    const int tid = otid(); const int lane = tid & 63; const int gw = obid() * 8 + (tid >> 6), nw = gridDim.x * 8;
    f32x4 gg[4], bb[4];
#pragma unroll
    for (int i = 0; i < 4; ++i) { gg[i] = *(const f32x4*)(pk->ln_g + i * 256 + lane * 4); bb[i] = *(const f32x4*)(pk->ln_b + i * 256 + lane * 4); }
    for (int row = gw; row < NTOK; row += nw) { f32x4 v[4]; float s = 0.f;
#pragma unroll
        for (int i = 0; i < 4; ++i) { v[i] = *(const f32x4*)(res + (size_t)row * 1024 + i * 256 + lane * 4); s += v[i][0] + v[i][1] + v[i][2] + v[i][3]; }
        const float mu = wave_sum(s, lane) * (1.f / 1024.f); float s2 = 0.f;
#pragma unroll
        for (int i = 0; i < 4; ++i) { v[i] = v[i] - mu; s2 += v[i][0] * v[i][0] + v[i][1] * v[i][1] + v[i][2] * v[i][2] + v[i][3] * v[i][3]; }
        const float rstd = rsqrtf(wave_sum(s2, lane) * (1.f / 1024.f) + 1e-5f);
#pragma unroll
        for (int i = 0; i < 4; ++i) *(f32x4*)(pk->out + (size_t)row * 1024 + i * 256 + lane * 4) = v[i] * rstd * gg[i] + bb[i]; }
}

__global__ void __launch_bounds__(512, 2) hymba_fwd(Params p_unused) {
    KP pk = kparams();
    extern __shared__ __attribute__((aligned(16))) unsigned char shm[];
    cg::grid_group grid = cg::this_grid();
    const int G = gridDim.x;
    if (threadIdx.x < 4) ((volatile LAS unsigned*)(LAS unsigned char*)shm)[32768 + threadIdx.x] = 0u;
    __syncthreads();
    const int ph_lo_chk = pk->ph_lo;
    XcdBarrier xb = xcd_barrier_post((unsigned*)(pk->ws + W_BAR), (volatile LAS unsigned*)(LAS unsigned char*)shm + 32768);
    if (ph_lo_chk < 0) grid.sync();
    { KP pk = kparams(); for (int rep = 0; rep < REP0; ++rep) phase_prep(pk, shm); }
    xcd_barrier(xb);
    for (int rep = 1; rep < REPS; ++rep) xcd_barrier(xb);
    { KP pk = kparams(); const int bid = obid();
      for (int rep = 0; rep < REP1; ++rep) {
        { pg8::Gemm g; g.A = (const bf16_t*)(pk->ws + W_XB); g.Bt = (const bf16_t*)(pk->ws + W_WINT); g.M = NTOK; g.N = NPROJ; g.K = 1024;
          pg8::StaticOrder S; S.init(g.M, g.N, G, bid); pg8::EpiBf16 E; E.O = (bf16_t*)(pk->ws + W_PROJ); E.ldc = NPROJ;
          pg8::gemm_phase<pg8::EpiBf16, pg8::StaticOrder>((LAS unsigned char*)shm, g, S, E); }
        { pg8::Gemm g; g.A = (const bf16_t*)(pk->ws + W_MEMB); g.Bt = (const bf16_t*)(pk->ws + W_WKVT); g.M = 2048; g.N = 2048; g.K = 1024;
          const int shift = (66 * 26) % G; pg8::StaticOrder S; S.init(g.M, g.N, G, (bid + G - shift) % G);
          pg8::EpiKV E; E.mk = pk->out + O_MKP; E.mv = pk->out + O_MVP; E.kb = (bf16_t*)(pk->ws + W_KB); E.vt = (bf16_t*)(pk->ws + W_VT);
          pg8::gemm_phase<pg8::EpiKV, pg8::StaticOrder>((LAS unsigned char*)shm, g, S, E); } } }
    xcd_barrier(xb);
    { KP pk = kparams(); const int bid = obid();
      for (int rep = 0; rep < REP2; ++rep) for (int it = bid; it < 512; it += G) { if (it < 256) ssd1_item(pk, shm, it >> 5, (it >> 1) & 15, it & 1); else if (it < 384) rgconv_item(pk, (it - 256) >> 4, (it - 256) & 15); else { const int u = it - 384; rg_item(pk, shm, true, u >> 5, (u >> 2) & 7, u & 3); } } }
    xcd_barrier(xb);
    { KP pk = kparams(); const int bid = obid();
      for (int rep = 0; rep < REP3; ++rep) for (int kk = 0; kk < 7; ++kk) { const int kq = kk; const int it = bid + kq * G;
          if (it >= 1792) continue;
          if (rep > 0 && (it < R3LO || it >= R3HI)) continue;
          if (it < 256) rg_item(pk, shm, false, it >> 5, (it >> 2) & 7, it & 3);
          else if (it < 512) statepass_item(pk, it - 256);
          else if (it < 768) { const int u = it - 512; ssds_item(pk, shm, u >> 1, u & 1); }
          else if (it < 1280) { const int u = it - 768; attns_item(pk, shm, u >> 2, u & 3); }
          else { const int u = it - 1280; attnp_item(pk, shm, u >> 6, (u >> 4) & 3, u & 15); } } }
    xcd_barrier(xb);
    { KP pk = kparams(); const int bid = obid();
      for (int rep = 0; rep < REP4; ++rep) for (int it = bid; it < 256; it += G) ssd3_item(pk, shm, it >> 5, (it >> 1) & 15, it & 1); }
    xcd_barrier(xb);
    { KP pk = kparams(); const int bid = obid();
      for (int rep = 0; rep < REP5; ++rep) {
        for (int it = bid; it < 256; it += G) outs_item(pk, shm, it);
        pg8::Gemm g; g.A = (const bf16_t*)(pk->ws + W_MIX); g.Bt = (const bf16_t*)(pk->ws + W_WOUTT); g.M = NTOKP; g.N = 1024; g.K = 3072;
        pg8::StaticOrder S; S.init(g.M, g.N, G, bid); pg8::EpiLn E; E.out = pk->out + O_YP; E.xp = pk->x_prompt; E.lng = pk->ln_g; E.lnb = pk->ln_b; E.stat = (float*)(pk->ws + W_SLOT); E.cnt = (unsigned*)(pk->ws + W_CNT); E.alpha = 1.189207115002721f; E.red = (LAS float*)(LAS unsigned char*)shm;
        pg8::gemm_phase<pg8::EpiLn, pg8::StaticOrder>((LAS unsigned char*)shm, g, S, E); } }
}

extern "C" void kernel_launch(void* const* d_in, const int* in_sizes, int n_in, void* d_out, int out_size, void* d_ws, size_t ws_size, hipStream_t stream) {
    static int grid_blocks = 0;
    if (!grid_blocks) {
        int dev = 0, cus = 0, per_cu = 0;
        hipGetDevice(&dev);
        hipDeviceGetAttribute(&cus, hipDeviceAttributeMultiprocessorCount, dev);
        if (hipFuncSetAttribute((const void*)hymba_fwd, hipFuncAttributeMaxDynamicSharedMemorySize, LDS_BYTES) != hipSuccess) fprintf(stderr, "hipFuncSetAttribute failed\n");
        hipOccupancyMaxActiveBlocksPerMultiprocessor(&per_cu, (const void*)hymba_fwd, 512, LDS_BYTES);
        if (per_cu < 1) { fprintf(stderr, "occupancy query says %d blocks per CU\n", per_cu); per_cu = 1; }
        grid_blocks = cus * 1;
        if (ws_size < W_END) fprintf(stderr, "workspace too small: %zu < %zu\n", ws_size, (size_t)W_END);
    }
    if (hipMemsetAsync((char*)d_ws + W_BAR, 0, W_ZERO_END - W_BAR, stream) != hipSuccess) fprintf(stderr, "memset failed\n");
    Params p{};
    const float** fp = (const float**)&p;
    for (int i = 0; i < 28; ++i) fp[i] = (const float*)d_in[i];
    p.out = (float*)d_out; p.ws = (unsigned char*)d_ws;
    p.ph_lo = 0; p.ph_hi = NPHASE;
    void* args[] = {&p};
    hipError_t e = hipLaunchCooperativeKernel((const void*)hymba_fwd, dim3(grid_blocks), dim3(512), args, LDS_BYTES, stream);
    if (e != hipSuccess) fprintf(stderr, "cooperative launch failed: %s (grid %d)\n", hipGetErrorString(e), grid_blocks);
}
```

```cpp
#include <hip/hip_runtime.h>
#include <hip/hip_cooperative_groups.h>
#include <cstdio>
namespace cg = cooperative_groups;

#ifndef REP2
#define REP2 1
#endif
#ifndef REP3
#define REP3 1
#endif
#ifndef REP4
#define REP4 1
#endif
#ifndef R3LO
#define R3LO 0
#define R3HI 256
#endif
#ifndef REP0
#define REP0 1
#endif
#ifndef REP1
#define REP1 1
#endif
#ifndef REP5
#define REP5 1
#endif
#ifndef REP6
#define REP6 1
#endif
#ifndef REPS
#define REPS 1
#endif
#ifndef PHM
#define PHM 127
#endif
#ifndef N_LAUNCH_PER_PHASE
#define N_LAUNCH_PER_PHASE 0
#endif

#define DI __device__ __forceinline__
#define LAS __attribute__((address_space(3)))
typedef unsigned short bf16_t;
typedef short bf16x8 __attribute__((ext_vector_type(8)));
typedef float f32x4 __attribute__((ext_vector_type(4)));
typedef unsigned u32x4 __attribute__((ext_vector_type(4)));
typedef unsigned u32x2 __attribute__((ext_vector_type(2)));

constexpr int NTOKP = 16384, NTOKS = 512, NTOK = 16896, DM = 1024, NPROJ = 6656, DMIX = 3072, DIN = 6672;
constexpr int C_RGX = 0, C_RGG = 1024, C_XBC = 2048, C_Z = 3584, C_Q = 4608, C_XG = 5632;
constexpr int NPHASE = 7;
constexpr int LDS_BYTES = 131072 + 64;

constexpr size_t O_YP = 0, O_YS = O_YP + (size_t)NTOKP * DM, O_RGCP = O_YS + (size_t)NTOKS * DM, O_RGHP = O_RGCP + 8 * 3 * 1024, O_SCP = O_RGHP + 8 * 1024,
                 O_SHP = O_SCP + 8 * 3 * 1536, O_MKP = O_SHP + (size_t)8 * 16 * 64 * 128, O_MVP = O_MKP + (size_t)2048 * 1024, O_RGCS = O_MVP + (size_t)2048 * 1024,
                 O_RGHS = O_RGCS + (size_t)128 * 3 * 1024, O_SCS = O_RGHS + 128 * 1024, O_SHS = O_SCS + (size_t)128 * 3 * 1536;

constexpr size_t al256(size_t x) { return (x + 255) & ~(size_t)255; }
constexpr size_t W_XB = 0;
constexpr size_t W_WINT = al256(W_XB + (size_t)NTOK * DM * 2);
constexpr size_t W_WDTT = al256(W_WINT + (size_t)NPROJ * DM * 2);
constexpr size_t W_WDTF = al256(W_WDTT + 16 * 1024 * 2);
constexpr size_t W_WOUTT = al256(W_WDTF + 16 * 1024 * 4);
constexpr size_t W_WKVT = al256(W_WOUTT + (size_t)1024 * 3072 * 2);
constexpr size_t W_MEMB = al256(W_WKVT + (size_t)2048 * 1024 * 2);
constexpr size_t W_WGT = al256(W_MEMB + (size_t)2048 * 1024 * 2);
constexpr size_t W_KB = al256(W_WGT + (size_t)8 * 4 * 64 * 128 * 2);
constexpr size_t W_VT = al256(W_KB + (size_t)2048 * 1024 * 2);
constexpr size_t W_XACT = al256(W_VT + (size_t)2048 * 1024 * 2);
constexpr size_t W_DT = al256(W_XACT + (size_t)NTOKP * 1536 * 2);
constexpr size_t W_ACUM = al256(W_DT + (size_t)NTOKP * 16 * 4);
constexpr size_t W_CD = al256(W_ACUM + (size_t)NTOKP * 16 * 4);
constexpr size_t W_ST = al256(W_CD + 8 * 16 * 16 * 4);
constexpr size_t W_MIX = al256(W_ST + (size_t)8 * 16 * 16 * 8192 * 4);
constexpr size_t W_PROJ = al256(W_MIX + (size_t)NTOK * DMIX * 2);
constexpr size_t W_RES = W_PROJ;
constexpr size_t W_BAR = al256(W_PROJ + (size_t)NTOK * NPROJ * 2);
constexpr size_t W_CNT = al256(W_BAR + 3456 * 4);
constexpr size_t W_STAT = al256(W_CNT + 80 * 256);
constexpr size_t W_ZERO_END = al256(W_STAT + (size_t)NTOKS * 2 * 4);
constexpr size_t W_SLOT = W_ZERO_END;
constexpr size_t W_END = al256(W_SLOT + (size_t)NTOKP * 8 * 4);

struct Params {
    const float *x_prompt, *x_sample, *mem_prompt, *state_rg_conv, *state_rg_h, *state_ssd_conv, *state_ssd_h, *cache_k, *cache_v;
    const float *w_in, *rg_conv_w, *rg_conv_b, *w_rg_a, *b_rg_a, *w_rg_i, *b_rg_i, *rg_lambda, *ssd_conv_w, *ssd_conv_b, *ssd_dt_bias, *ssd_a_log, *ssd_d, *ssd_norm_g,
        *w_mem_k, *w_mem_v, *w_out, *ln_g, *ln_b;
    float* out; unsigned char* ws;
    int ph_lo, ph_hi;
};
typedef const __attribute__((address_space(4))) Params* KP;
DI KP kparams() { KP k = (KP)__builtin_amdgcn_kernarg_segment_ptr(); asm volatile("" : "+s"(k)); return k; }

DI int otid() { int t = threadIdx.x; asm volatile("" : "+v"(t)); return t; }
DI int obid() { int t = blockIdx.x; asm volatile("" : "+s"(t)); return t; }
DI float bf2f(bf16_t b) { return __uint_as_float(((unsigned)b) << 16); }
typedef __bf16 hbf2 __attribute__((ext_vector_type(2)));
typedef float f32x2 __attribute__((ext_vector_type(2)));
DI unsigned pack2(float lo, float hi) { const f32x2 v = {lo, hi}; return __builtin_bit_cast(unsigned, __builtin_convertvector(v, hbf2)); }
DI bf16_t f2bf(float f) { return (bf16_t)(pack2(f, 0.f) & 0xFFFFu); }
DI float bflo(unsigned w) { return __uint_as_float(w << 16); }
DI float bfhi(unsigned w) { return __uint_as_float(w & 0xFFFF0000u); }
DI void unpack8(const u32x4 v, float (&o)[8]) { o[0] = bflo(v.x); o[1] = bfhi(v.x); o[2] = bflo(v.y); o[3] = bfhi(v.y); o[4] = bflo(v.z); o[5] = bfhi(v.z); o[6] = bflo(v.w); o[7] = bfhi(v.w); }
DI u32x4 pack8(const float (&o)[8]) { u32x4 w; w.x = pack2(o[0], o[1]); w.y = pack2(o[2], o[3]); w.z = pack2(o[4], o[5]); w.w = pack2(o[6], o[7]); return w; }
DI bf16x8 as_frag(u32x4 w) { return __builtin_bit_cast(bf16x8, w); }
DI bf16x8 frag2(u32x2 lo, u32x2 hi) { u32x4 w; w.x = lo.x; w.y = lo.y; w.z = hi.x; w.w = hi.y; return __builtin_bit_cast(bf16x8, w); }
DI float shx(float v, int m, int lane) { return __int_as_float(__builtin_amdgcn_ds_bpermute((lane ^ m) << 2, __float_as_int(v))); }
DI float shl(float v, int src) { return __int_as_float(__builtin_amdgcn_ds_bpermute(src << 2, __float_as_int(v))); }
DI float siluf(float x) { return x * __builtin_amdgcn_rcpf(1.f + __expf(-x)); }
DI float sigmf(float x) { return __builtin_amdgcn_rcpf(1.f + __expf(-x)); }
DI float softplusf(float v) { return v > 20.f ? v : __logf(1.f + __expf(v)); }
#define MFMA16(a, b, c) __builtin_amdgcn_mfma_f32_16x16x32_bf16((a), (b), (c), 0, 0, 0)

#define XB_TMO      128
#define XB_XCNT(j)  (256  + 64 * (j))
#define XB_XSUB(j)  (1280 + 64 * (j))
#define XB_XGEN(j)  (2304 + 64 * (j))
#define XB_TOP      3328
#define XB_TOPGEN   3392
#define XCD_BAR_WORDS 3456
#define XB_SPIN_CAP (1u << 20)
DI unsigned xb_ld(unsigned* ptr)              { return __hip_atomic_load(ptr, __ATOMIC_RELAXED, __HIP_MEMORY_SCOPE_AGENT); }
DI unsigned xb_add(unsigned* ptr, unsigned v) { return __hip_atomic_fetch_add(ptr, v, __ATOMIC_RELAXED, __HIP_MEMORY_SCOPE_AGENT); }
DI unsigned xb_xcc_id() { return (unsigned)__builtin_amdgcn_s_getreg((3 << 11) | 20) & 0xFu; }
#define XB_SPIN(cond, bar) do { unsigned _sp = 0; while (cond) { __builtin_amdgcn_s_sleep(1); \
    if ((++_sp & 255u) == 0u) { if (xb_ld(&(bar)[XB_TMO])) break; if (_sp > XB_SPIN_CAP) { atomicAdd(&(bar)[XB_TMO], 1u); break; } } } } while (0)
struct XcdBarrier { unsigned* bar; unsigned x; volatile LAS unsigned* st; };
DI XcdBarrier xcd_barrier_post(unsigned* bar, volatile LAS unsigned* st) {
    XcdBarrier b; b.bar = bar; b.x = xb_xcc_id(); b.st = st;
    if (threadIdx.x == 0) (void)xb_add(&bar[XB_XCNT(b.x)], 1u);
    return b;
}
DI void xcd_barrier_complete(unsigned* bar, unsigned x, unsigned& nloc, unsigned& nx) {
    const unsigned G = gridDim.x * gridDim.y * gridDim.z;
    unsigned sum, cnt, mine, sp = 0u;
    for (;;) {
        sum = 0u; cnt = 0u; mine = 0u;
#pragma unroll
        for (unsigned j = 0; j < 16; ++j) { const unsigned c = xb_ld(&bar[XB_XCNT(j)]); sum += c; cnt += (c > 0u) ? 1u : 0u; mine = (j == x) ? c : mine; }
        if (sum == G) break;
        __builtin_amdgcn_s_sleep(1);
        if ((++sp & 255u) == 0u) { if (xb_ld(&bar[XB_TMO])) break; if (sp > XB_SPIN_CAP) { atomicAdd(&bar[XB_TMO], 1u); break; } }
    }
    nloc = mine > 0u ? mine : 1u; nx = cnt > 0u ? cnt : 1u;
}
DI void xcd_barrier(const XcdBarrier& b) {
    asm volatile("s_waitcnt vmcnt(0)" ::: "memory");
    __syncthreads();
    if (threadIdx.x == 0) {
        unsigned* bar = b.bar;
        __builtin_amdgcn_s_waitcnt(0);
        unsigned nloc = b.st[0], nx = b.st[1];
        if (nloc == 0u) { xcd_barrier_complete(bar, b.x, nloc, nx); b.st[0] = nloc; b.st[1] = nx; }
        const unsigned old = xb_add(&bar[XB_XSUB(b.x)], 1u);
        const unsigned gen = old / nloc;
        if (old + 1u == (gen + 1u) * nloc) {
            __builtin_amdgcn_fence(__ATOMIC_RELEASE, "agent");
            asm volatile("s_waitcnt vmcnt(0)" ::: "memory");
            const unsigned og = xb_add(&bar[XB_TOP], 1u);
            const unsigned tg = og / nx;
            if (og + 1u == (tg + 1u) * nx) xb_add(&bar[XB_TOPGEN], 1u);
            else XB_SPIN(xb_ld(&bar[XB_TOPGEN]) == tg, bar);
            __builtin_amdgcn_fence(__ATOMIC_ACQUIRE, "agent");
            xb_add(&bar[XB_XGEN(b.x)], 1u);
            asm volatile("s_waitcnt vmcnt(0)" ::: "memory");
        } else {
            XB_SPIN(xb_ld(&bar[XB_XGEN(b.x)]) == gen, bar);
            __builtin_amdgcn_fence(__ATOMIC_ACQUIRE, "agent");
            asm volatile("s_waitcnt vmcnt(0)" ::: "memory");
        }
    }
    __syncthreads();
}

namespace pg8 {
constexpr int BM = 256, BK = 64, HALF = 128, HTB = HALF * BK * 2, STAGE_BYTES = 8 * HTB, NXCD = 8, WGM = 8;
DI int lds_byte(int r, int c) { const int st = (r >> 4) * 2 + (c >> 5), rr = r & 15, cc = c & 31, ob = rr * 64 + cc * 2; return st * 1024 + (ob ^ (((ob >> 9) & 1) << 5)); }
DI void stage_rc(int b, int& R, int& C) { const int st = b / 1024, sb = b % 1024, swz = sb ^ (((sb >> 9) & 1) << 5); R = (st >> 1) * 16 + swz / 64; C = (st & 1) * 32 + (swz % 64) / 2; }
DI int perm32(int rho) { const int n = rho >> 4, i = rho & 15; return 8 * (i >> 2) + 4 * n + (i & 3); }
struct Unit { int pm, pn; };
struct Gemm { const bf16_t* A; const bf16_t* Bt; int M, N, K; };
struct StaticOrder {
    int nM, nN, nwg, G, c;
    DI void init(int M, int N, int G_, int c_) { nM = M / BM; nN = N / BM; nwg = nM * nN; G = G_; c = c_; }
    DI bool next(int i, Unit& u) const {
        const long L = (long)i * G + c; if (L >= nwg) return false;
        int wgid = (int)L; { const int q = nwg / NXCD, r = nwg % NXCD, xcd = wgid % NXCD, off = wgid / NXCD; wgid = (xcd < r ? xcd * (q + 1) : r * (q + 1) + (xcd - r) * q) + off; }
        const int nig = WGM * nN, gid = wgid / nig, fm = gid * WGM, gsz = (nM - fm) < WGM ? (nM - fm) : WGM;
        u.pm = fm + ((wgid % nig) % gsz); u.pn = (wgid % nig) / gsz; return true;
    }
};
DI unsigned cvt_pk_bf16(float lo, float hi) { unsigned r; asm volatile("v_cvt_pk_bf16_f32 %0, %1, %2" : "=v"(r) : "v"(lo), "v"(hi)); return r; }

struct EpiBf16 {
    static constexpr bool PERM = true, AFTER_DRAIN = false;
    bf16_t* O; int ldc;
    DI void operator()(const f32x4 (&acc)[2][2][4][2], const Unit& u, int wr, int wc, int fr, int fq) const {
        const int row0 = u.pm * BM + wr * 64 + fr; const int col0 = u.pn * BM + wc * 32 + 8 * fq;
#pragma unroll
        for (int ai = 0; ai < 2; ++ai)
#pragma unroll
            for (int m = 0; m < 4; ++m) { bf16_t* rowp = O + (size_t)(row0 + ai * HALF + m * 16) * ldc + col0;
#pragma unroll
                for (int bj = 0; bj < 2; ++bj) { const f32x4 v0 = acc[ai][bj][m][0], v1 = acc[ai][bj][m][1];
                    u32x4 w; w.x = cvt_pk_bf16(v0[0], v0[1]); w.y = cvt_pk_bf16(v0[2], v0[3]); w.z = cvt_pk_bf16(v1[0], v1[1]); w.w = cvt_pk_bf16(v1[2], v1[3]);
                    *(u32x4*)(rowp + bj * HALF) = w; } }
    }
};
struct EpiKV {
    static constexpr bool PERM = false, AFTER_DRAIN = false;
    float* mk; float* mv; bf16_t* kb; bf16_t* vt;
    DI void operator()(const f32x4 (&acc)[2][2][4][2], const Unit& u, int wr, int wc, int fr, int fq) const {
        const int row0 = u.pm * BM + wr * 64 + fr, col0 = u.pn * BM + wc * 32 + 4 * fq;
#pragma unroll
        for (int ai = 0; ai < 2; ++ai)
#pragma unroll
            for (int m = 0; m < 4; ++m) { const int row = row0 + ai * HALF + m * 16;
#pragma unroll
                for (int bj = 0; bj < 2; ++bj)
#pragma unroll
                    for (int n = 0; n < 2; ++n) { const int col = col0 + bj * HALF + n * 16; const f32x4 v = acc[ai][bj][m][n];
                        if (col < 1024) { *(f32x4*)(mk + (size_t)row * 1024 + col) = v; u32x2 w; w.x = cvt_pk_bf16(v[0], v[1]); w.y = cvt_pk_bf16(v[2], v[3]); *(u32x2*)(kb + (size_t)row * 1024 + col) = w; }
                        else { const int cc = col - 1024; *(f32x4*)(mv + (size_t)row * 1024 + cc) = v; const int bb = row >> 8, mt = row & 255;
#pragma unroll
                            for (int j = 0; j < 4; ++j) { const int c2 = cc + j, head = c2 >> 8, d = c2 & 255; vt[((size_t)((bb * 4 + head) * 256 + d)) * 256 + mt] = f2bf(v[j]); } } } }
    }
};
DI void ln_wait(unsigned* cnt, unsigned target) { unsigned sp = 0; while (__hip_atomic_load(cnt, __ATOMIC_RELAXED, __HIP_MEMORY_SCOPE_AGENT) < target) { __builtin_amdgcn_s_sleep(1); if (++sp > (1u << 22)) break; } }
struct EpiLn {
    static constexpr bool PERM = false, AFTER_DRAIN = true;
    float* out; const bf16_t* xp; const float* lng; const float* lnb; float* stat; unsigned* cnt; float alpha; LAS float* red;
    DI void operator()(f32x4 (&acc)[2][2][4][2], const Unit& u, int wr, int wc, int fr, int fq) const {
        const int row0 = u.pm * BM + wr * 64 + fr, col0 = u.pn * BM + wc * 32 + 4 * fq; const int lane = fq * 16 + fr; const int tid = (wr * 4 + wc) * 64 + lane;
#pragma unroll
        for (int ai = 0; ai < 2; ++ai)
#pragma unroll
            for (int m = 0; m < 4; ++m) { const int row = row0 + ai * HALF + m * 16; const bf16_t* xr = xp + (size_t)row * 1024; float s1 = 0.f, s2 = 0.f;
#pragma unroll
                for (int bj = 0; bj < 2; ++bj)
#pragma unroll
                    for (int n = 0; n < 2; ++n) { const int col = col0 + bj * HALF + n * 16; const u32x2 xb2 = *(const u32x2*)(xr + col); const f32x4 xv = {bflo(xb2.x), bfhi(xb2.x), bflo(xb2.y), bfhi(xb2.y)}; const f32x4 v = acc[ai][bj][m][n] + xv * alpha; acc[ai][bj][m][n] = v;
                        s1 += v[0] + v[1] + v[2] + v[3]; s2 += v[0] * v[0] + v[1] * v[1] + v[2] * v[2] + v[3] * v[3]; }
                s1 += shx(s1, 16, lane); s1 += shx(s1, 32, lane); s2 += shx(s2, 16, lane); s2 += shx(s2, 32, lane);
                if (fq == 0) { const int lr = wr * 64 + ai * HALF + m * 16 + fr; red[(lr * 4 + wc) * 2] = s1; red[(lr * 4 + wc) * 2 + 1] = s2; } }
        __syncthreads();
        if (tid < 256) { const int lr = tid; float t1 = 0.f, t2 = 0.f;
#pragma unroll
            for (int c = 0; c < 4; ++c) { t1 += red[(lr * 4 + c) * 2]; t2 += red[(lr * 4 + c) * 2 + 1]; }
            float* sp = stat + ((size_t)(u.pm * BM + lr) * 4 + u.pn) * 2;
            __hip_atomic_store(sp, t1, __ATOMIC_RELAXED, __HIP_MEMORY_SCOPE_AGENT); __hip_atomic_store(sp + 1, t2, __ATOMIC_RELAXED, __HIP_MEMORY_SCOPE_AGENT);
            asm volatile("s_waitcnt vmcnt(0)" ::: "memory"); }
        __syncthreads();
        unsigned* c = cnt + u.pm * 64;
        if (tid == 0) { __hip_atomic_fetch_add(c, 1u, __ATOMIC_RELAXED, __HIP_MEMORY_SCOPE_AGENT); ln_wait(c, 4u); }
        __syncthreads();
        if (tid < 256) { const int lr = tid; float t1 = 0.f, t2 = 0.f; const float* sp = stat + (size_t)(u.pm * BM + lr) * 8;
#pragma unroll
            for (int c2 = 0; c2 < 4; ++c2) { t1 += __hip_atomic_load(sp + c2 * 2, __ATOMIC_RELAXED, __HIP_MEMORY_SCOPE_AGENT); t2 += __hip_atomic_load(sp + c2 * 2 + 1, __ATOMIC_RELAXED, __HIP_MEMORY_SCOPE_AGENT); }
            const float mu = t1 * (1.f / 1024.f); red[lr * 2] = mu; red[lr * 2 + 1] = rsqrtf(fmaxf(t2 * (1.f / 1024.f) - mu * mu, 0.f) + 1e-5f); }
        __syncthreads();
#pragma unroll
        for (int ai = 0; ai < 2; ++ai)
#pragma unroll
            for (int m = 0; m < 4; ++m) { const int row = row0 + ai * HALF + m * 16; const int lr = wr * 64 + ai * HALF + m * 16 + fr; const float mu = red[lr * 2], rstd = red[lr * 2 + 1];
#pragma unroll
                for (int bj = 0; bj < 2; ++bj)
#pragma unroll
                    for (int n = 0; n < 2; ++n) { const int col = col0 + bj * HALF + n * 16; const f32x4 gv = *(const f32x4*)(lng + col), bv = *(const f32x4*)(lnb + col);
                        *(f32x4*)(out + (size_t)row * 1024 + col) = (acc[ai][bj][m][n] - mu) * rstd * gv + bv; } }
    }
};
struct EpiRes {
    static constexpr bool PERM = false, AFTER_DRAIN = false;
    float* res; const float* xp; const float* xs; float alpha;
    DI void operator()(const f32x4 (&acc)[2][2][4][2], const Unit& u, int wr, int wc, int fr, int fq) const {
        const int row0 = u.pm * BM + wr * 64 + fr, col0 = u.pn * BM + wc * 32 + 4 * fq;
#pragma unroll
        for (int ai = 0; ai < 2; ++ai)
#pragma unroll
            for (int m = 0; m < 4; ++m) { const int row = row0 + ai * HALF + m * 16; const float* xr = row < NTOKP ? xp + (size_t)row * 1024 : xs + (size_t)(row - NTOKP) * 1024;
#pragma unroll
                for (int bj = 0; bj < 2; ++bj)
#pragma unroll
                    for (int n = 0; n < 2; ++n) { const int col = col0 + bj * HALF + n * 16; const f32x4 xv = *(const f32x4*)(xr + col);
                        *(f32x4*)(res + (size_t)row * 1024 + col) = acc[ai][bj][m][n] + xv * alpha; } }
    }
};

template <class Epi, class Sched>
DI void gemm_phase(LAS unsigned char* lds, const Gemm g, const Sched& S, const Epi& E) {
    const int tid = otid(), wid = __builtin_amdgcn_readfirstlane(tid >> 6), lane = tid & 63, wr = wid >> 2, wc = wid & 3, fr = lane & 15, fq = lane >> 4;
    const int K = g.K, nt = K / BK;
    unsigned voffA[2], voffB[2];
#pragma unroll
    for (int i = 0; i < 2; ++i) { int R, C; stage_rc(tid * 16 + i * 8192, R, C); const int Rb = Epi::PERM ? ((R & ~31) + perm32(R & 31)) : R;
        voffA[i] = (unsigned)(R * K + C) * 2u; voffB[i] = (unsigned)(Rb * K + C) * 2u; }
    const size_t kstep = (size_t)(BK * 2);
    const size_t hstep = (size_t)HALF * K * 2;
    const size_t tstep = 2 * hstep;
    const unsigned ldsw = (unsigned)wid * 1024u;
    const int aoff = lds_byte(wr * 64 + fr, fq * 8), boff = lds_byte(wc * 32 + fr, fq * 8);
#define PG8_SA(b, h) (((b) * 2 + (h)) * HTB)
#define PG8_SB(b, h) ((4 + (b) * 2 + (h)) * HTB)
#define PG8_STAGE(bufoff, gbase, voff) do { _Pragma("unroll") for (int _i = 0; _i < 2; ++_i) \
        __builtin_amdgcn_global_load_lds((const unsigned*)((const char*)(gbase) + (voff)[_i]), (LAS unsigned*)(lds + (bufoff) + ldsw + _i * 8192), 16, 0, 0); } while (0)
#define PG8_LDA(dst, b, h) do { _Pragma("unroll") for (int m = 0; m < 4; ++m) _Pragma("unroll") for (int k = 0; k < 2; ++k) dst[m][k] = *(const LAS bf16x8*)(lds + PG8_SA(b, h) + aoff + m * 2048 + k * 1024); } while (0)
#define PG8_LDB(dst, b, h) do { _Pragma("unroll") for (int n = 0; n < 2; ++n) _Pragma("unroll") for (int k = 0; k < 2; ++k) dst[n][k] = *(const LAS bf16x8*)(lds + PG8_SB(b, h) + boff + n * 2048 + k * 1024); } while (0)
#define PG8_MMA(ai, bj, At, Bt) do { __builtin_amdgcn_s_setprio(1); _Pragma("unroll") for (int m = 0; m < 4; ++m) _Pragma("unroll") for (int n = 0; n < 2; ++n) _Pragma("unroll") for (int k = 0; k < 2; ++k) \
        acc[ai][bj][m][n] = __builtin_amdgcn_mfma_f32_16x16x32_bf16(Bt[n][k], At[m][k], acc[ai][bj][m][n], 0, 0, 0); __builtin_amdgcn_s_setprio(0); } while (0)
#define PG8_WAIT_V(n) asm volatile("s_waitcnt vmcnt(" #n ")" ::: "memory")
#define PG8_WAIT_L(n) asm volatile("s_waitcnt lgkmcnt(" #n ")" ::: "memory")
#define PG8_BAR __builtin_amdgcn_s_barrier()
#define PG8_SCHED __builtin_amdgcn_sched_barrier(0)
    Unit cur, nxt; int ui = 0;
    if (!S.next(0, cur)) return;
    f32x4 acc[2][2][4][2];
#pragma unroll
    for (int a = 0; a < 2; ++a)
#pragma unroll
        for (int b = 0; b < 2; ++b)
#pragma unroll
            for (int m = 0; m < 4; ++m)
#pragma unroll
                for (int n = 0; n < 2; ++n) acc[a][b][m][n] = (f32x4){0.f, 0.f, 0.f, 0.f};
    bf16x8 At[4][2], B0[2][2], B1[2][2];
    const char* cA = (const char*)g.A + (size_t)cur.pm * tstep; const char* cB = (const char*)g.Bt + (size_t)cur.pn * tstep;
    PG8_STAGE(PG8_SB(0, 0), cB, voffB); PG8_STAGE(PG8_SA(0, 0), cA, voffA); PG8_STAGE(PG8_SB(0, 1), cB + hstep, voffB); PG8_STAGE(PG8_SA(0, 1), cA + hstep, voffA);
    if (wr == 1) PG8_BAR;
    PG8_WAIT_V(4); PG8_BAR;
    PG8_STAGE(PG8_SB(1, 0), cB + kstep, voffB); PG8_STAGE(PG8_SA(1, 0), cA + kstep, voffA); PG8_STAGE(PG8_SB(1, 1), cB + hstep + kstep, voffB);
    PG8_WAIT_V(6); PG8_BAR;
    for (;;) {
        const bool has_next = S.next(ui + 1, nxt);
        const char* nA = has_next ? (const char*)g.A + (size_t)nxt.pm * tstep : cA; const char* nB = has_next ? (const char*)g.Bt + (size_t)nxt.pn * tstep : cB;
        for (int t = 0; t < nt; t += 2) {
            const bool last = (t == nt - 2);
            const char* a1 = cA + (size_t)(t + 1) * kstep;
            const char* a2 = last ? nA : cA + (size_t)(t + 2) * kstep; const char* b2 = last ? nB : cB + (size_t)(t + 2) * kstep;
            const char* a3 = a2 + kstep; const char* b3 = b2 + kstep;
            PG8_LDB(B0, 0, 0); PG8_SCHED; PG8_LDA(At, 0, 0); PG8_STAGE(PG8_SA(1, 1), a1 + hstep, voffA);
            PG8_WAIT_L(8); PG8_BAR; PG8_WAIT_L(0); PG8_MMA(0, 0, At, B0); PG8_BAR; PG8_SCHED;
            PG8_LDB(B1, 0, 1); PG8_STAGE(PG8_SB(0, 0), b2, voffB);
            PG8_BAR; PG8_WAIT_L(0); PG8_MMA(0, 1, At, B1); PG8_BAR;
            PG8_LDA(At, 0, 1); PG8_STAGE(PG8_SA(0, 0), a2, voffA);
            PG8_BAR; PG8_WAIT_L(0); PG8_MMA(1, 0, At, B0); PG8_BAR; PG8_SCHED;
            PG8_STAGE(PG8_SB(0, 1), b2 + hstep, voffB);
            PG8_WAIT_V(6); PG8_BAR; PG8_MMA(1, 1, At, B1); PG8_BAR;
            PG8_LDB(B0, 1, 0); PG8_SCHED; PG8_LDA(At, 1, 0); PG8_STAGE(PG8_SA(0, 1), a2 + hstep, voffA);
            PG8_WAIT_L(8); PG8_BAR; PG8_WAIT_L(0); PG8_MMA(0, 0, At, B0); PG8_BAR; PG8_SCHED;
            PG8_LDB(B1, 1, 1); PG8_STAGE(PG8_SB(1, 0), b3, voffB);
            PG8_BAR; PG8_WAIT_L(0); PG8_MMA(0, 1, At, B1); PG8_BAR;
            PG8_LDA(At, 1, 1); PG8_STAGE(PG8_SA(1, 0), a3, voffA);
            PG8_BAR; PG8_WAIT_L(0); PG8_MMA(1, 0, At, B0); PG8_BAR; PG8_SCHED;
            PG8_STAGE(PG8_SB(1, 1), b3 + hstep, voffB);
            PG8_WAIT_V(6); PG8_BAR; PG8_MMA(1, 1, At, B1); PG8_BAR;
        }
        if constexpr (!Epi::AFTER_DRAIN) E(acc, cur, wr, wc, fr, fq);
        if (!has_next) break;
#pragma unroll
        for (int a = 0; a < 2; ++a)
#pragma unroll
            for (int b = 0; b < 2; ++b)
#pragma unroll
                for (int m = 0; m < 4; ++m)
#pragma unroll
                    for (int n = 0; n < 2; ++n) acc[a][b][m][n] = (f32x4){0.f, 0.f, 0.f, 0.f};
        cur = nxt; cA = nA; cB = nB; ++ui;
    }
    PG8_WAIT_V(0);
    if (wr == 0) PG8_BAR;
    PG8_BAR;
    if constexpr (Epi::AFTER_DRAIN) E(acc, cur, wr, wc, fr, fq);
#undef PG8_SA
#undef PG8_SB
#undef PG8_STAGE
#undef PG8_LDA
#undef PG8_LDB
#undef PG8_MMA
#undef PG8_WAIT_V
#undef PG8_WAIT_L
#undef PG8_BAR
#undef PG8_SCHED
}
}

DI void tr_tile(const float* src, int ld_src, int k0, int c0, bf16_t* dst, int ld_dst, int n0, float* lds) {
    const int tid = otid();
#pragma unroll
    for (int pass = 0; pass < 2; ++pass) { const int r = pass * 32 + (tid >> 4), c4 = (tid & 15) * 4;
        const f32x4 v = *(const f32x4*)(src + (size_t)(k0 + r) * ld_src + c0 + c4);
        lds[r * 65 + c4 + 0] = v[0]; lds[r * 65 + c4 + 1] = v[1]; lds[r * 65 + c4 + 2] = v[2]; lds[r * 65 + c4 + 3] = v[3]; }
    __syncthreads();
    const int nn = tid >> 3, kc = (tid & 7) * 8;
    float o[8];
#pragma unroll
    for (int e = 0; e < 8; ++e) o[e] = lds[(kc + e) * 65 + nn];
    *(u32x4*)(dst + (size_t)(n0 + nn) * ld_dst + k0 + kc) = pack8(o);
    __syncthreads();
}

DI void phase_prep(KP pk_in, unsigned char* lds) {
    KP pk = pk_in; asm volatile("" : "+s"(pk));
    unsigned char* ws = pk->ws;
    const int bidx_ = obid(); const size_t gtid = (size_t)bidx_ * 512 + otid(), nthr = (size_t)gridDim.x * 512;
    { bf16_t* xb = (bf16_t*)(ws + W_XB);
      for (size_t v = gtid; v < (size_t)NTOK * 128; v += nthr) { const float* s = v < (size_t)NTOKP * 128 ? pk->x_prompt + v * 8 : pk->x_sample + (v - (size_t)NTOKP * 128) * 8;
          const f32x4 a = *(const f32x4*)s, b = *(const f32x4*)(s + 4); float o[8] = {a[0], a[1], a[2], a[3], b[0], b[1], b[2], b[3]}; *(u32x4*)(xb + v * 8) = pack8(o); } }
    { bf16_t* mb = (bf16_t*)(ws + W_MEMB);
      for (size_t v = gtid; v < (size_t)2048 * 128; v += nthr) { const float* s = pk->mem_prompt + v * 8;
          const f32x4 a = *(const f32x4*)s, b = *(const f32x4*)(s + 4); float o[8] = {a[0], a[1], a[2], a[3], b[0], b[1], b[2], b[3]}; *(u32x4*)(mb + v * 8) = pack8(o); } }
    { bf16_t* wd = (bf16_t*)(ws + W_WDTT); float* wf = (float*)(ws + W_WDTF);
      for (size_t i = gtid; i < 16 * 1024; i += nthr) { const int h = (int)(i >> 10), k = (int)(i & 1023); const float v = pk->w_in[(size_t)k * DIN + 4608 + h]; wd[i] = f2bf(v); wf[i] = v; } }
    { bf16_t* wg = (bf16_t*)(ws + W_WGT);
      for (size_t i = gtid; i < (size_t)8 * 4 * 64 * 128; i += nthr) { const int k = (int)(i >> 15), qd = (int)(i >> 13) & 3, nn = (int)(i >> 7) & 63, ii = (int)(i & 127);
          const float v = nn < 32 ? pk->w_rg_a[((size_t)k * 128 + ii) * 128 + qd * 32 + nn] : pk->w_rg_i[((size_t)k * 128 + ii) * 128 + qd * 32 + nn - 32]; wg[i] = f2bf(v); } }
    float* tl = (float*)lds;
    for (int t = bidx_; t < 1664 + 768 + 512; t += gridDim.x) {
        if (t < 1664) { const int kt = t & 15, ntile = t >> 4; const int n0 = ntile * 64, c0 = n0 < 4608 ? n0 : n0 + 16;
            tr_tile(pk->w_in, DIN, kt * 64, c0, (bf16_t*)(ws + W_WINT), 1024, n0, tl); }
        else if (t < 1664 + 768) { const int u = t - 1664; const int kt = u % 48, ntile = u / 48;
            tr_tile(pk->w_out, 1024, kt * 64, ntile * 64, (bf16_t*)(ws + W_WOUTT), 3072, ntile * 64, tl); }
        else { const int u = t - 1664 - 768; const int kt = u & 15, ntile = u >> 4; const int n0 = ntile * 64;
            if (n0 < 1024) tr_tile(pk->w_mem_k, 1024, kt * 64, n0, (bf16_t*)(ws + W_WKVT), 1024, n0, tl);
            else tr_tile(pk->w_mem_v, 1024, kt * 64, n0 - 1024, (bf16_t*)(ws + W_WKVT), 1024, n0, tl); }
    }
}

DI void conv8_ssd_prompt(KP pk, const bf16_t* proj, int rowbase, int t, int ch, float (&o)[8]) {
    const f32x4 b0 = *(const f32x4*)(pk->ssd_conv_b + ch), b1 = *(const f32x4*)(pk->ssd_conv_b + ch + 4);
    float acc[8] = {b0[0], b0[1], b0[2], b0[3], b1[0], b1[1], b1[2], b1[3]};
    u32x4 vv[4];
#pragma unroll
    for (int kk = 0; kk < 4; ++kk) { const int tt = t - 3 + kk; vv[kk] = *(const u32x4*)(proj + (size_t)(rowbase + (tt < 0 ? 0 : tt)) * NPROJ + C_XBC + ch); }
#pragma unroll
    for (int kk = 0; kk < 4; ++kk) { const int tt = t - 3 + kk; const float msk = tt >= 0 ? 1.f : 0.f; float x[8]; unpack8(vv[kk], x);
            const f32x4 w0 = *(const f32x4*)(pk->ssd_conv_w + kk * 1536 + ch) * msk, w1 = *(const f32x4*)(pk->ssd_conv_w + kk * 1536 + ch + 4) * msk;
            acc[0] += x[0] * w0[0]; acc[1] += x[1] * w0[1]; acc[2] += x[2] * w0[2]; acc[3] += x[3] * w0[3];
            acc[4] += x[4] * w1[0]; acc[5] += x[5] * w1[1]; acc[6] += x[6] * w1[2]; acc[7] += x[7] * w1[3]; }
#pragma unroll
    for (int e = 0; e < 8; ++e) o[e] = siluf(acc[e]);
}

DI void ssd1_item(KP pk_in, unsigned char* lds, int b, int c, int g) {
    KP pk = pk_in; asm volatile("" : "+s"(pk));
    unsigned char* ws = pk->ws;
    const int tid = otid(), w = tid >> 6, lane = tid & 63, l15 = lane & 15, q = lane >> 4;
    float* dt_s = (float*)lds; float* acum_s = dt_s + 2048; float* w_s = acum_s + 2048; float* seg_s = w_s + 1024;
    bf16_t* BT = (bf16_t*)(lds + 22528); bf16_t* xsT = (bf16_t*)(lds + 22528 + 34816);
    const bf16_t* xb = (const bf16_t*)(ws + W_XB); const bf16_t* wdt = (const bf16_t*)(ws + W_WDTT); const bf16_t* proj = (const bf16_t*)(ws + W_PROJ);
    bf16_t* xact = (bf16_t*)(ws + W_XACT); float* dt_g = (float*)(ws + W_DT); float* acum_g = (float*)(ws + W_ACUM); float* cd_g = (float*)(ws + W_CD); bf16_t* st_g = (bf16_t*)(ws + W_ST);
    const int tok0 = b * 2048 + c * 128;
    __syncthreads();
    { f32x4 acc = {0.f, 0.f, 0.f, 0.f}; const bf16_t* ap = xb + (size_t)(tok0 + 16 * w + l15) * 1024 + q * 8; const bf16_t* bp = wdt + l15 * 1024 + q * 8;
#pragma unroll 8
      for (int ks = 0; ks < 32; ++ks) { const bf16x8 a = *(const bf16x8*)(ap + ks * 32); const bf16x8 bb = *(const bf16x8*)(bp + ks * 32); acc = MFMA16(a, bb, acc); }
      const float bias = pk->ssd_dt_bias[l15];
#pragma unroll
      for (int r = 0; r < 4; ++r) { const int i = 16 * w + 4 * q + r; const float dt = softplusf(acc[r] + bias); dt_s[i * 16 + l15] = dt; dt_g[(size_t)(tok0 + i) * 16 + l15] = dt; } }
    __syncthreads();
    { const int hd = tid & 15, sg = tid >> 4; const float ah = -__expf(pk->ssd_a_log[hd]); float loc[8]; float run = 0.f;
      if (tid < 256) {
#pragma unroll
          for (int i = 0; i < 8; ++i) { run += dt_s[(sg * 8 + i) * 16 + hd] * ah; loc[i] = run; }
          seg_s[sg * 16 + hd] = run; }
      __syncthreads();
      if (tid < 256) { float off = 0.f; for (int s2 = 0; s2 < sg; ++s2) off += seg_s[s2 * 16 + hd];
#pragma unroll
          for (int i = 0; i < 8; ++i) { const float v = loc[i] + off; acum_s[(sg * 8 + i) * 16 + hd] = v; acum_g[(size_t)(tok0 + sg * 8 + i) * 16 + hd] = v; } } }
    __syncthreads();
    if (tid < 8) cd_g[(b * 16 + c) * 16 + 8 * g + tid] = __expf(acum_s[127 * 16 + 8 * g + tid]);
    for (int idx = tid; idx < 1024; idx += 512) { const int j = idx >> 3, hl = idx & 7, h = 8 * g + hl; w_s[idx] = dt_s[j * 16 + h] * __expf(acum_s[127 * 16 + h] - acum_s[j * 16 + h]); }
    const int cv = (tid & 31) * 8, jg = tid >> 5;
    for (int pass = 0; pass < 3; ++pass) {
        const int ch = pass == 0 ? (cv < 128 ? 1024 + g * 128 + cv : 1280 + g * 128 + (cv - 128)) : g * 512 + (pass - 1) * 256 + cv;
        float wgt[4][8], bs[8];
        { const f32x4 b0 = *(const f32x4*)(pk->ssd_conv_b + ch), b1 = *(const f32x4*)(pk->ssd_conv_b + ch + 4);
          bs[0] = b0[0]; bs[1] = b0[1]; bs[2] = b0[2]; bs[3] = b0[3]; bs[4] = b1[0]; bs[5] = b1[1]; bs[6] = b1[2]; bs[7] = b1[3];
#pragma unroll
          for (int kk = 0; kk < 4; ++kk) { const f32x4 w0 = *(const f32x4*)(pk->ssd_conv_w + kk * 1536 + ch), w1 = *(const f32x4*)(pk->ssd_conv_w + kk * 1536 + ch + 4);
              wgt[kk][0] = w0[0]; wgt[kk][1] = w0[1]; wgt[kk][2] = w0[2]; wgt[kk][3] = w0[3]; wgt[kk][4] = w1[0]; wgt[kk][5] = w1[1]; wgt[kk][6] = w1[2]; wgt[kk][7] = w1[3]; } }
        const bf16_t* src = proj + (size_t)(b * 2048) * NPROJ + C_XBC + ch; const int t0 = c * 128 + jg * 8;
        u32x4 rows[11];
#pragma unroll
        for (int i = 0; i < 11; ++i) { const int tt = t0 - 3 + i; const u32x4 v = *(const u32x4*)(src + (size_t)(tt < 0 ? 0 : tt) * NPROJ); rows[i] = tt < 0 ? (u32x4){0u, 0u, 0u, 0u} : v; }
        if (pass > 0) __syncthreads();
        unsigned tp[8][4];
#pragma unroll
        for (int i = 0; i < 8; i += 2) { float oa[8], ob[8];
#pragma unroll
            for (int hh = 0; hh < 2; ++hh) { float x0[8], x1[8], x2[8], x3[8]; unpack8(rows[i + hh], x0); unpack8(rows[i + hh + 1], x1); unpack8(rows[i + hh + 2], x2); unpack8(rows[i + hh + 3], x3); float o[8];
#pragma unroll
                for (int e = 0; e < 8; ++e) o[e] = siluf(bs[e] + x0[e] * wgt[0][e] + x1[e] * wgt[1][e] + x2[e] * wgt[2][e] + x3[e] * wgt[3][e]);
                const int j = jg * 8 + i + hh;
                *(u32x4*)(xact + (size_t)(tok0 + j) * 1536 + ch) = pack8(o);
                const float wj = pass == 0 ? 1.f : w_s[j * 8 + (pass - 1) * 4 + (cv >> 6)];
#pragma unroll
                for (int e = 0; e < 8; ++e) { if (hh == 0) oa[e] = o[e] * wj; else ob[e] = o[e] * wj; } }
#pragma unroll
            for (int e = 0; e < 8; ++e) tp[e][i >> 1] = pack2(oa[e], ob[e]); }
        if (pass == 0) { if (cv < 128) {
#pragma unroll
            for (int e = 0; e < 8; ++e) { const int rr = cv + e; u32x4 wv; wv.x = tp[e][0]; wv.y = tp[e][1]; wv.z = tp[e][2]; wv.w = tp[e][3]; *(u32x4*)(BT + rr * 136 + ((jg * 8) ^ (((rr >> 3) & 15) << 3))) = wv; } } }
        else {
#pragma unroll
            for (int e = 0; e < 8; ++e) { const int rr = cv + e; u32x4 wv; wv.x = tp[e][0]; wv.y = tp[e][1]; wv.z = tp[e][2]; wv.w = tp[e][3]; *(u32x4*)(xsT + rr * 136 + ((jg * 8) ^ (((rr >> 3) & 15) << 3))) = wv; } }
        if (pass == 0) continue;
        __syncthreads();
        const int pt = w & 3, nh = w >> 2;
#pragma unroll 1
        for (int hq = 0; hq < 4; ++hq) { const int hl = (pass - 1) * 4 + hq;
            f32x4 acc[4];
#pragma unroll
            for (int nt = 0; nt < 4; ++nt) acc[nt] = (f32x4){0.f, 0.f, 0.f, 0.f};
#pragma unroll
            for (int ks = 0; ks < 4; ++ks) { const int ra = hq * 64 + pt * 16 + l15; const bf16x8 a = *(const bf16x8*)(xsT + ra * 136 + ((ks * 32 + q * 8) ^ (((ra >> 3) & 15) << 3)));
#pragma unroll
                for (int nt = 0; nt < 4; ++nt) { const int rb = nh * 64 + nt * 16 + l15; const bf16x8 bb = *(const bf16x8*)(BT + rb * 136 + ((ks * 32 + q * 8) ^ (((rb >> 3) & 15) << 3))); acc[nt] = MFMA16(a, bb, acc[nt]); } }
            bf16_t* sp = st_g + (size_t)(((b * 16 + c) * 16 + 8 * g + hl)) * 8192;
#pragma unroll
            for (int nt = 0; nt < 4; ++nt)
#pragma unroll
                for (int r = 0; r < 4; ++r) sp[(pt * 16 + 4 * q + r) * 128 + nh * 64 + nt * 16 + l15] = f2bf(acc[nt][r]); }
    }
    if (c == 15) {
        for (int idx = tid; idx < 3 * 768; idx += 512) { const int jj = idx / 768, cc = idx % 768; const int ch = cc < 512 ? g * 512 + cc : (cc < 640 ? 1024 + g * 128 + (cc - 512) : 1280 + g * 128 + (cc - 640));
            pk->out[O_SCP + (size_t)(b * 3 + jj) * 1536 + ch] = bf2f(proj[(size_t)(b * 2048 + 2045 + jj) * NPROJ + C_XBC + ch]); }
    }
}

DI void rgconv_item(KP pk_in, int b, int tile) {
    KP pk = pk_in; asm volatile("" : "+s"(pk));
    const int tid = otid();
    const bf16_t* proj = (const bf16_t*)(pk->ws + W_PROJ); bf16_t* mix = (bf16_t*)(pk->ws + W_MIX);
    const int ch = (tid & 127) * 8, t0 = tile * 128 + (tid >> 7) * 32;
    float wgt[4][8], bs[8];
    { const f32x4 b0 = *(const f32x4*)(pk->rg_conv_b + ch), b1 = *(const f32x4*)(pk->rg_conv_b + ch + 4);
      bs[0] = b0[0]; bs[1] = b0[1]; bs[2] = b0[2]; bs[3] = b0[3]; bs[4] = b1[0]; bs[5] = b1[1]; bs[6] = b1[2]; bs[7] = b1[3];
#pragma unroll
      for (int kk = 0; kk < 4; ++kk) { const f32x4 w0 = *(const f32x4*)(pk->rg_conv_w + kk * 1024 + ch), w1 = *(const f32x4*)(pk->rg_conv_w + kk * 1024 + ch + 4);
          wgt[kk][0] = w0[0]; wgt[kk][1] = w0[1]; wgt[kk][2] = w0[2]; wgt[kk][3] = w0[3]; wgt[kk][4] = w1[0]; wgt[kk][5] = w1[1]; wgt[kk][6] = w1[2]; wgt[kk][7] = w1[3]; } }
    const bf16_t* src = proj + (size_t)(b * 2048) * NPROJ + C_RGX + ch;
    u32x4 hist[3];
#pragma unroll
    for (int i = 0; i < 3; ++i) { const int tt = t0 - 3 + i; const u32x4 v = *(const u32x4*)(src + (size_t)(tt < 0 ? 0 : tt) * NPROJ); hist[i] = tt < 0 ? (u32x4){0u, 0u, 0u, 0u} : v; }
    for (int c8 = 0; c8 < 32; c8 += 8) { u32x4 nv[8];
#pragma unroll
        for (int i = 0; i < 8; ++i) nv[i] = *(const u32x4*)(src + (size_t)(t0 + c8 + i) * NPROJ);
#pragma unroll
        for (int i = 0; i < 8; ++i) { float x0[8], x1[8], x2[8], x3[8]; unpack8(hist[0], x0); unpack8(hist[1], x1); unpack8(hist[2], x2); unpack8(nv[i], x3); float acc[8];
#pragma unroll
            for (int e = 0; e < 8; ++e) acc[e] = bs[e] + x0[e] * wgt[0][e] + x1[e] * wgt[1][e] + x2[e] * wgt[2][e] + x3[e] * wgt[3][e];
            *(u32x4*)(mix + (size_t)(b * 2048 + t0 + c8 + i) * DMIX + 1024 + ch) = pack8(acc);
            hist[0] = hist[1]; hist[1] = hist[2]; hist[2] = nv[i]; } }
}

DI void statepass_item(KP pk_in, int sp) {
    KP pk = pk_in; asm volatile("" : "+s"(pk));
    const int b = sp >> 5, h = (sp >> 1) & 15, half = sp & 1; const int e0 = half * 4096 + otid() * 8;
    bf16_t* st_g = (bf16_t*)(pk->ws + W_ST); const float* cd_g = (const float*)(pk->ws + W_CD);
    float run[8] = {0.f, 0.f, 0.f, 0.f, 0.f, 0.f, 0.f, 0.f};
    u32x4 v[16]; float cd[16];
#pragma unroll
    for (int i = 0; i < 16; ++i) { v[i] = *(const u32x4*)(st_g + (size_t)((b * 16 + i) * 16 + h) * 8192 + e0); cd[i] = cd_g[(b * 16 + i) * 16 + h]; }
#pragma unroll
    for (int i = 0; i < 16; ++i) { *(u32x4*)(st_g + (size_t)((b * 16 + i) * 16 + h) * 8192 + e0) = pack8(run); float x[8]; unpack8(v[i], x);
#pragma unroll
        for (int e = 0; e < 8; ++e) run[e] = run[e] * cd[i] + x[e]; }
    float* o = pk->out + O_SHP + (size_t)(b * 16 + h) * 8192 + e0; *(f32x4*)o = (f32x4){run[0], run[1], run[2], run[3]}; *(f32x4*)(o + 4) = (f32x4){run[4], run[5], run[6], run[7]};
}

DI void rg_item(KP pk_in, unsigned char* lds, const bool sample, int bidx, int k, int qd) {
    KP pk = pk_in; asm volatile("" : "+s"(pk));
    unsigned char* ws = pk->ws;
    const int tid = otid(), w = tid >> 6, lane = tid & 63, l15 = lane & 15, q = lane >> 4;
    bf16_t* uA = (bf16_t*)lds;
    float* wagg = (float*)(lds + 34816);
    float* hcar = wagg + 1024;
    bf16_t* wS = (bf16_t*)(lds + 73728);
    const bf16_t* proj = (const bf16_t*)(ws + W_PROJ); bf16_t* mix = (bf16_t*)(ws + W_MIX);
    const bf16_t* wg = (const bf16_t*)(ws + W_WGT) + (size_t)((k * 4 + qd) * 64) * 128;
    __syncthreads();
    for (int idx = tid; idx < 1024; idx += 512) { const int n = idx >> 4, c8 = (idx & 15) * 8; *(u32x4*)(wS + n * 136 + c8) = *(const u32x4*)(wg + n * 128 + c8); }
    if (tid < 64) hcar[tid] = 0.f;
    float ba[2], bi[2], spl[2];
#pragma unroll
    for (int ntl = 0; ntl < 2; ++ntl) { const int ch = k * 128 + qd * 32 + ntl * 16 + l15; ba[ntl] = pk->b_rg_a[ch]; bi[ntl] = pk->b_rg_i[ch]; spl[ntl] = softplusf(-pk->rg_lambda[ch]); }
    const int ntiles = sample ? 1 : 16;
    const int crow = tid >> 2, cg0 = (tid & 3) * 32;
    const bf16_t* ug = mix + 1024;
    u32x4 av[4]; bf16_t uv[8];
#define RG_LOADP(TILE) do { const size_t r0 = (size_t)(bidx * 2048 + (TILE) * 128 + 16 * w); \
        _Pragma("unroll") for (int ks = 0; ks < 4; ++ks) av[ks] = *(const u32x4*)(ug + (r0 + l15) * DMIX + k * 128 + ks * 32 + q * 8); \
        _Pragma("unroll") for (int ntl = 0; ntl < 2; ++ntl) _Pragma("unroll") for (int r = 0; r < 4; ++r) uv[ntl * 4 + r] = ug[(r0 + 4 * q + r) * DMIX + k * 128 + qd * 32 + ntl * 16 + l15]; } while (0)
    if (!sample) RG_LOADP(0);
    bf16x8 afr[4]; float uvf[8];
    for (int tile = 0; tile < ntiles; ++tile) {
        const int par = tile & 1;
        bf16_t gtr[8];
        const size_t rowb = sample ? (size_t)(NTOKP + bidx * 128 + 16 * w + 4 * q) : (size_t)(bidx * 2048 + tile * 128 + 16 * w + 4 * q);
        if (!sample) {
#pragma unroll
          for (int ks = 0; ks < 4; ++ks) afr[ks] = as_frag(av[ks]);
#pragma unroll
          for (int e = 0; e < 8; ++e) uvf[e] = bf2f(uv[e]);
          if (tile + 1 < 16) RG_LOADP(tile + 1);
        } else { const int row = crow;
          __syncthreads();
#pragma unroll
          for (int v = 0; v < 4; ++v) { const int c8 = cg0 + v * 8, ch = k * 128 + c8;
              const f32x4 b0 = *(const f32x4*)(pk->rg_conv_b + ch), b1 = *(const f32x4*)(pk->rg_conv_b + ch + 4);
              float acc[8] = {b0[0], b0[1], b0[2], b0[3], b1[0], b1[1], b1[2], b1[3]};
#pragma unroll
              for (int kk = 0; kk < 4; ++kk) { float x[8];
                  { const int sbi = bidx * 32 + (row >> 2), ui = (row & 3) + kk; const bool st = ui < 3;
                      const float* sp_ = pk->state_rg_conv + (size_t)(sbi * 3 + (st ? ui : 2)) * 1024 + ch; const f32x4 s0 = *(const f32x4*)sp_, s1 = *(const f32x4*)(sp_ + 4);
                      const u32x4 vv = *(const u32x4*)(proj + (size_t)(NTOKP + sbi * 4 + (st ? 0 : ui - 3)) * NPROJ + C_RGX + ch); unpack8(vv, x);
                      x[0] = st ? s0[0] : x[0]; x[1] = st ? s0[1] : x[1]; x[2] = st ? s0[2] : x[2]; x[3] = st ? s0[3] : x[3];
                      x[4] = st ? s1[0] : x[4]; x[5] = st ? s1[1] : x[5]; x[6] = st ? s1[2] : x[6]; x[7] = st ? s1[3] : x[7]; }
                  { const f32x4 w0 = *(const f32x4*)(pk->rg_conv_w + kk * 1024 + ch), w1 = *(const f32x4*)(pk->rg_conv_w + kk * 1024 + ch + 4);
                      acc[0] += x[0] * w0[0]; acc[1] += x[1] * w0[1]; acc[2] += x[2] * w0[2]; acc[3] += x[3] * w0[3];
                      acc[4] += x[4] * w1[0]; acc[5] += x[5] * w1[1]; acc[6] += x[6] * w1[2]; acc[7] += x[7] * w1[3]; } }
              *(u32x4*)(uA + row * 136 + c8) = pack8(acc); }
        }
#pragma unroll
        for (int ntl = 0; ntl < 2; ++ntl)
#pragma unroll
            for (int r = 0; r < 4; ++r) gtr[ntl * 4 + r] = proj[(rowb + r) * NPROJ + C_RGG + k * 128 + qd * 32 + ntl * 16 + l15];
        __syncthreads();
        f32x4 acc[4];
#pragma unroll
        for (int nt = 0; nt < 4; ++nt) acc[nt] = (f32x4){0.f, 0.f, 0.f, 0.f};
#pragma unroll
        for (int ks = 0; ks < 4; ++ks) { const bf16x8 a = sample ? *(const bf16x8*)(uA + (16 * w + l15) * 136 + ks * 32 + q * 8) : afr[ks];
#pragma unroll
            for (int nt = 0; nt < 4; ++nt) { const bf16x8 bb = *(const bf16x8*)(wS + (nt * 16 + l15) * 136 + ks * 32 + q * 8); acc[nt] = MFMA16(a, bb, acc[nt]); } }
        float Ap[2][4], Bp[2][4];
#pragma unroll
        for (int ntl = 0; ntl < 2; ++ntl) { float A = 1.f, B = 0.f;
#pragma unroll
            for (int r = 0; r < 4; ++r) { const int row = 16 * w + 4 * q + r, cl = ntl * 16 + l15;
                const float rr = sigmf(acc[ntl][r] + ba[ntl]), ii = sigmf(acc[2 + ntl][r] + bi[ntl]);
                const float la = -8.f * rr * spl[ntl]; float a = __expf(la); const float uval = sample ? bf2f(uA[row * 136 + qd * 32 + cl]) : uvf[ntl * 4 + r];
                float bt = __builtin_amdgcn_sqrtf(fmaxf(1.f - a * a, 0.f)) * ii * uval;
                const bool first = sample ? (r == 0) : (tile == 0 && row == 0);
                if (first) { const float h0 = sample ? pk->state_rg_h[(size_t)(bidx * 32 + (row >> 2)) * 1024 + k * 128 + qd * 32 + cl] : 0.f; bt += a * h0; a = 0.f; }
                B = a * B + bt; A = a * A; Ap[ntl][r] = A; Bp[ntl][r] = B; } }
        float hq[2], Aex[2], Bex[2];
#pragma unroll
        for (int ntl = 0; ntl < 2; ++ntl) { float A = Ap[ntl][3], B = Bp[ntl][3];
            { const float Ao = shl(A, lane - 16), Bo = shl(B, lane - 16); if (q >= 1) { B = A * Bo + B; A = A * Ao; } }
            { const float Ao = shl(A, lane - 32), Bo = shl(B, lane - 32); if (q >= 2) { B = A * Bo + B; A = A * Ao; } }
            if (q == 3) { wagg[((par * 2 + 0) * 8 + w) * 32 + ntl * 16 + l15] = A; wagg[((par * 2 + 1) * 8 + w) * 32 + ntl * 16 + l15] = B; }
            float Ae = shl(A, lane - 16), Be = shl(B, lane - 16); if (q == 0) { Ae = 1.f; Be = 0.f; }
            Aex[ntl] = Ae; Bex[ntl] = Be; }
        __syncthreads();
#pragma unroll
        for (int ntl = 0; ntl < 2; ++ntl) { const int cl = ntl * 16 + l15; float hin = hcar[par * 32 + cl];
            for (int ww = 0; ww < w; ++ww) hin = wagg[((par * 2 + 0) * 8 + ww) * 32 + cl] * hin + wagg[((par * 2 + 1) * 8 + ww) * 32 + cl];
            hq[ntl] = Aex[ntl] * hin + Bex[ntl];
            if (w == 7 && q == 3) hcar[(par ^ 1) * 32 + cl] = Ap[ntl][3] * hq[ntl] + Bp[ntl][3]; }
#pragma unroll
        for (int ntl = 0; ntl < 2; ++ntl)
#pragma unroll
            for (int r = 0; r < 4; ++r) { const float h = Ap[ntl][r] * hq[ntl] + Bp[ntl][r]; const int chg = k * 128 + qd * 32 + ntl * 16 + l15;
                mix[(rowb + r) * DMIX + chg] = f2bf(h * siluf(bf2f(gtr[ntl * 4 + r])));
                if (sample) { if (r == 3) pk->out[O_RGHS + (size_t)(bidx * 32 + 4 * w + q) * 1024 + chg] = h; }
                else if (tile == 15 && w == 7 && q == 3 && r == 3) pk->out[O_RGHP + (size_t)bidx * 1024 + chg] = h; }
    }
#undef RG_LOADP
    if (!sample) { if (tid < 96) { const int jj = tid >> 5, cl = tid & 31, chg = k * 128 + qd * 32 + cl;
            pk->out[O_RGCP + (size_t)(bidx * 3 + jj) * 1024 + chg] = bf2f(proj[(size_t)(bidx * 2048 + 2045 + jj) * NPROJ + C_RGX + chg]); } }
    else { for (int idx = tid; idx < 32 * 3 * 32; idx += 512) { const int cl = idx & 31, jj = (idx >> 5) % 3, sl = idx / 96; const int sbi = bidx * 32 + sl, chg = k * 128 + qd * 32 + cl;
            pk->out[O_RGCS + (size_t)(sbi * 3 + jj) * 1024 + chg] = bf2f(proj[(size_t)(NTOKP + sbi * 4 + 1 + jj) * NPROJ + C_RGX + chg]); } }
}

DI void attnp_item(KP pk_in, unsigned char* lds, int b, int head, int qt) {
    KP pk = pk_in; asm volatile("" : "+s"(pk));
    unsigned char* ws = pk->ws;
    const int tid = otid(), w = tid >> 6, lane = tid & 63, l15 = lane & 15, q = lane >> 4;
    const bf16_t* proj = (const bf16_t*)(ws + W_PROJ); const bf16_t* kb = (const bf16_t*)(ws + W_KB); const bf16_t* vt = (const bf16_t*)(ws + W_VT); bf16_t* mix = (bf16_t*)(ws + W_MIX);
    const int tokb = b * 2048 + qt * 128 + 16 * w;
    constexpr int RS = 264;
    bf16_t* sm = (bf16_t*)lds;
    const int lr = tid >> 5, lc = (tid & 31) * 8;
    const bf16_t* kbase = kb + (size_t)(b * 256) * 1024 + head * 256; const bf16_t* vbase = vt + (size_t)((b * 4 + head) * 256) * 256;
    u32x4 pre[8];
#define AT_LOAD(S) do { _Pragma("unroll") for (int i = 0; i < 8; ++i) { const int r = lr + 16 * i; \
        pre[i] = (S) < 2 ? *(const u32x4*)(kbase + (size_t)(128 * (S) + r) * 1024 + lc) : *(const u32x4*)(vbase + (size_t)(128 * ((S) - 2) + r) * 256 + lc); } } while (0)
#define AT_STORE() do { _Pragma("unroll") for (int i = 0; i < 8; ++i) *(u32x4*)(sm + (lr + 16 * i) * RS + lc) = pre[i]; } while (0)
    AT_LOAD(0);
    bf16x8 qf[8];
#pragma unroll
    for (int ks = 0; ks < 8; ++ks) qf[ks] = *(const bf16x8*)(proj + (size_t)(tokb + l15) * NPROJ + C_Q + head * 256 + ks * 32 + q * 8);
    f32x4 st[16];
#pragma unroll
    for (int s = 0; s < 2; ++s) {
        __syncthreads(); AT_STORE(); __syncthreads(); AT_LOAD(s + 1);
#pragma unroll
        for (int mtl = 0; mtl < 8; ++mtl) { const int mt = 8 * s + mtl; st[mt] = (f32x4){0.f, 0.f, 0.f, 0.f}; const bf16_t* kp = sm + (16 * mtl + l15) * RS + q * 8;
#pragma unroll
            for (int ks = 0; ks < 8; ++ks) { const bf16x8 kf = *(const bf16x8*)(kp + ks * 32); st[mt] = MFMA16(kf, qf[ks], st[mt]); } }
    }
    float mx = -3.0e38f;
#pragma unroll
    for (int mt = 0; mt < 16; ++mt)
#pragma unroll
        for (int r = 0; r < 4; ++r) { st[mt][r] *= 0.0625f; mx = fmaxf(mx, st[mt][r]); }
    mx = fmaxf(mx, shx(mx, 16, lane)); mx = fmaxf(mx, shx(mx, 32, lane));
    float l = 0.f;
#pragma unroll
    for (int mt = 0; mt < 16; ++mt)
#pragma unroll
        for (int r = 0; r < 4; ++r) { const float e = __expf(st[mt][r] - mx); st[mt][r] = e; l += e; }
    l += shx(l, 16, lane); l += shx(l, 32, lane);
    bf16x8 pf[8];
#pragma unroll
    for (int s = 0; s < 8; ++s) { float m8[8] = {st[2 * s][0], st[2 * s][1], st[2 * s][2], st[2 * s][3], st[2 * s + 1][0], st[2 * s + 1][1], st[2 * s + 1][2], st[2 * s + 1][3]}; pf[s] = as_frag(pack8(m8)); }
    float linv[4];
#pragma unroll
    for (int r = 0; r < 4; ++r) linv[r] = 1.f / shl(l, 4 * q + r);
#pragma unroll
    for (int s2 = 0; s2 < 2; ++s2) {
        __syncthreads(); AT_STORE(); __syncthreads(); if (s2 == 0) AT_LOAD(3);
#pragma unroll
        for (int dtl = 0; dtl < 8; ++dtl) { const int dt = 8 * s2 + dtl; f32x4 o = {0.f, 0.f, 0.f, 0.f}; const bf16_t* vp = sm + (16 * dtl + l15) * RS + 4 * q;
            float gt[4];
#pragma unroll
            for (int r = 0; r < 4; ++r) gt[r] = bf2f(proj[(size_t)(tokb + 4 * q + r) * NPROJ + C_XG + head * 256 + 16 * dt + l15]);
#pragma unroll
            for (int s = 0; s < 8; ++s) { const u32x2 lo = *(const u32x2*)(vp + 32 * s), hi = *(const u32x2*)(vp + 32 * s + 16); o = MFMA16(pf[s], frag2(lo, hi), o); }
#pragma unroll
            for (int r = 0; r < 4; ++r) { const size_t tok = (size_t)(tokb + 4 * q + r); const int d = 16 * dt + l15;
                mix[tok * DMIX + 2048 + head * 256 + d] = f2bf(o[r] * linv[r] * siluf(gt[r])); } }
    }
#undef AT_LOAD
#undef AT_STORE
}

DI float wave_sum(float v, int lane) { v += shx(v, 32, lane); v += shx(v, 16, lane); v += shx(v, 8, lane); v += shx(v, 4, lane); v += shx(v, 2, lane); v += shx(v, 1, lane); return v; }
DI float wave_max(float v, int lane) { v = fmaxf(v, shx(v, 32, lane)); v = fmaxf(v, shx(v, 16, lane)); v = fmaxf(v, shx(v, 8, lane)); v = fmaxf(v, shx(v, 4, lane)); v = fmaxf(v, shx(v, 2, lane)); v = fmaxf(v, shx(v, 1, lane)); return v; }

DI void attns_item(KP pk_in, unsigned char* lds, int sbi, int head) {
    KP pk = pk_in; asm volatile("" : "+s"(pk));
    unsigned char* ws = pk->ws;
    const int tid = otid(), w = tid >> 6, lane = tid & 63;
    const bf16_t* proj = (const bf16_t*)(ws + W_PROJ); bf16_t* mix = (bf16_t*)(ws + W_MIX);
    float* qs = (float*)lds; float* sc = qs + 1024; float* ored = sc + 1024;
    __syncthreads();
    for (int idx = tid; idx < 1024; idx += 512) { const int t = idx >> 8, d = idx & 255; qs[idx] = bf2f(proj[(size_t)(NTOKP + sbi * 4 + t) * NPROJ + C_Q + head * 256 + d]); }
    __syncthreads();
    f32x4 qv[4];
#pragma unroll
    for (int t = 0; t < 4; ++t) qv[t] = *(const f32x4*)(qs + t * 256 + lane * 4);
    for (int m0 = w; m0 < 256; m0 += 64) { f32x4 kv[8];
#pragma unroll
        for (int i = 0; i < 8; ++i) kv[i] = *(const f32x4*)(pk->cache_k + ((size_t)(sbi * 256 + m0 + 8 * i) * 4 + head) * 256 + lane * 4);
        float v32[32];
#pragma unroll
        for (int i = 0; i < 8; ++i)
#pragma unroll
            for (int t = 0; t < 4; ++t) v32[i * 4 + t] = kv[i][0] * qv[t][0] + kv[i][1] * qv[t][1] + kv[i][2] * qv[t][2] + kv[i][3] * qv[t][3];
        float v16[16], v8[8], v4[4], v2[2];
        { const bool up = (lane & 32) != 0;
#pragma unroll
          for (int i = 0; i < 16; ++i) { const float keep = up ? v32[i + 16] : v32[i], send = up ? v32[i] : v32[i + 16]; v16[i] = keep + shx(send, 32, lane); } }
        { const bool up = (lane & 16) != 0;
#pragma unroll
          for (int i = 0; i < 8; ++i) { const float keep = up ? v16[i + 8] : v16[i], send = up ? v16[i] : v16[i + 8]; v8[i] = keep + shx(send, 16, lane); } }
        { const bool up = (lane & 8) != 0;
#pragma unroll
          for (int i = 0; i < 4; ++i) { const float keep = up ? v8[i + 4] : v8[i], send = up ? v8[i] : v8[i + 4]; v4[i] = keep + shx(send, 8, lane); } }
        { const bool up = (lane & 4) != 0;
#pragma unroll
          for (int i = 0; i < 2; ++i) { const float keep = up ? v4[i + 2] : v4[i], send = up ? v4[i] : v4[i + 2]; v2[i] = keep + shx(send, 4, lane); } }
        float v1; { const bool up = (lane & 2) != 0; const float keep = up ? v2[1] : v2[0], send = up ? v2[0] : v2[1]; v1 = keep + shx(send, 2, lane); }
        v1 += shx(v1, 1, lane);
        if ((lane & 1) == 0) { const int ii = lane >> 1; sc[(ii & 3) * 256 + m0 + 8 * (ii >> 2)] = v1 * 0.0625f; } }
    __syncthreads();
    if (w < 4) { const f32x4 v = *(const f32x4*)(sc + w * 256 + lane * 4); float mx = fmaxf(fmaxf(v[0], v[1]), fmaxf(v[2], v[3])); mx = wave_max(mx, lane);
        f32x4 e; e[0] = __expf(v[0] - mx); e[1] = __expf(v[1] - mx); e[2] = __expf(v[2] - mx); e[3] = __expf(v[3] - mx); float s = wave_sum(e[0] + e[1] + e[2] + e[3], lane); const float inv = 1.f / s;
        *(f32x4*)(sc + w * 256 + lane * 4) = e * inv; }
    __syncthreads();
    f32x4 acc[4];
#pragma unroll
    for (int t = 0; t < 4; ++t) acc[t] = (f32x4){0.f, 0.f, 0.f, 0.f};
    for (int m0 = w; m0 < 256; m0 += 64) { f32x4 vv[8];
#pragma unroll
        for (int i = 0; i < 8; ++i) vv[i] = *(const f32x4*)(pk->cache_v + ((size_t)(sbi * 256 + m0 + 8 * i) * 4 + head) * 256 + lane * 4);
#pragma unroll
        for (int i = 0; i < 8; ++i)
#pragma unroll
            for (int t = 0; t < 4; ++t) acc[t] += vv[i] * sc[t * 256 + m0 + 8 * i]; }
#pragma unroll
    for (int t = 0; t < 4; ++t) *(f32x4*)(ored + (w * 4 + t) * 256 + lane * 4) = acc[t];
    __syncthreads();
    for (int idx = tid; idx < 1024; idx += 512) { const int t = idx >> 8, d = idx & 255; float s = 0.f;
#pragma unroll
        for (int ww = 0; ww < 8; ++ww) s += ored[(ww * 4 + t) * 256 + d];
        const size_t tok = (size_t)(NTOKP + sbi * 4 + t); const float gate = bf2f(proj[tok * NPROJ + C_XG + head * 256 + d]); mix[tok * DMIX + 2048 + head * 256 + d] = f2bf(s * siluf(gate)); }
}

DI void ssds_item(KP pk_in, unsigned char* lds, int sbi, int g) {
    KP pk = pk_in; asm volatile("" : "+s"(pk));
    unsigned char* ws = pk->ws;
    const int tid = otid(), w = tid >> 6, lane = tid & 63;
    const bf16_t* proj = (const bf16_t*)(ws + W_PROJ); bf16_t* mix = (bf16_t*)(ws + W_MIX); const float* wdf = (const float*)(ws + W_WDTF);
    float* xs = (float*)lds; float* Bs = xs + 2048; float* Cs = Bs + 512; float* yg = Cs + 512; float* dts = yg + 2048; float* decs = dts + 32;
    __syncthreads();
#pragma unroll
    for (int d = 0; d < 4; ++d) { const int pi = w * 4 + d, t = pi & 3, hl = pi >> 2, h = 8 * g + hl; float s = 0.f;
#pragma unroll
        for (int i = 0; i < 4; ++i) { const f32x4 xv = *(const f32x4*)(pk->x_sample + (size_t)(sbi * 4 + t) * 1024 + i * 256 + lane * 4), wv = *(const f32x4*)(wdf + h * 1024 + i * 256 + lane * 4);
            s += xv[0] * wv[0] + xv[1] * wv[1] + xv[2] * wv[2] + xv[3] * wv[3]; }
        s = wave_sum(s, lane);
        if (lane == 0) { const float dt = softplusf(s + pk->ssd_dt_bias[h]); dts[t * 8 + hl] = dt; decs[t * 8 + hl] = __expf(-dt * __expf(pk->ssd_a_log[h])); } }
    for (int idx = tid; idx < 4 * 768; idx += 512) { const int t = idx / 768, cc = idx % 768; const int ch = cc < 512 ? g * 512 + cc : (cc < 640 ? 1024 + g * 128 + (cc - 512) : 1280 + g * 128 + (cc - 640));
        float acc = pk->ssd_conv_b[ch];
#pragma unroll
        for (int kk = 0; kk < 4; ++kk) { const int ui = t + kk; const bool st = ui < 3;
            const float xs_ = pk->state_ssd_conv[(size_t)(sbi * 3 + (st ? ui : 2)) * 1536 + ch]; const float xp_ = bf2f(proj[(size_t)(NTOKP + sbi * 4 + (st ? 0 : ui - 3)) * NPROJ + C_XBC + ch]);
            acc += (st ? xs_ : xp_) * pk->ssd_conv_w[kk * 1536 + ch]; }
        const float a = siluf(acc);
        if (cc < 512) xs[t * 512 + cc] = a; else if (cc < 640) Bs[t * 128 + cc - 512] = a; else Cs[t * 128 + cc - 640] = a; }
    for (int idx = tid; idx < 3 * 768; idx += 512) { const int jj = idx / 768, cc = idx % 768; const int ch = cc < 512 ? g * 512 + cc : (cc < 640 ? 1024 + g * 128 + (cc - 512) : 1280 + g * 128 + (cc - 640));
        pk->out[O_SCS + (size_t)(sbi * 3 + jj) * 1536 + ch] = bf2f(proj[(size_t)(NTOKP + sbi * 4 + 1 + jj) * NPROJ + C_XBC + ch]); }
    __syncthreads();
    const int pp = tid >> 3, n0 = (tid & 7) * 16;
    f32x4 bvr[4][4], cvr[4][4];
#pragma unroll
    for (int t = 0; t < 4; ++t)
#pragma unroll
        for (int v = 0; v < 4; ++v) { bvr[t][v] = *(const f32x4*)(Bs + t * 128 + n0 + v * 4); cvr[t][v] = *(const f32x4*)(Cs + t * 128 + n0 + v * 4); }
    f32x4 hs[4], hn[4];
#pragma unroll
    for (int v = 0; v < 4; ++v) hn[v] = *(const f32x4*)(pk->state_ssd_h + ((size_t)(sbi * 16 + 8 * g) * 64 + pp) * 128 + n0 + v * 4);
    for (int hl = 0; hl < 8; ++hl) { const int h = 8 * g + hl; const size_t so = ((size_t)(sbi * 16 + h) * 64 + pp) * 128 + n0;
#pragma unroll
        for (int v = 0; v < 4; ++v) hs[v] = hn[v];
        if (hl < 7) {
#pragma unroll
            for (int v = 0; v < 4; ++v) hn[v] = *(const f32x4*)(pk->state_ssd_h + so + 8192 + v * 4); }
        const float dsk = pk->ssd_d[h];
#pragma unroll
        for (int t = 0; t < 4; ++t) { const float dec = decs[t * 8 + hl], xv = xs[t * 512 + hl * 64 + pp], dtx = dts[t * 8 + hl] * xv; float part = 0.f;
#pragma unroll
            for (int v = 0; v < 4; ++v) { const f32x4 bv = bvr[t][v], cv = cvr[t][v];
                hs[v] = hs[v] * dec + bv * dtx; part += cv[0] * hs[v][0] + cv[1] * hs[v][1] + cv[2] * hs[v][2] + cv[3] * hs[v][3]; }
            part += shx(part, 1, lane); part += shx(part, 2, lane); part += shx(part, 4, lane);
            if ((tid & 7) == 0) { const float y = part + dsk * xv; const float z = bf2f(proj[(size_t)(NTOKP + sbi * 4 + t) * NPROJ + C_Z + h * 64 + pp]); yg[t * 512 + hl * 64 + pp] = y * siluf(z); } }
#pragma unroll
        for (int v = 0; v < 4; ++v) *(f32x4*)(pk->out + O_SHS + so + v * 4) = hs[v];
    }
    __syncthreads();
    if (w < 4) { const int t = w; float ss = 0.f; float v[8];
#pragma unroll
        for (int e = 0; e < 8; ++e) { v[e] = yg[t * 512 + e * 64 + lane]; ss += v[e] * v[e]; }
        ss = wave_sum(ss, lane); const float rstd = rsqrtf(ss * (1.f / 512.f) + 1e-5f);
#pragma unroll
        for (int e = 0; e < 8; ++e) { const int cc = e * 64 + lane; mix[(size_t)(NTOKP + sbi * 4 + t) * DMIX + 1024 + g * 512 + cc] = f2bf(v[e] * rstd * pk->ssd_norm_g[g * 512 + cc]); } }
}

DI void ssd3_item(KP pk_in, unsigned char* lds, int b, int c, int g) {
    KP pk = pk_in; asm volatile("" : "+s"(pk));
    unsigned char* ws = pk->ws;
    const int tid = otid(), w = tid >> 6, lane = tid & 63, l15 = lane & 15, q = lane >> 4;
    float* acum_s = (float*)lds; float* cf_s = acum_s + 1024; float* dt_s = cf_s + 1024; float* rstd_s = dt_s + 1024;
    bf16_t* xT = (bf16_t*)(lds + 12800);
    bf16_t* hS = (bf16_t*)(lds + 30208);
    const bf16_t* proj = (const bf16_t*)(ws + W_PROJ); const bf16_t* xact = (const bf16_t*)(ws + W_XACT); bf16_t* mix = (bf16_t*)(ws + W_MIX);
    const float* dt_g = (const float*)(ws + W_DT); const float* acum_g = (const float*)(ws + W_ACUM); const bf16_t* st_g = (const bf16_t*)(ws + W_ST);
    const int tok0 = b * 2048 + c * 128;
    __syncthreads();
    for (int idx = tid; idx < 1024; idx += 512) { const int j = idx >> 3, hl = idx & 7; acum_s[hl * 128 + j] = acum_g[(size_t)(tok0 + j) * 16 + 8 * g + hl]; }
    const int xpb = tid & 7, xjg = (tid >> 3) & 15;
    const int hp_ = tid >> 3, hn0 = (tid & 7) * 16;
    u32x4 xr[8]; u32x4 hr[2]; bf16_t zr[16];
#define S3_LOAD(HL) do { const int h_ = 8 * g + (HL); \
        if (tid < 128) { _Pragma("unroll") for (int i = 0; i < 8; ++i) xr[i] = *(const u32x4*)(xact + (size_t)(tok0 + xjg * 8 + i) * 1536 + g * 512 + (HL) * 64 + xpb * 8); } \
        { const bf16_t* hp0 = st_g + ((size_t)((b * 16 + c) * 16 + h_) * 64 + hp_) * 128 + hn0; hr[0] = *(const u32x4*)hp0; hr[1] = *(const u32x4*)(hp0 + 8); } \
        _Pragma("unroll") for (int pt = 0; pt < 4; ++pt) _Pragma("unroll") for (int r = 0; r < 4; ++r) zr[pt * 4 + r] = proj[(size_t)(tok0 + 16 * w + 4 * q + r) * NPROJ + C_Z + h_ * 64 + 16 * pt + l15]; } while (0)
    S3_LOAD(0);
    bf16x8 cf[4];
#pragma unroll
    for (int ks = 0; ks < 4; ++ks) cf[ks] = *(const bf16x8*)(xact + (size_t)(tok0 + 16 * w + l15) * 1536 + 1280 + g * 128 + ks * 32 + q * 8);
    f32x4 cbt[8];
#pragma unroll
    for (int jt = 0; jt < 8; ++jt) { cbt[jt] = (f32x4){0.f, 0.f, 0.f, 0.f};
        if (jt <= w) {
#pragma unroll
            for (int ks = 0; ks < 4; ++ks) { const bf16x8 bfr = *(const bf16x8*)(xact + (size_t)(tok0 + 16 * jt + l15) * 1536 + 1024 + g * 128 + ks * 32 + q * 8); cbt[jt] = MFMA16(bfr, cf[ks], cbt[jt]); } } }
    __syncthreads();
    for (int idx = tid; idx < 1024; idx += 512) { const int j = idx >> 3, hl = idx & 7; const float dtv = dt_g[(size_t)(tok0 + j) * 16 + 8 * g + hl]; dt_s[hl * 128 + j] = dtv; cf_s[hl * 128 + j] = __expf(acum_s[hl * 128 + (j | 15)] - acum_s[hl * 128 + j]) * dtv; }
    float ssq[4] = {0.f, 0.f, 0.f, 0.f};
    const int irow = 16 * w + l15;
    for (int hl = 0; hl < 8; ++hl) { const int h = 8 * g + hl;
        __syncthreads();
        { if (tid < 128) {
              const unsigned xw[8][4] = {{xr[0].x, xr[0].y, xr[0].z, xr[0].w}, {xr[1].x, xr[1].y, xr[1].z, xr[1].w}, {xr[2].x, xr[2].y, xr[2].z, xr[2].w}, {xr[3].x, xr[3].y, xr[3].z, xr[3].w},
                                         {xr[4].x, xr[4].y, xr[4].z, xr[4].w}, {xr[5].x, xr[5].y, xr[5].z, xr[5].w}, {xr[6].x, xr[6].y, xr[6].z, xr[6].w}, {xr[7].x, xr[7].y, xr[7].z, xr[7].w}};
#pragma unroll
              for (int e = 0; e < 8; ++e) { u32x4 wv;
                  if ((e & 1) == 0) { wv.x = (xw[0][e >> 1] & 0xFFFFu) | (xw[1][e >> 1] << 16); wv.y = (xw[2][e >> 1] & 0xFFFFu) | (xw[3][e >> 1] << 16); wv.z = (xw[4][e >> 1] & 0xFFFFu) | (xw[5][e >> 1] << 16); wv.w = (xw[6][e >> 1] & 0xFFFFu) | (xw[7][e >> 1] << 16); }
                  else { wv.x = (xw[0][e >> 1] >> 16) | (xw[1][e >> 1] & 0xFFFF0000u); wv.y = (xw[2][e >> 1] >> 16) | (xw[3][e >> 1] & 0xFFFF0000u); wv.z = (xw[4][e >> 1] >> 16) | (xw[5][e >> 1] & 0xFFFF0000u); wv.w = (xw[6][e >> 1] >> 16) | (xw[7][e >> 1] & 0xFFFF0000u); }
                  *(u32x4*)(xT + (xpb * 8 + e) * 136 + ((xjg * 8) ^ (xpb << 3))) = wv; } }
          *(u32x4*)(hS + hp_ * 136 + hn0) = hr[0]; *(u32x4*)(hS + hp_ * 136 + hn0 + 8) = hr[1]; }
        float zz[16];
#pragma unroll
        for (int e = 0; e < 16; ++e) zz[e] = bf2f(zr[e]);
        __syncthreads();
        if (hl < 7) S3_LOAD(hl + 1);
        const float ai = acum_s[hl * 128 + irow];
        bf16x8 af[4];
#pragma unroll
        for (int s = 0; s < 4; ++s) { float m8[8];
#pragma unroll
            for (int hf = 0; hf < 2; ++hf) { const int jt = 2 * s + hf;
                const float rf = jt < w ? __expf(ai - acum_s[hl * 128 + 16 * jt + 15]) : 0.f;
#pragma unroll
                for (int r = 0; r < 4; ++r) { const int j = 16 * jt + 4 * q + r; float val = 0.f;
                    if (jt < w) val = cbt[jt][r] * rf * cf_s[hl * 128 + j];
                    else if (jt == w && j <= irow) val = cbt[jt][r] * __expf(ai - acum_s[hl * 128 + j]) * dt_s[hl * 128 + j];
                    m8[hf * 4 + r] = val; } }
            af[s] = as_frag(pack8(m8)); }
        const float dsk = pk->ssd_d[h];
        float ea[4];
#pragma unroll
        for (int r = 0; r < 4; ++r) ea[r] = __expf(acum_s[hl * 128 + 16 * w + 4 * q + r]);
#pragma unroll
        for (int pt = 0; pt < 4; ++pt) { f32x4 yd = {0.f, 0.f, 0.f, 0.f}, yo = {0.f, 0.f, 0.f, 0.f};
            const bf16_t* xrw = xT + (16 * pt + l15) * 136; const int xsw = (((16 * pt + l15) >> 3) & 15) << 3;
#pragma unroll
            for (int s = 0; s < 4; ++s) if (2 * s <= w) { const u32x2 lo = *(const u32x2*)(xrw + ((32 * s + 4 * q) ^ xsw)), hi = *(const u32x2*)(xrw + ((32 * s + 16 + 4 * q) ^ xsw)); yd = MFMA16(af[s], frag2(lo, hi), yd); }
            const bf16_t* hrw = hS + (16 * pt + l15) * 136 + q * 8;
#pragma unroll
            for (int ks = 0; ks < 4; ++ks) { const bf16x8 hf = *(const bf16x8*)(hrw + ks * 32); yo = MFMA16(cf[ks], hf, yo); }
            const u32x2 xv2 = *(const u32x2*)(xrw + ((16 * w + 4 * q) ^ xsw)); const float xv[4] = {bflo(xv2.x), bfhi(xv2.x), bflo(xv2.y), bfhi(xv2.y)};
#pragma unroll
            for (int r = 0; r < 4; ++r) { const size_t tok = (size_t)(tok0 + 16 * w + 4 * q + r); const int pp = 16 * pt + l15;
                const float y = yd[r] + ea[r] * yo[r] + dsk * xv[r]; const float val = y * siluf(zz[pt * 4 + r]);
                ssq[r] += val * val; mix[tok * DMIX + 1024 + g * 512 + hl * 64 + pp] = f2bf(val); } }
    }
#pragma unroll
    for (int r = 0; r < 4; ++r) { float sv = ssq[r]; sv += shx(sv, 1, lane); sv += shx(sv, 2, lane); sv += shx(sv, 4, lane); sv += shx(sv, 8, lane); if (l15 == 0) rstd_s[16 * w + 4 * q + r] = rsqrtf(sv * (1.f / 512.f) + 1e-5f); }
    asm volatile("s_waitcnt vmcnt(0)" ::: "memory");
    __syncthreads();
    for (int idx = tid; idx < 128 * 64; idx += 512) { const int row = idx >> 6, c8 = (idx & 63) * 8; bf16_t* mp = mix + (size_t)(tok0 + row) * DMIX + 1024 + g * 512 + c8;
        const u32x4 v = *(const u32x4*)mp; float x[8]; unpack8(v, x); const float rs = rstd_s[row];
        const f32x4 g0 = *(const f32x4*)(pk->ssd_norm_g + g * 512 + c8), g1 = *(const f32x4*)(pk->ssd_norm_g + g * 512 + c8 + 4);
        x[0] *= rs * g0[0]; x[1] *= rs * g0[1]; x[2] *= rs * g0[2]; x[3] *= rs * g0[3]; x[4] *= rs * g1[0]; x[5] *= rs * g1[1]; x[6] *= rs * g1[2]; x[7] *= rs * g1[3];
        *(u32x4*)mp = pack8(x); }
#undef S3_LOAD
}

DI void outs_item(KP pk_in, unsigned char* lds, int piece) {
    KP pk = pk_in; asm volatile("" : "+s"(pk));
    const int tid = otid(), w = tid >> 6, lane = tid & 63, l15 = lane & 15, q = lane >> 4;
    const int rg = piece >> 4, cgp = piece & 15;
    const bf16_t* mix = (const bf16_t*)(pk->ws + W_MIX); const bf16_t* wo = (const bf16_t*)(pk->ws + W_WOUTT);
    float* part = (float*)lds;
    f32x4 acc[2][4];
#pragma unroll
    for (int mt = 0; mt < 2; ++mt)
#pragma unroll
        for (int nt = 0; nt < 4; ++nt) acc[mt][nt] = (f32x4){0.f, 0.f, 0.f, 0.f};
    const bf16_t* ap = mix + (size_t)(NTOKP + rg * 32 + l15) * DMIX + w * 384 + q * 8;
    const bf16_t* bp = wo + (size_t)(cgp * 64 + l15) * 3072 + w * 384 + q * 8;
#pragma unroll 4
    for (int ks = 0; ks < 12; ++ks) { bf16x8 a[2], bb[4];
#pragma unroll
        for (int mt = 0; mt < 2; ++mt) a[mt] = *(const bf16x8*)(ap + (size_t)mt * 16 * DMIX + ks * 32);
#pragma unroll
        for (int nt = 0; nt < 4; ++nt) bb[nt] = *(const bf16x8*)(bp + (size_t)nt * 16 * 3072 + ks * 32);
#pragma unroll
        for (int mt = 0; mt < 2; ++mt)
#pragma unroll
            for (int nt = 0; nt < 4; ++nt) acc[mt][nt] = MFMA16(a[mt], bb[nt], acc[mt][nt]); }
    __syncthreads();
#pragma unroll
    for (int mt = 0; mt < 2; ++mt)
#pragma unroll
        for (int nt = 0; nt < 4; ++nt)
#pragma unroll
            for (int r = 0; r < 4; ++r) part[(w * 32 + mt * 16 + 4 * q + r) * 64 + nt * 16 + l15] = acc[mt][nt][r];
    __syncthreads();
    { const int row = tid >> 4, c4 = (tid & 15) * 4; f32x4 sum = {0.f, 0.f, 0.f, 0.f};
#pragma unroll
      for (int ww = 0; ww < 8; ++ww) sum += *(const f32x4*)(part + (ww * 32 + row) * 64 + c4);
      const int srow = rg * 32 + row, col = cgp * 64 + c4; const f32x4 xv = *(const f32x4*)(pk->x_sample + (size_t)srow * 1024 + col);
      const f32x4 v = sum + xv * 1.189207115002721f;
      float s1 = v[0] + v[1] + v[2] + v[3], s2 = v[0] * v[0] + v[1] * v[1] + v[2] * v[2] + v[3] * v[3];
      s1 += shx(s1, 1, lane); s1 += shx(s1, 2, lane); s1 += shx(s1, 4, lane); s1 += shx(s1, 8, lane); s2 += shx(s2, 1, lane); s2 += shx(s2, 2, lane); s2 += shx(s2, 4, lane); s2 += shx(s2, 8, lane);
      float* stat = (float*)(pk->ws + W_STAT) + (size_t)srow * 2; unsigned* c = (unsigned*)(pk->ws + W_CNT) + (64 + rg) * 64;
      if (l15 == 0) { __hip_atomic_fetch_add(stat, s1, __ATOMIC_RELAXED, __HIP_MEMORY_SCOPE_AGENT); __hip_atomic_fetch_add(stat + 1, s2, __ATOMIC_RELAXED, __HIP_MEMORY_SCOPE_AGENT); }
      asm volatile("s_waitcnt vmcnt(0)" ::: "memory");
      if (lane == 0) __hip_atomic_fetch_add(c, 1u, __ATOMIC_RELAXED, __HIP_MEMORY_SCOPE_AGENT);
      pg8::ln_wait(c, 128u);
      const float t1 = __hip_atomic_load(stat, __ATOMIC_RELAXED, __HIP_MEMORY_SCOPE_AGENT), t2 = __hip_atomic_load(stat + 1, __ATOMIC_RELAXED, __HIP_MEMORY_SCOPE_AGENT);
      const float mu = t1 * (1.f / 1024.f); const float rstd = rsqrtf(fmaxf(t2 * (1.f / 1024.f) - mu * mu, 0.f) + 1e-5f);
      const f32x4 gv = *(const f32x4*)(pk->ln_g + col), bv = *(const f32x4*)(pk->ln_b + col);
      *(f32x4*)(pk->out + O_YS + (size_t)srow * 1024 + col) = (v - mu) * rstd * gv + bv; }
    __syncthreads();
}

DI void ln_rows(KP pk_in) {
    KP pk = pk_in; asm volatile("" : "+s"(pk));
    const float* res = (const float*)(pk->ws + W_RES);
    const int tid = otid(); const int lane = tid & 63; const int gw = obid() * 8 + (tid >> 6), nw = gridDim.x * 8;
    f32x4 gg[4], bb[4];
#pragma unroll
    for (int i = 0; i < 4; ++i) { gg[i] = *(const f32x4*)(pk->ln_g + i * 256 + lane * 4); bb[i] = *(const f32x4*)(pk->ln_b + i * 256 + lane * 4); }
    for (int row = gw; row < NTOK; row += nw) { f32x4 v[4]; float s = 0.f;
#pragma unroll
        for (int i = 0; i < 4; ++i) { v[i] = *(const f32x4*)(res + (size_t)row * 1024 + i * 256 + lane * 4); s += v[i][0] + v[i][1] + v[i][2] + v[i][3]; }
        const float mu = wave_sum(s, lane) * (1.f / 1024.f); float s2 = 0.f;
#pragma unroll
        for (int i = 0; i < 4; ++i) { v[i] = v[i] - mu; s2 += v[i][0] * v[i][0] + v[i][1] * v[i][1] + v[i][2] * v[i][2] + v[i][3] * v[i][3]; }
        const float rstd = rsqrtf(wave_sum(s2, lane) * (1.f / 1024.f) + 1e-5f);
#pragma unroll
        for (int i = 0; i < 4; ++i) *(f32x4*)(pk->out + (size_t)row * 1024 + i * 256 + lane * 4) = v[i] * rstd * gg[i] + bb[i]; }
}

__global__ void __launch_bounds__(512, 2) hymba_fwd(Params p_unused) {
    KP pk = kparams();
    extern __shared__ __attribute__((aligned(16))) unsigned char shm[];
    cg::grid_group grid = cg::this_grid();
    const int G = gridDim.x;
    if (threadIdx.x < 4) ((volatile LAS unsigned*)(LAS unsigned char*)shm)[32768 + threadIdx.x] = 0u;
    __syncthreads();
    const int ph_lo_chk = pk->ph_lo;
    XcdBarrier xb = xcd_barrier_post((unsigned*)(pk->ws + W_BAR), (volatile LAS unsigned*)(LAS unsigned char*)shm + 32768);
    if (ph_lo_chk < 0) grid.sync();
    { KP pk = kparams(); for (int rep = 0; rep < REP0; ++rep) phase_prep(pk, shm); }
    xcd_barrier(xb);
    for (int rep = 1; rep < REPS; ++rep) xcd_barrier(xb);
    { KP pk = kparams(); const int bid = obid();
      for (int rep = 0; rep < REP1; ++rep) {
        { pg8::Gemm g; g.A = (const bf16_t*)(pk->ws + W_XB); g.Bt = (const bf16_t*)(pk->ws + W_WINT); g.M = NTOK; g.N = NPROJ; g.K = 1024;
          pg8::StaticOrder S; S.init(g.M, g.N, G, bid); pg8::EpiBf16 E; E.O = (bf16_t*)(pk->ws + W_PROJ); E.ldc = NPROJ;
          pg8::gemm_phase<pg8::EpiBf16, pg8::StaticOrder>((LAS unsigned char*)shm, g, S, E); }
        { pg8::Gemm g; g.A = (const bf16_t*)(pk->ws + W_MEMB); g.Bt = (const bf16_t*)(pk->ws + W_WKVT); g.M = 2048; g.N = 2048; g.K = 1024;
          const int shift = (66 * 26) % G; pg8::StaticOrder S; S.init(g.M, g.N, G, (bid + G - shift) % G);
          pg8::EpiKV E; E.mk = pk->out + O_MKP; E.mv = pk->out + O_MVP; E.kb = (bf16_t*)(pk->ws + W_KB); E.vt = (bf16_t*)(pk->ws + W_VT);
          pg8::gemm_phase<pg8::EpiKV, pg8::StaticOrder>((LAS unsigned char*)shm, g, S, E); } } }
    xcd_barrier(xb);
    { KP pk = kparams(); const int bid = obid();
      for (int rep = 0; rep < REP2; ++rep) for (int it = bid; it < 512; it += G) { if (it < 256) ssd1_item(pk, shm, it >> 5, (it >> 1) & 15, it & 1); else if (it < 384) rgconv_item(pk, (it - 256) >> 4, (it - 256) & 15); else { const int u = it - 384; rg_item(pk, shm, true, u >> 5, (u >> 2) & 7, u & 3); } } }
    xcd_barrier(xb);
    { KP pk = kparams(); const int bid = obid();
      for (int rep = 0; rep < REP3; ++rep) for (int kk = 0; kk < 7; ++kk) { const int kq = kk; const int it = bid + kq * G;
          if (it >= 1792) continue;
          if (rep > 0 && (it < R3LO || it >= R3HI)) continue;
          if (it < 256) rg_item(pk, shm, false, it >> 5, (it >> 2) & 7, it & 3);
          else if (it < 512) statepass_item(pk, it - 256);
          else if (it < 768) { const int u = it - 512; ssds_item(pk, shm, u >> 1, u & 1); }
          else if (it < 1280) { const int u = it - 768; attns_item(pk, shm, u >> 2, u & 3); }
          else { const int u = it - 1280; attnp_item(pk, shm, u >> 6, (u >> 4) & 3, u & 15); } } }
    xcd_barrier(xb);
    { KP pk = kparams(); const int bid = obid();
      for (int rep = 0; rep < REP4; ++rep) for (int it = bid; it < 256; it += G) ssd3_item(pk, shm, it >> 5, (it >> 1) & 15, it & 1); }
    xcd_barrier(xb);
    { KP pk = kparams(); const int bid = obid();
      for (int rep = 0; rep < REP5; ++rep) {
        for (int it = bid; it < 256; it += G) outs_item(pk, shm, it);
        pg8::Gemm g; g.A = (const bf16_t*)(pk->ws + W_MIX); g.Bt = (const bf16_t*)(pk->ws + W_WOUTT); g.M = NTOKP; g.N = 1024; g.K = 3072;
        pg8::StaticOrder S; S.init(g.M, g.N, G, bid); pg8::EpiLn E; E.out = pk->out + O_YP; E.xp = (const bf16_t*)(pk->ws + W_XB); E.lng = pk->ln_g; E.lnb = pk->ln_b; E.stat = (float*)(pk->ws + W_SLOT); E.cnt = (unsigned*)(pk->ws + W_CNT); E.alpha = 1.189207115002721f; E.red = (LAS float*)(LAS unsigned char*)shm;
        pg8::gemm_phase<pg8::EpiLn, pg8::StaticOrder>((LAS unsigned char*)shm, g, S, E); } }
}

extern "C" void kernel_launch(void* const* d_in, const int* in_sizes, int n_in, void* d_out, int out_size, void* d_ws, size_t ws_size, hipStream_t stream) {
    static int grid_blocks = 0;
    if (!grid_blocks) {
        int dev = 0, cus = 0, per_cu = 0;
        hipGetDevice(&dev);
        hipDeviceGetAttribute(&cus, hipDeviceAttributeMultiprocessorCount, dev);
        if (hipFuncSetAttribute((const void*)hymba_fwd, hipFuncAttributeMaxDynamicSharedMemorySize, LDS_BYTES) != hipSuccess) fprintf(stderr, "hipFuncSetAttribute failed\n");
        hipOccupancyMaxActiveBlocksPerMultiprocessor(&per_cu, (const void*)hymba_fwd, 512, LDS_BYTES);
        if (per_cu < 1) { fprintf(stderr, "occupancy query says %d blocks per CU\n", per_cu); per_cu = 1; }
        grid_blocks = cus * 1;
        if (ws_size < W_END) fprintf(stderr, "workspace too small: %zu < %zu\n", ws_size, (size_t)W_END);
    }
    if (hipMemsetAsync((char*)d_ws + W_BAR, 0, W_ZERO_END - W_BAR, stream) != hipSuccess) fprintf(stderr, "memset failed\n");
    Params p{};
    const float** fp = (const float**)&p;
    for (int i = 0; i < 28; ++i) fp[i] = (const float*)d_in[i];
    p.out = (float*)d_out; p.ws = (unsigned char*)d_ws;
    p.ph_lo = 0; p.ph_hi = NPHASE;
    void* args[] = {&p};
    hipError_t e = hipLaunchCooperativeKernel((const void*)hymba_fwd, dim3(grid_blocks), dim3(512), args, LDS_BYTES, stream);
    if (e != hipSuccess) fprintf(stderr, "cooperative launch failed: %s (grid %d)\n", hipGetErrorString(e), grid_blocks);
}
```

```cpp
#include <hip/hip_runtime.h>
#include <hip/hip_cooperative_groups.h>
#include <cstdio>
namespace cg = cooperative_groups;

#ifndef REP2
#define REP2 1
#endif
#ifndef REP3
#define REP3 1
#endif
#ifndef REP4
#define REP4 1
#endif
#ifndef R3LO
#define R3LO 0
#define R3HI 256
#endif
#ifndef REP0
#define REP0 1
#endif
#ifndef REP1
#define REP1 1
#endif
#ifndef REP5
#define REP5 1
#endif
#ifndef REP6
#define REP6 1
#endif
#ifndef REPS
#define REPS 1
#endif
#ifndef PHM
#define PHM 127
#endif
#ifndef N_LAUNCH_PER_PHASE
#define N_LAUNCH_PER_PHASE 0
#endif

#define DI __device__ __forceinline__
#define LAS __attribute__((address_space(3)))
typedef unsigned short bf16_t;
typedef short bf16x8 __attribute__((ext_vector_type(8)));
typedef float f32x4 __attribute__((ext_vector_type(4)));
typedef unsigned u32x4 __attribute__((ext_vector_type(4)));
typedef unsigned u32x2 __attribute__((ext_vector_type(2)));

constexpr int NTOKP = 16384, NTOKS = 512, NTOK = 16896, DM = 1024, NPROJ = 6656, DMIX = 3072, DIN = 6672;
constexpr int C_RGX = 0, C_RGG = 1024, C_XBC = 2048, C_Z = 3584, C_Q = 4608, C_XG = 5632;
constexpr int NPHASE = 7;
constexpr int LDS_BYTES = 131072 + 64;

constexpr size_t O_YP = 0, O_YS = O_YP + (size_t)NTOKP * DM, O_RGCP = O_YS + (size_t)NTOKS * DM, O_RGHP = O_RGCP + 8 * 3 * 1024, O_SCP = O_RGHP + 8 * 1024,
                 O_SHP = O_SCP + 8 * 3 * 1536, O_MKP = O_SHP + (size_t)8 * 16 * 64 * 128, O_MVP = O_MKP + (size_t)2048 * 1024, O_RGCS = O_MVP + (size_t)2048 * 1024,
                 O_RGHS = O_RGCS + (size_t)128 * 3 * 1024, O_SCS = O_RGHS + 128 * 1024, O_SHS = O_SCS + (size_t)128 * 3 * 1536;

constexpr size_t al256(size_t x) { return (x + 255) & ~(size_t)255; }
constexpr size_t W_XB = 0;
constexpr size_t W_WINT = al256(W_XB + (size_t)NTOK * DM * 2);
constexpr size_t W_WDTT = al256(W_WINT + (size_t)NPROJ * DM * 2);
constexpr size_t W_WDTF = al256(W_WDTT + 16 * 1024 * 2);
constexpr size_t W_WOUTT = al256(W_WDTF + 16 * 1024 * 4);
constexpr size_t W_WKVT = al256(W_WOUTT + (size_t)1024 * 3072 * 2);
constexpr size_t W_MEMB = al256(W_WKVT + (size_t)2048 * 1024 * 2);
constexpr size_t W_WGT = al256(W_MEMB + (size_t)2048 * 1024 * 2);
constexpr size_t W_KB = al256(W_WGT + (size_t)8 * 4 * 64 * 128 * 2);
constexpr size_t W_VT = al256(W_KB + (size_t)2048 * 1024 * 2);
constexpr size_t W_XACT = al256(W_VT + (size_t)2048 * 1024 * 2);
constexpr size_t W_DT = al256(W_XACT + (size_t)NTOKP * 1536 * 2);
constexpr size_t W_ACUM = al256(W_DT + (size_t)NTOKP * 16 * 4);
constexpr size_t W_CD = al256(W_ACUM + (size_t)NTOKP * 16 * 4);
constexpr size_t W_ST = al256(W_CD + 8 * 16 * 16 * 4);
constexpr size_t W_MIX = al256(W_ST + (size_t)8 * 16 * 16 * 8192 * 4);
constexpr size_t W_PROJ = al256(W_MIX + (size_t)NTOK * DMIX * 2);
constexpr size_t W_RES = W_PROJ;
constexpr size_t W_BAR = al256(W_PROJ + (size_t)NTOK * NPROJ * 2);
constexpr size_t W_CNT = al256(W_BAR + 3456 * 4);
constexpr size_t W_STAT = al256(W_CNT + 80 * 256);
constexpr size_t W_ZERO_END = al256(W_STAT + (size_t)NTOKS * 2 * 4);
constexpr size_t W_SLOT = W_ZERO_END;
constexpr size_t W_END = al256(W_SLOT + (size_t)NTOKP * 8 * 4);

struct Params {
    const float *x_prompt, *x_sample, *mem_prompt, *state_rg_conv, *state_rg_h, *state_ssd_conv, *state_ssd_h, *cache_k, *cache_v;
    const float *w_in, *rg_conv_w, *rg_conv_b, *w_rg_a, *b_rg_a, *w_rg_i, *b_rg_i, *rg_lambda, *ssd_conv_w, *ssd_conv_b, *ssd_dt_bias, *ssd_a_log, *ssd_d, *ssd_norm_g,
        *w_mem_k, *w_mem_v, *w_out, *ln_g, *ln_b;
    float* out; unsigned char* ws;
    int ph_lo, ph_hi;
};
typedef const __attribute__((address_space(4))) Params* KP;
DI KP kparams() { KP k = (KP)__builtin_amdgcn_kernarg_segment_ptr(); asm volatile("" : "+s"(k)); return k; }

DI int otid() { int t = threadIdx.x; asm volatile("" : "+v"(t)); return t; }
DI int obid() { int t = blockIdx.x; asm volatile("" : "+s"(t)); return t; }
DI float bf2f(bf16_t b) { return __uint_as_float(((unsigned)b) << 16); }
typedef __bf16 hbf2 __attribute__((ext_vector_type(2)));
typedef float f32x2 __attribute__((ext_vector_type(2)));
DI unsigned pack2(float lo, float hi) { const f32x2 v = {lo, hi}; return __builtin_bit_cast(unsigned, __builtin_convertvector(v, hbf2)); }
DI bf16_t f2bf(float f) { return (bf16_t)(pack2(f, 0.f) & 0xFFFFu); }
DI float bflo(unsigned w) { return __uint_as_float(w << 16); }
DI float bfhi(unsigned w) { return __uint_as_float(w & 0xFFFF0000u); }
DI void unpack8(const u32x4 v, float (&o)[8]) { o[0] = bflo(v.x); o[1] = bfhi(v.x); o[2] = bflo(v.y); o[3] = bfhi(v.y); o[4] = bflo(v.z); o[5] = bfhi(v.z); o[6] = bflo(v.w); o[7] = bfhi(v.w); }
DI u32x4 pack8(const float (&o)[8]) { u32x4 w; w.x = pack2(o[0], o[1]); w.y = pack2(o[2], o[3]); w.z = pack2(o[4], o[5]); w.w = pack2(o[6], o[7]); return w; }
DI bf16x8 as_frag(u32x4 w) { return __builtin_bit_cast(bf16x8, w); }
DI bf16x8 frag2(u32x2 lo, u32x2 hi) { u32x4 w; w.x = lo.x; w.y = lo.y; w.z = hi.x; w.w = hi.y; return __builtin_bit_cast(bf16x8, w); }
DI float shx(float v, int m, int lane) { return __int_as_float(__builtin_amdgcn_ds_bpermute((lane ^ m) << 2, __float_as_int(v))); }
DI float shl(float v, int src) { return __int_as_float(__builtin_amdgcn_ds_bpermute(src << 2, __float_as_int(v))); }
DI float siluf(float x) { return x * __builtin_amdgcn_rcpf(1.f + __expf(-x)); }
DI float sigmf(float x) { return __builtin_amdgcn_rcpf(1.f + __expf(-x)); }
DI float softplusf(float v) { return v > 20.f ? v : __logf(1.f + __expf(v)); }
#define MFMA16(a, b, c) __builtin_amdgcn_mfma_f32_16x16x32_bf16((a), (b), (c), 0, 0, 0)

#define XB_TMO      128
#define XB_XCNT(j)  (256  + 64 * (j))
#define XB_XSUB(j)  (1280 + 64 * (j))
#define XB_XGEN(j)  (2304 + 64 * (j))
#define XB_TOP      3328
#define XB_TOPGEN   3392
#define XCD_BAR_WORDS 3456
#define XB_SPIN_CAP (1u << 20)
DI unsigned xb_ld(unsigned* ptr)              { return __hip_atomic_load(ptr, __ATOMIC_RELAXED, __HIP_MEMORY_SCOPE_AGENT); }
DI unsigned xb_add(unsigned* ptr, unsigned v) { return __hip_atomic_fetch_add(ptr, v, __ATOMIC_RELAXED, __HIP_MEMORY_SCOPE_AGENT); }
DI unsigned xb_xcc_id() { return (unsigned)__builtin_amdgcn_s_getreg((3 << 11) | 20) & 0xFu; }
#define XB_SPIN(cond, bar) do { unsigned _sp = 0; while (cond) { __builtin_amdgcn_s_sleep(1); \
    if ((++_sp & 255u) == 0u) { if (xb_ld(&(bar)[XB_TMO])) break; if (_sp > XB_SPIN_CAP) { atomicAdd(&(bar)[XB_TMO], 1u); break; } } } } while (0)
struct XcdBarrier { unsigned* bar; unsigned x; volatile LAS unsigned* st; };
DI XcdBarrier xcd_barrier_post(unsigned* bar, volatile LAS unsigned* st) {
    XcdBarrier b; b.bar = bar; b.x = xb_xcc_id(); b.st = st;
    if (threadIdx.x == 0) (void)xb_add(&bar[XB_XCNT(b.x)], 1u);
    return b;
}
DI void xcd_barrier_complete(unsigned* bar, unsigned x, unsigned& nloc, unsigned& nx) {
    const unsigned G = gridDim.x * gridDim.y * gridDim.z;
    unsigned sum, cnt, mine, sp = 0u;
    for (;;) {
        sum = 0u; cnt = 0u; mine = 0u;
#pragma unroll
        for (unsigned j = 0; j < 16; ++j) { const unsigned c = xb_ld(&bar[XB_XCNT(j)]); sum += c; cnt += (c > 0u) ? 1u : 0u; mine = (j == x) ? c : mine; }
        if (sum == G) break;
        __builtin_amdgcn_s_sleep(1);
        if ((++sp & 255u) == 0u) { if (xb_ld(&bar[XB_TMO])) break; if (sp > XB_SPIN_CAP) { atomicAdd(&bar[XB_TMO], 1u); break; } }
    }
    nloc = mine > 0u ? mine : 1u; nx = cnt > 0u ? cnt : 1u;
}
DI void xcd_barrier(const XcdBarrier& b) {
    asm volatile("s_waitcnt vmcnt(0)" ::: "memory");
    __syncthreads();
    if (threadIdx.x == 0) {
        unsigned* bar = b.bar;
        __builtin_amdgcn_s_waitcnt(0);
        unsigned nloc = b.st[0], nx = b.st[1];
        if (nloc == 0u) { xcd_barrier_complete(bar, b.x, nloc, nx); b.st[0] = nloc; b.st[1] = nx; }
        const unsigned old = xb_add(&bar[XB_XSUB(b.x)], 1u);
        const unsigned gen = old / nloc;
        if (old + 1u == (gen + 1u) * nloc) {
            __builtin_amdgcn_fence(__ATOMIC_RELEASE, "agent");
            asm volatile("s_waitcnt vmcnt(0)" ::: "memory");
            const unsigned og = xb_add(&bar[XB_TOP], 1u);
            const unsigned tg = og / nx;
            if (og + 1u == (tg + 1u) * nx) xb_add(&bar[XB_TOPGEN], 1u);
            else XB_SPIN(xb_ld(&bar[XB_TOPGEN]) == tg, bar);
            __builtin_amdgcn_fence(__ATOMIC_ACQUIRE, "agent");
            xb_add(&bar[XB_XGEN(b.x)], 1u);
            asm volatile("s_waitcnt vmcnt(0)" ::: "memory");
        } else {
            XB_SPIN(xb_ld(&bar[XB_XGEN(b.x)]) == gen, bar);
            __builtin_amdgcn_fence(__ATOMIC_ACQUIRE, "agent");
            asm volatile("s_waitcnt vmcnt(0)" ::: "memory");
        }
    }
    __syncthreads();
}

namespace pg8 {
constexpr int BM = 256, BK = 64, HALF = 128, HTB = HALF * BK * 2, STAGE_BYTES = 8 * HTB, NXCD = 8, WGM = 8;
DI int lds_byte(int r, int c) { const int st = (r >> 4) * 2 + (c >> 5), rr = r & 15, cc = c & 31, ob = rr * 64 + cc * 2; return st * 1024 + (ob ^ (((ob >> 9) & 1) << 5)); }
DI void stage_rc(int b, int& R, int& C) { const int st = b / 1024, sb = b % 1024, swz = sb ^ (((sb >> 9) & 1) << 5); R = (st >> 1) * 16 + swz / 64; C = (st & 1) * 32 + (swz % 64) / 2; }
DI int perm32(int rho) { const int n = rho >> 4, i = rho & 15; return 8 * (i >> 2) + 4 * n + (i & 3); }
struct Unit { int pm, pn; };
struct Gemm { const bf16_t* A; const bf16_t* Bt; int M, N, K; };
struct StaticOrder {
    int nM, nN, nwg, G, c;
    DI void init(int M, int N, int G_, int c_) { nM = M / BM; nN = N / BM; nwg = nM * nN; G = G_; c = c_; }
    DI bool next(int i, Unit& u) const {
        const long L = (long)i * G + c; if (L >= nwg) return false;
        int wgid = (int)L; { const int q = nwg / NXCD, r = nwg % NXCD, xcd = wgid % NXCD, off = wgid / NXCD; wgid = (xcd < r ? xcd * (q + 1) : r * (q + 1) + (xcd - r) * q) + off; }
        const int nig = WGM * nN, gid = wgid / nig, fm = gid * WGM, gsz = (nM - fm) < WGM ? (nM - fm) : WGM;
        u.pm = fm + ((wgid % nig) % gsz); u.pn = (wgid % nig) / gsz; return true;
    }
};
DI unsigned cvt_pk_bf16(float lo, float hi) { unsigned r; asm volatile("v_cvt_pk_bf16_f32 %0, %1, %2" : "=v"(r) : "v"(lo), "v"(hi)); return r; }

struct EpiBf16 {
    static constexpr bool PERM = true, AFTER_DRAIN = false;
    bf16_t* O; int ldc;
    DI void operator()(const f32x4 (&acc)[2][2][4][2], const Unit& u, int wr, int wc, int fr, int fq) const {
        const int row0 = u.pm * BM + wr * 64 + fr; const int col0 = u.pn * BM + wc * 32 + 8 * fq;
#pragma unroll
        for (int ai = 0; ai < 2; ++ai)
#pragma unroll
            for (int m = 0; m < 4; ++m) { bf16_t* rowp = O + (size_t)(row0 + ai * HALF + m * 16) * ldc + col0;
#pragma unroll
                for (int bj = 0; bj < 2; ++bj) { const f32x4 v0 = acc[ai][bj][m][0], v1 = acc[ai][bj][m][1];
                    u32x4 w; w.x = cvt_pk_bf16(v0[0], v0[1]); w.y = cvt_pk_bf16(v0[2], v0[3]); w.z = cvt_pk_bf16(v1[0], v1[1]); w.w = cvt_pk_bf16(v1[2], v1[3]);
                    *(u32x4*)(rowp + bj * HALF) = w; } }
    }
};
struct EpiKV {
    static constexpr bool PERM = false, AFTER_DRAIN = false;
    float* mk; float* mv; bf16_t* kb; bf16_t* vt;
    DI void operator()(const f32x4 (&acc)[2][2][4][2], const Unit& u, int wr, int wc, int fr, int fq) const {
        const int row0 = u.pm * BM + wr * 64 + fr, col0 = u.pn * BM + wc * 32 + 4 * fq;
#pragma unroll
        for (int ai = 0; ai < 2; ++ai)
#pragma unroll
            for (int m = 0; m < 4; ++m) { const int row = row0 + ai * HALF + m * 16;
#pragma unroll
                for (int bj = 0; bj < 2; ++bj)
#pragma unroll
                    for (int n = 0; n < 2; ++n) { const int col = col0 + bj * HALF + n * 16; const f32x4 v = acc[ai][bj][m][n];
                        if (col < 1024) { *(f32x4*)(mk + (size_t)row * 1024 + col) = v; u32x2 w; w.x = cvt_pk_bf16(v[0], v[1]); w.y = cvt_pk_bf16(v[2], v[3]); *(u32x2*)(kb + (size_t)row * 1024 + col) = w; }
                        else { const int cc = col - 1024; *(f32x4*)(mv + (size_t)row * 1024 + cc) = v; const int bb = row >> 8, mt = row & 255;
#pragma unroll
                            for (int j = 0; j < 4; ++j) { const int c2 = cc + j, head = c2 >> 8, d = c2 & 255; vt[((size_t)((bb * 4 + head) * 256 + d)) * 256 + mt] = f2bf(v[j]); } } } }
    }
};
DI void ln_wait(unsigned* cnt, unsigned target) { unsigned sp = 0; while (__hip_atomic_load(cnt, __ATOMIC_RELAXED, __HIP_MEMORY_SCOPE_AGENT) < target) { __builtin_amdgcn_s_sleep(1); if (++sp > (1u << 22)) break; } }
struct EpiLn {
    static constexpr bool PERM = false, AFTER_DRAIN = true;
    float* out; const bf16_t* xp; const float* lng; const float* lnb; float* stat; unsigned* cnt; float alpha; LAS float* red;
    DI void operator()(f32x4 (&acc)[2][2][4][2], const Unit& u, int wr, int wc, int fr, int fq) const {
        const int row0 = u.pm * BM + wr * 64 + fr, col0 = u.pn * BM + wc * 32 + 4 * fq; const int lane = fq * 16 + fr; const int tid = (wr * 4 + wc) * 64 + lane;
#pragma unroll
        for (int ai = 0; ai < 2; ++ai)
#pragma unroll
            for (int m = 0; m < 4; ++m) { const int row = row0 + ai * HALF + m * 16; const bf16_t* xr = xp + (size_t)row * 1024; float s1 = 0.f, s2 = 0.f;
#pragma unroll
                for (int bj = 0; bj < 2; ++bj)
#pragma unroll
                    for (int n = 0; n < 2; ++n) { const int col = col0 + bj * HALF + n * 16; const u32x2 xb2 = *(const u32x2*)(xr + col); const f32x4 xv = {bflo(xb2.x), bfhi(xb2.x), bflo(xb2.y), bfhi(xb2.y)}; const f32x4 v = acc[ai][bj][m][n] + xv * alpha; acc[ai][bj][m][n] = v;
                        s1 += v[0] + v[1] + v[2] + v[3]; s2 += v[0] * v[0] + v[1] * v[1] + v[2] * v[2] + v[3] * v[3]; }
                s1 += shx(s1, 16, lane); s1 += shx(s1, 32, lane); s2 += shx(s2, 16, lane); s2 += shx(s2, 32, lane);
                if (fq == 0) { const int lr = wr * 64 + ai * HALF + m * 16 + fr; red[(lr * 4 + wc) * 2] = s1; red[(lr * 4 + wc) * 2 + 1] = s2; } }
        __syncthreads();
        if (tid < 256) { const int lr = tid; float t1 = 0.f, t2 = 0.f;
#pragma unroll
            for (int c = 0; c < 4; ++c) { t1 += red[(lr * 4 + c) * 2]; t2 += red[(lr * 4 + c) * 2 + 1]; }
            float* sp = stat + ((size_t)(u.pm * BM + lr) * 4 + u.pn) * 2;
            __hip_atomic_store(sp, t1, __ATOMIC_RELAXED, __HIP_MEMORY_SCOPE_AGENT); __hip_atomic_store(sp + 1, t2, __ATOMIC_RELAXED, __HIP_MEMORY_SCOPE_AGENT);
            asm volatile("s_waitcnt vmcnt(0)" ::: "memory"); }
        __syncthreads();
        unsigned* c = cnt + u.pm * 64;
        if (tid == 0) { __hip_atomic_fetch_add(c, 1u, __ATOMIC_RELAXED, __HIP_MEMORY_SCOPE_AGENT); ln_wait(c, 4u); }
        __syncthreads();
        if (tid < 256) { const int lr = tid; float t1 = 0.f, t2 = 0.f; const float* sp = stat + (size_t)(u.pm * BM + lr) * 8;
#pragma unroll
            for (int c2 = 0; c2 < 4; ++c2) { t1 += __hip_atomic_load(sp + c2 * 2, __ATOMIC_RELAXED, __HIP_MEMORY_SCOPE_AGENT); t2 += __hip_atomic_load(sp + c2 * 2 + 1, __ATOMIC_RELAXED, __HIP_MEMORY_SCOPE_AGENT); }
            const float mu = t1 * (1.f / 1024.f); red[lr * 2] = mu; red[lr * 2 + 1] = rsqrtf(fmaxf(t2 * (1.f / 1024.f) - mu * mu, 0.f) + 1e-5f); }
        __syncthreads();
#pragma unroll
        for (int ai = 0; ai < 2; ++ai)
#pragma unroll
            for (int m = 0; m < 4; ++m) { const int row = row0 + ai * HALF + m * 16; const int lr = wr * 64 + ai * HALF + m * 16 + fr; const float mu = red[lr * 2], rstd = red[lr * 2 + 1];
#pragma unroll
                for (int bj = 0; bj < 2; ++bj)
#pragma unroll
                    for (int n = 0; n < 2; ++n) { const int col = col0 + bj * HALF + n * 16; const f32x4 gv = *(const f32x4*)(lng + col), bv = *(const f32x4*)(lnb + col);
                        *(f32x4*)(out + (size_t)row * 1024 + col) = (acc[ai][bj][m][n] - mu) * rstd * gv + bv; } }
    }
};
struct EpiRes {
    static constexpr bool PERM = false, AFTER_DRAIN = false;
    float* res; const float* xp; const float* xs; float alpha;
    DI void operator()(const f32x4 (&acc)[2][2][4][2], const Unit& u, int wr, int wc, int fr, int fq) const {
        const int row0 = u.pm * BM + wr * 64 + fr, col0 = u.pn * BM + wc * 32 + 4 * fq;
#pragma unroll
        for (int ai = 0; ai < 2; ++ai)
#pragma unroll
            for (int m = 0; m < 4; ++m) { const int row = row0 + ai * HALF + m * 16; const float* xr = row < NTOKP ? xp + (size_t)row * 1024 : xs + (size_t)(row - NTOKP) * 1024;
#pragma unroll
                for (int bj = 0; bj < 2; ++bj)
#pragma unroll
                    for (int n = 0; n < 2; ++n) { const int col = col0 + bj * HALF + n * 16; const f32x4 xv = *(const f32x4*)(xr + col);
                        *(f32x4*)(res + (size_t)row * 1024 + col) = acc[ai][bj][m][n] + xv * alpha; } }
    }
};

template <class Epi, class Sched>
DI void gemm_phase(LAS unsigned char* lds, const Gemm g, const Sched& S, const Epi& E) {
    const int tid = otid(), wid = __builtin_amdgcn_readfirstlane(tid >> 6), lane = tid & 63, wr = wid >> 2, wc = wid & 3, fr = lane & 15, fq = lane >> 4;
    const int K = g.K, nt = K / BK;
    unsigned voffA[2], voffB[2];
#pragma unroll
    for (int i = 0; i < 2; ++i) { int R, C; stage_rc(tid * 16 + i * 8192, R, C); const int Rb = Epi::PERM ? ((R & ~31) + perm32(R & 31)) : R;
        voffA[i] = (unsigned)(R * K + C) * 2u; voffB[i] = (unsigned)(Rb * K + C) * 2u; }
    const size_t kstep = (size_t)(BK * 2);
    const size_t hstep = (size_t)HALF * K * 2;
    const size_t tstep = 2 * hstep;
    const unsigned ldsw = (unsigned)wid * 1024u;
    const int aoff = lds_byte(wr * 64 + fr, fq * 8), boff = lds_byte(wc * 32 + fr, fq * 8);
#define PG8_SA(b, h) (((b) * 2 + (h)) * HTB)
#define PG8_SB(b, h) ((4 + (b) * 2 + (h)) * HTB)
#define PG8_STAGE(bufoff, gbase, voff) do { _Pragma("unroll") for (int _i = 0; _i < 2; ++_i) \
        __builtin_amdgcn_global_load_lds((const unsigned*)((const char*)(gbase) + (voff)[_i]), (LAS unsigned*)(lds + (bufoff) + ldsw + _i * 8192), 16, 0, 0); } while (0)
#define PG8_LDA(dst, b, h) do { _Pragma("unroll") for (int m = 0; m < 4; ++m) _Pragma("unroll") for (int k = 0; k < 2; ++k) dst[m][k] = *(const LAS bf16x8*)(lds + PG8_SA(b, h) + aoff + m * 2048 + k * 1024); } while (0)
#define PG8_LDB(dst, b, h) do { _Pragma("unroll") for (int n = 0; n < 2; ++n) _Pragma("unroll") for (int k = 0; k < 2; ++k) dst[n][k] = *(const LAS bf16x8*)(lds + PG8_SB(b, h) + boff + n * 2048 + k * 1024); } while (0)
#define PG8_MMA(ai, bj, At, Bt) do { __builtin_amdgcn_s_setprio(1); _Pragma("unroll") for (int m = 0; m < 4; ++m) _Pragma("unroll") for (int n = 0; n < 2; ++n) _Pragma("unroll") for (int k = 0; k < 2; ++k) \
        acc[ai][bj][m][n] = __builtin_amdgcn_mfma_f32_16x16x32_bf16(Bt[n][k], At[m][k], acc[ai][bj][m][n], 0, 0, 0); __builtin_amdgcn_s_setprio(0); } while (0)
#define PG8_WAIT_V(n) asm volatile("s_waitcnt vmcnt(" #n ")" ::: "memory")
#define PG8_WAIT_L(n) asm volatile("s_waitcnt lgkmcnt(" #n ")" ::: "memory")
#define PG8_BAR __builtin_amdgcn_s_barrier()
#define PG8_SCHED __builtin_amdgcn_sched_barrier(0)
    Unit cur, nxt; int ui = 0;
    if (!S.next(0, cur)) return;
    f32x4 acc[2][2][4][2];
#pragma unroll
    for (int a = 0; a < 2; ++a)
#pragma unroll
        for (int b = 0; b < 2; ++b)
#pragma unroll
            for (int m = 0; m < 4; ++m)
#pragma unroll
                for (int n = 0; n < 2; ++n) acc[a][b][m][n] = (f32x4){0.f, 0.f, 0.f, 0.f};
    bf16x8 At[4][2], B0[2][2], B1[2][2];
    const char* cA = (const char*)g.A + (size_t)cur.pm * tstep; const char* cB = (const char*)g.Bt + (size_t)cur.pn * tstep;
    PG8_STAGE(PG8_SB(0, 0), cB, voffB); PG8_STAGE(PG8_SA(0, 0), cA, voffA); PG8_STAGE(PG8_SB(0, 1), cB + hstep, voffB); PG8_STAGE(PG8_SA(0, 1), cA + hstep, voffA);
    if (wr == 1) PG8_BAR;
    PG8_WAIT_V(4); PG8_BAR;
    PG8_STAGE(PG8_SB(1, 0), cB + kstep, voffB); PG8_STAGE(PG8_SA(1, 0), cA + kstep, voffA); PG8_STAGE(PG8_SB(1, 1), cB + hstep + kstep, voffB);
    PG8_WAIT_V(6); PG8_BAR;
    for (;;) {
        const bool has_next = S.next(ui + 1, nxt);
        const char* nA = has_next ? (const char*)g.A + (size_t)nxt.pm * tstep : cA; const char* nB = has_next ? (const char*)g.Bt + (size_t)nxt.pn * tstep : cB;
        for (int t = 0; t < nt; t += 2) {
            const bool last = (t == nt - 2);
            const char* a1 = cA + (size_t)(t + 1) * kstep;
            const char* a2 = last ? nA : cA + (size_t)(t + 2) * kstep; const char* b2 = last ? nB : cB + (size_t)(t + 2) * kstep;
            const char* a3 = a2 + kstep; const char* b3 = b2 + kstep;
            PG8_LDB(B0, 0, 0); PG8_SCHED; PG8_LDA(At, 0, 0); PG8_STAGE(PG8_SA(1, 1), a1 + hstep, voffA);
            PG8_WAIT_L(8); PG8_BAR; PG8_WAIT_L(0); PG8_MMA(0, 0, At, B0); PG8_BAR; PG8_SCHED;
            PG8_LDB(B1, 0, 1); PG8_STAGE(PG8_SB(0, 0), b2, voffB);
            PG8_BAR; PG8_WAIT_L(0); PG8_MMA(0, 1, At, B1); PG8_BAR;
            PG8_LDA(At, 0, 1); PG8_STAGE(PG8_SA(0, 0), a2, voffA);
            PG8_BAR; PG8_WAIT_L(0); PG8_MMA(1, 0, At, B0); PG8_BAR; PG8_SCHED;
            PG8_STAGE(PG8_SB(0, 1), b2 + hstep, voffB);
            PG8_WAIT_V(6); PG8_BAR; PG8_MMA(1, 1, At, B1); PG8_BAR;
            PG8_LDB(B0, 1, 0); PG8_SCHED; PG8_LDA(At, 1, 0); PG8_STAGE(PG8_SA(0, 1), a2 + hstep, voffA);
            PG8_WAIT_L(8); PG8_BAR; PG8_WAIT_L(0); PG8_MMA(0, 0, At, B0); PG8_BAR; PG8_SCHED;
            PG8_LDB(B1, 1, 1); PG8_STAGE(PG8_SB(1, 0), b3, voffB);
            PG8_BAR; PG8_WAIT_L(0); PG8_MMA(0, 1, At, B1); PG8_BAR;
            PG8_LDA(At, 1, 1); PG8_STAGE(PG8_SA(1, 0), a3, voffA);
            PG8_BAR; PG8_WAIT_L(0); PG8_MMA(1, 0, At, B0); PG8_BAR; PG8_SCHED;
            PG8_STAGE(PG8_SB(1, 1), b3 + hstep, voffB);
            PG8_WAIT_V(6); PG8_BAR; PG8_MMA(1, 1, At, B1); PG8_BAR;
        }
        if constexpr (!Epi::AFTER_DRAIN) E(acc, cur, wr, wc, fr, fq);
        if (!has_next) break;
#pragma unroll
        for (int a = 0; a < 2; ++a)
#pragma unroll
            for (int b = 0; b < 2; ++b)
#pragma unroll
                for (int m = 0; m < 4; ++m)
#pragma unroll
                    for (int n = 0; n < 2; ++n) acc[a][b][m][n] = (f32x4){0.f, 0.f, 0.f, 0.f};
        cur = nxt; cA = nA; cB = nB; ++ui;
    }
    PG8_WAIT_V(0);
    if (wr == 0) PG8_BAR;
    PG8_BAR;
    if constexpr (Epi::AFTER_DRAIN) E(acc, cur, wr, wc, fr, fq);
#undef PG8_SA
#undef PG8_SB
#undef PG8_STAGE
#undef PG8_LDA
#undef PG8_LDB
#undef PG8_MMA
#undef PG8_WAIT_V
#undef PG8_WAIT_L
#undef PG8_BAR
#undef PG8_SCHED
}
}

DI void tr_tile(const float* src, int ld_src, int k0, int c0, bf16_t* dst, int ld_dst, int n0, float* lds) {
    const int tid = otid();
#pragma unroll
    for (int pass = 0; pass < 2; ++pass) { const int r = pass * 32 + (tid >> 4), c4 = (tid & 15) * 4;
        const f32x4 v = *(const f32x4*)(src + (size_t)(k0 + r) * ld_src + c0 + c4);
        lds[r * 65 + c4 + 0] = v[0]; lds[r * 65 + c4 + 1] = v[1]; lds[r * 65 + c4 + 2] = v[2]; lds[r * 65 + c4 + 3] = v[3]; }
    __syncthreads();
    const int nn = tid >> 3, kc = (tid & 7) * 8;
    float o[8];
#pragma unroll
    for (int e = 0; e < 8; ++e) o[e] = lds[(kc + e) * 65 + nn];
    *(u32x4*)(dst + (size_t)(n0 + nn) * ld_dst + k0 + kc) = pack8(o);
    __syncthreads();
}

DI void phase_prep(KP pk_in, unsigned char* lds) {
    KP pk = pk_in; asm volatile("" : "+s"(pk));
    unsigned char* ws = pk->ws;
    const int bidx_ = obid(); const size_t gtid = (size_t)bidx_ * 512 + otid(), nthr = (size_t)gridDim.x * 512;
    { bf16_t* xb = (bf16_t*)(ws + W_XB);
      for (size_t v = gtid; v < (size_t)NTOK * 128; v += nthr) { const float* s = v < (size_t)NTOKP * 128 ? pk->x_prompt + v * 8 : pk->x_sample + (v - (size_t)NTOKP * 128) * 8;
          const f32x4 a = *(const f32x4*)s, b = *(const f32x4*)(s + 4); float o[8] = {a[0], a[1], a[2], a[3], b[0], b[1], b[2], b[3]}; *(u32x4*)(xb + v * 8) = pack8(o); } }
    { bf16_t* mb = (bf16_t*)(ws + W_MEMB);
      for (size_t v = gtid; v < (size_t)2048 * 128; v += nthr) { const float* s = pk->mem_prompt + v * 8;
          const f32x4 a = *(const f32x4*)s, b = *(const f32x4*)(s + 4); float o[8] = {a[0], a[1], a[2], a[3], b[0], b[1], b[2], b[3]}; *(u32x4*)(mb + v * 8) = pack8(o); } }
    { bf16_t* wd = (bf16_t*)(ws + W_WDTT); float* wf = (float*)(ws + W_WDTF);
      for (size_t i = gtid; i < 16 * 1024; i += nthr) { const int h = (int)(i >> 10), k = (int)(i & 1023); const float v = pk->w_in[(size_t)k * DIN + 4608 + h]; wd[i] = f2bf(v); wf[i] = v; } }
    { bf16_t* wg = (bf16_t*)(ws + W_WGT);
      for (size_t i = gtid; i < (size_t)8 * 4 * 64 * 128; i += nthr) { const int k = (int)(i >> 15), qd = (int)(i >> 13) & 3, nn = (int)(i >> 7) & 63, ii = (int)(i & 127);
          const float v = nn < 32 ? pk->w_rg_a[((size_t)k * 128 + ii) * 128 + qd * 32 + nn] : pk->w_rg_i[((size_t)k * 128 + ii) * 128 + qd * 32 + nn - 32]; wg[i] = f2bf(v); } }
    float* tl = (float*)lds;
    for (int t = bidx_; t < 1664 + 768 + 512; t += gridDim.x) {
        if (t < 1664) { const int kt = t & 15, ntile = t >> 4; const int n0 = ntile * 64, c0 = n0 < 4608 ? n0 : n0 + 16;
            tr_tile(pk->w_in, DIN, kt * 64, c0, (bf16_t*)(ws + W_WINT), 1024, n0, tl); }
        else if (t < 1664 + 768) { const int u = t - 1664; const int kt = u % 48, ntile = u / 48;
            tr_tile(pk->w_out, 1024, kt * 64, ntile * 64, (bf16_t*)(ws + W_WOUTT), 3072, ntile * 64, tl); }
        else { const int u = t - 1664 - 768; const int kt = u & 15, ntile = u >> 4; const int n0 = ntile * 64;
            if (n0 < 1024) tr_tile(pk->w_mem_k, 1024, kt * 64, n0, (bf16_t*)(ws + W_WKVT), 1024, n0, tl);
            else tr_tile(pk->w_mem_v, 1024, kt * 64, n0 - 1024, (bf16_t*)(ws + W_WKVT), 1024, n0, tl); }
    }
}

DI void conv8_ssd_prompt(KP pk, const bf16_t* proj, int rowbase, int t, int ch, float (&o)[8]) {
    const f32x4 b0 = *(const f32x4*)(pk->ssd_conv_b + ch), b1 = *(const f32x4*)(pk->ssd_conv_b + ch + 4);
    float acc[8] = {b0[0], b0[1], b0[2], b0[3], b1[0], b1[1], b1[2], b1[3]};
    u32x4 vv[4];
#pragma unroll
    for (int kk = 0; kk < 4; ++kk) { const int tt = t - 3 + kk; vv[kk] = *(const u32x4*)(proj + (size_t)(rowbase + (tt < 0 ? 0 : tt)) * NPROJ + C_XBC + ch); }
#pragma unroll
    for (int kk = 0; kk < 4; ++kk) { const int tt = t - 3 + kk; const float msk = tt >= 0 ? 1.f : 0.f; float x[8]; unpack8(vv[kk], x);
            const f32x4 w0 = *(const f32x4*)(pk->ssd_conv_w + kk * 1536 + ch) * msk, w1 = *(const f32x4*)(pk->ssd_conv_w + kk * 1536 + ch + 4) * msk;
            acc[0] += x[0] * w0[0]; acc[1] += x[1] * w0[1]; acc[2] += x[2] * w0[2]; acc[3] += x[3] * w0[3];
            acc[4] += x[4] * w1[0]; acc[5] += x[5] * w1[1]; acc[6] += x[6] * w1[2]; acc[7] += x[7] * w1[3]; }
#pragma unroll
    for (int e = 0; e < 8; ++e) o[e] = siluf(acc[e]);
}

DI void ssd1_item(KP pk_in, unsigned char* lds, int b, int c, int g) {
    KP pk = pk_in; asm volatile("" : "+s"(pk));
    unsigned char* ws = pk->ws;
    const int tid = otid(), w = tid >> 6, lane = tid & 63, l15 = lane & 15, q = lane >> 4;
    float* dt_s = (float*)lds; float* acum_s = dt_s + 2048; float* w_s = acum_s + 2048; float* seg_s = w_s + 1024;
    bf16_t* BT = (bf16_t*)(lds + 22528); bf16_t* xsT = (bf16_t*)(lds + 22528 + 34816);
    const bf16_t* xb = (const bf16_t*)(ws + W_XB); const bf16_t* wdt = (const bf16_t*)(ws + W_WDTT); const bf16_t* proj = (const bf16_t*)(ws + W_PROJ);
    bf16_t* xact = (bf16_t*)(ws + W_XACT); float* dt_g = (float*)(ws + W_DT); float* acum_g = (float*)(ws + W_ACUM); float* cd_g = (float*)(ws + W_CD); bf16_t* st_g = (bf16_t*)(ws + W_ST);
    const int tok0 = b * 2048 + c * 128;
    __syncthreads();
    { f32x4 acc = {0.f, 0.f, 0.f, 0.f}; const bf16_t* ap = xb + (size_t)(tok0 + 16 * w + l15) * 1024 + q * 8; const bf16_t* bp = wdt + l15 * 1024 + q * 8;
#pragma unroll 16
      for (int ks = 0; ks < 32; ++ks) { const bf16x8 a = *(const bf16x8*)(ap + ks * 32); const bf16x8 bb = *(const bf16x8*)(bp + ks * 32); acc = MFMA16(a, bb, acc); }
      const float bias = pk->ssd_dt_bias[l15];
#pragma unroll
      for (int r = 0; r < 4; ++r) { const int i = 16 * w + 4 * q + r; const float dt = softplusf(acc[r] + bias); dt_s[i * 16 + l15] = dt; dt_g[(size_t)(tok0 + i) * 16 + l15] = dt; } }
    __syncthreads();
    { const int hd = tid & 15, sg = tid >> 4; const float ah = -__expf(pk->ssd_a_log[hd]); float loc[8]; float run = 0.f;
      if (tid < 256) {
#pragma unroll
          for (int i = 0; i < 8; ++i) { run += dt_s[(sg * 8 + i) * 16 + hd] * ah; loc[i] = run; }
          seg_s[sg * 16 + hd] = run; }
      __syncthreads();
      if (tid < 256) { float off = 0.f; for (int s2 = 0; s2 < sg; ++s2) off += seg_s[s2 * 16 + hd];
#pragma unroll
          for (int i = 0; i < 8; ++i) { const float v = loc[i] + off; acum_s[(sg * 8 + i) * 16 + hd] = v; acum_g[(size_t)(tok0 + sg * 8 + i) * 16 + hd] = v; } } }
    __syncthreads();
    if (tid < 8) cd_g[(b * 16 + c) * 16 + 8 * g + tid] = __expf(acum_s[127 * 16 + 8 * g + tid]);
    for (int idx = tid; idx < 1024; idx += 512) { const int j = idx >> 3, hl = idx & 7, h = 8 * g + hl; w_s[idx] = dt_s[j * 16 + h] * __expf(acum_s[127 * 16 + h] - acum_s[j * 16 + h]); }
    const int cv = (tid & 31) * 8, jg = tid >> 5;
    for (int pass = 0; pass < 3; ++pass) {
        const int ch = pass == 0 ? (cv < 128 ? 1024 + g * 128 + cv : 1280 + g * 128 + (cv - 128)) : g * 512 + (pass - 1) * 256 + cv;
        float wgt[4][8], bs[8];
        { const f32x4 b0 = *(const f32x4*)(pk->ssd_conv_b + ch), b1 = *(const f32x4*)(pk->ssd_conv_b + ch + 4);
          bs[0] = b0[0]; bs[1] = b0[1]; bs[2] = b0[2]; bs[3] = b0[3]; bs[4] = b1[0]; bs[5] = b1[1]; bs[6] = b1[2]; bs[7] = b1[3];
#pragma unroll
          for (int kk = 0; kk < 4; ++kk) { const f32x4 w0 = *(const f32x4*)(pk->ssd_conv_w + kk * 1536 + ch), w1 = *(const f32x4*)(pk->ssd_conv_w + kk * 1536 + ch + 4);
              wgt[kk][0] = w0[0]; wgt[kk][1] = w0[1]; wgt[kk][2] = w0[2]; wgt[kk][3] = w0[3]; wgt[kk][4] = w1[0]; wgt[kk][5] = w1[1]; wgt[kk][6] = w1[2]; wgt[kk][7] = w1[3]; } }
        const bf16_t* src = proj + (size_t)(b * 2048) * NPROJ + C_XBC + ch; const int t0 = c * 128 + jg * 8;
        u32x4 rows[11];
#pragma unroll
        for (int i = 0; i < 11; ++i) { const int tt = t0 - 3 + i; const u32x4 v = *(const u32x4*)(src + (size_t)(tt < 0 ? 0 : tt) * NPROJ); rows[i] = tt < 0 ? (u32x4){0u, 0u, 0u, 0u} : v; }
        if (pass > 0) __syncthreads();
        unsigned tp[8][4];
#pragma unroll
        for (int i = 0; i < 8; i += 2) { float oa[8], ob[8];
#pragma unroll
            for (int hh = 0; hh < 2; ++hh) { float x0[8], x1[8], x2[8], x3[8]; unpack8(rows[i + hh], x0); unpack8(rows[i + hh + 1], x1); unpack8(rows[i + hh + 2], x2); unpack8(rows[i + hh + 3], x3); float o[8];
#pragma unroll
                for (int e = 0; e < 8; ++e) o[e] = siluf(bs[e] + x0[e] * wgt[0][e] + x1[e] * wgt[1][e] + x2[e] * wgt[2][e] + x3[e] * wgt[3][e]);
                const int j = jg * 8 + i + hh;
                *(u32x4*)(xact + (size_t)(tok0 + j) * 1536 + ch) = pack8(o);
                const float wj = pass == 0 ? 1.f : w_s[j * 8 + (pass - 1) * 4 + (cv >> 6)];
#pragma unroll
                for (int e = 0; e < 8; ++e) { if (hh == 0) oa[e] = o[e] * wj; else ob[e] = o[e] * wj; } }
#pragma unroll
            for (int e = 0; e < 8; ++e) tp[e][i >> 1] = pack2(oa[e], ob[e]); }
        if (pass == 0) { if (cv < 128) {
#pragma unroll
            for (int e = 0; e < 8; ++e) { const int rr = cv + e; u32x4 wv; wv.x = tp[e][0]; wv.y = tp[e][1]; wv.z = tp[e][2]; wv.w = tp[e][3]; *(u32x4*)(BT + rr * 136 + ((jg * 8) ^ (((rr >> 3) & 15) << 3))) = wv; } } }
        else {
#pragma unroll
            for (int e = 0; e < 8; ++e) { const int rr = cv + e; u32x4 wv; wv.x = tp[e][0]; wv.y = tp[e][1]; wv.z = tp[e][2]; wv.w = tp[e][3]; *(u32x4*)(xsT + rr * 136 + ((jg * 8) ^ (((rr >> 3) & 15) << 3))) = wv; } }
        if (pass == 0) continue;
        __syncthreads();
        const int pt = w & 3, nh = w >> 2;
#pragma unroll 1
        for (int hq = 0; hq < 4; ++hq) { const int hl = (pass - 1) * 4 + hq;
            f32x4 acc[4];
#pragma unroll
            for (int nt = 0; nt < 4; ++nt) acc[nt] = (f32x4){0.f, 0.f, 0.f, 0.f};
#pragma unroll
            for (int ks = 0; ks < 4; ++ks) { const int ra = hq * 64 + pt * 16 + l15; const bf16x8 a = *(const bf16x8*)(xsT + ra * 136 + ((ks * 32 + q * 8) ^ (((ra >> 3) & 15) << 3)));
#pragma unroll
                for (int nt = 0; nt < 4; ++nt) { const int rb = nh * 64 + nt * 16 + l15; const bf16x8 bb = *(const bf16x8*)(BT + rb * 136 + ((ks * 32 + q * 8) ^ (((rb >> 3) & 15) << 3))); acc[nt] = MFMA16(a, bb, acc[nt]); } }
            bf16_t* sp = st_g + (size_t)(((b * 16 + c) * 16 + 8 * g + hl)) * 8192;
#pragma unroll
            for (int nt = 0; nt < 4; ++nt)
#pragma unroll
                for (int r = 0; r < 4; ++r) sp[(pt * 16 + 4 * q + r) * 128 + nh * 64 + nt * 16 + l15] = f2bf(acc[nt][r]); }
    }
    if (c == 15) {
        for (int idx = tid; idx < 3 * 768; idx += 512) { const int jj = idx / 768, cc = idx % 768; const int ch = cc < 512 ? g * 512 + cc : (cc < 640 ? 1024 + g * 128 + (cc - 512) : 1280 + g * 128 + (cc - 640));
            pk->out[O_SCP + (size_t)(b * 3 + jj) * 1536 + ch] = bf2f(proj[(size_t)(b * 2048 + 2045 + jj) * NPROJ + C_XBC + ch]); }
    }
}

DI void rgconv_item(KP pk_in, int b, int tile) {
    KP pk = pk_in; asm volatile("" : "+s"(pk));
    const int tid = otid();
    const bf16_t* proj = (const bf16_t*)(pk->ws + W_PROJ); bf16_t* mix = (bf16_t*)(pk->ws + W_MIX);
    const int ch = (tid & 127) * 8, t0 = tile * 128 + (tid >> 7) * 32;
    float wgt[4][8], bs[8];
    { const f32x4 b0 = *(const f32x4*)(pk->rg_conv_b + ch), b1 = *(const f32x4*)(pk->rg_conv_b + ch + 4);
      bs[0] = b0[0]; bs[1] = b0[1]; bs[2] = b0[2]; bs[3] = b0[3]; bs[4] = b1[0]; bs[5] = b1[1]; bs[6] = b1[2]; bs[7] = b1[3];
#pragma unroll
      for (int kk = 0; kk < 4; ++kk) { const f32x4 w0 = *(const f32x4*)(pk->rg_conv_w + kk * 1024 + ch), w1 = *(const f32x4*)(pk->rg_conv_w + kk * 1024 + ch + 4);
          wgt[kk][0] = w0[0]; wgt[kk][1] = w0[1]; wgt[kk][2] = w0[2]; wgt[kk][3] = w0[3]; wgt[kk][4] = w1[0]; wgt[kk][5] = w1[1]; wgt[kk][6] = w1[2]; wgt[kk][7] = w1[3]; } }
    const bf16_t* src = proj + (size_t)(b * 2048) * NPROJ + C_RGX + ch;
    u32x4 hist[3];
#pragma unroll
    for (int i = 0; i < 3; ++i) { const int tt = t0 - 3 + i; const u32x4 v = *(const u32x4*)(src + (size_t)(tt < 0 ? 0 : tt) * NPROJ); hist[i] = tt < 0 ? (u32x4){0u, 0u, 0u, 0u} : v; }
    for (int c8 = 0; c8 < 32; c8 += 8) { u32x4 nv[8];
#pragma unroll
        for (int i = 0; i < 8; ++i) nv[i] = *(const u32x4*)(src + (size_t)(t0 + c8 + i) * NPROJ);
#pragma unroll
        for (int i = 0; i < 8; ++i) { float x0[8], x1[8], x2[8], x3[8]; unpack8(hist[0], x0); unpack8(hist[1], x1); unpack8(hist[2], x2); unpack8(nv[i], x3); float acc[8];
#pragma unroll
            for (int e = 0; e < 8; ++e) acc[e] = bs[e] + x0[e] * wgt[0][e] + x1[e] * wgt[1][e] + x2[e] * wgt[2][e] + x3[e] * wgt[3][e];
            *(u32x4*)(mix + (size_t)(b * 2048 + t0 + c8 + i) * DMIX + 1024 + ch) = pack8(acc);
            hist[0] = hist[1]; hist[1] = hist[2]; hist[2] = nv[i]; } }
}

DI void statepass_item(KP pk_in, int sp) {
    KP pk = pk_in; asm volatile("" : "+s"(pk));
    const int b = sp >> 5, h = (sp >> 1) & 15, half = sp & 1; const int e0 = half * 4096 + otid() * 8;
    bf16_t* st_g = (bf16_t*)(pk->ws + W_ST); const float* cd_g = (const float*)(pk->ws + W_CD);
    float run[8] = {0.f, 0.f, 0.f, 0.f, 0.f, 0.f, 0.f, 0.f};
    u32x4 v[16]; float cd[16];
#pragma unroll
    for (int i = 0; i < 16; ++i) { v[i] = *(const u32x4*)(st_g + (size_t)((b * 16 + i) * 16 + h) * 8192 + e0); cd[i] = cd_g[(b * 16 + i) * 16 + h]; }
#pragma unroll
    for (int i = 0; i < 16; ++i) { *(u32x4*)(st_g + (size_t)((b * 16 + i) * 16 + h) * 8192 + e0) = pack8(run); float x[8]; unpack8(v[i], x);
#pragma unroll
        for (int e = 0; e < 8; ++e) run[e] = run[e] * cd[i] + x[e]; }
    float* o = pk->out + O_SHP + (size_t)(b * 16 + h) * 8192 + e0; *(f32x4*)o = (f32x4){run[0], run[1], run[2], run[3]}; *(f32x4*)(o + 4) = (f32x4){run[4], run[5], run[6], run[7]};
}

DI void rg_item(KP pk_in, unsigned char* lds, const bool sample, int bidx, int k, int qd) {
    KP pk = pk_in; asm volatile("" : "+s"(pk));
    unsigned char* ws = pk->ws;
    const int tid = otid(), w = tid >> 6, lane = tid & 63, l15 = lane & 15, q = lane >> 4;
    bf16_t* uA = (bf16_t*)lds;
    float* wagg = (float*)(lds + 34816);
    float* hcar = wagg + 2048;
    bf16_t* wS = (bf16_t*)(lds + 73728);
    const bf16_t* proj = (const bf16_t*)(ws + W_PROJ); bf16_t* mix = (bf16_t*)(ws + W_MIX);
    const bf16_t* wg = (const bf16_t*)(ws + W_WGT) + (size_t)((k * 4 + qd) * 64) * 128;
    __syncthreads();
    for (int idx = tid; idx < 1024; idx += 512) { const int n = idx >> 4, c8 = (idx & 15) * 8; *(u32x4*)(wS + n * 136 + c8) = *(const u32x4*)(wg + n * 128 + c8); }
    if (tid < 64) hcar[tid] = 0.f;
    float ba[2], bi[2], spl[2];
#pragma unroll
    for (int ntl = 0; ntl < 2; ++ntl) { const int ch = k * 128 + qd * 32 + ntl * 16 + l15; ba[ntl] = pk->b_rg_a[ch]; bi[ntl] = pk->b_rg_i[ch]; spl[ntl] = softplusf(-pk->rg_lambda[ch]); }
    const int NT = sample ? 1 : 2;
    const int niter = sample ? 1 : 8;
    const int crow = tid >> 2, cg0 = (tid & 3) * 32;
    const bf16_t* ug = mix + 1024;
    u32x4 av[2][4]; bf16_t uv[2][8];
#define RG_LOADP(IT) do { _Pragma("unroll") for (int tt = 0; tt < 2; ++tt) { const size_t r0 = (size_t)(bidx * 2048 + (2 * (IT) + tt) * 128 + 16 * w); \
        _Pragma("unroll") for (int ks = 0; ks < 4; ++ks) av[tt][ks] = *(const u32x4*)(ug + (r0 + l15) * DMIX + k * 128 + ks * 32 + q * 8); \
        _Pragma("unroll") for (int ntl = 0; ntl < 2; ++ntl) _Pragma("unroll") for (int r = 0; r < 4; ++r) uv[tt][ntl * 4 + r] = ug[(r0 + 4 * q + r) * DMIX + k * 128 + qd * 32 + ntl * 16 + l15]; } } while (0)
    if (!sample) RG_LOADP(0);
    __syncthreads();
    for (int it = 0; it < niter; ++it) {
        const int par = it & 1;
        bf16x8 afr[2][4]; float uvf[2][8]; bf16_t gtr[2][8];
        if (!sample) {
#pragma unroll
          for (int tt = 0; tt < 2; ++tt) {
#pragma unroll
            for (int ks = 0; ks < 4; ++ks) afr[tt][ks] = as_frag(av[tt][ks]);
#pragma unroll
            for (int e = 0; e < 8; ++e) uvf[tt][e] = bf2f(uv[tt][e]); }
          if (it + 1 < 8) RG_LOADP(it + 1);
        } else { const int row = crow;
          __syncthreads();
#pragma unroll
          for (int v = 0; v < 4; ++v) { const int c8 = cg0 + v * 8, ch = k * 128 + c8;
              const f32x4 b0 = *(const f32x4*)(pk->rg_conv_b + ch), b1 = *(const f32x4*)(pk->rg_conv_b + ch + 4);
              float acc[8] = {b0[0], b0[1], b0[2], b0[3], b1[0], b1[1], b1[2], b1[3]};
#pragma unroll
              for (int kk = 0; kk < 4; ++kk) { float x[8];
                  { const int sbi = bidx * 32 + (row >> 2), ui = (row & 3) + kk; const bool st = ui < 3;
                      const float* sp_ = pk->state_rg_conv + (size_t)(sbi * 3 + (st ? ui : 2)) * 1024 + ch; const f32x4 s0 = *(const f32x4*)sp_, s1 = *(const f32x4*)(sp_ + 4);
                      const u32x4 vv = *(const u32x4*)(proj + (size_t)(NTOKP + sbi * 4 + (st ? 0 : ui - 3)) * NPROJ + C_RGX + ch); unpack8(vv, x);
                      x[0] = st ? s0[0] : x[0]; x[1] = st ? s0[1] : x[1]; x[2] = st ? s0[2] : x[2]; x[3] = st ? s0[3] : x[3];
                      x[4] = st ? s1[0] : x[4]; x[5] = st ? s1[1] : x[5]; x[6] = st ? s1[2] : x[6]; x[7] = st ? s1[3] : x[7]; }
                  { const f32x4 w0 = *(const f32x4*)(pk->rg_conv_w + kk * 1024 + ch), w1 = *(const f32x4*)(pk->rg_conv_w + kk * 1024 + ch + 4);
                      acc[0] += x[0] * w0[0]; acc[1] += x[1] * w0[1]; acc[2] += x[2] * w0[2]; acc[3] += x[3] * w0[3];
                      acc[4] += x[4] * w1[0]; acc[5] += x[5] * w1[1]; acc[6] += x[6] * w1[2]; acc[7] += x[7] * w1[3]; } }
              *(u32x4*)(uA + row * 136 + c8) = pack8(acc); }
        }
        size_t rowb[2];
#pragma unroll
        for (int tt = 0; tt < 2; ++tt) if (tt < NT) { rowb[tt] = sample ? (size_t)(NTOKP + bidx * 128 + 16 * w + 4 * q) : (size_t)(bidx * 2048 + (2 * it + tt) * 128 + 16 * w + 4 * q);
#pragma unroll
            for (int ntl = 0; ntl < 2; ++ntl)
#pragma unroll
                for (int r = 0; r < 4; ++r) gtr[tt][ntl * 4 + r] = proj[(rowb[tt] + r) * NPROJ + C_RGG + k * 128 + qd * 32 + ntl * 16 + l15]; }
        if (sample) __syncthreads();
        float Ap[2][2][4], Bp[2][2][4], Aex[2][2], Bex[2][2];
#pragma unroll
        for (int tt = 0; tt < 2; ++tt) if (tt < NT) {
            f32x4 acc[4];
#pragma unroll
            for (int nt = 0; nt < 4; ++nt) acc[nt] = (f32x4){0.f, 0.f, 0.f, 0.f};
#pragma unroll
            for (int ks = 0; ks < 4; ++ks) { const bf16x8 a = sample ? *(const bf16x8*)(uA + (16 * w + l15) * 136 + ks * 32 + q * 8) : afr[tt][ks];
#pragma unroll
                for (int nt = 0; nt < 4; ++nt) { const bf16x8 bb = *(const bf16x8*)(wS + (nt * 16 + l15) * 136 + ks * 32 + q * 8); acc[nt] = MFMA16(a, bb, acc[nt]); } }
#pragma unroll
            for (int ntl = 0; ntl < 2; ++ntl) { float A = 1.f, B = 0.f;
#pragma unroll
                for (int r = 0; r < 4; ++r) { const int row = 16 * w + 4 * q + r, cl = ntl * 16 + l15;
                    const float rr = sigmf(acc[ntl][r] + ba[ntl]), ii = sigmf(acc[2 + ntl][r] + bi[ntl]);
                    const float la = -8.f * rr * spl[ntl]; float a = __expf(la); const float uval = sample ? bf2f(uA[row * 136 + qd * 32 + cl]) : uvf[tt][ntl * 4 + r];
                    float bt = __builtin_amdgcn_sqrtf(fmaxf(1.f - a * a, 0.f)) * ii * uval;
                    const bool first = sample ? (r == 0) : (it == 0 && tt == 0 && row == 0);
                    if (first) { const float h0 = sample ? pk->state_rg_h[(size_t)(bidx * 32 + (row >> 2)) * 1024 + k * 128 + qd * 32 + cl] : 0.f; bt += a * h0; a = 0.f; }
                    B = a * B + bt; A = a * A; Ap[tt][ntl][r] = A; Bp[tt][ntl][r] = B; }
                { const float Ao = shl(A, lane - 16), Bo = shl(B, lane - 16); if (q >= 1) { B = A * Bo + B; A = A * Ao; } }
                { const float Ao = shl(A, lane - 32), Bo = shl(B, lane - 32); if (q >= 2) { B = A * Bo + B; A = A * Ao; } }
                if (q == 3) { wagg[((par * 2 + 0) * 16 + tt * 8 + w) * 32 + ntl * 16 + l15] = A; wagg[((par * 2 + 1) * 16 + tt * 8 + w) * 32 + ntl * 16 + l15] = B; }
                float Ae = shl(A, lane - 16), Be = shl(B, lane - 16); if (q == 0) { Ae = 1.f; Be = 0.f; }
                Aex[tt][ntl] = Ae; Bex[tt][ntl] = Be; } }
        __syncthreads();
#pragma unroll
        for (int ntl = 0; ntl < 2; ++ntl) { const int cl = ntl * 16 + l15; float hin = hcar[par * 32 + cl];
            float wa[16], wb[16];
#pragma unroll
            for (int e = 0; e < 16; ++e) if (e < 8 * NT) { wa[e] = wagg[((par * 2 + 0) * 16 + e) * 32 + cl]; wb[e] = wagg[((par * 2 + 1) * 16 + e) * 32 + cl]; }
#pragma unroll
            for (int tt = 0; tt < 2; ++tt) if (tt < NT) {
#pragma unroll
                for (int e = 0; e < 8; ++e) if (e < w) hin = wa[tt * 8 + e] * hin + wb[tt * 8 + e];
                const float hq = Aex[tt][ntl] * hin + Bex[tt][ntl];
                const int chg = k * 128 + qd * 32 + cl;
#pragma unroll
                for (int r = 0; r < 4; ++r) { const float h = Ap[tt][ntl][r] * hq + Bp[tt][ntl][r];
                    mix[(rowb[tt] + r) * DMIX + chg] = f2bf(h * siluf(bf2f(gtr[tt][ntl * 4 + r])));
                    if (sample) { if (r == 3) pk->out[O_RGHS + (size_t)(bidx * 32 + 4 * w + q) * 1024 + chg] = h; }
                    else if (it == 7 && tt == 1 && w == 7 && q == 3 && r == 3) pk->out[O_RGHP + (size_t)bidx * 1024 + chg] = h; }
#pragma unroll
                for (int e = 0; e < 8; ++e) if (e >= w) hin = wa[tt * 8 + e] * hin + wb[tt * 8 + e];
            }
            if (w == 7 && q == 3) hcar[(par ^ 1) * 32 + cl] = hin; }
    }
#undef RG_LOADP
    if (!sample) { if (tid < 96) { const int jj = tid >> 5, cl = tid & 31, chg = k * 128 + qd * 32 + cl;
            pk->out[O_RGCP + (size_t)(bidx * 3 + jj) * 1024 + chg] = bf2f(proj[(size_t)(bidx * 2048 + 2045 + jj) * NPROJ + C_RGX + chg]); } }
    else { for (int idx = tid; idx < 32 * 3 * 32; idx += 512) { const int cl = idx & 31, jj = (idx >> 5) % 3, sl = idx / 96; const int sbi = bidx * 32 + sl, chg = k * 128 + qd * 32 + cl;
            pk->out[O_RGCS + (size_t)(sbi * 3 + jj) * 1024 + chg] = bf2f(proj[(size_t)(NTOKP + sbi * 4 + 1 + jj) * NPROJ + C_RGX + chg]); } }
}

DI void attnp_item(KP pk_in, unsigned char* lds, int b, int head, int qt) {
    KP pk = pk_in; asm volatile("" : "+s"(pk));
    unsigned char* ws = pk->ws;
    const int tid = otid(), w = tid >> 6, lane = tid & 63, l15 = lane & 15, q = lane >> 4;
    const bf16_t* proj = (const bf16_t*)(ws + W_PROJ); const bf16_t* kb = (const bf16_t*)(ws + W_KB); const bf16_t* vt = (const bf16_t*)(ws + W_VT); bf16_t* mix = (bf16_t*)(ws + W_MIX);
    const int tokb = b * 2048 + qt * 128 + 16 * w;
    constexpr int RS = 264;
    bf16_t* sm = (bf16_t*)lds;
    const int lr = tid >> 5, lc = (tid & 31) * 8;
    const bf16_t* kbase = kb + (size_t)(b * 256) * 1024 + head * 256; const bf16_t* vbase = vt + (size_t)((b * 4 + head) * 256) * 256;
    u32x4 pre[8];
#define AT_LOAD(S) do { _Pragma("unroll") for (int i = 0; i < 8; ++i) { const int r = lr + 16 * i; \
        pre[i] = (S) < 2 ? *(const u32x4*)(kbase + (size_t)(128 * (S) + r) * 1024 + lc) : *(const u32x4*)(vbase + (size_t)(128 * ((S) - 2) + r) * 256 + lc); } } while (0)
#define AT_STORE() do { _Pragma("unroll") for (int i = 0; i < 8; ++i) *(u32x4*)(sm + (lr + 16 * i) * RS + lc) = pre[i]; } while (0)
    AT_LOAD(0);
    bf16x8 qf[8];
#pragma unroll
    for (int ks = 0; ks < 8; ++ks) qf[ks] = *(const bf16x8*)(proj + (size_t)(tokb + l15) * NPROJ + C_Q + head * 256 + ks * 32 + q * 8);
    f32x4 st[16];
#pragma unroll
    for (int s = 0; s < 2; ++s) {
        __syncthreads(); AT_STORE(); __syncthreads(); AT_LOAD(s + 1);
#pragma unroll
        for (int mtl = 0; mtl < 8; ++mtl) { const int mt = 8 * s + mtl; st[mt] = (f32x4){0.f, 0.f, 0.f, 0.f}; const bf16_t* kp = sm + (16 * mtl + l15) * RS + q * 8;
#pragma unroll
            for (int ks = 0; ks < 8; ++ks) { const bf16x8 kf = *(const bf16x8*)(kp + ks * 32); st[mt] = MFMA16(kf, qf[ks], st[mt]); } }
    }
    float mx = -3.0e38f;
#pragma unroll
    for (int mt = 0; mt < 16; ++mt)
#pragma unroll
        for (int r = 0; r < 4; ++r) { st[mt][r] *= 0.0625f; mx = fmaxf(mx, st[mt][r]); }
    mx = fmaxf(mx, shx(mx, 16, lane)); mx = fmaxf(mx, shx(mx, 32, lane));
    float l = 0.f;
#pragma unroll
    for (int mt = 0; mt < 16; ++mt)
#pragma unroll
        for (int r = 0; r < 4; ++r) { const float e = __expf(st[mt][r] - mx); st[mt][r] = e; l += e; }
    l += shx(l, 16, lane); l += shx(l, 32, lane);
    bf16x8 pf[8];
#pragma unroll
    for (int s = 0; s < 8; ++s) { float m8[8] = {st[2 * s][0], st[2 * s][1], st[2 * s][2], st[2 * s][3], st[2 * s + 1][0], st[2 * s + 1][1], st[2 * s + 1][2], st[2 * s + 1][3]}; pf[s] = as_frag(pack8(m8)); }
    float linv[4];
#pragma unroll
    for (int r = 0; r < 4; ++r) linv[r] = 1.f / shl(l, 4 * q + r);
#pragma unroll
    for (int s2 = 0; s2 < 2; ++s2) {
        __syncthreads(); AT_STORE(); __syncthreads(); if (s2 == 0) AT_LOAD(3);
#pragma unroll
        for (int dtl = 0; dtl < 8; ++dtl) { const int dt = 8 * s2 + dtl; f32x4 o = {0.f, 0.f, 0.f, 0.f}; const bf16_t* vp = sm + (16 * dtl + l15) * RS + 4 * q;
            float gt[4];
#pragma unroll
            for (int r = 0; r < 4; ++r) gt[r] = bf2f(proj[(size_t)(tokb + 4 * q + r) * NPROJ + C_XG + head * 256 + 16 * dt + l15]);
#pragma unroll
            for (int s = 0; s < 8; ++s) { const u32x2 lo = *(const u32x2*)(vp + 32 * s), hi = *(const u32x2*)(vp + 32 * s + 16); o = MFMA16(pf[s], frag2(lo, hi), o); }
#pragma unroll
            for (int r = 0; r < 4; ++r) { const size_t tok = (size_t)(tokb + 4 * q + r); const int d = 16 * dt + l15;
                mix[tok * DMIX + 2048 + head * 256 + d] = f2bf(o[r] * linv[r] * siluf(gt[r])); } }
    }
#undef AT_LOAD
#undef AT_STORE
}

DI float wave_sum(float v, int lane) { v += shx(v, 32, lane); v += shx(v, 16, lane); v += shx(v, 8, lane); v += shx(v, 4, lane); v += shx(v, 2, lane); v += shx(v, 1, lane); return v; }
DI float wave_max(float v, int lane) { v = fmaxf(v, shx(v, 32, lane)); v = fmaxf(v, shx(v, 16, lane)); v = fmaxf(v, shx(v, 8, lane)); v = fmaxf(v, shx(v, 4, lane)); v = fmaxf(v, shx(v, 2, lane)); v = fmaxf(v, shx(v, 1, lane)); return v; }

DI void attns_item(KP pk_in, unsigned char* lds, int sbi, int head) {
    KP pk = pk_in; asm volatile("" : "+s"(pk));
    unsigned char* ws = pk->ws;
    const int tid = otid(), w = tid >> 6, lane = tid & 63;
    const bf16_t* proj = (const bf16_t*)(ws + W_PROJ); bf16_t* mix = (bf16_t*)(ws + W_MIX);
    float* qs = (float*)lds; float* sc = qs + 1024; float* ored = sc + 1024;
    __syncthreads();
    for (int idx = tid; idx < 1024; idx += 512) { const int t = idx >> 8, d = idx & 255; qs[idx] = bf2f(proj[(size_t)(NTOKP + sbi * 4 + t) * NPROJ + C_Q + head * 256 + d]); }
    __syncthreads();
    f32x4 qv[4];
#pragma unroll
    for (int t = 0; t < 4; ++t) qv[t] = *(const f32x4*)(qs + t * 256 + lane * 4);
    for (int m0 = w; m0 < 256; m0 += 64) { f32x4 kv[8];
#pragma unroll
        for (int i = 0; i < 8; ++i) kv[i] = *(const f32x4*)(pk->cache_k + ((size_t)(sbi * 256 + m0 + 8 * i) * 4 + head) * 256 + lane * 4);
        float v32[32];
#pragma unroll
        for (int i = 0; i < 8; ++i)
#pragma unroll
            for (int t = 0; t < 4; ++t) v32[i * 4 + t] = kv[i][0] * qv[t][0] + kv[i][1] * qv[t][1] + kv[i][2] * qv[t][2] + kv[i][3] * qv[t][3];
        float v16[16], v8[8], v4[4], v2[2];
        { const bool up = (lane & 32) != 0;
#pragma unroll
          for (int i = 0; i < 16; ++i) { const float keep = up ? v32[i + 16] : v32[i], send = up ? v32[i] : v32[i + 16]; v16[i] = keep + shx(send, 32, lane); } }
        { const bool up = (lane & 16) != 0;
#pragma unroll
          for (int i = 0; i < 8; ++i) { const float keep = up ? v16[i + 8] : v16[i], send = up ? v16[i] : v16[i + 8]; v8[i] = keep + shx(send, 16, lane); } }
        { const bool up = (lane & 8) != 0;
#pragma unroll
          for (int i = 0; i < 4; ++i) { const float keep = up ? v8[i + 4] : v8[i], send = up ? v8[i] : v8[i + 4]; v4[i] = keep + shx(send, 8, lane); } }
        { const bool up = (lane & 4) != 0;
#pragma unroll
          for (int i = 0; i < 2; ++i) { const float keep = up ? v4[i + 2] : v4[i], send = up ? v4[i] : v4[i + 2]; v2[i] = keep + shx(send, 4, lane); } }
        float v1; { const bool up = (lane & 2) != 0; const float keep = up ? v2[1] : v2[0], send = up ? v2[0] : v2[1]; v1 = keep + shx(send, 2, lane); }
        v1 += shx(v1, 1, lane);
        if ((lane & 1) == 0) { const int ii = lane >> 1; sc[(ii & 3) * 256 + m0 + 8 * (ii >> 2)] = v1 * 0.0625f; } }
    __syncthreads();
    if (w < 4) { const f32x4 v = *(const f32x4*)(sc + w * 256 + lane * 4); float mx = fmaxf(fmaxf(v[0], v[1]), fmaxf(v[2], v[3])); mx = wave_max(mx, lane);
        f32x4 e; e[0] = __expf(v[0] - mx); e[1] = __expf(v[1] - mx); e[2] = __expf(v[2] - mx); e[3] = __expf(v[3] - mx); float s = wave_sum(e[0] + e[1] + e[2] + e[3], lane); const float inv = 1.f / s;
        *(f32x4*)(sc + w * 256 + lane * 4) = e * inv; }
    __syncthreads();
    f32x4 acc[4];
#pragma unroll
    for (int t = 0; t < 4; ++t) acc[t] = (f32x4){0.f, 0.f, 0.f, 0.f};
    for (int m0 = w; m0 < 256; m0 += 64) { f32x4 vv[8];
#pragma unroll
        for (int i = 0; i < 8; ++i) vv[i] = *(const f32x4*)(pk->cache_v + ((size_t)(sbi * 256 + m0 + 8 * i) * 4 + head) * 256 + lane * 4);
#pragma unroll
        for (int i = 0; i < 8; ++i)
#pragma unroll
            for (int t = 0; t < 4; ++t) acc[t] += vv[i] * sc[t * 256 + m0 + 8 * i]; }
#pragma unroll
    for (int t = 0; t < 4; ++t) *(f32x4*)(ored + (w * 4 + t) * 256 + lane * 4) = acc[t];
    __syncthreads();
    for (int idx = tid; idx < 1024; idx += 512) { const int t = idx >> 8, d = idx & 255; float s = 0.f;
#pragma unroll
        for (int ww = 0; ww < 8; ++ww) s += ored[(ww * 4 + t) * 256 + d];
        const size_t tok = (size_t)(NTOKP + sbi * 4 + t); const float gate = bf2f(proj[tok * NPROJ + C_XG + head * 256 + d]); mix[tok * DMIX + 2048 + head * 256 + d] = f2bf(s * siluf(gate)); }
}

DI void ssds_item(KP pk_in, unsigned char* lds, int sbi, int g) {
    KP pk = pk_in; asm volatile("" : "+s"(pk));
    unsigned char* ws = pk->ws;
    const int tid = otid(), w = tid >> 6, lane = tid & 63;
    const bf16_t* proj = (const bf16_t*)(ws + W_PROJ); bf16_t* mix = (bf16_t*)(ws + W_MIX); const float* wdf = (const float*)(ws + W_WDTF);
    float* xs = (float*)lds; float* Bs = xs + 2048; float* Cs = Bs + 512; float* yg = Cs + 512; float* dts = yg + 2048; float* decs = dts + 32;
    __syncthreads();
#pragma unroll
    for (int d = 0; d < 4; ++d) { const int pi = w * 4 + d, t = pi & 3, hl = pi >> 2, h = 8 * g + hl; float s = 0.f;
#pragma unroll
        for (int i = 0; i < 4; ++i) { const f32x4 xv = *(const f32x4*)(pk->x_sample + (size_t)(sbi * 4 + t) * 1024 + i * 256 + lane * 4), wv = *(const f32x4*)(wdf + h * 1024 + i * 256 + lane * 4);
            s += xv[0] * wv[0] + xv[1] * wv[1] + xv[2] * wv[2] + xv[3] * wv[3]; }
        s = wave_sum(s, lane);
        if (lane == 0) { const float dt = softplusf(s + pk->ssd_dt_bias[h]); dts[t * 8 + hl] = dt; decs[t * 8 + hl] = __expf(-dt * __expf(pk->ssd_a_log[h])); } }
    for (int idx = tid; idx < 4 * 768; idx += 512) { const int t = idx / 768, cc = idx % 768; const int ch = cc < 512 ? g * 512 + cc : (cc < 640 ? 1024 + g * 128 + (cc - 512) : 1280 + g * 128 + (cc - 640));
        float acc = pk->ssd_conv_b[ch];
#pragma unroll
        for (int kk = 0; kk < 4; ++kk) { const int ui = t + kk; const bool st = ui < 3;
            const float xs_ = pk->state_ssd_conv[(size_t)(sbi * 3 + (st ? ui : 2)) * 1536 + ch]; const float xp_ = bf2f(proj[(size_t)(NTOKP + sbi * 4 + (st ? 0 : ui - 3)) * NPROJ + C_XBC + ch]);
            acc += (st ? xs_ : xp_) * pk->ssd_conv_w[kk * 1536 + ch]; }
        const float a = siluf(acc);
        if (cc < 512) xs[t * 512 + cc] = a; else if (cc < 640) Bs[t * 128 + cc - 512] = a; else Cs[t * 128 + cc - 640] = a; }
    for (int idx = tid; idx < 3 * 768; idx += 512) { const int jj = idx / 768, cc = idx % 768; const int ch = cc < 512 ? g * 512 + cc : (cc < 640 ? 1024 + g * 128 + (cc - 512) : 1280 + g * 128 + (cc - 640));
        pk->out[O_SCS + (size_t)(sbi * 3 + jj) * 1536 + ch] = bf2f(proj[(size_t)(NTOKP + sbi * 4 + 1 + jj) * NPROJ + C_XBC + ch]); }
    __syncthreads();
    const int pp = tid >> 3, n0 = (tid & 7) * 16;
    f32x4 bvr[4][4], cvr[4][4];
#pragma unroll
    for (int t = 0; t < 4; ++t)
#pragma unroll
        for (int v = 0; v < 4; ++v) { bvr[t][v] = *(const f32x4*)(Bs + t * 128 + n0 + v * 4); cvr[t][v] = *(const f32x4*)(Cs + t * 128 + n0 + v * 4); }
    f32x4 hs[4], hn[4];
#pragma unroll
    for (int v = 0; v < 4; ++v) hn[v] = *(const f32x4*)(pk->state_ssd_h + ((size_t)(sbi * 16 + 8 * g) * 64 + pp) * 128 + n0 + v * 4);
    for (int hl = 0; hl < 8; ++hl) { const int h = 8 * g + hl; const size_t so = ((size_t)(sbi * 16 + h) * 64 + pp) * 128 + n0;
#pragma unroll
        for (int v = 0; v < 4; ++v) hs[v] = hn[v];
        if (hl < 7) {
#pragma unroll
            for (int v = 0; v < 4; ++v) hn[v] = *(const f32x4*)(pk->state_ssd_h + so + 8192 + v * 4); }
        const float dsk = pk->ssd_d[h];
#pragma unroll
        for (int t = 0; t < 4; ++t) { const float dec = decs[t * 8 + hl], xv = xs[t * 512 + hl * 64 + pp], dtx = dts[t * 8 + hl] * xv; float part = 0.f;
#pragma unroll
            for (int v = 0; v < 4; ++v) { const f32x4 bv = bvr[t][v], cv = cvr[t][v];
                hs[v] = hs[v] * dec + bv * dtx; part += cv[0] * hs[v][0] + cv[1] * hs[v][1] + cv[2] * hs[v][2] + cv[3] * hs[v][3]; }
            part += shx(part, 1, lane); part += shx(part, 2, lane); part += shx(part, 4, lane);
            if ((tid & 7) == 0) { const float y = part + dsk * xv; const float z = bf2f(proj[(size_t)(NTOKP + sbi * 4 + t) * NPROJ + C_Z + h * 64 + pp]); yg[t * 512 + hl * 64 + pp] = y * siluf(z); } }
#pragma unroll
        for (int v = 0; v < 4; ++v) *(f32x4*)(pk->out + O_SHS + so + v * 4) = hs[v];
    }
    __syncthreads();
    if (w < 4) { const int t = w; float ss = 0.f; float v[8];
#pragma unroll
        for (int e = 0; e < 8; ++e) { v[e] = yg[t * 512 + e * 64 + lane]; ss += v[e] * v[e]; }
        ss = wave_sum(ss, lane); const float rstd = rsqrtf(ss * (1.f / 512.f) + 1e-5f);
#pragma unroll
        for (int e = 0; e < 8; ++e) { const int cc = e * 64 + lane; mix[(size_t)(NTOKP + sbi * 4 + t) * DMIX + 1024 + g * 512 + cc] = f2bf(v[e] * rstd * pk->ssd_norm_g[g * 512 + cc]); } }
}

DI void ssd3_item(KP pk_in, unsigned char* lds, int b, int c, int g) {
    KP pk = pk_in; asm volatile("" : "+s"(pk));
    unsigned char* ws = pk->ws;
    const int tid = otid(), w = tid >> 6, lane = tid & 63, l15 = lane & 15, q = lane >> 4;
    float* acum_s = (float*)lds; float* cf_s = acum_s + 1024; float* dt_s = cf_s + 1024; float* rstd_s = dt_s + 1024;
    bf16_t* xT = (bf16_t*)(lds + 12800);
    bf16_t* hS = (bf16_t*)(lds + 30208);
    const bf16_t* proj = (const bf16_t*)(ws + W_PROJ); const bf16_t* xact = (const bf16_t*)(ws + W_XACT); bf16_t* mix = (bf16_t*)(ws + W_MIX);
    const float* dt_g = (const float*)(ws + W_DT); const float* acum_g = (const float*)(ws + W_ACUM); const bf16_t* st_g = (const bf16_t*)(ws + W_ST);
    const int tok0 = b * 2048 + c * 128;
    __syncthreads();
    for (int idx = tid; idx < 1024; idx += 512) { const int j = idx >> 3, hl = idx & 7; acum_s[hl * 128 + j] = acum_g[(size_t)(tok0 + j) * 16 + 8 * g + hl]; }
    const int xpb = tid & 7, xjg = (tid >> 3) & 15;
    const int hp_ = tid >> 3, hn0 = (tid & 7) * 16;
    u32x4 xr[8]; u32x4 hr[2]; bf16_t zr[16];
#define S3_LOAD(HL) do { const int h_ = 8 * g + (HL); \
        if (tid < 128) { _Pragma("unroll") for (int i = 0; i < 8; ++i) xr[i] = *(const u32x4*)(xact + (size_t)(tok0 + xjg * 8 + i) * 1536 + g * 512 + (HL) * 64 + xpb * 8); } \
        { const bf16_t* hp0 = st_g + ((size_t)((b * 16 + c) * 16 + h_) * 64 + hp_) * 128 + hn0; hr[0] = *(const u32x4*)hp0; hr[1] = *(const u32x4*)(hp0 + 8); } \
        _Pragma("unroll") for (int pt = 0; pt < 4; ++pt) _Pragma("unroll") for (int r = 0; r < 4; ++r) zr[pt * 4 + r] = proj[(size_t)(tok0 + 16 * w + 4 * q + r) * NPROJ + C_Z + h_ * 64 + 16 * pt + l15]; } while (0)
    S3_LOAD(0);
    bf16x8 cf[4];
#pragma unroll
    for (int ks = 0; ks < 4; ++ks) cf[ks] = *(const bf16x8*)(xact + (size_t)(tok0 + 16 * w + l15) * 1536 + 1280 + g * 128 + ks * 32 + q * 8);
    f32x4 cbt[8];
#pragma unroll
    for (int jt = 0; jt < 8; ++jt) { cbt[jt] = (f32x4){0.f, 0.f, 0.f, 0.f};
        if (jt <= w) {
#pragma unroll
            for (int ks = 0; ks < 4; ++ks) { const bf16x8 bfr = *(const bf16x8*)(xact + (size_t)(tok0 + 16 * jt + l15) * 1536 + 1024 + g * 128 + ks * 32 + q * 8); cbt[jt] = MFMA16(bfr, cf[ks], cbt[jt]); } } }
    __syncthreads();
    for (int idx = tid; idx < 1024; idx += 512) { const int j = idx >> 3, hl = idx & 7; const float dtv = dt_g[(size_t)(tok0 + j) * 16 + 8 * g + hl]; dt_s[hl * 128 + j] = dtv; cf_s[hl * 128 + j] = __expf(acum_s[hl * 128 + (j | 15)] - acum_s[hl * 128 + j]) * dtv; }
    float ssq[4] = {0.f, 0.f, 0.f, 0.f};
    const int irow = 16 * w + l15;
    for (int hl = 0; hl < 8; ++hl) { const int h = 8 * g + hl;
        __syncthreads();
        { if (tid < 128) {
              const unsigned xw[8][4] = {{xr[0].x, xr[0].y, xr[0].z, xr[0].w}, {xr[1].x, xr[1].y, xr[1].z, xr[1].w}, {xr[2].x, xr[2].y, xr[2].z, xr[2].w}, {xr[3].x, xr[3].y, xr[3].z, xr[3].w},
                                         {xr[4].x, xr[4].y, xr[4].z, xr[4].w}, {xr[5].x, xr[5].y, xr[5].z, xr[5].w}, {xr[6].x, xr[6].y, xr[6].z, xr[6].w}, {xr[7].x, xr[7].y, xr[7].z, xr[7].w}};
#pragma unroll
              for (int e = 0; e < 8; ++e) { u32x4 wv;
                  if ((e & 1) == 0) { wv.x = (xw[0][e >> 1] & 0xFFFFu) | (xw[1][e >> 1] << 16); wv.y = (xw[2][e >> 1] & 0xFFFFu) | (xw[3][e >> 1] << 16); wv.z = (xw[4][e >> 1] & 0xFFFFu) | (xw[5][e >> 1] << 16); wv.w = (xw[6][e >> 1] & 0xFFFFu) | (xw[7][e >> 1] << 16); }
                  else { wv.x = (xw[0][e >> 1] >> 16) | (xw[1][e >> 1] & 0xFFFF0000u); wv.y = (xw[2][e >> 1] >> 16) | (xw[3][e >> 1] & 0xFFFF0000u); wv.z = (xw[4][e >> 1] >> 16) | (xw[5][e >> 1] & 0xFFFF0000u); wv.w = (xw[6][e >> 1] >> 16) | (xw[7][e >> 1] & 0xFFFF0000u); }
                  *(u32x4*)(xT + (xpb * 8 + e) * 136 + ((xjg * 8) ^ (xpb << 3))) = wv; } }
          *(u32x4*)(hS + hp_ * 136 + hn0) = hr[0]; *(u32x4*)(hS + hp_ * 136 + hn0 + 8) = hr[1]; }
        float zz[16];
#pragma unroll
        for (int e = 0; e < 16; ++e) zz[e] = bf2f(zr[e]);
        __syncthreads();
        if (hl < 7) S3_LOAD(hl + 1);
        const float ai = acum_s[hl * 128 + irow];
        bf16x8 af[4];
#pragma unroll
        for (int s = 0; s < 4; ++s) { float m8[8];
#pragma unroll
            for (int hf = 0; hf < 2; ++hf) { const int jt = 2 * s + hf;
                const float rf = jt < w ? __expf(ai - acum_s[hl * 128 + 16 * jt + 15]) : 0.f;
#pragma unroll
                for (int r = 0; r < 4; ++r) { const int j = 16 * jt + 4 * q + r; float val = 0.f;
                    if (jt < w) val = cbt[jt][r] * rf * cf_s[hl * 128 + j];
                    else if (jt == w && j <= irow) val = cbt[jt][r] * __expf(ai - acum_s[hl * 128 + j]) * dt_s[hl * 128 + j];
                    m8[hf * 4 + r] = val; } }
            af[s] = as_frag(pack8(m8)); }
        const float dsk = pk->ssd_d[h];
        float ea[4];
#pragma unroll
        for (int r = 0; r < 4; ++r) ea[r] = __expf(acum_s[hl * 128 + 16 * w + 4 * q + r]);
#pragma unroll
        for (int pt = 0; pt < 4; ++pt) { f32x4 yd = {0.f, 0.f, 0.f, 0.f}, yo = {0.f, 0.f, 0.f, 0.f};
            const bf16_t* xrw = xT + (16 * pt + l15) * 136; const int xsw = (((16 * pt + l15) >> 3) & 15) << 3;
#pragma unroll
            for (int s = 0; s < 4; ++s) if (2 * s <= w) { const u32x2 lo = *(const u32x2*)(xrw + ((32 * s + 4 * q) ^ xsw)), hi = *(const u32x2*)(xrw + ((32 * s + 16 + 4 * q) ^ xsw)); yd = MFMA16(af[s], frag2(lo, hi), yd); }
            const bf16_t* hrw = hS + (16 * pt + l15) * 136 + q * 8;
#pragma unroll
            for (int ks = 0; ks < 4; ++ks) { const bf16x8 hf = *(const bf16x8*)(hrw + ks * 32); yo = MFMA16(cf[ks], hf, yo); }
            const u32x2 xv2 = *(const u32x2*)(xrw + ((16 * w + 4 * q) ^ xsw)); const float xv[4] = {bflo(xv2.x), bfhi(xv2.x), bflo(xv2.y), bfhi(xv2.y)};
#pragma unroll
            for (int r = 0; r < 4; ++r) { const size_t tok = (size_t)(tok0 + 16 * w + 4 * q + r); const int pp = 16 * pt + l15;
                const float y = yd[r] + ea[r] * yo[r] + dsk * xv[r]; const float val = y * siluf(zz[pt * 4 + r]);
                ssq[r] += val * val; mix[tok * DMIX + 1024 + g * 512 + hl * 64 + pp] = f2bf(val); } }
    }
#pragma unroll
    for (int r = 0; r < 4; ++r) { float sv = ssq[r]; sv += shx(sv, 1, lane); sv += shx(sv, 2, lane); sv += shx(sv, 4, lane); sv += shx(sv, 8, lane); if (l15 == 0) rstd_s[16 * w + 4 * q + r] = rsqrtf(sv * (1.f / 512.f) + 1e-5f); }
    asm volatile("s_waitcnt vmcnt(0)" ::: "memory");
    __syncthreads();
    for (int idx = tid; idx < 128 * 64; idx += 512) { const int row = idx >> 6, c8 = (idx & 63) * 8; bf16_t* mp = mix + (size_t)(tok0 + row) * DMIX + 1024 + g * 512 + c8;
        const u32x4 v = *(const u32x4*)mp; float x[8]; unpack8(v, x); const float rs = rstd_s[row];
        const f32x4 g0 = *(const f32x4*)(pk->ssd_norm_g + g * 512 + c8), g1 = *(const f32x4*)(pk->ssd_norm_g + g * 512 + c8 + 4);
        x[0] *= rs * g0[0]; x[1] *= rs * g0[1]; x[2] *= rs * g0[2]; x[3] *= rs * g0[3]; x[4] *= rs * g1[0]; x[5] *= rs * g1[1]; x[6] *= rs * g1[2]; x[7] *= rs * g1[3];
        *(u32x4*)mp = pack8(x); }
#undef S3_LOAD
}

DI void outs_item(KP pk_in, unsigned char* lds, int piece) {
    KP pk = pk_in; asm volatile("" : "+s"(pk));
    const int tid = otid(), w = tid >> 6, lane = tid & 63, l15 = lane & 15, q = lane >> 4;
    const int rg = piece >> 4, cgp = piece & 15;
    const bf16_t* mix = (const bf16_t*)(pk->ws + W_MIX); const bf16_t* wo = (const bf16_t*)(pk->ws + W_WOUTT);
    float* part = (float*)lds;
    f32x4 acc[2][4];
#pragma unroll
    for (int mt = 0; mt < 2; ++mt)
#pragma unroll
        for (int nt = 0; nt < 4; ++nt) acc[mt][nt] = (f32x4){0.f, 0.f, 0.f, 0.f};
    const bf16_t* ap = mix + (size_t)(NTOKP + rg * 32 + l15) * DMIX + w * 384 + q * 8;
    const bf16_t* bp = wo + (size_t)(cgp * 64 + l15) * 3072 + w * 384 + q * 8;
#pragma unroll 4
    for (int ks = 0; ks < 12; ++ks) { bf16x8 a[2], bb[4];
#pragma unroll
        for (int mt = 0; mt < 2; ++mt) a[mt] = *(const bf16x8*)(ap + (size_t)mt * 16 * DMIX + ks * 32);
#pragma unroll
        for (int nt = 0; nt < 4; ++nt) bb[nt] = *(const bf16x8*)(bp + (size_t)nt * 16 * 3072 + ks * 32);
#pragma unroll
        for (int mt = 0; mt < 2; ++mt)
#pragma unroll
            for (int nt = 0; nt < 4; ++nt) acc[mt][nt] = MFMA16(a[mt], bb[nt], acc[mt][nt]); }
    __syncthreads();
#pragma unroll
    for (int mt = 0; mt < 2; ++mt)
#pragma unroll
        for (int nt = 0; nt < 4; ++nt)
#pragma unroll
            for (int r = 0; r < 4; ++r) part[(w * 32 + mt * 16 + 4 * q + r) * 64 + nt * 16 + l15] = acc[mt][nt][r];
    __syncthreads();
    { const int row = tid >> 4, c4 = (tid & 15) * 4; f32x4 sum = {0.f, 0.f, 0.f, 0.f};
#pragma unroll
      for (int ww = 0; ww < 8; ++ww) sum += *(const f32x4*)(part + (ww * 32 + row) * 64 + c4);
      const int srow = rg * 32 + row, col = cgp * 64 + c4; const f32x4 xv = *(const f32x4*)(pk->x_sample + (size_t)srow * 1024 + col);
      const f32x4 v = sum + xv * 1.189207115002721f;
      float s1 = v[0] + v[1] + v[2] + v[3], s2 = v[0] * v[0] + v[1] * v[1] + v[2] * v[2] + v[3] * v[3];
      s1 += shx(s1, 1, lane); s1 += shx(s1, 2, lane); s1 += shx(s1, 4, lane); s1 += shx(s1, 8, lane); s2 += shx(s2, 1, lane); s2 += shx(s2, 2, lane); s2 += shx(s2, 4, lane); s2 += shx(s2, 8, lane);
      float* stat = (float*)(pk->ws + W_STAT) + (size_t)srow * 2; unsigned* c = (unsigned*)(pk->ws + W_CNT) + (64 + rg) * 64;
      if (l15 == 0) { __hip_atomic_fetch_add(stat, s1, __ATOMIC_RELAXED, __HIP_MEMORY_SCOPE_AGENT); __hip_atomic_fetch_add(stat + 1, s2, __ATOMIC_RELAXED, __HIP_MEMORY_SCOPE_AGENT); }
      asm volatile("s_waitcnt vmcnt(0)" ::: "memory");
      if (lane == 0) __hip_atomic_fetch_add(c, 1u, __ATOMIC_RELAXED, __HIP_MEMORY_SCOPE_AGENT);
      pg8::ln_wait(c, 128u);
      const float t1 = __hip_atomic_load(stat, __ATOMIC_RELAXED, __HIP_MEMORY_SCOPE_AGENT), t2 = __hip_atomic_load(stat + 1, __ATOMIC_RELAXED, __HIP_MEMORY_SCOPE_AGENT);
      const float mu = t1 * (1.f / 1024.f); const float rstd = rsqrtf(fmaxf(t2 * (1.f / 1024.f) - mu * mu, 0.f) + 1e-5f);
      const f32x4 gv = *(const f32x4*)(pk->ln_g + col), bv = *(const f32x4*)(pk->ln_b + col);
      *(f32x4*)(pk->out + O_YS + (size_t)srow * 1024 + col) = (v - mu) * rstd * gv + bv; }
    __syncthreads();
}

DI void ln_rows(KP pk_in) {
    KP pk = pk_in; asm volatile("" : "+s"(pk));
    const float* res = (const float*)(pk->ws + W_RES);
    const int tid = otid(); const int lane = tid & 63; const int gw = obid() * 8 + (tid >> 6), nw = gridDim.x * 8;
    f32x4 gg[4], bb[4];
#pragma unroll
    for (int i = 0; i < 4; ++i) { gg[i] = *(const f32x4*)(pk->ln_g + i * 256 + lane * 4); bb[i] = *(const f32x4*)(pk->ln_b + i * 256 + lane * 4); }
    for (int row = gw; row < NTOK; row += nw) { f32x4 v[4]; float s = 0.f;
#pragma unroll
        for (int i = 0; i < 4; ++i) { v[i] = *(const f32x4*)(res + (size_t)row * 1024 + i * 256 + lane * 4); s += v[i][0] + v[i][1] + v[i][2] + v[i][3]; }
        const float mu = wave_sum(s, lane) * (1.f / 1024.f); float s2 = 0.f;
#pragma unroll
        for (int i = 0; i < 4; ++i) { v[i] = v[i] - mu; s2 += v[i][0] * v[i][0] + v[i][1] * v[i][1] + v[i][2] * v[i][2] + v[i][3] * v[i][3]; }
        const float rstd = rsqrtf(wave_sum(s2, lane) * (1.f / 1024.f) + 1e-5f);
#pragma unroll
        for (int i = 0; i < 4; ++i) *(f32x4*)(pk->out + (size_t)row * 1024 + i * 256 + lane * 4) = v[i] * rstd * gg[i] + bb[i]; }
}

__global__ void __launch_bounds__(512, 2) hymba_fwd(Params p_unused) {
    KP pk = kparams();
    extern __shared__ __attribute__((aligned(16))) unsigned char shm[];
    cg::grid_group grid = cg::this_grid();
    const int G = gridDim.x;
    if (threadIdx.x < 4) ((volatile LAS unsigned*)(LAS unsigned char*)shm)[32768 + threadIdx.x] = 0u;
    __syncthreads();
    const int ph_lo_chk = pk->ph_lo;
    XcdBarrier xb = xcd_barrier_post((unsigned*)(pk->ws + W_BAR), (volatile LAS unsigned*)(LAS unsigned char*)shm + 32768);
    if (ph_lo_chk < 0) grid.sync();
    { KP pk = kparams(); for (int rep = 0; rep < REP0; ++rep) phase_prep(pk, shm); }
    xcd_barrier(xb);
    for (int rep = 1; rep < REPS; ++rep) xcd_barrier(xb);
    { KP pk = kparams(); const int bid = obid();
      for (int rep = 0; rep < REP1; ++rep) {
        { pg8::Gemm g; g.A = (const bf16_t*)(pk->ws + W_XB); g.Bt = (const bf16_t*)(pk->ws + W_WINT); g.M = NTOK; g.N = NPROJ; g.K = 1024;
          pg8::StaticOrder S; S.init(g.M, g.N, G, bid); pg8::EpiBf16 E; E.O = (bf16_t*)(pk->ws + W_PROJ); E.ldc = NPROJ;
          pg8::gemm_phase<pg8::EpiBf16, pg8::StaticOrder>((LAS unsigned char*)shm, g, S, E); }
        { pg8::Gemm g; g.A = (const bf16_t*)(pk->ws + W_MEMB); g.Bt = (const bf16_t*)(pk->ws + W_WKVT); g.M = 2048; g.N = 2048; g.K = 1024;
          const int shift = (66 * 26) % G; pg8::StaticOrder S; S.init(g.M, g.N, G, (bid + G - shift) % G);
          pg8::EpiKV E; E.mk = pk->out + O_MKP; E.mv = pk->out + O_MVP; E.kb = (bf16_t*)(pk->ws + W_KB); E.vt = (bf16_t*)(pk->ws + W_VT);
          pg8::gemm_phase<pg8::EpiKV, pg8::StaticOrder>((LAS unsigned char*)shm, g, S, E); } } }
    xcd_barrier(xb);
    { KP pk = kparams(); const int bid = obid();
      for (int rep = 0; rep < REP2; ++rep) for (int it = bid; it < 512; it += G) { if (it < 256) ssd1_item(pk, shm, it >> 5, (it >> 1) & 15, it & 1); else if (it < 384) rgconv_item(pk, (it - 256) >> 4, (it - 256) & 15); else { const int u = it - 384; rg_item(pk, shm, true, u >> 5, (u >> 2) & 7, u & 3); } } }
    xcd_barrier(xb);
    { KP pk = kparams(); const int bid = obid();
      for (int rep = 0; rep < REP3; ++rep) for (int kk = 0; kk < 7; ++kk) { const int kq = kk; const int it = bid + kq * G;
          if (it >= 1792) continue;
          if (rep > 0 && (it < R3LO || it >= R3HI)) continue;
          if (it < 256) rg_item(pk, shm, false, it >> 5, (it >> 2) & 7, it & 3);
          else if (it < 512) statepass_item(pk, it - 256);
          else if (it < 768) { const int u = it - 512; ssds_item(pk, shm, u >> 1, u & 1); }
          else if (it < 1280) { const int u = it - 768; attns_item(pk, shm, u >> 2, u & 3); }
          else { const int u = it - 1280; attnp_item(pk, shm, u >> 6, (u >> 4) & 3, u & 15); } } }
    xcd_barrier(xb);
    { KP pk = kparams(); const int bid = obid();
      for (int rep = 0; rep < REP4; ++rep) for (int it = bid; it < 256; it += G) ssd3_item(pk, shm, it >> 5, (it >> 1) & 15, it & 1); }
    xcd_barrier(xb);
    { KP pk = kparams(); const int bid = obid();
      for (int rep = 0; rep < REP5; ++rep) {
        for (int it = bid; it < 256; it += G) outs_item(pk, shm, it);
        pg8::Gemm g; g.A = (const bf16_t*)(pk->ws + W_MIX); g.Bt = (const bf16_t*)(pk->ws + W_WOUTT); g.M = NTOKP; g.N = 1024; g.K = 3072;
        pg8::StaticOrder S; S.init(g.M, g.N, G, bid); pg8::EpiLn E; E.out = pk->out + O_YP; E.xp = (const bf16_t*)(pk->ws + W_XB); E.lng = pk->ln_g; E.lnb = pk->ln_b; E.stat = (float*)(pk->ws + W_SLOT); E.cnt = (unsigned*)(pk->ws + W_CNT); E.alpha = 1.189207115002721f; E.red = (LAS float*)(LAS unsigned char*)shm;
        pg8::gemm_phase<pg8::EpiLn, pg8::StaticOrder>((LAS unsigned char*)shm, g, S, E); } }
}

extern "C" void kernel_launch(void* const* d_in, const int* in_sizes, int n_in, void* d_out, int out_size, void* d_ws, size_t ws_size, hipStream_t stream) {
    static int grid_blocks = 0;
    if (!grid_blocks) {
        int dev = 0, cus = 0, per_cu = 0;
        hipGetDevice(&dev);
        hipDeviceGetAttribute(&cus, hipDeviceAttributeMultiprocessorCount, dev);
        if (hipFuncSetAttribute((const void*)hymba_fwd, hipFuncAttributeMaxDynamicSharedMemorySize, LDS_BYTES) != hipSuccess) fprintf(stderr, "hipFuncSetAttribute failed\n");
        hipOccupancyMaxActiveBlocksPerMultiprocessor(&per_cu, (const void*)hymba_fwd, 512, LDS_BYTES);
        if (per_cu < 1) { fprintf(stderr, "occupancy query says %d blocks per CU\n", per_cu); per_cu = 1; }
        grid_blocks = cus * 1;
        if (ws_size < W_END) fprintf(stderr, "workspace too small: %zu < %zu\n", ws_size, (size_t)W_END);
    }
    if (hipMemsetAsync((char*)d_ws + W_BAR, 0, W_ZERO_END - W_BAR, stream) != hipSuccess) fprintf(stderr, "memset failed\n");
    Params p{};
    const float** fp = (const float**)&p;
    for (int i = 0; i < 28; ++i) fp[i] = (const float*)d_in[i];
    p.out = (float*)d_out; p.ws = (unsigned char*)d_ws;
    p.ph_lo = 0; p.ph_hi = NPHASE;
    void* args[] = {&p};
    hipError_t e = hipLaunchCooperativeKernel((const void*)hymba_fwd, dim3(grid_blocks), dim3(512), args, LDS_BYTES, stream);
    if (e != hipSuccess) fprintf(stderr, "cooperative launch failed: %s (grid %d)\n", hipGetErrorString(e), grid_blocks);
}
```
